# Optimizing an MI355X kernel written in HIP

```python
import math
import jax, jax.numpy as jnp
from jax import lax
import numpy as np

D_MODEL = 1024
BATCH = 8
SEQ = 4096
DEPTH = 1

HEAD_DIM = 64
DIL_GROUPS = ((128, 1), (512, 4), (2048, 16))
DIL_HEADS = 4
DIL_WIDTH = len(DIL_GROUPS) * DIL_HEADS * HEAD_DIM
DIL_OUT = DIL_HEADS * HEAD_DIM
SWA_Q_HEADS = 16
SWA_KV_HEADS = 2
SWA_REP = SWA_Q_HEADS // SWA_KV_HEADS
SWA_WINDOW = 128
SWA_Q_WIDTH = SWA_Q_HEADS * HEAD_DIM
SWA_KV_WIDTH = SWA_KV_HEADS * HEAD_DIM
N_ALIBI_HEADS = SWA_Q_HEADS + len(DIL_GROUPS) * DIL_HEADS
ATTN_BLOCK = 128
SPLIT_SIZES = (DIL_WIDTH, DIL_WIDTH, DIL_WIDTH, SWA_Q_WIDTH, SWA_KV_WIDTH, SWA_KV_WIDTH, D_MODEL, D_MODEL)
SPLIT_POINTS = tuple(sum(SPLIT_SIZES[:i + 1]) for i in range(len(SPLIT_SIZES) - 1))
IN_COLS = sum(SPLIT_SIZES)
N_EXPERTS = 32
TOP_K = 4
D_FF = 1024
SWIGLU_LIMIT = 7.0
SWIGLU_ALPHA = 1.702
MOE_BLOCK = 128
LN_EPS = 1e-5
DEEPNORM_ALPHA = (2 * DEPTH) ** 0.25
DEEPNORM_BETA = (8 * DEPTH) ** -0.25
NEG_INF = -1e30

kernel_name = "hybrid_dilated_swa_sink_moe_deepnorm"


def layer_norm(x, g, b):
    xf = x.astype(jnp.float32)
    mu = jnp.mean(xf, axis=-1, keepdims=True)
    var = jnp.mean(jnp.square(xf - mu), axis=-1, keepdims=True)
    y = (xf - mu) * lax.rsqrt(var + LN_EPS) * g.astype(jnp.float32) + b.astype(jnp.float32)
    return y.astype(x.dtype)


def alibi_slopes():
    h = jnp.arange(1, N_ALIBI_HEADS + 1, dtype=jnp.float32)
    return jnp.exp2(-8.0 * h / N_ALIBI_HEADS)


def banded_attention(q, k, v, slopes, max_diff, dist_scale, sinks):
    n, g, r, L, hd = q.shape
    nb = -(-L // ATTN_BLOCK)
    pad = nb * ATTN_BLOCK - L
    q = jnp.pad(q, ((0, 0), (0, 0), (0, 0), (0, pad), (0, 0)))
    k = jnp.pad(k, ((0, 0), (0, 0), (ATTN_BLOCK, pad), (0, 0)))
    v = jnp.pad(v, ((0, 0), (0, 0), (ATTN_BLOCK, pad), (0, 0)))
    qb = q.reshape(n, g, r, nb, ATTN_BLOCK, hd)
    kb = k.reshape(n, g, nb + 1, ATTN_BLOCK, hd)
    vb = v.reshape(n, g, nb + 1, ATTN_BLOCK, hd)
    kw = jnp.concatenate([kb[:, :, :-1], kb[:, :, 1:]], axis=3)
    vw = jnp.concatenate([vb[:, :, :-1], vb[:, :, 1:]], axis=3)
    s = jnp.einsum('ngrbqd,ngbkd->ngrbqk', qb, kw, preferred_element_type=jnp.float32) * (hd ** -0.5)
    qi = jnp.arange(ATTN_BLOCK)[:, None]
    kj = jnp.arange(2 * ATTN_BLOCK)[None, :]
    diff = qi - kj + ATTN_BLOCK
    kpos = jnp.arange(nb)[:, None, None] * ATTN_BLOCK - ATTN_BLOCK + kj[None]
    valid = (diff >= 0) & (diff <= max_diff) & (kpos >= 0)
    bias = -slopes.astype(jnp.float32)[:, :, None, None, None] * (dist_scale * diff).astype(jnp.float32)
    s = jnp.where(valid, s + bias, NEG_INF)
    m = jnp.max(s, axis=-1)
    if sinks is not None:
        sink = sinks.astype(jnp.float32)[:, :, None, None]
        m = jnp.maximum(m, sink)
    p = jnp.exp(s - m[..., None])
    denom = jnp.sum(p, axis=-1)
    if sinks is not None:
        denom = denom + jnp.exp(sink - m)
    o = jnp.einsum('ngrbqk,ngbkd->ngrbqd', p.astype(v.dtype), vw, preferred_element_type=jnp.float32)
    o = o / denom[..., None]
    lse = m + jnp.log(denom)
    o = o.reshape(n, g, r, nb * ATTN_BLOCK, hd)[:, :, :, :L]
    lse = lse.reshape(n, g, r, nb * ATTN_BLOCK)[:, :, :, :L]
    return o.astype(q.dtype), lse


def dilated_attention(q, k, v, slopes_a):
    b, S, _ = q.shape
    q = q.reshape(b, S, len(DIL_GROUPS), DIL_HEADS, HEAD_DIM)
    k = k.reshape(b, S, len(DIL_GROUPS), DIL_HEADS, HEAD_DIM)
    v = v.reshape(b, S, len(DIL_GROUPS), DIL_HEADS, HEAD_DIM)
    outs, lses = [], []
    for gi, (window, dil) in enumerate(DIL_GROUPS):
        L = S // dil

        def to_sub(t):
            t = t[:, :, gi].reshape(b, L, dil, DIL_HEADS, HEAD_DIM)
            return t.transpose(0, 2, 3, 1, 4).reshape(b * dil, DIL_HEADS, L, HEAD_DIM)

        qs, ks, vs = to_sub(q), to_sub(k), to_sub(v)
        o, lse = banded_attention(qs[:, :, None], ks, vs, slopes_a[gi][:, None],
                                  max_diff=window // dil, dist_scale=dil, sinks=None)
        o = o[:, :, 0].reshape(b, dil, DIL_HEADS, L, HEAD_DIM).transpose(0, 3, 1, 2, 4).reshape(b, S, DIL_HEADS, HEAD_DIM)
        lse = lse[:, :, 0].reshape(b, dil, DIL_HEADS, L).transpose(0, 3, 1, 2).reshape(b, S, DIL_HEADS)
        outs.append(o)
        lses.append(lse)
    w = jax.nn.softmax(jnp.stack(lses, axis=0), axis=0)
    o = jnp.einsum('gbsh,gbshd->bshd', w, jnp.stack(outs, axis=0).astype(jnp.float32))
    return o.reshape(b, S, DIL_OUT).astype(q.dtype)


def swa_sink_attention(q, k, v, slopes_b, sinks):
    b, S, _ = q.shape
    q = q.reshape(b, S, SWA_KV_HEADS, SWA_REP, HEAD_DIM).transpose(0, 2, 3, 1, 4)
    k = k.reshape(b, S, SWA_KV_HEADS, HEAD_DIM).transpose(0, 2, 1, 3)
    v = v.reshape(b, S, SWA_KV_HEADS, HEAD_DIM).transpose(0, 2, 1, 3)
    o, _ = banded_attention(q, k, v, slopes_b, max_diff=SWA_WINDOW - 1, dist_scale=1, sinks=sinks)
    return o.transpose(0, 3, 1, 2, 4).reshape(b, S, SWA_Q_WIDTH)


def token_mixer(x, w_in, sinks, w_proj_a, w_proj_b, w_out, slopes):
    h = jnp.einsum('bsd,dc->bsc', x, w_in)
    a_q, a_k, a_v, b_q, b_k, b_v, g_a, g_b = jnp.split(h, SPLIT_POINTS, axis=-1)
    slopes_b = slopes[:SWA_Q_HEADS].reshape(SWA_KV_HEADS, SWA_REP)
    slopes_a = slopes[SWA_Q_HEADS:].reshape(len(DIL_GROUPS), DIL_HEADS)
    out_a = dilated_attention(a_q, a_k, a_v, slopes_a)
    out_b = swa_sink_attention(b_q, b_k, b_v, slopes_b, sinks.reshape(SWA_KV_HEADS, SWA_REP))
    merged = (jax.nn.sigmoid(g_a) * jnp.einsum('bsc,cd->bsd', out_a, w_proj_a)
              + jax.nn.sigmoid(g_b) * jnp.einsum('bsc,cd->bsd', out_b, w_proj_b))
    return jnp.einsum('bsd,de->bse', merged, w_out)


def moe_ffn(y, router_w, router_b, w_gate, b_gate, w_up, b_up, w_down, b_down):
    b, S, D = y.shape
    n_tok = b * S
    yf = y.reshape(n_tok, D)
    logits = (yf @ router_w + router_b).astype(jnp.float32)
    top_val, top_idx = lax.top_k(logits, TOP_K)
    gates = jax.nn.softmax(top_val, axis=-1)
    n_assign = n_tok * TOP_K
    flat_e = top_idx.reshape(-1)
    order = jnp.argsort(flat_e)
    sorted_e = flat_e[order]
    tok = order // TOP_K
    counts = jnp.zeros((N_EXPERTS,), jnp.int32).at[flat_e].add(1)
    padded = (counts + MOE_BLOCK - 1) // MOE_BLOCK * MOE_BLOCK
    p_end = jnp.cumsum(padded)
    p_start = p_end - padded
    u_start = jnp.cumsum(counts) - counts
    dest = p_start[sorted_e] + jnp.arange(n_assign, dtype=jnp.int32) - u_start[sorted_e]
    n_blocks = -(-n_assign // MOE_BLOCK) + N_EXPERTS
    rows = n_blocks * MOE_BLOCK
    xs = jnp.zeros((rows, D), y.dtype).at[dest].set(yf[tok])
    block_e = jnp.minimum(jnp.searchsorted(p_end, jnp.arange(n_blocks, dtype=jnp.int32) * MOE_BLOCK, side='right'),
                          N_EXPERTS - 1).astype(jnp.int32)

    def expert_block(args):
        xb, e = args
        gt = xb @ w_gate[e] + b_gate[e]
        up = xb @ w_up[e] + b_up[e]
        gt = jnp.minimum(gt, SWIGLU_LIMIT)
        up = jnp.clip(up, -SWIGLU_LIMIT, SWIGLU_LIMIT)
        hdn = gt * jax.nn.sigmoid(SWIGLU_ALPHA * gt) * (up + 1.0)
        return hdn @ w_down[e] + b_down[e]

    ys = lax.map(expert_block, (xs.reshape(n_blocks, MOE_BLOCK, D), block_e)).reshape(rows, D)
    contrib = ys[dest] * gates.reshape(-1)[order][:, None].astype(ys.dtype)
    out = jax.ops.segment_sum(contrib, tok, num_segments=n_tok)
    return out.reshape(b, S, D)


def setup_inputs(seed: int = 0) -> dict:
    key = jax.random.key(seed)
    ks = jax.random.split(key, 20)
    f32 = jnp.float32
    beta = DEEPNORM_BETA
    col_scale = jnp.concatenate([
        jnp.ones((2 * DIL_WIDTH,), f32), jnp.full((DIL_WIDTH,), beta, f32),
        jnp.ones((SWA_Q_WIDTH + SWA_KV_WIDTH,), f32), jnp.full((SWA_KV_WIDTH,), beta, f32),
        jnp.ones((2 * D_MODEL,), f32)])
    nrm = lambda k, shape: jax.random.normal(k, shape, f32)
    return {
        "x": nrm(ks[0], (BATCH, SEQ, D_MODEL)),
        "w_in": nrm(ks[1], (DEPTH, D_MODEL, IN_COLS)) * (D_MODEL ** -0.5) * col_scale,
        "sinks": 0.5 * nrm(ks[2], (DEPTH, SWA_Q_HEADS)),
        "w_proj_a": nrm(ks[3], (DEPTH, DIL_OUT, D_MODEL)) * (DIL_OUT ** -0.5),
        "w_proj_b": nrm(ks[4], (DEPTH, SWA_Q_WIDTH, D_MODEL)) * (SWA_Q_WIDTH ** -0.5),
        "w_out": nrm(ks[5], (DEPTH, D_MODEL, D_MODEL)) * (D_MODEL ** -0.5) * beta,
        "ln1_g": 1.0 + 0.05 * nrm(ks[6], (DEPTH, D_MODEL)),
        "ln1_b": 0.02 * nrm(ks[7], (DEPTH, D_MODEL)),
        "router_w": nrm(ks[8], (DEPTH, D_MODEL, N_EXPERTS)) * (D_MODEL ** -0.5),
        "router_b": 0.01 * nrm(ks[9], (DEPTH, N_EXPERTS)),
        "w_gate": nrm(ks[10], (DEPTH, N_EXPERTS, D_MODEL, D_FF)) * (D_MODEL ** -0.5),
        "b_gate": 0.02 * nrm(ks[11], (DEPTH, N_EXPERTS, D_FF)),
        "w_up": nrm(ks[12], (DEPTH, N_EXPERTS, D_MODEL, D_FF)) * (D_MODEL ** -0.5),
        "b_up": 0.02 * nrm(ks[13], (DEPTH, N_EXPERTS, D_FF)),
        "w_down": nrm(ks[14], (DEPTH, N_EXPERTS, D_FF, D_MODEL)) * (D_FF ** -0.5) * beta,
        "b_down": 0.02 * nrm(ks[15], (DEPTH, N_EXPERTS, D_MODEL)),
        "ln2_g": 1.0 + 0.05 * nrm(ks[16], (DEPTH, D_MODEL)),
        "ln2_b": 0.02 * nrm(ks[17], (DEPTH, D_MODEL)),
    }


def reference(x, w_in, sinks, w_proj_a, w_proj_b, w_out, ln1_g, ln1_b, router_w, router_b,
              w_gate, b_gate, w_up, b_up, w_down, b_down, ln2_g, ln2_b):
    slopes = alibi_slopes()
    for l in range(DEPTH):
        mix = token_mixer(x, w_in[l], sinks[l], w_proj_a[l], w_proj_b[l], w_out[l], slopes)
        x = layer_norm(DEEPNORM_ALPHA * x + mix, ln1_g[l], ln1_b[l])
        ffn = moe_ffn(x, router_w[l], router_b[l], w_gate[l], b_gate[l], w_up[l], b_up[l], w_down[l], b_down[l])
        x = layer_norm(DEEPNORM_ALPHA * x + ffn, ln2_g[l], ln2_b[l])
    return x
```

```cpp
#include <hip/hip_runtime.h>
#include <cstdio>
#include <cstdint>

#define GAS __attribute__((address_space(1)))
#define LAS __attribute__((address_space(3)))
typedef unsigned short bf16_t;
typedef short bf16x8 __attribute__((ext_vector_type(8)));
typedef short s16x4 __attribute__((ext_vector_type(4)));
typedef float f32x2 __attribute__((ext_vector_type(2)));
typedef float f32x4 __attribute__((ext_vector_type(4)));
typedef float f32x16 __attribute__((ext_vector_type(16)));
typedef unsigned u32x2 __attribute__((ext_vector_type(2)));
typedef unsigned u32x4 __attribute__((ext_vector_type(4)));
typedef GAS unsigned gu32;

#ifndef MK_N_LAUNCHES
#define MK_N_LAUNCHES 1
#endif
#ifndef DUP_PHASE
#define DUP_PHASE -1
#endif
constexpr int N_PHASES = 10;
constexpr int N_LAUNCHES = MK_N_LAUNCHES;

constexpr int NB = 8, SEQ = 4096, D = 1024, NTOK = NB * SEQ;
constexpr int HQ_P = 3584;
constexpr int SG_P = 2048;
constexpr int OAB_P = 1280;
constexpr int IN_COLS = 5632;
constexpr int NEXP = 32, TOPK = 4, DFF = 1024;
constexpr int MAX_MT = 544;
constexpr float LN_EPS = 1e-5f;
constexpr float DN_ALPHA = 1.189207115002721f;
constexpr float LOG2E = 1.4426950408889634f, LN2 = 0.6931471805599453f;
constexpr float QSCALE = 0.125f * LOG2E;
constexpr float NEG_BIG = -1e30f;

constexpr size_t MiB = 1u << 20;
constexpr size_t WS_CTL = 0, CTL_ZERO_BYTES = 1 * MiB;
constexpr size_t WS_XBUF = 1 * MiB;
constexpr size_t WS_Y = 194 * MiB;
constexpr size_t WS_STAT = 258 * MiB;
constexpr size_t WS_HQ = 2 * MiB;
constexpr size_t HQ_QD = 0, HQ_KD = 48 * MiB, HQ_VD = 96 * MiB, HQ_QS = 144 * MiB, HQ_KS = 208 * MiB, HQ_VS = 216 * MiB;
constexpr size_t WS_WGU = 404 * MiB;
constexpr size_t WS_WD = 468 * MiB;
constexpr size_t WS_X1B = 98 * MiB;
constexpr size_t WS_X1Q = 162 * MiB;
constexpr size_t WS_HDN = 194 * MiB;
constexpr size_t WS_SG = 226 * MiB;
constexpr size_t WS_YS23 = 330 * MiB;
constexpr size_t WS_OAG = 354 * MiB;
constexpr size_t WS_LSE = 402 * MiB;
constexpr size_t WS_MRG = 2 * MiB;
constexpr size_t WS_WOUT = 530 * MiB;
constexpr size_t WS_PETOK = 532 * MiB;
constexpr size_t WS_PEGATE = 536 * MiB;
constexpr size_t WS_WRT = 540 * MiB;
constexpr size_t WS_END = 540 * MiB + 256 * 1024;
constexpr float SX = 8.0f, SW = 512.0f, SH = 4.0f, SXIN = 8.0f, SY = 64.0f, SM = 64.0f, SO = 64.0f, SSG = 256.0f;
static_assert(WS_HQ + (size_t)NTOK * HQ_P * 2 <= WS_SG && WS_SG + (size_t)NTOK * SG_P <= WS_OAG && WS_OAG + (size_t)3 * NTOK * 256 * 2 <= WS_LSE && WS_LSE + (size_t)3 * NTOK * 4 * 4 <= WS_WGU, "ws map 1");
static_assert(WS_WGU + (size_t)NEXP * 2048 * D <= WS_WD && WS_WD + (size_t)NEXP * D * DFF <= WS_WOUT && WS_MRG + (size_t)NTOK * D <= WS_X1B && WS_X1B + (size_t)NTOK * D * 2 <= WS_X1Q && WS_X1Q + (size_t)NTOK * D <= WS_HDN, "ws map 2");
static_assert(WS_HDN + (size_t)MAX_MT * 256 * DFF <= WS_OAG && WS_WOUT + (size_t)D * D <= WS_PETOK, "ws map 3");
constexpr size_t DO_XB = 0;
constexpr size_t DO_OAB = 0;
constexpr size_t DO_WIN = 96 * MiB;
constexpr size_t DO_WCAT = 108 * MiB;
constexpr int CW_TMO = 0, CW_CODE = 1;
constexpr int CW_BAR = 4096;
constexpr int CW_SEAM = 16384;
constexpr int CW_ECNT = 32768;
static_assert((CW_ECNT + 2 * 64 * NEXP) * 4 <= (int)CTL_ZERO_BYTES, "CTL words inside the memset region");

constexpr int RING_BYTES = 131072;
constexpr int SCR_BYTES = 143360;
constexpr int LDSCTL_OFF = SCR_BYTES;
constexpr int MISC_OFF = LDSCTL_OFF + 320;
constexpr int MOE_OFF = LDSCTL_OFF + 512;
constexpr int LDS_BYTES = 147456;
static_assert(MOE_OFF + 128 + 136 + MAX_MT <= LDS_BYTES, "LDS map");

#define RLX_AGENT __ATOMIC_RELAXED, __HIP_MEMORY_SCOPE_AGENT
#define LDS_WAIT() asm volatile("s_waitcnt lgkmcnt(0)" ::: "memory")
#define VM_WAIT() asm volatile("s_waitcnt vmcnt(0)" ::: "memory")

__device__ __forceinline__ unsigned cvt_pk_bf16(float lo, float hi) { unsigned r; asm volatile("v_cvt_pk_bf16_f32 %0, %1, %2" : "=v"(r) : "v"(lo), "v"(hi)); return r; }
__device__ __forceinline__ int opaque(int v) { asm volatile("" : "+v"(v)); return v; }
__device__ __forceinline__ unsigned pk4_fp8(float a, float b, float c, float d) { int w = 0; w = __builtin_amdgcn_cvt_pk_fp8_f32(a, b, w, false); w = __builtin_amdgcn_cvt_pk_fp8_f32(c, d, w, true); return (unsigned)w; }
__device__ __forceinline__ unsigned f2e4m3_sw(float x) { const unsigned u = __float_as_uint(x); const unsigned sg = (u >> 24) & 0x80u; const float a = fminf(fabsf(x), 448.f); unsigned r;
  if (a < 0.015625f) r = (unsigned)__builtin_rintf(a * 512.f); else { unsigned v = __float_as_uint(a); v += 0x7FFFFu + ((v >> 20) & 1u); r = (v >> 20) - (120u << 3); } return sg | r; }
__device__ __forceinline__ float clamp_fp8(float v) { return __builtin_amdgcn_fmed3f(v, -448.0f, 448.0f); }
__device__ __forceinline__ float bf_lo(unsigned w) { return __uint_as_float(w << 16); }
__device__ __forceinline__ float bf_hi(unsigned w) { return __uint_as_float(w & 0xffff0000u); }
__device__ __forceinline__ float fast_sigmoid(float g) { g = fminf(fmaxf(g, -60.f), 60.f); return __builtin_amdgcn_rcpf(1.0f + __builtin_amdgcn_exp2f(-g * LOG2E)); }

namespace pg8 {
constexpr int BM = 256, BK = 64, HALF = 128, HTB = HALF * BK * 2, STAGE_BYTES = 8 * HTB, NXCD = 8, WGM = 8;
__host__ __device__ __forceinline__ int lds_byte(int r, int c) { const int st = (r >> 4) * 2 + (c >> 5), rr = r & 15, cc = c & 31, ob = rr * 64 + cc * 2; return st * 1024 + (ob ^ (((ob >> 9) & 1) << 5)); }
__host__ __device__ __forceinline__ void stage_rc(int b, int& R, int& C) { const int st = b / 1024, sb = b % 1024, swz = sb ^ (((sb >> 9) & 1) << 5); R = (st >> 1) * 16 + swz / 64; C = (st & 1) * 32 + (swz % 64) / 2; }
__host__ __device__ __forceinline__ int perm32(int rho) { const int n = rho >> 4, i = rho & 15; return 8 * (i >> 2) + 4 * n + (i & 3); }

struct Unit { int pm, pn, e, ti, valid; };
struct Gemm { const char* A; const char* Bt; int lda, ldb, nt; };

__device__ __forceinline__ bool tile_of(long L, int nM, int nN, int& pm, int& pn) {
    const int nwg = nM * nN; if (L >= nwg) return false;
    int wgid = (int)L; { const int q = nwg / NXCD, r = nwg % NXCD, xcd = wgid % NXCD, off = wgid / NXCD; wgid = (xcd < r ? xcd * (q + 1) : r * (q + 1) + (xcd - r) * q) + off; }
    const int nig = WGM * nN, gid = wgid / nig, fm = gid * WGM, gsz = (nM - fm) < WGM ? (nM - fm) : WGM;
    pm = fm + ((wgid % nig) % gsz); pn = (wgid % nig) / gsz; return true;
}
struct StaticOrder {
    int nM, nN, G, c;
    __device__ __forceinline__ void init(int M, int N, int G_, int c_) { nM = M / BM; nN = N / BM; G = G_; c = c_; }
    __device__ __forceinline__ bool next(int i, Unit& u) const { u.e = 0; u.ti = 0; u.valid = 256; return tile_of((long)i * G + c, nM, nN, u.pm, u.pn); }
    __device__ __forceinline__ const char* a_ptr(const Gemm& g, const Unit& u) const { return g.A + (size_t)u.pm * 256 * g.lda; }
    __device__ __forceinline__ const char* b_ptr(const Gemm& g, const Unit& u) const { return g.Bt + (size_t)u.pn * 256 * g.ldb; }
    __device__ __forceinline__ unsigned row_off(const Unit&, int) const { return 0u; }
};
struct MoeOrder {
    int T, nN, G, c; const LAS int* cnt; const LAS int* fs; const LAS unsigned char* te;
    const int* petok; size_t b_exp_stride; bool gather; unsigned rowbytes;
    __device__ __forceinline__ bool next(int i, Unit& u) const {
        if (!tile_of((long)i * G + c, T, nN, u.pm, u.pn)) return false;
        u.e = __builtin_amdgcn_readfirstlane((int)te[u.pm]); u.ti = u.pm - __builtin_amdgcn_readfirstlane(fs[u.e]); const int left = __builtin_amdgcn_readfirstlane(cnt[u.e]) - u.ti * 256; u.valid = left < 256 ? left : 256; return true;
    }
    __device__ __forceinline__ const char* a_ptr(const Gemm& g, const Unit& u) const { return gather ? g.A : g.A + (size_t)u.pm * 256 * g.lda; }
    __device__ __forceinline__ const char* b_ptr(const Gemm& g, const Unit& u) const { return g.Bt + (size_t)u.e * b_exp_stride + (size_t)u.pn * 256 * g.ldb; }
    __device__ __forceinline__ unsigned row_off(const Unit& u, int R) const {
        int tok = 0; if (R < u.valid) tok = petok[(size_t)u.e * NTOK + u.ti * 256 + R] >> 2;
        return (unsigned)tok * rowbytes;
    }
};

typedef int v8i32 __attribute__((ext_vector_type(8)));
template <class Epi, class Sched, bool ALIGN_EPI, bool GATHER, bool F8 = false>
__device__ __forceinline__ void gemm_phase(LAS unsigned char* lds, const Gemm g, const Sched& S, const Epi& E) {
    const int tid = threadIdx.x, wid = __builtin_amdgcn_readfirstlane(tid >> 6), lane = tid & 63, wr = wid >> 2, wc = wid & 3, fr = lane & 15, fq = lane >> 4;
    const int nt = g.nt;
    unsigned voffA[2], voffB[2]; int RA[2], CA2[2];
#pragma unroll
    for (int i = 0; i < 2; ++i) { int R, C; stage_rc(tid * 16 + i * 8192, R, C); const int Rb = Epi::PERM ? ((R & ~31) + perm32(R & 31)) : R;
        voffA[i] = (unsigned)(R * g.lda + C * 2); voffB[i] = (unsigned)(Rb * g.ldb + C * 2); RA[i] = R; CA2[i] = C * 2; }
    const size_t kstep = (size_t)(BK * 2);
    const size_t hstepA = (size_t)HALF * g.lda, hstepB = (size_t)HALF * g.ldb;
    const unsigned ldsw = (unsigned)wid * 1024u;
    const int aoff = lds_byte(wr * 64 + fr, fq * 8), boff = lds_byte(wc * 32 + fr, fq * 8);
    const int aoff0 = aoff, boff0 = boff, aoff1 = aoff + 1024, boff1 = boff + 1024;
#define PG8_SA(b, h) (((b) * 2 + (h)) * HTB)
#define PG8_SB(b, h) ((4 + (b) * 2 + (h)) * HTB)
#define PG8_STAGE(bufoff, gbase, voff) do { _Pragma("unroll") for (int _i = 0; _i < 2; ++_i) \
        __builtin_amdgcn_global_load_lds((const unsigned*)((const char*)(gbase) + (voff)[_i]), (LAS unsigned*)(lds + (bufoff) + ldsw + _i * 8192), 16, 0, 0); } while (0)
#define PG8_STAGE_A(bufoff, kp, h, nx) do { if constexpr (GATHER) { unsigned _v[2]; _v[0] = (nx) ? gN[h][0] : gC[h][0]; _v[1] = (nx) ? gN[h][1] : gC[h][1]; PG8_STAGE(bufoff, kp, _v); } \
        else { PG8_STAGE(bufoff, (kp) + (h) * hstepA, voffA); } } while (0)
#define PG8_LDA(dst, b, h) do { _Pragma("unroll") for (int m = 0; m < 4; ++m) _Pragma("unroll") for (int k = 0; k < 2; ++k) dst[m][k] = *(const LAS bf16x8*)(lds + PG8_SA(b, h) + (k ? aoff1 : aoff0) + m * 2048); } while (0)
#define PG8_LDB(dst, b, h) do { _Pragma("unroll") for (int n = 0; n < 2; ++n) _Pragma("unroll") for (int k = 0; k < 2; ++k) dst[n][k] = *(const LAS bf16x8*)(lds + PG8_SB(b, h) + (k ? boff1 : boff0) + n * 2048); } while (0)
#define PG8_F8OP(X) __builtin_bit_cast(v8i32, __builtin_shufflevector(X[0], X[1], 0, 1, 2, 3, 4, 5, 6, 7, 8, 9, 10, 11, 12, 13, 14, 15))
#define PG8_MMA(ai, bj, At, Bt) do { __builtin_amdgcn_s_setprio(1); if constexpr (F8) { _Pragma("unroll") for (int m = 0; m < 4; ++m) _Pragma("unroll") for (int n = 0; n < 2; ++n) \
        asm volatile("v_mfma_scale_f32_16x16x128_f8f6f4 %0, %1, %2, %0, %3, %3 op_sel_hi:[0,0,0]" : "+v"(acc[ai][bj][m][n]) : "v"(PG8_F8OP(Bt[n])), "v"(PG8_F8OP(At[m])), "v"(one_scale)); } \
        else { _Pragma("unroll") for (int m = 0; m < 4; ++m) _Pragma("unroll") for (int n = 0; n < 2; ++n) _Pragma("unroll") for (int k = 0; k < 2; ++k) \
        acc[ai][bj][m][n] = __builtin_amdgcn_mfma_f32_16x16x32_bf16(Bt[n][k], At[m][k], acc[ai][bj][m][n], 0, 0, 0); } __builtin_amdgcn_s_setprio(0); } while (0)
#define PG8_WAIT_V(n) asm volatile("s_waitcnt vmcnt(" #n ")" ::: "memory")
#define PG8_WAIT_L(n) asm volatile("s_waitcnt lgkmcnt(" #n ")" ::: "memory")
#define PG8_BAR __builtin_amdgcn_s_barrier()
#define PG8_SCHED __builtin_amdgcn_sched_barrier(0)
    Unit cur, nxt; int ui = 0;
    if (!S.next(0, cur)) return;
    int one_scale = 0x7f7f7f7f; if constexpr (F8) asm volatile("" : "+v"(one_scale));
    unsigned gC[2][2], gN[2][2];
#pragma unroll
    for (int h = 0; h < 2; ++h)
#pragma unroll
        for (int i = 0; i < 2; ++i) { gC[h][i] = GATHER ? S.row_off(cur, h * HALF + RA[i]) + (unsigned)CA2[i] : 0u; gN[h][i] = gC[h][i]; }
    f32x4 acc[2][2][4][2];
#pragma unroll
    for (int a = 0; a < 2; ++a)
#pragma unroll
        for (int b = 0; b < 2; ++b)
#pragma unroll
            for (int m = 0; m < 4; ++m)
#pragma unroll
                for (int n = 0; n < 2; ++n) acc[a][b][m][n] = (f32x4){0.f, 0.f, 0.f, 0.f};
    bf16x8 At[4][2], B0[2][2], B1[2][2];
    const char* cA = S.a_ptr(g, cur); const char* cB = S.b_ptr(g, cur);
    PG8_STAGE(PG8_SB(0, 0), cB, voffB); PG8_STAGE(PG8_SB(0, 1), cB + hstepB, voffB); PG8_STAGE_A(PG8_SA(0, 0), cA, 0, false); PG8_STAGE_A(PG8_SA(0, 1), cA, 1, false);
    if (wr == 1) PG8_BAR;
    PG8_WAIT_V(2); PG8_BAR;
    PG8_STAGE(PG8_SB(1, 0), cB + kstep, voffB); PG8_STAGE_A(PG8_SA(1, 0), cA + kstep, 0, false); PG8_STAGE(PG8_SB(1, 1), cB + hstepB + kstep, voffB);
    PG8_WAIT_V(6); PG8_BAR;
    for (;;) {
        const bool has_next = S.next(ui + 1, nxt);
        const char* nA = has_next ? S.a_ptr(g, nxt) : cA; const char* nB = has_next ? S.b_ptr(g, nxt) : cB;
        if constexpr (GATHER) { if (has_next) {
#pragma unroll
            for (int h = 0; h < 2; ++h)
#pragma unroll
                for (int i = 0; i < 2; ++i) gN[h][i] = S.row_off(nxt, h * HALF + RA[i]) + (unsigned)CA2[i]; } }
#pragma unroll 1
        for (int t = 0; t < nt; t += 2) {
            const bool last = (t == nt - 2);
            asm volatile("" : "+v"(voffA[0]), "+v"(voffA[1]), "+v"(voffB[0]), "+v"(voffB[1]));
            if constexpr (Epi::HAS_MID) { if (t == Epi::MID_T) E.mid(acc, cur, wr, wc, fr, fq); }
            const char* a1 = cA + (size_t)(t + 1) * kstep;
            const char* a2 = last ? nA : cA + (size_t)(t + 2) * kstep; const char* b2 = last ? nB : cB + (size_t)(t + 2) * kstep;
            const char* a3 = a2 + kstep; const char* b3 = b2 + kstep;
            PG8_LDB(B0, 0, 0); PG8_LDB(B1, 0, 1); PG8_SCHED; PG8_LDA(At, 0, 0); PG8_STAGE_A(PG8_SA(1, 1), a1, 1, false);
            PG8_WAIT_V(8); PG8_WAIT_L(0); PG8_BAR; PG8_MMA(0, 0, At, B0); PG8_MMA(0, 1, At, B1); PG8_BAR; PG8_SCHED;
            PG8_LDA(At, 0, 1); PG8_STAGE(PG8_SB(0, 0), b2, voffB); PG8_STAGE(PG8_SB(0, 1), b2 + hstepB, voffB); PG8_STAGE_A(PG8_SA(0, 0), a2, 0, last);
            PG8_WAIT_V(8); PG8_WAIT_L(0); PG8_BAR; PG8_MMA(1, 0, At, B0); PG8_MMA(1, 1, At, B1); PG8_BAR; PG8_SCHED;
            PG8_LDB(B0, 1, 0); PG8_LDB(B1, 1, 1); PG8_SCHED; PG8_LDA(At, 1, 0); PG8_STAGE_A(PG8_SA(0, 1), a2, 1, last);
            PG8_WAIT_V(8); PG8_WAIT_L(0); PG8_BAR; PG8_MMA(0, 0, At, B0); PG8_MMA(0, 1, At, B1); PG8_BAR; PG8_SCHED;
            PG8_LDA(At, 1, 1); PG8_STAGE(PG8_SB(1, 0), b3, voffB); PG8_STAGE(PG8_SB(1, 1), b3 + hstepB, voffB); PG8_STAGE_A(PG8_SA(1, 0), a3, 0, last);
            PG8_WAIT_V(8); PG8_WAIT_L(0); PG8_BAR; PG8_MMA(1, 0, At, B0); PG8_MMA(1, 1, At, B1); PG8_BAR; PG8_SCHED;
        }
        if constexpr (ALIGN_EPI) { if (wr == 0) PG8_BAR; }
        if constexpr (F8) asm volatile("s_nop 15\n\ts_nop 15" ::: "memory");
        if constexpr (!Epi::AFTER_DRAIN) { E(acc, cur, wr, wc, fr, fq); }
        if (!has_next) break;
#pragma unroll
        for (int a = 0; a < 2; ++a)
#pragma unroll
            for (int b = 0; b < 2; ++b)
#pragma unroll
                for (int m = 0; m < 4; ++m)
#pragma unroll
                    for (int n = 0; n < 2; ++n) acc[a][b][m][n] = (f32x4){0.f, 0.f, 0.f, 0.f};
        cur = nxt; cA = nA; cB = nB; ++ui;
#pragma unroll
        for (int h = 0; h < 2; ++h)
#pragma unroll
            for (int i = 0; i < 2; ++i) gC[h][i] = gN[h][i];
        if constexpr (ALIGN_EPI) { if (wr == 1) PG8_BAR; }
    }
    PG8_WAIT_V(0);
    if constexpr (!ALIGN_EPI) { if (wr == 0) PG8_BAR; }
    PG8_BAR;
    if constexpr (Epi::AFTER_DRAIN) { E.fused(acc, cur, wr, wc, fr, fq, lds, wid, lane); }
#undef PG8_SA
#undef PG8_SB
#undef PG8_STAGE
#undef PG8_STAGE_A
#undef PG8_LDA
#undef PG8_LDB
#undef PG8_MMA
#undef PG8_F8OP
#undef PG8_WAIT_V
#undef PG8_WAIT_L
#undef PG8_BAR
#undef PG8_SCHED
}
}

namespace pg8 {
struct EpiInProj {
    static constexpr bool PERM = true, AFTER_DRAIN = false, HAS_MID = false; static constexpr int MID_T = 0;
    unsigned char* HQ; unsigned char* SG; float rs;
    __device__ __forceinline__ void mid(f32x4 (&)[2][2][4][2], const Unit&, int, int, int, int) const {}
    __device__ __forceinline__ void operator()(const f32x4 (&acc)[2][2][4][2], const Unit& u, int wr, int wc, int fr, int fq) const {
        const int row0 = u.pm * BM + wr * 64 + opaque(fr), pn = u.pn;
        const bool gate = pn >= 14; const bool qs = (pn < 3) || (pn >= 9 && pn < 13);
        const float sc = (qs ? QSCALE : 1.0f) * rs; const int dcol = (wc & 1) * 32 + 8 * fq;
#pragma unroll
        for (int ai = 0; ai < 2; ++ai)
#pragma unroll
            for (int m = 0; m < 4; ++m) { const int row = row0 + ai * HALF + m * 16, b = row >> 12, t = row & (SEQ - 1);
#pragma unroll
                for (int bj = 0; bj < 2; ++bj) { f32x4 v0 = acc[ai][bj][m][0], v1 = acc[ai][bj][m][1];
                    bf16_t* dst;
                    if (gate) {
#pragma unroll
                        for (int q = 0; q < 4; ++q) { v0[q] = fmaxf(fast_sigmoid(v0[q] * rs) * SSG, 0.001953125f); v1[q] = fmaxf(fast_sigmoid(v1[q] * rs) * SSG, 0.001953125f); }
                        u32x2 w8; w8.x = pk4_fp8(v0[0], v0[1], v0[2], v0[3]); w8.y = pk4_fp8(v1[0], v1[1], v1[2], v1[3]);
                        *(u32x2*)(SG + (size_t)row * SG_P + (pn - 14) * 256 + bj * HALF + wc * 32 + 8 * fq) = w8; continue; }
                    else { v0 = v0 * sc; v1 = v1 * sc; const int hl = bj * 2 + (wc >> 1);
                        if (pn < 9) { const int ty = pn / 3, g = pn - 3 * ty, sh = 2 * g, pos = ((t & ((1 << sh) - 1)) << (12 - sh)) + (t >> sh);
                            dst = (bf16_t*)(HQ + (size_t)ty * (48 * MiB)) + ((size_t)(((g * NB + b) * 4 + hl) * SEQ + pos)) * 64 + dcol; }
                        else if (pn < 13) dst = (bf16_t*)(HQ + HQ_QS) + ((size_t)((b * 16 + (pn - 9) * 4 + hl) * SEQ + t)) * 64 + dcol;
                        else dst = (bf16_t*)(HQ + (bj ? HQ_VS : HQ_KS)) + ((size_t)((b * 2 + (wc >> 1)) * SEQ + t)) * 64 + dcol; }
                    u32x4 w; w.x = cvt_pk_bf16(v0[0], v0[1]); w.y = cvt_pk_bf16(v0[2], v0[3]); w.z = cvt_pk_bf16(v1[0], v1[1]); w.w = cvt_pk_bf16(v1[2], v1[3]);
                    *(u32x4*)dst = w; } }
    }
};
struct EpiGate {
    static constexpr bool PERM = true, AFTER_DRAIN = false, HAS_MID = true; static constexpr int MID_T = 2;
    const unsigned char* __restrict__ SG; unsigned char* __restrict__ O;
    __device__ __forceinline__ void mid(f32x4 (&acc)[2][2][4][2], const Unit& u, int wr, int wc, int fr, int fq) const {
        const int row0 = u.pm * BM + wr * 64 + opaque(fr), col0 = u.pn * BM + wc * 32 + 8 * opaque(fq);
#pragma unroll
        for (int ai = 0; ai < 2; ++ai) {
            u32x2 a[4][2], b[4][2];
#pragma unroll
            for (int mm = 0; mm < 4; ++mm) { const unsigned char* sp = SG + (size_t)(row0 + ai * HALF + mm * 16) * SG_P + col0;
#pragma unroll
                for (int bj = 0; bj < 2; ++bj) { a[mm][bj] = *(const u32x2*)(sp + bj * HALF); b[mm][bj] = *(const u32x2*)(sp + 1024 + bj * HALF); } }
#pragma unroll
            for (int m = 0; m < 4; ++m) {
#pragma unroll
                for (int bj = 0; bj < 2; ++bj) {
#pragma unroll
                    for (int n = 0; n < 2; ++n) { const int aw = (int)a[m][bj][n], bw = (int)b[m][bj][n];
                        const f32x2 al = __builtin_amdgcn_cvt_pk_f32_fp8(aw, false), ah = __builtin_amdgcn_cvt_pk_f32_fp8(aw, true), bl = __builtin_amdgcn_cvt_pk_f32_fp8(bw, false), bh = __builtin_amdgcn_cvt_pk_f32_fp8(bw, true);
                        f32x4 r; r[0] = al[0] * __builtin_amdgcn_rcpf(bl[0]); r[1] = al[1] * __builtin_amdgcn_rcpf(bl[1]); r[2] = ah[0] * __builtin_amdgcn_rcpf(bh[0]); r[3] = ah[1] * __builtin_amdgcn_rcpf(bh[1]);
                        acc[ai][bj][m][n] = acc[ai][bj][m][n] * r; } }
                asm volatile("" : "+v"(acc[ai][0][m][0]), "+v"(acc[ai][0][m][1]), "+v"(acc[ai][1][m][0]), "+v"(acc[ai][1][m][1])); }
            asm volatile("" ::: "memory"); }
    }
    __device__ __forceinline__ void operator()(const f32x4 (&acc)[2][2][4][2], const Unit& u, int wr, int wc, int fr, int fq) const {
        const int row0 = u.pm * BM + wr * 64 + opaque(fr), col0 = u.pn * BM + wc * 32 + 8 * opaque(fq);
        constexpr float FS = SM / (SO * SW * SSG);
#pragma unroll
        for (int ai = 0; ai < 2; ++ai) {
            u32x2 bq[4][2];
#pragma unroll
            for (int m = 0; m < 4; ++m)
#pragma unroll
                for (int bj = 0; bj < 2; ++bj) bq[m][bj] = *(const u32x2*)(SG + (size_t)(row0 + ai * HALF + m * 16) * SG_P + 1024 + col0 + bj * HALF);
#pragma unroll
            for (int m = 0; m < 4; ++m) { unsigned char* op = O + (size_t)(row0 + ai * HALF + m * 16) * D + col0;
#pragma unroll
                for (int bj = 0; bj < 2; ++bj) { u32x2 w;
#pragma unroll
                    for (int n = 0; n < 2; ++n) { const int bw = (int)bq[m][bj][n]; const f32x2 bl = __builtin_amdgcn_cvt_pk_f32_fp8(bw, false), bh = __builtin_amdgcn_cvt_pk_f32_fp8(bw, true); const f32x4 v = acc[ai][bj][m][n] * FS;
                        w[n] = pk4_fp8(clamp_fp8(v[0] * bl[0]), clamp_fp8(v[1] * bl[1]), clamp_fp8(v[2] * bh[0]), clamp_fp8(v[3] * bh[1])); }
                    *(u32x2*)(op + bj * HALF) = w; } }
            asm volatile("" ::: "memory"); }
    }
};

struct PanelStats {
    unsigned* xbuf;
    unsigned* cnt;
    unsigned* tmo;
    int pm_off; float eps; unsigned code;
    __device__ __forceinline__ bool run(const f32x4 (&v)[2][2][4][2], const Unit& u, int wr, int wc, int fr, int fq, LAS unsigned char* lds, int wid, int lane) const {
        LAS f32x2* P = (LAS f32x2*)lds;
        LAS f32x2* S = (LAS f32x2*)(lds + 8192);
        LAS unsigned* flag = (LAS unsigned*)(lds + 8192 + 2048);
        const int panel = u.pm + pm_off;
#pragma unroll
        for (int ai = 0; ai < 2; ++ai)
#pragma unroll
            for (int m = 0; m < 4; ++m) {
                float s = 0.f;
#pragma unroll
                for (int bj = 0; bj < 2; ++bj)
#pragma unroll
                    for (int n = 0; n < 2; ++n) { const f32x4 x = v[ai][bj][m][n]; s += (x[0] + x[1]) + (x[2] + x[3]); }
                s += __shfl_xor(s, 16); s += __shfl_xor(s, 32);
                const float mw = s * (1.0f / 64.0f); float q = 0.f;
#pragma unroll
                for (int bj = 0; bj < 2; ++bj)
#pragma unroll
                    for (int n = 0; n < 2; ++n) { const f32x4 d = v[ai][bj][m][n] - mw; q += (d[0] * d[0] + d[1] * d[1]) + (d[2] * d[2] + d[3] * d[3]); }
                q += __shfl_xor(q, 16); q += __shfl_xor(q, 32);
                if (fq == 0) P[(ai * HALF + wr * 64 + m * 16 + fr) * 4 + wc] = (f32x2){mw, q};
            }
        asm volatile("s_waitcnt lgkmcnt(0)" ::: "memory"); __builtin_amdgcn_s_barrier(); asm volatile("" ::: "memory");
        const int row = wid * 32 + (lane & 31);
        if (lane < 32) {
            const f32x2 a = P[row * 4 + 0], b = P[row * 4 + 1], c = P[row * 4 + 2], d = P[row * 4 + 3];
            const float mt = (a.x + b.x + c.x + d.x) * 0.25f;
            const float da = a.x - mt, db = b.x - mt, dc = c.x - mt, dd = d.x - mt;
            const float m2 = (a.y + b.y) + (c.y + d.y) + 64.0f * ((da * da + db * db) + (dc * dc + dd * dd));
            unsigned long long* slot = (unsigned long long*)xbuf + ((size_t)(panel * BM + row) * 4 + u.pn);
            __hip_atomic_store(slot, ((unsigned long long)__float_as_uint(m2) << 32) | __float_as_uint(mt), __ATOMIC_RELAXED, __HIP_MEMORY_SCOPE_AGENT);
        }
        asm volatile("s_waitcnt vmcnt(0)" ::: "memory");
        if (lane == 0) __hip_atomic_fetch_add(cnt + 64 * panel, 1u, __ATOMIC_RELAXED, __HIP_MEMORY_SCOPE_AGENT);
        if (wid == 0) {
            bool dead = false; const unsigned long long t0 = __builtin_amdgcn_s_memrealtime(); const unsigned want = 8u * 4u;
            for (;;) {
                if ((unsigned)__builtin_amdgcn_readfirstlane(__hip_atomic_load(cnt + 64 * panel, __ATOMIC_RELAXED, __HIP_MEMORY_SCOPE_AGENT)) >= want) break;
                if (__builtin_amdgcn_s_memrealtime() - t0 > 2000000ull) {
                    if (lane == 0) { unsigned expect = 0u; __hip_atomic_compare_exchange_strong(tmo + 1, &expect, code | (unsigned)(panel & 0xff), __ATOMIC_RELAXED, __ATOMIC_RELAXED, __HIP_MEMORY_SCOPE_AGENT);
                                     __hip_atomic_store(tmo, 1u, __ATOMIC_RELAXED, __HIP_MEMORY_SCOPE_AGENT); }
                    dead = true; break; }
                __builtin_amdgcn_s_sleep(2);
            }
            __builtin_amdgcn_fence(__ATOMIC_ACQUIRE, "agent");
            if (lane == 0) flag[0] = dead ? 1u : 0u;
        }
        asm volatile("s_waitcnt vmcnt(0) lgkmcnt(0)" ::: "memory"); __builtin_amdgcn_s_barrier(); asm volatile("" ::: "memory");
        const bool bad = flag[0] != 0u;
        if (lane < 32) {
            const unsigned long long* slot = (const unsigned long long*)xbuf + (size_t)(panel * BM + row) * 4; float mt[4], m2[4]; float ms = 0.f;
#pragma unroll
            for (int t = 0; t < 4; ++t) { const unsigned long long w = __hip_atomic_load(slot + t, __ATOMIC_RELAXED, __HIP_MEMORY_SCOPE_AGENT); mt[t] = __uint_as_float((unsigned)w); m2[t] = __uint_as_float((unsigned)(w >> 32)); ms += mt[t]; }
            const float mean = ms * 0.25f; float q = 0.f;
#pragma unroll
            for (int t = 0; t < 4; ++t) { const float dm = mt[t] - mean; q += m2[t] + 256.0f * dm * dm; }
            S[row] = (f32x2){mean, 1.0f / sqrtf(q * (1.0f / 1024.0f) + eps)};
        }
        asm volatile("s_waitcnt lgkmcnt(0)" ::: "memory"); __builtin_amdgcn_s_barrier(); asm volatile("" ::: "memory");
        return bad;
    }
};
struct EpiLn1 {
    static constexpr bool PERM = true, AFTER_DRAIN = true, HAS_MID = false; static constexpr int MID_T = 0;
    const float* x; float* out; bf16_t* xb; unsigned char* xq; const float* gam; const float* bet; PanelStats st; int row_off; unsigned poison; float rs;
    __device__ __forceinline__ void mid(f32x4 (&)[2][2][4][2], const Unit&, int, int, int, int) const {}
    __device__ __forceinline__ void operator()(const f32x4 (&)[2][2][4][2], const Unit&, int, int, int, int) const {}
    __device__ __forceinline__ void fused(f32x4 (&acc)[2][2][4][2], const Unit& u, int wr, int wc, int fr, int fq, LAS unsigned char* lds, int wid, int lane) const {
        const LAS f32x2* S = (const LAS f32x2*)(lds + 8192);
        const int col0 = u.pn * BM + wc * 32 + 8 * opaque(fq);
        const int grow0 = row_off + u.pm * BM; fr = opaque(fr);
#pragma unroll
        for (int ai = 0; ai < 2; ++ai)
#pragma unroll
            for (int m = 0; m < 4; ++m) { const size_t off = (size_t)(grow0 + ai * HALF + wr * 64 + m * 16 + fr) * D + col0;
#pragma unroll
                for (int bj = 0; bj < 2; ++bj)
#pragma unroll
                    for (int n = 0; n < 2; ++n) { const f32x4 bs = *(const f32x4*)(x + off + bj * HALF + n * 4); acc[ai][bj][m][n] = acc[ai][bj][m][n] * rs + bs * DN_ALPHA; }
                asm volatile("" : "+v"(acc[ai][0][m][0]), "+v"(acc[ai][0][m][1]), "+v"(acc[ai][1][m][0]), "+v"(acc[ai][1][m][1]));
                if (m == 3) asm volatile("" ::: "memory"); }
        const bool bad = st.run(acc, u, wr, wc, fr, fq, lds, wid, lane) || poison != 0u;
        const float qnan = __builtin_nanf("");
        f32x4 gv[2][2], bv[2][2];
#pragma unroll
        for (int bj = 0; bj < 2; ++bj)
#pragma unroll
            for (int n = 0; n < 2; ++n) { gv[bj][n] = *(const f32x4*)(gam + col0 + bj * HALF + n * 4); bv[bj][n] = *(const f32x4*)(bet + col0 + bj * HALF + n * 4); }
#pragma unroll
        for (int ai = 0; ai < 2; ++ai)
#pragma unroll
            for (int m = 0; m < 4; ++m) { const int r = ai * HALF + wr * 64 + m * 16 + fr; const f32x2 sr = S[r]; const size_t off = (size_t)(grow0 + r) * D + col0;
#pragma unroll
                for (int bj = 0; bj < 2; ++bj) { f32x4 o0 = (acc[ai][bj][m][0] - sr.x) * sr.y * gv[bj][0] + bv[bj][0], o1 = (acc[ai][bj][m][1] - sr.x) * sr.y * gv[bj][1] + bv[bj][1];
                    if (bad) { o0 = (f32x4){qnan, qnan, qnan, qnan}; o1 = o0; }
                    u32x4 w; w.x = cvt_pk_bf16(o0[0], o0[1]); w.y = cvt_pk_bf16(o0[2], o0[3]); w.z = cvt_pk_bf16(o1[0], o1[1]); w.w = cvt_pk_bf16(o1[2], o1[3]); *(u32x4*)(xb + off + bj * HALF) = w;
                    u32x2 q8; q8.x = pk4_fp8(clamp_fp8(o0[0] * SX), clamp_fp8(o0[1] * SX), clamp_fp8(o0[2] * SX), clamp_fp8(o0[3] * SX)); q8.y = pk4_fp8(clamp_fp8(o1[0] * SX), clamp_fp8(o1[1] * SX), clamp_fp8(o1[2] * SX), clamp_fp8(o1[3] * SX));
                    *(u32x2*)(xq + off + bj * HALF) = q8; } }
    }
};
struct EpiY {
    static constexpr bool PERM = true, AFTER_DRAIN = false, HAS_MID = false; static constexpr int MID_T = 0;
    const float* __restrict__ x; bf16_t* __restrict__ Y; float* __restrict__ ST; float rs;
    __device__ __forceinline__ void mid(f32x4 (&)[2][2][4][2], const Unit&, int, int, int, int) const {}
    __device__ __forceinline__ void operator()(const f32x4 (&acc)[2][2][4][2], const Unit& u, int wr, int wc, int fr, int fq) const {
        const int row0 = u.pm * BM + wr * 64 + opaque(fr), col0 = u.pn * BM + wc * 32 + 8 * opaque(fq);
#pragma unroll
        for (int ai = 0; ai < 2; ++ai) {
            f32x4 xv[4][2][2];
#pragma unroll
            for (int m = 0; m < 4; ++m)
#pragma unroll
                for (int bj = 0; bj < 2; ++bj)
#pragma unroll
                    for (int n = 0; n < 2; ++n) xv[m][bj][n] = *(const f32x4*)(x + (size_t)(row0 + ai * HALF + m * 16) * D + col0 + bj * HALF + n * 4);
#pragma unroll
            for (int m = 0; m < 4; ++m) { const size_t r = (size_t)(row0 + ai * HALF + m * 16); float s1 = 0.f, s2 = 0.f;
#pragma unroll
                for (int bj = 0; bj < 2; ++bj) { const f32x4 y0 = acc[ai][bj][m][0] * rs + xv[m][bj][0] * DN_ALPHA, y1 = acc[ai][bj][m][1] * rs + xv[m][bj][1] * DN_ALPHA;
                    s1 += (y0[0] + y0[1]) + (y0[2] + y0[3]) + (y1[0] + y1[1]) + (y1[2] + y1[3]);
                    s2 += (y0[0] * y0[0] + y0[1] * y0[1]) + (y0[2] * y0[2] + y0[3] * y0[3]) + (y1[0] * y1[0] + y1[1] * y1[1]) + (y1[2] * y1[2] + y1[3] * y1[3]);
                    u32x4 w; w.x = cvt_pk_bf16(y0[0], y0[1]); w.y = cvt_pk_bf16(y0[2], y0[3]); w.z = cvt_pk_bf16(y1[0], y1[1]); w.w = cvt_pk_bf16(y1[2], y1[3]);
                    *(u32x4*)(Y + r * D + col0 + bj * HALF) = w; }
                s1 += __shfl_xor(s1, 16); s1 += __shfl_xor(s1, 32); s2 += __shfl_xor(s2, 16); s2 += __shfl_xor(s2, 32);
                if (fq == 0) *(f32x2*)(ST + (r * 16 + u.pn * 4 + wc) * 2) = (f32x2){s1, s2}; }
            asm volatile("" ::: "memory"); }
    }
};
struct EpiGU {
    static constexpr bool PERM = true, AFTER_DRAIN = false, HAS_MID = false; static constexpr int MID_T = 0;
    const float* bg; const float* bu; unsigned char* H;
    __device__ __forceinline__ void mid(f32x4 (&)[2][2][4][2], const Unit&, int, int, int, int) const {}
    __device__ __forceinline__ void operator()(const f32x4 (&acc)[2][2][4][2], const Unit& u, int wr, int wc, int fr, int fq) const {
        const int row0 = u.pm * BM + wr * 64 + opaque(fr), j0 = u.pn * HALF + wc * 32 + 8 * opaque(fq);
        const f32x4 g0 = *(const f32x4*)(bg + u.e * DFF + j0), g1 = *(const f32x4*)(bg + u.e * DFF + j0 + 4);
        const f32x4 u0 = *(const f32x4*)(bu + u.e * DFF + j0), u1 = *(const f32x4*)(bu + u.e * DFF + j0 + 4);
#pragma unroll
        for (int ai = 0; ai < 2; ++ai)
#pragma unroll
            for (int m = 0; m < 4; ++m) {
                constexpr float RS = 1.0f / (SX * SW);
                f32x4 gt0 = acc[ai][0][m][0] * RS + g0, gt1 = acc[ai][0][m][1] * RS + g1, up0 = acc[ai][1][m][0] * RS + u0, up1 = acc[ai][1][m][1] * RS + u1; f32x4 h0, h1;
#pragma unroll
                for (int q = 0; q < 4; ++q) {
                    const float a = fminf(gt0[q], 7.0f), b = fminf(gt1[q], 7.0f);
                    const float ua = fminf(fmaxf(up0[q], -7.0f), 7.0f), ub = fminf(fmaxf(up1[q], -7.0f), 7.0f);
                    h0[q] = (a * __builtin_amdgcn_rcpf(1.0f + __builtin_amdgcn_exp2f(-1.702f * LOG2E * a))) * __builtin_fmaf(ua, SH, SH);
                    h1[q] = (b * __builtin_amdgcn_rcpf(1.0f + __builtin_amdgcn_exp2f(-1.702f * LOG2E * b))) * __builtin_fmaf(ub, SH, SH); }
                u32x2 w; w.x = pk4_fp8(h0[0], h0[1], h0[2], h0[3]); w.y = pk4_fp8(h1[0], h1[1], h1[2], h1[3]);
                *(u32x2*)(H + (size_t)(row0 + ai * HALF + m * 16) * DFF + j0) = w; }
    }
};
struct EpiDown {
    static constexpr bool PERM = true, AFTER_DRAIN = false, HAS_MID = false; static constexpr int MID_T = 0;
    const float* bd; const int* petok; const float* pegate; unsigned char* Y;
    __device__ __forceinline__ void mid(f32x4 (&)[2][2][4][2], const Unit&, int, int, int, int) const {}
    __device__ __forceinline__ void operator()(const f32x4 (&acc)[2][2][4][2], const Unit& u, int wr, int wc, int fr, int fq) const {
        const int r0 = wr * 64 + opaque(fr), col0 = u.pn * BM + wc * 32 + 8 * opaque(fq);
        f32x4 b[2][2];
#pragma unroll
        for (int bj = 0; bj < 2; ++bj) { b[bj][0] = *(const f32x4*)(bd + u.e * D + col0 + bj * HALF); b[bj][1] = *(const f32x4*)(bd + u.e * D + col0 + bj * HALF + 4); }
        const size_t eb = (size_t)u.e * NTOK + (size_t)u.ti * 256;
        int info[2][4]; float gwv[2][4];
#pragma unroll
        for (int ai = 0; ai < 2; ++ai)
#pragma unroll
            for (int m = 0; m < 4; ++m) { const int r = r0 + ai * HALF + m * 16; info[ai][m] = petok[eb + r]; gwv[ai][m] = pegate[eb + r] * SY; }
#pragma unroll
        for (int ai = 0; ai < 2; ++ai)
#pragma unroll
            for (int m = 0; m < 4; ++m) { const int r = r0 + ai * HALF + m * 16;
                if (r < u.valid) { const float gw = gwv[ai][m];
                    unsigned char* op = Y + (size_t)info[ai][m] * 1024 + col0;
#pragma unroll
                    for (int bj = 0; bj < 2; ++bj) { constexpr float RS = 1.0f / (SH * SW); const f32x4 v0 = (acc[ai][bj][m][0] * RS + b[bj][0]) * gw, v1 = (acc[ai][bj][m][1] * RS + b[bj][1]) * gw;
                        u32x2 w; w.x = pk4_fp8(clamp_fp8(v0[0]), clamp_fp8(v0[1]), clamp_fp8(v0[2]), clamp_fp8(v0[3])); w.y = pk4_fp8(clamp_fp8(v1[0]), clamp_fp8(v1[1]), clamp_fp8(v1[2]), clamp_fp8(v1[3]));
                        *(u32x2*)(op + bj * HALF) = w; } } }
    }
};
}

#define XB_TMO      128
#define XB_XCNT(j)  (256  + 64 * (j))
#define XB_XSUB(j)  (1280 + 64 * (j))
#define XB_XGEN(j)  (2304 + 64 * (j))
#define XB_TOP      3328
#define XB_TOPGEN   3392
#define XCD_BAR_WORDS 3456
#define XB_SPIN_CAP (1u << 18)
__device__ __forceinline__ unsigned xb_ld(unsigned* p)              { return __hip_atomic_load(p, __ATOMIC_RELAXED, __HIP_MEMORY_SCOPE_AGENT); }
__device__ __forceinline__ unsigned xb_add(unsigned* p, unsigned v) { return __hip_atomic_fetch_add(p, v, __ATOMIC_RELAXED, __HIP_MEMORY_SCOPE_AGENT); }
__device__ __forceinline__ unsigned xb_xcc_id() { return (unsigned)__builtin_amdgcn_s_getreg((3 << 11) | 20) & 0xFu; }
#define XB_SPIN(cond, bar) do { unsigned _sp = 0; while (cond) { __builtin_amdgcn_s_sleep(1); \
    if ((++_sp & 255u) == 0u) { if (xb_ld(&(bar)[XB_TMO])) break; if (_sp > XB_SPIN_CAP) { atomicAdd(&(bar)[XB_TMO], 1u); break; } } } } while (0)
struct XcdBarrier { unsigned* bar; unsigned x; volatile LAS unsigned* st; };
__device__ __forceinline__ XcdBarrier xcd_barrier_post(unsigned* bar, volatile LAS unsigned* st) {
    XcdBarrier b; b.bar = bar; b.x = xb_xcc_id(); b.st = st;
    if (threadIdx.x == 0) (void)xb_add(&bar[XB_XCNT(b.x)], 1u);
    return b;
}
__device__ __forceinline__ void xcd_barrier_complete(unsigned* bar, unsigned x, unsigned& nloc, unsigned& nx) {
    const unsigned G = gridDim.x * gridDim.y * gridDim.z;
    unsigned sum, cnt, mine, sp = 0u;
    for (;;) {
        sum = 0u; cnt = 0u; mine = 0u;
#pragma unroll
        for (unsigned j = 0; j < 16; ++j) { const unsigned c = xb_ld(&bar[XB_XCNT(j)]); sum += c; cnt += (c > 0u) ? 1u : 0u; mine = (j == x) ? c : mine; }
        if (sum == G) break;
        __builtin_amdgcn_s_sleep(1);
        if ((++sp & 255u) == 0u) { if (xb_ld(&bar[XB_TMO])) break; if (sp > XB_SPIN_CAP) { atomicAdd(&bar[XB_TMO], 1u); break; } }
    }
    nloc = mine > 0u ? mine : 1u; nx = cnt > 0u ? cnt : 1u;
}
__device__ __forceinline__ void xcd_barrier(const XcdBarrier& b) {
    asm volatile("s_waitcnt vmcnt(0)" ::: "memory");
    __syncthreads();
    if (threadIdx.x == 0) {
        unsigned* bar = b.bar;
        __builtin_amdgcn_s_waitcnt(0);
        unsigned nloc = b.st[0], nx = b.st[1];
        if (nloc == 0u) { xcd_barrier_complete(bar, b.x, nloc, nx); b.st[0] = nloc; b.st[1] = nx; }
        const unsigned old = xb_add(&bar[XB_XSUB(b.x)], 1u);
        const unsigned gen = old / nloc;
        if (old + 1u == (gen + 1u) * nloc) {
            __builtin_amdgcn_fence(__ATOMIC_RELEASE, "agent");
            asm volatile("s_waitcnt vmcnt(0)" ::: "memory");
            const unsigned og = xb_add(&bar[XB_TOP], 1u);
            const unsigned tg = og / nx;
            if (og + 1u == (tg + 1u) * nx) xb_add(&bar[XB_TOPGEN], 1u);
            else XB_SPIN(xb_ld(&bar[XB_TOPGEN]) == tg, bar);
            __builtin_amdgcn_fence(__ATOMIC_ACQUIRE, "agent");
            xb_add(&bar[XB_XGEN(b.x)], 1u);
            asm volatile("s_waitcnt vmcnt(0)" ::: "memory");
        } else {
            XB_SPIN(xb_ld(&bar[XB_XGEN(b.x)]) == gen, bar);
            __builtin_amdgcn_fence(__ATOMIC_ACQUIRE, "agent");
            asm volatile("s_waitcnt vmcnt(0)" ::: "memory");
        }
    }
    __syncthreads();
}

constexpr int NWAVES = 8;
struct Frame {
    LAS unsigned char* lds; volatile LAS unsigned* MISC; gu32* ctl;
    int tid, lane, wave, vcu, G;
    unsigned char* ws; unsigned char* dout;
};
__device__ __forceinline__ float wave_sum(float v) {
#pragma unroll
    for (int o = 1; o < 64; o <<= 1) v += __shfl_xor(v, o);
    return v;
}
__device__ __forceinline__ void transpose_item(const float* W, int N, int k0, int n0, bf16_t* WT, int ldw, size_t drow0, int dcol0, LAS float* scr, int lane) {
#pragma unroll 8
    for (int i = 0; i < 32; ++i) { const int kk = 2 * i + (lane >> 5); scr[kk * 33 + (lane & 31)] = W[(size_t)(k0 + kk) * N + n0 + (lane & 31)]; }
    LDS_WAIT(); asm volatile("" ::: "memory");
    const int c = lane & 7;
#pragma unroll
    for (int j = 0; j < 4; ++j) { const int n = (lane >> 3) + 8 * j; const LAS float* s = scr + (8 * c) * 33 + n;
        u32x4 o; o.x = cvt_pk_bf16(s[0 * 33], s[1 * 33]); o.y = cvt_pk_bf16(s[2 * 33], s[3 * 33]); o.z = cvt_pk_bf16(s[4 * 33], s[5 * 33]); o.w = cvt_pk_bf16(s[6 * 33], s[7 * 33]);
        *(GAS u32x4*)(WT + (drow0 + n) * (size_t)ldw + dcol0 + 8 * c) = o; }
    LDS_WAIT(); asm volatile("" ::: "memory");
}
__device__ __forceinline__ void transpose_item_f8(const float* W, int N, int k0, int n0, unsigned char* WT, int ldw, size_t drow0, int dcol0, LAS float* scr, int lane);
__device__ __forceinline__ void p0_convert(Frame& F, const float* x, const float* w_in, const float* w_pa, const float* w_pb, const float* w_out, const float* rw) {
    LAS float* scr = (LAS float*)(F.lds + F.wave * 17408);
    const int gw = F.vcu * NWAVES + F.wave, NGW = F.G * NWAVES;
    unsigned char* WIN = F.dout + DO_WIN; unsigned char* WCAT = F.dout + DO_WCAT; unsigned char* WOUT = F.ws + WS_WOUT;
    constexpr int I_IN = (D / 128) * (IN_COLS / 32), I_OUT = (D / 128) * (D / 32), I_PA = (256 / 128) * (D / 32), I_PB = (D / 128) * (D / 32);
    for (int it = gw; it < I_IN + I_OUT + I_PA + I_PB; it += NGW) {
        int r = it;
        if (r < I_IN) { const int nb = IN_COLS / 32; transpose_item_f8(w_in, IN_COLS, 128 * (r / nb), 32 * (r % nb), WIN, D, (size_t)(32 * (r % nb)), 128 * (r / nb), scr, F.lane); continue; } r -= I_IN;
        if (r < I_OUT) { const int nb = D / 32; transpose_item_f8(w_out, D, 128 * (r / nb), 32 * (r % nb), WOUT, D, (size_t)(32 * (r % nb)), 128 * (r / nb), scr, F.lane); continue; } r -= I_OUT;
        if (r < I_PA) { const int nb = D / 32; transpose_item_f8(w_pa, D, 128 * (r / nb), 32 * (r % nb), WCAT, OAB_P, (size_t)(32 * (r % nb)), 128 * (r / nb), scr, F.lane); continue; } r -= I_PA;
        { const int nb = D / 32; transpose_item_f8(w_pb, D, 128 * (r / nb), 32 * (r % nb), WCAT, OAB_P, (size_t)(32 * (r % nb)), 256 + 128 * (r / nb), scr, F.lane); }
    }
    { bf16_t* WRT = (bf16_t*)(F.ws + WS_WRT);
      for (int i = gw * 64 + F.lane; i < NEXP * D; i += NGW * 64) { const int e = i >> 10, k = i & (D - 1); const float w = rw[k * NEXP + e];
          const unsigned hi = cvt_pk_bf16(w, 0.f) & 0xffffu; const float r = w - __uint_as_float(hi << 16);
          WRT[i] = (bf16_t)hi; WRT[NEXP * D + i] = (bf16_t)(cvt_pk_bf16(r, 0.f) & 0xffffu); } }
    unsigned char* XQ = F.dout + DO_XB;
    const size_t n16 = (size_t)NTOK * D / 16;
    for (size_t i = (size_t)gw * 64 + F.lane; i < n16; i += (size_t)NGW * 64) {
        const f32x4 a = *(const GAS f32x4*)(x + i * 16), b = *(const GAS f32x4*)(x + i * 16 + 4), c = *(const GAS f32x4*)(x + i * 16 + 8), d = *(const GAS f32x4*)(x + i * 16 + 12);
        u32x4 o;
        o.x = pk4_fp8(clamp_fp8(a[0] * SXIN), clamp_fp8(a[1] * SXIN), clamp_fp8(a[2] * SXIN), clamp_fp8(a[3] * SXIN)); o.y = pk4_fp8(clamp_fp8(b[0] * SXIN), clamp_fp8(b[1] * SXIN), clamp_fp8(b[2] * SXIN), clamp_fp8(b[3] * SXIN));
        o.z = pk4_fp8(clamp_fp8(c[0] * SXIN), clamp_fp8(c[1] * SXIN), clamp_fp8(c[2] * SXIN), clamp_fp8(c[3] * SXIN)); o.w = pk4_fp8(clamp_fp8(d[0] * SXIN), clamp_fp8(d[1] * SXIN), clamp_fp8(d[2] * SXIN), clamp_fp8(d[3] * SXIN));
        *(GAS u32x4*)(XQ + i * 16) = o;
    }
}
__device__ __forceinline__ void transpose_item_f8(const float* W, int N, int k0, int n0, unsigned char* WT, int ldw, size_t drow0, int dcol0, LAS float* scr, int lane) {
    f32x4 wv[16];
#pragma unroll
    for (int i = 0; i < 16; ++i) wv[i] = *(const GAS f32x4*)(W + (size_t)(k0 + 8 * i + (lane >> 3)) * N + n0 + (lane & 7) * 4);
#pragma unroll
    for (int i = 0; i < 16; ++i) { LAS float* d = scr + (8 * i + (lane >> 3)) * 33 + (lane & 7) * 4; d[0] = wv[i][0]; d[1] = wv[i][1]; d[2] = wv[i][2]; d[3] = wv[i][3]; }
    LDS_WAIT(); asm volatile("" ::: "memory");
    const int c = lane & 7;
#pragma unroll
    for (int j = 0; j < 4; ++j) { const int n = (lane >> 3) + 8 * j; const LAS float* s = scr + (16 * c) * 33 + n;
        u32x4 o;
        o.x = pk4_fp8(clamp_fp8(s[0 * 33] * SW), clamp_fp8(s[1 * 33] * SW), clamp_fp8(s[2 * 33] * SW), clamp_fp8(s[3 * 33] * SW));
        o.y = pk4_fp8(clamp_fp8(s[4 * 33] * SW), clamp_fp8(s[5 * 33] * SW), clamp_fp8(s[6 * 33] * SW), clamp_fp8(s[7 * 33] * SW));
        o.z = pk4_fp8(clamp_fp8(s[8 * 33] * SW), clamp_fp8(s[9 * 33] * SW), clamp_fp8(s[10 * 33] * SW), clamp_fp8(s[11 * 33] * SW));
        o.w = pk4_fp8(clamp_fp8(s[12 * 33] * SW), clamp_fp8(s[13 * 33] * SW), clamp_fp8(s[14 * 33] * SW), clamp_fp8(s[15 * 33] * SW));
        *(GAS u32x4*)(WT + (drow0 + n) * (size_t)ldw + dcol0 + 16 * c) = o; }
    LDS_WAIT(); asm volatile("" ::: "memory");
}
__device__ __forceinline__ void p3_convert_moe(Frame& F, const float* w_gate, const float* w_up, const float* w_down, int wg, int nwg) {
    LAS float* scr = (LAS float*)(F.lds + F.wave * 17408);
    const int gw = wg * NWAVES + F.wave, NGW = nwg * NWAVES;
    unsigned char* WGU = F.ws + WS_WGU; unsigned char* WD = F.ws + WS_WD;
    constexpr int IPM = (D / 128) * (DFF / 32);
    for (int it = gw; it < NEXP * 3 * IPM; it += NGW) {
        const int e = it / (3 * IPM), r3 = it % (3 * IPM), which = r3 / IPM, r = r3 % IPM, kb = r / 32, nb = r % 32, k0 = 128 * kb, n0 = 32 * nb;
        const size_t moff = (size_t)e * D * DFF;
        if (which == 2) transpose_item_f8(w_down + moff, D, k0, n0, WD + moff, DFF, (size_t)n0, k0, scr, F.lane);
        else { const int pn = n0 >> 7, jj = n0 & 127; transpose_item_f8((which ? w_up : w_gate) + moff, DFF, k0, n0, WGU + 2 * moff, D, (size_t)(256 * pn + 128 * which + jj), k0, scr, F.lane); }
    }
}
typedef short v4i16_t __attribute__((ext_vector_type(4)));
__device__ __forceinline__ s16x4 tr_read(const LAS unsigned char* p) { return __builtin_bit_cast(s16x4, __builtin_amdgcn_ds_read_tr16_b64_v4i16((LAS v4i16_t*)p)); }
constexpr int ATT_KOFF = 0, ATT_VOFF = 12 * 4096, ATT_STG = 24 * 4096, ATT_STGW = 4608;
static_assert(ATT_STG + 8 * ATT_STGW <= SCR_BYTES, "attention LDS map");
__device__ __forceinline__ void attn_unit(LAS unsigned char* lds, int lane, int wave, const bf16_t* qseq, const bf16_t* kseq, const bf16_t* vseq, int jt0, int nkt, int jq, int s0,
                                          float sl2, bool swa, float sink2, bf16_t* ob, unsigned op, float* lseb, unsigned lsep) {
    const int i32 = lane & 31, h = lane >> 5;
    for (int p = wave; p < nkt * 8; p += 8) {
        const int s = p >> 3, kind = (p >> 2) & 1, qt = p & 3; const int tj = jt0 + s; const size_t pos0 = (size_t)(32 * (tj >= 0 ? tj : 0));
        if (kind == 0) { const int key = 8 * qt + (lane >> 3), c = (lane & 7) ^ ((key >> 1) & 7);
            __builtin_amdgcn_global_load_lds((const unsigned*)((const char*)kseq + (pos0 + key) * 128 + c * 16), (LAS unsigned*)(lds + ATT_KOFF + s * 4096 + qt * 1024), 16, 0, 0); }
        else { const int blk = qt >> 1, part = qt & 1, key = 16 * part + (lane >> 2);
            __builtin_amdgcn_global_load_lds((const unsigned*)((const char*)vseq + (pos0 + key) * 128 + blk * 64 + (lane & 3) * 16), (LAS unsigned*)(lds + ATT_VOFF + s * 4096 + blk * 2048 + part * 1024), 16, 0, 0); }
    }
    bf16x8 qf[4];
    { const char* qrow = (const char*)qseq + (size_t)(32 * jq + i32) * 128 + h * 16;
#pragma unroll
      for (int d0 = 0; d0 < 4; ++d0) qf[d0] = *(const bf16x8*)(qrow + d0 * 32); }
    f32x16 bias;
#pragma unroll
    for (int r = 0; r < 16; ++r) { const int kk = (r & 3) + 8 * (r >> 2) + 4 * h; bias[r] = sl2 * (float)(kk - i32); }
    asm volatile("s_waitcnt vmcnt(0)" ::: "memory");
    __builtin_amdgcn_s_barrier();
    asm volatile("" ::: "memory");
    f32x16 S[5];
    float m2 = sink2;
    const int kro = i32 * 128, ksw = (i32 >> 1) & 7;
    bf16x8 kf[2][4];
#pragma unroll
    for (int c = 0; c < 5; ++c) {
        const bool tv = (jq - 4 + c) >= 0;
        const LAS unsigned char* ks = lds + ATT_KOFF + (s0 + c) * 4096 + kro;
#pragma unroll
        for (int d0 = 0; d0 < 4; ++d0) kf[c & 1][d0] = *(const LAS bf16x8*)(ks + (((2 * d0 + h) ^ ksw) * 16));
        if (c > 0) asm volatile("" :: "v"(kf[(c - 1) & 1][0]), "v"(kf[(c - 1) & 1][1]), "v"(kf[(c - 1) & 1][2]), "v"(kf[(c - 1) & 1][3]) : "memory");
        f32x16 a = bias;
#pragma unroll
        for (int d0 = 0; d0 < 4; ++d0) a = __builtin_amdgcn_mfma_f32_32x32x16_bf16(kf[c & 1][d0], qf[d0], a, 0, 0, 0);
        const float off = -sl2 * (float)(32 * (4 - c));
#pragma unroll
        for (int r = 0; r < 16; ++r) { const int kk = (r & 3) + 8 * (r >> 2) + 4 * h; bool ok = tv;
            if (c == 4) ok = ok && (kk <= i32);
            if (c == 0) ok = ok && (swa ? (kk > i32) : (kk >= i32));
            const float v = ok ? a[r] + off : NEG_BIG; a[r] = v; m2 = fmaxf(m2, v); }
        S[c] = a;
    }
    m2 = fmaxf(m2, __shfl_xor(m2, 32));
    float l = 0.f;
#pragma unroll
    for (int c = 0; c < 5; ++c)
#pragma unroll
        for (int r = 0; r < 16; ++r) { const float p = __builtin_amdgcn_exp2f(S[c][r] - m2); S[c][r] = p; l += p; }
    l += __shfl_xor(l, 32);
    l += __builtin_amdgcn_exp2f(sink2 - m2);
    asm volatile("" :: "v"(kf[0][0]), "v"(kf[0][1]), "v"(kf[0][2]), "v"(kf[0][3]), "v"(kf[1][0]), "v"(kf[1][1]), "v"(kf[1][2]), "v"(kf[1][3]) : "memory");
    f32x16 O[2]; O[0] = (f32x16){}; O[1] = (f32x16){};
    const int vaddr0 = ((lane >> 4) & 1) * 32 + (lane & 3) * 8 + (4 * h + ((lane & 15) >> 2)) * 64;
    bf16x8 va[2][4];
#pragma unroll
    for (int c = 0; c < 5; ++c) {
        const LAS unsigned char* buf = lds + ATT_VOFF + (s0 + c) * 4096;
        bf16x8 pf[2];
#pragma unroll
        for (int s = 0; s < 2; ++s) { u32x4 w; w.x = cvt_pk_bf16(S[c][8 * s + 0], S[c][8 * s + 1]); w.y = cvt_pk_bf16(S[c][8 * s + 2], S[c][8 * s + 3]);
            w.z = cvt_pk_bf16(S[c][8 * s + 4], S[c][8 * s + 5]); w.w = cvt_pk_bf16(S[c][8 * s + 6], S[c][8 * s + 7]); pf[s] = __builtin_bit_cast(bf16x8, w); }
#pragma unroll
        for (int blk = 0; blk < 2; ++blk)
#pragma unroll
            for (int s = 0; s < 2; ++s) {
                const s16x4 lo = tr_read(buf + blk * 2048 + (16 * s) * 64 + vaddr0), hi = tr_read(buf + blk * 2048 + (16 * s + 8) * 64 + vaddr0);
                va[c & 1][blk * 2 + s] = (bf16x8){lo[0], lo[1], lo[2], lo[3], hi[0], hi[1], hi[2], hi[3]}; }
        if (c > 0) asm volatile("" :: "v"(va[(c - 1) & 1][0]), "v"(va[(c - 1) & 1][1]), "v"(va[(c - 1) & 1][2]), "v"(va[(c - 1) & 1][3]) : "memory");
#pragma unroll
        for (int blk = 0; blk < 2; ++blk)
#pragma unroll
            for (int s = 0; s < 2; ++s) O[blk] = __builtin_amdgcn_mfma_f32_32x32x16_bf16(va[c & 1][blk * 2 + s], pf[s], O[blk], 0, 0, 0);
    }
    const float inv = 1.0f / l;
    LAS unsigned char* stg = lds + ATT_STG + wave * ATT_STGW;
    if (swa) {
        const float is = inv * SO;
#pragma unroll
        for (int blk = 0; blk < 2; ++blk)
#pragma unroll
            for (int g4 = 0; g4 < 4; ++g4) { const int d0 = blk * 32 + 8 * g4 + 4 * h;
                *(LAS unsigned*)(stg + i32 * 80 + d0) = f2e4m3_sw(O[blk][4 * g4 + 0] * is) | (f2e4m3_sw(O[blk][4 * g4 + 1] * is) << 8) | (f2e4m3_sw(O[blk][4 * g4 + 2] * is) << 16) | (f2e4m3_sw(O[blk][4 * g4 + 3] * is) << 24); }
        asm volatile("s_waitcnt lgkmcnt(0)" ::: "memory");
#pragma unroll
        for (int it = 0; it < 2; ++it) { const int row = it * 16 + (lane >> 2), ch = lane & 3;
            const u32x4 v = *(const LAS u32x4*)(stg + row * 80 + ch * 16);
            *(u32x4*)((char*)ob + (size_t)(32 * jq + row) * op + ch * 16) = v; }
    } else {
#pragma unroll
        for (int blk = 0; blk < 2; ++blk)
#pragma unroll
            for (int g4 = 0; g4 < 4; ++g4) { const int d0 = blk * 32 + 8 * g4 + 4 * h;
                u32x2 w; w.x = cvt_pk_bf16(O[blk][4 * g4 + 0] * inv, O[blk][4 * g4 + 1] * inv); w.y = cvt_pk_bf16(O[blk][4 * g4 + 2] * inv, O[blk][4 * g4 + 3] * inv);
                *(LAS u32x2*)(stg + i32 * 144 + d0 * 2) = w; }
        asm volatile("s_waitcnt lgkmcnt(0)" ::: "memory");
#pragma unroll
        for (int it = 0; it < 4; ++it) { const int row = it * 8 + (lane >> 3), ch = lane & 7;
            const u32x4 v = *(const LAS u32x4*)(stg + row * 144 + ch * 16);
            *(u32x4*)((char*)ob + (size_t)(32 * jq + row) * op + ch * 16) = v; }
    }
    asm volatile("" :: "v"(va[0][0]), "v"(va[0][1]), "v"(va[0][2]), "v"(va[0][3]), "v"(va[1][0]), "v"(va[1][1]), "v"(va[1][2]), "v"(va[1][3]) : "memory");
    if (lseb != nullptr && h == 0) lseb[(size_t)(32 * jq + i32) * lsep] = (m2 + __builtin_amdgcn_logf(l)) * LN2;
    asm volatile("s_waitcnt lgkmcnt(0)" ::: "memory");
    __builtin_amdgcn_s_barrier();
    asm volatile("" ::: "memory");
}
__device__ __forceinline__ void p2_attention(Frame& F, const float* sinks) {
    const unsigned char* HQ = F.ws + WS_HQ; unsigned char* OAB = F.dout + DO_OAB; bf16_t* OAG = (bf16_t*)(F.ws + WS_OAG); float* LSE = (float*)(F.ws + WS_LSE);
    constexpr int NUNIT = 2048 + 1536;
    const int per = (NUNIT + F.G - 1) / F.G;
    for (int ui = 0; ui < per; ++ui) {
        const int U = ui * F.G + F.vcu; if (U >= NUNIT) break;
        if (U < 2048) {
            const int b = U >> 8, kvh = (U >> 7) & 1, j = U & 127, hq = kvh * 8 + F.wave;
            const float slope = exp2f(-8.0f * (float)(hq + 1) / 28.0f);
            attn_unit(F.lds, F.lane, F.wave, (const bf16_t*)(HQ + HQ_QS) + (size_t)(b * 16 + hq) * SEQ * 64, (const bf16_t*)(HQ + HQ_KS) + (size_t)(b * 2 + kvh) * SEQ * 64, (const bf16_t*)(HQ + HQ_VS) + (size_t)(b * 2 + kvh) * SEQ * 64,
                      j - 4, 5, j, 0, slope * LOG2E, true, sinks[hq] * LOG2E, (bf16_t*)(OAB + (size_t)b * SEQ * OAB_P + 256 + hq * 64), OAB_P, nullptr, 0);
        } else {
            const int v = U - 2048, g = v >> 9, w_ = v & 511, b = w_ >> 6, x = w_ & 63, hh = x >> 4, y = x & 15;
            const int dil = (g == 0) ? 1 : (g == 1) ? 4 : 16;
            const int res = (g == 0) ? 0 : (g == 1) ? (y >> 2) : y;
            const int j0 = (g == 0) ? y * 8 : (g == 1) ? (y & 3) * 8 : 0;
            const size_t seq = ((size_t)((g * NB + b) * 4 + hh) * SEQ + (size_t)res * (SEQ / dil)) * 64;
            const size_t tok0 = (size_t)b * SEQ + res;
            const float slope = exp2f(-8.0f * (float)(16 + g * 4 + hh + 1) / 28.0f);
            attn_unit(F.lds, F.lane, F.wave, (const bf16_t*)(HQ + HQ_QD) + seq, (const bf16_t*)(HQ + HQ_KD) + seq, (const bf16_t*)(HQ + HQ_VD) + seq,
                      j0 - 4, 12, j0 + F.wave, F.wave, slope * (float)dil * LOG2E, false, NEG_BIG,
                      OAG + ((size_t)g * NTOK + tok0) * 256 + hh * 64, (unsigned)(dil * 256 * 2), LSE + ((size_t)g * NTOK + tok0) * 4 + hh, (unsigned)(dil * 4));
        }
    }
}
__device__ __forceinline__ void p3_merge(Frame& F) {
    const bf16_t* OAG = (const bf16_t*)(F.ws + WS_OAG); const float* LSE = (const float*)(F.ws + WS_LSE); unsigned char* OAB = F.dout + DO_OAB;
    const int gw = F.vcu * NWAVES + F.wave, NGW = F.G * NWAVES;
    for (int idx = gw; idx < NTOK / 2; idx += NGW) {
        const int tok = idx * 2 + (F.lane >> 5), c8 = F.lane & 31, hh = c8 >> 3;
        float ls[3]; u32x4 o[3];
#pragma unroll
        for (int g = 0; g < 3; ++g) { ls[g] = LSE[((size_t)g * NTOK + tok) * 4 + hh]; o[g] = *(const u32x4*)(OAG + ((size_t)g * NTOK + tok) * 256 + c8 * 8); }
        const float m = fmaxf(fmaxf(ls[0], ls[1]), ls[2]);
        float w[3]; float sum = 0.f;
#pragma unroll
        for (int g = 0; g < 3; ++g) { w[g] = __builtin_amdgcn_exp2f((ls[g] - m) * LOG2E); sum += w[g]; }
        const float is = 1.0f / sum; float r[8];
#pragma unroll
        for (int q = 0; q < 8; ++q) r[q] = 0.f;
#pragma unroll
        for (int g = 0; g < 3; ++g) { const float wg = w[g] * is;
            r[0] += wg * bf_lo(o[g].x); r[1] += wg * bf_hi(o[g].x); r[2] += wg * bf_lo(o[g].y); r[3] += wg * bf_hi(o[g].y);
            r[4] += wg * bf_lo(o[g].z); r[5] += wg * bf_hi(o[g].z); r[6] += wg * bf_lo(o[g].w); r[7] += wg * bf_hi(o[g].w); }
        u32x2 out; out.x = pk4_fp8(clamp_fp8(r[0] * SO), clamp_fp8(r[1] * SO), clamp_fp8(r[2] * SO), clamp_fp8(r[3] * SO)); out.y = pk4_fp8(clamp_fp8(r[4] * SO), clamp_fp8(r[5] * SO), clamp_fp8(r[6] * SO), clamp_fp8(r[7] * SO));
        *(u32x2*)(OAB + (size_t)tok * OAB_P + c8 * 8) = out;
    }
}

__device__ __forceinline__ void p6_router(Frame& F, const bf16_t* y, const float* stat, const float* gam, const float* bet, bf16_t* x1b, unsigned char* x1q, const float* rb, int cw_ecnt, size_t pe_off) {
    constexpr int WPITCH = 2064;
    constexpr int WIMG = 64 * WPITCH;
    constexpr int GOFF = WIMG + 2048;
    static_assert(GOFF + 8192 <= SCR_BYTES, "router LDS map");
    LAS int* wcnt = (LAS int*)(F.lds + WIMG + F.wave * 256); LAS int* wbase = wcnt + 32;
    int* petok = (int*)(F.ws + WS_PETOK + pe_off); float* pegate = (float*)(F.ws + WS_PEGATE + pe_off);
    const bf16_t* WRT = (const bf16_t*)(F.ws + WS_WRT);
    const int gw = F.vcu * NWAVES + F.wave, NGW = F.G * NWAVES, lane = F.lane, j = lane & 15, kq = lane >> 4;
    __syncthreads();
    for (int q = F.tid; q < 64 * 128; q += NWAVES * 64) { const u32x4 v = *(const u32x4*)((const char*)WRT + (size_t)q * 16); *(LAS u32x4*)(F.lds + (q >> 7) * WPITCH + (q & 127) * 16) = v; }
    for (int q = F.tid; q < 512; q += NWAVES * 64) { const f32x4 v = (q < 256) ? *(const f32x4*)(gam + q * 4) : *(const f32x4*)(bet + (q - 256) * 4); *(LAS f32x4*)(F.lds + GOFF + q * 16) = v; }
    __syncthreads();
    const LAS unsigned char* wrow = F.lds + j * WPITCH + kq * 16;
    const LAS float* gl = (const LAS float*)(F.lds + GOFF) + 8 * kq; const LAS float* bl = gl + 1024;
    for (int tb = F.vcu * NWAVES; tb < NTOK / 16; tb += NGW) {
        const int tt = tb + F.wave; const bool valid = tt < NTOK / 16; const int t0 = (valid ? tt : 0) * 16;
        float mean, rstd;
        { const f32x4* sp = (const f32x4*)(stat + (size_t)(t0 + j) * 32); float s1 = 0.f, s2 = 0.f;
#pragma unroll
          for (int q = 0; q < 8; ++q) { const f32x4 v = sp[q]; s1 += v[0] + v[2]; s2 += v[1] + v[3]; }
          mean = s1 * (1.0f / D); const float var = fmaxf(s2 * (1.0f / D) - mean * mean, 0.f); rstd = 1.0f / sqrtf(var + LN_EPS); }
        f32x4 acc[2]; acc[0] = (f32x4){0.f, 0.f, 0.f, 0.f}; acc[1] = acc[0];
        const bf16_t* yrow = y + (size_t)(t0 + j) * D + 8 * kq;
        bf16_t* xbrow = (valid ? x1b : (bf16_t*)(F.ws + 300 * MiB)) + (size_t)(t0 + j) * D + 8 * kq; unsigned char* xqrow = (valid ? x1q : F.ws + 300 * MiB) + (size_t)(t0 + j) * D + 8 * kq;
        bf16x8 wf[2][4]; wf[1][0] = (bf16x8){}; wf[1][1] = wf[1][0]; wf[1][2] = wf[1][0]; wf[1][3] = wf[1][0];
        u32x4 yv[4], yn[4];
#pragma unroll
        for (int u = 0; u < 4; ++u) yv[u] = *(const u32x4*)(yrow + 32 * u);
#pragma unroll 1
        for (int so = 0; so < D / 32; so += 4) {
            const int sn = (so + 4 < D / 32) ? so + 4 : so;
#pragma unroll
            for (int u = 0; u < 4; ++u) yn[u] = *(const u32x4*)(yrow + 32 * (sn + u));
#pragma unroll
            for (int u = 0; u < 4; ++u) { const int sI = so + u;
                wf[u & 1][0] = *(const LAS bf16x8*)(wrow + 64 * sI); wf[u & 1][1] = *(const LAS bf16x8*)(wrow + 16 * WPITCH + 64 * sI);
                wf[u & 1][2] = *(const LAS bf16x8*)(wrow + 32 * WPITCH + 64 * sI); wf[u & 1][3] = *(const LAS bf16x8*)(wrow + 48 * WPITCH + 64 * sI);
                const f32x4 g0 = *(const LAS f32x4*)(gl + 32 * sI), g1 = *(const LAS f32x4*)(gl + 32 * sI + 4), b0 = *(const LAS f32x4*)(bl + 32 * sI), b1 = *(const LAS f32x4*)(bl + 32 * sI + 4);
                asm volatile("" :: "v"(wf[(u + 1) & 1][0]), "v"(wf[(u + 1) & 1][1]), "v"(wf[(u + 1) & 1][2]), "v"(wf[(u + 1) & 1][3]) : "memory");
                f32x4 n0, n1;
                n0[0] = (bf_lo(yv[u].x) - mean) * rstd * g0[0] + b0[0]; n0[1] = (bf_hi(yv[u].x) - mean) * rstd * g0[1] + b0[1]; n0[2] = (bf_lo(yv[u].y) - mean) * rstd * g0[2] + b0[2]; n0[3] = (bf_hi(yv[u].y) - mean) * rstd * g0[3] + b0[3];
                n1[0] = (bf_lo(yv[u].z) - mean) * rstd * g1[0] + b1[0]; n1[1] = (bf_hi(yv[u].z) - mean) * rstd * g1[1] + b1[1]; n1[2] = (bf_lo(yv[u].w) - mean) * rstd * g1[2] + b1[2]; n1[3] = (bf_hi(yv[u].w) - mean) * rstd * g1[3] + b1[3];
                u32x4 xw; xw.x = cvt_pk_bf16(n0[0], n0[1]); xw.y = cvt_pk_bf16(n0[2], n0[3]); xw.z = cvt_pk_bf16(n1[0], n1[1]); xw.w = cvt_pk_bf16(n1[2], n1[3]);
                *(u32x4*)(xbrow + 32 * sI) = xw;
                { u32x2 q8; q8.x = pk4_fp8(clamp_fp8(n0[0] * SX), clamp_fp8(n0[1] * SX), clamp_fp8(n0[2] * SX), clamp_fp8(n0[3] * SX)); q8.y = pk4_fp8(clamp_fp8(n1[0] * SX), clamp_fp8(n1[1] * SX), clamp_fp8(n1[2] * SX), clamp_fp8(n1[3] * SX));
                  *(u32x2*)(xqrow + 32 * sI) = q8; }
                const bf16x8 xh = __builtin_bit_cast(bf16x8, xw);
                acc[0] = __builtin_amdgcn_mfma_f32_16x16x32_bf16(wf[u & 1][0], xh, acc[0], 0, 0, 0); acc[1] = __builtin_amdgcn_mfma_f32_16x16x32_bf16(wf[u & 1][1], xh, acc[1], 0, 0, 0);
                acc[0] = __builtin_amdgcn_mfma_f32_16x16x32_bf16(wf[u & 1][2], xh, acc[0], 0, 0, 0); acc[1] = __builtin_amdgcn_mfma_f32_16x16x32_bf16(wf[u & 1][3], xh, acc[1], 0, 0, 0); }
#pragma unroll
            for (int u = 0; u < 4; ++u) yv[u] = yn[u];
        }
        float lg[8];
#pragma unroll
        for (int q = 0; q < 8; ++q) lg[q] = acc[q >> 2][q & 3] + rb[16 * (q >> 2) + 4 * kq + (q & 3)];
        unsigned taken = 0u; float tv[4]; int ti[4];
#pragma unroll
        for (int k = 0; k < 4; ++k) {
            float bv = -3.0e38f; int bi = 64;
#pragma unroll
            for (int q = 0; q < 8; ++q) { const bool free_ = ((taken >> q) & 1u) == 0u; if (free_ && lg[q] > bv) { bv = lg[q]; bi = 16 * (q >> 2) + 4 * kq + (q & 3); } }
            const int mybi = bi;
#pragma unroll
            for (int o = 16; o < 64; o <<= 1) { const float ov = __shfl_xor(bv, o); const int oi = __shfl_xor(bi, o); const bool keep = (bv > ov) || (bv == ov && bi < oi); bv = keep ? bv : ov; bi = keep ? bi : oi; }
            tv[k] = bv; ti[k] = bi;
            if (bi == mybi && ((bi >> 2) & 3) == kq) taken |= 1u << (4 * (bi >> 4) + (bi & 3));
        }
        float gk[4]; float gs = 0.f;
#pragma unroll
        for (int k = 0; k < 4; ++k) { gk[k] = __builtin_amdgcn_exp2f((tv[k] - tv[0]) * LOG2E); gs += gk[k]; }
        const float gi = 1.0f / gs;
        if (lane < 32) wcnt[lane] = 0;
        asm volatile("s_waitcnt lgkmcnt(0)" ::: "memory");
        const int e0 = (kq == 0) ? ti[0] : (kq == 1) ? ti[1] : (kq == 2) ? ti[2] : ti[3];
        const float g0 = ((kq == 0) ? gk[0] : (kq == 1) ? gk[1] : (kq == 2) ? gk[2] : gk[3]) * gi;
        int r0 = 0;
        if (valid) r0 = __hip_atomic_fetch_add(wcnt + e0, 1, __ATOMIC_RELAXED, __HIP_MEMORY_SCOPE_WORKGROUP);
        asm volatile("s_waitcnt lgkmcnt(0)" ::: "memory");
        __syncthreads();
        if (F.wave == 0 && lane < 32) { int c[NWAVES]; int tot = 0;
#pragma unroll
            for (int w = 0; w < NWAVES; ++w) { c[w] = *(LAS int*)(F.lds + WIMG + w * 256 + 4 * lane); tot += c[w]; }
            int b = 0; if (tot > 0) b = (int)__hip_atomic_fetch_add((unsigned*)(F.ctl + cw_ecnt + 64 * lane), (unsigned)tot, RLX_AGENT);
#pragma unroll
            for (int w = 0; w < NWAVES; ++w) { *(LAS int*)(F.lds + WIMG + w * 256 + 128 + 4 * lane) = b; b += c[w]; } }
        asm volatile("s_waitcnt vmcnt(0) lgkmcnt(0)" ::: "memory");
        __syncthreads();
        if (valid) { const int p0 = wbase[e0] + r0;
            petok[(size_t)e0 * NTOK + p0] = (t0 + j) * 4 + kq; pegate[(size_t)e0 * NTOK + p0] = g0; }
        asm volatile("s_waitcnt lgkmcnt(0)" ::: "memory");
        __syncthreads();
    }
}
__device__ __forceinline__ int moe_tables(Frame& F) {
    LAS int* cnt = (LAS int*)(F.lds + MOE_OFF); LAS int* fs = (LAS int*)(F.lds + MOE_OFF + 128); LAS unsigned char* te = F.lds + MOE_OFF + 128 + 136;
    __syncthreads();
    if (F.tid < NEXP) cnt[F.tid] = (int)__hip_atomic_load(F.ctl + CW_ECNT + 64 * F.tid, RLX_AGENT);
    __syncthreads();
    if (F.tid == 0) { int s = 0; for (int e = 0; e < NEXP; ++e) { fs[e] = s; s += (cnt[e] + 255) >> 8; } fs[NEXP] = s; }
    __syncthreads();
    const int T = fs[NEXP];
    for (int t = F.tid; t < T; t += NWAVES * 64) { int e = 0;
#pragma unroll 8
        for (int q = 1; q < NEXP; ++q) e += (fs[q] <= t) ? 1 : 0;
        te[t] = (unsigned char)e; }
    __syncthreads();
    return T;
}
__device__ __forceinline__ void p9_final(Frame& F, const float* gam, const float* bet, const float* out, float* outw, bool poison) {
    const bf16_t* X1B = (const bf16_t*)(F.ws + WS_X1B);
    const int gw = F.vcu * NWAVES + F.wave, NGW = F.G * NWAVES, lane = F.lane;
    const float qnan = __builtin_nanf("");
    const f32x4 g0 = *(const f32x4*)(gam + lane * 16), g1 = *(const f32x4*)(gam + lane * 16 + 4), g2 = *(const f32x4*)(gam + lane * 16 + 8), g3 = *(const f32x4*)(gam + lane * 16 + 12);
    const f32x4 b0 = *(const f32x4*)(bet + lane * 16), b1 = *(const f32x4*)(bet + lane * 16 + 4), b2 = *(const f32x4*)(bet + lane * 16 + 8), b3 = *(const f32x4*)(bet + lane * 16 + 12);
    for (int tok0 = gw; tok0 < NTOK; tok0 += 2 * NGW) {
        u32x4 xa[2], xb[2], y0[2], y1[2], y2[2], y3[2];
#pragma unroll
        for (int tI = 0; tI < 2; ++tI) { const int tok = min(tok0 + tI * NGW, NTOK - 1);
            const unsigned char* y = (const unsigned char*)out + (size_t)tok * 4096 + lane * 16;
            xa[tI] = *(const u32x4*)(X1B + (size_t)tok * D + lane * 16); xb[tI] = *(const u32x4*)(X1B + (size_t)tok * D + lane * 16 + 8);
            y0[tI] = *(const u32x4*)(y); y1[tI] = *(const u32x4*)(y + 1024); y2[tI] = *(const u32x4*)(y + 2048); y3[tI] = *(const u32x4*)(y + 3072); }
#pragma unroll
        for (int tI = 0; tI < 2; ++tI) { const int tok = tok0 + tI * NGW; if (tok >= NTOK) break;
            float v[16];
#pragma unroll
            for (int w = 0; w < 4; ++w) { const unsigned xw = (w < 2) ? xa[tI][2 * w] : xb[tI][2 * (w - 2)], xw2 = (w < 2) ? xa[tI][2 * w + 1] : xb[tI][2 * (w - 2) + 1];
                v[4 * w + 0] = DN_ALPHA * bf_lo(xw); v[4 * w + 1] = DN_ALPHA * bf_hi(xw); v[4 * w + 2] = DN_ALPHA * bf_lo(xw2); v[4 * w + 3] = DN_ALPHA * bf_hi(xw2);
                f32x2 lo = __builtin_amdgcn_cvt_pk_f32_fp8((int)y0[tI][w], false) + __builtin_amdgcn_cvt_pk_f32_fp8((int)y1[tI][w], false) + __builtin_amdgcn_cvt_pk_f32_fp8((int)y2[tI][w], false) + __builtin_amdgcn_cvt_pk_f32_fp8((int)y3[tI][w], false);
                f32x2 hi = __builtin_amdgcn_cvt_pk_f32_fp8((int)y0[tI][w], true) + __builtin_amdgcn_cvt_pk_f32_fp8((int)y1[tI][w], true) + __builtin_amdgcn_cvt_pk_f32_fp8((int)y2[tI][w], true) + __builtin_amdgcn_cvt_pk_f32_fp8((int)y3[tI][w], true);
                v[4 * w + 0] += lo[0] * (1.0f / SY); v[4 * w + 1] += lo[1] * (1.0f / SY); v[4 * w + 2] += hi[0] * (1.0f / SY); v[4 * w + 3] += hi[1] * (1.0f / SY); }
            float s = 0.f;
#pragma unroll
            for (int q = 0; q < 16; ++q) s += v[q];
            const float mean = wave_sum(s) * (1.0f / D); float s2 = 0.f;
#pragma unroll
            for (int q = 0; q < 16; ++q) { v[q] -= mean; s2 += v[q] * v[q]; }
            const float rstd = 1.0f / sqrtf(wave_sum(s2) * (1.0f / D) + LN_EPS);
            f32x4 o0, o1, o2, o3;
#pragma unroll
            for (int q = 0; q < 4; ++q) { o0[q] = v[q] * rstd * g0[q] + b0[q]; o1[q] = v[4 + q] * rstd * g1[q] + b1[q]; o2[q] = v[8 + q] * rstd * g2[q] + b2[q]; o3[q] = v[12 + q] * rstd * g3[q] + b3[q]; }
            if (poison) { o0 = (f32x4){qnan, qnan, qnan, qnan}; o1 = o0; o2 = o0; o3 = o0; }
            float* op = outw + (size_t)tok * D + lane * 16;
            *(f32x4*)(op) = o0; *(f32x4*)(op + 4) = o1; *(f32x4*)(op + 8) = o2; *(f32x4*)(op + 12) = o3; }
    }
}
#define CAS __attribute__((address_space(4)))
__device__ __forceinline__ const float* arg_in(int i) {
    const unsigned char CAS* ka = (const unsigned char CAS*)__builtin_amdgcn_kernarg_segment_ptr();
    asm volatile("" : "+s"(ka));
    return *(const float* const CAS*)(ka + 8 * i);
}
struct Args { const float* in[18]; float* out; unsigned char* ws; int ph_lo, ph_hi; };
__global__ void __launch_bounds__(NWAVES * 64, 2) fwd_kernel(Args args) {
    extern __shared__ __attribute__((aligned(16))) unsigned char lds[];
    Frame F;
    F.lds = (LAS unsigned char*)lds;
    F.MISC = (volatile LAS unsigned*)(F.lds + MISC_OFF);
    F.tid = threadIdx.x; F.lane = F.tid & 63; F.wave = __builtin_amdgcn_readfirstlane(F.tid >> 6);
    F.G = gridDim.x; { const int bx = blockIdx.x; F.vcu = (F.G % 8 == 0) ? (bx % 8) * (F.G / 8) + bx / 8 : bx; }
    F.ws = args.ws; F.dout = (unsigned char*)args.out;
    F.ctl = (gu32*)(args.ws + WS_CTL);
    for (int u = F.tid; u < (LDS_BYTES - LDSCTL_OFF) / 4; u += NWAVES * 64) ((LAS unsigned*)(F.lds + LDSCTL_OFF))[u] = 0u;
    __syncthreads();
    XcdBarrier bar; bar.bar = (unsigned*)(F.ctl + CW_BAR); bar.x = 0; bar.st = nullptr;
    if (N_LAUNCHES == 1) bar = xcd_barrier_post((unsigned*)(F.ctl + CW_BAR), F.MISC + 8);
    const int lo = args.ph_lo, hi = args.ph_hi;
#ifdef ONLY_PHASE
#define IN(k) ((k) == ONLY_PHASE && lo <= (k) && (k) < hi)
#else
#define IN(k) (lo <= (k) && (k) < hi)
#endif
#define SEAM(k) do { if (IN(k) && IN((k) + 1)) xcd_barrier(bar); } while (0)
    unsigned char* HQ = F.ws + WS_HQ; unsigned char* SG = F.ws + WS_SG;

#define PHASE(k, ...) do { if (IN(k)) { __VA_ARGS__ if (DUP_PHASE == (k)) { __VA_ARGS__ } } } while (0)
    PHASE(0, p0_convert(F, arg_in(0), arg_in(1), arg_in(3), arg_in(4), arg_in(5), arg_in(8));); SEAM(0);
    PHASE(1,
        { const int gemm_wgs = (F.G == 256) ? 192 : F.G;
          if ((int)blockIdx.x < gemm_wgs) {
            pg8::Gemm g{(const char*)(F.dout + DO_XB), (const char*)(F.dout + DO_WIN), D, D, D / 128}; pg8::StaticOrder S; S.init(NTOK, IN_COLS, gemm_wgs, (int)blockIdx.x);
            pg8::EpiInProj E{HQ, SG, 1.0f / (SXIN * SW)};
            pg8::gemm_phase<pg8::EpiInProj, pg8::StaticOrder, true, false, true>(F.lds, g, S, E); }
          if (gemm_wgs == F.G) p3_convert_moe(F, arg_in(10), arg_in(12), arg_in(14), F.vcu, F.G);
          else if ((int)blockIdx.x >= gemm_wgs) p3_convert_moe(F, arg_in(10), arg_in(12), arg_in(14), (int)blockIdx.x - gemm_wgs, F.G - gemm_wgs); }
    ); SEAM(1);
    PHASE(2, p2_attention(F, arg_in(2));); SEAM(2);
    PHASE(3, p3_merge(F);); SEAM(3);
    PHASE(4,
        { pg8::Gemm g{(const char*)(F.dout + DO_OAB), (const char*)(F.dout + DO_WCAT), OAB_P, OAB_P, OAB_P / 128}; pg8::StaticOrder S; S.init(NTOK, D, F.G, (int)blockIdx.x);
        pg8::EpiGate E{SG, F.ws + WS_MRG};
        pg8::gemm_phase<pg8::EpiGate, pg8::StaticOrder, true, false, true>(F.lds, g, S, E); }
    ); SEAM(4);
    PHASE(5,
        { pg8::Gemm g{(const char*)(F.ws + WS_MRG), (const char*)(F.ws + WS_WOUT), D, D, D / 128}; pg8::StaticOrder S; S.init(NTOK, D, F.G, (int)blockIdx.x);
        pg8::EpiY E{arg_in(0), (bf16_t*)(F.ws + WS_Y), (float*)(F.ws + WS_STAT), 1.0f / (SM * SW)};
        pg8::gemm_phase<pg8::EpiY, pg8::StaticOrder, true, false, true>(F.lds, g, S, E); }
    ); SEAM(5);
    if (IN(6)) { if (DUP_PHASE == 6) p6_router(F, (const bf16_t*)(F.ws + WS_Y), (const float*)(F.ws + WS_STAT), arg_in(6), arg_in(7), (bf16_t*)(F.ws + 264 * MiB), F.ws + 330 * MiB, arg_in(9), CW_ECNT + 64 * NEXP, (size_t)362 * MiB - WS_PETOK);
        p6_router(F, (const bf16_t*)(F.ws + WS_Y), (const float*)(F.ws + WS_STAT), arg_in(6), arg_in(7), (bf16_t*)(F.ws + WS_X1B), F.ws + WS_X1Q, arg_in(9), CW_ECNT, 0); } SEAM(6);
    PHASE(7,
        { const int T = moe_tables(F);
        pg8::Gemm g{(const char*)(F.ws + WS_X1Q), (const char*)(F.ws + WS_WGU), D, D, D / 128};
        pg8::MoeOrder S{T, 8, F.G, (int)blockIdx.x, (const LAS int*)(F.lds + MOE_OFF), (const LAS int*)(F.lds + MOE_OFF + 128), (const LAS unsigned char*)(F.lds + MOE_OFF + 128 + 136),
                        (const int*)(F.ws + WS_PETOK), (size_t)2048 * D, true, (unsigned)D};
        pg8::EpiGU E{arg_in(11), arg_in(13), F.ws + WS_HDN};
        pg8::gemm_phase<pg8::EpiGU, pg8::MoeOrder, true, true, true>(F.lds, g, S, E); }
    ); SEAM(7);
    PHASE(8,
        { const int T = moe_tables(F);
        pg8::Gemm g{(const char*)(F.ws + WS_HDN), (const char*)(F.ws + WS_WD), DFF, DFF, DFF / 128};
        pg8::MoeOrder S{T, 4, F.G, (int)blockIdx.x, (const LAS int*)(F.lds + MOE_OFF), (const LAS int*)(F.lds + MOE_OFF + 128), (const LAS unsigned char*)(F.lds + MOE_OFF + 128 + 136),
                        (const int*)(F.ws + WS_PETOK), (size_t)D * DFF, false, 0u};
        pg8::EpiDown E{arg_in(15), (const int*)(F.ws + WS_PETOK), (const float*)(F.ws + WS_PEGATE), F.dout};
        pg8::gemm_phase<pg8::EpiDown, pg8::MoeOrder, true, false, true>(F.lds, g, S, E); }
    ); SEAM(8);
    if (IN(9)) {
        bool poison = (__hip_atomic_load(F.ctl + CW_TMO, RLX_AGENT) != 0u) || (__hip_atomic_load(F.ctl + CW_BAR + XB_TMO, RLX_AGENT) != 0u);
        if (DUP_PHASE == 9) p9_final(F, arg_in(16), arg_in(17), (const float*)F.dout, (float*)(F.ws + 194 * MiB), poison);
        p9_final(F, arg_in(16), arg_in(17), (const float*)F.dout, (float*)F.dout, poison);
    }
#undef PHASE
#undef IN
#undef SEAM
}

extern "C" void kernel_launch(void* const* d_in, const int* in_sizes, int n_in, void* d_out, int out_size, void* d_ws, size_t ws_size, hipStream_t stream) {
    static int grid = 0;
    if (grid == 0) {
        if (n_in != 18 || in_sizes[0] != NTOK * D || out_size != NTOK * D || ws_size < WS_END) { fprintf(stderr, "kernel_launch: unexpected shapes (n_in %d, ws %zu); nothing launched\n", n_in, ws_size); grid = -1; return; }
        int dev = 0, cus = 0, per_cu = 0;
        if (hipGetDevice(&dev) != hipSuccess || hipDeviceGetAttribute(&cus, hipDeviceAttributeMultiprocessorCount, dev) != hipSuccess) { grid = -1; return; }
        if (hipFuncSetAttribute((const void*)fwd_kernel, hipFuncAttributeMaxDynamicSharedMemorySize, LDS_BYTES) != hipSuccess) { fprintf(stderr, "kernel_launch: hipFuncSetAttribute failed\n"); grid = -1; return; }
        if (hipOccupancyMaxActiveBlocksPerMultiprocessor(&per_cu, (const void*)fwd_kernel, NWAVES * 64, LDS_BYTES) != hipSuccess || per_cu < 1) fprintf(stderr, "kernel_launch: occupancy query reports %d\n", per_cu);
        (void)hipGetLastError();
        grid = cus;
    }
    if (grid < 0) return;
    if (hipMemsetAsync((char*)d_ws + WS_CTL, 0, CTL_ZERO_BYTES, stream) != hipSuccess) return;
    Args a{};
    for (int i = 0; i < 18; ++i) a.in[i] = (const float*)d_in[i];
    a.out = (float*)d_out; a.ws = (unsigned char*)d_ws;
    if (N_LAUNCHES == 1) { a.ph_lo = 0; a.ph_hi = N_PHASES; hipLaunchKernelGGL(fwd_kernel, dim3(grid), dim3(NWAVES * 64), LDS_BYTES, stream, a); }
    else for (int p = 0; p < N_PHASES; ++p) { a.ph_lo = p; a.ph_hi = p + 1; hipLaunchKernelGGL(fwd_kernel, dim3(grid), dim3(NWAVES * 64), LDS_BYTES, stream, a); }
}
```

```cpp
#include <hip/hip_runtime.h>
#include <cstdio>
#include <cstdint>

#define GAS __attribute__((address_space(1)))
#define LAS __attribute__((address_space(3)))
typedef unsigned short bf16_t;
typedef short bf16x8 __attribute__((ext_vector_type(8)));
typedef short s16x4 __attribute__((ext_vector_type(4)));
typedef float f32x2 __attribute__((ext_vector_type(2)));
typedef float f32x4 __attribute__((ext_vector_type(4)));
typedef float f32x16 __attribute__((ext_vector_type(16)));
typedef unsigned u32x2 __attribute__((ext_vector_type(2)));
typedef unsigned u32x4 __attribute__((ext_vector_type(4)));
typedef GAS unsigned gu32;

#ifndef MK_N_LAUNCHES
#define MK_N_LAUNCHES 1
#endif
#ifndef DUP_PHASE
#define DUP_PHASE -1
#endif
constexpr int N_PHASES = 10;
constexpr int N_LAUNCHES = MK_N_LAUNCHES;

constexpr int NB = 8, SEQ = 4096, D = 1024, NTOK = NB * SEQ;
constexpr int HQ_P = 3584;
constexpr int SG_P = 2048;
constexpr int OAB_P = 1280;
constexpr int IN_COLS = 5632;
constexpr int NEXP = 32, TOPK = 4, DFF = 1024;
constexpr int MAX_MT = 544;
constexpr float LN_EPS = 1e-5f;
constexpr float DN_ALPHA = 1.189207115002721f;
constexpr float LOG2E = 1.4426950408889634f, LN2 = 0.6931471805599453f;
constexpr float QSCALE = 0.125f * LOG2E;
constexpr float NEG_BIG = -1e30f;

constexpr size_t MiB = 1u << 20;
constexpr size_t WS_CTL = 0, CTL_ZERO_BYTES = 1 * MiB;
constexpr size_t WS_XBUF = 1 * MiB;
constexpr size_t WS_Y = 194 * MiB;
constexpr size_t WS_STAT = 258 * MiB;
constexpr size_t WS_HQ = 2 * MiB;
constexpr size_t HQ_QD = 0, HQ_KD = 48 * MiB, HQ_VD = 96 * MiB, HQ_QS = 144 * MiB, HQ_KS = 208 * MiB, HQ_VS = 216 * MiB;
constexpr size_t WS_WGU = 404 * MiB;
constexpr size_t WS_WD = 468 * MiB;
constexpr size_t WS_X1B = 98 * MiB;
constexpr size_t WS_X1Q = 162 * MiB;
constexpr size_t WS_HDN = 194 * MiB;
constexpr size_t WS_SG = 226 * MiB;
constexpr size_t WS_YS23 = 330 * MiB;
constexpr size_t WS_OAG = 354 * MiB;
constexpr size_t WS_LSE = 402 * MiB;
constexpr size_t WS_MRG = 2 * MiB;
constexpr size_t WS_WOUT = 530 * MiB;
constexpr size_t WS_PETOK = 532 * MiB;
constexpr size_t WS_PEGATE = 536 * MiB;
constexpr size_t WS_WRT = 540 * MiB;
constexpr size_t WS_END = 540 * MiB + 256 * 1024;
constexpr float SX = 8.0f, SW = 512.0f, SH = 4.0f, SXIN = 8.0f, SY = 64.0f, SM = 64.0f, SO = 64.0f, SSG = 256.0f, SQ = 64.0f, SK = 16.0f;
static_assert(WS_HQ + (size_t)NTOK * HQ_P * 2 <= WS_SG && WS_SG + (size_t)NTOK * SG_P <= WS_OAG && WS_OAG + (size_t)3 * NTOK * 256 * 2 <= WS_LSE && WS_LSE + (size_t)3 * NTOK * 4 * 4 <= WS_WGU, "ws map 1");
static_assert(WS_WGU + (size_t)NEXP * 2048 * D <= WS_WD && WS_WD + (size_t)NEXP * D * DFF <= WS_WOUT && WS_MRG + (size_t)NTOK * D <= WS_X1B && WS_X1B + (size_t)NTOK * D * 2 <= WS_X1Q && WS_X1Q + (size_t)NTOK * D <= WS_HDN, "ws map 2");
static_assert(WS_HDN + (size_t)MAX_MT * 256 * DFF <= WS_OAG && WS_WOUT + (size_t)D * D <= WS_PETOK, "ws map 3");
constexpr size_t DO_XB = 0;
constexpr size_t DO_OAB = 0;
constexpr size_t DO_WIN = 96 * MiB;
constexpr size_t DO_WCAT = 108 * MiB;
constexpr int CW_TMO = 0, CW_CODE = 1;
constexpr int CW_BAR = 4096;
constexpr int CW_SEAM = 16384;
constexpr int CW_ECNT = 32768;
static_assert((CW_ECNT + 2 * 64 * NEXP) * 4 <= (int)CTL_ZERO_BYTES, "CTL words inside the memset region");

constexpr int RING_BYTES = 131072;
constexpr int SCR_BYTES = 143360;
constexpr int LDSCTL_OFF = SCR_BYTES;
constexpr int MISC_OFF = LDSCTL_OFF + 320;
constexpr int MOE_OFF = LDSCTL_OFF + 512;
constexpr int LDS_BYTES = 147456;
static_assert(MOE_OFF + 128 + 136 + MAX_MT <= LDS_BYTES, "LDS map");

#define RLX_AGENT __ATOMIC_RELAXED, __HIP_MEMORY_SCOPE_AGENT
#define LDS_WAIT() asm volatile("s_waitcnt lgkmcnt(0)" ::: "memory")
#define VM_WAIT() asm volatile("s_waitcnt vmcnt(0)" ::: "memory")

__device__ __forceinline__ unsigned cvt_pk_bf16(float lo, float hi) { unsigned r; asm volatile("v_cvt_pk_bf16_f32 %0, %1, %2" : "=v"(r) : "v"(lo), "v"(hi)); return r; }
__device__ __forceinline__ int opaque(int v) { asm volatile("" : "+v"(v)); return v; }
__device__ __forceinline__ unsigned pk4_fp8(float a, float b, float c, float d) { int w = 0; w = __builtin_amdgcn_cvt_pk_fp8_f32(a, b, w, false); w = __builtin_amdgcn_cvt_pk_fp8_f32(c, d, w, true); return (unsigned)w; }
__device__ __forceinline__ unsigned f2e4m3_sw(float x) { const unsigned u = __float_as_uint(x); const unsigned sg = (u >> 24) & 0x80u; const float a = fminf(fabsf(x), 448.f); unsigned r;
  if (a < 0.015625f) r = (unsigned)__builtin_rintf(a * 512.f); else { unsigned v = __float_as_uint(a); v += 0x7FFFFu + ((v >> 20) & 1u); r = (v >> 20) - (120u << 3); } return sg | r; }
__device__ __forceinline__ float clamp_fp8(float v) { return __builtin_amdgcn_fmed3f(v, -448.0f, 448.0f); }
__device__ __forceinline__ float bf_lo(unsigned w) { return __uint_as_float(w << 16); }
__device__ __forceinline__ float bf_hi(unsigned w) { return __uint_as_float(w & 0xffff0000u); }
__device__ __forceinline__ float fast_sigmoid(float g) { g = fminf(fmaxf(g, -60.f), 60.f); return __builtin_amdgcn_rcpf(1.0f + __builtin_amdgcn_exp2f(-g * LOG2E)); }

namespace pg8 {
constexpr int BM = 256, BK = 64, HALF = 128, HTB = HALF * BK * 2, STAGE_BYTES = 8 * HTB, NXCD = 8, WGM = 8;
__host__ __device__ __forceinline__ int lds_byte(int r, int c) { const int st = (r >> 4) * 2 + (c >> 5), rr = r & 15, cc = c & 31, ob = rr * 64 + cc * 2; return st * 1024 + (ob ^ (((ob >> 9) & 1) << 5)); }
__host__ __device__ __forceinline__ void stage_rc(int b, int& R, int& C) { const int st = b / 1024, sb = b % 1024, swz = sb ^ (((sb >> 9) & 1) << 5); R = (st >> 1) * 16 + swz / 64; C = (st & 1) * 32 + (swz % 64) / 2; }
__host__ __device__ __forceinline__ int perm32(int rho) { const int n = rho >> 4, i = rho & 15; return 8 * (i >> 2) + 4 * n + (i & 3); }

struct Unit { int pm, pn, e, ti, valid; };
struct Gemm { const char* A; const char* Bt; int lda, ldb, nt; };

__device__ __forceinline__ bool tile_of(long L, int nM, int nN, int& pm, int& pn) {
    const int nwg = nM * nN; if (L >= nwg) return false;
    int wgid = (int)L; { const int q = nwg / NXCD, r = nwg % NXCD, xcd = wgid % NXCD, off = wgid / NXCD; wgid = (xcd < r ? xcd * (q + 1) : r * (q + 1) + (xcd - r) * q) + off; }
    const int nig = WGM * nN, gid = wgid / nig, fm = gid * WGM, gsz = (nM - fm) < WGM ? (nM - fm) : WGM;
    pm = fm + ((wgid % nig) % gsz); pn = (wgid % nig) / gsz; return true;
}
struct StaticOrder {
    int nM, nN, G, c;
    __device__ __forceinline__ void init(int M, int N, int G_, int c_) { nM = M / BM; nN = N / BM; G = G_; c = c_; }
    __device__ __forceinline__ bool next(int i, Unit& u) const { u.e = 0; u.ti = 0; u.valid = 256; return tile_of((long)i * G + c, nM, nN, u.pm, u.pn); }
    __device__ __forceinline__ const char* a_ptr(const Gemm& g, const Unit& u) const { return g.A + (size_t)u.pm * 256 * g.lda; }
    __device__ __forceinline__ const char* b_ptr(const Gemm& g, const Unit& u) const { return g.Bt + (size_t)u.pn * 256 * g.ldb; }
    __device__ __forceinline__ unsigned row_off(const Unit&, int) const { return 0u; }
};
struct MoeOrder {
    int T, nN, G, c; const LAS int* cnt; const LAS int* fs; const LAS unsigned char* te;
    const int* petok; size_t b_exp_stride; bool gather; unsigned rowbytes;
    __device__ __forceinline__ bool next(int i, Unit& u) const {
        if (!tile_of((long)i * G + c, T, nN, u.pm, u.pn)) return false;
        u.e = __builtin_amdgcn_readfirstlane((int)te[u.pm]); u.ti = u.pm - __builtin_amdgcn_readfirstlane(fs[u.e]); const int left = __builtin_amdgcn_readfirstlane(cnt[u.e]) - u.ti * 256; u.valid = left < 256 ? left : 256; return true;
    }
    __device__ __forceinline__ const char* a_ptr(const Gemm& g, const Unit& u) const { return gather ? g.A : g.A + (size_t)u.pm * 256 * g.lda; }
    __device__ __forceinline__ const char* b_ptr(const Gemm& g, const Unit& u) const { return g.Bt + (size_t)u.e * b_exp_stride + (size_t)u.pn * 256 * g.ldb; }
    __device__ __forceinline__ unsigned row_off(const Unit& u, int R) const {
        int tok = 0; if (R < u.valid) tok = petok[(size_t)u.e * NTOK + u.ti * 256 + R] >> 2;
        return (unsigned)tok * rowbytes;
    }
};

typedef int v8i32 __attribute__((ext_vector_type(8)));
template <class Epi, class Sched, bool ALIGN_EPI, bool GATHER, bool F8 = false>
__device__ __forceinline__ void gemm_phase(LAS unsigned char* lds, const Gemm g, const Sched& S, const Epi& E) {
    const int tid = threadIdx.x, wid = __builtin_amdgcn_readfirstlane(tid >> 6), lane = tid & 63, wr = wid >> 2, wc = wid & 3, fr = lane & 15, fq = lane >> 4;
    const int nt = g.nt;
    unsigned voffA[2], voffB[2]; int RA[2], CA2[2];
#pragma unroll
    for (int i = 0; i < 2; ++i) { int R, C; stage_rc(tid * 16 + i * 8192, R, C); const int Rb = Epi::PERM ? ((R & ~31) + perm32(R & 31)) : R;
        voffA[i] = (unsigned)(R * g.lda + C * 2); voffB[i] = (unsigned)(Rb * g.ldb + C * 2); RA[i] = R; CA2[i] = C * 2; }
    const size_t kstep = (size_t)(BK * 2);
    const size_t hstepA = (size_t)HALF * g.lda, hstepB = (size_t)HALF * g.ldb;
    const unsigned ldsw = (unsigned)wid * 1024u;
    const int aoff = lds_byte(wr * 64 + fr, fq * 8), boff = lds_byte(wc * 32 + fr, fq * 8);
    const int aoff0 = aoff, boff0 = boff, aoff1 = aoff + 1024, boff1 = boff + 1024;
#define PG8_SA(b, h) (((b) * 2 + (h)) * HTB)
#define PG8_SB(b, h) ((4 + (b) * 2 + (h)) * HTB)
#define PG8_STAGE(bufoff, gbase, voff) do { _Pragma("unroll") for (int _i = 0; _i < 2; ++_i) \
        __builtin_amdgcn_global_load_lds((const unsigned*)((const char*)(gbase) + (voff)[_i]), (LAS unsigned*)(lds + (bufoff) + ldsw + _i * 8192), 16, 0, 0); } while (0)
#define PG8_STAGE_A(bufoff, kp, h, nx) do { if constexpr (GATHER) { unsigned _v[2]; _v[0] = (nx) ? gN[h][0] : gC[h][0]; _v[1] = (nx) ? gN[h][1] : gC[h][1]; PG8_STAGE(bufoff, kp, _v); } \
        else { PG8_STAGE(bufoff, (kp) + (h) * hstepA, voffA); } } while (0)
#define PG8_LDA(dst, b, h) do { _Pragma("unroll") for (int m = 0; m < 4; ++m) _Pragma("unroll") for (int k = 0; k < 2; ++k) dst[m][k] = *(const LAS bf16x8*)(lds + PG8_SA(b, h) + (k ? aoff1 : aoff0) + m * 2048); } while (0)
#define PG8_LDB(dst, b, h) do { _Pragma("unroll") for (int n = 0; n < 2; ++n) _Pragma("unroll") for (int k = 0; k < 2; ++k) dst[n][k] = *(const LAS bf16x8*)(lds + PG8_SB(b, h) + (k ? boff1 : boff0) + n * 2048); } while (0)
#define PG8_F8OP(X) __builtin_bit_cast(v8i32, __builtin_shufflevector(X[0], X[1], 0, 1, 2, 3, 4, 5, 6, 7, 8, 9, 10, 11, 12, 13, 14, 15))
#define PG8_MMA(ai, bj, At, Bt) do { __builtin_amdgcn_s_setprio(1); if constexpr (F8) { _Pragma("unroll") for (int m = 0; m < 4; ++m) _Pragma("unroll") for (int n = 0; n < 2; ++n) \
        asm volatile("v_mfma_scale_f32_16x16x128_f8f6f4 %0, %1, %2, %0, %3, %3 op_sel_hi:[0,0,0]" : "+v"(acc[ai][bj][m][n]) : "v"(PG8_F8OP(Bt[n])), "v"(PG8_F8OP(At[m])), "v"(one_scale)); } \
        else { _Pragma("unroll") for (int m = 0; m < 4; ++m) _Pragma("unroll") for (int n = 0; n < 2; ++n) _Pragma("unroll") for (int k = 0; k < 2; ++k) \
        acc[ai][bj][m][n] = __builtin_amdgcn_mfma_f32_16x16x32_bf16(Bt[n][k], At[m][k], acc[ai][bj][m][n], 0, 0, 0); } __builtin_amdgcn_s_setprio(0); } while (0)
#define PG8_WAIT_V(n) asm volatile("s_waitcnt vmcnt(" #n ")" ::: "memory")
#define PG8_WAIT_L(n) asm volatile("s_waitcnt lgkmcnt(" #n ")" ::: "memory")
#define PG8_BAR __builtin_amdgcn_s_barrier()
#define PG8_SCHED __builtin_amdgcn_sched_barrier(0)
    Unit cur, nxt; int ui = 0;
    if (!S.next(0, cur)) return;
    int one_scale = 0x7f7f7f7f; if constexpr (F8) asm volatile("" : "+v"(one_scale));
    unsigned gC[2][2], gN[2][2];
#pragma unroll
    for (int h = 0; h < 2; ++h)
#pragma unroll
        for (int i = 0; i < 2; ++i) { gC[h][i] = GATHER ? S.row_off(cur, h * HALF + RA[i]) + (unsigned)CA2[i] : 0u; gN[h][i] = gC[h][i]; }
    f32x4 acc[2][2][4][2];
#pragma unroll
    for (int a = 0; a < 2; ++a)
#pragma unroll
        for (int b = 0; b < 2; ++b)
#pragma unroll
            for (int m = 0; m < 4; ++m)
#pragma unroll
                for (int n = 0; n < 2; ++n) acc[a][b][m][n] = (f32x4){0.f, 0.f, 0.f, 0.f};
    bf16x8 At[4][2], B0[2][2], B1[2][2];
    const char* cA = S.a_ptr(g, cur); const char* cB = S.b_ptr(g, cur);
    PG8_STAGE(PG8_SB(0, 0), cB, voffB); PG8_STAGE(PG8_SB(0, 1), cB + hstepB, voffB); PG8_STAGE_A(PG8_SA(0, 0), cA, 0, false); PG8_STAGE_A(PG8_SA(0, 1), cA, 1, false);
    if (wr == 1) PG8_BAR;
    PG8_WAIT_V(2); PG8_BAR;
    PG8_STAGE(PG8_SB(1, 0), cB + kstep, voffB); PG8_STAGE_A(PG8_SA(1, 0), cA + kstep, 0, false); PG8_STAGE(PG8_SB(1, 1), cB + hstepB + kstep, voffB);
    PG8_WAIT_V(6); PG8_BAR;
    for (;;) {
        const bool has_next = S.next(ui + 1, nxt);
        const char* nA = has_next ? S.a_ptr(g, nxt) : cA; const char* nB = has_next ? S.b_ptr(g, nxt) : cB;
        if constexpr (GATHER) { if (has_next) {
#pragma unroll
            for (int h = 0; h < 2; ++h)
#pragma unroll
                for (int i = 0; i < 2; ++i) gN[h][i] = S.row_off(nxt, h * HALF + RA[i]) + (unsigned)CA2[i]; } }
#pragma unroll 1
        for (int t = 0; t < nt; t += 2) {
            const bool last = (t == nt - 2);
            asm volatile("" : "+v"(voffA[0]), "+v"(voffA[1]), "+v"(voffB[0]), "+v"(voffB[1]));
            if constexpr (Epi::HAS_MID) { if (t == Epi::MID_T) E.mid(acc, cur, wr, wc, fr, fq); }
            const char* a1 = cA + (size_t)(t + 1) * kstep;
            const char* a2 = last ? nA : cA + (size_t)(t + 2) * kstep; const char* b2 = last ? nB : cB + (size_t)(t + 2) * kstep;
            const char* a3 = a2 + kstep; const char* b3 = b2 + kstep;
            PG8_LDB(B0, 0, 0); PG8_LDB(B1, 0, 1); PG8_SCHED; PG8_LDA(At, 0, 0); PG8_STAGE_A(PG8_SA(1, 1), a1, 1, false);
            PG8_WAIT_V(8); PG8_WAIT_L(0); PG8_BAR; PG8_MMA(0, 0, At, B0); PG8_MMA(0, 1, At, B1); PG8_BAR; PG8_SCHED;
            PG8_LDA(At, 0, 1); PG8_STAGE(PG8_SB(0, 0), b2, voffB); PG8_STAGE(PG8_SB(0, 1), b2 + hstepB, voffB); PG8_STAGE_A(PG8_SA(0, 0), a2, 0, last);
            PG8_WAIT_V(8); PG8_WAIT_L(0); PG8_BAR; PG8_MMA(1, 0, At, B0); PG8_MMA(1, 1, At, B1); PG8_BAR; PG8_SCHED;
            PG8_LDB(B0, 1, 0); PG8_LDB(B1, 1, 1); PG8_SCHED; PG8_LDA(At, 1, 0); PG8_STAGE_A(PG8_SA(0, 1), a2, 1, last);
            PG8_WAIT_V(8); PG8_WAIT_L(0); PG8_BAR; PG8_MMA(0, 0, At, B0); PG8_MMA(0, 1, At, B1); PG8_BAR; PG8_SCHED;
            PG8_LDA(At, 1, 1); PG8_STAGE(PG8_SB(1, 0), b3, voffB); PG8_STAGE(PG8_SB(1, 1), b3 + hstepB, voffB); PG8_STAGE_A(PG8_SA(1, 0), a3, 0, last);
            PG8_WAIT_V(8); PG8_WAIT_L(0); PG8_BAR; PG8_MMA(1, 0, At, B0); PG8_MMA(1, 1, At, B1); PG8_BAR; PG8_SCHED;
        }
        if constexpr (ALIGN_EPI) { if (wr == 0) PG8_BAR; }
        if constexpr (F8) asm volatile("s_nop 15\n\ts_nop 15" ::: "memory");
        if constexpr (!Epi::AFTER_DRAIN) { E(acc, cur, wr, wc, fr, fq); }
        if (!has_next) break;
#pragma unroll
        for (int a = 0; a < 2; ++a)
#pragma unroll
            for (int b = 0; b < 2; ++b)
#pragma unroll
                for (int m = 0; m < 4; ++m)
#pragma unroll
                    for (int n = 0; n < 2; ++n) acc[a][b][m][n] = (f32x4){0.f, 0.f, 0.f, 0.f};
        cur = nxt; cA = nA; cB = nB; ++ui;
#pragma unroll
        for (int h = 0; h < 2; ++h)
#pragma unroll
            for (int i = 0; i < 2; ++i) gC[h][i] = gN[h][i];
        if constexpr (ALIGN_EPI) { if (wr == 1) PG8_BAR; }
    }
    PG8_WAIT_V(0);
    if constexpr (!ALIGN_EPI) { if (wr == 0) PG8_BAR; }
    PG8_BAR;
    if constexpr (Epi::AFTER_DRAIN) { E.fused(acc, cur, wr, wc, fr, fq, lds, wid, lane); }
#undef PG8_SA
#undef PG8_SB
#undef PG8_STAGE
#undef PG8_STAGE_A
#undef PG8_LDA
#undef PG8_LDB
#undef PG8_MMA
#undef PG8_F8OP
#undef PG8_WAIT_V
#undef PG8_WAIT_L
#undef PG8_BAR
#undef PG8_SCHED
}
}

namespace pg8 {
struct EpiInProj {
    static constexpr bool PERM = true, AFTER_DRAIN = false, HAS_MID = false; static constexpr int MID_T = 0;
    unsigned char* HQ; unsigned char* SG; float rs;
    __device__ __forceinline__ void mid(f32x4 (&)[2][2][4][2], const Unit&, int, int, int, int) const {}
    __device__ __forceinline__ void operator()(const f32x4 (&acc)[2][2][4][2], const Unit& u, int wr, int wc, int fr, int fq) const {
        const int row0 = u.pm * BM + wr * 64 + opaque(fr), pn = u.pn;
        const bool gate = pn >= 14; const bool qs = (pn < 3) || (pn >= 9 && pn < 13);
        const float sc = (qs ? QSCALE : 1.0f) * rs; const int dcol = (wc & 1) * 32 + 8 * fq;
#pragma unroll
        for (int ai = 0; ai < 2; ++ai)
#pragma unroll
            for (int m = 0; m < 4; ++m) { const int row = row0 + ai * HALF + m * 16, b = row >> 12, t = row & (SEQ - 1);
#pragma unroll
                for (int bj = 0; bj < 2; ++bj) { f32x4 v0 = acc[ai][bj][m][0], v1 = acc[ai][bj][m][1];
                    bf16_t* dst;
                    if (gate) {
#pragma unroll
                        for (int q = 0; q < 4; ++q) { v0[q] = fmaxf(fast_sigmoid(v0[q] * rs) * SSG, 0.001953125f); v1[q] = fmaxf(fast_sigmoid(v1[q] * rs) * SSG, 0.001953125f); }
                        u32x2 w8; w8.x = pk4_fp8(v0[0], v0[1], v0[2], v0[3]); w8.y = pk4_fp8(v1[0], v1[1], v1[2], v1[3]);
                        *(u32x2*)(SG + (size_t)row * SG_P + (pn - 14) * 256 + bj * HALF + wc * 32 + 8 * fq) = w8; continue; }
                    else { v0 = v0 * sc; v1 = v1 * sc; const int hl = bj * 2 + (wc >> 1);
                        size_t rowi; unsigned char* base8; float qk; bool is8;
                        if (pn < 9) { const int ty = pn / 3, g = pn - 3 * ty, sh = 2 * g, pos = ((t & ((1 << sh) - 1)) << (12 - sh)) + (t >> sh);
                            rowi = (size_t)(((g * NB + b) * 4 + hl) * SEQ + pos); base8 = HQ + (size_t)ty * (48 * MiB); is8 = ty < 2; qk = ty == 0 ? SQ : SK; }
                        else if (pn < 13) { rowi = (size_t)((b * 16 + (pn - 9) * 4 + hl) * SEQ + t); base8 = HQ + HQ_QS; is8 = true; qk = SQ; }
                        else { rowi = (size_t)((b * 2 + (wc >> 1)) * SEQ + t); base8 = HQ + (bj ? HQ_VS : HQ_KS); is8 = (bj == 0); qk = SK; }
                        if (is8) { u32x2 w8; w8.x = pk4_fp8(clamp_fp8(v0[0] * qk), clamp_fp8(v0[1] * qk), clamp_fp8(v0[2] * qk), clamp_fp8(v0[3] * qk)); w8.y = pk4_fp8(clamp_fp8(v1[0] * qk), clamp_fp8(v1[1] * qk), clamp_fp8(v1[2] * qk), clamp_fp8(v1[3] * qk));
                            *(u32x2*)(base8 + rowi * 64 + dcol) = w8; continue; }
                        dst = (bf16_t*)base8 + rowi * 64 + dcol; }
                    u32x4 w; w.x = cvt_pk_bf16(v0[0], v0[1]); w.y = cvt_pk_bf16(v0[2], v0[3]); w.z = cvt_pk_bf16(v1[0], v1[1]); w.w = cvt_pk_bf16(v1[2], v1[3]);
                    *(u32x4*)dst = w; } }
    }
};
struct EpiGate {
    static constexpr bool PERM = true, AFTER_DRAIN = false, HAS_MID = true; static constexpr int MID_T = 2;
    const unsigned char* __restrict__ SG; unsigned char* __restrict__ O;
    __device__ __forceinline__ void mid(f32x4 (&acc)[2][2][4][2], const Unit& u, int wr, int wc, int fr, int fq) const {
        const int row0 = u.pm * BM + wr * 64 + opaque(fr), col0 = u.pn * BM + wc * 32 + 8 * opaque(fq);
#pragma unroll
        for (int ai = 0; ai < 2; ++ai) {
            u32x2 a[4][2], b[4][2];
#pragma unroll
            for (int mm = 0; mm < 4; ++mm) { const unsigned char* sp = SG + (size_t)(row0 + ai * HALF + mm * 16) * SG_P + col0;
#pragma unroll
                for (int bj = 0; bj < 2; ++bj) { a[mm][bj] = *(const u32x2*)(sp + bj * HALF); b[mm][bj] = *(const u32x2*)(sp + 1024 + bj * HALF); } }
#pragma unroll
            for (int m = 0; m < 4; ++m) {
#pragma unroll
                for (int bj = 0; bj < 2; ++bj) {
#pragma unroll
                    for (int n = 0; n < 2; ++n) { const int aw = (int)a[m][bj][n], bw = (int)b[m][bj][n];
                        const f32x2 al = __builtin_amdgcn_cvt_pk_f32_fp8(aw, false), ah = __builtin_amdgcn_cvt_pk_f32_fp8(aw, true), bl = __builtin_amdgcn_cvt_pk_f32_fp8(bw, false), bh = __builtin_amdgcn_cvt_pk_f32_fp8(bw, true);
                        f32x4 r; r[0] = al[0] * __builtin_amdgcn_rcpf(bl[0]); r[1] = al[1] * __builtin_amdgcn_rcpf(bl[1]); r[2] = ah[0] * __builtin_amdgcn_rcpf(bh[0]); r[3] = ah[1] * __builtin_amdgcn_rcpf(bh[1]);
                        acc[ai][bj][m][n] = acc[ai][bj][m][n] * r; } }
                asm volatile("" : "+v"(acc[ai][0][m][0]), "+v"(acc[ai][0][m][1]), "+v"(acc[ai][1][m][0]), "+v"(acc[ai][1][m][1])); }
            asm volatile("" ::: "memory"); }
    }
    __device__ __forceinline__ void operator()(const f32x4 (&acc)[2][2][4][2], const Unit& u, int wr, int wc, int fr, int fq) const {
        const int row0 = u.pm * BM + wr * 64 + opaque(fr), col0 = u.pn * BM + wc * 32 + 8 * opaque(fq);
        constexpr float FS = SM / (SO * SW * SSG);
#pragma unroll
        for (int ai = 0; ai < 2; ++ai) {
            u32x2 bq[4][2];
#pragma unroll
            for (int m = 0; m < 4; ++m)
#pragma unroll
                for (int bj = 0; bj < 2; ++bj) bq[m][bj] = *(const u32x2*)(SG + (size_t)(row0 + ai * HALF + m * 16) * SG_P + 1024 + col0 + bj * HALF);
#pragma unroll
            for (int m = 0; m < 4; ++m) { unsigned char* op = O + (size_t)(row0 + ai * HALF + m * 16) * D + col0;
#pragma unroll
                for (int bj = 0; bj < 2; ++bj) { u32x2 w;
#pragma unroll
                    for (int n = 0; n < 2; ++n) { const int bw = (int)bq[m][bj][n]; const f32x2 bl = __builtin_amdgcn_cvt_pk_f32_fp8(bw, false), bh = __builtin_amdgcn_cvt_pk_f32_fp8(bw, true); const f32x4 v = acc[ai][bj][m][n] * FS;
                        w[n] = pk4_fp8(clamp_fp8(v[0] * bl[0]), clamp_fp8(v[1] * bl[1]), clamp_fp8(v[2] * bh[0]), clamp_fp8(v[3] * bh[1])); }
                    *(u32x2*)(op + bj * HALF) = w; } }
            asm volatile("" ::: "memory"); }
    }
};

struct PanelStats {
    unsigned* xbuf;
    unsigned* cnt;
    unsigned* tmo;
    int pm_off; float eps; unsigned code;
    __device__ __forceinline__ bool run(const f32x4 (&v)[2][2][4][2], const Unit& u, int wr, int wc, int fr, int fq, LAS unsigned char* lds, int wid, int lane) const {
        LAS f32x2* P = (LAS f32x2*)lds;
        LAS f32x2* S = (LAS f32x2*)(lds + 8192);
        LAS unsigned* flag = (LAS unsigned*)(lds + 8192 + 2048);
        const int panel = u.pm + pm_off;
#pragma unroll
        for (int ai = 0; ai < 2; ++ai)
#pragma unroll
            for (int m = 0; m < 4; ++m) {
                float s = 0.f;
#pragma unroll
                for (int bj = 0; bj < 2; ++bj)
#pragma unroll
                    for (int n = 0; n < 2; ++n) { const f32x4 x = v[ai][bj][m][n]; s += (x[0] + x[1]) + (x[2] + x[3]); }
                s += __shfl_xor(s, 16); s += __shfl_xor(s, 32);
                const float mw = s * (1.0f / 64.0f); float q = 0.f;
#pragma unroll
                for (int bj = 0; bj < 2; ++bj)
#pragma unroll
                    for (int n = 0; n < 2; ++n) { const f32x4 d = v[ai][bj][m][n] - mw; q += (d[0] * d[0] + d[1] * d[1]) + (d[2] * d[2] + d[3] * d[3]); }
                q += __shfl_xor(q, 16); q += __shfl_xor(q, 32);
                if (fq == 0) P[(ai * HALF + wr * 64 + m * 16 + fr) * 4 + wc] = (f32x2){mw, q};
            }
        asm volatile("s_waitcnt lgkmcnt(0)" ::: "memory"); __builtin_amdgcn_s_barrier(); asm volatile("" ::: "memory");
        const int row = wid * 32 + (lane & 31);
        if (lane < 32) {
            const f32x2 a = P[row * 4 + 0], b = P[row * 4 + 1], c = P[row * 4 + 2], d = P[row * 4 + 3];
            const float mt = (a.x + b.x + c.x + d.x) * 0.25f;
            const float da = a.x - mt, db = b.x - mt, dc = c.x - mt, dd = d.x - mt;
            const float m2 = (a.y + b.y) + (c.y + d.y) + 64.0f * ((da * da + db * db) + (dc * dc + dd * dd));
            unsigned long long* slot = (unsigned long long*)xbuf + ((size_t)(panel * BM + row) * 4 + u.pn);
            __hip_atomic_store(slot, ((unsigned long long)__float_as_uint(m2) << 32) | __float_as_uint(mt), __ATOMIC_RELAXED, __HIP_MEMORY_SCOPE_AGENT);
        }
        asm volatile("s_waitcnt vmcnt(0)" ::: "memory");
        if (lane == 0) __hip_atomic_fetch_add(cnt + 64 * panel, 1u, __ATOMIC_RELAXED, __HIP_MEMORY_SCOPE_AGENT);
        if (wid == 0) {
            bool dead = false; const unsigned long long t0 = __builtin_amdgcn_s_memrealtime(); const unsigned want = 8u * 4u;
            for (;;) {
                if ((unsigned)__builtin_amdgcn_readfirstlane(__hip_atomic_load(cnt + 64 * panel, __ATOMIC_RELAXED, __HIP_MEMORY_SCOPE_AGENT)) >= want) break;
                if (__builtin_amdgcn_s_memrealtime() - t0 > 2000000ull) {
                    if (lane == 0) { unsigned expect = 0u; __hip_atomic_compare_exchange_strong(tmo + 1, &expect, code | (unsigned)(panel & 0xff), __ATOMIC_RELAXED, __ATOMIC_RELAXED, __HIP_MEMORY_SCOPE_AGENT);
                                     __hip_atomic_store(tmo, 1u, __ATOMIC_RELAXED, __HIP_MEMORY_SCOPE_AGENT); }
                    dead = true; break; }
                __builtin_amdgcn_s_sleep(2);
            }
            __builtin_amdgcn_fence(__ATOMIC_ACQUIRE, "agent");
            if (lane == 0) flag[0] = dead ? 1u : 0u;
        }
        asm volatile("s_waitcnt vmcnt(0) lgkmcnt(0)" ::: "memory"); __builtin_amdgcn_s_barrier(); asm volatile("" ::: "memory");
        const bool bad = flag[0] != 0u;
        if (lane < 32) {
            const unsigned long long* slot = (const unsigned long long*)xbuf + (size_t)(panel * BM + row) * 4; float mt[4], m2[4]; float ms = 0.f;
#pragma unroll
            for (int t = 0; t < 4; ++t) { const unsigned long long w = __hip_atomic_load(slot + t, __ATOMIC_RELAXED, __HIP_MEMORY_SCOPE_AGENT); mt[t] = __uint_as_float((unsigned)w); m2[t] = __uint_as_float((unsigned)(w >> 32)); ms += mt[t]; }
            const float mean = ms * 0.25f; float q = 0.f;
#pragma unroll
            for (int t = 0; t < 4; ++t) { const float dm = mt[t] - mean; q += m2[t] + 256.0f * dm * dm; }
            S[row] = (f32x2){mean, 1.0f / sqrtf(q * (1.0f / 1024.0f) + eps)};
        }
        asm volatile("s_waitcnt lgkmcnt(0)" ::: "memory"); __builtin_amdgcn_s_barrier(); asm volatile("" ::: "memory");
        return bad;
    }
};
struct EpiLn1 {
    static constexpr bool PERM = true, AFTER_DRAIN = true, HAS_MID = false; static constexpr int MID_T = 0;
    const float* x; float* out; bf16_t* xb; unsigned char* xq; const float* gam; const float* bet; PanelStats st; int row_off; unsigned poison; float rs;
    __device__ __forceinline__ void mid(f32x4 (&)[2][2][4][2], const Unit&, int, int, int, int) const {}
    __device__ __forceinline__ void operator()(const f32x4 (&)[2][2][4][2], const Unit&, int, int, int, int) const {}
    __device__ __forceinline__ void fused(f32x4 (&acc)[2][2][4][2], const Unit& u, int wr, int wc, int fr, int fq, LAS unsigned char* lds, int wid, int lane) const {
        const LAS f32x2* S = (const LAS f32x2*)(lds + 8192);
        const int col0 = u.pn * BM + wc * 32 + 8 * opaque(fq);
        const int grow0 = row_off + u.pm * BM; fr = opaque(fr);
#pragma unroll
        for (int ai = 0; ai < 2; ++ai)
#pragma unroll
            for (int m = 0; m < 4; ++m) { const size_t off = (size_t)(grow0 + ai * HALF + wr * 64 + m * 16 + fr) * D + col0;
#pragma unroll
                for (int bj = 0; bj < 2; ++bj)
#pragma unroll
                    for (int n = 0; n < 2; ++n) { const f32x4 bs = *(const f32x4*)(x + off + bj * HALF + n * 4); acc[ai][bj][m][n] = acc[ai][bj][m][n] * rs + bs * DN_ALPHA; }
                asm volatile("" : "+v"(acc[ai][0][m][0]), "+v"(acc[ai][0][m][1]), "+v"(acc[ai][1][m][0]), "+v"(acc[ai][1][m][1]));
                if (m == 3) asm volatile("" ::: "memory"); }
        const bool bad = st.run(acc, u, wr, wc, fr, fq, lds, wid, lane) || poison != 0u;
        const float qnan = __builtin_nanf("");
        f32x4 gv[2][2], bv[2][2];
#pragma unroll
        for (int bj = 0; bj < 2; ++bj)
#pragma unroll
            for (int n = 0; n < 2; ++n) { gv[bj][n] = *(const f32x4*)(gam + col0 + bj * HALF + n * 4); bv[bj][n] = *(const f32x4*)(bet + col0 + bj * HALF + n * 4); }
#pragma unroll
        for (int ai = 0; ai < 2; ++ai)
#pragma unroll
            for (int m = 0; m < 4; ++m) { const int r = ai * HALF + wr * 64 + m * 16 + fr; const f32x2 sr = S[r]; const size_t off = (size_t)(grow0 + r) * D + col0;
#pragma unroll
                for (int bj = 0; bj < 2; ++bj) { f32x4 o0 = (acc[ai][bj][m][0] - sr.x) * sr.y * gv[bj][0] + bv[bj][0], o1 = (acc[ai][bj][m][1] - sr.x) * sr.y * gv[bj][1] + bv[bj][1];
                    if (bad) { o0 = (f32x4){qnan, qnan, qnan, qnan}; o1 = o0; }
                    u32x4 w; w.x = cvt_pk_bf16(o0[0], o0[1]); w.y = cvt_pk_bf16(o0[2], o0[3]); w.z = cvt_pk_bf16(o1[0], o1[1]); w.w = cvt_pk_bf16(o1[2], o1[3]); *(u32x4*)(xb + off + bj * HALF) = w;
                    u32x2 q8; q8.x = pk4_fp8(clamp_fp8(o0[0] * SX), clamp_fp8(o0[1] * SX), clamp_fp8(o0[2] * SX), clamp_fp8(o0[3] * SX)); q8.y = pk4_fp8(clamp_fp8(o1[0] * SX), clamp_fp8(o1[1] * SX), clamp_fp8(o1[2] * SX), clamp_fp8(o1[3] * SX));
                    *(u32x2*)(xq + off + bj * HALF) = q8; } }
    }
};
struct EpiY {
    static constexpr bool PERM = true, AFTER_DRAIN = false, HAS_MID = false; static constexpr int MID_T = 0;
    const float* __restrict__ x; bf16_t* __restrict__ Y; float* __restrict__ ST; float rs;
    __device__ __forceinline__ void mid(f32x4 (&)[2][2][4][2], const Unit&, int, int, int, int) const {}
    __device__ __forceinline__ void operator()(const f32x4 (&acc)[2][2][4][2], const Unit& u, int wr, int wc, int fr, int fq) const {
        const int row0 = u.pm * BM + wr * 64 + opaque(fr), col0 = u.pn * BM + wc * 32 + 8 * opaque(fq);
#pragma unroll
        for (int ai = 0; ai < 2; ++ai) {
            f32x4 xv[4][2][2];
#pragma unroll
            for (int m = 0; m < 4; ++m)
#pragma unroll
                for (int bj = 0; bj < 2; ++bj)
#pragma unroll
                    for (int n = 0; n < 2; ++n) xv[m][bj][n] = *(const f32x4*)(x + (size_t)(row0 + ai * HALF + m * 16) * D + col0 + bj * HALF + n * 4);
#pragma unroll
            for (int m = 0; m < 4; ++m) { const size_t r = (size_t)(row0 + ai * HALF + m * 16); float s1 = 0.f, s2 = 0.f;
#pragma unroll
                for (int bj = 0; bj < 2; ++bj) { const f32x4 y0 = acc[ai][bj][m][0] * rs + xv[m][bj][0] * DN_ALPHA, y1 = acc[ai][bj][m][1] * rs + xv[m][bj][1] * DN_ALPHA;
                    s1 += (y0[0] + y0[1]) + (y0[2] + y0[3]) + (y1[0] + y1[1]) + (y1[2] + y1[3]);
                    s2 += (y0[0] * y0[0] + y0[1] * y0[1]) + (y0[2] * y0[2] + y0[3] * y0[3]) + (y1[0] * y1[0] + y1[1] * y1[1]) + (y1[2] * y1[2] + y1[3] * y1[3]);
                    u32x4 w; w.x = cvt_pk_bf16(y0[0], y0[1]); w.y = cvt_pk_bf16(y0[2], y0[3]); w.z = cvt_pk_bf16(y1[0], y1[1]); w.w = cvt_pk_bf16(y1[2], y1[3]);
                    *(u32x4*)(Y + r * D + col0 + bj * HALF) = w; }
                s1 += __shfl_xor(s1, 16); s1 += __shfl_xor(s1, 32); s2 += __shfl_xor(s2, 16); s2 += __shfl_xor(s2, 32);
                if (fq == 0) *(f32x2*)(ST + (r * 16 + u.pn * 4 + wc) * 2) = (f32x2){s1, s2}; }
            asm volatile("" ::: "memory"); }
    }
};
struct EpiGU {
    static constexpr bool PERM = true, AFTER_DRAIN = false, HAS_MID = false; static constexpr int MID_T = 0;
    const float* bg; const float* bu; unsigned char* H;
    __device__ __forceinline__ void mid(f32x4 (&)[2][2][4][2], const Unit&, int, int, int, int) const {}
    __device__ __forceinline__ void operator()(const f32x4 (&acc)[2][2][4][2], const Unit& u, int wr, int wc, int fr, int fq) const {
        const int row0 = u.pm * BM + wr * 64 + opaque(fr), j0 = u.pn * HALF + wc * 32 + 8 * opaque(fq);
        const f32x4 g0 = *(const f32x4*)(bg + u.e * DFF + j0), g1 = *(const f32x4*)(bg + u.e * DFF + j0 + 4);
        const f32x4 u0 = *(const f32x4*)(bu + u.e * DFF + j0), u1 = *(const f32x4*)(bu + u.e * DFF + j0 + 4);
#pragma unroll
        for (int ai = 0; ai < 2; ++ai)
#pragma unroll
            for (int m = 0; m < 4; ++m) {
                constexpr float RS = 1.0f / (SX * SW);
                f32x4 gt0 = acc[ai][0][m][0] * RS + g0, gt1 = acc[ai][0][m][1] * RS + g1, up0 = acc[ai][1][m][0] * RS + u0, up1 = acc[ai][1][m][1] * RS + u1; f32x4 h0, h1;
#pragma unroll
                for (int q = 0; q < 4; ++q) {
                    const float a = fminf(gt0[q], 7.0f), b = fminf(gt1[q], 7.0f);
                    const float ua = fminf(fmaxf(up0[q], -7.0f), 7.0f), ub = fminf(fmaxf(up1[q], -7.0f), 7.0f);
                    h0[q] = (a * __builtin_amdgcn_rcpf(1.0f + __builtin_amdgcn_exp2f(-1.702f * LOG2E * a))) * __builtin_fmaf(ua, SH, SH);
                    h1[q] = (b * __builtin_amdgcn_rcpf(1.0f + __builtin_amdgcn_exp2f(-1.702f * LOG2E * b))) * __builtin_fmaf(ub, SH, SH); }
                u32x2 w; w.x = pk4_fp8(h0[0], h0[1], h0[2], h0[3]); w.y = pk4_fp8(h1[0], h1[1], h1[2], h1[3]);
                *(u32x2*)(H + (size_t)(row0 + ai * HALF + m * 16) * DFF + j0) = w; }
    }
};
struct EpiDown {
    static constexpr bool PERM = true, AFTER_DRAIN = false, HAS_MID = false; static constexpr int MID_T = 0;
    const float* bd; const int* petok; const float* pegate; unsigned char* Y;
    __device__ __forceinline__ void mid(f32x4 (&)[2][2][4][2], const Unit&, int, int, int, int) const {}
    __device__ __forceinline__ void operator()(const f32x4 (&acc)[2][2][4][2], const Unit& u, int wr, int wc, int fr, int fq) const {
        const int r0 = wr * 64 + opaque(fr), col0 = u.pn * BM + wc * 32 + 8 * opaque(fq);
        f32x4 b[2][2];
#pragma unroll
        for (int bj = 0; bj < 2; ++bj) { b[bj][0] = *(const f32x4*)(bd + u.e * D + col0 + bj * HALF); b[bj][1] = *(const f32x4*)(bd + u.e * D + col0 + bj * HALF + 4); }
        const size_t eb = (size_t)u.e * NTOK + (size_t)u.ti * 256;
        int info[2][4]; float gwv[2][4];
#pragma unroll
        for (int ai = 0; ai < 2; ++ai)
#pragma unroll
            for (int m = 0; m < 4; ++m) { const int r = r0 + ai * HALF + m * 16; info[ai][m] = petok[eb + r]; gwv[ai][m] = pegate[eb + r] * SY; }
        if (u.valid == 256) {
#pragma unroll
        for (int ai = 0; ai < 2; ++ai)
#pragma unroll
            for (int m = 0; m < 4; ++m) { const int r = r0 + ai * HALF + m * 16;
                { const float gw = gwv[ai][m];
                    unsigned char* op = Y + (size_t)info[ai][m] * 1024 + col0;
#pragma unroll
                    for (int bj = 0; bj < 2; ++bj) { constexpr float RS = 1.0f / (SH * SW); const f32x4 v0 = (acc[ai][bj][m][0] * RS + b[bj][0]) * gw, v1 = (acc[ai][bj][m][1] * RS + b[bj][1]) * gw;
                        u32x2 w; w.x = pk4_fp8(clamp_fp8(v0[0]), clamp_fp8(v0[1]), clamp_fp8(v0[2]), clamp_fp8(v0[3])); w.y = pk4_fp8(clamp_fp8(v1[0]), clamp_fp8(v1[1]), clamp_fp8(v1[2]), clamp_fp8(v1[3]));
                        *(u32x2*)(op + bj * HALF) = w; } } }
        } else {
#pragma unroll
        for (int ai = 0; ai < 2; ++ai)
#pragma unroll
            for (int m = 0; m < 4; ++m) { const int r = r0 + ai * HALF + m * 16;
                if (r < u.valid) { const float gw = gwv[ai][m];
                    unsigned char* op = Y + (size_t)info[ai][m] * 1024 + col0;
#pragma unroll
                    for (int bj = 0; bj < 2; ++bj) { constexpr float RS = 1.0f / (SH * SW); const f32x4 v0 = (acc[ai][bj][m][0] * RS + b[bj][0]) * gw, v1 = (acc[ai][bj][m][1] * RS + b[bj][1]) * gw;
                        u32x2 w; w.x = pk4_fp8(clamp_fp8(v0[0]), clamp_fp8(v0[1]), clamp_fp8(v0[2]), clamp_fp8(v0[3])); w.y = pk4_fp8(clamp_fp8(v1[0]), clamp_fp8(v1[1]), clamp_fp8(v1[2]), clamp_fp8(v1[3]));
                        *(u32x2*)(op + bj * HALF) = w; } } }
        }
    }
};
}

#define XB_TMO      128
#define XB_XCNT(j)  (256  + 64 * (j))
#define XB_XSUB(j)  (1280 + 64 * (j))
#define XB_XGEN(j)  (2304 + 64 * (j))
#define XB_TOP      3328
#define XB_TOPGEN   3392
#define XCD_BAR_WORDS 3456
#define XB_SPIN_CAP (1u << 18)
__device__ __forceinline__ unsigned xb_ld(unsigned* p)              { return __hip_atomic_load(p, __ATOMIC_RELAXED, __HIP_MEMORY_SCOPE_AGENT); }
__device__ __forceinline__ unsigned xb_add(unsigned* p, unsigned v) { return __hip_atomic_fetch_add(p, v, __ATOMIC_RELAXED, __HIP_MEMORY_SCOPE_AGENT); }
__device__ __forceinline__ unsigned xb_xcc_id() { return (unsigned)__builtin_amdgcn_s_getreg((3 << 11) | 20) & 0xFu; }
#define XB_SPIN(cond, bar) do { unsigned _sp = 0; while (cond) { __builtin_amdgcn_s_sleep(1); \
    if ((++_sp & 255u) == 0u) { if (xb_ld(&(bar)[XB_TMO])) break; if (_sp > XB_SPIN_CAP) { atomicAdd(&(bar)[XB_TMO], 1u); break; } } } } while (0)
struct XcdBarrier { unsigned* bar; unsigned x; volatile LAS unsigned* st; };
__device__ __forceinline__ XcdBarrier xcd_barrier_post(unsigned* bar, volatile LAS unsigned* st) {
    XcdBarrier b; b.bar = bar; b.x = xb_xcc_id(); b.st = st;
    if (threadIdx.x == 0) (void)xb_add(&bar[XB_XCNT(b.x)], 1u);
    return b;
}
__device__ __forceinline__ void xcd_barrier_complete(unsigned* bar, unsigned x, unsigned& nloc, unsigned& nx) {
    const unsigned G = gridDim.x * gridDim.y * gridDim.z;
    unsigned sum, cnt, mine, sp = 0u;
    for (;;) {
        sum = 0u; cnt = 0u; mine = 0u;
#pragma unroll
        for (unsigned j = 0; j < 16; ++j) { const unsigned c = xb_ld(&bar[XB_XCNT(j)]); sum += c; cnt += (c > 0u) ? 1u : 0u; mine = (j == x) ? c : mine; }
        if (sum == G) break;
        __builtin_amdgcn_s_sleep(1);
        if ((++sp & 255u) == 0u) { if (xb_ld(&bar[XB_TMO])) break; if (sp > XB_SPIN_CAP) { atomicAdd(&bar[XB_TMO], 1u); break; } }
    }
    nloc = mine > 0u ? mine : 1u; nx = cnt > 0u ? cnt : 1u;
}
__device__ __forceinline__ void xcd_barrier(const XcdBarrier& b) {
    asm volatile("s_waitcnt vmcnt(0)" ::: "memory");
    __syncthreads();
    if (threadIdx.x == 0) {
        unsigned* bar = b.bar;
        __builtin_amdgcn_s_waitcnt(0);
        unsigned nloc = b.st[0], nx = b.st[1];
        if (nloc == 0u) { xcd_barrier_complete(bar, b.x, nloc, nx); b.st[0] = nloc; b.st[1] = nx; }
        const unsigned old = xb_add(&bar[XB_XSUB(b.x)], 1u);
        const unsigned gen = old / nloc;
        if (old + 1u == (gen + 1u) * nloc) {
            __builtin_amdgcn_fence(__ATOMIC_RELEASE, "agent");
            asm volatile("s_waitcnt vmcnt(0)" ::: "memory");
            const unsigned og = xb_add(&bar[XB_TOP], 1u);
            const unsigned tg = og / nx;
            if (og + 1u == (tg + 1u) * nx) xb_add(&bar[XB_TOPGEN], 1u);
            else XB_SPIN(xb_ld(&bar[XB_TOPGEN]) == tg, bar);
            __builtin_amdgcn_fence(__ATOMIC_ACQUIRE, "agent");
            xb_add(&bar[XB_XGEN(b.x)], 1u);
            asm volatile("s_waitcnt vmcnt(0)" ::: "memory");
        } else {
            XB_SPIN(xb_ld(&bar[XB_XGEN(b.x)]) == gen, bar);
            __builtin_amdgcn_fence(__ATOMIC_ACQUIRE, "agent");
            asm volatile("s_waitcnt vmcnt(0)" ::: "memory");
        }
    }
    __syncthreads();
}

constexpr int NWAVES = 8;
struct Frame {
    LAS unsigned char* lds; volatile LAS unsigned* MISC; gu32* ctl;
    int tid, lane, wave, vcu, G;
    unsigned char* ws; unsigned char* dout;
};
__device__ __forceinline__ float wave_sum(float v) {
#pragma unroll
    for (int o = 1; o < 64; o <<= 1) v += __shfl_xor(v, o);
    return v;
}
__device__ __forceinline__ void transpose_item(const float* W, int N, int k0, int n0, bf16_t* WT, int ldw, size_t drow0, int dcol0, LAS float* scr, int lane) {
#pragma unroll 8
    for (int i = 0; i < 32; ++i) { const int kk = 2 * i + (lane >> 5); scr[kk * 33 + (lane & 31)] = W[(size_t)(k0 + kk) * N + n0 + (lane & 31)]; }
    LDS_WAIT(); asm volatile("" ::: "memory");
    const int c = lane & 7;
#pragma unroll
    for (int j = 0; j < 4; ++j) { const int n = (lane >> 3) + 8 * j; const LAS float* s = scr + (8 * c) * 33 + n;
        u32x4 o; o.x = cvt_pk_bf16(s[0 * 33], s[1 * 33]); o.y = cvt_pk_bf16(s[2 * 33], s[3 * 33]); o.z = cvt_pk_bf16(s[4 * 33], s[5 * 33]); o.w = cvt_pk_bf16(s[6 * 33], s[7 * 33]);
        *(GAS u32x4*)(WT + (drow0 + n) * (size_t)ldw + dcol0 + 8 * c) = o; }
    LDS_WAIT(); asm volatile("" ::: "memory");
}
__device__ __forceinline__ void transpose_item_f8(const float* W, int N, int k0, int n0, unsigned char* WT, int ldw, size_t drow0, int dcol0, LAS float* scr, int lane);
__device__ __forceinline__ void p0_convert(Frame& F, const float* x, const float* w_in, const float* w_pa, const float* w_pb, const float* w_out, const float* rw) {
    LAS float* scr = (LAS float*)(F.lds + F.wave * 17408);
    const int gw = F.vcu * NWAVES + F.wave, NGW = F.G * NWAVES;
    unsigned char* WIN = F.dout + DO_WIN; unsigned char* WCAT = F.dout + DO_WCAT; unsigned char* WOUT = F.ws + WS_WOUT;
    constexpr int I_IN = (D / 128) * (IN_COLS / 32), I_OUT = (D / 128) * (D / 32), I_PA = (256 / 128) * (D / 32), I_PB = (D / 128) * (D / 32);
    for (int it = gw; it < I_IN + I_OUT + I_PA + I_PB; it += NGW) {
        int r = it;
        if (r < I_IN) { const int nb = IN_COLS / 32; transpose_item_f8(w_in, IN_COLS, 128 * (r / nb), 32 * (r % nb), WIN, D, (size_t)(32 * (r % nb)), 128 * (r / nb), scr, F.lane); continue; } r -= I_IN;
        if (r < I_OUT) { const int nb = D / 32; transpose_item_f8(w_out, D, 128 * (r / nb), 32 * (r % nb), WOUT, D, (size_t)(32 * (r % nb)), 128 * (r / nb), scr, F.lane); continue; } r -= I_OUT;
        if (r < I_PA) { const int nb = D / 32; transpose_item_f8(w_pa, D, 128 * (r / nb), 32 * (r % nb), WCAT, OAB_P, (size_t)(32 * (r % nb)), 128 * (r / nb), scr, F.lane); continue; } r -= I_PA;
        { const int nb = D / 32; transpose_item_f8(w_pb, D, 128 * (r / nb), 32 * (r % nb), WCAT, OAB_P, (size_t)(32 * (r % nb)), 256 + 128 * (r / nb), scr, F.lane); }
    }
    { bf16_t* WRT = (bf16_t*)(F.ws + WS_WRT);
      for (int i = gw * 64 + F.lane; i < NEXP * D; i += NGW * 64) { const int e = i >> 10, k = i & (D - 1); const float w = rw[k * NEXP + e];
          const unsigned hi = cvt_pk_bf16(w, 0.f) & 0xffffu; const float r = w - __uint_as_float(hi << 16);
          WRT[i] = (bf16_t)hi; WRT[NEXP * D + i] = (bf16_t)(cvt_pk_bf16(r, 0.f) & 0xffffu); } }
    unsigned char* XQ = F.dout + DO_XB;
    const size_t n16 = (size_t)NTOK * D / 16;
    for (size_t i = (size_t)gw * 64 + F.lane; i < n16; i += (size_t)NGW * 64) {
        const f32x4 a = *(const GAS f32x4*)(x + i * 16), b = *(const GAS f32x4*)(x + i * 16 + 4), c = *(const GAS f32x4*)(x + i * 16 + 8), d = *(const GAS f32x4*)(x + i * 16 + 12);
        u32x4 o;
        o.x = pk4_fp8(clamp_fp8(a[0] * SXIN), clamp_fp8(a[1] * SXIN), clamp_fp8(a[2] * SXIN), clamp_fp8(a[3] * SXIN)); o.y = pk4_fp8(clamp_fp8(b[0] * SXIN), clamp_fp8(b[1] * SXIN), clamp_fp8(b[2] * SXIN), clamp_fp8(b[3] * SXIN));
        o.z = pk4_fp8(clamp_fp8(c[0] * SXIN), clamp_fp8(c[1] * SXIN), clamp_fp8(c[2] * SXIN), clamp_fp8(c[3] * SXIN)); o.w = pk4_fp8(clamp_fp8(d[0] * SXIN), clamp_fp8(d[1] * SXIN), clamp_fp8(d[2] * SXIN), clamp_fp8(d[3] * SXIN));
        *(GAS u32x4*)(XQ + i * 16) = o;
    }
}
__device__ __forceinline__ void transpose_item_f8(const float* W, int N, int k0, int n0, unsigned char* WT, int ldw, size_t drow0, int dcol0, LAS float* scr, int lane) {
    f32x4 wv[16];
#pragma unroll
    for (int i = 0; i < 16; ++i) wv[i] = *(const GAS f32x4*)(W + (size_t)(k0 + 8 * i + (lane >> 3)) * N + n0 + (lane & 7) * 4);
#pragma unroll
    for (int i = 0; i < 16; ++i) { LAS float* d = scr + (8 * i + (lane >> 3)) * 33 + (lane & 7) * 4; d[0] = wv[i][0]; d[1] = wv[i][1]; d[2] = wv[i][2]; d[3] = wv[i][3]; }
    LDS_WAIT(); asm volatile("" ::: "memory");
    const int c = lane & 7;
#pragma unroll
    for (int j = 0; j < 4; ++j) { const int n = (lane >> 3) + 8 * j; const LAS float* s = scr + (16 * c) * 33 + n;
        u32x4 o;
        o.x = pk4_fp8(clamp_fp8(s[0 * 33] * SW), clamp_fp8(s[1 * 33] * SW), clamp_fp8(s[2 * 33] * SW), clamp_fp8(s[3 * 33] * SW));
        o.y = pk4_fp8(clamp_fp8(s[4 * 33] * SW), clamp_fp8(s[5 * 33] * SW), clamp_fp8(s[6 * 33] * SW), clamp_fp8(s[7 * 33] * SW));
        o.z = pk4_fp8(clamp_fp8(s[8 * 33] * SW), clamp_fp8(s[9 * 33] * SW), clamp_fp8(s[10 * 33] * SW), clamp_fp8(s[11 * 33] * SW));
        o.w = pk4_fp8(clamp_fp8(s[12 * 33] * SW), clamp_fp8(s[13 * 33] * SW), clamp_fp8(s[14 * 33] * SW), clamp_fp8(s[15 * 33] * SW));
        *(GAS u32x4*)(WT + (drow0 + n) * (size_t)ldw + dcol0 + 16 * c) = o; }
    LDS_WAIT(); asm volatile("" ::: "memory");
}
__device__ __forceinline__ void p3_convert_moe(Frame& F, const float* w_gate, const float* w_up, const float* w_down, int wg, int nwg) {
    LAS float* scr = (LAS float*)(F.lds + F.wave * 17408);
    const int gw = wg * NWAVES + F.wave, NGW = nwg * NWAVES;
    unsigned char* WGU = F.ws + WS_WGU; unsigned char* WD = F.ws + WS_WD;
    constexpr int IPM = (D / 128) * (DFF / 32);
    for (int it = gw; it < NEXP * 3 * IPM; it += NGW) {
        const int e = it / (3 * IPM), r3 = it % (3 * IPM), which = r3 / IPM, r = r3 % IPM, kb = r / 32, nb = r % 32, k0 = 128 * kb, n0 = 32 * nb;
        const size_t moff = (size_t)e * D * DFF;
        if (which == 2) transpose_item_f8(w_down + moff, D, k0, n0, WD + moff, DFF, (size_t)n0, k0, scr, F.lane);
        else { const int pn = n0 >> 7, jj = n0 & 127; transpose_item_f8((which ? w_up : w_gate) + moff, DFF, k0, n0, WGU + 2 * moff, D, (size_t)(256 * pn + 128 * which + jj), k0, scr, F.lane); }
    }
}
typedef short v4i16_t __attribute__((ext_vector_type(4)));
__device__ __forceinline__ s16x4 tr_read(const LAS unsigned char* p) { return __builtin_bit_cast(s16x4, __builtin_amdgcn_ds_read_tr16_b64_v4i16((LAS v4i16_t*)p)); }
constexpr int ATT_KOFF = 0, ATT_VOFF = 12 * 4096, ATT_STG = 24 * 4096, ATT_STGW = 4608;
static_assert(ATT_STG + 8 * ATT_STGW <= SCR_BYTES, "attention LDS map");
__device__ __forceinline__ void attn_unit(LAS unsigned char* lds, int lane, int wave, const unsigned char* qseq, const unsigned char* kseq, const bf16_t* vseq, int jt0, int nkt, int jq, int s0,
                                          float sl2, bool swa, float sink2, bf16_t* ob, unsigned op, float* lseb, unsigned lsep) {
    const int i32 = lane & 31, h = lane >> 5;
    for (int p = wave; p < nkt * 6; p += 8) {
        if (p < nkt * 2) { const int s = p >> 1, qt = p & 1; const int tj = jt0 + s; const size_t pos0 = (size_t)(32 * (tj >= 0 ? tj : 0));
            const int key = 16 * qt + (lane >> 2), cc = (lane & 3) ^ ((key >> 2) & 3);
            __builtin_amdgcn_global_load_lds((const unsigned*)((const char*)kseq + (pos0 + key) * 64 + cc * 16), (LAS unsigned*)(lds + ATT_KOFF + s * 2048 + qt * 1024), 16, 0, 0); }
        else { const int p2 = p - nkt * 2, s = p2 >> 2, qt = p2 & 3; const int tj = jt0 + s; const size_t pos0 = (size_t)(32 * (tj >= 0 ? tj : 0));
            const int blk = qt >> 1, part = qt & 1, key = 16 * part + (lane >> 2);
            __builtin_amdgcn_global_load_lds((const unsigned*)((const char*)vseq + (pos0 + key) * 128 + blk * 64 + (lane & 3) * 16), (LAS unsigned*)(lds + ATT_VOFF + s * 4096 + blk * 2048 + part * 1024), 16, 0, 0); }
    }
    long qf[4];
    { const char* qrow = (const char*)qseq + (size_t)(32 * jq + i32) * 64 + h * 8;
#pragma unroll
      for (int d0 = 0; d0 < 4; ++d0) qf[d0] = *(const long*)(qrow + d0 * 16); }
    constexpr float QKS = SQ * SK, RQK = 1.0f / (SQ * SK);
    f32x16 bias;
#pragma unroll
    for (int r = 0; r < 16; ++r) { const int kk = (r & 3) + 8 * (r >> 2) + 4 * h; bias[r] = sl2 * QKS * (float)(kk - i32); }
    asm volatile("s_waitcnt vmcnt(0)" ::: "memory");
    __builtin_amdgcn_s_barrier();
    asm volatile("" ::: "memory");
    f32x16 S[5];
    float m2 = sink2;
    const int kro = i32 * 64 + h * 8, ksw = (i32 >> 2) & 3;
    long kf[2][4];
#pragma unroll
    for (int c = 0; c < 5; ++c) {
        const bool tv = (jq - 4 + c) >= 0;
        const LAS unsigned char* ks = lds + ATT_KOFF + (s0 + c) * 2048 + kro;
#pragma unroll
        for (int d0 = 0; d0 < 4; ++d0) kf[c & 1][d0] = *(const LAS long*)(ks + ((d0 ^ ksw) * 16));
        if (c > 0) asm volatile("" :: "v"(kf[(c - 1) & 1][0]), "v"(kf[(c - 1) & 1][1]), "v"(kf[(c - 1) & 1][2]), "v"(kf[(c - 1) & 1][3]) : "memory");
        f32x16 a = bias;
#pragma unroll
        for (int d0 = 0; d0 < 4; ++d0) a = __builtin_amdgcn_mfma_f32_32x32x16_fp8_fp8(kf[c & 1][d0], qf[d0], a, 0, 0, 0);
        const float off = -sl2 * (float)(32 * (4 - c));
#pragma unroll
        for (int r = 0; r < 16; ++r) { const int kk = (r & 3) + 8 * (r >> 2) + 4 * h; bool ok = tv;
            if (c == 4) ok = ok && (kk <= i32);
            if (c == 0) ok = ok && (swa ? (kk > i32) : (kk >= i32));
            const float v = ok ? __builtin_fmaf(a[r], RQK, off) : NEG_BIG; a[r] = v; m2 = fmaxf(m2, v); }
        S[c] = a;
    }
    m2 = fmaxf(m2, __shfl_xor(m2, 32));
    float l = 0.f;
#pragma unroll
    for (int c = 0; c < 5; ++c)
#pragma unroll
        for (int r = 0; r < 16; ++r) { const float p = __builtin_amdgcn_exp2f(S[c][r] - m2); S[c][r] = p; l += p; }
    l += __shfl_xor(l, 32);
    l += __builtin_amdgcn_exp2f(sink2 - m2);
    asm volatile("" :: "v"(kf[0][0]), "v"(kf[0][1]), "v"(kf[0][2]), "v"(kf[0][3]), "v"(kf[1][0]), "v"(kf[1][1]), "v"(kf[1][2]), "v"(kf[1][3]) : "memory");
    f32x16 O[2]; O[0] = (f32x16){}; O[1] = (f32x16){};
    const int vaddr0 = ((lane >> 4) & 1) * 32 + (lane & 3) * 8 + (4 * h + ((lane & 15) >> 2)) * 64;
    bf16x8 va[2][4];
#pragma unroll
    for (int c = 0; c < 5; ++c) {
        const LAS unsigned char* buf = lds + ATT_VOFF + (s0 + c) * 4096;
        bf16x8 pf[2];
#pragma unroll
        for (int s = 0; s < 2; ++s) { u32x4 w; w.x = cvt_pk_bf16(S[c][8 * s + 0], S[c][8 * s + 1]); w.y = cvt_pk_bf16(S[c][8 * s + 2], S[c][8 * s + 3]);
            w.z = cvt_pk_bf16(S[c][8 * s + 4], S[c][8 * s + 5]); w.w = cvt_pk_bf16(S[c][8 * s + 6], S[c][8 * s + 7]); pf[s] = __builtin_bit_cast(bf16x8, w); }
#pragma unroll
        for (int blk = 0; blk < 2; ++blk)
#pragma unroll
            for (int s = 0; s < 2; ++s) {
                const s16x4 lo = tr_read(buf + blk * 2048 + (16 * s) * 64 + vaddr0), hi = tr_read(buf + blk * 2048 + (16 * s + 8) * 64 + vaddr0);
                va[c & 1][blk * 2 + s] = (bf16x8){lo[0], lo[1], lo[2], lo[3], hi[0], hi[1], hi[2], hi[3]}; }
        if (c > 0) asm volatile("" :: "v"(va[(c - 1) & 1][0]), "v"(va[(c - 1) & 1][1]), "v"(va[(c - 1) & 1][2]), "v"(va[(c - 1) & 1][3]) : "memory");
#pragma unroll
        for (int blk = 0; blk < 2; ++blk)
#pragma unroll
            for (int s = 0; s < 2; ++s) O[blk] = __builtin_amdgcn_mfma_f32_32x32x16_bf16(va[c & 1][blk * 2 + s], pf[s], O[blk], 0, 0, 0);
    }
    const float inv = 1.0f / l;
    LAS unsigned char* stg = lds + ATT_STG + wave * ATT_STGW;
    if (swa) {
        const float is = inv * SO;
#pragma unroll
        for (int blk = 0; blk < 2; ++blk)
#pragma unroll
            for (int g4 = 0; g4 < 4; ++g4) { const int d0 = blk * 32 + 8 * g4 + 4 * h;
                *(LAS unsigned*)(stg + i32 * 80 + d0) = f2e4m3_sw(O[blk][4 * g4 + 0] * is) | (f2e4m3_sw(O[blk][4 * g4 + 1] * is) << 8) | (f2e4m3_sw(O[blk][4 * g4 + 2] * is) << 16) | (f2e4m3_sw(O[blk][4 * g4 + 3] * is) << 24); }
        asm volatile("s_waitcnt lgkmcnt(0)" ::: "memory");
#pragma unroll
        for (int it = 0; it < 2; ++it) { const int row = it * 16 + (lane >> 2), ch = lane & 3;
            const u32x4 v = *(const LAS u32x4*)(stg + row * 80 + ch * 16);
            *(u32x4*)((char*)ob + (size_t)(32 * jq + row) * op + ch * 16) = v; }
    } else {
#pragma unroll
        for (int blk = 0; blk < 2; ++blk)
#pragma unroll
            for (int g4 = 0; g4 < 4; ++g4) { const int d0 = blk * 32 + 8 * g4 + 4 * h;
                u32x2 w; w.x = cvt_pk_bf16(O[blk][4 * g4 + 0] * inv, O[blk][4 * g4 + 1] * inv); w.y = cvt_pk_bf16(O[blk][4 * g4 + 2] * inv, O[blk][4 * g4 + 3] * inv);
                *(LAS u32x2*)(stg + i32 * 144 + d0 * 2) = w; }
        asm volatile("s_waitcnt lgkmcnt(0)" ::: "memory");
#pragma unroll
        for (int it = 0; it < 4; ++it) { const int row = it * 8 + (lane >> 3), ch = lane & 7;
            const u32x4 v = *(const LAS u32x4*)(stg + row * 144 + ch * 16);
            *(u32x4*)((char*)ob + (size_t)(32 * jq + row) * op + ch * 16) = v; }
    }
    asm volatile("" :: "v"(va[0][0]), "v"(va[0][1]), "v"(va[0][2]), "v"(va[0][3]), "v"(va[1][0]), "v"(va[1][1]), "v"(va[1][2]), "v"(va[1][3]) : "memory");
    if (lseb != nullptr && h == 0) lseb[(size_t)(32 * jq + i32) * lsep] = (m2 + __builtin_amdgcn_logf(l)) * LN2;
    asm volatile("s_waitcnt lgkmcnt(0)" ::: "memory");
    __builtin_amdgcn_s_barrier();
    asm volatile("" ::: "memory");
}
__device__ __forceinline__ void p2_attention(Frame& F, const float* sinks) {
    const unsigned char* HQ = F.ws + WS_HQ; unsigned char* OAB = F.dout + DO_OAB; bf16_t* OAG = (bf16_t*)(F.ws + WS_OAG); float* LSE = (float*)(F.ws + WS_LSE);
    constexpr int NUNIT = 2048 + 1536;
    const int per = (NUNIT + F.G - 1) / F.G;
    for (int ui = 0; ui < per; ++ui) {
        const int U = ui * F.G + F.vcu; if (U >= NUNIT) break;
        if (U < 2048) {
            const int b = U >> 8, kvh = (U >> 7) & 1, j = U & 127, hq = kvh * 8 + F.wave;
            const float slope = exp2f(-8.0f * (float)(hq + 1) / 28.0f);
            attn_unit(F.lds, F.lane, F.wave, HQ + HQ_QS + (size_t)(b * 16 + hq) * SEQ * 64, HQ + HQ_KS + (size_t)(b * 2 + kvh) * SEQ * 64, (const bf16_t*)(HQ + HQ_VS) + (size_t)(b * 2 + kvh) * SEQ * 64,
                      j - 4, 5, j, 0, slope * LOG2E, true, sinks[hq] * LOG2E, (bf16_t*)(OAB + (size_t)b * SEQ * OAB_P + 256 + hq * 64), OAB_P, nullptr, 0);
        } else {
            const int v = U - 2048, g = v >> 9, w_ = v & 511, b = w_ >> 6, x = w_ & 63, hh = x >> 4, y = x & 15;
            const int dil = (g == 0) ? 1 : (g == 1) ? 4 : 16;
            const int res = (g == 0) ? 0 : (g == 1) ? (y >> 2) : y;
            const int j0 = (g == 0) ? y * 8 : (g == 1) ? (y & 3) * 8 : 0;
            const size_t seq = ((size_t)((g * NB + b) * 4 + hh) * SEQ + (size_t)res * (SEQ / dil)) * 64;
            const size_t tok0 = (size_t)b * SEQ + res;
            const float slope = exp2f(-8.0f * (float)(16 + g * 4 + hh + 1) / 28.0f);
            attn_unit(F.lds, F.lane, F.wave, HQ + HQ_QD + seq, HQ + HQ_KD + seq, (const bf16_t*)(HQ + HQ_VD) + seq,
                      j0 - 4, 12, j0 + F.wave, F.wave, slope * (float)dil * LOG2E, false, NEG_BIG,
                      OAG + ((size_t)g * NTOK + tok0) * 256 + hh * 64, (unsigned)(dil * 256 * 2), LSE + ((size_t)g * NTOK + tok0) * 4 + hh, (unsigned)(dil * 4));
        }
    }
}
__device__ __forceinline__ void p3_merge(Frame& F) {
    const bf16_t* OAG = (const bf16_t*)(F.ws + WS_OAG); const float* LSE = (const float*)(F.ws + WS_LSE); unsigned char* OAB = F.dout + DO_OAB;
    const int gw = F.vcu * NWAVES + F.wave, NGW = F.G * NWAVES;
    for (int idx = gw; idx < NTOK / 2; idx += NGW) {
        const int tok = idx * 2 + (F.lane >> 5), c8 = F.lane & 31, hh = c8 >> 3;
        float ls[3]; u32x4 o[3];
#pragma unroll
        for (int g = 0; g < 3; ++g) { ls[g] = LSE[((size_t)g * NTOK + tok) * 4 + hh]; o[g] = *(const u32x4*)(OAG + ((size_t)g * NTOK + tok) * 256 + c8 * 8); }
        const float m = fmaxf(fmaxf(ls[0], ls[1]), ls[2]);
        float w[3]; float sum = 0.f;
#pragma unroll
        for (int g = 0; g < 3; ++g) { w[g] = __builtin_amdgcn_exp2f((ls[g] - m) * LOG2E); sum += w[g]; }
        const float is = 1.0f / sum; float r[8];
#pragma unroll
        for (int q = 0; q < 8; ++q) r[q] = 0.f;
#pragma unroll
        for (int g = 0; g < 3; ++g) { const float wg = w[g] * is;
            r[0] += wg * bf_lo(o[g].x); r[1] += wg * bf_hi(o[g].x); r[2] += wg * bf_lo(o[g].y); r[3] += wg * bf_hi(o[g].y);
            r[4] += wg * bf_lo(o[g].z); r[5] += wg * bf_hi(o[g].z); r[6] += wg * bf_lo(o[g].w); r[7] += wg * bf_hi(o[g].w); }
        u32x2 out; out.x = pk4_fp8(clamp_fp8(r[0] * SO), clamp_fp8(r[1] * SO), clamp_fp8(r[2] * SO), clamp_fp8(r[3] * SO)); out.y = pk4_fp8(clamp_fp8(r[4] * SO), clamp_fp8(r[5] * SO), clamp_fp8(r[6] * SO), clamp_fp8(r[7] * SO));
        *(u32x2*)(OAB + (size_t)tok * OAB_P + c8 * 8) = out;
    }
}

__device__ __forceinline__ void p6_router(Frame& F, const bf16_t* y, const float* stat, const float* gam, const float* bet, bf16_t* x1b, unsigned char* x1q, const float* rb, int cw_ecnt, size_t pe_off) {
    constexpr int WPITCH = 2064;
    constexpr int WIMG = 64 * WPITCH;
    constexpr int GOFF = WIMG + 2048;
    static_assert(GOFF + 8192 <= SCR_BYTES, "router LDS map");
    LAS int* wcnt = (LAS int*)(F.lds + WIMG + F.wave * 256); LAS int* wbase = wcnt + 32;
    int* petok = (int*)(F.ws + WS_PETOK + pe_off); float* pegate = (float*)(F.ws + WS_PEGATE + pe_off);
    const bf16_t* WRT = (const bf16_t*)(F.ws + WS_WRT);
    const int gw = F.vcu * NWAVES + F.wave, NGW = F.G * NWAVES, lane = F.lane, j = lane & 15, kq = lane >> 4;
    __syncthreads();
    for (int q = F.tid; q < 64 * 128; q += NWAVES * 64) { const u32x4 v = *(const u32x4*)((const char*)WRT + (size_t)q * 16); *(LAS u32x4*)(F.lds + (q >> 7) * WPITCH + (q & 127) * 16) = v; }
    for (int q = F.tid; q < 512; q += NWAVES * 64) { const f32x4 v = (q < 256) ? *(const f32x4*)(gam + q * 4) : *(const f32x4*)(bet + (q - 256) * 4); *(LAS f32x4*)(F.lds + GOFF + q * 16) = v; }
    __syncthreads();
    const LAS unsigned char* wrow = F.lds + j * WPITCH + kq * 16;
    const LAS float* gl = (const LAS float*)(F.lds + GOFF) + 8 * kq; const LAS float* bl = gl + 1024;
    for (int tb = F.vcu * NWAVES; tb < NTOK / 16; tb += NGW) {
        const int tt = tb + F.wave; const bool valid = tt < NTOK / 16; const int t0 = (valid ? tt : 0) * 16;
        float mean, rstd;
        { const f32x4* sp = (const f32x4*)(stat + (size_t)(t0 + j) * 32); float s1 = 0.f, s2 = 0.f;
#pragma unroll
          for (int q = 0; q < 8; ++q) { const f32x4 v = sp[q]; s1 += v[0] + v[2]; s2 += v[1] + v[3]; }
          mean = s1 * (1.0f / D); const float var = fmaxf(s2 * (1.0f / D) - mean * mean, 0.f); rstd = 1.0f / sqrtf(var + LN_EPS); }
        f32x4 acc[2]; acc[0] = (f32x4){0.f, 0.f, 0.f, 0.f}; acc[1] = acc[0];
        const bf16_t* yrow = y + (size_t)(t0 + j) * D + 8 * kq;
        bf16_t* xbrow = (valid ? x1b : (bf16_t*)(F.ws + 300 * MiB)) + (size_t)(t0 + j) * D + 8 * kq; unsigned char* xqrow = (valid ? x1q : F.ws + 300 * MiB) + (size_t)(t0 + j) * D + 8 * kq;
        bf16x8 wf[2][4]; wf[1][0] = (bf16x8){}; wf[1][1] = wf[1][0]; wf[1][2] = wf[1][0]; wf[1][3] = wf[1][0];
        u32x4 yv[4], yn[4];
#pragma unroll
        for (int u = 0; u < 4; ++u) yv[u] = *(const u32x4*)(yrow + 32 * u);
#pragma unroll 1
        for (int so = 0; so < D / 32; so += 4) {
            const int sn = (so + 4 < D / 32) ? so + 4 : so;
#pragma unroll
            for (int u = 0; u < 4; ++u) yn[u] = *(const u32x4*)(yrow + 32 * (sn + u));
#pragma unroll
            for (int u = 0; u < 4; ++u) { const int sI = so + u;
                wf[u & 1][0] = *(const LAS bf16x8*)(wrow + 64 * sI); wf[u & 1][1] = *(const LAS bf16x8*)(wrow + 16 * WPITCH + 64 * sI);
                wf[u & 1][2] = *(const LAS bf16x8*)(wrow + 32 * WPITCH + 64 * sI); wf[u & 1][3] = *(const LAS bf16x8*)(wrow + 48 * WPITCH + 64 * sI);
                const f32x4 g0 = *(const LAS f32x4*)(gl + 32 * sI), g1 = *(const LAS f32x4*)(gl + 32 * sI + 4), b0 = *(const LAS f32x4*)(bl + 32 * sI), b1 = *(const LAS f32x4*)(bl + 32 * sI + 4);
                asm volatile("" :: "v"(wf[(u + 1) & 1][0]), "v"(wf[(u + 1) & 1][1]), "v"(wf[(u + 1) & 1][2]), "v"(wf[(u + 1) & 1][3]) : "memory");
                f32x4 n0, n1;
                n0[0] = (bf_lo(yv[u].x) - mean) * rstd * g0[0] + b0[0]; n0[1] = (bf_hi(yv[u].x) - mean) * rstd * g0[1] + b0[1]; n0[2] = (bf_lo(yv[u].y) - mean) * rstd * g0[2] + b0[2]; n0[3] = (bf_hi(yv[u].y) - mean) * rstd * g0[3] + b0[3];
                n1[0] = (bf_lo(yv[u].z) - mean) * rstd * g1[0] + b1[0]; n1[1] = (bf_hi(yv[u].z) - mean) * rstd * g1[1] + b1[1]; n1[2] = (bf_lo(yv[u].w) - mean) * rstd * g1[2] + b1[2]; n1[3] = (bf_hi(yv[u].w) - mean) * rstd * g1[3] + b1[3];
                u32x4 xw; xw.x = cvt_pk_bf16(n0[0], n0[1]); xw.y = cvt_pk_bf16(n0[2], n0[3]); xw.z = cvt_pk_bf16(n1[0], n1[1]); xw.w = cvt_pk_bf16(n1[2], n1[3]);
                *(u32x4*)(xbrow + 32 * sI) = xw;
                { u32x2 q8; q8.x = pk4_fp8(clamp_fp8(n0[0] * SX), clamp_fp8(n0[1] * SX), clamp_fp8(n0[2] * SX), clamp_fp8(n0[3] * SX)); q8.y = pk4_fp8(clamp_fp8(n1[0] * SX), clamp_fp8(n1[1] * SX), clamp_fp8(n1[2] * SX), clamp_fp8(n1[3] * SX));
                  *(u32x2*)(xqrow + 32 * sI) = q8; }
                const bf16x8 xh = __builtin_bit_cast(bf16x8, xw);
                acc[0] = __builtin_amdgcn_mfma_f32_16x16x32_bf16(wf[u & 1][0], xh, acc[0], 0, 0, 0); acc[1] = __builtin_amdgcn_mfma_f32_16x16x32_bf16(wf[u & 1][1], xh, acc[1], 0, 0, 0);
                acc[0] = __builtin_amdgcn_mfma_f32_16x16x32_bf16(wf[u & 1][2], xh, acc[0], 0, 0, 0); acc[1] = __builtin_amdgcn_mfma_f32_16x16x32_bf16(wf[u & 1][3], xh, acc[1], 0, 0, 0); }
#pragma unroll
            for (int u = 0; u < 4; ++u) yv[u] = yn[u];
        }
        float lg[8];
#pragma unroll
        for (int q = 0; q < 8; ++q) lg[q] = acc[q >> 2][q & 3] + rb[16 * (q >> 2) + 4 * kq + (q & 3)];
        unsigned taken = 0u; float tv[4]; int ti[4];
#pragma unroll
        for (int k = 0; k < 4; ++k) {
            float bv = -3.0e38f; int bi = 64;
#pragma unroll
            for (int q = 0; q < 8; ++q) { const bool free_ = ((taken >> q) & 1u) == 0u; if (free_ && lg[q] > bv) { bv = lg[q]; bi = 16 * (q >> 2) + 4 * kq + (q & 3); } }
            const int mybi = bi;
#pragma unroll
            for (int o = 16; o < 64; o <<= 1) { const float ov = __shfl_xor(bv, o); const int oi = __shfl_xor(bi, o); const bool keep = (bv > ov) || (bv == ov && bi < oi); bv = keep ? bv : ov; bi = keep ? bi : oi; }
            tv[k] = bv; ti[k] = bi;
            if (bi == mybi && ((bi >> 2) & 3) == kq) taken |= 1u << (4 * (bi >> 4) + (bi & 3));
        }
        float gk[4]; float gs = 0.f;
#pragma unroll
        for (int k = 0; k < 4; ++k) { gk[k] = __builtin_amdgcn_exp2f((tv[k] - tv[0]) * LOG2E); gs += gk[k]; }
        const float gi = 1.0f / gs;
        if (lane < 32) wcnt[lane] = 0;
        asm volatile("s_waitcnt lgkmcnt(0)" ::: "memory");
        const int e0 = (kq == 0) ? ti[0] : (kq == 1) ? ti[1] : (kq == 2) ? ti[2] : ti[3];
        const float g0 = ((kq == 0) ? gk[0] : (kq == 1) ? gk[1] : (kq == 2) ? gk[2] : gk[3]) * gi;
        int r0 = 0;
        if (valid) r0 = __hip_atomic_fetch_add(wcnt + e0, 1, __ATOMIC_RELAXED, __HIP_MEMORY_SCOPE_WORKGROUP);
        asm volatile("s_waitcnt lgkmcnt(0)" ::: "memory");
        __syncthreads();
        if (F.wave == 0 && lane < 32) { int c[NWAVES]; int tot = 0;
#pragma unroll
            for (int w = 0; w < NWAVES; ++w) { c[w] = *(LAS int*)(F.lds + WIMG + w * 256 + 4 * lane); tot += c[w]; }
            int b = 0; if (tot > 0) b = (int)__hip_atomic_fetch_add((unsigned*)(F.ctl + cw_ecnt + 64 * lane), (unsigned)tot, RLX_AGENT);
#pragma unroll
            for (int w = 0; w < NWAVES; ++w) { *(LAS int*)(F.lds + WIMG + w * 256 + 128 + 4 * lane) = b; b += c[w]; } }
        asm volatile("s_waitcnt vmcnt(0) lgkmcnt(0)" ::: "memory");
        __syncthreads();
        if (valid) { const int p0 = wbase[e0] + r0;
            petok[(size_t)e0 * NTOK + p0] = (t0 + j) * 4 + kq; pegate[(size_t)e0 * NTOK + p0] = g0; }
        asm volatile("s_waitcnt lgkmcnt(0)" ::: "memory");
        __syncthreads();
    }
}
__device__ __forceinline__ int moe_tables(Frame& F) {
    LAS int* cnt = (LAS int*)(F.lds + MOE_OFF); LAS int* fs = (LAS int*)(F.lds + MOE_OFF + 128); LAS unsigned char* te = F.lds + MOE_OFF + 128 + 136;
    __syncthreads();
    if (F.tid < NEXP) cnt[F.tid] = (int)__hip_atomic_load(F.ctl + CW_ECNT + 64 * F.tid, RLX_AGENT);
    __syncthreads();
    if (F.tid == 0) { int s = 0; for (int e = 0; e < NEXP; ++e) { fs[e] = s; s += (cnt[e] + 255) >> 8; } fs[NEXP] = s; }
    __syncthreads();
    const int T = fs[NEXP];
    for (int t = F.tid; t < T; t += NWAVES * 64) { int e = 0;
#pragma unroll 8
        for (int q = 1; q < NEXP; ++q) e += (fs[q] <= t) ? 1 : 0;
        te[t] = (unsigned char)e; }
    __syncthreads();
    return T;
}
__device__ __forceinline__ void p9_final(Frame& F, const float* gam, const float* bet, const float* out, float* outw, bool poison) {
    const bf16_t* X1B = (const bf16_t*)(F.ws + WS_X1B);
    const int gw = F.vcu * NWAVES + F.wave, NGW = F.G * NWAVES, lane = F.lane;
    const float qnan = __builtin_nanf("");
    const f32x4 g0 = *(const f32x4*)(gam + lane * 16), g1 = *(const f32x4*)(gam + lane * 16 + 4), g2 = *(const f32x4*)(gam + lane * 16 + 8), g3 = *(const f32x4*)(gam + lane * 16 + 12);
    const f32x4 b0 = *(const f32x4*)(bet + lane * 16), b1 = *(const f32x4*)(bet + lane * 16 + 4), b2 = *(const f32x4*)(bet + lane * 16 + 8), b3 = *(const f32x4*)(bet + lane * 16 + 12);
    for (int tok0 = gw; tok0 < NTOK; tok0 += 2 * NGW) {
        u32x4 xa[2], xb[2], y0[2], y1[2], y2[2], y3[2];
#pragma unroll
        for (int tI = 0; tI < 2; ++tI) { const int tok = min(tok0 + tI * NGW, NTOK - 1);
            const unsigned char* y = (const unsigned char*)out + (size_t)tok * 4096 + lane * 16;
            xa[tI] = *(const u32x4*)(X1B + (size_t)tok * D + lane * 16); xb[tI] = *(const u32x4*)(X1B + (size_t)tok * D + lane * 16 + 8);
            y0[tI] = *(const u32x4*)(y); y1[tI] = *(const u32x4*)(y + 1024); y2[tI] = *(const u32x4*)(y + 2048); y3[tI] = *(const u32x4*)(y + 3072); }
#pragma unroll
        for (int tI = 0; tI < 2; ++tI) { const int tok = tok0 + tI * NGW; if (tok >= NTOK) break;
            float v[16];
#pragma unroll
            for (int w = 0; w < 4; ++w) { const unsigned xw = (w < 2) ? xa[tI][2 * w] : xb[tI][2 * (w - 2)], xw2 = (w < 2) ? xa[tI][2 * w + 1] : xb[tI][2 * (w - 2) + 1];
                v[4 * w + 0] = DN_ALPHA * bf_lo(xw); v[4 * w + 1] = DN_ALPHA * bf_hi(xw); v[4 * w + 2] = DN_ALPHA * bf_lo(xw2); v[4 * w + 3] = DN_ALPHA * bf_hi(xw2);
                f32x2 lo = __builtin_amdgcn_cvt_pk_f32_fp8((int)y0[tI][w], false) + __builtin_amdgcn_cvt_pk_f32_fp8((int)y1[tI][w], false) + __builtin_amdgcn_cvt_pk_f32_fp8((int)y2[tI][w], false) + __builtin_amdgcn_cvt_pk_f32_fp8((int)y3[tI][w], false);
                f32x2 hi = __builtin_amdgcn_cvt_pk_f32_fp8((int)y0[tI][w], true) + __builtin_amdgcn_cvt_pk_f32_fp8((int)y1[tI][w], true) + __builtin_amdgcn_cvt_pk_f32_fp8((int)y2[tI][w], true) + __builtin_amdgcn_cvt_pk_f32_fp8((int)y3[tI][w], true);
                v[4 * w + 0] += lo[0] * (1.0f / SY); v[4 * w + 1] += lo[1] * (1.0f / SY); v[4 * w + 2] += hi[0] * (1.0f / SY); v[4 * w + 3] += hi[1] * (1.0f / SY); }
            float s = 0.f;
#pragma unroll
            for (int q = 0; q < 16; ++q) s += v[q];
            const float mean = wave_sum(s) * (1.0f / D); float s2 = 0.f;
#pragma unroll
            for (int q = 0; q < 16; ++q) { v[q] -= mean; s2 += v[q] * v[q]; }
            const float rstd = 1.0f / sqrtf(wave_sum(s2) * (1.0f / D) + LN_EPS);
            f32x4 o0, o1, o2, o3;
#pragma unroll
            for (int q = 0; q < 4; ++q) { o0[q] = v[q] * rstd * g0[q] + b0[q]; o1[q] = v[4 + q] * rstd * g1[q] + b1[q]; o2[q] = v[8 + q] * rstd * g2[q] + b2[q]; o3[q] = v[12 + q] * rstd * g3[q] + b3[q]; }
            if (poison) { o0 = (f32x4){qnan, qnan, qnan, qnan}; o1 = o0; o2 = o0; o3 = o0; }
            float* op = outw + (size_t)tok * D + lane * 16;
            *(f32x4*)(op) = o0; *(f32x4*)(op + 4) = o1; *(f32x4*)(op + 8) = o2; *(f32x4*)(op + 12) = o3; }
    }
}
#define CAS __attribute__((address_space(4)))
__device__ __forceinline__ const float* arg_in(int i) {
    const unsigned char CAS* ka = (const unsigned char CAS*)__builtin_amdgcn_kernarg_segment_ptr();
    asm volatile("" : "+s"(ka));
    return *(const float* const CAS*)(ka + 8 * i);
}
struct Args { const float* in[18]; float* out; unsigned char* ws; int ph_lo, ph_hi; };
__global__ void __launch_bounds__(NWAVES * 64, 2) fwd_kernel(Args args) {
    extern __shared__ __attribute__((aligned(16))) unsigned char lds[];
    Frame F;
    F.lds = (LAS unsigned char*)lds;
    F.MISC = (volatile LAS unsigned*)(F.lds + MISC_OFF);
    F.tid = threadIdx.x; F.lane = F.tid & 63; F.wave = __builtin_amdgcn_readfirstlane(F.tid >> 6);
    F.G = gridDim.x; { const int bx = blockIdx.x; F.vcu = (F.G % 8 == 0) ? (bx % 8) * (F.G / 8) + bx / 8 : bx; }
    F.ws = args.ws; F.dout = (unsigned char*)args.out;
    F.ctl = (gu32*)(args.ws + WS_CTL);
    for (int u = F.tid; u < (LDS_BYTES - LDSCTL_OFF) / 4; u += NWAVES * 64) ((LAS unsigned*)(F.lds + LDSCTL_OFF))[u] = 0u;
    __syncthreads();
    XcdBarrier bar; bar.bar = (unsigned*)(F.ctl + CW_BAR); bar.x = 0; bar.st = nullptr;
    if (N_LAUNCHES == 1) bar = xcd_barrier_post((unsigned*)(F.ctl + CW_BAR), F.MISC + 8);
    const int lo = args.ph_lo, hi = args.ph_hi;
#ifdef ONLY_PHASE
#define IN(k) ((k) == ONLY_PHASE && lo <= (k) && (k) < hi)
#else
#define IN(k) (lo <= (k) && (k) < hi)
#endif
#define SEAM(k) do { if (IN(k) && IN((k) + 1)) xcd_barrier(bar); } while (0)
    unsigned char* HQ = F.ws + WS_HQ; unsigned char* SG = F.ws + WS_SG;

#define PHASE(k, ...) do { if (IN(k)) { __VA_ARGS__ if (DUP_PHASE == (k)) { __VA_ARGS__ } } } while (0)
    PHASE(0, p0_convert(F, arg_in(0), arg_in(1), arg_in(3), arg_in(4), arg_in(5), arg_in(8));); SEAM(0);
    PHASE(1,
        { const int gemm_wgs = (F.G == 256) ? 192 : F.G;
          if ((int)blockIdx.x < gemm_wgs) {
            pg8::Gemm g{(const char*)(F.dout + DO_XB), (const char*)(F.dout + DO_WIN), D, D, D / 128}; pg8::StaticOrder S; S.init(NTOK, IN_COLS, gemm_wgs, (int)blockIdx.x);
            pg8::EpiInProj E{HQ, SG, 1.0f / (SXIN * SW)};
            pg8::gemm_phase<pg8::EpiInProj, pg8::StaticOrder, true, false, true>(F.lds, g, S, E); }
          if (gemm_wgs == F.G) p3_convert_moe(F, arg_in(10), arg_in(12), arg_in(14), F.vcu, F.G);
          else if ((int)blockIdx.x >= gemm_wgs) p3_convert_moe(F, arg_in(10), arg_in(12), arg_in(14), (int)blockIdx.x - gemm_wgs, F.G - gemm_wgs); }
    ); SEAM(1);
    PHASE(2, p2_attention(F, arg_in(2));); SEAM(2);
    PHASE(3, p3_merge(F);); SEAM(3);
    PHASE(4,
        { pg8::Gemm g{(const char*)(F.dout + DO_OAB), (const char*)(F.dout + DO_WCAT), OAB_P, OAB_P, OAB_P / 128}; pg8::StaticOrder S; S.init(NTOK, D, F.G, (int)blockIdx.x);
        pg8::EpiGate E{SG, F.ws + WS_MRG};
        pg8::gemm_phase<pg8::EpiGate, pg8::StaticOrder, true, false, true>(F.lds, g, S, E); }
    ); SEAM(4);
    PHASE(5,
        { pg8::Gemm g{(const char*)(F.ws + WS_MRG), (const char*)(F.ws + WS_WOUT), D, D, D / 128}; pg8::StaticOrder S; S.init(NTOK, D, F.G, (int)blockIdx.x);
        pg8::EpiY E{arg_in(0), (bf16_t*)(F.ws + WS_Y), (float*)(F.ws + WS_STAT), 1.0f / (SM * SW)};
        pg8::gemm_phase<pg8::EpiY, pg8::StaticOrder, true, false, true>(F.lds, g, S, E); }
    ); SEAM(5);
    if (IN(6)) { if (DUP_PHASE == 6) p6_router(F, (const bf16_t*)(F.ws + WS_Y), (const float*)(F.ws + WS_STAT), arg_in(6), arg_in(7), (bf16_t*)(F.ws + 264 * MiB), F.ws + 330 * MiB, arg_in(9), CW_ECNT + 64 * NEXP, (size_t)362 * MiB - WS_PETOK);
        p6_router(F, (const bf16_t*)(F.ws + WS_Y), (const float*)(F.ws + WS_STAT), arg_in(6), arg_in(7), (bf16_t*)(F.ws + WS_X1B), F.ws + WS_X1Q, arg_in(9), CW_ECNT, 0); } SEAM(6);
    PHASE(7,
        { const int T = moe_tables(F);
        pg8::Gemm g{(const char*)(F.ws + WS_X1Q), (const char*)(F.ws + WS_WGU), D, D, D / 128};
        pg8::MoeOrder S{T, 8, F.G, (int)blockIdx.x, (const LAS int*)(F.lds + MOE_OFF), (const LAS int*)(F.lds + MOE_OFF + 128), (const LAS unsigned char*)(F.lds + MOE_OFF + 128 + 136),
                        (const int*)(F.ws + WS_PETOK), (size_t)2048 * D, true, (unsigned)D};
        pg8::EpiGU E{arg_in(11), arg_in(13), F.ws + WS_HDN};
        pg8::gemm_phase<pg8::EpiGU, pg8::MoeOrder, true, true, true>(F.lds, g, S, E); }
    ); SEAM(7);
    PHASE(8,
        { const int T = moe_tables(F);
        pg8::Gemm g{(const char*)(F.ws + WS_HDN), (const char*)(F.ws + WS_WD), DFF, DFF, DFF / 128};
        pg8::MoeOrder S{T, 4, F.G, (int)blockIdx.x, (const LAS int*)(F.lds + MOE_OFF), (const LAS int*)(F.lds + MOE_OFF + 128), (const LAS unsigned char*)(F.lds + MOE_OFF + 128 + 136),
                        (const int*)(F.ws + WS_PETOK), (size_t)D * DFF, false, 0u};
        pg8::EpiDown E{arg_in(15), (const int*)(F.ws + WS_PETOK), (const float*)(F.ws + WS_PEGATE), F.dout};
        pg8::gemm_phase<pg8::EpiDown, pg8::MoeOrder, true, false, true>(F.lds, g, S, E); }
    ); SEAM(8);
    if (IN(9)) {
        bool poison = (__hip_atomic_load(F.ctl + CW_TMO, RLX_AGENT) != 0u) || (__hip_atomic_load(F.ctl + CW_BAR + XB_TMO, RLX_AGENT) != 0u);
        if (DUP_PHASE == 9) p9_final(F, arg_in(16), arg_in(17), (const float*)F.dout, (float*)(F.ws + 194 * MiB), poison);
        p9_final(F, arg_in(16), arg_in(17), (const float*)F.dout, (float*)F.dout, poison);
    }
#undef PHASE
#undef IN
#undef SEAM
}

extern "C" void kernel_launch(void* const* d_in, const int* in_sizes, int n_in, void* d_out, int out_size, void* d_ws, size_t ws_size, hipStream_t stream) {
    static int grid = 0;
    if (grid == 0) {
        if (n_in != 18 || in_sizes[0] != NTOK * D || out_size != NTOK * D || ws_size < WS_END) { fprintf(stderr, "kernel_launch: unexpected shapes (n_in %d, ws %zu); nothing launched\n", n_in, ws_size); grid = -1; return; }
        int dev = 0, cus = 0, per_cu = 0;
        if (hipGetDevice(&dev) != hipSuccess || hipDeviceGetAttribute(&cus, hipDeviceAttributeMultiprocessorCount, dev) != hipSuccess) { grid = -1; return; }
        if (hipFuncSetAttribute((const void*)fwd_kernel, hipFuncAttributeMaxDynamicSharedMemorySize, LDS_BYTES) != hipSuccess) { fprintf(stderr, "kernel_launch: hipFuncSetAttribute failed\n"); grid = -1; return; }
        if (hipOccupancyMaxActiveBlocksPerMultiprocessor(&per_cu, (const void*)fwd_kernel, NWAVES * 64, LDS_BYTES) != hipSuccess || per_cu < 1) fprintf(stderr, "kernel_launch: occupancy query reports %d\n", per_cu);
        (void)hipGetLastError();
        grid = cus;
    }
    if (grid < 0) return;
    if (hipMemsetAsync((char*)d_ws + WS_CTL, 0, CTL_ZERO_BYTES, stream) != hipSuccess) return;
    Args a{};
    for (int i = 0; i < 18; ++i) a.in[i] = (const float*)d_in[i];
    a.out = (float*)d_out; a.ws = (unsigned char*)d_ws;
    if (N_LAUNCHES == 1) { a.ph_lo = 0; a.ph_hi = N_PHASES; hipLaunchKernelGGL(fwd_kernel, dim3(grid), dim3(NWAVES * 64), LDS_BYTES, stream, a); }
    else for (int p = 0; p < N_PHASES; ++p) { a.ph_lo = p; a.ph_hi = p + 1; hipLaunchKernelGGL(fwd_kernel, dim3(grid), dim3(NWAVES * 64), LDS_BYTES, stream, a); }
}
```

```cpp
#include <hip/hip_runtime.h>
#include <cstdio>
#include <cstdint>

#define GAS __attribute__((address_space(1)))
#define LAS __attribute__((address_space(3)))
typedef unsigned short bf16_t;
typedef short bf16x8 __attribute__((ext_vector_type(8)));
typedef short s16x4 __attribute__((ext_vector_type(4)));
typedef float f32x2 __attribute__((ext_vector_type(2)));
typedef float f32x4 __attribute__((ext_vector_type(4)));
typedef float f32x16 __attribute__((ext_vector_type(16)));
typedef unsigned u32x2 __attribute__((ext_vector_type(2)));
typedef unsigned u32x4 __attribute__((ext_vector_type(4)));
typedef GAS unsigned gu32;

#ifndef MK_N_LAUNCHES
#define MK_N_LAUNCHES 1
#endif
#ifndef DUP_PHASE
#define DUP_PHASE -1
#endif
constexpr int N_PHASES = 10;
constexpr int N_LAUNCHES = MK_N_LAUNCHES;

constexpr int NB = 8, SEQ = 4096, D = 1024, NTOK = NB * SEQ;
constexpr int HQ_P = 3584;
constexpr int SG_P = 2048;
constexpr int OAB_P = 1280;
constexpr int IN_COLS = 5632;
constexpr int NEXP = 32, TOPK = 4, DFF = 1024;
constexpr int MAX_MT = 544;
constexpr float LN_EPS = 1e-5f;
constexpr float DN_ALPHA = 1.189207115002721f;
constexpr float LOG2E = 1.4426950408889634f, LN2 = 0.6931471805599453f;
constexpr float QSCALE = 0.125f * LOG2E;
constexpr float NEG_BIG = -1e30f;

constexpr size_t MiB = 1u << 20;
constexpr size_t WS_CTL = 0, CTL_ZERO_BYTES = 1 * MiB;
constexpr size_t WS_XBUF = 1 * MiB;
constexpr size_t WS_Y = 194 * MiB;
constexpr size_t WS_STAT = 258 * MiB;
constexpr size_t WS_HQ = 2 * MiB;
constexpr size_t HQ_QD = 0, HQ_KD = 48 * MiB, HQ_VD = 96 * MiB, HQ_QS = 144 * MiB, HQ_KS = 208 * MiB, HQ_VS = 216 * MiB;
constexpr size_t WS_WGU = 404 * MiB;
constexpr size_t WS_WD = 468 * MiB;
constexpr size_t WS_X1B = 98 * MiB;
constexpr size_t WS_X1Q = 162 * MiB;
constexpr size_t WS_HDN = 194 * MiB;
constexpr size_t WS_SG = 226 * MiB;
constexpr size_t WS_YS23 = 330 * MiB;
constexpr size_t WS_OAG = 354 * MiB;
constexpr size_t WS_LSE = 402 * MiB;
constexpr size_t WS_MRG = 2 * MiB;
constexpr size_t WS_WOUT = 530 * MiB;
constexpr size_t WS_PETOK = 532 * MiB;
constexpr size_t WS_PEGATE = 536 * MiB;
constexpr size_t WS_WRT = 540 * MiB;
constexpr size_t WS_END = 540 * MiB + 256 * 1024;
constexpr float SX = 8.0f, SW = 512.0f, SH = 4.0f, SXIN = 8.0f, SY = 64.0f, SM = 64.0f, SO = 64.0f, SSG = 256.0f, SQ = 64.0f, SK = 16.0f;
static_assert(WS_HQ + (size_t)NTOK * HQ_P * 2 <= WS_SG && WS_SG + (size_t)NTOK * SG_P <= WS_OAG && WS_OAG + (size_t)3 * NTOK * 256 * 2 <= WS_LSE && WS_LSE + (size_t)3 * NTOK * 4 * 4 <= WS_WGU, "ws map 1");
static_assert(WS_WGU + (size_t)NEXP * 2048 * D <= WS_WD && WS_WD + (size_t)NEXP * D * DFF <= WS_WOUT && WS_MRG + (size_t)NTOK * D <= WS_X1B && WS_X1B + (size_t)NTOK * D * 2 <= WS_X1Q && WS_X1Q + (size_t)NTOK * D <= WS_HDN, "ws map 2");
static_assert(WS_HDN + (size_t)MAX_MT * 256 * DFF <= WS_OAG && WS_WOUT + (size_t)D * D <= WS_PETOK, "ws map 3");
constexpr size_t DO_XB = 0;
constexpr size_t DO_OAB = 0;
constexpr size_t DO_WIN = 96 * MiB;
constexpr size_t DO_WCAT = 108 * MiB;
constexpr int CW_TMO = 0, CW_CODE = 1;
constexpr int CW_BAR = 4096;
constexpr int CW_SEAM = 16384;
constexpr int CW_ECNT = 32768;
static_assert((CW_ECNT + 2 * 64 * NEXP) * 4 <= (int)CTL_ZERO_BYTES, "CTL words inside the memset region");

constexpr int RING_BYTES = 131072;
constexpr int SCR_BYTES = 143360;
constexpr int LDSCTL_OFF = SCR_BYTES;
constexpr int MISC_OFF = LDSCTL_OFF + 320;
constexpr int MOE_OFF = LDSCTL_OFF + 512;
constexpr int LDS_BYTES = 147456;
static_assert(MOE_OFF + 128 + 136 + MAX_MT <= LDS_BYTES, "LDS map");

#define RLX_AGENT __ATOMIC_RELAXED, __HIP_MEMORY_SCOPE_AGENT
#define LDS_WAIT() asm volatile("s_waitcnt lgkmcnt(0)" ::: "memory")
#define VM_WAIT() asm volatile("s_waitcnt vmcnt(0)" ::: "memory")

__device__ __forceinline__ unsigned cvt_pk_bf16(float lo, float hi) { unsigned r; asm volatile("v_cvt_pk_bf16_f32 %0, %1, %2" : "=v"(r) : "v"(lo), "v"(hi)); return r; }
__device__ __forceinline__ int opaque(int v) { asm volatile("" : "+v"(v)); return v; }
__device__ __forceinline__ unsigned pk4_fp8(float a, float b, float c, float d) { int w = 0; w = __builtin_amdgcn_cvt_pk_fp8_f32(a, b, w, false); w = __builtin_amdgcn_cvt_pk_fp8_f32(c, d, w, true); return (unsigned)w; }
__device__ __forceinline__ unsigned f2e4m3_sw(float x) { const unsigned u = __float_as_uint(x); const unsigned sg = (u >> 24) & 0x80u; const float a = fminf(fabsf(x), 448.f); unsigned r;
  if (a < 0.015625f) r = (unsigned)__builtin_rintf(a * 512.f); else { unsigned v = __float_as_uint(a); v += 0x7FFFFu + ((v >> 20) & 1u); r = (v >> 20) - (120u << 3); } return sg | r; }
__device__ __forceinline__ float clamp_fp8(float v) { return __builtin_amdgcn_fmed3f(v, -448.0f, 448.0f); }
__device__ __forceinline__ float bf_lo(unsigned w) { return __uint_as_float(w << 16); }
__device__ __forceinline__ float bf_hi(unsigned w) { return __uint_as_float(w & 0xffff0000u); }
__device__ __forceinline__ float fast_sigmoid(float g) { g = fminf(fmaxf(g, -60.f), 60.f); return __builtin_amdgcn_rcpf(1.0f + __builtin_amdgcn_exp2f(-g * LOG2E)); }

namespace pg8 {
constexpr int BM = 256, BK = 64, HALF = 128, HTB = HALF * BK * 2, STAGE_BYTES = 8 * HTB, NXCD = 8, WGM = 8;
__host__ __device__ __forceinline__ int lds_byte(int r, int c) { const int st = (r >> 4) * 2 + (c >> 5), rr = r & 15, cc = c & 31, ob = rr * 64 + cc * 2; return st * 1024 + (ob ^ (((ob >> 9) & 1) << 5)); }
__host__ __device__ __forceinline__ void stage_rc(int b, int& R, int& C) { const int st = b / 1024, sb = b % 1024, swz = sb ^ (((sb >> 9) & 1) << 5); R = (st >> 1) * 16 + swz / 64; C = (st & 1) * 32 + (swz % 64) / 2; }
__host__ __device__ __forceinline__ int perm32(int rho) { const int n = rho >> 4, i = rho & 15; return 8 * (i >> 2) + 4 * n + (i & 3); }

struct Unit { int pm, pn, e, ti, valid; };
struct Gemm { const char* A; const char* Bt; int lda, ldb, nt; };

__device__ __forceinline__ bool tile_of(long L, int nM, int nN, int& pm, int& pn) {
    const int nwg = nM * nN; if (L >= nwg) return false;
    int wgid = (int)L; { const int q = nwg / NXCD, r = nwg % NXCD, xcd = wgid % NXCD, off = wgid / NXCD; wgid = (xcd < r ? xcd * (q + 1) : r * (q + 1) + (xcd - r) * q) + off; }
    const int nig = WGM * nN, gid = wgid / nig, fm = gid * WGM, gsz = (nM - fm) < WGM ? (nM - fm) : WGM;
    pm = fm + ((wgid % nig) % gsz); pn = (wgid % nig) / gsz; return true;
}
struct StaticOrder {
    int nM, nN, G, c;
    __device__ __forceinline__ void init(int M, int N, int G_, int c_) { nM = M / BM; nN = N / BM; G = G_; c = c_; }
    __device__ __forceinline__ bool next(int i, Unit& u) const { u.e = 0; u.ti = 0; u.valid = 256; return tile_of((long)i * G + c, nM, nN, u.pm, u.pn); }
    __device__ __forceinline__ const char* a_ptr(const Gemm& g, const Unit& u) const { return g.A + (size_t)u.pm * 256 * g.lda; }
    __device__ __forceinline__ const char* b_ptr(const Gemm& g, const Unit& u) const { return g.Bt + (size_t)u.pn * 256 * g.ldb; }
    __device__ __forceinline__ unsigned row_off(const Unit&, int) const { return 0u; }
};
struct MoeOrder {
    int T, nN, G, c; const LAS int* cnt; const LAS int* fs; const LAS unsigned char* te;
    const int* petok; size_t b_exp_stride; bool gather; unsigned rowbytes;
    __device__ __forceinline__ bool next(int i, Unit& u) const {
        if (!tile_of((long)i * G + c, T, nN, u.pm, u.pn)) return false;
        u.e = __builtin_amdgcn_readfirstlane((int)te[u.pm]); u.ti = u.pm - __builtin_amdgcn_readfirstlane(fs[u.e]); const int left = __builtin_amdgcn_readfirstlane(cnt[u.e]) - u.ti * 256; u.valid = left < 256 ? left : 256; return true;
    }
    __device__ __forceinline__ const char* a_ptr(const Gemm& g, const Unit& u) const { return gather ? g.A : g.A + (size_t)u.pm * 256 * g.lda; }
    __device__ __forceinline__ const char* b_ptr(const Gemm& g, const Unit& u) const { return g.Bt + (size_t)u.e * b_exp_stride + (size_t)u.pn * 256 * g.ldb; }
    __device__ __forceinline__ unsigned row_off(const Unit& u, int R) const {
        int tok = 0; if (R < u.valid) tok = petok[(size_t)u.e * NTOK + u.ti * 256 + R] >> 2;
        return (unsigned)tok * rowbytes;
    }
};

typedef int v8i32 __attribute__((ext_vector_type(8)));
template <class Epi, class Sched, bool ALIGN_EPI, bool GATHER, bool F8 = false>
__device__ __forceinline__ void gemm_phase(LAS unsigned char* lds, const Gemm g, const Sched& S, const Epi& E) {
    const int tid = threadIdx.x, wid = __builtin_amdgcn_readfirstlane(tid >> 6), lane = tid & 63, wr = wid >> 2, wc = wid & 3, fr = lane & 15, fq = lane >> 4;
    const int nt = g.nt;
    unsigned voffA[2], voffB[2]; int RA[2], CA2[2];
#pragma unroll
    for (int i = 0; i < 2; ++i) { int R, C; stage_rc(tid * 16 + i * 8192, R, C); const int Rb = Epi::PERM ? ((R & ~31) + perm32(R & 31)) : R;
        voffA[i] = (unsigned)(R * g.lda + C * 2); voffB[i] = (unsigned)(Rb * g.ldb + C * 2); RA[i] = R; CA2[i] = C * 2; }
    const size_t kstep = (size_t)(BK * 2);
    const size_t hstepA = (size_t)HALF * g.lda, hstepB = (size_t)HALF * g.ldb;
    const unsigned ldsw = (unsigned)wid * 1024u;
    const int aoff = lds_byte(wr * 64 + fr, fq * 8), boff = lds_byte(wc * 32 + fr, fq * 8);
    const int aoff0 = aoff, boff0 = boff, aoff1 = aoff + 1024, boff1 = boff + 1024;
#define PG8_SA(b, h) (((b) * 2 + (h)) * HTB)
#define PG8_SB(b, h) ((4 + (b) * 2 + (h)) * HTB)
#define PG8_STAGE(bufoff, gbase, voff) do { _Pragma("unroll") for (int _i = 0; _i < 2; ++_i) \
        __builtin_amdgcn_global_load_lds((const unsigned*)((const char*)(gbase) + (voff)[_i]), (LAS unsigned*)(lds + (bufoff) + ldsw + _i * 8192), 16, 0, 0); } while (0)
#define PG8_STAGE_A(bufoff, kp, h, nx) do { if constexpr (GATHER) { unsigned _v[2]; _v[0] = (nx) ? gN[h][0] : gC[h][0]; _v[1] = (nx) ? gN[h][1] : gC[h][1]; PG8_STAGE(bufoff, kp, _v); } \
        else { PG8_STAGE(bufoff, (kp) + (h) * hstepA, voffA); } } while (0)
#define PG8_LDA(dst, b, h) do { _Pragma("unroll") for (int m = 0; m < 4; ++m) _Pragma("unroll") for (int k = 0; k < 2; ++k) dst[m][k] = *(const LAS bf16x8*)(lds + PG8_SA(b, h) + (k ? aoff1 : aoff0) + m * 2048); } while (0)
#define PG8_LDB(dst, b, h) do { _Pragma("unroll") for (int n = 0; n < 2; ++n) _Pragma("unroll") for (int k = 0; k < 2; ++k) dst[n][k] = *(const LAS bf16x8*)(lds + PG8_SB(b, h) + (k ? boff1 : boff0) + n * 2048); } while (0)
#define PG8_F8OP(X) __builtin_bit_cast(v8i32, __builtin_shufflevector(X[0], X[1], 0, 1, 2, 3, 4, 5, 6, 7, 8, 9, 10, 11, 12, 13, 14, 15))
#define PG8_MMA(ai, bj, At, Bt) do { __builtin_amdgcn_s_setprio(1); if constexpr (F8) { _Pragma("unroll") for (int m = 0; m < 4; ++m) _Pragma("unroll") for (int n = 0; n < 2; ++n) \
        asm volatile("v_mfma_scale_f32_16x16x128_f8f6f4 %0, %1, %2, %0, %3, %3 op_sel_hi:[0,0,0]" : "+v"(acc[ai][bj][m][n]) : "v"(PG8_F8OP(Bt[n])), "v"(PG8_F8OP(At[m])), "v"(one_scale)); } \
        else { _Pragma("unroll") for (int m = 0; m < 4; ++m) _Pragma("unroll") for (int n = 0; n < 2; ++n) _Pragma("unroll") for (int k = 0; k < 2; ++k) \
        acc[ai][bj][m][n] = __builtin_amdgcn_mfma_f32_16x16x32_bf16(Bt[n][k], At[m][k], acc[ai][bj][m][n], 0, 0, 0); } __builtin_amdgcn_s_setprio(0); } while (0)
#define PG8_WAIT_V(n) asm volatile("s_waitcnt vmcnt(" #n ")" ::: "memory")
#define PG8_WAIT_L(n) asm volatile("s_waitcnt lgkmcnt(" #n ")" ::: "memory")
#define PG8_BAR __builtin_amdgcn_s_barrier()
#define PG8_SCHED __builtin_amdgcn_sched_barrier(0)
    Unit cur, nxt; int ui = 0;
    if (!S.next(0, cur)) return;
    int one_scale = 0x7f7f7f7f; if constexpr (F8) asm volatile("" : "+v"(one_scale));
    unsigned gC[2][2], gN[2][2];
#pragma unroll
    for (int h = 0; h < 2; ++h)
#pragma unroll
        for (int i = 0; i < 2; ++i) { gC[h][i] = GATHER ? S.row_off(cur, h * HALF + RA[i]) + (unsigned)CA2[i] : 0u; gN[h][i] = gC[h][i]; }
    f32x4 acc[2][2][4][2];
#pragma unroll
    for (int a = 0; a < 2; ++a)
#pragma unroll
        for (int b = 0; b < 2; ++b)
#pragma unroll
            for (int m = 0; m < 4; ++m)
#pragma unroll
                for (int n = 0; n < 2; ++n) acc[a][b][m][n] = (f32x4){0.f, 0.f, 0.f, 0.f};
    bf16x8 At[4][2], B0[2][2], B1[2][2];
    const char* cA = S.a_ptr(g, cur); const char* cB = S.b_ptr(g, cur);
    PG8_STAGE(PG8_SB(0, 0), cB, voffB); PG8_STAGE(PG8_SB(0, 1), cB + hstepB, voffB); PG8_STAGE_A(PG8_SA(0, 0), cA, 0, false); PG8_STAGE_A(PG8_SA(0, 1), cA, 1, false);
    if (wr == 1) PG8_BAR;
    PG8_WAIT_V(2); PG8_BAR;
    PG8_STAGE(PG8_SB(1, 0), cB + kstep, voffB); PG8_STAGE_A(PG8_SA(1, 0), cA + kstep, 0, false); PG8_STAGE(PG8_SB(1, 1), cB + hstepB + kstep, voffB);
    PG8_WAIT_V(6); PG8_BAR;
    for (;;) {
        const bool has_next = S.next(ui + 1, nxt);
        const char* nA = has_next ? S.a_ptr(g, nxt) : cA; const char* nB = has_next ? S.b_ptr(g, nxt) : cB;
        if constexpr (GATHER) { if (has_next) {
#pragma unroll
            for (int h = 0; h < 2; ++h)
#pragma unroll
                for (int i = 0; i < 2; ++i) gN[h][i] = S.row_off(nxt, h * HALF + RA[i]) + (unsigned)CA2[i]; } }
#pragma unroll 1
        for (int t = 0; t < nt; t += 2) {
            const bool last = (t == nt - 2);
            asm volatile("" : "+v"(voffA[0]), "+v"(voffA[1]), "+v"(voffB[0]), "+v"(voffB[1]));
            if constexpr (Epi::HAS_MID) { if (t == Epi::MID_T) E.mid(acc, cur, wr, wc, fr, fq); }
            const char* a1 = cA + (size_t)(t + 1) * kstep;
            const char* a2 = last ? nA : cA + (size_t)(t + 2) * kstep; const char* b2 = last ? nB : cB + (size_t)(t + 2) * kstep;
            const char* a3 = a2 + kstep; const char* b3 = b2 + kstep;
            PG8_LDB(B0, 0, 0); PG8_LDB(B1, 0, 1); PG8_SCHED; PG8_LDA(At, 0, 0); PG8_STAGE_A(PG8_SA(1, 1), a1, 1, false);
            PG8_WAIT_V(8); PG8_WAIT_L(0); PG8_BAR; PG8_MMA(0, 0, At, B0); PG8_MMA(0, 1, At, B1); PG8_BAR; PG8_SCHED;
            PG8_LDA(At, 0, 1); PG8_STAGE(PG8_SB(0, 0), b2, voffB); PG8_STAGE(PG8_SB(0, 1), b2 + hstepB, voffB); PG8_STAGE_A(PG8_SA(0, 0), a2, 0, last);
            PG8_WAIT_V(8); PG8_WAIT_L(0); PG8_BAR; PG8_MMA(1, 0, At, B0); PG8_MMA(1, 1, At, B1); PG8_BAR; PG8_SCHED;
            PG8_LDB(B0, 1, 0); PG8_LDB(B1, 1, 1); PG8_SCHED; PG8_LDA(At, 1, 0); PG8_STAGE_A(PG8_SA(0, 1), a2, 1, last);
            PG8_WAIT_V(8); PG8_WAIT_L(0); PG8_BAR; PG8_MMA(0, 0, At, B0); PG8_MMA(0, 1, At, B1); PG8_BAR; PG8_SCHED;
            PG8_LDA(At, 1, 1); PG8_STAGE(PG8_SB(1, 0), b3, voffB); PG8_STAGE(PG8_SB(1, 1), b3 + hstepB, voffB); PG8_STAGE_A(PG8_SA(1, 0), a3, 0, last);
            PG8_WAIT_V(8); PG8_WAIT_L(0); PG8_BAR; PG8_MMA(1, 0, At, B0); PG8_MMA(1, 1, At, B1); PG8_BAR; PG8_SCHED;
        }
        if constexpr (ALIGN_EPI) { if (wr == 0) PG8_BAR; }
        if constexpr (F8) asm volatile("s_nop 15\n\ts_nop 15" ::: "memory");
        if constexpr (!Epi::AFTER_DRAIN) { E(acc, cur, wr, wc, fr, fq); }
        if (!has_next) break;
#pragma unroll
        for (int a = 0; a < 2; ++a)
#pragma unroll
            for (int b = 0; b < 2; ++b)
#pragma unroll
                for (int m = 0; m < 4; ++m)
#pragma unroll
                    for (int n = 0; n < 2; ++n) acc[a][b][m][n] = (f32x4){0.f, 0.f, 0.f, 0.f};
        cur = nxt; cA = nA; cB = nB; ++ui;
#pragma unroll
        for (int h = 0; h < 2; ++h)
#pragma unroll
            for (int i = 0; i < 2; ++i) gC[h][i] = gN[h][i];
        if constexpr (ALIGN_EPI) { if (wr == 1) PG8_BAR; }
    }
    PG8_WAIT_V(0);
    if constexpr (!ALIGN_EPI) { if (wr == 0) PG8_BAR; }
    PG8_BAR;
    if constexpr (Epi::AFTER_DRAIN) { E.fused(acc, cur, wr, wc, fr, fq, lds, wid, lane); }
#undef PG8_SA
#undef PG8_SB
#undef PG8_STAGE
#undef PG8_STAGE_A
#undef PG8_LDA
#undef PG8_LDB
#undef PG8_MMA
#undef PG8_F8OP
#undef PG8_WAIT_V
#undef PG8_WAIT_L
#undef PG8_BAR
#undef PG8_SCHED
}
}

namespace pg8 {
struct EpiInProj {
    static constexpr bool PERM = true, AFTER_DRAIN = false, HAS_MID = false; static constexpr int MID_T = 0;
    unsigned char* HQ; unsigned char* SG; float rs;
    __device__ __forceinline__ void mid(f32x4 (&)[2][2][4][2], const Unit&, int, int, int, int) const {}
    __device__ __forceinline__ void operator()(const f32x4 (&acc)[2][2][4][2], const Unit& u, int wr, int wc, int fr, int fq) const {
        const int row0 = u.pm * BM + wr * 64 + opaque(fr), pn = u.pn;
        const bool gate = pn >= 14; const bool qs = (pn < 3) || (pn >= 9 && pn < 13);
        const float sc = (qs ? QSCALE : 1.0f) * rs; const int dcol = (wc & 1) * 32 + 8 * fq;
#pragma unroll
        for (int ai = 0; ai < 2; ++ai)
#pragma unroll
            for (int m = 0; m < 4; ++m) { const int row = row0 + ai * HALF + m * 16, b = row >> 12, t = row & (SEQ - 1);
#pragma unroll
                for (int bj = 0; bj < 2; ++bj) { f32x4 v0 = acc[ai][bj][m][0], v1 = acc[ai][bj][m][1];
                    bf16_t* dst;
                    if (gate) {
#pragma unroll
                        for (int q = 0; q < 4; ++q) { v0[q] = fmaxf(fast_sigmoid(v0[q] * rs) * SSG, 0.001953125f); v1[q] = fmaxf(fast_sigmoid(v1[q] * rs) * SSG, 0.001953125f); }
                        u32x2 w8; w8.x = pk4_fp8(v0[0], v0[1], v0[2], v0[3]); w8.y = pk4_fp8(v1[0], v1[1], v1[2], v1[3]);
                        *(u32x2*)(SG + (size_t)row * SG_P + (pn - 14) * 256 + bj * HALF + wc * 32 + 8 * fq) = w8; continue; }
                    else { v0 = v0 * sc; v1 = v1 * sc; const int hl = bj * 2 + (wc >> 1);
                        size_t rowi; unsigned char* base8; float qk; bool is8;
                        if (pn < 9) { const int ty = pn / 3, g = pn - 3 * ty, sh = 2 * g, pos = ((t & ((1 << sh) - 1)) << (12 - sh)) + (t >> sh);
                            rowi = (size_t)(((g * NB + b) * 4 + hl) * SEQ + pos); base8 = HQ + (size_t)ty * (48 * MiB); is8 = ty < 2; qk = ty == 0 ? SQ : SK; }
                        else if (pn < 13) { rowi = (size_t)((b * 16 + (pn - 9) * 4 + hl) * SEQ + t); base8 = HQ + HQ_QS; is8 = true; qk = SQ; }
                        else { rowi = (size_t)((b * 2 + (wc >> 1)) * SEQ + t); base8 = HQ + (bj ? HQ_VS : HQ_KS); is8 = (bj == 0); qk = SK; }
                        if (is8) { u32x2 w8; w8.x = pk4_fp8(clamp_fp8(v0[0] * qk), clamp_fp8(v0[1] * qk), clamp_fp8(v0[2] * qk), clamp_fp8(v0[3] * qk)); w8.y = pk4_fp8(clamp_fp8(v1[0] * qk), clamp_fp8(v1[1] * qk), clamp_fp8(v1[2] * qk), clamp_fp8(v1[3] * qk));
                            *(u32x2*)(base8 + rowi * 64 + dcol) = w8; continue; }
                        dst = (bf16_t*)base8 + rowi * 64 + dcol; }
                    u32x4 w; w.x = cvt_pk_bf16(v0[0], v0[1]); w.y = cvt_pk_bf16(v0[2], v0[3]); w.z = cvt_pk_bf16(v1[0], v1[1]); w.w = cvt_pk_bf16(v1[2], v1[3]);
                    *(u32x4*)dst = w; } }
    }
};
struct EpiGate {
    static constexpr bool PERM = true, AFTER_DRAIN = false, HAS_MID = true; static constexpr int MID_T = 2;
    const unsigned char* __restrict__ SG; unsigned char* __restrict__ O;
    __device__ __forceinline__ void mid(f32x4 (&acc)[2][2][4][2], const Unit& u, int wr, int wc, int fr, int fq) const {
        const int row0 = u.pm * BM + wr * 64 + opaque(fr), col0 = u.pn * BM + wc * 32 + 8 * opaque(fq);
#pragma unroll
        for (int ai = 0; ai < 2; ++ai) {
            u32x2 a[4][2], b[4][2];
#pragma unroll
            for (int mm = 0; mm < 4; ++mm) { const unsigned char* sp = SG + (size_t)(row0 + ai * HALF + mm * 16) * SG_P + col0;
#pragma unroll
                for (int bj = 0; bj < 2; ++bj) { a[mm][bj] = *(const u32x2*)(sp + bj * HALF); b[mm][bj] = *(const u32x2*)(sp + 1024 + bj * HALF); } }
#pragma unroll
            for (int m = 0; m < 4; ++m) {
#pragma unroll
                for (int bj = 0; bj < 2; ++bj) {
#pragma unroll
                    for (int n = 0; n < 2; ++n) { const int aw = (int)a[m][bj][n], bw = (int)b[m][bj][n];
                        const f32x2 al = __builtin_amdgcn_cvt_pk_f32_fp8(aw, false), ah = __builtin_amdgcn_cvt_pk_f32_fp8(aw, true), bl = __builtin_amdgcn_cvt_pk_f32_fp8(bw, false), bh = __builtin_amdgcn_cvt_pk_f32_fp8(bw, true);
                        f32x4 r; r[0] = al[0] * __builtin_amdgcn_rcpf(bl[0]); r[1] = al[1] * __builtin_amdgcn_rcpf(bl[1]); r[2] = ah[0] * __builtin_amdgcn_rcpf(bh[0]); r[3] = ah[1] * __builtin_amdgcn_rcpf(bh[1]);
                        acc[ai][bj][m][n] = acc[ai][bj][m][n] * r; } }
                asm volatile("" : "+v"(acc[ai][0][m][0]), "+v"(acc[ai][0][m][1]), "+v"(acc[ai][1][m][0]), "+v"(acc[ai][1][m][1])); }
            asm volatile("" ::: "memory"); }
    }
    __device__ __forceinline__ void operator()(const f32x4 (&acc)[2][2][4][2], const Unit& u, int wr, int wc, int fr, int fq) const {
        const int row0 = u.pm * BM + wr * 64 + opaque(fr), col0 = u.pn * BM + wc * 32 + 8 * opaque(fq);
        constexpr float FS = SM / (SO * SW * SSG);
#pragma unroll
        for (int ai = 0; ai < 2; ++ai) {
            u32x2 bq[4][2];
#pragma unroll
            for (int m = 0; m < 4; ++m)
#pragma unroll
                for (int bj = 0; bj < 2; ++bj) bq[m][bj] = *(const u32x2*)(SG + (size_t)(row0 + ai * HALF + m * 16) * SG_P + 1024 + col0 + bj * HALF);
#pragma unroll
            for (int m = 0; m < 4; ++m) { unsigned char* op = O + (size_t)(row0 + ai * HALF + m * 16) * D + col0;
#pragma unroll
                for (int bj = 0; bj < 2; ++bj) { u32x2 w;
#pragma unroll
                    for (int n = 0; n < 2; ++n) { const int bw = (int)bq[m][bj][n]; const f32x2 bl = __builtin_amdgcn_cvt_pk_f32_fp8(bw, false), bh = __builtin_amdgcn_cvt_pk_f32_fp8(bw, true); const f32x4 v = acc[ai][bj][m][n] * FS;
                        w[n] = pk4_fp8(clamp_fp8(v[0] * bl[0]), clamp_fp8(v[1] * bl[1]), clamp_fp8(v[2] * bh[0]), clamp_fp8(v[3] * bh[1])); }
                    *(u32x2*)(op + bj * HALF) = w; } }
            asm volatile("" ::: "memory"); }
    }
};

struct PanelStats {
    unsigned* xbuf;
    unsigned* cnt;
    unsigned* tmo;
    int pm_off; float eps; unsigned code;
    __device__ __forceinline__ bool run(const f32x4 (&v)[2][2][4][2], const Unit& u, int wr, int wc, int fr, int fq, LAS unsigned char* lds, int wid, int lane) const {
        LAS f32x2* P = (LAS f32x2*)lds;
        LAS f32x2* S = (LAS f32x2*)(lds + 8192);
        LAS unsigned* flag = (LAS unsigned*)(lds + 8192 + 2048);
        const int panel = u.pm + pm_off;
#pragma unroll
        for (int ai = 0; ai < 2; ++ai)
#pragma unroll
            for (int m = 0; m < 4; ++m) {
                float s = 0.f;
#pragma unroll
                for (int bj = 0; bj < 2; ++bj)
#pragma unroll
                    for (int n = 0; n < 2; ++n) { const f32x4 x = v[ai][bj][m][n]; s += (x[0] + x[1]) + (x[2] + x[3]); }
                s += __shfl_xor(s, 16); s += __shfl_xor(s, 32);
                const float mw = s * (1.0f / 64.0f); float q = 0.f;
#pragma unroll
                for (int bj = 0; bj < 2; ++bj)
#pragma unroll
                    for (int n = 0; n < 2; ++n) { const f32x4 d = v[ai][bj][m][n] - mw; q += (d[0] * d[0] + d[1] * d[1]) + (d[2] * d[2] + d[3] * d[3]); }
                q += __shfl_xor(q, 16); q += __shfl_xor(q, 32);
                if (fq == 0) P[(ai * HALF + wr * 64 + m * 16 + fr) * 4 + wc] = (f32x2){mw, q};
            }
        asm volatile("s_waitcnt lgkmcnt(0)" ::: "memory"); __builtin_amdgcn_s_barrier(); asm volatile("" ::: "memory");
        const int row = wid * 32 + (lane & 31);
        if (lane < 32) {
            const f32x2 a = P[row * 4 + 0], b = P[row * 4 + 1], c = P[row * 4 + 2], d = P[row * 4 + 3];
            const float mt = (a.x + b.x + c.x + d.x) * 0.25f;
            const float da = a.x - mt, db = b.x - mt, dc = c.x - mt, dd = d.x - mt;
            const float m2 = (a.y + b.y) + (c.y + d.y) + 64.0f * ((da * da + db * db) + (dc * dc + dd * dd));
            unsigned long long* slot = (unsigned long long*)xbuf + ((size_t)(panel * BM + row) * 4 + u.pn);
            __hip_atomic_store(slot, ((unsigned long long)__float_as_uint(m2) << 32) | __float_as_uint(mt), __ATOMIC_RELAXED, __HIP_MEMORY_SCOPE_AGENT);
        }
        asm volatile("s_waitcnt vmcnt(0)" ::: "memory");
        if (lane == 0) __hip_atomic_fetch_add(cnt + 64 * panel, 1u, __ATOMIC_RELAXED, __HIP_MEMORY_SCOPE_AGENT);
        if (wid == 0) {
            bool dead = false; const unsigned long long t0 = __builtin_amdgcn_s_memrealtime(); const unsigned want = 8u * 4u;
            for (;;) {
                if ((unsigned)__builtin_amdgcn_readfirstlane(__hip_atomic_load(cnt + 64 * panel, __ATOMIC_RELAXED, __HIP_MEMORY_SCOPE_AGENT)) >= want) break;
                if (__builtin_amdgcn_s_memrealtime() - t0 > 2000000ull) {
                    if (lane == 0) { unsigned expect = 0u; __hip_atomic_compare_exchange_strong(tmo + 1, &expect, code | (unsigned)(panel & 0xff), __ATOMIC_RELAXED, __ATOMIC_RELAXED, __HIP_MEMORY_SCOPE_AGENT);
                                     __hip_atomic_store(tmo, 1u, __ATOMIC_RELAXED, __HIP_MEMORY_SCOPE_AGENT); }
                    dead = true; break; }
                __builtin_amdgcn_s_sleep(2);
            }
            __builtin_amdgcn_fence(__ATOMIC_ACQUIRE, "agent");
            if (lane == 0) flag[0] = dead ? 1u : 0u;
        }
        asm volatile("s_waitcnt vmcnt(0) lgkmcnt(0)" ::: "memory"); __builtin_amdgcn_s_barrier(); asm volatile("" ::: "memory");
        const bool bad = flag[0] != 0u;
        if (lane < 32) {
            const unsigned long long* slot = (const unsigned long long*)xbuf + (size_t)(panel * BM + row) * 4; float mt[4], m2[4]; float ms = 0.f;
#pragma unroll
            for (int t = 0; t < 4; ++t) { const unsigned long long w = __hip_atomic_load(slot + t, __ATOMIC_RELAXED, __HIP_MEMORY_SCOPE_AGENT); mt[t] = __uint_as_float((unsigned)w); m2[t] = __uint_as_float((unsigned)(w >> 32)); ms += mt[t]; }
            const float mean = ms * 0.25f; float q = 0.f;
#pragma unroll
            for (int t = 0; t < 4; ++t) { const float dm = mt[t] - mean; q += m2[t] + 256.0f * dm * dm; }
            S[row] = (f32x2){mean, 1.0f / sqrtf(q * (1.0f / 1024.0f) + eps)};
        }
        asm volatile("s_waitcnt lgkmcnt(0)" ::: "memory"); __builtin_amdgcn_s_barrier(); asm volatile("" ::: "memory");
        return bad;
    }
};
struct EpiLn1 {
    static constexpr bool PERM = true, AFTER_DRAIN = true, HAS_MID = false; static constexpr int MID_T = 0;
    const float* x; float* out; bf16_t* xb; unsigned char* xq; const float* gam; const float* bet; PanelStats st; int row_off; unsigned poison; float rs;
    __device__ __forceinline__ void mid(f32x4 (&)[2][2][4][2], const Unit&, int, int, int, int) const {}
    __device__ __forceinline__ void operator()(const f32x4 (&)[2][2][4][2], const Unit&, int, int, int, int) const {}
    __device__ __forceinline__ void fused(f32x4 (&acc)[2][2][4][2], const Unit& u, int wr, int wc, int fr, int fq, LAS unsigned char* lds, int wid, int lane) const {
        const LAS f32x2* S = (const LAS f32x2*)(lds + 8192);
        const int col0 = u.pn * BM + wc * 32 + 8 * opaque(fq);
        const int grow0 = row_off + u.pm * BM; fr = opaque(fr);
#pragma unroll
        for (int ai = 0; ai < 2; ++ai)
#pragma unroll
            for (int m = 0; m < 4; ++m) { const size_t off = (size_t)(grow0 + ai * HALF + wr * 64 + m * 16 + fr) * D + col0;
#pragma unroll
                for (int bj = 0; bj < 2; ++bj)
#pragma unroll
                    for (int n = 0; n < 2; ++n) { const f32x4 bs = *(const f32x4*)(x + off + bj * HALF + n * 4); acc[ai][bj][m][n] = acc[ai][bj][m][n] * rs + bs * DN_ALPHA; }
                asm volatile("" : "+v"(acc[ai][0][m][0]), "+v"(acc[ai][0][m][1]), "+v"(acc[ai][1][m][0]), "+v"(acc[ai][1][m][1]));
                if (m == 3) asm volatile("" ::: "memory"); }
        const bool bad = st.run(acc, u, wr, wc, fr, fq, lds, wid, lane) || poison != 0u;
        const float qnan = __builtin_nanf("");
        f32x4 gv[2][2], bv[2][2];
#pragma unroll
        for (int bj = 0; bj < 2; ++bj)
#pragma unroll
            for (int n = 0; n < 2; ++n) { gv[bj][n] = *(const f32x4*)(gam + col0 + bj * HALF + n * 4); bv[bj][n] = *(const f32x4*)(bet + col0 + bj * HALF + n * 4); }
#pragma unroll
        for (int ai = 0; ai < 2; ++ai)
#pragma unroll
            for (int m = 0; m < 4; ++m) { const int r = ai * HALF + wr * 64 + m * 16 + fr; const f32x2 sr = S[r]; const size_t off = (size_t)(grow0 + r) * D + col0;
#pragma unroll
                for (int bj = 0; bj < 2; ++bj) { f32x4 o0 = (acc[ai][bj][m][0] - sr.x) * sr.y * gv[bj][0] + bv[bj][0], o1 = (acc[ai][bj][m][1] - sr.x) * sr.y * gv[bj][1] + bv[bj][1];
                    if (bad) { o0 = (f32x4){qnan, qnan, qnan, qnan}; o1 = o0; }
                    u32x4 w; w.x = cvt_pk_bf16(o0[0], o0[1]); w.y = cvt_pk_bf16(o0[2], o0[3]); w.z = cvt_pk_bf16(o1[0], o1[1]); w.w = cvt_pk_bf16(o1[2], o1[3]); *(u32x4*)(xb + off + bj * HALF) = w;
                    u32x2 q8; q8.x = pk4_fp8(clamp_fp8(o0[0] * SX), clamp_fp8(o0[1] * SX), clamp_fp8(o0[2] * SX), clamp_fp8(o0[3] * SX)); q8.y = pk4_fp8(clamp_fp8(o1[0] * SX), clamp_fp8(o1[1] * SX), clamp_fp8(o1[2] * SX), clamp_fp8(o1[3] * SX));
                    *(u32x2*)(xq + off + bj * HALF) = q8; } }
    }
};
struct EpiY {
    static constexpr bool PERM = true, AFTER_DRAIN = false, HAS_MID = false; static constexpr int MID_T = 0;
    const float* __restrict__ x; bf16_t* __restrict__ Y; float* __restrict__ ST; float rs;
    __device__ __forceinline__ void mid(f32x4 (&)[2][2][4][2], const Unit&, int, int, int, int) const {}
    __device__ __forceinline__ void operator()(const f32x4 (&acc)[2][2][4][2], const Unit& u, int wr, int wc, int fr, int fq) const {
        const int row0 = u.pm * BM + wr * 64 + opaque(fr), col0 = u.pn * BM + wc * 32 + 8 * opaque(fq);
#pragma unroll
        for (int ai = 0; ai < 2; ++ai) {
            f32x4 xv[4][2][2];
#pragma unroll
            for (int m = 0; m < 4; ++m)
#pragma unroll
                for (int bj = 0; bj < 2; ++bj)
#pragma unroll
                    for (int n = 0; n < 2; ++n) xv[m][bj][n] = *(const f32x4*)(x + (size_t)(row0 + ai * HALF + m * 16) * D + col0 + bj * HALF + n * 4);
#pragma unroll
            for (int m = 0; m < 4; ++m) { const size_t r = (size_t)(row0 + ai * HALF + m * 16); float s1 = 0.f, s2 = 0.f;
#pragma unroll
                for (int bj = 0; bj < 2; ++bj) { const f32x4 y0 = acc[ai][bj][m][0] * rs + xv[m][bj][0] * DN_ALPHA, y1 = acc[ai][bj][m][1] * rs + xv[m][bj][1] * DN_ALPHA;
                    s1 += (y0[0] + y0[1]) + (y0[2] + y0[3]) + (y1[0] + y1[1]) + (y1[2] + y1[3]);
                    s2 += (y0[0] * y0[0] + y0[1] * y0[1]) + (y0[2] * y0[2] + y0[3] * y0[3]) + (y1[0] * y1[0] + y1[1] * y1[1]) + (y1[2] * y1[2] + y1[3] * y1[3]);
                    u32x4 w; w.x = cvt_pk_bf16(y0[0], y0[1]); w.y = cvt_pk_bf16(y0[2], y0[3]); w.z = cvt_pk_bf16(y1[0], y1[1]); w.w = cvt_pk_bf16(y1[2], y1[3]);
                    *(u32x4*)(Y + r * D + col0 + bj * HALF) = w; }
                s1 += __shfl_xor(s1, 16); s1 += __shfl_xor(s1, 32); s2 += __shfl_xor(s2, 16); s2 += __shfl_xor(s2, 32);
                if (fq == 0) *(f32x2*)(ST + (r * 16 + u.pn * 4 + wc) * 2) = (f32x2){s1, s2}; }
            asm volatile("" ::: "memory"); }
    }
};
struct EpiGU {
    static constexpr bool PERM = true, AFTER_DRAIN = false, HAS_MID = false; static constexpr int MID_T = 0;
    const float* bg; const float* bu; unsigned char* H;
    __device__ __forceinline__ void mid(f32x4 (&)[2][2][4][2], const Unit&, int, int, int, int) const {}
    __device__ __forceinline__ void operator()(const f32x4 (&acc)[2][2][4][2], const Unit& u, int wr, int wc, int fr, int fq) const {
        const int row0 = u.pm * BM + wr * 64 + opaque(fr), j0 = u.pn * HALF + wc * 32 + 8 * opaque(fq);
        const f32x4 g0 = *(const f32x4*)(bg + u.e * DFF + j0), g1 = *(const f32x4*)(bg + u.e * DFF + j0 + 4);
        const f32x4 u0 = *(const f32x4*)(bu + u.e * DFF + j0), u1 = *(const f32x4*)(bu + u.e * DFF + j0 + 4);
#pragma unroll
        for (int ai = 0; ai < 2; ++ai)
#pragma unroll
            for (int m = 0; m < 4; ++m) {
                constexpr float RS = 1.0f / (SX * SW);
                f32x4 gt0 = acc[ai][0][m][0] * RS + g0, gt1 = acc[ai][0][m][1] * RS + g1, up0 = acc[ai][1][m][0] * RS + u0, up1 = acc[ai][1][m][1] * RS + u1; f32x4 h0, h1;
#pragma unroll
                for (int q = 0; q < 4; ++q) {
                    const float a = fminf(gt0[q], 7.0f), b = fminf(gt1[q], 7.0f);
                    const float ua = fminf(fmaxf(up0[q], -7.0f), 7.0f), ub = fminf(fmaxf(up1[q], -7.0f), 7.0f);
                    h0[q] = (a * __builtin_amdgcn_rcpf(1.0f + __builtin_amdgcn_exp2f(-1.702f * LOG2E * a))) * __builtin_fmaf(ua, SH, SH);
                    h1[q] = (b * __builtin_amdgcn_rcpf(1.0f + __builtin_amdgcn_exp2f(-1.702f * LOG2E * b))) * __builtin_fmaf(ub, SH, SH); }
                u32x2 w; w.x = pk4_fp8(h0[0], h0[1], h0[2], h0[3]); w.y = pk4_fp8(h1[0], h1[1], h1[2], h1[3]);
                *(u32x2*)(H + (size_t)(row0 + ai * HALF + m * 16) * DFF + j0) = w; }
    }
};
struct EpiDown {
    static constexpr bool PERM = true, AFTER_DRAIN = false, HAS_MID = false; static constexpr int MID_T = 0;
    const float* bd; const int* petok; const float* pegate; unsigned char* Y;
    __device__ __forceinline__ void mid(f32x4 (&)[2][2][4][2], const Unit&, int, int, int, int) const {}
    __device__ __forceinline__ void operator()(const f32x4 (&acc)[2][2][4][2], const Unit& u, int wr, int wc, int fr, int fq) const {
        const int r0 = wr * 64 + opaque(fr), col0 = u.pn * BM + wc * 32 + 8 * opaque(fq);
        f32x4 b[2][2];
#pragma unroll
        for (int bj = 0; bj < 2; ++bj) { b[bj][0] = *(const f32x4*)(bd + u.e * D + col0 + bj * HALF); b[bj][1] = *(const f32x4*)(bd + u.e * D + col0 + bj * HALF + 4); }
        const size_t eb = (size_t)u.e * NTOK + (size_t)u.ti * 256;
        int info[2][4]; float gwv[2][4];
#pragma unroll
        for (int ai = 0; ai < 2; ++ai)
#pragma unroll
            for (int m = 0; m < 4; ++m) { const int r = r0 + ai * HALF + m * 16; info[ai][m] = petok[eb + r]; gwv[ai][m] = pegate[eb + r] * SY; }
        if (u.valid == 256) {
#pragma unroll
        for (int ai = 0; ai < 2; ++ai)
#pragma unroll
            for (int m = 0; m < 4; ++m) { const int r = r0 + ai * HALF + m * 16;
                { const float gw = gwv[ai][m];
                    unsigned char* op = Y + (size_t)info[ai][m] * 1024 + col0;
#pragma unroll
                    for (int bj = 0; bj < 2; ++bj) { constexpr float RS = 1.0f / (SH * SW); const f32x4 v0 = (acc[ai][bj][m][0] * RS + b[bj][0]) * gw, v1 = (acc[ai][bj][m][1] * RS + b[bj][1]) * gw;
                        u32x2 w; w.x = pk4_fp8(clamp_fp8(v0[0]), clamp_fp8(v0[1]), clamp_fp8(v0[2]), clamp_fp8(v0[3])); w.y = pk4_fp8(clamp_fp8(v1[0]), clamp_fp8(v1[1]), clamp_fp8(v1[2]), clamp_fp8(v1[3]));
                        *(u32x2*)(op + bj * HALF) = w; } } }
        } else {
#pragma unroll
        for (int ai = 0; ai < 2; ++ai)
#pragma unroll
            for (int m = 0; m < 4; ++m) { const int r = r0 + ai * HALF + m * 16;
                if (r < u.valid) { const float gw = gwv[ai][m];
                    unsigned char* op = Y + (size_t)info[ai][m] * 1024 + col0;
#pragma unroll
                    for (int bj = 0; bj < 2; ++bj) { constexpr float RS = 1.0f / (SH * SW); const f32x4 v0 = (acc[ai][bj][m][0] * RS + b[bj][0]) * gw, v1 = (acc[ai][bj][m][1] * RS + b[bj][1]) * gw;
                        u32x2 w; w.x = pk4_fp8(clamp_fp8(v0[0]), clamp_fp8(v0[1]), clamp_fp8(v0[2]), clamp_fp8(v0[3])); w.y = pk4_fp8(clamp_fp8(v1[0]), clamp_fp8(v1[1]), clamp_fp8(v1[2]), clamp_fp8(v1[3]));
                        *(u32x2*)(op + bj * HALF) = w; } } }
        }
    }
};
}

#define XB_TMO      128
#define XB_XCNT(j)  (256  + 64 * (j))
#define XB_XSUB(j)  (1280 + 64 * (j))
#define XB_XGEN(j)  (2304 + 64 * (j))
#define XB_TOP      3328
#define XB_TOPGEN   3392
#define XCD_BAR_WORDS 3456
#define XB_SPIN_CAP (1u << 18)
__device__ __forceinline__ unsigned xb_ld(unsigned* p)              { return __hip_atomic_load(p, __ATOMIC_RELAXED, __HIP_MEMORY_SCOPE_AGENT); }
__device__ __forceinline__ unsigned xb_add(unsigned* p, unsigned v) { return __hip_atomic_fetch_add(p, v, __ATOMIC_RELAXED, __HIP_MEMORY_SCOPE_AGENT); }
__device__ __forceinline__ unsigned xb_xcc_id() { return (unsigned)__builtin_amdgcn_s_getreg((3 << 11) | 20) & 0xFu; }
#define XB_SPIN(cond, bar) do { unsigned _sp = 0; while (cond) { __builtin_amdgcn_s_sleep(1); \
    if ((++_sp & 255u) == 0u) { if (xb_ld(&(bar)[XB_TMO])) break; if (_sp > XB_SPIN_CAP) { atomicAdd(&(bar)[XB_TMO], 1u); break; } } } } while (0)
struct XcdBarrier { unsigned* bar; unsigned x; volatile LAS unsigned* st; };
__device__ __forceinline__ XcdBarrier xcd_barrier_post(unsigned* bar, volatile LAS unsigned* st) {
    XcdBarrier b; b.bar = bar; b.x = xb_xcc_id(); b.st = st;
    if (threadIdx.x == 0) (void)xb_add(&bar[XB_XCNT(b.x)], 1u);
    return b;
}
__device__ __forceinline__ void xcd_barrier_complete(unsigned* bar, unsigned x, unsigned& nloc, unsigned& nx) {
    const unsigned G = gridDim.x * gridDim.y * gridDim.z;
    unsigned sum, cnt, mine, sp = 0u;
    for (;;) {
        sum = 0u; cnt = 0u; mine = 0u;
#pragma unroll
        for (unsigned j = 0; j < 16; ++j) { const unsigned c = xb_ld(&bar[XB_XCNT(j)]); sum += c; cnt += (c > 0u) ? 1u : 0u; mine = (j == x) ? c : mine; }
        if (sum == G) break;
        __builtin_amdgcn_s_sleep(1);
        if ((++sp & 255u) == 0u) { if (xb_ld(&bar[XB_TMO])) break; if (sp > XB_SPIN_CAP) { atomicAdd(&bar[XB_TMO], 1u); break; } }
    }
    nloc = mine > 0u ? mine : 1u; nx = cnt > 0u ? cnt : 1u;
}
__device__ __forceinline__ void xcd_barrier(const XcdBarrier& b) {
    asm volatile("s_waitcnt vmcnt(0)" ::: "memory");
    __syncthreads();
    if (threadIdx.x == 0) {
        unsigned* bar = b.bar;
        __builtin_amdgcn_s_waitcnt(0);
        unsigned nloc = b.st[0], nx = b.st[1];
        if (nloc == 0u) { xcd_barrier_complete(bar, b.x, nloc, nx); b.st[0] = nloc; b.st[1] = nx; }
        const unsigned old = xb_add(&bar[XB_XSUB(b.x)], 1u);
        const unsigned gen = old / nloc;
        if (old + 1u == (gen + 1u) * nloc) {
            __builtin_amdgcn_fence(__ATOMIC_RELEASE, "agent");
            asm volatile("s_waitcnt vmcnt(0)" ::: "memory");
            const unsigned og = xb_add(&bar[XB_TOP], 1u);
            const unsigned tg = og / nx;
            if (og + 1u == (tg + 1u) * nx) xb_add(&bar[XB_TOPGEN], 1u);
            else XB_SPIN(xb_ld(&bar[XB_TOPGEN]) == tg, bar);
            __builtin_amdgcn_fence(__ATOMIC_ACQUIRE, "agent");
            xb_add(&bar[XB_XGEN(b.x)], 1u);
            asm volatile("s_waitcnt vmcnt(0)" ::: "memory");
        } else {
            XB_SPIN(xb_ld(&bar[XB_XGEN(b.x)]) == gen, bar);
            __builtin_amdgcn_fence(__ATOMIC_ACQUIRE, "agent");
            asm volatile("s_waitcnt vmcnt(0)" ::: "memory");
        }
    }
    __syncthreads();
}

constexpr int NWAVES = 8;
struct Frame {
    LAS unsigned char* lds; volatile LAS unsigned* MISC; gu32* ctl;
    int tid, lane, wave, vcu, G;
    unsigned char* ws; unsigned char* dout;
};
__device__ __forceinline__ float wave_sum(float v) {
#pragma unroll
    for (int o = 1; o < 64; o <<= 1) v += __shfl_xor(v, o);
    return v;
}
__device__ __forceinline__ void transpose_item(const float* W, int N, int k0, int n0, bf16_t* WT, int ldw, size_t drow0, int dcol0, LAS float* scr, int lane) {
#pragma unroll 8
    for (int i = 0; i < 32; ++i) { const int kk = 2 * i + (lane >> 5); scr[kk * 33 + (lane & 31)] = W[(size_t)(k0 + kk) * N + n0 + (lane & 31)]; }
    LDS_WAIT(); asm volatile("" ::: "memory");
    const int c = lane & 7;
#pragma unroll
    for (int j = 0; j < 4; ++j) { const int n = (lane >> 3) + 8 * j; const LAS float* s = scr + (8 * c) * 33 + n;
        u32x4 o; o.x = cvt_pk_bf16(s[0 * 33], s[1 * 33]); o.y = cvt_pk_bf16(s[2 * 33], s[3 * 33]); o.z = cvt_pk_bf16(s[4 * 33], s[5 * 33]); o.w = cvt_pk_bf16(s[6 * 33], s[7 * 33]);
        *(GAS u32x4*)(WT + (drow0 + n) * (size_t)ldw + dcol0 + 8 * c) = o; }
    LDS_WAIT(); asm volatile("" ::: "memory");
}
__device__ __forceinline__ void transpose_item_f8(const float* W, int N, int k0, int n0, unsigned char* WT, int ldw, size_t drow0, int dcol0, LAS float* scr, int lane);
__device__ __forceinline__ void p0_convert(Frame& F, const float* x, const float* w_in, const float* w_pa, const float* w_pb, const float* w_out, const float* rw) {
    LAS float* scr = (LAS float*)(F.lds + F.wave * 17408);
    const int gw = F.vcu * NWAVES + F.wave, NGW = F.G * NWAVES;
    unsigned char* WIN = F.dout + DO_WIN; unsigned char* WCAT = F.dout + DO_WCAT; unsigned char* WOUT = F.ws + WS_WOUT;
    constexpr int I_IN = (D / 128) * (IN_COLS / 32), I_OUT = (D / 128) * (D / 32), I_PA = (256 / 128) * (D / 32), I_PB = (D / 128) * (D / 32);
    for (int it = gw; it < I_IN + I_OUT + I_PA + I_PB; it += NGW) {
        int r = it;
        if (r < I_IN) { const int nb = IN_COLS / 32; transpose_item_f8(w_in, IN_COLS, 128 * (r / nb), 32 * (r % nb), WIN, D, (size_t)(32 * (r % nb)), 128 * (r / nb), scr, F.lane); continue; } r -= I_IN;
        if (r < I_OUT) { const int nb = D / 32; transpose_item_f8(w_out, D, 128 * (r / nb), 32 * (r % nb), WOUT, D, (size_t)(32 * (r % nb)), 128 * (r / nb), scr, F.lane); continue; } r -= I_OUT;
        if (r < I_PA) { const int nb = D / 32; transpose_item_f8(w_pa, D, 128 * (r / nb), 32 * (r % nb), WCAT, OAB_P, (size_t)(32 * (r % nb)), 128 * (r / nb), scr, F.lane); continue; } r -= I_PA;
        { const int nb = D / 32; transpose_item_f8(w_pb, D, 128 * (r / nb), 32 * (r % nb), WCAT, OAB_P, (size_t)(32 * (r % nb)), 256 + 128 * (r / nb), scr, F.lane); }
    }
    { bf16_t* WRT = (bf16_t*)(F.ws + WS_WRT);
      for (int i = gw * 64 + F.lane; i < NEXP * D; i += NGW * 64) { const int e = i >> 10, k = i & (D - 1); const float w = rw[k * NEXP + e];
          const unsigned hi = cvt_pk_bf16(w, 0.f) & 0xffffu; const float r = w - __uint_as_float(hi << 16);
          WRT[i] = (bf16_t)hi; WRT[NEXP * D + i] = (bf16_t)(cvt_pk_bf16(r, 0.f) & 0xffffu); } }
    unsigned char* XQ = F.dout + DO_XB;
    const size_t n16 = (size_t)NTOK * D / 16;
    for (size_t i = (size_t)gw * 64 + F.lane; i < n16; i += (size_t)NGW * 64) {
        const f32x4 a = *(const GAS f32x4*)(x + i * 16), b = *(const GAS f32x4*)(x + i * 16 + 4), c = *(const GAS f32x4*)(x + i * 16 + 8), d = *(const GAS f32x4*)(x + i * 16 + 12);
        u32x4 o;
        o.x = pk4_fp8(clamp_fp8(a[0] * SXIN), clamp_fp8(a[1] * SXIN), clamp_fp8(a[2] * SXIN), clamp_fp8(a[3] * SXIN)); o.y = pk4_fp8(clamp_fp8(b[0] * SXIN), clamp_fp8(b[1] * SXIN), clamp_fp8(b[2] * SXIN), clamp_fp8(b[3] * SXIN));
        o.z = pk4_fp8(clamp_fp8(c[0] * SXIN), clamp_fp8(c[1] * SXIN), clamp_fp8(c[2] * SXIN), clamp_fp8(c[3] * SXIN)); o.w = pk4_fp8(clamp_fp8(d[0] * SXIN), clamp_fp8(d[1] * SXIN), clamp_fp8(d[2] * SXIN), clamp_fp8(d[3] * SXIN));
        *(GAS u32x4*)(XQ + i * 16) = o;
    }
}
__device__ __forceinline__ void transpose_item_f8(const float* W, int N, int k0, int n0, unsigned char* WT, int ldw, size_t drow0, int dcol0, LAS float* scr, int lane) {
    f32x4 wv[16];
#pragma unroll
    for (int i = 0; i < 16; ++i) wv[i] = *(const GAS f32x4*)(W + (size_t)(k0 + 8 * i + (lane >> 3)) * N + n0 + (lane & 7) * 4);
#pragma unroll
    for (int i = 0; i < 16; ++i) { LAS float* d = scr + (8 * i + (lane >> 3)) * 33 + (lane & 7) * 4; d[0] = wv[i][0]; d[1] = wv[i][1]; d[2] = wv[i][2]; d[3] = wv[i][3]; }
    LDS_WAIT(); asm volatile("" ::: "memory");
    const int c = lane & 7;
#pragma unroll
    for (int j = 0; j < 4; ++j) { const int n = (lane >> 3) + 8 * j; const LAS float* s = scr + (16 * c) * 33 + n;
        u32x4 o;
        o.x = pk4_fp8(clamp_fp8(s[0 * 33] * SW), clamp_fp8(s[1 * 33] * SW), clamp_fp8(s[2 * 33] * SW), clamp_fp8(s[3 * 33] * SW));
        o.y = pk4_fp8(clamp_fp8(s[4 * 33] * SW), clamp_fp8(s[5 * 33] * SW), clamp_fp8(s[6 * 33] * SW), clamp_fp8(s[7 * 33] * SW));
        o.z = pk4_fp8(clamp_fp8(s[8 * 33] * SW), clamp_fp8(s[9 * 33] * SW), clamp_fp8(s[10 * 33] * SW), clamp_fp8(s[11 * 33] * SW));
        o.w = pk4_fp8(clamp_fp8(s[12 * 33] * SW), clamp_fp8(s[13 * 33] * SW), clamp_fp8(s[14 * 33] * SW), clamp_fp8(s[15 * 33] * SW));
        *(GAS u32x4*)(WT + (drow0 + n) * (size_t)ldw + dcol0 + 16 * c) = o; }
    LDS_WAIT(); asm volatile("" ::: "memory");
}
__device__ __forceinline__ void p3_convert_moe(Frame& F, const float* w_gate, const float* w_up, const float* w_down, int wg, int nwg) {
    LAS float* scr = (LAS float*)(F.lds + F.wave * 17408);
    const int gw = wg * NWAVES + F.wave, NGW = nwg * NWAVES;
    unsigned char* WGU = F.ws + WS_WGU; unsigned char* WD = F.ws + WS_WD;
    constexpr int IPM = (D / 128) * (DFF / 32);
    for (int it = gw; it < NEXP * 3 * IPM; it += NGW) {
        const int e = it / (3 * IPM), r3 = it % (3 * IPM), which = r3 / IPM, r = r3 % IPM, kb = r / 32, nb = r % 32, k0 = 128 * kb, n0 = 32 * nb;
        const size_t moff = (size_t)e * D * DFF;
        if (which == 2) transpose_item_f8(w_down + moff, D, k0, n0, WD + moff, DFF, (size_t)n0, k0, scr, F.lane);
        else { const int pn = n0 >> 7, jj = n0 & 127; transpose_item_f8((which ? w_up : w_gate) + moff, DFF, k0, n0, WGU + 2 * moff, D, (size_t)(256 * pn + 128 * which + jj), k0, scr, F.lane); }
    }
}
typedef short v4i16_t __attribute__((ext_vector_type(4)));
__device__ __forceinline__ s16x4 tr_read(const LAS unsigned char* p) { return __builtin_bit_cast(s16x4, __builtin_amdgcn_ds_read_tr16_b64_v4i16((LAS v4i16_t*)p)); }
template <int C>
__device__ __forceinline__ void tr_read8(s16x4 (&r)[8], unsigned addr) {
#define TRR(i) asm volatile("ds_read_b64_tr_b16 %0, %1 offset:%2" : "=v"(r[i]) : "v"(addr), "n"(C * 4096 + (i) * 512))
    TRR(0); TRR(1); TRR(2); TRR(3); TRR(4); TRR(5); TRR(6); TRR(7);
#undef TRR
}
__device__ __forceinline__ void tr_wait8(s16x4 (&r)[8]) {
    asm volatile("s_waitcnt lgkmcnt(0)" : "+v"(r[0]), "+v"(r[1]), "+v"(r[2]), "+v"(r[3]), "+v"(r[4]), "+v"(r[5]), "+v"(r[6]), "+v"(r[7]));
}
template <int C>
__device__ __forceinline__ void pv_tile(s16x4 (&cur)[8], s16x4 (&prev)[8], bf16x8 (&pf)[2], bf16x8 (&pfprev)[2], unsigned vbase, const f32x16& Sc, f32x16 (&O)[2]) {
#pragma unroll
    for (int s = 0; s < 2; ++s) { u32x4 w; w.x = cvt_pk_bf16(Sc[8 * s + 0], Sc[8 * s + 1]); w.y = cvt_pk_bf16(Sc[8 * s + 2], Sc[8 * s + 3]);
        w.z = cvt_pk_bf16(Sc[8 * s + 4], Sc[8 * s + 5]); w.w = cvt_pk_bf16(Sc[8 * s + 6], Sc[8 * s + 7]); pf[s] = __builtin_bit_cast(bf16x8, w); }
    tr_read8<C>(cur, vbase);
    if (C > 0) { asm volatile("" :: "v"(prev[0]), "v"(prev[1]), "v"(prev[2]), "v"(prev[3]), "v"(prev[4]), "v"(prev[5]), "v"(prev[6]), "v"(prev[7]) : "memory");
                 asm volatile("" :: "v"(pfprev[0]), "v"(pfprev[1]) : "memory"); }
    tr_wait8(cur);
    __builtin_amdgcn_sched_barrier(0);
#pragma unroll
    for (int blk = 0; blk < 2; ++blk)
#pragma unroll
        for (int s = 0; s < 2; ++s) { const s16x4 lo = cur[(blk * 2 + s) * 2], hi = cur[(blk * 2 + s) * 2 + 1];
            O[blk] = __builtin_amdgcn_mfma_f32_32x32x16_bf16((bf16x8){lo[0], lo[1], lo[2], lo[3], hi[0], hi[1], hi[2], hi[3]}, pf[s], O[blk], 0, 0, 0); }
    __builtin_amdgcn_sched_barrier(0);
}
constexpr int ATT_KOFF = 0, ATT_QOFF = 12 * 2048, ATT_VOFF = 12 * 4096, ATT_STG = 24 * 4096, ATT_STGW = 4608;
static_assert(ATT_STG + 8 * ATT_STGW <= SCR_BYTES, "attention LDS map");
struct AKV { const unsigned char* qseq; const unsigned char* kseq; const bf16_t* vseq; int jt0, nkt, jq; };
__device__ __forceinline__ AKV attn_kv(const Frame& F, int U) {
    const unsigned char* HQ = F.ws + WS_HQ; AKV r;
    if (U < 2048) {
        const int b = U >> 8, kvh = (U >> 7) & 1, j = U & 127, hq = kvh * 8 + F.wave;
        r.qseq = HQ + HQ_QS + (size_t)(b * 16 + hq) * SEQ * 64; r.kseq = HQ + HQ_KS + (size_t)(b * 2 + kvh) * SEQ * 64; r.vseq = (const bf16_t*)(HQ + HQ_VS) + (size_t)(b * 2 + kvh) * SEQ * 64;
        r.jt0 = j - 4; r.nkt = 5; r.jq = j;
    } else {
        const int v = U - 2048, g = v >> 9, w_ = v & 511, b = w_ >> 6, x = w_ & 63, hh = x >> 4, y = x & 15;
        const int dil = (g == 0) ? 1 : (g == 1) ? 4 : 16;
        const int res = (g == 0) ? 0 : (g == 1) ? (y >> 2) : y;
        const int j0 = (g == 0) ? y * 8 : (g == 1) ? (y & 3) * 8 : 0;
        const size_t seq = ((size_t)((g * NB + b) * 4 + hh) * SEQ + (size_t)res * (SEQ / dil)) * 64;
        r.qseq = HQ + HQ_QD + seq; r.kseq = HQ + HQ_KD + seq; r.vseq = (const bf16_t*)(HQ + HQ_VD) + seq;
        r.jt0 = j0 - 4; r.nkt = 12; r.jq = j0 + F.wave;
    }
    return r;
}
__device__ __forceinline__ void attn_issue_k(LAS unsigned char* lds, int lane, int wave, const AKV& u) {
    for (int p = wave; p < u.nkt * 2; p += 8) {
        const int s = p >> 1, qt = p & 1; const int tj = u.jt0 + s; const size_t pos0 = (size_t)(32 * (tj >= 0 ? tj : 0));
        const int key = 16 * qt + (lane >> 2), cc = (lane & 3) ^ ((key >> 2) & 3);
        __builtin_amdgcn_global_load_lds((const unsigned*)((const char*)u.kseq + (pos0 + key) * 64 + cc * 16), (LAS unsigned*)(lds + ATT_KOFF + s * 2048 + qt * 1024), 16, 0, 0);
    }
}
__device__ __forceinline__ void attn_issue_q(LAS unsigned char* lds, int lane, int wave, const AKV& u) {
#pragma unroll
    for (int qt = 0; qt < 2; ++qt) { const int row = 16 * qt + (lane >> 2), cc = (lane & 3) ^ ((row >> 2) & 3);
        __builtin_amdgcn_global_load_lds((const unsigned*)((const char*)u.qseq + ((size_t)(32 * u.jq) + row) * 64 + cc * 16), (LAS unsigned*)(lds + ATT_QOFF + wave * 2048 + qt * 1024), 16, 0, 0); }
}
template <int NKT>
__device__ __forceinline__ int attn_issue_v(LAS unsigned char* lds, int lane, int wave, const AKV& u) {
    const int w4 = (wave + 4) & 7;
#pragma unroll
    for (int i = 0; i < (NKT * 4 + 7) / 8; ++i) { const int p = w4 + 8 * i;
        if (p < NKT * 4) { const int s = p >> 2, qt = p & 3; const int tj = u.jt0 + s; const size_t pos0 = (size_t)(32 * (tj >= 0 ? tj : 0));
            const int blk = qt >> 1, part = qt & 1, key = 16 * part + (lane >> 2);
            __builtin_amdgcn_global_load_lds((const unsigned*)((const char*)u.vseq + (pos0 + key) * 128 + blk * 64 + (lane & 3) * 16), (LAS unsigned*)(lds + ATT_VOFF + s * 4096 + blk * 2048 + part * 1024), 16, 0, 0); } }
    return NKT == 12 ? 6 : (w4 < 4 ? 3 : 2);
}
__device__ __forceinline__ void attn_wait(int n) {
#define AW(N) asm volatile("s_waitcnt vmcnt(" #N ")" ::: "memory")
    if (n == 11) AW(11); else if (n == 8) AW(8); else if (n == 7) AW(7); else if (n == 6) AW(6); else if (n == 5) AW(5); else if (n == 4) AW(4); else if (n == 3) AW(3); else if (n == 2) AW(2); else AW(0);
#undef AW
}
template <bool swa>
__device__ __forceinline__ void attn_unit(LAS unsigned char* lds, int lane, int wave, const AKV& u, int s0,
                                          float sl2, float sink2, bf16_t* ob, unsigned op, float* lseb, unsigned lsep, bool hasn, const AKV& nx) {
    const int i32 = lane & 31, h = lane >> 5;
    const int jq = u.jq;
    constexpr float QKS = SQ * SK, RQK = 1.0f / (SQ * SK);
    f32x16 bias;
#pragma unroll
    for (int r = 0; r < 16; ++r) { const int kk = (r & 3) + 8 * (r >> 2) + 4 * h; bias[r] = sl2 * QKS * (float)(kk - i32); }
    __builtin_amdgcn_s_barrier();
    asm volatile("" ::: "memory");
    f32x16 S[5];
    float m2 = sink2;
    const int kro = i32 * 64 + h * 8, ksw = (i32 >> 2) & 3;
    long qf[4];
#pragma unroll
    for (int d0 = 0; d0 < 4; ++d0) qf[d0] = *(const LAS long*)(lds + ATT_QOFF + wave * 2048 + kro + ((d0 ^ ksw) * 16));
    long kf[2][4];
#pragma unroll
    for (int c = 0; c < 5; ++c) {
        const bool tv = (jq - 4 + c) >= 0;
        const LAS unsigned char* ks = lds + ATT_KOFF + (s0 + c) * 2048 + kro;
#pragma unroll
        for (int d0 = 0; d0 < 4; ++d0) kf[c & 1][d0] = *(const LAS long*)(ks + ((d0 ^ ksw) * 16));
        if (c > 0) asm volatile("" :: "v"(kf[(c - 1) & 1][0]), "v"(kf[(c - 1) & 1][1]), "v"(kf[(c - 1) & 1][2]), "v"(kf[(c - 1) & 1][3]) : "memory");
        f32x16 a = bias;
#pragma unroll
        for (int d0 = 0; d0 < 4; ++d0) a = __builtin_amdgcn_mfma_f32_32x32x16_fp8_fp8(kf[c & 1][d0], qf[d0], a, 0, 0, 0);
        const float off = -sl2 * (float)(32 * (4 - c));
#pragma unroll
        for (int r = 0; r < 16; ++r) { const int kk = (r & 3) + 8 * (r >> 2) + 4 * h; bool ok = tv;
            if (c == 4) ok = ok && (kk <= i32);
            if (c == 0) ok = ok && (swa ? (kk > i32) : (kk >= i32));
            const float v = ok ? __builtin_fmaf(a[r], RQK, off) : NEG_BIG; a[r] = v; m2 = fmaxf(m2, v); }
        S[c] = a;
    }
    m2 = fmaxf(m2, __shfl_xor(m2, 32));
    float l = 0.f;
#pragma unroll
    for (int c = 0; c < 5; ++c)
#pragma unroll
        for (int r = 0; r < 16; ++r) { const float p = __builtin_amdgcn_exp2f(S[c][r] - m2); S[c][r] = p; l += p; }
    l += __shfl_xor(l, 32);
    l += __builtin_amdgcn_exp2f(sink2 - m2);
    asm volatile("" :: "v"(kf[0][0]), "v"(kf[0][1]), "v"(kf[0][2]), "v"(kf[0][3]), "v"(kf[1][0]), "v"(kf[1][1]), "v"(kf[1][2]), "v"(kf[1][3]) : "memory");
    asm volatile("s_waitcnt vmcnt(0) lgkmcnt(0)" : "+v"(l) :: "memory");
    __builtin_amdgcn_s_barrier();
    asm volatile("" ::: "memory");
    if (hasn) { attn_issue_k(lds, lane, wave, nx); attn_issue_q(lds, lane, wave, nx); }
    f32x16 O[2]; O[0] = (f32x16){}; O[1] = (f32x16){};
    const int vaddr0 = ((lane >> 4) & 1) * 32 + (lane & 3) * 8 + (4 * h + ((lane & 15) >> 2)) * 64;
    const unsigned vbase = (unsigned)(size_t)(lds + ATT_VOFF) + (unsigned)(s0 * 4096 + vaddr0);
    s16x4 va[2][8]; bf16x8 pf[2][2];
    pv_tile<0>(va[0], va[1], pf[0], pf[1], vbase, S[0], O); pv_tile<1>(va[1], va[0], pf[1], pf[0], vbase, S[1], O); pv_tile<2>(va[0], va[1], pf[0], pf[1], vbase, S[2], O);
    pv_tile<3>(va[1], va[0], pf[1], pf[0], vbase, S[3], O); pv_tile<4>(va[0], va[1], pf[0], pf[1], vbase, S[4], O);
    asm volatile("" :: "v"(pf[0][0]), "v"(pf[0][1]), "v"(pf[1][0]), "v"(pf[1][1]) : "memory");
    asm volatile("" :: "v"(va[0][0]), "v"(va[0][1]), "v"(va[0][2]), "v"(va[0][3]), "v"(va[0][4]), "v"(va[0][5]), "v"(va[0][6]), "v"(va[0][7]) : "memory");
    asm volatile("" :: "v"(va[1][0]), "v"(va[1][1]), "v"(va[1][2]), "v"(va[1][3]), "v"(va[1][4]), "v"(va[1][5]), "v"(va[1][6]), "v"(va[1][7]) : "memory");
    __builtin_amdgcn_s_barrier();
    asm volatile("" ::: "memory");
    int nv = 0;
    if (hasn) { if (nx.nkt == 12) nv = attn_issue_v<12>(lds, lane, wave, nx); else nv = attn_issue_v<5>(lds, lane, wave, nx); }
    const float inv = 1.0f / l;
    LAS unsigned char* stg = lds + ATT_STG + wave * ATT_STGW;
    if (swa) {
        const float is = inv * SO;
#pragma unroll
        for (int blk = 0; blk < 2; ++blk)
#pragma unroll
            for (int g4 = 0; g4 < 4; ++g4) { const int d0 = blk * 32 + 8 * g4 + 4 * h;
                *(LAS unsigned*)(stg + i32 * 80 + d0) = f2e4m3_sw(O[blk][4 * g4 + 0] * is) | (f2e4m3_sw(O[blk][4 * g4 + 1] * is) << 8) | (f2e4m3_sw(O[blk][4 * g4 + 2] * is) << 16) | (f2e4m3_sw(O[blk][4 * g4 + 3] * is) << 24); }
        asm volatile("s_waitcnt lgkmcnt(0)" ::: "memory");
#pragma unroll
        for (int it = 0; it < 2; ++it) { const int row = it * 16 + (lane >> 2), ch = lane & 3;
            const u32x4 v = *(const LAS u32x4*)(stg + row * 80 + ch * 16);
            *(u32x4*)((char*)ob + (size_t)(32 * jq + row) * op + ch * 16) = v; }
    } else {
#pragma unroll
        for (int blk = 0; blk < 2; ++blk)
#pragma unroll
            for (int g4 = 0; g4 < 4; ++g4) { const int d0 = blk * 32 + 8 * g4 + 4 * h;
                u32x2 w; w.x = cvt_pk_bf16(O[blk][4 * g4 + 0] * inv, O[blk][4 * g4 + 1] * inv); w.y = cvt_pk_bf16(O[blk][4 * g4 + 2] * inv, O[blk][4 * g4 + 3] * inv);
                *(LAS u32x2*)(stg + i32 * 144 + d0 * 2) = w; }
        asm volatile("s_waitcnt lgkmcnt(0)" ::: "memory");
#pragma unroll
        for (int it = 0; it < 4; ++it) { const int row = it * 8 + (lane >> 3), ch = lane & 7;
            const u32x4 v = *(const LAS u32x4*)(stg + row * 144 + ch * 16);
            *(u32x4*)((char*)ob + (size_t)(32 * jq + row) * op + ch * 16) = v; }
    }
    if (lseb != nullptr && h == 0) lseb[(size_t)(32 * jq + i32) * lsep] = (m2 + __builtin_amdgcn_logf(l)) * LN2;
    attn_wait(hasn ? nv + (swa ? 2 : 5) : 0);
}
__device__ __forceinline__ void p2_attention(Frame& F, const float* sinks) {
    unsigned char* OAB = F.dout + DO_OAB; bf16_t* OAG = (bf16_t*)(F.ws + WS_OAG); float* LSE = (float*)(F.ws + WS_LSE);
    constexpr int NUNIT = 2048 + 1536;
    int U = F.vcu; if (U >= NUNIT) return;
    float snk0 = sinks[F.wave] * LOG2E, snk1 = sinks[8 + F.wave] * LOG2E;
    asm volatile("" : "+v"(snk0), "+v"(snk1));
    AKV cur = attn_kv(F, U);
    attn_issue_k(F.lds, F.lane, F.wave, cur);
    attn_issue_q(F.lds, F.lane, F.wave, cur);
    { const int nv0 = (cur.nkt == 12) ? attn_issue_v<12>(F.lds, F.lane, F.wave, cur) : attn_issue_v<5>(F.lds, F.lane, F.wave, cur); attn_wait(nv0); }
    for (;;) {
        const int Un = U + F.G; const bool hasn = Un < NUNIT;
        const AKV nxt = attn_kv(F, hasn ? Un : U);
        if (U < 2048) {
            const int b = U >> 8, kvh = (U >> 7) & 1, hq = kvh * 8 + F.wave;
            const float slope = exp2f(-8.0f * (float)(hq + 1) / 28.0f);
            attn_unit<true>(F.lds, F.lane, F.wave, cur, 0, slope * LOG2E, kvh ? snk1 : snk0, (bf16_t*)(OAB + (size_t)b * SEQ * OAB_P + 256 + hq * 64), OAB_P, nullptr, 0, hasn, nxt);
        } else {
            const int v = U - 2048, g = v >> 9, w_ = v & 511, b = w_ >> 6, x = w_ & 63, hh = x >> 4, y = x & 15;
            const int dil = (g == 0) ? 1 : (g == 1) ? 4 : 16;
            const int res = (g == 0) ? 0 : (g == 1) ? (y >> 2) : y;
            const size_t tok0 = (size_t)b * SEQ + res;
            const float slope = exp2f(-8.0f * (float)(16 + g * 4 + hh + 1) / 28.0f);
            attn_unit<false>(F.lds, F.lane, F.wave, cur, F.wave, slope * (float)dil * LOG2E, NEG_BIG,
                             OAG + ((size_t)g * NTOK + tok0) * 256 + hh * 64, (unsigned)(dil * 256 * 2), LSE + ((size_t)g * NTOK + tok0) * 4 + hh, (unsigned)(dil * 4), hasn, nxt);
        }
        if (!hasn) break;
        U = Un; cur = nxt;
    }
}
__device__ __forceinline__ void p3_merge(Frame& F) {
    const bf16_t* OAG = (const bf16_t*)(F.ws + WS_OAG); const float* LSE = (const float*)(F.ws + WS_LSE); unsigned char* OAB = F.dout + DO_OAB;
    const int gw = F.vcu * NWAVES + F.wave, NGW = F.G * NWAVES;
    for (int idx = gw; idx < NTOK / 2; idx += NGW) {
        const int tok = idx * 2 + (F.lane >> 5), c8 = F.lane & 31, hh = c8 >> 3;
        float ls[3]; u32x4 o[3];
#pragma unroll
        for (int g = 0; g < 3; ++g) { ls[g] = LSE[((size_t)g * NTOK + tok) * 4 + hh]; o[g] = *(const u32x4*)(OAG + ((size_t)g * NTOK + tok) * 256 + c8 * 8); }
        const float m = fmaxf(fmaxf(ls[0], ls[1]), ls[2]);
        float w[3]; float sum = 0.f;
#pragma unroll
        for (int g = 0; g < 3; ++g) { w[g] = __builtin_amdgcn_exp2f((ls[g] - m) * LOG2E); sum += w[g]; }
        const float is = 1.0f / sum; float r[8];
#pragma unroll
        for (int q = 0; q < 8; ++q) r[q] = 0.f;
#pragma unroll
        for (int g = 0; g < 3; ++g) { const float wg = w[g] * is;
            r[0] += wg * bf_lo(o[g].x); r[1] += wg * bf_hi(o[g].x); r[2] += wg * bf_lo(o[g].y); r[3] += wg * bf_hi(o[g].y);
            r[4] += wg * bf_lo(o[g].z); r[5] += wg * bf_hi(o[g].z); r[6] += wg * bf_lo(o[g].w); r[7] += wg * bf_hi(o[g].w); }
        u32x2 out; out.x = pk4_fp8(clamp_fp8(r[0] * SO), clamp_fp8(r[1] * SO), clamp_fp8(r[2] * SO), clamp_fp8(r[3] * SO)); out.y = pk4_fp8(clamp_fp8(r[4] * SO), clamp_fp8(r[5] * SO), clamp_fp8(r[6] * SO), clamp_fp8(r[7] * SO));
        *(u32x2*)(OAB + (size_t)tok * OAB_P + c8 * 8) = out;
    }
}

__device__ __forceinline__ void p6_router(Frame& F, const bf16_t* y, const float* stat, const float* gam, const float* bet, bf16_t* x1b, unsigned char* x1q, const float* rb, int cw_ecnt, size_t pe_off) {
    constexpr int WPITCH = 2064;
    constexpr int WIMG = 64 * WPITCH;
    constexpr int GOFF = WIMG + 2048;
    static_assert(GOFF + 8192 <= SCR_BYTES, "router LDS map");
    LAS int* wcnt = (LAS int*)(F.lds + WIMG + F.wave * 256); LAS int* wbase = wcnt + 32;
    int* petok = (int*)(F.ws + WS_PETOK + pe_off); float* pegate = (float*)(F.ws + WS_PEGATE + pe_off);
    const bf16_t* WRT = (const bf16_t*)(F.ws + WS_WRT);
    const int gw = F.vcu * NWAVES + F.wave, NGW = F.G * NWAVES, lane = F.lane, j = lane & 15, kq = lane >> 4;
    __syncthreads();
    for (int q = F.tid; q < 64 * 128; q += NWAVES * 64) { const u32x4 v = *(const u32x4*)((const char*)WRT + (size_t)q * 16); *(LAS u32x4*)(F.lds + (q >> 7) * WPITCH + (q & 127) * 16) = v; }
    for (int q = F.tid; q < 512; q += NWAVES * 64) { const f32x4 v = (q < 256) ? *(const f32x4*)(gam + q * 4) : *(const f32x4*)(bet + (q - 256) * 4); *(LAS f32x4*)(F.lds + GOFF + q * 16) = v; }
    __syncthreads();
    const LAS unsigned char* wrow = F.lds + j * WPITCH + kq * 16;
    const LAS float* gl = (const LAS float*)(F.lds + GOFF) + 8 * kq; const LAS float* bl = gl + 1024;
    for (int tb = F.vcu * NWAVES; tb < NTOK / 16; tb += NGW) {
        const int tt = tb + F.wave; const bool valid = tt < NTOK / 16; const int t0 = (valid ? tt : 0) * 16;
        float mean, rstd;
        { const f32x4* sp = (const f32x4*)(stat + (size_t)(t0 + j) * 32); float s1 = 0.f, s2 = 0.f;
#pragma unroll
          for (int q = 0; q < 8; ++q) { const f32x4 v = sp[q]; s1 += v[0] + v[2]; s2 += v[1] + v[3]; }
          mean = s1 * (1.0f / D); const float var = fmaxf(s2 * (1.0f / D) - mean * mean, 0.f); rstd = 1.0f / sqrtf(var + LN_EPS); }
        f32x4 acc[2]; acc[0] = (f32x4){0.f, 0.f, 0.f, 0.f}; acc[1] = acc[0];
        const bf16_t* yrow = y + (size_t)(t0 + j) * D + 8 * kq;
        bf16_t* xbrow = (valid ? x1b : (bf16_t*)(F.ws + 300 * MiB)) + (size_t)(t0 + j) * D + 8 * kq; unsigned char* xqrow = (valid ? x1q : F.ws + 300 * MiB) + (size_t)(t0 + j) * D + 8 * kq;
        bf16x8 wf[2][4]; wf[1][0] = (bf16x8){}; wf[1][1] = wf[1][0]; wf[1][2] = wf[1][0]; wf[1][3] = wf[1][0];
        u32x4 yv[4], yn[4];
#pragma unroll
        for (int u = 0; u < 4; ++u) yv[u] = *(const u32x4*)(yrow + 32 * u);
#pragma unroll 1
        for (int so = 0; so < D / 32; so += 4) {
            const int sn = (so + 4 < D / 32) ? so + 4 : so;
#pragma unroll
            for (int u = 0; u < 4; ++u) yn[u] = *(const u32x4*)(yrow + 32 * (sn + u));
#pragma unroll
            for (int u = 0; u < 4; ++u) { const int sI = so + u;
                wf[u & 1][0] = *(const LAS bf16x8*)(wrow + 64 * sI); wf[u & 1][1] = *(const LAS bf16x8*)(wrow + 16 * WPITCH + 64 * sI);
                wf[u & 1][2] = *(const LAS bf16x8*)(wrow + 32 * WPITCH + 64 * sI); wf[u & 1][3] = *(const LAS bf16x8*)(wrow + 48 * WPITCH + 64 * sI);
                const f32x4 g0 = *(const LAS f32x4*)(gl + 32 * sI), g1 = *(const LAS f32x4*)(gl + 32 * sI + 4), b0 = *(const LAS f32x4*)(bl + 32 * sI), b1 = *(const LAS f32x4*)(bl + 32 * sI + 4);
                asm volatile("" :: "v"(wf[(u + 1) & 1][0]), "v"(wf[(u + 1) & 1][1]), "v"(wf[(u + 1) & 1][2]), "v"(wf[(u + 1) & 1][3]) : "memory");
                f32x4 n0, n1;
                n0[0] = (bf_lo(yv[u].x) - mean) * rstd * g0[0] + b0[0]; n0[1] = (bf_hi(yv[u].x) - mean) * rstd * g0[1] + b0[1]; n0[2] = (bf_lo(yv[u].y) - mean) * rstd * g0[2] + b0[2]; n0[3] = (bf_hi(yv[u].y) - mean) * rstd * g0[3] + b0[3];
                n1[0] = (bf_lo(yv[u].z) - mean) * rstd * g1[0] + b1[0]; n1[1] = (bf_hi(yv[u].z) - mean) * rstd * g1[1] + b1[1]; n1[2] = (bf_lo(yv[u].w) - mean) * rstd * g1[2] + b1[2]; n1[3] = (bf_hi(yv[u].w) - mean) * rstd * g1[3] + b1[3];
                u32x4 xw; xw.x = cvt_pk_bf16(n0[0], n0[1]); xw.y = cvt_pk_bf16(n0[2], n0[3]); xw.z = cvt_pk_bf16(n1[0], n1[1]); xw.w = cvt_pk_bf16(n1[2], n1[3]);
                *(u32x4*)(xbrow + 32 * sI) = xw;
                { u32x2 q8; q8.x = pk4_fp8(clamp_fp8(n0[0] * SX), clamp_fp8(n0[1] * SX), clamp_fp8(n0[2] * SX), clamp_fp8(n0[3] * SX)); q8.y = pk4_fp8(clamp_fp8(n1[0] * SX), clamp_fp8(n1[1] * SX), clamp_fp8(n1[2] * SX), clamp_fp8(n1[3] * SX));
                  *(u32x2*)(xqrow + 32 * sI) = q8; }
                const bf16x8 xh = __builtin_bit_cast(bf16x8, xw);
                acc[0] = __builtin_amdgcn_mfma_f32_16x16x32_bf16(wf[u & 1][0], xh, acc[0], 0, 0, 0); acc[1] = __builtin_amdgcn_mfma_f32_16x16x32_bf16(wf[u & 1][1], xh, acc[1], 0, 0, 0);
                acc[0] = __builtin_amdgcn_mfma_f32_16x16x32_bf16(wf[u & 1][2], xh, acc[0], 0, 0, 0); acc[1] = __builtin_amdgcn_mfma_f32_16x16x32_bf16(wf[u & 1][3], xh, acc[1], 0, 0, 0); }
#pragma unroll
            for (int u = 0; u < 4; ++u) yv[u] = yn[u];
        }
        float lg[8];
#pragma unroll
        for (int q = 0; q < 8; ++q) lg[q] = acc[q >> 2][q & 3] + rb[16 * (q >> 2) + 4 * kq + (q & 3)];
        unsigned taken = 0u; float tv[4]; int ti[4];
#pragma unroll
        for (int k = 0; k < 4; ++k) {
            float bv = -3.0e38f; int bi = 64;
#pragma unroll
            for (int q = 0; q < 8; ++q) { const bool free_ = ((taken >> q) & 1u) == 0u; if (free_ && lg[q] > bv) { bv = lg[q]; bi = 16 * (q >> 2) + 4 * kq + (q & 3); } }
            const int mybi = bi;
#pragma unroll
            for (int o = 16; o < 64; o <<= 1) { const float ov = __shfl_xor(bv, o); const int oi = __shfl_xor(bi, o); const bool keep = (bv > ov) || (bv == ov && bi < oi); bv = keep ? bv : ov; bi = keep ? bi : oi; }
            tv[k] = bv; ti[k] = bi;
            if (bi == mybi && ((bi >> 2) & 3) == kq) taken |= 1u << (4 * (bi >> 4) + (bi & 3));
        }
        float gk[4]; float gs = 0.f;
#pragma unroll
        for (int k = 0; k < 4; ++k) { gk[k] = __builtin_amdgcn_exp2f((tv[k] - tv[0]) * LOG2E); gs += gk[k]; }
        const float gi = 1.0f / gs;
        if (lane < 32) wcnt[lane] = 0;
        asm volatile("s_waitcnt lgkmcnt(0)" ::: "memory");
        const int e0 = (kq == 0) ? ti[0] : (kq == 1) ? ti[1] : (kq == 2) ? ti[2] : ti[3];
        const float g0 = ((kq == 0) ? gk[0] : (kq == 1) ? gk[1] : (kq == 2) ? gk[2] : gk[3]) * gi;
        int r0 = 0;
        if (valid) r0 = __hip_atomic_fetch_add(wcnt + e0, 1, __ATOMIC_RELAXED, __HIP_MEMORY_SCOPE_WORKGROUP);
        asm volatile("s_waitcnt lgkmcnt(0)" ::: "memory");
        __syncthreads();
        if (F.wave == 0 && lane < 32) { int c[NWAVES]; int tot = 0;
#pragma unroll
            for (int w = 0; w < NWAVES; ++w) { c[w] = *(LAS int*)(F.lds + WIMG + w * 256 + 4 * lane); tot += c[w]; }
            int b = 0; if (tot > 0) b = (int)__hip_atomic_fetch_add((unsigned*)(F.ctl + cw_ecnt + 64 * lane), (unsigned)tot, RLX_AGENT);
#pragma unroll
            for (int w = 0; w < NWAVES; ++w) { *(LAS int*)(F.lds + WIMG + w * 256 + 128 + 4 * lane) = b; b += c[w]; } }
        asm volatile("s_waitcnt vmcnt(0) lgkmcnt(0)" ::: "memory");
        __syncthreads();
        if (valid) { const int p0 = wbase[e0] + r0;
            petok[(size_t)e0 * NTOK + p0] = (t0 + j) * 4 + kq; pegate[(size_t)e0 * NTOK + p0] = g0; }
        asm volatile("s_waitcnt lgkmcnt(0)" ::: "memory");
        __syncthreads();
    }
}
__device__ __forceinline__ int moe_tables(Frame& F) {
    LAS int* cnt = (LAS int*)(F.lds + MOE_OFF); LAS int* fs = (LAS int*)(F.lds + MOE_OFF + 128); LAS unsigned char* te = F.lds + MOE_OFF + 128 + 136;
    __syncthreads();
    if (F.tid < NEXP) cnt[F.tid] = (int)__hip_atomic_load(F.ctl + CW_ECNT + 64 * F.tid, RLX_AGENT);
    __syncthreads();
    if (F.tid == 0) { int s = 0; for (int e = 0; e < NEXP; ++e) { fs[e] = s; s += (cnt[e] + 255) >> 8; } fs[NEXP] = s; }
    __syncthreads();
    const int T = fs[NEXP];
    for (int t = F.tid; t < T; t += NWAVES * 64) { int e = 0;
#pragma unroll 8
        for (int q = 1; q < NEXP; ++q) e += (fs[q] <= t) ? 1 : 0;
        te[t] = (unsigned char)e; }
    __syncthreads();
    return T;
}
__device__ __forceinline__ void p9_final(Frame& F, const float* gam, const float* bet, const float* out, float* outw, bool poison) {
    const bf16_t* X1B = (const bf16_t*)(F.ws + WS_X1B);
    const int gw = F.vcu * NWAVES + F.wave, NGW = F.G * NWAVES, lane = F.lane;
    const float qnan = __builtin_nanf("");
    const f32x4 g0 = *(const f32x4*)(gam + lane * 16), g1 = *(const f32x4*)(gam + lane * 16 + 4), g2 = *(const f32x4*)(gam + lane * 16 + 8), g3 = *(const f32x4*)(gam + lane * 16 + 12);
    const f32x4 b0 = *(const f32x4*)(bet + lane * 16), b1 = *(const f32x4*)(bet + lane * 16 + 4), b2 = *(const f32x4*)(bet + lane * 16 + 8), b3 = *(const f32x4*)(bet + lane * 16 + 12);
    for (int tok0 = gw; tok0 < NTOK; tok0 += 2 * NGW) {
        u32x4 xa[2], xb[2], y0[2], y1[2], y2[2], y3[2];
#pragma unroll
        for (int tI = 0; tI < 2; ++tI) { const int tok = min(tok0 + tI * NGW, NTOK - 1);
            const unsigned char* y = (const unsigned char*)out + (size_t)tok * 4096 + lane * 16;
            xa[tI] = *(const u32x4*)(X1B + (size_t)tok * D + lane * 16); xb[tI] = *(const u32x4*)(X1B + (size_t)tok * D + lane * 16 + 8);
            y0[tI] = *(const u32x4*)(y); y1[tI] = *(const u32x4*)(y + 1024); y2[tI] = *(const u32x4*)(y + 2048); y3[tI] = *(const u32x4*)(y + 3072); }
#pragma unroll
        for (int tI = 0; tI < 2; ++tI) { const int tok = tok0 + tI * NGW; if (tok >= NTOK) break;
            float v[16];
#pragma unroll
            for (int w = 0; w < 4; ++w) { const unsigned xw = (w < 2) ? xa[tI][2 * w] : xb[tI][2 * (w - 2)], xw2 = (w < 2) ? xa[tI][2 * w + 1] : xb[tI][2 * (w - 2) + 1];
                v[4 * w + 0] = DN_ALPHA * bf_lo(xw); v[4 * w + 1] = DN_ALPHA * bf_hi(xw); v[4 * w + 2] = DN_ALPHA * bf_lo(xw2); v[4 * w + 3] = DN_ALPHA * bf_hi(xw2);
                f32x2 lo = __builtin_amdgcn_cvt_pk_f32_fp8((int)y0[tI][w], false) + __builtin_amdgcn_cvt_pk_f32_fp8((int)y1[tI][w], false) + __builtin_amdgcn_cvt_pk_f32_fp8((int)y2[tI][w], false) + __builtin_amdgcn_cvt_pk_f32_fp8((int)y3[tI][w], false);
                f32x2 hi = __builtin_amdgcn_cvt_pk_f32_fp8((int)y0[tI][w], true) + __builtin_amdgcn_cvt_pk_f32_fp8((int)y1[tI][w], true) + __builtin_amdgcn_cvt_pk_f32_fp8((int)y2[tI][w], true) + __builtin_amdgcn_cvt_pk_f32_fp8((int)y3[tI][w], true);
                v[4 * w + 0] += lo[0] * (1.0f / SY); v[4 * w + 1] += lo[1] * (1.0f / SY); v[4 * w + 2] += hi[0] * (1.0f / SY); v[4 * w + 3] += hi[1] * (1.0f / SY); }
            float s = 0.f;
#pragma unroll
            for (int q = 0; q < 16; ++q) s += v[q];
            const float mean = wave_sum(s) * (1.0f / D); float s2 = 0.f;
#pragma unroll
            for (int q = 0; q < 16; ++q) { v[q] -= mean; s2 += v[q] * v[q]; }
            const float rstd = 1.0f / sqrtf(wave_sum(s2) * (1.0f / D) + LN_EPS);
            f32x4 o0, o1, o2, o3;
#pragma unroll
            for (int q = 0; q < 4; ++q) { o0[q] = v[q] * rstd * g0[q] + b0[q]; o1[q] = v[4 + q] * rstd * g1[q] + b1[q]; o2[q] = v[8 + q] * rstd * g2[q] + b2[q]; o3[q] = v[12 + q] * rstd * g3[q] + b3[q]; }
            if (poison) { o0 = (f32x4){qnan, qnan, qnan, qnan}; o1 = o0; o2 = o0; o3 = o0; }
            float* op = outw + (size_t)tok * D + lane * 16;
            *(f32x4*)(op) = o0; *(f32x4*)(op + 4) = o1; *(f32x4*)(op + 8) = o2; *(f32x4*)(op + 12) = o3; }
    }
}
#define CAS __attribute__((address_space(4)))
__device__ __forceinline__ const float* arg_in(int i) {
    const unsigned char CAS* ka = (const unsigned char CAS*)__builtin_amdgcn_kernarg_segment_ptr();
    asm volatile("" : "+s"(ka));
    return *(const float* const CAS*)(ka + 8 * i);
}
struct Args { const float* in[18]; float* out; unsigned char* ws; int ph_lo, ph_hi; };
__global__ void __launch_bounds__(NWAVES * 64, 2) fwd_kernel(Args args) {
    extern __shared__ __attribute__((aligned(16))) unsigned char lds[];
    Frame F;
    F.lds = (LAS unsigned char*)lds;
    F.MISC = (volatile LAS unsigned*)(F.lds + MISC_OFF);
    F.tid = threadIdx.x; F.lane = F.tid & 63; F.wave = __builtin_amdgcn_readfirstlane(F.tid >> 6);
    F.G = gridDim.x; { const int bx = blockIdx.x; F.vcu = (F.G % 8 == 0) ? (bx % 8) * (F.G / 8) + bx / 8 : bx; }
    F.ws = args.ws; F.dout = (unsigned char*)args.out;
    F.ctl = (gu32*)(args.ws + WS_CTL);
    for (int u = F.tid; u < (LDS_BYTES - LDSCTL_OFF) / 4; u += NWAVES * 64) ((LAS unsigned*)(F.lds + LDSCTL_OFF))[u] = 0u;
    __syncthreads();
    XcdBarrier bar; bar.bar = (unsigned*)(F.ctl + CW_BAR); bar.x = 0; bar.st = nullptr;
    if (N_LAUNCHES == 1) bar = xcd_barrier_post((unsigned*)(F.ctl + CW_BAR), F.MISC + 8);
    const int lo = args.ph_lo, hi = args.ph_hi;
#ifdef ONLY_PHASE
#define IN(k) ((k) == ONLY_PHASE && lo <= (k) && (k) < hi)
#else
#define IN(k) (lo <= (k) && (k) < hi)
#endif
#define SEAM(k) do { if (IN(k) && IN((k) + 1)) xcd_barrier(bar); } while (0)
    unsigned char* HQ = F.ws + WS_HQ; unsigned char* SG = F.ws + WS_SG;

#define PHASE(k, ...) do { if (IN(k)) { __VA_ARGS__ if (DUP_PHASE == (k)) { __VA_ARGS__ } } } while (0)
    PHASE(0, p0_convert(F, arg_in(0), arg_in(1), arg_in(3), arg_in(4), arg_in(5), arg_in(8));); SEAM(0);
    PHASE(1,
        { const int gemm_wgs = (F.G == 256) ? 192 : F.G;
          if ((int)blockIdx.x < gemm_wgs) {
            pg8::Gemm g{(const char*)(F.dout + DO_XB), (const char*)(F.dout + DO_WIN), D, D, D / 128}; pg8::StaticOrder S; S.init(NTOK, IN_COLS, gemm_wgs, (int)blockIdx.x);
            pg8::EpiInProj E{HQ, SG, 1.0f / (SXIN * SW)};
            pg8::gemm_phase<pg8::EpiInProj, pg8::StaticOrder, true, false, true>(F.lds, g, S, E); }
          if (gemm_wgs == F.G) p3_convert_moe(F, arg_in(10), arg_in(12), arg_in(14), F.vcu, F.G);
          else if ((int)blockIdx.x >= gemm_wgs) p3_convert_moe(F, arg_in(10), arg_in(12), arg_in(14), (int)blockIdx.x - gemm_wgs, F.G - gemm_wgs); }
    ); SEAM(1);
    PHASE(2, p2_attention(F, arg_in(2));); SEAM(2);
    PHASE(3, p3_merge(F);); SEAM(3);
    PHASE(4,
        { pg8::Gemm g{(const char*)(F.dout + DO_OAB), (const char*)(F.dout + DO_WCAT), OAB_P, OAB_P, OAB_P / 128}; pg8::StaticOrder S; S.init(NTOK, D, F.G, (int)blockIdx.x);
        pg8::EpiGate E{SG, F.ws + WS_MRG};
        pg8::gemm_phase<pg8::EpiGate, pg8::StaticOrder, true, false, true>(F.lds, g, S, E); }
    ); SEAM(4);
    PHASE(5,
        { pg8::Gemm g{(const char*)(F.ws + WS_MRG), (const char*)(F.ws + WS_WOUT), D, D, D / 128}; pg8::StaticOrder S; S.init(NTOK, D, F.G, (int)blockIdx.x);
        pg8::EpiY E{arg_in(0), (bf16_t*)(F.ws + WS_Y), (float*)(F.ws + WS_STAT), 1.0f / (SM * SW)};
        pg8::gemm_phase<pg8::EpiY, pg8::StaticOrder, true, false, true>(F.lds, g, S, E); }
    ); SEAM(5);
    if (IN(6)) { if (DUP_PHASE == 6) p6_router(F, (const bf16_t*)(F.ws + WS_Y), (const float*)(F.ws + WS_STAT), arg_in(6), arg_in(7), (bf16_t*)(F.ws + 264 * MiB), F.ws + 330 * MiB, arg_in(9), CW_ECNT + 64 * NEXP, (size_t)362 * MiB - WS_PETOK);
        p6_router(F, (const bf16_t*)(F.ws + WS_Y), (const float*)(F.ws + WS_STAT), arg_in(6), arg_in(7), (bf16_t*)(F.ws + WS_X1B), F.ws + WS_X1Q, arg_in(9), CW_ECNT, 0); } SEAM(6);
    PHASE(7,
        { const int T = moe_tables(F);
        pg8::Gemm g{(const char*)(F.ws + WS_X1Q), (const char*)(F.ws + WS_WGU), D, D, D / 128};
        pg8::MoeOrder S{T, 8, F.G, (int)blockIdx.x, (const LAS int*)(F.lds + MOE_OFF), (const LAS int*)(F.lds + MOE_OFF + 128), (const LAS unsigned char*)(F.lds + MOE_OFF + 128 + 136),
                        (const int*)(F.ws + WS_PETOK), (size_t)2048 * D, true, (unsigned)D};
        pg8::EpiGU E{arg_in(11), arg_in(13), F.ws + WS_HDN};
        pg8::gemm_phase<pg8::EpiGU, pg8::MoeOrder, true, true, true>(F.lds, g, S, E); }
    ); SEAM(7);
    PHASE(8,
        { const int T = moe_tables(F);
        pg8::Gemm g{(const char*)(F.ws + WS_HDN), (const char*)(F.ws + WS_WD), DFF, DFF, DFF / 128};
        pg8::MoeOrder S{T, 4, F.G, (int)blockIdx.x, (const LAS int*)(F.lds + MOE_OFF), (const LAS int*)(F.lds + MOE_OFF + 128), (const LAS unsigned char*)(F.lds + MOE_OFF + 128 + 136),
                        (const int*)(F.ws + WS_PETOK), (size_t)D * DFF, false, 0u};
        pg8::EpiDown E{arg_in(15), (const int*)(F.ws + WS_PETOK), (const float*)(F.ws + WS_PEGATE), F.dout};
        pg8::gemm_phase<pg8::EpiDown, pg8::MoeOrder, true, false, true>(F.lds, g, S, E); }
    ); SEAM(8);
    if (IN(9)) {
        bool poison = (__hip_atomic_load(F.ctl + CW_TMO, RLX_AGENT) != 0u) || (__hip_atomic_load(F.ctl + CW_BAR + XB_TMO, RLX_AGENT) != 0u);
        if (DUP_PHASE == 9) p9_final(F, arg_in(16), arg_in(17), (const float*)F.dout, (float*)(F.ws + 194 * MiB), poison);
        p9_final(F, arg_in(16), arg_in(17), (const float*)F.dout, (float*)F.dout, poison);
    }
#undef PHASE
#undef IN
#undef SEAM
}

extern "C" void kernel_launch(void* const* d_in, const int* in_sizes, int n_in, void* d_out, int out_size, void* d_ws, size_t ws_size, hipStream_t stream) {
    static int grid = 0;
    if (grid == 0) {
        if (n_in != 18 || in_sizes[0] != NTOK * D || out_size != NTOK * D || ws_size < WS_END) { fprintf(stderr, "kernel_launch: unexpected shapes (n_in %d, ws %zu); nothing launched\n", n_in, ws_size); grid = -1; return; }
        int dev = 0, cus = 0, per_cu = 0;
        if (hipGetDevice(&dev) != hipSuccess || hipDeviceGetAttribute(&cus, hipDeviceAttributeMultiprocessorCount, dev) != hipSuccess) { grid = -1; return; }
        if (hipFuncSetAttribute((const void*)fwd_kernel, hipFuncAttributeMaxDynamicSharedMemorySize, LDS_BYTES) != hipSuccess) { fprintf(stderr, "kernel_launch: hipFuncSetAttribute failed\n"); grid = -1; return; }
        if (hipOccupancyMaxActiveBlocksPerMultiprocessor(&per_cu, (const void*)fwd_kernel, NWAVES * 64, LDS_BYTES) != hipSuccess || per_cu < 1) fprintf(stderr, "kernel_launch: occupancy query reports %d\n", per_cu);
        (void)hipGetLastError();
        grid = cus;
    }
    if (grid < 0) return;
    if (hipMemsetAsync((char*)d_ws + WS_CTL, 0, CTL_ZERO_BYTES, stream) != hipSuccess) return;
    Args a{};
    for (int i = 0; i < 18; ++i) a.in[i] = (const float*)d_in[i];
    a.out = (float*)d_out; a.ws = (unsigned char*)d_ws;
    if (N_LAUNCHES == 1) { a.ph_lo = 0; a.ph_hi = N_PHASES; hipLaunchKernelGGL(fwd_kernel, dim3(grid), dim3(NWAVES * 64), LDS_BYTES, stream, a); }
    else for (int p = 0; p < N_PHASES; ++p) { a.ph_lo = p; a.ph_hi = p + 1; hipLaunchKernelGGL(fwd_kernel, dim3(grid), dim3(NWAVES * 64), LDS_BYTES, stream, a); }
}
```

```cpp
#include <hip/hip_runtime.h>
#include <cstdio>
#include <cstdint>

#define GAS __attribute__((address_space(1)))
#define LAS __attribute__((address_space(3)))
typedef unsigned short bf16_t;
typedef short bf16x8 __attribute__((ext_vector_type(8)));
typedef short s16x4 __attribute__((ext_vector_type(4)));
typedef float f32x2 __attribute__((ext_vector_type(2)));
typedef float f32x4 __attribute__((ext_vector_type(4)));
typedef float f32x16 __attribute__((ext_vector_type(16)));
typedef unsigned u32x2 __attribute__((ext_vector_type(2)));
typedef unsigned u32x4 __attribute__((ext_vector_type(4)));
typedef GAS unsigned gu32;

#ifndef MK_N_LAUNCHES
#define MK_N_LAUNCHES 1
#endif
#ifndef DUP_PHASE
#define DUP_PHASE -1
#endif
constexpr int N_PHASES = 10;
constexpr int N_LAUNCHES = MK_N_LAUNCHES;

constexpr int NB = 8, SEQ = 4096, D = 1024, NTOK = NB * SEQ;
constexpr int HQ_P = 3584;
constexpr int SG_P = 2048;
constexpr int OAB_P = 1280;
constexpr int IN_COLS = 5632;
constexpr int NEXP = 32, TOPK = 4, DFF = 1024;
constexpr int MAX_MT = 544;
constexpr float LN_EPS = 1e-5f;
constexpr float DN_ALPHA = 1.189207115002721f;
constexpr float LOG2E = 1.4426950408889634f, LN2 = 0.6931471805599453f;
constexpr float QSCALE = 0.125f * LOG2E;
constexpr float NEG_BIG = -1e30f;

constexpr size_t MiB = 1u << 20;
constexpr size_t WS_CTL = 0, CTL_ZERO_BYTES = 1 * MiB;
constexpr size_t WS_XBUF = 1 * MiB;
constexpr size_t WS_Y = 194 * MiB;
constexpr size_t WS_STAT = 258 * MiB;
constexpr size_t WS_HQ = 2 * MiB;
constexpr size_t HQ_QD = 0, HQ_KD = 48 * MiB, HQ_VD = 96 * MiB, HQ_QS = 144 * MiB, HQ_KS = 208 * MiB, HQ_VS = 216 * MiB;
constexpr size_t WS_WGU = 404 * MiB;
constexpr size_t WS_WD = 468 * MiB;
constexpr size_t WS_X1B = 98 * MiB;
constexpr size_t WS_X1Q = 162 * MiB;
constexpr size_t WS_HDN = 194 * MiB;
constexpr size_t WS_SG = 226 * MiB;
constexpr size_t WS_YS23 = 330 * MiB;
constexpr size_t WS_OAG = 354 * MiB;
constexpr size_t WS_LSE = 402 * MiB;
constexpr size_t WS_MRG = 2 * MiB;
constexpr size_t WS_WOUT = 530 * MiB;
constexpr size_t WS_PETOK = 532 * MiB;
constexpr size_t WS_PEGATE = 536 * MiB;
constexpr size_t WS_WRT = 540 * MiB;
constexpr size_t WS_END = 540 * MiB + 256 * 1024;
constexpr float SX = 8.0f, SW = 512.0f, SH = 4.0f, SXIN = 8.0f, SY = 64.0f, SM = 64.0f, SO = 64.0f, SSG = 256.0f, SQ = 64.0f, SK = 16.0f;
static_assert(WS_HQ + (size_t)NTOK * HQ_P * 2 <= WS_SG && WS_SG + (size_t)NTOK * SG_P <= WS_OAG && WS_OAG + (size_t)3 * NTOK * 256 * 2 <= WS_LSE && WS_LSE + (size_t)3 * NTOK * 4 * 4 <= WS_WGU, "ws map 1");
static_assert(WS_WGU + (size_t)NEXP * 2048 * D <= WS_WD && WS_WD + (size_t)NEXP * D * DFF <= WS_WOUT && WS_MRG + (size_t)NTOK * D <= WS_X1B && WS_X1B + (size_t)NTOK * D * 2 <= WS_X1Q && WS_X1Q + (size_t)NTOK * D <= WS_HDN, "ws map 2");
static_assert(WS_HDN + (size_t)MAX_MT * 256 * DFF <= WS_OAG && WS_WOUT + (size_t)D * D <= WS_PETOK, "ws map 3");
constexpr size_t DO_XB = 0;
constexpr size_t DO_OAB = 0;
constexpr size_t DO_WIN = 96 * MiB;
constexpr size_t DO_WCAT = 108 * MiB;
constexpr int CW_TMO = 0, CW_CODE = 1;
constexpr int CW_BAR = 4096;
constexpr int CW_SEAM = 16384;
constexpr int CW_ECNT = 32768;
static_assert((CW_ECNT + 2 * 64 * NEXP) * 4 <= (int)CTL_ZERO_BYTES, "CTL words inside the memset region");

constexpr int RING_BYTES = 131072;
constexpr int SCR_BYTES = 143360;
constexpr int LDSCTL_OFF = SCR_BYTES;
constexpr int MISC_OFF = LDSCTL_OFF + 320;
constexpr int MOE_OFF = LDSCTL_OFF + 512;
constexpr int LDS_BYTES = 147456;
static_assert(MOE_OFF + 128 + 136 + MAX_MT <= LDS_BYTES, "LDS map");

#define RLX_AGENT __ATOMIC_RELAXED, __HIP_MEMORY_SCOPE_AGENT
#define LDS_WAIT() asm volatile("s_waitcnt lgkmcnt(0)" ::: "memory")
#define VM_WAIT() asm volatile("s_waitcnt vmcnt(0)" ::: "memory")

__device__ __forceinline__ unsigned cvt_pk_bf16(float lo, float hi) { unsigned r; asm volatile("v_cvt_pk_bf16_f32 %0, %1, %2" : "=v"(r) : "v"(lo), "v"(hi)); return r; }
__device__ __forceinline__ int opaque(int v) { asm volatile("" : "+v"(v)); return v; }
__device__ __forceinline__ unsigned pk4_fp8(float a, float b, float c, float d) { int w = 0; w = __builtin_amdgcn_cvt_pk_fp8_f32(a, b, w, false); w = __builtin_amdgcn_cvt_pk_fp8_f32(c, d, w, true); return (unsigned)w; }
__device__ __forceinline__ unsigned f2e4m3_sw(float x) {
    const float a = __builtin_amdgcn_fmed3f(fabsf(x), 9.5367431640625e-07f, 448.f);
    const int e1 = max(__builtin_amdgcn_frexp_expf(a), -5);
    const unsigned m = (unsigned)__builtin_rintf(__builtin_amdgcn_ldexpf(a, 4 - e1));
    return ((__float_as_uint(x) >> 24) & 0x80u) | (unsigned)((e1 << 3) + 40 + (int)m); }
__device__ __forceinline__ unsigned pk4_fp8_pad(float a, float b, float c, float d) {
    unsigned w;
    asm("v_cvt_pk_fp8_f32 %0, %1, %2\n\ts_nop 1" : "=v"(w) : "v"(a), "v"(b));
    asm("v_cvt_pk_fp8_f32 %0, %1, %2 op_sel:[0,0,1]\n\ts_nop 1" : "+v"(w) : "v"(c), "v"(d));
    return w; }
__device__ __forceinline__ float clamp_fp8(float v) { return __builtin_amdgcn_fmed3f(v, -448.0f, 448.0f); }
__device__ __forceinline__ float bf_lo(unsigned w) { return __uint_as_float(w << 16); }
__device__ __forceinline__ float bf_hi(unsigned w) { return __uint_as_float(w & 0xffff0000u); }
__device__ __forceinline__ float fast_sigmoid(float g) { g = fminf(fmaxf(g, -60.f), 60.f); return __builtin_amdgcn_rcpf(1.0f + __builtin_amdgcn_exp2f(-g * LOG2E)); }

namespace pg8 {
constexpr int BM = 256, BK = 64, HALF = 128, HTB = HALF * BK * 2, STAGE_BYTES = 8 * HTB, NXCD = 8, WGM = 8;
__host__ __device__ __forceinline__ int lds_byte(int r, int c) { const int st = (r >> 4) * 2 + (c >> 5), rr = r & 15, cc = c & 31, ob = rr * 64 + cc * 2; return st * 1024 + (ob ^ (((ob >> 9) & 1) << 5)); }
__host__ __device__ __forceinline__ void stage_rc(int b, int& R, int& C) { const int st = b / 1024, sb = b % 1024, swz = sb ^ (((sb >> 9) & 1) << 5); R = (st >> 1) * 16 + swz / 64; C = (st & 1) * 32 + (swz % 64) / 2; }
__host__ __device__ __forceinline__ int perm32(int rho) { const int n = rho >> 4, i = rho & 15; return 8 * (i >> 2) + 4 * n + (i & 3); }

struct Unit { int pm, pn, e, ti, valid; };
struct Gemm { const char* A; const char* Bt; int lda, ldb, nt; };

__device__ __forceinline__ bool tile_of(long L, int nM, int nN, int& pm, int& pn) {
    const int nwg = nM * nN; if (L >= nwg) return false;
    int wgid = (int)L; { const int q = nwg / NXCD, r = nwg % NXCD, xcd = wgid % NXCD, off = wgid / NXCD; wgid = (xcd < r ? xcd * (q + 1) : r * (q + 1) + (xcd - r) * q) + off; }
    const int nig = WGM * nN, gid = wgid / nig, fm = gid * WGM, gsz = (nM - fm) < WGM ? (nM - fm) : WGM;
    pm = fm + ((wgid % nig) % gsz); pn = (wgid % nig) / gsz; return true;
}
struct StaticOrder {
    int nM, nN, G, c;
    __device__ __forceinline__ void init(int M, int N, int G_, int c_) { nM = M / BM; nN = N / BM; G = G_; c = c_; }
    __device__ __forceinline__ bool next(int i, Unit& u) const { u.e = 0; u.ti = 0; u.valid = 256; return tile_of((long)i * G + c, nM, nN, u.pm, u.pn); }
    __device__ __forceinline__ const char* a_ptr(const Gemm& g, const Unit& u) const { return g.A + (size_t)u.pm * 256 * g.lda; }
    __device__ __forceinline__ const char* b_ptr(const Gemm& g, const Unit& u) const { return g.Bt + (size_t)u.pn * 256 * g.ldb; }
    __device__ __forceinline__ unsigned row_off(const Unit&, int) const { return 0u; }
};
struct MoeOrder {
    int T, nN, G, c; const LAS int* cnt; const LAS int* fs; const LAS unsigned char* te;
    const int* petok; size_t b_exp_stride; bool gather; unsigned rowbytes;
    __device__ __forceinline__ bool next(int i, Unit& u) const {
        if (!tile_of((long)i * G + c, T, nN, u.pm, u.pn)) return false;
        u.e = __builtin_amdgcn_readfirstlane((int)te[u.pm]); u.ti = u.pm - __builtin_amdgcn_readfirstlane(fs[u.e]); const int left = __builtin_amdgcn_readfirstlane(cnt[u.e]) - u.ti * 256; u.valid = left < 256 ? left : 256; return true;
    }
    __device__ __forceinline__ const char* a_ptr(const Gemm& g, const Unit& u) const { return gather ? g.A : g.A + (size_t)u.pm * 256 * g.lda; }
    __device__ __forceinline__ const char* b_ptr(const Gemm& g, const Unit& u) const { return g.Bt + (size_t)u.e * b_exp_stride + (size_t)u.pn * 256 * g.ldb; }
    __device__ __forceinline__ unsigned row_off(const Unit& u, int R) const {
        int tok = 0; if (R < u.valid) tok = petok[(size_t)u.e * NTOK + u.ti * 256 + R] >> 2;
        return (unsigned)tok * rowbytes;
    }
};

typedef int v8i32 __attribute__((ext_vector_type(8)));
template <class Epi, class Sched, bool ALIGN_EPI, bool GATHER, bool F8 = false>
__device__ __forceinline__ void gemm_phase(LAS unsigned char* lds, const Gemm g, const Sched& S, const Epi& E) {
    const int tid = threadIdx.x, wid = __builtin_amdgcn_readfirstlane(tid >> 6), lane = tid & 63, wr = wid >> 2, wc = wid & 3, fr = lane & 15, fq = lane >> 4;
    const int nt = g.nt;
    unsigned voffA[2], voffB[2]; int RA[2], CA2[2];
#pragma unroll
    for (int i = 0; i < 2; ++i) { int R, C; stage_rc(tid * 16 + i * 8192, R, C); const int Rb = Epi::PERM ? ((R & ~31) + perm32(R & 31)) : R;
        voffA[i] = (unsigned)(R * g.lda + C * 2); voffB[i] = (unsigned)(Rb * g.ldb + C * 2); RA[i] = R; CA2[i] = C * 2; }
    const size_t kstep = (size_t)(BK * 2);
    const size_t hstepA = (size_t)HALF * g.lda, hstepB = (size_t)HALF * g.ldb;
    const unsigned ldsw = (unsigned)wid * 1024u;
    const int aoff = lds_byte(wr * 64 + fr, fq * 8), boff = lds_byte(wc * 32 + fr, fq * 8);
    const int aoff0 = aoff, boff0 = boff, aoff1 = aoff + 1024, boff1 = boff + 1024;
#define PG8_SA(b, h) (((b) * 2 + (h)) * HTB)
#define PG8_SB(b, h) ((4 + (b) * 2 + (h)) * HTB)
#define PG8_STAGE(bufoff, gbase, voff) do { _Pragma("unroll") for (int _i = 0; _i < 2; ++_i) \
        __builtin_amdgcn_global_load_lds((const unsigned*)((const char*)(gbase) + (voff)[_i]), (LAS unsigned*)(lds + (bufoff) + ldsw + _i * 8192), 16, 0, 0); } while (0)
#define PG8_STAGE_A(bufoff, kp, h, nx) do { if constexpr (GATHER) { unsigned _v[2]; _v[0] = (nx) ? gN[h][0] : gC[h][0]; _v[1] = (nx) ? gN[h][1] : gC[h][1]; PG8_STAGE(bufoff, kp, _v); } \
        else { PG8_STAGE(bufoff, (kp) + (h) * hstepA, voffA); } } while (0)
#define PG8_LDA(dst, b, h) do { _Pragma("unroll") for (int m = 0; m < 4; ++m) _Pragma("unroll") for (int k = 0; k < 2; ++k) dst[m][k] = *(const LAS bf16x8*)(lds + PG8_SA(b, h) + (k ? aoff1 : aoff0) + m * 2048); } while (0)
#define PG8_LDB(dst, b, h) do { _Pragma("unroll") for (int n = 0; n < 2; ++n) _Pragma("unroll") for (int k = 0; k < 2; ++k) dst[n][k] = *(const LAS bf16x8*)(lds + PG8_SB(b, h) + (k ? boff1 : boff0) + n * 2048); } while (0)
#define PG8_F8OP(X) __builtin_bit_cast(v8i32, __builtin_shufflevector(X[0], X[1], 0, 1, 2, 3, 4, 5, 6, 7, 8, 9, 10, 11, 12, 13, 14, 15))
#define PG8_MMA(ai, bj, At, Bt) do { __builtin_amdgcn_s_setprio(1); if constexpr (F8) { _Pragma("unroll") for (int m = 0; m < 4; ++m) _Pragma("unroll") for (int n = 0; n < 2; ++n) \
        asm volatile("v_mfma_scale_f32_16x16x128_f8f6f4 %0, %1, %2, %0, %3, %3 op_sel_hi:[0,0,0]" : "+v"(acc[ai][bj][m][n]) : "v"(PG8_F8OP(Bt[n])), "v"(PG8_F8OP(At[m])), "v"(one_scale)); } \
        else { _Pragma("unroll") for (int m = 0; m < 4; ++m) _Pragma("unroll") for (int n = 0; n < 2; ++n) _Pragma("unroll") for (int k = 0; k < 2; ++k) \
        acc[ai][bj][m][n] = __builtin_amdgcn_mfma_f32_16x16x32_bf16(Bt[n][k], At[m][k], acc[ai][bj][m][n], 0, 0, 0); } __builtin_amdgcn_s_setprio(0); } while (0)
#define PG8_WAIT_V(n) asm volatile("s_waitcnt vmcnt(" #n ")" ::: "memory")
#define PG8_WAIT_L(n) asm volatile("s_waitcnt lgkmcnt(" #n ")" ::: "memory")
#define PG8_BAR __builtin_amdgcn_s_barrier()
#define PG8_SCHED __builtin_amdgcn_sched_barrier(0)
    Unit cur, nxt; int ui = 0;
    if (!S.next(0, cur)) return;
    int one_scale = 0x7f7f7f7f; if constexpr (F8) asm volatile("" : "+v"(one_scale));
    unsigned gC[2][2], gN[2][2];
#pragma unroll
    for (int h = 0; h < 2; ++h)
#pragma unroll
        for (int i = 0; i < 2; ++i) { gC[h][i] = GATHER ? S.row_off(cur, h * HALF + RA[i]) + (unsigned)CA2[i] : 0u; gN[h][i] = gC[h][i]; }
    f32x4 acc[2][2][4][2];
#pragma unroll
    for (int a = 0; a < 2; ++a)
#pragma unroll
        for (int b = 0; b < 2; ++b)
#pragma unroll
            for (int m = 0; m < 4; ++m)
#pragma unroll
                for (int n = 0; n < 2; ++n) acc[a][b][m][n] = (f32x4){0.f, 0.f, 0.f, 0.f};
    bf16x8 At[4][2], B0[2][2], B1[2][2];
    const char* cA = S.a_ptr(g, cur); const char* cB = S.b_ptr(g, cur);
    PG8_STAGE(PG8_SB(0, 0), cB, voffB); PG8_STAGE(PG8_SB(0, 1), cB + hstepB, voffB); PG8_STAGE_A(PG8_SA(0, 0), cA, 0, false); PG8_STAGE_A(PG8_SA(0, 1), cA, 1, false);
    if (wr == 1) PG8_BAR;
    PG8_WAIT_V(2); PG8_BAR;
    PG8_STAGE(PG8_SB(1, 0), cB + kstep, voffB); PG8_STAGE_A(PG8_SA(1, 0), cA + kstep, 0, false); PG8_STAGE(PG8_SB(1, 1), cB + hstepB + kstep, voffB);
    PG8_WAIT_V(6); PG8_BAR;
    for (;;) {
        const bool has_next = S.next(ui + 1, nxt);
        const char* nA = has_next ? S.a_ptr(g, nxt) : cA; const char* nB = has_next ? S.b_ptr(g, nxt) : cB;
        if constexpr (GATHER) { if (has_next) {
#pragma unroll
            for (int h = 0; h < 2; ++h)
#pragma unroll
                for (int i = 0; i < 2; ++i) gN[h][i] = S.row_off(nxt, h * HALF + RA[i]) + (unsigned)CA2[i]; } }
#pragma unroll 1
        for (int t = 0; t < nt; t += 2) {
            const bool last = (t == nt - 2);
            asm volatile("" : "+v"(voffA[0]), "+v"(voffA[1]), "+v"(voffB[0]), "+v"(voffB[1]));
            if constexpr (Epi::HAS_MID) { if (t == Epi::MID_T) E.mid(acc, cur, wr, wc, fr, fq); }
            const char* a1 = cA + (size_t)(t + 1) * kstep;
            const char* a2 = last ? nA : cA + (size_t)(t + 2) * kstep; const char* b2 = last ? nB : cB + (size_t)(t + 2) * kstep;
            const char* a3 = a2 + kstep; const char* b3 = b2 + kstep;
            PG8_LDB(B0, 0, 0); PG8_LDB(B1, 0, 1); PG8_SCHED; PG8_LDA(At, 0, 0); PG8_STAGE_A(PG8_SA(1, 1), a1, 1, false);
            PG8_WAIT_V(8); PG8_WAIT_L(0); PG8_BAR; PG8_MMA(0, 0, At, B0); PG8_MMA(0, 1, At, B1); PG8_BAR; PG8_SCHED;
            PG8_LDA(At, 0, 1); PG8_STAGE(PG8_SB(0, 0), b2, voffB); PG8_STAGE(PG8_SB(0, 1), b2 + hstepB, voffB); PG8_STAGE_A(PG8_SA(0, 0), a2, 0, last);
            PG8_WAIT_V(8); PG8_WAIT_L(0); PG8_BAR; PG8_MMA(1, 0, At, B0); PG8_MMA(1, 1, At, B1); PG8_BAR; PG8_SCHED;
            PG8_LDB(B0, 1, 0); PG8_LDB(B1, 1, 1); PG8_SCHED; PG8_LDA(At, 1, 0); PG8_STAGE_A(PG8_SA(0, 1), a2, 1, last);
            PG8_WAIT_V(8); PG8_WAIT_L(0); PG8_BAR; PG8_MMA(0, 0, At, B0); PG8_MMA(0, 1, At, B1); PG8_BAR; PG8_SCHED;
            PG8_LDA(At, 1, 1); PG8_STAGE(PG8_SB(1, 0), b3, voffB); PG8_STAGE(PG8_SB(1, 1), b3 + hstepB, voffB); PG8_STAGE_A(PG8_SA(1, 0), a3, 0, last);
            PG8_WAIT_V(8); PG8_WAIT_L(0); PG8_BAR; PG8_MMA(1, 0, At, B0); PG8_MMA(1, 1, At, B1); PG8_BAR; PG8_SCHED;
        }
        if constexpr (ALIGN_EPI) { if (wr == 0) PG8_BAR; }
        if constexpr (F8) asm volatile("s_nop 15\n\ts_nop 15" ::: "memory");
        if constexpr (!Epi::AFTER_DRAIN) { E(acc, cur, wr, wc, fr, fq); }
        if (!has_next) break;
#pragma unroll
        for (int a = 0; a < 2; ++a)
#pragma unroll
            for (int b = 0; b < 2; ++b)
#pragma unroll
                for (int m = 0; m < 4; ++m)
#pragma unroll
                    for (int n = 0; n < 2; ++n) acc[a][b][m][n] = (f32x4){0.f, 0.f, 0.f, 0.f};
        cur = nxt; cA = nA; cB = nB; ++ui;
#pragma unroll
        for (int h = 0; h < 2; ++h)
#pragma unroll
            for (int i = 0; i < 2; ++i) gC[h][i] = gN[h][i];
        if constexpr (ALIGN_EPI) { if (wr == 1) PG8_BAR; }
    }
    PG8_WAIT_V(0);
    if constexpr (!ALIGN_EPI) { if (wr == 0) PG8_BAR; }
    PG8_BAR;
    if constexpr (Epi::AFTER_DRAIN) { E.fused(acc, cur, wr, wc, fr, fq, lds, wid, lane); }
#undef PG8_SA
#undef PG8_SB
#undef PG8_STAGE
#undef PG8_STAGE_A
#undef PG8_LDA
#undef PG8_LDB
#undef PG8_MMA
#undef PG8_F8OP
#undef PG8_WAIT_V
#undef PG8_WAIT_L
#undef PG8_BAR
#undef PG8_SCHED
}
}

namespace pg8 {
struct EpiInProj {
    static constexpr bool PERM = true, AFTER_DRAIN = false, HAS_MID = false; static constexpr int MID_T = 0;
    unsigned char* HQ; unsigned char* SG; float rs;
    __device__ __forceinline__ void mid(f32x4 (&)[2][2][4][2], const Unit&, int, int, int, int) const {}
    __device__ __forceinline__ void operator()(const f32x4 (&acc)[2][2][4][2], const Unit& u, int wr, int wc, int fr, int fq) const {
        const int row0 = u.pm * BM + wr * 64 + opaque(fr), pn = u.pn;
        const bool gate = pn >= 14; const bool qs = (pn < 3) || (pn >= 9 && pn < 13);
        const float sc = (qs ? QSCALE : 1.0f) * rs; const int dcol = (wc & 1) * 32 + 8 * fq;
#pragma unroll
        for (int ai = 0; ai < 2; ++ai)
#pragma unroll
            for (int m = 0; m < 4; ++m) { const int row = row0 + ai * HALF + m * 16, b = row >> 12, t = row & (SEQ - 1);
#pragma unroll
                for (int bj = 0; bj < 2; ++bj) { f32x4 v0 = acc[ai][bj][m][0], v1 = acc[ai][bj][m][1];
                    bf16_t* dst;
                    if (gate) {
#pragma unroll
                        for (int q = 0; q < 4; ++q) { v0[q] = fmaxf(fast_sigmoid(v0[q] * rs) * SSG, 0.001953125f); v1[q] = fmaxf(fast_sigmoid(v1[q] * rs) * SSG, 0.001953125f); }
                        u32x2 w8; w8.x = pk4_fp8(v0[0], v0[1], v0[2], v0[3]); w8.y = pk4_fp8(v1[0], v1[1], v1[2], v1[3]);
                        *(u32x2*)(SG + (size_t)row * SG_P + (pn - 14) * 256 + bj * HALF + wc * 32 + 8 * fq) = w8; continue; }
                    else { v0 = v0 * sc; v1 = v1 * sc; const int hl = bj * 2 + (wc >> 1);
                        size_t rowi; unsigned char* base8; float qk; bool is8;
                        if (pn < 9) { const int ty = pn / 3, g = pn - 3 * ty, sh = 2 * g, pos = ((t & ((1 << sh) - 1)) << (12 - sh)) + (t >> sh);
                            rowi = (size_t)(((g * NB + b) * 4 + hl) * SEQ + pos); base8 = HQ + (size_t)ty * (48 * MiB); is8 = ty < 2; qk = ty == 0 ? SQ : SK; }
                        else if (pn < 13) { rowi = (size_t)((b * 16 + (pn - 9) * 4 + hl) * SEQ + t); base8 = HQ + HQ_QS; is8 = true; qk = SQ; }
                        else { rowi = (size_t)((b * 2 + (wc >> 1)) * SEQ + t); base8 = HQ + (bj ? HQ_VS : HQ_KS); is8 = (bj == 0); qk = SK; }
                        if (is8) { u32x2 w8; w8.x = pk4_fp8(clamp_fp8(v0[0] * qk), clamp_fp8(v0[1] * qk), clamp_fp8(v0[2] * qk), clamp_fp8(v0[3] * qk)); w8.y = pk4_fp8(clamp_fp8(v1[0] * qk), clamp_fp8(v1[1] * qk), clamp_fp8(v1[2] * qk), clamp_fp8(v1[3] * qk));
                            *(u32x2*)(base8 + rowi * 64 + dcol) = w8; continue; }
                        dst = (bf16_t*)base8 + rowi * 64 + dcol; }
                    u32x4 w; w.x = cvt_pk_bf16(v0[0], v0[1]); w.y = cvt_pk_bf16(v0[2], v0[3]); w.z = cvt_pk_bf16(v1[0], v1[1]); w.w = cvt_pk_bf16(v1[2], v1[3]);
                    *(u32x4*)dst = w; } }
    }
};
struct EpiGate {
    static constexpr bool PERM = true, AFTER_DRAIN = false, HAS_MID = true; static constexpr int MID_T = 2;
    const unsigned char* __restrict__ SG; unsigned char* __restrict__ O;
    __device__ __forceinline__ void mid(f32x4 (&acc)[2][2][4][2], const Unit& u, int wr, int wc, int fr, int fq) const {
        const int row0 = u.pm * BM + wr * 64 + opaque(fr), col0 = u.pn * BM + wc * 32 + 8 * opaque(fq);
#pragma unroll
        for (int ai = 0; ai < 2; ++ai) {
            u32x2 a[4][2], b[4][2];
#pragma unroll
            for (int mm = 0; mm < 4; ++mm) { const unsigned char* sp = SG + (size_t)(row0 + ai * HALF + mm * 16) * SG_P + col0;
#pragma unroll
                for (int bj = 0; bj < 2; ++bj) { a[mm][bj] = *(const u32x2*)(sp + bj * HALF); b[mm][bj] = *(const u32x2*)(sp + 1024 + bj * HALF); } }
#pragma unroll
            for (int m = 0; m < 4; ++m) {
#pragma unroll
                for (int bj = 0; bj < 2; ++bj) {
#pragma unroll
                    for (int n = 0; n < 2; ++n) { const int aw = (int)a[m][bj][n], bw = (int)b[m][bj][n];
                        const f32x2 al = __builtin_amdgcn_cvt_pk_f32_fp8(aw, false), ah = __builtin_amdgcn_cvt_pk_f32_fp8(aw, true), bl = __builtin_amdgcn_cvt_pk_f32_fp8(bw, false), bh = __builtin_amdgcn_cvt_pk_f32_fp8(bw, true);
                        f32x4 r; r[0] = al[0] * __builtin_amdgcn_rcpf(bl[0]); r[1] = al[1] * __builtin_amdgcn_rcpf(bl[1]); r[2] = ah[0] * __builtin_amdgcn_rcpf(bh[0]); r[3] = ah[1] * __builtin_amdgcn_rcpf(bh[1]);
                        acc[ai][bj][m][n] = acc[ai][bj][m][n] * r; } }
                asm volatile("" : "+v"(acc[ai][0][m][0]), "+v"(acc[ai][0][m][1]), "+v"(acc[ai][1][m][0]), "+v"(acc[ai][1][m][1])); }
            asm volatile("" ::: "memory"); }
    }
    __device__ __forceinline__ void operator()(const f32x4 (&acc)[2][2][4][2], const Unit& u, int wr, int wc, int fr, int fq) const {
        const int row0 = u.pm * BM + wr * 64 + opaque(fr), col0 = u.pn * BM + wc * 32 + 8 * opaque(fq);
        constexpr float FS = SM / (SO * SW * SSG);
#pragma unroll
        for (int ai = 0; ai < 2; ++ai) {
            u32x2 bq[4][2];
#pragma unroll
            for (int m = 0; m < 4; ++m)
#pragma unroll
                for (int bj = 0; bj < 2; ++bj) bq[m][bj] = *(const u32x2*)(SG + (size_t)(row0 + ai * HALF + m * 16) * SG_P + 1024 + col0 + bj * HALF);
#pragma unroll
            for (int m = 0; m < 4; ++m) { unsigned char* op = O + (size_t)(row0 + ai * HALF + m * 16) * D + col0;
#pragma unroll
                for (int bj = 0; bj < 2; ++bj) { u32x2 w;
#pragma unroll
                    for (int n = 0; n < 2; ++n) { const int bw = (int)bq[m][bj][n]; const f32x2 bl = __builtin_amdgcn_cvt_pk_f32_fp8(bw, false), bh = __builtin_amdgcn_cvt_pk_f32_fp8(bw, true); const f32x4 v = acc[ai][bj][m][n] * FS;
                        w[n] = pk4_fp8(clamp_fp8(v[0] * bl[0]), clamp_fp8(v[1] * bl[1]), clamp_fp8(v[2] * bh[0]), clamp_fp8(v[3] * bh[1])); }
                    *(u32x2*)(op + bj * HALF) = w; } }
            asm volatile("" ::: "memory"); }
    }
};

struct PanelStats {
    unsigned* xbuf;
    unsigned* cnt;
    unsigned* tmo;
    int pm_off; float eps; unsigned code;
    __device__ __forceinline__ bool run(const f32x4 (&v)[2][2][4][2], const Unit& u, int wr, int wc, int fr, int fq, LAS unsigned char* lds, int wid, int lane) const {
        LAS f32x2* P = (LAS f32x2*)lds;
        LAS f32x2* S = (LAS f32x2*)(lds + 8192);
        LAS unsigned* flag = (LAS unsigned*)(lds + 8192 + 2048);
        const int panel = u.pm + pm_off;
#pragma unroll
        for (int ai = 0; ai < 2; ++ai)
#pragma unroll
            for (int m = 0; m < 4; ++m) {
                float s = 0.f;
#pragma unroll
                for (int bj = 0; bj < 2; ++bj)
#pragma unroll
                    for (int n = 0; n < 2; ++n) { const f32x4 x = v[ai][bj][m][n]; s += (x[0] + x[1]) + (x[2] + x[3]); }
                s += __shfl_xor(s, 16); s += __shfl_xor(s, 32);
                const float mw = s * (1.0f / 64.0f); float q = 0.f;
#pragma unroll
                for (int bj = 0; bj < 2; ++bj)
#pragma unroll
                    for (int n = 0; n < 2; ++n) { const f32x4 d = v[ai][bj][m][n] - mw; q += (d[0] * d[0] + d[1] * d[1]) + (d[2] * d[2] + d[3] * d[3]); }
                q += __shfl_xor(q, 16); q += __shfl_xor(q, 32);
                if (fq == 0) P[(ai * HALF + wr * 64 + m * 16 + fr) * 4 + wc] = (f32x2){mw, q};
            }
        asm volatile("s_waitcnt lgkmcnt(0)" ::: "memory"); __builtin_amdgcn_s_barrier(); asm volatile("" ::: "memory");
        const int row = wid * 32 + (lane & 31);
        if (lane < 32) {
            const f32x2 a = P[row * 4 + 0], b = P[row * 4 + 1], c = P[row * 4 + 2], d = P[row * 4 + 3];
            const float mt = (a.x + b.x + c.x + d.x) * 0.25f;
            const float da = a.x - mt, db = b.x - mt, dc = c.x - mt, dd = d.x - mt;
            const float m2 = (a.y + b.y) + (c.y + d.y) + 64.0f * ((da * da + db * db) + (dc * dc + dd * dd));
            unsigned long long* slot = (unsigned long long*)xbuf + ((size_t)(panel * BM + row) * 4 + u.pn);
            __hip_atomic_store(slot, ((unsigned long long)__float_as_uint(m2) << 32) | __float_as_uint(mt), __ATOMIC_RELAXED, __HIP_MEMORY_SCOPE_AGENT);
        }
        asm volatile("s_waitcnt vmcnt(0)" ::: "memory");
        if (lane == 0) __hip_atomic_fetch_add(cnt + 64 * panel, 1u, __ATOMIC_RELAXED, __HIP_MEMORY_SCOPE_AGENT);
        if (wid == 0) {
            bool dead = false; const unsigned long long t0 = __builtin_amdgcn_s_memrealtime(); const unsigned want = 8u * 4u;
            for (;;) {
                if ((unsigned)__builtin_amdgcn_readfirstlane(__hip_atomic_load(cnt + 64 * panel, __ATOMIC_RELAXED, __HIP_MEMORY_SCOPE_AGENT)) >= want) break;
                if (__builtin_amdgcn_s_memrealtime() - t0 > 2000000ull) {
                    if (lane == 0) { unsigned expect = 0u; __hip_atomic_compare_exchange_strong(tmo + 1, &expect, code | (unsigned)(panel & 0xff), __ATOMIC_RELAXED, __ATOMIC_RELAXED, __HIP_MEMORY_SCOPE_AGENT);
                                     __hip_atomic_store(tmo, 1u, __ATOMIC_RELAXED, __HIP_MEMORY_SCOPE_AGENT); }
                    dead = true; break; }
                __builtin_amdgcn_s_sleep(2);
            }
            __builtin_amdgcn_fence(__ATOMIC_ACQUIRE, "agent");
            if (lane == 0) flag[0] = dead ? 1u : 0u;
        }
        asm volatile("s_waitcnt vmcnt(0) lgkmcnt(0)" ::: "memory"); __builtin_amdgcn_s_barrier(); asm volatile("" ::: "memory");
        const bool bad = flag[0] != 0u;
        if (lane < 32) {
            const unsigned long long* slot = (const unsigned long long*)xbuf + (size_t)(panel * BM + row) * 4; float mt[4], m2[4]; float ms = 0.f;
#pragma unroll
            for (int t = 0; t < 4; ++t) { const unsigned long long w = __hip_atomic_load(slot + t, __ATOMIC_RELAXED, __HIP_MEMORY_SCOPE_AGENT); mt[t] = __uint_as_float((unsigned)w); m2[t] = __uint_as_float((unsigned)(w >> 32)); ms += mt[t]; }
            const float mean = ms * 0.25f; float q = 0.f;
#pragma unroll
            for (int t = 0; t < 4; ++t) { const float dm = mt[t] - mean; q += m2[t] + 256.0f * dm * dm; }
            S[row] = (f32x2){mean, 1.0f / sqrtf(q * (1.0f / 1024.0f) + eps)};
        }
        asm volatile("s_waitcnt lgkmcnt(0)" ::: "memory"); __builtin_amdgcn_s_barrier(); asm volatile("" ::: "memory");
        return bad;
    }
};
struct EpiLn1 {
    static constexpr bool PERM = true, AFTER_DRAIN = true, HAS_MID = false; static constexpr int MID_T = 0;
    const float* x; float* out; bf16_t* xb; unsigned char* xq; const float* gam; const float* bet; PanelStats st; int row_off; unsigned poison; float rs;
    __device__ __forceinline__ void mid(f32x4 (&)[2][2][4][2], const Unit&, int, int, int, int) const {}
    __device__ __forceinline__ void operator()(const f32x4 (&)[2][2][4][2], const Unit&, int, int, int, int) const {}
    __device__ __forceinline__ void fused(f32x4 (&acc)[2][2][4][2], const Unit& u, int wr, int wc, int fr, int fq, LAS unsigned char* lds, int wid, int lane) const {
        const LAS f32x2* S = (const LAS f32x2*)(lds + 8192);
        const int col0 = u.pn * BM + wc * 32 + 8 * opaque(fq);
        const int grow0 = row_off + u.pm * BM; fr = opaque(fr);
#pragma unroll
        for (int ai = 0; ai < 2; ++ai)
#pragma unroll
            for (int m = 0; m < 4; ++m) { const size_t off = (size_t)(grow0 + ai * HALF + wr * 64 + m * 16 + fr) * D + col0;
#pragma unroll
                for (int bj = 0; bj < 2; ++bj)
#pragma unroll
                    for (int n = 0; n < 2; ++n) { const f32x4 bs = *(const f32x4*)(x + off + bj * HALF + n * 4); acc[ai][bj][m][n] = acc[ai][bj][m][n] * rs + bs * DN_ALPHA; }
                asm volatile("" : "+v"(acc[ai][0][m][0]), "+v"(acc[ai][0][m][1]), "+v"(acc[ai][1][m][0]), "+v"(acc[ai][1][m][1]));
                if (m == 3) asm volatile("" ::: "memory"); }
        const bool bad = st.run(acc, u, wr, wc, fr, fq, lds, wid, lane) || poison != 0u;
        const float qnan = __builtin_nanf("");
        f32x4 gv[2][2], bv[2][2];
#pragma unroll
        for (int bj = 0; bj < 2; ++bj)
#pragma unroll
            for (int n = 0; n < 2; ++n) { gv[bj][n] = *(const f32x4*)(gam + col0 + bj * HALF + n * 4); bv[bj][n] = *(const f32x4*)(bet + col0 + bj * HALF + n * 4); }
#pragma unroll
        for (int ai = 0; ai < 2; ++ai)
#pragma unroll
            for (int m = 0; m < 4; ++m) { const int r = ai * HALF + wr * 64 + m * 16 + fr; const f32x2 sr = S[r]; const size_t off = (size_t)(grow0 + r) * D + col0;
#pragma unroll
                for (int bj = 0; bj < 2; ++bj) { f32x4 o0 = (acc[ai][bj][m][0] - sr.x) * sr.y * gv[bj][0] + bv[bj][0], o1 = (acc[ai][bj][m][1] - sr.x) * sr.y * gv[bj][1] + bv[bj][1];
                    if (bad) { o0 = (f32x4){qnan, qnan, qnan, qnan}; o1 = o0; }
                    u32x4 w; w.x = cvt_pk_bf16(o0[0], o0[1]); w.y = cvt_pk_bf16(o0[2], o0[3]); w.z = cvt_pk_bf16(o1[0], o1[1]); w.w = cvt_pk_bf16(o1[2], o1[3]); *(u32x4*)(xb + off + bj * HALF) = w;
                    u32x2 q8; q8.x = pk4_fp8(clamp_fp8(o0[0] * SX), clamp_fp8(o0[1] * SX), clamp_fp8(o0[2] * SX), clamp_fp8(o0[3] * SX)); q8.y = pk4_fp8(clamp_fp8(o1[0] * SX), clamp_fp8(o1[1] * SX), clamp_fp8(o1[2] * SX), clamp_fp8(o1[3] * SX));
                    *(u32x2*)(xq + off + bj * HALF) = q8; } }
    }
};
struct EpiY {
    static constexpr bool PERM = true, AFTER_DRAIN = false, HAS_MID = false; static constexpr int MID_T = 0;
    const float* __restrict__ x; bf16_t* __restrict__ Y; float* __restrict__ ST; float rs;
    __device__ __forceinline__ void mid(f32x4 (&)[2][2][4][2], const Unit&, int, int, int, int) const {}
    __device__ __forceinline__ void operator()(const f32x4 (&acc)[2][2][4][2], const Unit& u, int wr, int wc, int fr, int fq) const {
        const int row0 = u.pm * BM + wr * 64 + opaque(fr), col0 = u.pn * BM + wc * 32 + 8 * opaque(fq);
#pragma unroll
        for (int ai = 0; ai < 2; ++ai) {
            f32x4 xv[4][2][2];
#pragma unroll
            for (int m = 0; m < 4; ++m)
#pragma unroll
                for (int bj = 0; bj < 2; ++bj)
#pragma unroll
                    for (int n = 0; n < 2; ++n) xv[m][bj][n] = *(const f32x4*)(x + (size_t)(row0 + ai * HALF + m * 16) * D + col0 + bj * HALF + n * 4);
#pragma unroll
            for (int m = 0; m < 4; ++m) { const size_t r = (size_t)(row0 + ai * HALF + m * 16); float s1 = 0.f, s2 = 0.f;
#pragma unroll
                for (int bj = 0; bj < 2; ++bj) { const f32x4 y0 = acc[ai][bj][m][0] * rs + xv[m][bj][0] * DN_ALPHA, y1 = acc[ai][bj][m][1] * rs + xv[m][bj][1] * DN_ALPHA;
                    s1 += (y0[0] + y0[1]) + (y0[2] + y0[3]) + (y1[0] + y1[1]) + (y1[2] + y1[3]);
                    s2 += (y0[0] * y0[0] + y0[1] * y0[1]) + (y0[2] * y0[2] + y0[3] * y0[3]) + (y1[0] * y1[0] + y1[1] * y1[1]) + (y1[2] * y1[2] + y1[3] * y1[3]);
                    u32x4 w; w.x = cvt_pk_bf16(y0[0], y0[1]); w.y = cvt_pk_bf16(y0[2], y0[3]); w.z = cvt_pk_bf16(y1[0], y1[1]); w.w = cvt_pk_bf16(y1[2], y1[3]);
                    *(u32x4*)(Y + r * D + col0 + bj * HALF) = w; }
                s1 += __shfl_xor(s1, 16); s1 += __shfl_xor(s1, 32); s2 += __shfl_xor(s2, 16); s2 += __shfl_xor(s2, 32);
                if (fq == 0) *(f32x2*)(ST + (r * 16 + u.pn * 4 + wc) * 2) = (f32x2){s1, s2}; }
            asm volatile("" ::: "memory"); }
    }
};
struct EpiGU {
    static constexpr bool PERM = true, AFTER_DRAIN = false, HAS_MID = false; static constexpr int MID_T = 0;
    const float* bg; const float* bu; unsigned char* H;
    __device__ __forceinline__ void mid(f32x4 (&)[2][2][4][2], const Unit&, int, int, int, int) const {}
    __device__ __forceinline__ void operator()(const f32x4 (&acc)[2][2][4][2], const Unit& u, int wr, int wc, int fr, int fq) const {
        const int row0 = u.pm * BM + wr * 64 + opaque(fr), j0 = u.pn * HALF + wc * 32 + 8 * opaque(fq);
        const f32x4 g0 = *(const f32x4*)(bg + u.e * DFF + j0), g1 = *(const f32x4*)(bg + u.e * DFF + j0 + 4);
        const f32x4 u0 = *(const f32x4*)(bu + u.e * DFF + j0), u1 = *(const f32x4*)(bu + u.e * DFF + j0 + 4);
#pragma unroll
        for (int ai = 0; ai < 2; ++ai)
#pragma unroll
            for (int m = 0; m < 4; ++m) {
                constexpr float RS = 1.0f / (SX * SW);
                f32x4 gt0 = acc[ai][0][m][0] * RS + g0, gt1 = acc[ai][0][m][1] * RS + g1, up0 = acc[ai][1][m][0] * RS + u0, up1 = acc[ai][1][m][1] * RS + u1; f32x4 h0, h1;
#pragma unroll
                for (int q = 0; q < 4; ++q) {
                    const float a = fminf(gt0[q], 7.0f), b = fminf(gt1[q], 7.0f);
                    const float ua = fminf(fmaxf(up0[q], -7.0f), 7.0f), ub = fminf(fmaxf(up1[q], -7.0f), 7.0f);
                    h0[q] = (a * __builtin_amdgcn_rcpf(1.0f + __builtin_amdgcn_exp2f(-1.702f * LOG2E * a))) * __builtin_fmaf(ua, SH, SH);
                    h1[q] = (b * __builtin_amdgcn_rcpf(1.0f + __builtin_amdgcn_exp2f(-1.702f * LOG2E * b))) * __builtin_fmaf(ub, SH, SH); }
                u32x2 w; w.x = pk4_fp8(h0[0], h0[1], h0[2], h0[3]); w.y = pk4_fp8(h1[0], h1[1], h1[2], h1[3]);
                *(u32x2*)(H + (size_t)(row0 + ai * HALF + m * 16) * DFF + j0) = w; }
    }
};
struct EpiDown {
    static constexpr bool PERM = true, AFTER_DRAIN = false, HAS_MID = false; static constexpr int MID_T = 0;
    const float* bd; const int* petok; const float* pegate; unsigned char* Y;
    __device__ __forceinline__ void mid(f32x4 (&)[2][2][4][2], const Unit&, int, int, int, int) const {}
    __device__ __forceinline__ void operator()(const f32x4 (&acc)[2][2][4][2], const Unit& u, int wr, int wc, int fr, int fq) const {
        const int r0 = wr * 64 + opaque(fr), col0 = u.pn * BM + wc * 32 + 8 * opaque(fq);
        f32x4 b[2][2];
#pragma unroll
        for (int bj = 0; bj < 2; ++bj) { b[bj][0] = *(const f32x4*)(bd + u.e * D + col0 + bj * HALF); b[bj][1] = *(const f32x4*)(bd + u.e * D + col0 + bj * HALF + 4); }
        const size_t eb = (size_t)u.e * NTOK + (size_t)u.ti * 256;
        int info[2][4]; float gwv[2][4];
#pragma unroll
        for (int ai = 0; ai < 2; ++ai)
#pragma unroll
            for (int m = 0; m < 4; ++m) { const int r = r0 + ai * HALF + m * 16; info[ai][m] = petok[eb + r]; gwv[ai][m] = pegate[eb + r] * SY; }
        if (u.valid == 256) {
#pragma unroll
        for (int ai = 0; ai < 2; ++ai)
#pragma unroll
            for (int m = 0; m < 4; ++m) { const int r = r0 + ai * HALF + m * 16;
                { const float gw = gwv[ai][m];
                    unsigned char* op = Y + (size_t)info[ai][m] * 1024 + col0;
#pragma unroll
                    for (int bj = 0; bj < 2; ++bj) { constexpr float RS = 1.0f / (SH * SW); const f32x4 v0 = (acc[ai][bj][m][0] * RS + b[bj][0]) * gw, v1 = (acc[ai][bj][m][1] * RS + b[bj][1]) * gw;
                        u32x2 w; w.x = pk4_fp8(clamp_fp8(v0[0]), clamp_fp8(v0[1]), clamp_fp8(v0[2]), clamp_fp8(v0[3])); w.y = pk4_fp8(clamp_fp8(v1[0]), clamp_fp8(v1[1]), clamp_fp8(v1[2]), clamp_fp8(v1[3]));
                        *(u32x2*)(op + bj * HALF) = w; } } }
        } else {
#pragma unroll
        for (int ai = 0; ai < 2; ++ai)
#pragma unroll
            for (int m = 0; m < 4; ++m) { const int r = r0 + ai * HALF + m * 16;
                if (r < u.valid) { const float gw = gwv[ai][m];
                    unsigned char* op = Y + (size_t)info[ai][m] * 1024 + col0;
#pragma unroll
                    for (int bj = 0; bj < 2; ++bj) { constexpr float RS = 1.0f / (SH * SW); const f32x4 v0 = (acc[ai][bj][m][0] * RS + b[bj][0]) * gw, v1 = (acc[ai][bj][m][1] * RS + b[bj][1]) * gw;
                        u32x2 w; w.x = pk4_fp8(clamp_fp8(v0[0]), clamp_fp8(v0[1]), clamp_fp8(v0[2]), clamp_fp8(v0[3])); w.y = pk4_fp8(clamp_fp8(v1[0]), clamp_fp8(v1[1]), clamp_fp8(v1[2]), clamp_fp8(v1[3]));
                        *(u32x2*)(op + bj * HALF) = w; } } }
        }
    }
};
}

#define XB_TMO      128
#define XB_XCNT(j)  (256  + 64 * (j))
#define XB_XSUB(j)  (1280 + 64 * (j))
#define XB_XGEN(j)  (2304 + 64 * (j))
#define XB_TOP      3328
#define XB_TOPGEN   3392
#define XCD_BAR_WORDS 3456
#define XB_SPIN_CAP (1u << 18)
__device__ __forceinline__ unsigned xb_ld(unsigned* p)              { return __hip_atomic_load(p, __ATOMIC_RELAXED, __HIP_MEMORY_SCOPE_AGENT); }
__device__ __forceinline__ unsigned xb_add(unsigned* p, unsigned v) { return __hip_atomic_fetch_add(p, v, __ATOMIC_RELAXED, __HIP_MEMORY_SCOPE_AGENT); }
__device__ __forceinline__ unsigned xb_xcc_id() { return (unsigned)__builtin_amdgcn_s_getreg((3 << 11) | 20) & 0xFu; }
#define XB_SPIN(cond, bar) do { unsigned _sp = 0; while (cond) { __builtin_amdgcn_s_sleep(1); \
    if ((++_sp & 255u) == 0u) { if (xb_ld(&(bar)[XB_TMO])) break; if (_sp > XB_SPIN_CAP) { atomicAdd(&(bar)[XB_TMO], 1u); break; } } } } while (0)
struct XcdBarrier { unsigned* bar; unsigned x; volatile LAS unsigned* st; };
__device__ __forceinline__ XcdBarrier xcd_barrier_post(unsigned* bar, volatile LAS unsigned* st) {
    XcdBarrier b; b.bar = bar; b.x = xb_xcc_id(); b.st = st;
    if (threadIdx.x == 0) (void)xb_add(&bar[XB_XCNT(b.x)], 1u);
    return b;
}
__device__ __forceinline__ void xcd_barrier_complete(unsigned* bar, unsigned x, unsigned& nloc, unsigned& nx) {
    const unsigned G = gridDim.x * gridDim.y * gridDim.z;
    unsigned sum, cnt, mine, sp = 0u;
    for (;;) {
        sum = 0u; cnt = 0u; mine = 0u;
#pragma unroll
        for (unsigned j = 0; j < 16; ++j) { const unsigned c = xb_ld(&bar[XB_XCNT(j)]); sum += c; cnt += (c > 0u) ? 1u : 0u; mine = (j == x) ? c : mine; }
        if (sum == G) break;
        __builtin_amdgcn_s_sleep(1);
        if ((++sp & 255u) == 0u) { if (xb_ld(&bar[XB_TMO])) break; if (sp > XB_SPIN_CAP) { atomicAdd(&bar[XB_TMO], 1u); break; } }
    }
    nloc = mine > 0u ? mine : 1u; nx = cnt > 0u ? cnt : 1u;
}
__device__ __forceinline__ void xcd_barrier(const XcdBarrier& b) {
    asm volatile("s_waitcnt vmcnt(0)" ::: "memory");
    __syncthreads();
    if (threadIdx.x == 0) {
        unsigned* bar = b.bar;
        __builtin_amdgcn_s_waitcnt(0);
        unsigned nloc = b.st[0], nx = b.st[1];
        if (nloc == 0u) { xcd_barrier_complete(bar, b.x, nloc, nx); b.st[0] = nloc; b.st[1] = nx; }
        const unsigned old = xb_add(&bar[XB_XSUB(b.x)], 1u);
        const unsigned gen = old / nloc;
        if (old + 1u == (gen + 1u) * nloc) {
            __builtin_amdgcn_fence(__ATOMIC_RELEASE, "agent");
            asm volatile("s_waitcnt vmcnt(0)" ::: "memory");
            const unsigned og = xb_add(&bar[XB_TOP], 1u);
            const unsigned tg = og / nx;
            if (og + 1u == (tg + 1u) * nx) xb_add(&bar[XB_TOPGEN], 1u);
            else XB_SPIN(xb_ld(&bar[XB_TOPGEN]) == tg, bar);
            __builtin_amdgcn_fence(__ATOMIC_ACQUIRE, "agent");
            xb_add(&bar[XB_XGEN(b.x)], 1u);
            asm volatile("s_waitcnt vmcnt(0)" ::: "memory");
        } else {
            XB_SPIN(xb_ld(&bar[XB_XGEN(b.x)]) == gen, bar);
            __builtin_amdgcn_fence(__ATOMIC_ACQUIRE, "agent");
            asm volatile("s_waitcnt vmcnt(0)" ::: "memory");
        }
    }
    __syncthreads();
}

constexpr int NWAVES = 8;
struct Frame {
    LAS unsigned char* lds; volatile LAS unsigned* MISC; gu32* ctl;
    int tid, lane, wave, vcu, G;
    unsigned char* ws; unsigned char* dout;
};
__device__ __forceinline__ float wave_sum(float v) {
#pragma unroll
    for (int o = 1; o < 64; o <<= 1) v += __shfl_xor(v, o);
    return v;
}
__device__ __forceinline__ void transpose_item(const float* W, int N, int k0, int n0, bf16_t* WT, int ldw, size_t drow0, int dcol0, LAS float* scr, int lane) {
#pragma unroll 8
    for (int i = 0; i < 32; ++i) { const int kk = 2 * i + (lane >> 5); scr[kk * 33 + (lane & 31)] = W[(size_t)(k0 + kk) * N + n0 + (lane & 31)]; }
    LDS_WAIT(); asm volatile("" ::: "memory");
    const int c = lane & 7;
#pragma unroll
    for (int j = 0; j < 4; ++j) { const int n = (lane >> 3) + 8 * j; const LAS float* s = scr + (8 * c) * 33 + n;
        u32x4 o; o.x = cvt_pk_bf16(s[0 * 33], s[1 * 33]); o.y = cvt_pk_bf16(s[2 * 33], s[3 * 33]); o.z = cvt_pk_bf16(s[4 * 33], s[5 * 33]); o.w = cvt_pk_bf16(s[6 * 33], s[7 * 33]);
        *(GAS u32x4*)(WT + (drow0 + n) * (size_t)ldw + dcol0 + 8 * c) = o; }
    LDS_WAIT(); asm volatile("" ::: "memory");
}
__device__ __forceinline__ void transpose_item_f8(const float* W, int N, int k0, int n0, unsigned char* WT, int ldw, size_t drow0, int dcol0, LAS float* scr, int lane);
__device__ __forceinline__ void p0_convert(Frame& F, const float* x, const float* w_in, const float* w_pa, const float* w_pb, const float* w_out, const float* rw) {
    LAS float* scr = (LAS float*)(F.lds + F.wave * 17408);
    const int gw = F.vcu * NWAVES + F.wave, NGW = F.G * NWAVES;
    unsigned char* WIN = F.dout + DO_WIN; unsigned char* WCAT = F.dout + DO_WCAT; unsigned char* WOUT = F.ws + WS_WOUT;
    constexpr int I_IN = (D / 128) * (IN_COLS / 32), I_OUT = (D / 128) * (D / 32), I_PA = (256 / 128) * (D / 32), I_PB = (D / 128) * (D / 32);
    for (int it = gw; it < I_IN + I_OUT + I_PA + I_PB; it += NGW) {
        int r = it;
        if (r < I_IN) { const int nb = IN_COLS / 32; transpose_item_f8(w_in, IN_COLS, 128 * (r / nb), 32 * (r % nb), WIN, D, (size_t)(32 * (r % nb)), 128 * (r / nb), scr, F.lane); continue; } r -= I_IN;
        if (r < I_OUT) { const int nb = D / 32; transpose_item_f8(w_out, D, 128 * (r / nb), 32 * (r % nb), WOUT, D, (size_t)(32 * (r % nb)), 128 * (r / nb), scr, F.lane); continue; } r -= I_OUT;
        if (r < I_PA) { const int nb = D / 32; transpose_item_f8(w_pa, D, 128 * (r / nb), 32 * (r % nb), WCAT, OAB_P, (size_t)(32 * (r % nb)), 128 * (r / nb), scr, F.lane); continue; } r -= I_PA;
        { const int nb = D / 32; transpose_item_f8(w_pb, D, 128 * (r / nb), 32 * (r % nb), WCAT, OAB_P, (size_t)(32 * (r % nb)), 256 + 128 * (r / nb), scr, F.lane); }
    }
    { bf16_t* WRT = (bf16_t*)(F.ws + WS_WRT);
      for (int i = gw * 64 + F.lane; i < NEXP * D; i += NGW * 64) { const int e = i >> 10, k = i & (D - 1); const float w = rw[k * NEXP + e];
          const unsigned hi = cvt_pk_bf16(w, 0.f) & 0xffffu; const float r = w - __uint_as_float(hi << 16);
          WRT[i] = (bf16_t)hi; WRT[NEXP * D + i] = (bf16_t)(cvt_pk_bf16(r, 0.f) & 0xffffu); } }
    unsigned char* XQ = F.dout + DO_XB;
    const size_t n16 = (size_t)NTOK * D / 16;
    for (size_t i = (size_t)gw * 64 + F.lane; i < n16; i += (size_t)NGW * 64) {
        const f32x4 a = *(const GAS f32x4*)(x + i * 16), b = *(const GAS f32x4*)(x + i * 16 + 4), c = *(const GAS f32x4*)(x + i * 16 + 8), d = *(const GAS f32x4*)(x + i * 16 + 12);
        u32x4 o;
        o.x = pk4_fp8(clamp_fp8(a[0] * SXIN), clamp_fp8(a[1] * SXIN), clamp_fp8(a[2] * SXIN), clamp_fp8(a[3] * SXIN)); o.y = pk4_fp8(clamp_fp8(b[0] * SXIN), clamp_fp8(b[1] * SXIN), clamp_fp8(b[2] * SXIN), clamp_fp8(b[3] * SXIN));
        o.z = pk4_fp8(clamp_fp8(c[0] * SXIN), clamp_fp8(c[1] * SXIN), clamp_fp8(c[2] * SXIN), clamp_fp8(c[3] * SXIN)); o.w = pk4_fp8(clamp_fp8(d[0] * SXIN), clamp_fp8(d[1] * SXIN), clamp_fp8(d[2] * SXIN), clamp_fp8(d[3] * SXIN));
        *(GAS u32x4*)(XQ + i * 16) = o;
    }
}
__device__ __forceinline__ void transpose_item_f8(const float* W, int N, int k0, int n0, unsigned char* WT, int ldw, size_t drow0, int dcol0, LAS float* scr, int lane) {
    f32x4 wv[16];
#pragma unroll
    for (int i = 0; i < 16; ++i) wv[i] = *(const GAS f32x4*)(W + (size_t)(k0 + 8 * i + (lane >> 3)) * N + n0 + (lane & 7) * 4);
#pragma unroll
    for (int i = 0; i < 16; ++i) { LAS float* d = scr + (8 * i + (lane >> 3)) * 33 + (lane & 7) * 4; d[0] = wv[i][0]; d[1] = wv[i][1]; d[2] = wv[i][2]; d[3] = wv[i][3]; }
    LDS_WAIT(); asm volatile("" ::: "memory");
    const int c = lane & 7;
#pragma unroll
    for (int j = 0; j < 4; ++j) { const int n = (lane >> 3) + 8 * j; const LAS float* s = scr + (16 * c) * 33 + n;
        u32x4 o;
        o.x = pk4_fp8(clamp_fp8(s[0 * 33] * SW), clamp_fp8(s[1 * 33] * SW), clamp_fp8(s[2 * 33] * SW), clamp_fp8(s[3 * 33] * SW));
        o.y = pk4_fp8(clamp_fp8(s[4 * 33] * SW), clamp_fp8(s[5 * 33] * SW), clamp_fp8(s[6 * 33] * SW), clamp_fp8(s[7 * 33] * SW));
        o.z = pk4_fp8(clamp_fp8(s[8 * 33] * SW), clamp_fp8(s[9 * 33] * SW), clamp_fp8(s[10 * 33] * SW), clamp_fp8(s[11 * 33] * SW));
        o.w = pk4_fp8(clamp_fp8(s[12 * 33] * SW), clamp_fp8(s[13 * 33] * SW), clamp_fp8(s[14 * 33] * SW), clamp_fp8(s[15 * 33] * SW));
        *(GAS u32x4*)(WT + (drow0 + n) * (size_t)ldw + dcol0 + 16 * c) = o; }
    LDS_WAIT(); asm volatile("" ::: "memory");
}
__device__ __forceinline__ void p3_convert_moe(Frame& F, const float* w_gate, const float* w_up, const float* w_down, int wg, int nwg) {
    LAS float* scr = (LAS float*)(F.lds + F.wave * 17408);
    const int gw = wg * NWAVES + F.wave, NGW = nwg * NWAVES;
    unsigned char* WGU = F.ws + WS_WGU; unsigned char* WD = F.ws + WS_WD;
    constexpr int IPM = (D / 128) * (DFF / 32);
    for (int it = gw; it < NEXP * 3 * IPM; it += NGW) {
        const int e = it / (3 * IPM), r3 = it % (3 * IPM), which = r3 / IPM, r = r3 % IPM, kb = r / 32, nb = r % 32, k0 = 128 * kb, n0 = 32 * nb;
        const size_t moff = (size_t)e * D * DFF;
        if (which == 2) transpose_item_f8(w_down + moff, D, k0, n0, WD + moff, DFF, (size_t)n0, k0, scr, F.lane);
        else { const int pn = n0 >> 7, jj = n0 & 127; transpose_item_f8((which ? w_up : w_gate) + moff, DFF, k0, n0, WGU + 2 * moff, D, (size_t)(256 * pn + 128 * which + jj), k0, scr, F.lane); }
    }
}
typedef short v4i16_t __attribute__((ext_vector_type(4)));
__device__ __forceinline__ s16x4 tr_read(const LAS unsigned char* p) { return __builtin_bit_cast(s16x4, __builtin_amdgcn_ds_read_tr16_b64_v4i16((LAS v4i16_t*)p)); }
template <int C>
__device__ __forceinline__ void tr_read8(s16x4 (&r)[8], unsigned addr) {
#define TRR(i) asm volatile("ds_read_b64_tr_b16 %0, %1 offset:%2" : "=v"(r[i]) : "v"(addr), "n"(C * 4096 + (i) * 512))
    TRR(0); TRR(1); TRR(2); TRR(3); TRR(4); TRR(5); TRR(6); TRR(7);
#undef TRR
}
__device__ __forceinline__ void tr_wait8(s16x4 (&r)[8]) {
    asm volatile("s_waitcnt lgkmcnt(0)" : "+v"(r[0]), "+v"(r[1]), "+v"(r[2]), "+v"(r[3]), "+v"(r[4]), "+v"(r[5]), "+v"(r[6]), "+v"(r[7]));
}
template <int C>
__device__ __forceinline__ void pv_tile(s16x4 (&cur)[8], s16x4 (&prev)[8], bf16x8 (&pf)[2], bf16x8 (&pfprev)[2], unsigned vbase, const f32x16& Sc, f32x16 (&O)[2]) {
#pragma unroll
    for (int s = 0; s < 2; ++s) { u32x4 w; w.x = cvt_pk_bf16(Sc[8 * s + 0], Sc[8 * s + 1]); w.y = cvt_pk_bf16(Sc[8 * s + 2], Sc[8 * s + 3]);
        w.z = cvt_pk_bf16(Sc[8 * s + 4], Sc[8 * s + 5]); w.w = cvt_pk_bf16(Sc[8 * s + 6], Sc[8 * s + 7]); pf[s] = __builtin_bit_cast(bf16x8, w); }
    tr_read8<C>(cur, vbase);
    if (C > 0) { asm volatile("" :: "v"(prev[0]), "v"(prev[1]), "v"(prev[2]), "v"(prev[3]), "v"(prev[4]), "v"(prev[5]), "v"(prev[6]), "v"(prev[7]) : "memory");
                 asm volatile("" :: "v"(pfprev[0]), "v"(pfprev[1]) : "memory"); }
    tr_wait8(cur);
    __builtin_amdgcn_sched_barrier(0);
#pragma unroll
    for (int blk = 0; blk < 2; ++blk)
#pragma unroll
        for (int s = 0; s < 2; ++s) { const s16x4 lo = cur[(blk * 2 + s) * 2], hi = cur[(blk * 2 + s) * 2 + 1];
            O[blk] = __builtin_amdgcn_mfma_f32_32x32x16_bf16((bf16x8){lo[0], lo[1], lo[2], lo[3], hi[0], hi[1], hi[2], hi[3]}, pf[s], O[blk], 0, 0, 0); }
    __builtin_amdgcn_sched_barrier(0);
}
constexpr int ATT_KOFF = 0, ATT_QOFF = 12 * 2048, ATT_VOFF = 12 * 4096, ATT_STG = 24 * 4096, ATT_STGW = 4608;
static_assert(ATT_STG + 8 * ATT_STGW <= SCR_BYTES, "attention LDS map");
struct AKV { const unsigned char* qseq; const unsigned char* kseq; const bf16_t* vseq; int jt0, nkt, jq; };
__device__ __forceinline__ AKV attn_kv(const Frame& F, int U) {
    const unsigned char* HQ = F.ws + WS_HQ; AKV r;
    if (U < 2048) {
        const int b = U >> 8, kvh = (U >> 7) & 1, j = U & 127, hq = kvh * 8 + F.wave;
        r.qseq = HQ + HQ_QS + (size_t)(b * 16 + hq) * SEQ * 64; r.kseq = HQ + HQ_KS + (size_t)(b * 2 + kvh) * SEQ * 64; r.vseq = (const bf16_t*)(HQ + HQ_VS) + (size_t)(b * 2 + kvh) * SEQ * 64;
        r.jt0 = j - 4; r.nkt = 5; r.jq = j;
    } else {
        const int v = U - 2048, g = v >> 9, w_ = v & 511, b = w_ >> 6, x = w_ & 63, hh = x >> 4, y = x & 15;
        const int dil = (g == 0) ? 1 : (g == 1) ? 4 : 16;
        const int res = (g == 0) ? 0 : (g == 1) ? (y >> 2) : y;
        const int j0 = (g == 0) ? y * 8 : (g == 1) ? (y & 3) * 8 : 0;
        const size_t seq = ((size_t)((g * NB + b) * 4 + hh) * SEQ + (size_t)res * (SEQ / dil)) * 64;
        r.qseq = HQ + HQ_QD + seq; r.kseq = HQ + HQ_KD + seq; r.vseq = (const bf16_t*)(HQ + HQ_VD) + seq;
        r.jt0 = j0 - 4; r.nkt = 12; r.jq = j0 + F.wave;
    }
    return r;
}
__device__ __forceinline__ unsigned attn_koff(int lane) { return (unsigned)((lane >> 2) * 64 + (((lane & 3) ^ ((lane >> 4) & 3)) * 16)); }
__device__ __forceinline__ unsigned attn_voff(int lane) { return (unsigned)((lane >> 2) * 128 + (lane & 3) * 16); }
__device__ __forceinline__ void attn_issue_k(LAS unsigned char* lds, int lane, int wave, const AKV& u) {
    const unsigned koff = attn_koff(lane);
    for (int p = wave; p < u.nkt * 2; p += 8) {
        const int s = p >> 1, qt = p & 1; const int tj = u.jt0 + s; const size_t pos0 = (size_t)(32 * (tj >= 0 ? tj : 0) + 16 * qt);
        __builtin_amdgcn_global_load_lds((const unsigned*)((const char*)u.kseq + pos0 * 64 + koff), (LAS unsigned*)(lds + ATT_KOFF + s * 2048 + qt * 1024), 16, 0, 0);
    }
}
__device__ __forceinline__ void attn_issue_q(LAS unsigned char* lds, int lane, int wave, const AKV& u) {
    const unsigned koff = attn_koff(lane);
#pragma unroll
    for (int qt = 0; qt < 2; ++qt)
        __builtin_amdgcn_global_load_lds((const unsigned*)((const char*)u.qseq + (size_t)(32 * u.jq + 16 * qt) * 64 + koff), (LAS unsigned*)(lds + ATT_QOFF + wave * 2048 + qt * 1024), 16, 0, 0);
}
template <int NKT>
__device__ __forceinline__ int attn_issue_v(LAS unsigned char* lds, int lane, int wave, const AKV& u) {
    const int w4 = (wave + 4) & 7;
    const unsigned voff = attn_voff(lane);
#pragma unroll
    for (int i = 0; i < (NKT * 4 + 7) / 8; ++i) { const int p = w4 + 8 * i;
        if (p < NKT * 4) { const int s = p >> 2, qt = p & 3; const int tj = u.jt0 + s; const int blk = qt >> 1, part = qt & 1;
            const size_t pos0 = (size_t)(32 * (tj >= 0 ? tj : 0) + 16 * part);
            __builtin_amdgcn_global_load_lds((const unsigned*)((const char*)u.vseq + pos0 * 128 + blk * 64 + voff), (LAS unsigned*)(lds + ATT_VOFF + s * 4096 + blk * 2048 + part * 1024), 16, 0, 0); } }
    return NKT == 12 ? 6 : (w4 < 4 ? 3 : 2);
}
__device__ __forceinline__ void attn_wait(int n) {
#define AW(N) asm volatile("s_waitcnt vmcnt(" #N ")" ::: "memory")
    if (n == 11) AW(11); else if (n == 8) AW(8); else if (n == 7) AW(7); else if (n == 6) AW(6); else if (n == 5) AW(5); else if (n == 4) AW(4); else if (n == 3) AW(3); else if (n == 2) AW(2); else AW(0);
#undef AW
}
template <bool swa>
__device__ __forceinline__ void attn_unit(LAS unsigned char* lds, int lane, int wave, const AKV& u, int s0,
                                          float sl2, float sink2, bf16_t* ob, unsigned op, float* lseb, unsigned lsep, bool hasn, const AKV& nx) {
    const int i32 = lane & 31, h = lane >> 5;
    const int jq = u.jq;
    constexpr float QKS = SQ * SK, RQK = 1.0f / (SQ * SK), NEG_RAW = -1.0e30f;
    f32x16 bias;
#pragma unroll
    for (int r = 0; r < 16; ++r) { const int kk = (r & 3) + 8 * (r >> 2) + 4 * h; bias[r] = sl2 * QKS * (float)(kk - i32); }
    __builtin_amdgcn_s_barrier();
    asm volatile("" ::: "memory");
    f32x16 S[5];
    float m2 = sink2;
    const int kro = i32 * 64 + h * 8, ksw = (i32 >> 2) & 3;
    long qf[4];
#pragma unroll
    for (int d0 = 0; d0 < 4; ++d0) qf[d0] = *(const LAS long*)(lds + ATT_QOFF + wave * 2048 + kro + ((d0 ^ ksw) * 16));
    long kf[2][4];
#pragma unroll
    for (int c = 0; c < 5; ++c) {
        const bool tv = (jq - 4 + c) >= 0;
        const LAS unsigned char* ks = lds + ATT_KOFF + (s0 + c) * 2048 + kro;
#pragma unroll
        for (int d0 = 0; d0 < 4; ++d0) kf[c & 1][d0] = *(const LAS long*)(ks + ((d0 ^ ksw) * 16));
        if (c > 0) asm volatile("" :: "v"(kf[(c - 1) & 1][0]), "v"(kf[(c - 1) & 1][1]), "v"(kf[(c - 1) & 1][2]), "v"(kf[(c - 1) & 1][3]) : "memory");
        f32x16 a = bias;
#pragma unroll
        for (int d0 = 0; d0 < 4; ++d0) a = __builtin_amdgcn_mfma_f32_32x32x16_fp8_fp8(kf[c & 1][d0], qf[d0], a, 0, 0, 0);
        if (c == 0 || c == 4) {
#pragma unroll
            for (int r = 0; r < 16; ++r) { const int kk = (r & 3) + 8 * (r >> 2) + 4 * h;
                const bool ok = (c == 4) ? (kk <= i32) : (swa ? (kk > i32) : (kk >= i32));
                a[r] = ok ? a[r] : NEG_RAW; }
        }
        float mt = fmaxf(fmaxf(a[0], a[1]), a[2]);
#pragma unroll
        for (int r = 3; r < 15; r += 2) mt = fmaxf(fmaxf(mt, a[r]), a[r + 1]);
        mt = fmaxf(mt, a[15]);
        m2 = fmaxf(m2, __builtin_fmaf(mt, RQK, tv ? -sl2 * (float)(32 * (4 - c)) : NEG_RAW));
        S[c] = a;
    }
    m2 = fmaxf(m2, __shfl_xor(m2, 32));
    float l = 0.f;
#pragma unroll
    for (int c = 0; c < 5; ++c) {
        const float offc = ((jq - 4 + c) >= 0 ? -sl2 * (float)(32 * (4 - c)) : NEG_RAW) - m2;
#pragma unroll
        for (int r = 0; r < 16; ++r) { const float p = __builtin_amdgcn_exp2f(__builtin_fmaf(S[c][r], RQK, offc)); S[c][r] = p; l += p; }
    }
    l += __shfl_xor(l, 32);
    l += __builtin_amdgcn_exp2f(sink2 - m2);
    asm volatile("" :: "v"(kf[0][0]), "v"(kf[0][1]), "v"(kf[0][2]), "v"(kf[0][3]), "v"(kf[1][0]), "v"(kf[1][1]), "v"(kf[1][2]), "v"(kf[1][3]) : "memory");
    asm volatile("s_waitcnt vmcnt(0) lgkmcnt(0)" : "+v"(l) :: "memory");
    __builtin_amdgcn_s_barrier();
    asm volatile("" ::: "memory");
    if (hasn) { attn_issue_k(lds, lane, wave, nx); attn_issue_q(lds, lane, wave, nx); }
    f32x16 O[2]; O[0] = (f32x16){}; O[1] = (f32x16){};
    const int vaddr0 = ((lane >> 4) & 1) * 32 + (lane & 3) * 8 + (4 * h + ((lane & 15) >> 2)) * 64;
    const unsigned vbase = (unsigned)(size_t)(lds + ATT_VOFF) + (unsigned)(s0 * 4096 + vaddr0);
    s16x4 va[2][8]; bf16x8 pf[2][2];
    pv_tile<0>(va[0], va[1], pf[0], pf[1], vbase, S[0], O); pv_tile<1>(va[1], va[0], pf[1], pf[0], vbase, S[1], O); pv_tile<2>(va[0], va[1], pf[0], pf[1], vbase, S[2], O);
    pv_tile<3>(va[1], va[0], pf[1], pf[0], vbase, S[3], O); pv_tile<4>(va[0], va[1], pf[0], pf[1], vbase, S[4], O);
    asm volatile("" :: "v"(pf[0][0]), "v"(pf[0][1]), "v"(pf[1][0]), "v"(pf[1][1]) : "memory");
    asm volatile("" :: "v"(va[0][0]), "v"(va[0][1]), "v"(va[0][2]), "v"(va[0][3]), "v"(va[0][4]), "v"(va[0][5]), "v"(va[0][6]), "v"(va[0][7]) : "memory");
    asm volatile("" :: "v"(va[1][0]), "v"(va[1][1]), "v"(va[1][2]), "v"(va[1][3]), "v"(va[1][4]), "v"(va[1][5]), "v"(va[1][6]), "v"(va[1][7]) : "memory");
    __builtin_amdgcn_s_barrier();
    asm volatile("" ::: "memory");
    int nv = 0;
    if (hasn) { if (nx.nkt == 12) nv = attn_issue_v<12>(lds, lane, wave, nx); else nv = attn_issue_v<5>(lds, lane, wave, nx); }
    const float inv = 1.0f / l;
    LAS unsigned char* stg = lds + ATT_STG + wave * ATT_STGW;
    if (swa) {
        const float is = inv * SO;
#pragma unroll
        for (int blk = 0; blk < 2; ++blk)
#pragma unroll
            for (int g4 = 0; g4 < 4; ++g4) { const int d0 = blk * 32 + 8 * g4 + 4 * h;
                *(LAS unsigned*)(stg + i32 * 80 + d0) = pk4_fp8_pad(clamp_fp8(O[blk][4 * g4 + 0] * is), clamp_fp8(O[blk][4 * g4 + 1] * is), clamp_fp8(O[blk][4 * g4 + 2] * is), clamp_fp8(O[blk][4 * g4 + 3] * is)); }
        asm volatile("s_waitcnt lgkmcnt(0)" ::: "memory");
#pragma unroll
        for (int it = 0; it < 2; ++it) { const int row = it * 16 + (lane >> 2), ch = lane & 3;
            const u32x4 v = *(const LAS u32x4*)(stg + row * 80 + ch * 16);
            *(u32x4*)((char*)ob + (size_t)(32 * jq + row) * op + ch * 16) = v; }
    } else {
#pragma unroll
        for (int blk = 0; blk < 2; ++blk)
#pragma unroll
            for (int g4 = 0; g4 < 4; ++g4) { const int d0 = blk * 32 + 8 * g4 + 4 * h;
                u32x2 w; w.x = cvt_pk_bf16(O[blk][4 * g4 + 0] * inv, O[blk][4 * g4 + 1] * inv); w.y = cvt_pk_bf16(O[blk][4 * g4 + 2] * inv, O[blk][4 * g4 + 3] * inv);
                *(LAS u32x2*)(stg + i32 * 144 + d0 * 2) = w; }
        asm volatile("s_waitcnt lgkmcnt(0)" ::: "memory");
#pragma unroll
        for (int it = 0; it < 4; ++it) { const int row = it * 8 + (lane >> 3), ch = lane & 7;
            const u32x4 v = *(const LAS u32x4*)(stg + row * 144 + ch * 16);
            *(u32x4*)((char*)ob + (size_t)(32 * jq + row) * op + ch * 16) = v; }
    }
    if (lseb != nullptr && h == 0) lseb[(size_t)(32 * jq + i32) * lsep] = (m2 + __builtin_amdgcn_logf(l)) * LN2;
    attn_wait(hasn ? nv + (swa ? 2 : 5) : 0);
}
__device__ __forceinline__ void p2_attention(Frame& F, const float* sinks) {
    unsigned char* OAB = F.dout + DO_OAB; bf16_t* OAG = (bf16_t*)(F.ws + WS_OAG); float* LSE = (float*)(F.ws + WS_LSE);
    constexpr int NUNIT = 2048 + 1536;
    int U = F.vcu; if (U >= NUNIT) return;
    float snk0 = sinks[F.wave] * LOG2E, snk1 = sinks[8 + F.wave] * LOG2E;
    asm volatile("" : "+v"(snk0), "+v"(snk1));
    AKV cur = attn_kv(F, U);
    attn_issue_k(F.lds, F.lane, F.wave, cur);
    attn_issue_q(F.lds, F.lane, F.wave, cur);
    { const int nv0 = (cur.nkt == 12) ? attn_issue_v<12>(F.lds, F.lane, F.wave, cur) : attn_issue_v<5>(F.lds, F.lane, F.wave, cur); attn_wait(nv0); }
    for (;;) {
        const int Un = U + F.G; const bool hasn = Un < NUNIT;
        const AKV nxt = attn_kv(F, hasn ? Un : U);
        if (U < 2048) {
            const int b = U >> 8, kvh = (U >> 7) & 1, hq = kvh * 8 + F.wave;
            const float slope = exp2f(-8.0f * (float)(hq + 1) / 28.0f);
            attn_unit<true>(F.lds, F.lane, F.wave, cur, 0, slope * LOG2E, kvh ? snk1 : snk0, (bf16_t*)(OAB + (size_t)b * SEQ * OAB_P + 256 + hq * 64), OAB_P, nullptr, 0, hasn, nxt);
        } else {
            const int v = U - 2048, g = v >> 9, w_ = v & 511, b = w_ >> 6, x = w_ & 63, hh = x >> 4, y = x & 15;
            const int dil = (g == 0) ? 1 : (g == 1) ? 4 : 16;
            const int res = (g == 0) ? 0 : (g == 1) ? (y >> 2) : y;
            const size_t tok0 = (size_t)b * SEQ + res;
            const float slope = exp2f(-8.0f * (float)(16 + g * 4 + hh + 1) / 28.0f);
            attn_unit<false>(F.lds, F.lane, F.wave, cur, F.wave, slope * (float)dil * LOG2E, NEG_BIG,
                             OAG + ((size_t)g * NTOK + tok0) * 256 + hh * 64, (unsigned)(dil * 256 * 2), LSE + ((size_t)g * NTOK + tok0) * 4 + hh, (unsigned)(dil * 4), hasn, nxt);
        }
        if (!hasn) break;
        U = Un; cur = nxt;
    }
}
__device__ __forceinline__ void p3_merge(Frame& F) {
    const bf16_t* OAG = (const bf16_t*)(F.ws + WS_OAG); const float* LSE = (const float*)(F.ws + WS_LSE); unsigned char* OAB = F.dout + DO_OAB;
    const int gw = F.vcu * NWAVES + F.wave, NGW = F.G * NWAVES;
    for (int idx = gw; idx < NTOK / 2; idx += NGW) {
        const int tok = idx * 2 + (F.lane >> 5), c8 = F.lane & 31, hh = c8 >> 3;
        float ls[3]; u32x4 o[3];
#pragma unroll
        for (int g = 0; g < 3; ++g) { ls[g] = LSE[((size_t)g * NTOK + tok) * 4 + hh]; o[g] = *(const u32x4*)(OAG + ((size_t)g * NTOK + tok) * 256 + c8 * 8); }
        const float m = fmaxf(fmaxf(ls[0], ls[1]), ls[2]);
        float w[3]; float sum = 0.f;
#pragma unroll
        for (int g = 0; g < 3; ++g) { w[g] = __builtin_amdgcn_exp2f((ls[g] - m) * LOG2E); sum += w[g]; }
        const float is = 1.0f / sum; float r[8];
#pragma unroll
        for (int q = 0; q < 8; ++q) r[q] = 0.f;
#pragma unroll
        for (int g = 0; g < 3; ++g) { const float wg = w[g] * is;
            r[0] += wg * bf_lo(o[g].x); r[1] += wg * bf_hi(o[g].x); r[2] += wg * bf_lo(o[g].y); r[3] += wg * bf_hi(o[g].y);
            r[4] += wg * bf_lo(o[g].z); r[5] += wg * bf_hi(o[g].z); r[6] += wg * bf_lo(o[g].w); r[7] += wg * bf_hi(o[g].w); }
        u32x2 out; out.x = pk4_fp8(clamp_fp8(r[0] * SO), clamp_fp8(r[1] * SO), clamp_fp8(r[2] * SO), clamp_fp8(r[3] * SO)); out.y = pk4_fp8(clamp_fp8(r[4] * SO), clamp_fp8(r[5] * SO), clamp_fp8(r[6] * SO), clamp_fp8(r[7] * SO));
        *(u32x2*)(OAB + (size_t)tok * OAB_P + c8 * 8) = out;
    }
}

__device__ __forceinline__ void p6_router(Frame& F, const bf16_t* y, const float* stat, const float* gam, const float* bet, bf16_t* x1b, unsigned char* x1q, const float* rb, int cw_ecnt, size_t pe_off) {
    constexpr int WPITCH = 2064;
    constexpr int WIMG = 64 * WPITCH;
    constexpr int GOFF = WIMG + 2048;
    static_assert(GOFF + 8192 <= SCR_BYTES, "router LDS map");
    LAS int* wcnt = (LAS int*)(F.lds + WIMG + F.wave * 256); LAS int* wbase = wcnt + 32;
    int* petok = (int*)(F.ws + WS_PETOK + pe_off); float* pegate = (float*)(F.ws + WS_PEGATE + pe_off);
    const bf16_t* WRT = (const bf16_t*)(F.ws + WS_WRT);
    const int gw = F.vcu * NWAVES + F.wave, NGW = F.G * NWAVES, lane = F.lane, j = lane & 15, kq = lane >> 4;
    __syncthreads();
    for (int q = F.tid; q < 64 * 128; q += NWAVES * 64) { const u32x4 v = *(const u32x4*)((const char*)WRT + (size_t)q * 16); *(LAS u32x4*)(F.lds + (q >> 7) * WPITCH + (q & 127) * 16) = v; }
    for (int q = F.tid; q < 512; q += NWAVES * 64) { const f32x4 v = (q < 256) ? *(const f32x4*)(gam + q * 4) : *(const f32x4*)(bet + (q - 256) * 4); *(LAS f32x4*)(F.lds + GOFF + q * 16) = v; }
    __syncthreads();
    const LAS unsigned char* wrow = F.lds + j * WPITCH + kq * 16;
    const LAS float* gl = (const LAS float*)(F.lds + GOFF) + 8 * kq; const LAS float* bl = gl + 1024;
    for (int tb = F.vcu * NWAVES; tb < NTOK / 16; tb += NGW) {
        const int tt = tb + F.wave; const bool valid = tt < NTOK / 16; const int t0 = (valid ? tt : 0) * 16;
        float mean, rstd;
        { const f32x4* sp = (const f32x4*)(stat + (size_t)(t0 + j) * 32); float s1 = 0.f, s2 = 0.f;
#pragma unroll
          for (int q = 0; q < 8; ++q) { const f32x4 v = sp[q]; s1 += v[0] + v[2]; s2 += v[1] + v[3]; }
          mean = s1 * (1.0f / D); const float var = fmaxf(s2 * (1.0f / D) - mean * mean, 0.f); rstd = 1.0f / sqrtf(var + LN_EPS); }
        f32x4 acc[2]; acc[0] = (f32x4){0.f, 0.f, 0.f, 0.f}; acc[1] = acc[0];
        const bf16_t* yrow = y + (size_t)(t0 + j) * D + 8 * kq;
        bf16_t* xbrow = (valid ? x1b : (bf16_t*)(F.ws + 300 * MiB)) + (size_t)(t0 + j) * D + 8 * kq; unsigned char* xqrow = (valid ? x1q : F.ws + 300 * MiB) + (size_t)(t0 + j) * D + 8 * kq;
        bf16x8 wf[2][4]; wf[1][0] = (bf16x8){}; wf[1][1] = wf[1][0]; wf[1][2] = wf[1][0]; wf[1][3] = wf[1][0];
        u32x4 yv[4], yn[4];
#pragma unroll
        for (int u = 0; u < 4; ++u) yv[u] = *(const u32x4*)(yrow + 32 * u);
#pragma unroll 1
        for (int so = 0; so < D / 32; so += 4) {
            const int sn = (so + 4 < D / 32) ? so + 4 : so;
#pragma unroll
            for (int u = 0; u < 4; ++u) yn[u] = *(const u32x4*)(yrow + 32 * (sn + u));
#pragma unroll
            for (int u = 0; u < 4; ++u) { const int sI = so + u;
                wf[u & 1][0] = *(const LAS bf16x8*)(wrow + 64 * sI); wf[u & 1][1] = *(const LAS bf16x8*)(wrow + 16 * WPITCH + 64 * sI);
                wf[u & 1][2] = *(const LAS bf16x8*)(wrow + 32 * WPITCH + 64 * sI); wf[u & 1][3] = *(const LAS bf16x8*)(wrow + 48 * WPITCH + 64 * sI);
                const f32x4 g0 = *(const LAS f32x4*)(gl + 32 * sI), g1 = *(const LAS f32x4*)(gl + 32 * sI + 4), b0 = *(const LAS f32x4*)(bl + 32 * sI), b1 = *(const LAS f32x4*)(bl + 32 * sI + 4);
                asm volatile("" :: "v"(wf[(u + 1) & 1][0]), "v"(wf[(u + 1) & 1][1]), "v"(wf[(u + 1) & 1][2]), "v"(wf[(u + 1) & 1][3]) : "memory");
                f32x4 n0, n1;
                n0[0] = (bf_lo(yv[u].x) - mean) * rstd * g0[0] + b0[0]; n0[1] = (bf_hi(yv[u].x) - mean) * rstd * g0[1] + b0[1]; n0[2] = (bf_lo(yv[u].y) - mean) * rstd * g0[2] + b0[2]; n0[3] = (bf_hi(yv[u].y) - mean) * rstd * g0[3] + b0[3];
                n1[0] = (bf_lo(yv[u].z) - mean) * rstd * g1[0] + b1[0]; n1[1] = (bf_hi(yv[u].z) - mean) * rstd * g1[1] + b1[1]; n1[2] = (bf_lo(yv[u].w) - mean) * rstd * g1[2] + b1[2]; n1[3] = (bf_hi(yv[u].w) - mean) * rstd * g1[3] + b1[3];
                u32x4 xw; xw.x = cvt_pk_bf16(n0[0], n0[1]); xw.y = cvt_pk_bf16(n0[2], n0[3]); xw.z = cvt_pk_bf16(n1[0], n1[1]); xw.w = cvt_pk_bf16(n1[2], n1[3]);
                *(u32x4*)(xbrow + 32 * sI) = xw;
                { u32x2 q8; q8.x = pk4_fp8(clamp_fp8(n0[0] * SX), clamp_fp8(n0[1] * SX), clamp_fp8(n0[2] * SX), clamp_fp8(n0[3] * SX)); q8.y = pk4_fp8(clamp_fp8(n1[0] * SX), clamp_fp8(n1[1] * SX), clamp_fp8(n1[2] * SX), clamp_fp8(n1[3] * SX));
                  *(u32x2*)(xqrow + 32 * sI) = q8; }
                const bf16x8 xh = __builtin_bit_cast(bf16x8, xw);
                acc[0] = __builtin_amdgcn_mfma_f32_16x16x32_bf16(wf[u & 1][0], xh, acc[0], 0, 0, 0); acc[1] = __builtin_amdgcn_mfma_f32_16x16x32_bf16(wf[u & 1][1], xh, acc[1], 0, 0, 0);
                acc[0] = __builtin_amdgcn_mfma_f32_16x16x32_bf16(wf[u & 1][2], xh, acc[0], 0, 0, 0); acc[1] = __builtin_amdgcn_mfma_f32_16x16x32_bf16(wf[u & 1][3], xh, acc[1], 0, 0, 0); }
#pragma unroll
            for (int u = 0; u < 4; ++u) yv[u] = yn[u];
        }
        float lg[8];
#pragma unroll
        for (int q = 0; q < 8; ++q) lg[q] = acc[q >> 2][q & 3] + rb[16 * (q >> 2) + 4 * kq + (q & 3)];
        unsigned taken = 0u; float tv[4]; int ti[4];
#pragma unroll
        for (int k = 0; k < 4; ++k) {
            float bv = -3.0e38f; int bi = 64;
#pragma unroll
            for (int q = 0; q < 8; ++q) { const bool free_ = ((taken >> q) & 1u) == 0u; if (free_ && lg[q] > bv) { bv = lg[q]; bi = 16 * (q >> 2) + 4 * kq + (q & 3); } }
            const int mybi = bi;
#pragma unroll
            for (int o = 16; o < 64; o <<= 1) { const float ov = __shfl_xor(bv, o); const int oi = __shfl_xor(bi, o); const bool keep = (bv > ov) || (bv == ov && bi < oi); bv = keep ? bv : ov; bi = keep ? bi : oi; }
            tv[k] = bv; ti[k] = bi;
            if (bi == mybi && ((bi >> 2) & 3) == kq) taken |= 1u << (4 * (bi >> 4) + (bi & 3));
        }
        float gk[4]; float gs = 0.f;
#pragma unroll
        for (int k = 0; k < 4; ++k) { gk[k] = __builtin_amdgcn_exp2f((tv[k] - tv[0]) * LOG2E); gs += gk[k]; }
        const float gi = 1.0f / gs;
        if (lane < 32) wcnt[lane] = 0;
        asm volatile("s_waitcnt lgkmcnt(0)" ::: "memory");
        const int e0 = (kq == 0) ? ti[0] : (kq == 1) ? ti[1] : (kq == 2) ? ti[2] : ti[3];
        const float g0 = ((kq == 0) ? gk[0] : (kq == 1) ? gk[1] : (kq == 2) ? gk[2] : gk[3]) * gi;
        int r0 = 0;
        if (valid) r0 = __hip_atomic_fetch_add(wcnt + e0, 1, __ATOMIC_RELAXED, __HIP_MEMORY_SCOPE_WORKGROUP);
        asm volatile("s_waitcnt lgkmcnt(0)" ::: "memory");
        __syncthreads();
        if (F.wave == 0 && lane < 32) { int c[NWAVES]; int tot = 0;
#pragma unroll
            for (int w = 0; w < NWAVES; ++w) { c[w] = *(LAS int*)(F.lds + WIMG + w * 256 + 4 * lane); tot += c[w]; }
            int b = 0; if (tot > 0) b = (int)__hip_atomic_fetch_add((unsigned*)(F.ctl + cw_ecnt + 64 * lane), (unsigned)tot, RLX_AGENT);
#pragma unroll
            for (int w = 0; w < NWAVES; ++w) { *(LAS int*)(F.lds + WIMG + w * 256 + 128 + 4 * lane) = b; b += c[w]; } }
        asm volatile("s_waitcnt vmcnt(0) lgkmcnt(0)" ::: "memory");
        __syncthreads();
        if (valid) { const int p0 = wbase[e0] + r0;
            petok[(size_t)e0 * NTOK + p0] = (t0 + j) * 4 + kq; pegate[(size_t)e0 * NTOK + p0] = g0; }
        asm volatile("s_waitcnt lgkmcnt(0)" ::: "memory");
        __syncthreads();
    }
}
__device__ __forceinline__ int moe_tables(Frame& F) {
    LAS int* cnt = (LAS int*)(F.lds + MOE_OFF); LAS int* fs = (LAS int*)(F.lds + MOE_OFF + 128); LAS unsigned char* te = F.lds + MOE_OFF + 128 + 136;
    __syncthreads();
    if (F.tid < NEXP) cnt[F.tid] = (int)__hip_atomic_load(F.ctl + CW_ECNT + 64 * F.tid, RLX_AGENT);
    __syncthreads();
    if (F.tid == 0) { int s = 0; for (int e = 0; e < NEXP; ++e) { fs[e] = s; s += (cnt[e] + 255) >> 8; } fs[NEXP] = s; }
    __syncthreads();
    const int T = fs[NEXP];
    for (int t = F.tid; t < T; t += NWAVES * 64) { int e = 0;
#pragma unroll 8
        for (int q = 1; q < NEXP; ++q) e += (fs[q] <= t) ? 1 : 0;
        te[t] = (unsigned char)e; }
    __syncthreads();
    return T;
}
__device__ __forceinline__ void p9_final(Frame& F, const float* gam, const float* bet, const float* out, float* outw, bool poison) {
    const bf16_t* X1B = (const bf16_t*)(F.ws + WS_X1B);
    const int gw = F.vcu * NWAVES + F.wave, NGW = F.G * NWAVES, lane = F.lane;
    const float qnan = __builtin_nanf("");
    const f32x4 g0 = *(const f32x4*)(gam + lane * 16), g1 = *(const f32x4*)(gam + lane * 16 + 4), g2 = *(const f32x4*)(gam + lane * 16 + 8), g3 = *(const f32x4*)(gam + lane * 16 + 12);
    const f32x4 b0 = *(const f32x4*)(bet + lane * 16), b1 = *(const f32x4*)(bet + lane * 16 + 4), b2 = *(const f32x4*)(bet + lane * 16 + 8), b3 = *(const f32x4*)(bet + lane * 16 + 12);
    for (int tok0 = gw; tok0 < NTOK; tok0 += 2 * NGW) {
        u32x4 xa[2], xb[2], y0[2], y1[2], y2[2], y3[2];
#pragma unroll
        for (int tI = 0; tI < 2; ++tI) { const int tok = min(tok0 + tI * NGW, NTOK - 1);
            const unsigned char* y = (const unsigned char*)out + (size_t)tok * 4096 + lane * 16;
            xa[tI] = *(const u32x4*)(X1B + (size_t)tok * D + lane * 16); xb[tI] = *(const u32x4*)(X1B + (size_t)tok * D + lane * 16 + 8);
            y0[tI] = *(const u32x4*)(y); y1[tI] = *(const u32x4*)(y + 1024); y2[tI] = *(const u32x4*)(y + 2048); y3[tI] = *(const u32x4*)(y + 3072); }
#pragma unroll
        for (int tI = 0; tI < 2; ++tI) { const int tok = tok0 + tI * NGW; if (tok >= NTOK) break;
            float v[16];
#pragma unroll
            for (int w = 0; w < 4; ++w) { const unsigned xw = (w < 2) ? xa[tI][2 * w] : xb[tI][2 * (w - 2)], xw2 = (w < 2) ? xa[tI][2 * w + 1] : xb[tI][2 * (w - 2) + 1];
                v[4 * w + 0] = DN_ALPHA * bf_lo(xw); v[4 * w + 1] = DN_ALPHA * bf_hi(xw); v[4 * w + 2] = DN_ALPHA * bf_lo(xw2); v[4 * w + 3] = DN_ALPHA * bf_hi(xw2);
                f32x2 lo = __builtin_amdgcn_cvt_pk_f32_fp8((int)y0[tI][w], false) + __builtin_amdgcn_cvt_pk_f32_fp8((int)y1[tI][w], false) + __builtin_amdgcn_cvt_pk_f32_fp8((int)y2[tI][w], false) + __builtin_amdgcn_cvt_pk_f32_fp8((int)y3[tI][w], false);
                f32x2 hi = __builtin_amdgcn_cvt_pk_f32_fp8((int)y0[tI][w], true) + __builtin_amdgcn_cvt_pk_f32_fp8((int)y1[tI][w], true) + __builtin_amdgcn_cvt_pk_f32_fp8((int)y2[tI][w], true) + __builtin_amdgcn_cvt_pk_f32_fp8((int)y3[tI][w], true);
                v[4 * w + 0] += lo[0] * (1.0f / SY); v[4 * w + 1] += lo[1] * (1.0f / SY); v[4 * w + 2] += hi[0] * (1.0f / SY); v[4 * w + 3] += hi[1] * (1.0f / SY); }
            float s = 0.f;
#pragma unroll
            for (int q = 0; q < 16; ++q) s += v[q];
            const float mean = wave_sum(s) * (1.0f / D); float s2 = 0.f;
#pragma unroll
            for (int q = 0; q < 16; ++q) { v[q] -= mean; s2 += v[q] * v[q]; }
            const float rstd = 1.0f / sqrtf(wave_sum(s2) * (1.0f / D) + LN_EPS);
            f32x4 o0, o1, o2, o3;
#pragma unroll
            for (int q = 0; q < 4; ++q) { o0[q] = v[q] * rstd * g0[q] + b0[q]; o1[q] = v[4 + q] * rstd * g1[q] + b1[q]; o2[q] = v[8 + q] * rstd * g2[q] + b2[q]; o3[q] = v[12 + q] * rstd * g3[q] + b3[q]; }
            if (poison) { o0 = (f32x4){qnan, qnan, qnan, qnan}; o1 = o0; o2 = o0; o3 = o0; }
            float* op = outw + (size_t)tok * D + lane * 16;
            *(f32x4*)(op) = o0; *(f32x4*)(op + 4) = o1; *(f32x4*)(op + 8) = o2; *(f32x4*)(op + 12) = o3; }
    }
}
#define CAS __attribute__((address_space(4)))
__device__ __forceinline__ const float* arg_in(int i) {
    const unsigned char CAS* ka = (const unsigned char CAS*)__builtin_amdgcn_kernarg_segment_ptr();
    asm volatile("" : "+s"(ka));
    return *(const float* const CAS*)(ka + 8 * i);
}
struct Args { const float* in[18]; float* out; unsigned char* ws; int ph_lo, ph_hi; };
__global__ void __launch_bounds__(NWAVES * 64, 2) fwd_kernel(Args args) {
    extern __shared__ __attribute__((aligned(16))) unsigned char lds[];
    Frame F;
    F.lds = (LAS unsigned char*)lds;
    F.MISC = (volatile LAS unsigned*)(F.lds + MISC_OFF);
    F.tid = threadIdx.x; F.lane = F.tid & 63; F.wave = __builtin_amdgcn_readfirstlane(F.tid >> 6);
    F.G = gridDim.x; { const int bx = blockIdx.x; F.vcu = (F.G % 8 == 0) ? (bx % 8) * (F.G / 8) + bx / 8 : bx; }
    F.ws = args.ws; F.dout = (unsigned char*)args.out;
    F.ctl = (gu32*)(args.ws + WS_CTL);
    for (int u = F.tid; u < (LDS_BYTES - LDSCTL_OFF) / 4; u += NWAVES * 64) ((LAS unsigned*)(F.lds + LDSCTL_OFF))[u] = 0u;
    __syncthreads();
    XcdBarrier bar; bar.bar = (unsigned*)(F.ctl + CW_BAR); bar.x = 0; bar.st = nullptr;
    if (N_LAUNCHES == 1) bar = xcd_barrier_post((unsigned*)(F.ctl + CW_BAR), F.MISC + 8);
    const int lo = args.ph_lo, hi = args.ph_hi;
#ifdef ONLY_PHASE
#define IN(k) ((k) == ONLY_PHASE && lo <= (k) && (k) < hi)
#else
#define IN(k) (lo <= (k) && (k) < hi)
#endif
#define SEAM(k) do { if (IN(k) && IN((k) + 1)) xcd_barrier(bar); } while (0)
    unsigned char* HQ = F.ws + WS_HQ; unsigned char* SG = F.ws + WS_SG;

#define PHASE(k, ...) do { if (IN(k)) { __VA_ARGS__ if (DUP_PHASE == (k)) { __VA_ARGS__ } } } while (0)
    PHASE(0, p0_convert(F, arg_in(0), arg_in(1), arg_in(3), arg_in(4), arg_in(5), arg_in(8));); SEAM(0);
    PHASE(1,
        { const int gemm_wgs = (F.G == 256) ? 192 : F.G;
          if ((int)blockIdx.x < gemm_wgs) {
            pg8::Gemm g{(const char*)(F.dout + DO_XB), (const char*)(F.dout + DO_WIN), D, D, D / 128}; pg8::StaticOrder S; S.init(NTOK, IN_COLS, gemm_wgs, (int)blockIdx.x);
            pg8::EpiInProj E{HQ, SG, 1.0f / (SXIN * SW)};
            pg8::gemm_phase<pg8::EpiInProj, pg8::StaticOrder, true, false, true>(F.lds, g, S, E); }
          if (gemm_wgs == F.G) p3_convert_moe(F, arg_in(10), arg_in(12), arg_in(14), F.vcu, F.G);
          else if ((int)blockIdx.x >= gemm_wgs) p3_convert_moe(F, arg_in(10), arg_in(12), arg_in(14), (int)blockIdx.x - gemm_wgs, F.G - gemm_wgs); }
    ); SEAM(1);
    PHASE(2, p2_attention(F, arg_in(2));); SEAM(2);
    PHASE(3, p3_merge(F);); SEAM(3);
    PHASE(4,
        { pg8::Gemm g{(const char*)(F.dout + DO_OAB), (const char*)(F.dout + DO_WCAT), OAB_P, OAB_P, OAB_P / 128}; pg8::StaticOrder S; S.init(NTOK, D, F.G, (int)blockIdx.x);
        pg8::EpiGate E{SG, F.ws + WS_MRG};
        pg8::gemm_phase<pg8::EpiGate, pg8::StaticOrder, true, false, true>(F.lds, g, S, E); }
    ); SEAM(4);
    PHASE(5,
        { pg8::Gemm g{(const char*)(F.ws + WS_MRG), (const char*)(F.ws + WS_WOUT), D, D, D / 128}; pg8::StaticOrder S; S.init(NTOK, D, F.G, (int)blockIdx.x);
        pg8::EpiY E{arg_in(0), (bf16_t*)(F.ws + WS_Y), (float*)(F.ws + WS_STAT), 1.0f / (SM * SW)};
        pg8::gemm_phase<pg8::EpiY, pg8::StaticOrder, true, false, true>(F.lds, g, S, E); }
    ); SEAM(5);
    if (IN(6)) { if (DUP_PHASE == 6) p6_router(F, (const bf16_t*)(F.ws + WS_Y), (const float*)(F.ws + WS_STAT), arg_in(6), arg_in(7), (bf16_t*)(F.ws + 264 * MiB), F.ws + 330 * MiB, arg_in(9), CW_ECNT + 64 * NEXP, (size_t)362 * MiB - WS_PETOK);
        p6_router(F, (const bf16_t*)(F.ws + WS_Y), (const float*)(F.ws + WS_STAT), arg_in(6), arg_in(7), (bf16_t*)(F.ws + WS_X1B), F.ws + WS_X1Q, arg_in(9), CW_ECNT, 0); } SEAM(6);
    PHASE(7,
        { const int T = moe_tables(F);
        pg8::Gemm g{(const char*)(F.ws + WS_X1Q), (const char*)(F.ws + WS_WGU), D, D, D / 128};
        pg8::MoeOrder S{T, 8, F.G, (int)blockIdx.x, (const LAS int*)(F.lds + MOE_OFF), (const LAS int*)(F.lds + MOE_OFF + 128), (const LAS unsigned char*)(F.lds + MOE_OFF + 128 + 136),
                        (const int*)(F.ws + WS_PETOK), (size_t)2048 * D, true, (unsigned)D};
        pg8::EpiGU E{arg_in(11), arg_in(13), F.ws + WS_HDN};
        pg8::gemm_phase<pg8::EpiGU, pg8::MoeOrder, true, true, true>(F.lds, g, S, E); }
    ); SEAM(7);
    PHASE(8,
        { const int T = moe_tables(F);
        pg8::Gemm g{(const char*)(F.ws + WS_HDN), (const char*)(F.ws + WS_WD), DFF, DFF, DFF / 128};
        pg8::MoeOrder S{T, 4, F.G, (int)blockIdx.x, (const LAS int*)(F.lds + MOE_OFF), (const LAS int*)(F.lds + MOE_OFF + 128), (const LAS unsigned char*)(F.lds + MOE_OFF + 128 + 136),
                        (const int*)(F.ws + WS_PETOK), (size_t)D * DFF, false, 0u};
        pg8::EpiDown E{arg_in(15), (const int*)(F.ws + WS_PETOK), (const float*)(F.ws + WS_PEGATE), F.dout};
        pg8::gemm_phase<pg8::EpiDown, pg8::MoeOrder, true, false, true>(F.lds, g, S, E); }
    ); SEAM(8);
    if (IN(9)) {
        bool poison = (__hip_atomic_load(F.ctl + CW_TMO, RLX_AGENT) != 0u) || (__hip_atomic_load(F.ctl + CW_BAR + XB_TMO, RLX_AGENT) != 0u);
        if (DUP_PHASE == 9) p9_final(F, arg_in(16), arg_in(17), (const float*)F.dout, (float*)(F.ws + 194 * MiB), poison);
        p9_final(F, arg_in(16), arg_in(17), (const float*)F.dout, (float*)F.dout, poison);
    }
#undef PHASE
#undef IN
#undef SEAM
}

extern "C" void kernel_launch(void* const* d_in, const int* in_sizes, int n_in, void* d_out, int out_size, void* d_ws, size_t ws_size, hipStream_t stream) {
    static int grid = 0;
    if (grid == 0) {
        if (n_in != 18 || in_sizes[0] != NTOK * D || out_size != NTOK * D || ws_size < WS_END) { fprintf(stderr, "kernel_launch: unexpected shapes (n_in %d, ws %zu); nothing launched\n", n_in, ws_size); grid = -1; return; }
        int dev = 0, cus = 0, per_cu = 0;
        if (hipGetDevice(&dev) != hipSuccess || hipDeviceGetAttribute(&cus, hipDeviceAttributeMultiprocessorCount, dev) != hipSuccess) { grid = -1; return; }
        if (hipFuncSetAttribute((const void*)fwd_kernel, hipFuncAttributeMaxDynamicSharedMemorySize, LDS_BYTES) != hipSuccess) { fprintf(stderr, "kernel_launch: hipFuncSetAttribute failed\n"); grid = -1; return; }
        if (hipOccupancyMaxActiveBlocksPerMultiprocessor(&per_cu, (const void*)fwd_kernel, NWAVES * 64, LDS_BYTES) != hipSuccess || per_cu < 1) fprintf(stderr, "kernel_launch: occupancy query reports %d\n", per_cu);
        (void)hipGetLastError();
        grid = cus;
    }
    if (grid < 0) return;
    if (hipMemsetAsync((char*)d_ws + WS_CTL, 0, CTL_ZERO_BYTES, stream) != hipSuccess) return;
    Args a{};
    for (int i = 0; i < 18; ++i) a.in[i] = (const float*)d_in[i];
    a.out = (float*)d_out; a.ws = (unsigned char*)d_ws;
    if (N_LAUNCHES == 1) { a.ph_lo = 0; a.ph_hi = N_PHASES; hipLaunchKernelGGL(fwd_kernel, dim3(grid), dim3(NWAVES * 64), LDS_BYTES, stream, a); }
    else for (int p = 0; p < N_PHASES; ++p) { a.ph_lo = p; a.ph_hi = p + 1; hipLaunchKernelGGL(fwd_kernel, dim3(grid), dim3(NWAVES * 64), LDS_BYTES, stream, a); }
}
```

```cpp
#include <hip/hip_runtime.h>
#include <cstdio>
#include <cstdint>

#define GAS __attribute__((address_space(1)))
#define LAS __attribute__((address_space(3)))
typedef unsigned short bf16_t;
typedef short bf16x8 __attribute__((ext_vector_type(8)));
typedef short s16x4 __attribute__((ext_vector_type(4)));
typedef float f32x2 __attribute__((ext_vector_type(2)));
typedef float f32x4 __attribute__((ext_vector_type(4)));
typedef float f32x16 __attribute__((ext_vector_type(16)));
typedef unsigned u32x2 __attribute__((ext_vector_type(2)));
typedef unsigned u32x4 __attribute__((ext_vector_type(4)));
typedef GAS unsigned gu32;

#ifndef MK_N_LAUNCHES
#define MK_N_LAUNCHES 1
#endif
#ifndef DUP_PHASE
#define DUP_PHASE -1
#endif
constexpr int N_PHASES = 10;
constexpr int N_LAUNCHES = MK_N_LAUNCHES;

constexpr int NB = 8, SEQ = 4096, D = 1024, NTOK = NB * SEQ;
constexpr int HQ_P = 3584;
constexpr int SG_P = 2048;
constexpr int OAB_P = 1280;
constexpr int IN_COLS = 5632;
constexpr int NEXP = 32, TOPK = 4, DFF = 1024;
constexpr int MAX_MT = 544;
constexpr float LN_EPS = 1e-5f;
constexpr float DN_ALPHA = 1.189207115002721f;
constexpr float LOG2E = 1.4426950408889634f, LN2 = 0.6931471805599453f;
constexpr float QSCALE = 0.125f * LOG2E;
constexpr float NEG_BIG = -1e30f;

constexpr size_t MiB = 1u << 20;
constexpr size_t WS_CTL = 0, CTL_ZERO_BYTES = 1 * MiB;
constexpr size_t WS_XBUF = 1 * MiB;
constexpr size_t WS_Y = 194 * MiB;
constexpr size_t WS_STAT = 258 * MiB;
constexpr size_t WS_HQ = 2 * MiB;
constexpr size_t HQ_QD = 0, HQ_KD = 48 * MiB, HQ_VD = 96 * MiB, HQ_QS = 144 * MiB, HQ_KS = 208 * MiB, HQ_VS = 216 * MiB;
constexpr size_t WS_WGU = 404 * MiB;
constexpr size_t WS_WD = 468 * MiB;
constexpr size_t WS_X1B = 98 * MiB;
constexpr size_t WS_X1Q = 162 * MiB;
constexpr size_t WS_HDN = 194 * MiB;
constexpr size_t WS_SG = 226 * MiB;
constexpr size_t WS_YS23 = 330 * MiB;
constexpr size_t WS_OAG = 354 * MiB;
constexpr size_t WS_LSE = 402 * MiB;
constexpr size_t WS_MRG = 2 * MiB;
constexpr size_t WS_WOUT = 530 * MiB;
constexpr size_t WS_PETOK = 532 * MiB;
constexpr size_t WS_PEGATE = 536 * MiB;
constexpr size_t WS_WRT = 540 * MiB;
constexpr size_t WS_END = 540 * MiB + 256 * 1024;
constexpr float SX = 8.0f, SW = 512.0f, SH = 4.0f, SXIN = 8.0f, SY = 64.0f, SM = 64.0f, SO = 64.0f, SSG = 256.0f, SQ = 64.0f, SK = 16.0f;
static_assert(WS_HQ + (size_t)NTOK * HQ_P * 2 <= WS_SG && WS_SG + (size_t)NTOK * SG_P <= WS_OAG && WS_OAG + (size_t)3 * NTOK * 256 * 2 <= WS_LSE && WS_LSE + (size_t)3 * NTOK * 4 * 4 <= WS_WGU, "ws map 1");
static_assert(WS_WGU + (size_t)NEXP * 2048 * D <= WS_WD && WS_WD + (size_t)NEXP * D * DFF <= WS_WOUT && WS_MRG + (size_t)NTOK * D <= WS_X1B && WS_X1B + (size_t)NTOK * D * 2 <= WS_X1Q && WS_X1Q + (size_t)NTOK * D <= WS_HDN, "ws map 2");
static_assert(WS_HDN + (size_t)MAX_MT * 256 * DFF <= WS_OAG && WS_WOUT + (size_t)D * D <= WS_PETOK, "ws map 3");
constexpr size_t DO_XB = 0;
constexpr size_t DO_OAB = 0;
constexpr size_t DO_WIN = 96 * MiB;
constexpr size_t DO_WCAT = 108 * MiB;
constexpr int CW_TMO = 0, CW_CODE = 1;
constexpr int CW_BAR = 4096;
constexpr int CW_SEAM = 16384;
constexpr int CW_ECNT = 32768;
static_assert((CW_ECNT + 2 * 64 * NEXP) * 4 <= (int)CTL_ZERO_BYTES, "CTL words inside the memset region");

constexpr int RING_BYTES = 131072;
constexpr int SCR_BYTES = 143360;
constexpr int LDSCTL_OFF = SCR_BYTES;
constexpr int MISC_OFF = LDSCTL_OFF + 320;
constexpr int MOE_OFF = LDSCTL_OFF + 512;
constexpr int LDS_BYTES = 147456;
static_assert(MOE_OFF + 128 + 136 + MAX_MT <= LDS_BYTES, "LDS map");

#define RLX_AGENT __ATOMIC_RELAXED, __HIP_MEMORY_SCOPE_AGENT
#define LDS_WAIT() asm volatile("s_waitcnt lgkmcnt(0)" ::: "memory")
#define VM_WAIT() asm volatile("s_waitcnt vmcnt(0)" ::: "memory")

__device__ __forceinline__ unsigned cvt_pk_bf16(float lo, float hi) { unsigned r; asm volatile("v_cvt_pk_bf16_f32 %0, %1, %2" : "=v"(r) : "v"(lo), "v"(hi)); return r; }
__device__ __forceinline__ int opaque(int v) { asm volatile("" : "+v"(v)); return v; }
__device__ __forceinline__ unsigned pk4_fp8(float a, float b, float c, float d) { int w = 0; w = __builtin_amdgcn_cvt_pk_fp8_f32(a, b, w, false); w = __builtin_amdgcn_cvt_pk_fp8_f32(c, d, w, true); return (unsigned)w; }
__device__ __forceinline__ unsigned f2e4m3_sw(float x) {
    const float a = __builtin_amdgcn_fmed3f(fabsf(x), 9.5367431640625e-07f, 448.f);
    const int e1 = max(__builtin_amdgcn_frexp_expf(a), -5);
    const unsigned m = (unsigned)__builtin_rintf(__builtin_amdgcn_ldexpf(a, 4 - e1));
    return ((__float_as_uint(x) >> 24) & 0x80u) | (unsigned)((e1 << 3) + 40 + (int)m); }
__device__ __forceinline__ unsigned pk4_fp8_pad(float a, float b, float c, float d) {
    unsigned w;
    asm("v_cvt_pk_fp8_f32 %0, %1, %2\n\ts_nop 1" : "=v"(w) : "v"(a), "v"(b));
    asm("v_cvt_pk_fp8_f32 %0, %1, %2 op_sel:[0,0,1]\n\ts_nop 1" : "+v"(w) : "v"(c), "v"(d));
    return w; }
__device__ __forceinline__ float clamp_fp8(float v) { return __builtin_amdgcn_fmed3f(v, -448.0f, 448.0f); }
__device__ __forceinline__ float bf_lo(unsigned w) { return __uint_as_float(w << 16); }
__device__ __forceinline__ float bf_hi(unsigned w) { return __uint_as_float(w & 0xffff0000u); }
__device__ __forceinline__ float fast_sigmoid(float g) { g = fminf(fmaxf(g, -60.f), 60.f); return __builtin_amdgcn_rcpf(1.0f + __builtin_amdgcn_exp2f(-g * LOG2E)); }

namespace pg8 {
constexpr int BM = 256, BK = 64, HALF = 128, HTB = HALF * BK * 2, STAGE_BYTES = 8 * HTB, NXCD = 8, WGM = 8;
constexpr int EPRE_OFF = STAGE_BYTES;
static_assert(EPRE_OFF + 3072 <= SCR_BYTES, "epilogue prefetch area");
__host__ __device__ __forceinline__ int lds_byte(int r, int c) { const int st = (r >> 4) * 2 + (c >> 5), rr = r & 15, cc = c & 31, ob = rr * 64 + cc * 2; return st * 1024 + (ob ^ (((ob >> 9) & 1) << 5)); }
__host__ __device__ __forceinline__ void stage_rc(int b, int& R, int& C) { const int st = b / 1024, sb = b % 1024, swz = sb ^ (((sb >> 9) & 1) << 5); R = (st >> 1) * 16 + swz / 64; C = (st & 1) * 32 + (swz % 64) / 2; }
__host__ __device__ __forceinline__ int perm32(int rho) { const int n = rho >> 4, i = rho & 15; return 8 * (i >> 2) + 4 * n + (i & 3); }

struct Unit { int pm, pn, e, ti, valid; };
struct Gemm { const char* A; const char* Bt; int lda, ldb, nt; };

__device__ __forceinline__ bool tile_of(long L, int nM, int nN, int& pm, int& pn) {
    const int nwg = nM * nN; if (L >= nwg) return false;
    int wgid = (int)L; { const int q = nwg / NXCD, r = nwg % NXCD, xcd = wgid % NXCD, off = wgid / NXCD; wgid = (xcd < r ? xcd * (q + 1) : r * (q + 1) + (xcd - r) * q) + off; }
    const int nig = WGM * nN, gid = wgid / nig, fm = gid * WGM, gsz = (nM - fm) < WGM ? (nM - fm) : WGM;
    pm = fm + ((wgid % nig) % gsz); pn = (wgid % nig) / gsz; return true;
}
struct StaticOrder {
    int nM, nN, G, c;
    __device__ __forceinline__ void init(int M, int N, int G_, int c_) { nM = M / BM; nN = N / BM; G = G_; c = c_; }
    __device__ __forceinline__ bool next(int i, Unit& u) const { u.e = 0; u.ti = 0; u.valid = 256; return tile_of((long)i * G + c, nM, nN, u.pm, u.pn); }
    __device__ __forceinline__ const char* a_ptr(const Gemm& g, const Unit& u) const { return g.A + (size_t)u.pm * 256 * g.lda; }
    __device__ __forceinline__ const char* b_ptr(const Gemm& g, const Unit& u) const { return g.Bt + (size_t)u.pn * 256 * g.ldb; }
    __device__ __forceinline__ unsigned row_off(const Unit&, int) const { return 0u; }
};
struct MoeOrder {
    int T, nN, G, c; const LAS int* cnt; const LAS int* fs; const LAS unsigned char* te;
    const int* petok; size_t b_exp_stride; bool gather; unsigned rowbytes;
    __device__ __forceinline__ bool next(int i, Unit& u) const {
        if (!tile_of((long)i * G + c, T, nN, u.pm, u.pn)) return false;
        u.e = __builtin_amdgcn_readfirstlane((int)te[u.pm]); u.ti = u.pm - __builtin_amdgcn_readfirstlane(fs[u.e]); const int left = __builtin_amdgcn_readfirstlane(cnt[u.e]) - u.ti * 256; u.valid = left < 256 ? left : 256; return true;
    }
    __device__ __forceinline__ const char* a_ptr(const Gemm& g, const Unit& u) const { return gather ? g.A : g.A + (size_t)u.pm * 256 * g.lda; }
    __device__ __forceinline__ const char* b_ptr(const Gemm& g, const Unit& u) const { return g.Bt + (size_t)u.e * b_exp_stride + (size_t)u.pn * 256 * g.ldb; }
    __device__ __forceinline__ unsigned row_off(const Unit& u, int R) const {
        int tok = 0; if (R < u.valid) tok = petok[(size_t)u.e * NTOK + u.ti * 256 + R] >> 2;
        return (unsigned)tok * rowbytes;
    }
};

typedef int v8i32 __attribute__((ext_vector_type(8)));
template <class Epi, class Sched, bool ALIGN_EPI, bool GATHER, bool F8 = false>
__device__ __forceinline__ void gemm_phase(LAS unsigned char* lds, const Gemm g, const Sched& S, const Epi& E) {
    const int tid = threadIdx.x, wid = __builtin_amdgcn_readfirstlane(tid >> 6), lane = tid & 63, wr = wid >> 2, wc = wid & 3, fr = lane & 15, fq = lane >> 4;
    const int nt = g.nt;
    unsigned voffA[2], voffB[2]; int RA[2], CA2[2];
#pragma unroll
    for (int i = 0; i < 2; ++i) { int R, C; stage_rc(tid * 16 + i * 8192, R, C); const int Rb = Epi::PERM ? ((R & ~31) + perm32(R & 31)) : R;
        voffA[i] = (unsigned)(R * g.lda + C * 2); voffB[i] = (unsigned)(Rb * g.ldb + C * 2); RA[i] = R; CA2[i] = C * 2; }
    const size_t kstep = (size_t)(BK * 2);
    const size_t hstepA = (size_t)HALF * g.lda, hstepB = (size_t)HALF * g.ldb;
    const unsigned ldsw = (unsigned)wid * 1024u;
    const int aoff = lds_byte(wr * 64 + fr, fq * 8), boff = lds_byte(wc * 32 + fr, fq * 8);
    const int aoff0 = aoff, boff0 = boff, aoff1 = aoff + 1024, boff1 = boff + 1024;
#define PG8_SA(b, h) (((b) * 2 + (h)) * HTB)
#define PG8_SB(b, h) ((4 + (b) * 2 + (h)) * HTB)
#define PG8_STAGE(bufoff, gbase, voff) do { _Pragma("unroll") for (int _i = 0; _i < 2; ++_i) \
        __builtin_amdgcn_global_load_lds((const unsigned*)((const char*)(gbase) + (voff)[_i]), (LAS unsigned*)(lds + (bufoff) + ldsw + _i * 8192), 16, 0, 0); } while (0)
#define PG8_STAGE_A(bufoff, kp, h, nx) do { if constexpr (GATHER) { unsigned _v[2]; _v[0] = (nx) ? gN[h][0] : gC[h][0]; _v[1] = (nx) ? gN[h][1] : gC[h][1]; PG8_STAGE(bufoff, kp, _v); } \
        else { PG8_STAGE(bufoff, (kp) + (h) * hstepA, voffA); } } while (0)
#define PG8_LDA(dst, b, h) do { _Pragma("unroll") for (int m = 0; m < 4; ++m) _Pragma("unroll") for (int k = 0; k < 2; ++k) dst[m][k] = *(const LAS bf16x8*)(lds + PG8_SA(b, h) + (k ? aoff1 : aoff0) + m * 2048); } while (0)
#define PG8_LDB(dst, b, h) do { _Pragma("unroll") for (int n = 0; n < 2; ++n) _Pragma("unroll") for (int k = 0; k < 2; ++k) dst[n][k] = *(const LAS bf16x8*)(lds + PG8_SB(b, h) + (k ? boff1 : boff0) + n * 2048); } while (0)
#define PG8_F8OP(X) __builtin_bit_cast(v8i32, __builtin_shufflevector(X[0], X[1], 0, 1, 2, 3, 4, 5, 6, 7, 8, 9, 10, 11, 12, 13, 14, 15))
#define PG8_MMA(ai, bj, At, Bt) do { __builtin_amdgcn_s_setprio(1); if constexpr (F8) { _Pragma("unroll") for (int m = 0; m < 4; ++m) _Pragma("unroll") for (int n = 0; n < 2; ++n) \
        asm volatile("v_mfma_scale_f32_16x16x128_f8f6f4 %0, %1, %2, %0, %3, %3 op_sel_hi:[0,0,0]" : "+v"(acc[ai][bj][m][n]) : "v"(PG8_F8OP(Bt[n])), "v"(PG8_F8OP(At[m])), "v"(one_scale)); } \
        else { _Pragma("unroll") for (int m = 0; m < 4; ++m) _Pragma("unroll") for (int n = 0; n < 2; ++n) _Pragma("unroll") for (int k = 0; k < 2; ++k) \
        acc[ai][bj][m][n] = __builtin_amdgcn_mfma_f32_16x16x32_bf16(Bt[n][k], At[m][k], acc[ai][bj][m][n], 0, 0, 0); } __builtin_amdgcn_s_setprio(0); } while (0)
#define PG8_WAIT_V(n) asm volatile("s_waitcnt vmcnt(" #n ")" ::: "memory")
#define PG8_WAIT_L(n) asm volatile("s_waitcnt lgkmcnt(" #n ")" ::: "memory")
#define PG8_BAR __builtin_amdgcn_s_barrier()
#define PG8_SCHED __builtin_amdgcn_sched_barrier(0)
    Unit cur, nxt; int ui = 0;
    if (!S.next(0, cur)) return;
    int one_scale = 0x7f7f7f7f; if constexpr (F8) asm volatile("" : "+v"(one_scale));
    unsigned gC[2][2], gN[2][2];
#pragma unroll
    for (int h = 0; h < 2; ++h)
#pragma unroll
        for (int i = 0; i < 2; ++i) { gC[h][i] = GATHER ? S.row_off(cur, h * HALF + RA[i]) + (unsigned)CA2[i] : 0u; gN[h][i] = gC[h][i]; }
    f32x4 acc[2][2][4][2];
#pragma unroll
    for (int a = 0; a < 2; ++a)
#pragma unroll
        for (int b = 0; b < 2; ++b)
#pragma unroll
            for (int m = 0; m < 4; ++m)
#pragma unroll
                for (int n = 0; n < 2; ++n) acc[a][b][m][n] = (f32x4){0.f, 0.f, 0.f, 0.f};
    bf16x8 At[4][2], B0[2][2], B1[2][2];
    const char* cA = S.a_ptr(g, cur); const char* cB = S.b_ptr(g, cur);
    PG8_STAGE(PG8_SB(0, 0), cB, voffB); PG8_STAGE(PG8_SB(0, 1), cB + hstepB, voffB); PG8_STAGE_A(PG8_SA(0, 0), cA, 0, false); PG8_STAGE_A(PG8_SA(0, 1), cA, 1, false);
    if (wr == 1) PG8_BAR;
    PG8_WAIT_V(2); PG8_BAR;
    PG8_STAGE(PG8_SB(1, 0), cB + kstep, voffB); PG8_STAGE_A(PG8_SA(1, 0), cA + kstep, 0, false); PG8_STAGE(PG8_SB(1, 1), cB + hstepB + kstep, voffB);
    PG8_WAIT_V(6); PG8_BAR;
    for (;;) {
        const bool has_next = S.next(ui + 1, nxt);
        const char* nA = has_next ? S.a_ptr(g, nxt) : cA; const char* nB = has_next ? S.b_ptr(g, nxt) : cB;
        if constexpr (GATHER) { if (has_next) {
#pragma unroll
            for (int h = 0; h < 2; ++h)
#pragma unroll
                for (int i = 0; i < 2; ++i) gN[h][i] = S.row_off(nxt, h * HALF + RA[i]) + (unsigned)CA2[i]; } }
#pragma unroll 1
        for (int t = 0; t < nt; t += 2) {
            const bool last = (t == nt - 2);
            asm volatile("" : "+v"(voffA[0]), "+v"(voffA[1]), "+v"(voffB[0]), "+v"(voffB[1]));
            if constexpr (Epi::HAS_MID) { if (t == Epi::MID_T) E.mid(acc, cur, wr, wc, fr, fq); }
            if constexpr (Epi::HAS_PRE) { if (last) E.pre(lds, cur, wid, lane); }
            const char* a1 = cA + (size_t)(t + 1) * kstep;
            const char* a2 = last ? nA : cA + (size_t)(t + 2) * kstep; const char* b2 = last ? nB : cB + (size_t)(t + 2) * kstep;
            const char* a3 = a2 + kstep; const char* b3 = b2 + kstep;
            PG8_LDB(B0, 0, 0); PG8_LDB(B1, 0, 1); PG8_SCHED; PG8_LDA(At, 0, 0); PG8_STAGE_A(PG8_SA(1, 1), a1, 1, false);
            PG8_WAIT_V(8); PG8_WAIT_L(0); PG8_BAR; PG8_MMA(0, 0, At, B0); PG8_MMA(0, 1, At, B1); PG8_BAR; PG8_SCHED;
            PG8_LDA(At, 0, 1); PG8_STAGE(PG8_SB(0, 0), b2, voffB); PG8_STAGE(PG8_SB(0, 1), b2 + hstepB, voffB); PG8_STAGE_A(PG8_SA(0, 0), a2, 0, last);
            PG8_WAIT_V(8); PG8_WAIT_L(0); PG8_BAR; PG8_MMA(1, 0, At, B0); PG8_MMA(1, 1, At, B1); PG8_BAR; PG8_SCHED;
            PG8_LDB(B0, 1, 0); PG8_LDB(B1, 1, 1); PG8_SCHED; PG8_LDA(At, 1, 0); PG8_STAGE_A(PG8_SA(0, 1), a2, 1, last);
            PG8_WAIT_V(8); PG8_WAIT_L(0); PG8_BAR; PG8_MMA(0, 0, At, B0); PG8_MMA(0, 1, At, B1); PG8_BAR; PG8_SCHED;
            PG8_LDA(At, 1, 1); PG8_STAGE(PG8_SB(1, 0), b3, voffB); PG8_STAGE(PG8_SB(1, 1), b3 + hstepB, voffB); PG8_STAGE_A(PG8_SA(1, 0), a3, 0, last);
            PG8_WAIT_V(8); PG8_WAIT_L(0); PG8_BAR; PG8_MMA(1, 0, At, B0); PG8_MMA(1, 1, At, B1); PG8_BAR; PG8_SCHED;
        }
        if constexpr (ALIGN_EPI) { if (wr == 0) PG8_BAR; }
        if constexpr (F8) asm volatile("s_nop 15\n\ts_nop 15" ::: "memory");
        if constexpr (!Epi::AFTER_DRAIN) { E(acc, cur, wr, wc, fr, fq); }
        if (!has_next) break;
#pragma unroll
        for (int a = 0; a < 2; ++a)
#pragma unroll
            for (int b = 0; b < 2; ++b)
#pragma unroll
                for (int m = 0; m < 4; ++m)
#pragma unroll
                    for (int n = 0; n < 2; ++n) acc[a][b][m][n] = (f32x4){0.f, 0.f, 0.f, 0.f};
        cur = nxt; cA = nA; cB = nB; ++ui;
#pragma unroll
        for (int h = 0; h < 2; ++h)
#pragma unroll
            for (int i = 0; i < 2; ++i) gC[h][i] = gN[h][i];
        if constexpr (ALIGN_EPI) { if (wr == 1) PG8_BAR; }
    }
    PG8_WAIT_V(0);
    if constexpr (!ALIGN_EPI) { if (wr == 0) PG8_BAR; }
    PG8_BAR;
    if constexpr (Epi::AFTER_DRAIN) { E.fused(acc, cur, wr, wc, fr, fq, lds, wid, lane); }
#undef PG8_SA
#undef PG8_SB
#undef PG8_STAGE
#undef PG8_STAGE_A
#undef PG8_LDA
#undef PG8_LDB
#undef PG8_MMA
#undef PG8_F8OP
#undef PG8_WAIT_V
#undef PG8_WAIT_L
#undef PG8_BAR
#undef PG8_SCHED
}
}

namespace pg8 {
struct EpiInProj {
    static constexpr bool PERM = true, AFTER_DRAIN = false, HAS_MID = false, HAS_PRE = false; static constexpr int MID_T = 0;
    unsigned char* HQ; unsigned char* SG; float rs;
    __device__ __forceinline__ void mid(f32x4 (&)[2][2][4][2], const Unit&, int, int, int, int) const {}
    __device__ __forceinline__ void operator()(const f32x4 (&acc)[2][2][4][2], const Unit& u, int wr, int wc, int fr, int fq) const {
        const int row0 = u.pm * BM + wr * 64 + opaque(fr), pn = u.pn;
        const bool gate = pn >= 14; const bool qs = (pn < 3) || (pn >= 9 && pn < 13);
        const float sc = (qs ? QSCALE : 1.0f) * rs; const int dcol = (wc & 1) * 32 + 8 * fq;
#pragma unroll
        for (int ai = 0; ai < 2; ++ai)
#pragma unroll
            for (int m = 0; m < 4; ++m) { const int row = row0 + ai * HALF + m * 16, b = row >> 12, t = row & (SEQ - 1);
#pragma unroll
                for (int bj = 0; bj < 2; ++bj) { f32x4 v0 = acc[ai][bj][m][0], v1 = acc[ai][bj][m][1];
                    bf16_t* dst;
                    if (gate) {
#pragma unroll
                        for (int q = 0; q < 4; ++q) { v0[q] = fmaxf(fast_sigmoid(v0[q] * rs) * SSG, 0.001953125f); v1[q] = fmaxf(fast_sigmoid(v1[q] * rs) * SSG, 0.001953125f); }
                        u32x2 w8; w8.x = pk4_fp8(v0[0], v0[1], v0[2], v0[3]); w8.y = pk4_fp8(v1[0], v1[1], v1[2], v1[3]);
                        *(u32x2*)(SG + (size_t)row * SG_P + (pn - 14) * 256 + bj * HALF + wc * 32 + 8 * fq) = w8; continue; }
                    else { v0 = v0 * sc; v1 = v1 * sc; const int hl = bj * 2 + (wc >> 1);
                        size_t rowi; unsigned char* base8; float qk; bool is8;
                        if (pn < 9) { const int ty = pn / 3, g = pn - 3 * ty, sh = 2 * g, pos = ((t & ((1 << sh) - 1)) << (12 - sh)) + (t >> sh);
                            rowi = (size_t)(((g * NB + b) * 4 + hl) * SEQ + pos); base8 = HQ + (size_t)ty * (48 * MiB); is8 = ty < 2; qk = ty == 0 ? SQ : SK; }
                        else if (pn < 13) { rowi = (size_t)((b * 16 + (pn - 9) * 4 + hl) * SEQ + t); base8 = HQ + HQ_QS; is8 = true; qk = SQ; }
                        else { rowi = (size_t)((b * 2 + (wc >> 1)) * SEQ + t); base8 = HQ + (bj ? HQ_VS : HQ_KS); is8 = (bj == 0); qk = SK; }
                        if (is8) { u32x2 w8; w8.x = pk4_fp8(clamp_fp8(v0[0] * qk), clamp_fp8(v0[1] * qk), clamp_fp8(v0[2] * qk), clamp_fp8(v0[3] * qk)); w8.y = pk4_fp8(clamp_fp8(v1[0] * qk), clamp_fp8(v1[1] * qk), clamp_fp8(v1[2] * qk), clamp_fp8(v1[3] * qk));
                            *(u32x2*)(base8 + rowi * 64 + dcol) = w8; continue; }
                        dst = (bf16_t*)base8 + rowi * 64 + dcol; }
                    u32x4 w; w.x = cvt_pk_bf16(v0[0], v0[1]); w.y = cvt_pk_bf16(v0[2], v0[3]); w.z = cvt_pk_bf16(v1[0], v1[1]); w.w = cvt_pk_bf16(v1[2], v1[3]);
                    *(u32x4*)dst = w; } }
    }
};
struct EpiGate {
    static constexpr bool PERM = true, AFTER_DRAIN = false, HAS_MID = true, HAS_PRE = false; static constexpr int MID_T = 2;
    const unsigned char* __restrict__ SG; unsigned char* __restrict__ O;
    __device__ __forceinline__ void mid(f32x4 (&acc)[2][2][4][2], const Unit& u, int wr, int wc, int fr, int fq) const {
        const int row0 = u.pm * BM + wr * 64 + opaque(fr), col0 = u.pn * BM + wc * 32 + 8 * opaque(fq);
#pragma unroll
        for (int ai = 0; ai < 2; ++ai) {
            u32x2 a[4][2], b[4][2];
#pragma unroll
            for (int mm = 0; mm < 4; ++mm) { const unsigned char* sp = SG + (size_t)(row0 + ai * HALF + mm * 16) * SG_P + col0;
#pragma unroll
                for (int bj = 0; bj < 2; ++bj) { a[mm][bj] = *(const u32x2*)(sp + bj * HALF); b[mm][bj] = *(const u32x2*)(sp + 1024 + bj * HALF); } }
#pragma unroll
            for (int m = 0; m < 4; ++m) {
#pragma unroll
                for (int bj = 0; bj < 2; ++bj) {
#pragma unroll
                    for (int n = 0; n < 2; ++n) { const int aw = (int)a[m][bj][n], bw = (int)b[m][bj][n];
                        const f32x2 al = __builtin_amdgcn_cvt_pk_f32_fp8(aw, false), ah = __builtin_amdgcn_cvt_pk_f32_fp8(aw, true), bl = __builtin_amdgcn_cvt_pk_f32_fp8(bw, false), bh = __builtin_amdgcn_cvt_pk_f32_fp8(bw, true);
                        f32x4 r; r[0] = al[0] * __builtin_amdgcn_rcpf(bl[0]); r[1] = al[1] * __builtin_amdgcn_rcpf(bl[1]); r[2] = ah[0] * __builtin_amdgcn_rcpf(bh[0]); r[3] = ah[1] * __builtin_amdgcn_rcpf(bh[1]);
                        acc[ai][bj][m][n] = acc[ai][bj][m][n] * r; } }
                asm volatile("" : "+v"(acc[ai][0][m][0]), "+v"(acc[ai][0][m][1]), "+v"(acc[ai][1][m][0]), "+v"(acc[ai][1][m][1])); }
            asm volatile("" ::: "memory"); }
    }
    __device__ __forceinline__ void operator()(const f32x4 (&acc)[2][2][4][2], const Unit& u, int wr, int wc, int fr, int fq) const {
        const int row0 = u.pm * BM + wr * 64 + opaque(fr), col0 = u.pn * BM + wc * 32 + 8 * opaque(fq);
        constexpr float FS = SM / (SO * SW * SSG);
#pragma unroll
        for (int ai = 0; ai < 2; ++ai) {
            u32x2 bq[4][2];
#pragma unroll
            for (int m = 0; m < 4; ++m)
#pragma unroll
                for (int bj = 0; bj < 2; ++bj) bq[m][bj] = *(const u32x2*)(SG + (size_t)(row0 + ai * HALF + m * 16) * SG_P + 1024 + col0 + bj * HALF);
#pragma unroll
            for (int m = 0; m < 4; ++m) { unsigned char* op = O + (size_t)(row0 + ai * HALF + m * 16) * D + col0;
#pragma unroll
                for (int bj = 0; bj < 2; ++bj) { u32x2 w;
#pragma unroll
                    for (int n = 0; n < 2; ++n) { const int bw = (int)bq[m][bj][n]; const f32x2 bl = __builtin_amdgcn_cvt_pk_f32_fp8(bw, false), bh = __builtin_amdgcn_cvt_pk_f32_fp8(bw, true); const f32x4 v = acc[ai][bj][m][n] * FS;
                        w[n] = pk4_fp8(clamp_fp8(v[0] * bl[0]), clamp_fp8(v[1] * bl[1]), clamp_fp8(v[2] * bh[0]), clamp_fp8(v[3] * bh[1])); }
                    *(u32x2*)(op + bj * HALF) = w; } }
            asm volatile("" ::: "memory"); }
    }
};

struct PanelStats {
    unsigned* xbuf;
    unsigned* cnt;
    unsigned* tmo;
    int pm_off; float eps; unsigned code;
    __device__ __forceinline__ bool run(const f32x4 (&v)[2][2][4][2], const Unit& u, int wr, int wc, int fr, int fq, LAS unsigned char* lds, int wid, int lane) const {
        LAS f32x2* P = (LAS f32x2*)lds;
        LAS f32x2* S = (LAS f32x2*)(lds + 8192);
        LAS unsigned* flag = (LAS unsigned*)(lds + 8192 + 2048);
        const int panel = u.pm + pm_off;
#pragma unroll
        for (int ai = 0; ai < 2; ++ai)
#pragma unroll
            for (int m = 0; m < 4; ++m) {
                float s = 0.f;
#pragma unroll
                for (int bj = 0; bj < 2; ++bj)
#pragma unroll
                    for (int n = 0; n < 2; ++n) { const f32x4 x = v[ai][bj][m][n]; s += (x[0] + x[1]) + (x[2] + x[3]); }
                s += __shfl_xor(s, 16); s += __shfl_xor(s, 32);
                const float mw = s * (1.0f / 64.0f); float q = 0.f;
#pragma unroll
                for (int bj = 0; bj < 2; ++bj)
#pragma unroll
                    for (int n = 0; n < 2; ++n) { const f32x4 d = v[ai][bj][m][n] - mw; q += (d[0] * d[0] + d[1] * d[1]) + (d[2] * d[2] + d[3] * d[3]); }
                q += __shfl_xor(q, 16); q += __shfl_xor(q, 32);
                if (fq == 0) P[(ai * HALF + wr * 64 + m * 16 + fr) * 4 + wc] = (f32x2){mw, q};
            }
        asm volatile("s_waitcnt lgkmcnt(0)" ::: "memory"); __builtin_amdgcn_s_barrier(); asm volatile("" ::: "memory");
        const int row = wid * 32 + (lane & 31);
        if (lane < 32) {
            const f32x2 a = P[row * 4 + 0], b = P[row * 4 + 1], c = P[row * 4 + 2], d = P[row * 4 + 3];
            const float mt = (a.x + b.x + c.x + d.x) * 0.25f;
            const float da = a.x - mt, db = b.x - mt, dc = c.x - mt, dd = d.x - mt;
            const float m2 = (a.y + b.y) + (c.y + d.y) + 64.0f * ((da * da + db * db) + (dc * dc + dd * dd));
            unsigned long long* slot = (unsigned long long*)xbuf + ((size_t)(panel * BM + row) * 4 + u.pn);
            __hip_atomic_store(slot, ((unsigned long long)__float_as_uint(m2) << 32) | __float_as_uint(mt), __ATOMIC_RELAXED, __HIP_MEMORY_SCOPE_AGENT);
        }
        asm volatile("s_waitcnt vmcnt(0)" ::: "memory");
        if (lane == 0) __hip_atomic_fetch_add(cnt + 64 * panel, 1u, __ATOMIC_RELAXED, __HIP_MEMORY_SCOPE_AGENT);
        if (wid == 0) {
            bool dead = false; const unsigned long long t0 = __builtin_amdgcn_s_memrealtime(); const unsigned want = 8u * 4u;
            for (;;) {
                if ((unsigned)__builtin_amdgcn_readfirstlane(__hip_atomic_load(cnt + 64 * panel, __ATOMIC_RELAXED, __HIP_MEMORY_SCOPE_AGENT)) >= want) break;
                if (__builtin_amdgcn_s_memrealtime() - t0 > 2000000ull) {
                    if (lane == 0) { unsigned expect = 0u; __hip_atomic_compare_exchange_strong(tmo + 1, &expect, code | (unsigned)(panel & 0xff), __ATOMIC_RELAXED, __ATOMIC_RELAXED, __HIP_MEMORY_SCOPE_AGENT);
                                     __hip_atomic_store(tmo, 1u, __ATOMIC_RELAXED, __HIP_MEMORY_SCOPE_AGENT); }
                    dead = true; break; }
                __builtin_amdgcn_s_sleep(2);
            }
            __builtin_amdgcn_fence(__ATOMIC_ACQUIRE, "agent");
            if (lane == 0) flag[0] = dead ? 1u : 0u;
        }
        asm volatile("s_waitcnt vmcnt(0) lgkmcnt(0)" ::: "memory"); __builtin_amdgcn_s_barrier(); asm volatile("" ::: "memory");
        const bool bad = flag[0] != 0u;
        if (lane < 32) {
            const unsigned long long* slot = (const unsigned long long*)xbuf + (size_t)(panel * BM + row) * 4; float mt[4], m2[4]; float ms = 0.f;
#pragma unroll
            for (int t = 0; t < 4; ++t) { const unsigned long long w = __hip_atomic_load(slot + t, __ATOMIC_RELAXED, __HIP_MEMORY_SCOPE_AGENT); mt[t] = __uint_as_float((unsigned)w); m2[t] = __uint_as_float((unsigned)(w >> 32)); ms += mt[t]; }
            const float mean = ms * 0.25f; float q = 0.f;
#pragma unroll
            for (int t = 0; t < 4; ++t) { const float dm = mt[t] - mean; q += m2[t] + 256.0f * dm * dm; }
            S[row] = (f32x2){mean, 1.0f / sqrtf(q * (1.0f / 1024.0f) + eps)};
        }
        asm volatile("s_waitcnt lgkmcnt(0)" ::: "memory"); __builtin_amdgcn_s_barrier(); asm volatile("" ::: "memory");
        return bad;
    }
};
struct EpiLn1 {
    static constexpr bool PERM = true, AFTER_DRAIN = true, HAS_MID = false, HAS_PRE = false; static constexpr int MID_T = 0;
    const float* x; float* out; bf16_t* xb; unsigned char* xq; const float* gam; const float* bet; PanelStats st; int row_off; unsigned poison; float rs;
    __device__ __forceinline__ void mid(f32x4 (&)[2][2][4][2], const Unit&, int, int, int, int) const {}
    __device__ __forceinline__ void operator()(const f32x4 (&)[2][2][4][2], const Unit&, int, int, int, int) const {}
    __device__ __forceinline__ void fused(f32x4 (&acc)[2][2][4][2], const Unit& u, int wr, int wc, int fr, int fq, LAS unsigned char* lds, int wid, int lane) const {
        const LAS f32x2* S = (const LAS f32x2*)(lds + 8192);
        const int col0 = u.pn * BM + wc * 32 + 8 * opaque(fq);
        const int grow0 = row_off + u.pm * BM; fr = opaque(fr);
#pragma unroll
        for (int ai = 0; ai < 2; ++ai)
#pragma unroll
            for (int m = 0; m < 4; ++m) { const size_t off = (size_t)(grow0 + ai * HALF + wr * 64 + m * 16 + fr) * D + col0;
#pragma unroll
                for (int bj = 0; bj < 2; ++bj)
#pragma unroll
                    for (int n = 0; n < 2; ++n) { const f32x4 bs = *(const f32x4*)(x + off + bj * HALF + n * 4); acc[ai][bj][m][n] = acc[ai][bj][m][n] * rs + bs * DN_ALPHA; }
                asm volatile("" : "+v"(acc[ai][0][m][0]), "+v"(acc[ai][0][m][1]), "+v"(acc[ai][1][m][0]), "+v"(acc[ai][1][m][1]));
                if (m == 3) asm volatile("" ::: "memory"); }
        const bool bad = st.run(acc, u, wr, wc, fr, fq, lds, wid, lane) || poison != 0u;
        const float qnan = __builtin_nanf("");
        f32x4 gv[2][2], bv[2][2];
#pragma unroll
        for (int bj = 0; bj < 2; ++bj)
#pragma unroll
            for (int n = 0; n < 2; ++n) { gv[bj][n] = *(const f32x4*)(gam + col0 + bj * HALF + n * 4); bv[bj][n] = *(const f32x4*)(bet + col0 + bj * HALF + n * 4); }
#pragma unroll
        for (int ai = 0; ai < 2; ++ai)
#pragma unroll
            for (int m = 0; m < 4; ++m) { const int r = ai * HALF + wr * 64 + m * 16 + fr; const f32x2 sr = S[r]; const size_t off = (size_t)(grow0 + r) * D + col0;
#pragma unroll
                for (int bj = 0; bj < 2; ++bj) { f32x4 o0 = (acc[ai][bj][m][0] - sr.x) * sr.y * gv[bj][0] + bv[bj][0], o1 = (acc[ai][bj][m][1] - sr.x) * sr.y * gv[bj][1] + bv[bj][1];
                    if (bad) { o0 = (f32x4){qnan, qnan, qnan, qnan}; o1 = o0; }
                    u32x4 w; w.x = cvt_pk_bf16(o0[0], o0[1]); w.y = cvt_pk_bf16(o0[2], o0[3]); w.z = cvt_pk_bf16(o1[0], o1[1]); w.w = cvt_pk_bf16(o1[2], o1[3]); *(u32x4*)(xb + off + bj * HALF) = w;
                    u32x2 q8; q8.x = pk4_fp8(clamp_fp8(o0[0] * SX), clamp_fp8(o0[1] * SX), clamp_fp8(o0[2] * SX), clamp_fp8(o0[3] * SX)); q8.y = pk4_fp8(clamp_fp8(o1[0] * SX), clamp_fp8(o1[1] * SX), clamp_fp8(o1[2] * SX), clamp_fp8(o1[3] * SX));
                    *(u32x2*)(xq + off + bj * HALF) = q8; } }
    }
};
struct EpiY {
    static constexpr bool PERM = true, AFTER_DRAIN = false, HAS_MID = false, HAS_PRE = false; static constexpr int MID_T = 0;
    const float* __restrict__ x; bf16_t* __restrict__ Y; float* __restrict__ ST; float rs;
    __device__ __forceinline__ void mid(f32x4 (&)[2][2][4][2], const Unit&, int, int, int, int) const {}
    __device__ __forceinline__ void operator()(const f32x4 (&acc)[2][2][4][2], const Unit& u, int wr, int wc, int fr, int fq) const {
        const int row0 = u.pm * BM + wr * 64 + opaque(fr), col0 = u.pn * BM + wc * 32 + 8 * opaque(fq);
#pragma unroll
        for (int ai = 0; ai < 2; ++ai) {
            f32x4 xv[4][2][2];
#pragma unroll
            for (int m = 0; m < 4; ++m)
#pragma unroll
                for (int bj = 0; bj < 2; ++bj)
#pragma unroll
                    for (int n = 0; n < 2; ++n) xv[m][bj][n] = *(const f32x4*)(x + (size_t)(row0 + ai * HALF + m * 16) * D + col0 + bj * HALF + n * 4);
#pragma unroll
            for (int m = 0; m < 4; ++m) { const size_t r = (size_t)(row0 + ai * HALF + m * 16); float s1 = 0.f, s2 = 0.f;
#pragma unroll
                for (int bj = 0; bj < 2; ++bj) { const f32x4 y0 = acc[ai][bj][m][0] * rs + xv[m][bj][0] * DN_ALPHA, y1 = acc[ai][bj][m][1] * rs + xv[m][bj][1] * DN_ALPHA;
                    s1 += (y0[0] + y0[1]) + (y0[2] + y0[3]) + (y1[0] + y1[1]) + (y1[2] + y1[3]);
                    s2 += (y0[0] * y0[0] + y0[1] * y0[1]) + (y0[2] * y0[2] + y0[3] * y0[3]) + (y1[0] * y1[0] + y1[1] * y1[1]) + (y1[2] * y1[2] + y1[3] * y1[3]);
                    u32x4 w; w.x = cvt_pk_bf16(y0[0], y0[1]); w.y = cvt_pk_bf16(y0[2], y0[3]); w.z = cvt_pk_bf16(y1[0], y1[1]); w.w = cvt_pk_bf16(y1[2], y1[3]);
                    *(u32x4*)(Y + r * D + col0 + bj * HALF) = w; }
                s1 += __shfl_xor(s1, 16); s1 += __shfl_xor(s1, 32); s2 += __shfl_xor(s2, 16); s2 += __shfl_xor(s2, 32);
                if (fq == 0) *(f32x2*)(ST + (r * 16 + u.pn * 4 + wc) * 2) = (f32x2){s1, s2}; }
            asm volatile("" ::: "memory"); }
    }
};
struct EpiGU {
    static constexpr bool PERM = true, AFTER_DRAIN = false, HAS_MID = false, HAS_PRE = true; static constexpr int MID_T = 0;
    const float* bg; const float* bu; unsigned char* H; LAS unsigned char* plds;
    __device__ __forceinline__ void mid(f32x4 (&)[2][2][4][2], const Unit&, int, int, int, int) const {}
    __device__ __forceinline__ void pre(LAS unsigned char* lds, const Unit& u, int wid, int lane) const {
        if (wid == 0) __builtin_amdgcn_global_load_lds((const unsigned*)((lane < 32 ? bg : bu) + u.e * DFF + u.pn * HALF + (lane & 31) * 4), (LAS unsigned*)(lds + EPRE_OFF), 16, 0, 0);
    }
    __device__ __forceinline__ void operator()(const f32x4 (&acc)[2][2][4][2], const Unit& u, int wr, int wc, int fr, int fq) const {
        const int row0 = u.pm * BM + wr * 64 + opaque(fr), jl = wc * 32 + 8 * opaque(fq), j0 = u.pn * HALF + jl;
        const LAS float* pb = (const LAS float*)(plds + EPRE_OFF) + jl;
        const f32x4 g0 = *(const LAS f32x4*)pb, g1 = *(const LAS f32x4*)(pb + 4), u0 = *(const LAS f32x4*)(pb + HALF), u1 = *(const LAS f32x4*)(pb + HALF + 4);
        f32x4 us0 = (u0 + 1.0f) * SH, us1 = (u1 + 1.0f) * SH;
        asm volatile("" : "+v"(us0), "+v"(us1));
#pragma unroll
        for (int ai = 0; ai < 2; ++ai)
#pragma unroll
            for (int m = 0; m < 4; ++m) {
                constexpr float RS = 1.0f / (SX * SW), CS = -1.702f * LOG2E;
                f32x4 h0, h1;
#pragma unroll
                for (int q = 0; q < 4; ++q) {
                    const float a = fminf(__builtin_fmaf(acc[ai][0][m][0][q], RS, g0[q]), 7.0f), b = fminf(__builtin_fmaf(acc[ai][0][m][1][q], RS, g1[q]), 7.0f);
                    const float ua = __builtin_amdgcn_fmed3f(__builtin_fmaf(acc[ai][1][m][0][q], RS * SH, us0[q]), -6.0f * SH, 8.0f * SH), ub = __builtin_amdgcn_fmed3f(__builtin_fmaf(acc[ai][1][m][1][q], RS * SH, us1[q]), -6.0f * SH, 8.0f * SH);
                    h0[q] = (a * __builtin_amdgcn_rcpf(1.0f + __builtin_amdgcn_exp2f(CS * a))) * ua;
                    h1[q] = (b * __builtin_amdgcn_rcpf(1.0f + __builtin_amdgcn_exp2f(CS * b))) * ub; }
                u32x2 w; w.x = pk4_fp8(h0[0], h0[1], h0[2], h0[3]); w.y = pk4_fp8(h1[0], h1[1], h1[2], h1[3]);
                *(u32x2*)(H + (size_t)(row0 + ai * HALF + m * 16) * DFF + j0) = w; }
    }
};
struct EpiDown {
    static constexpr bool PERM = true, AFTER_DRAIN = false, HAS_MID = false, HAS_PRE = true; static constexpr int MID_T = 0;
    const float* bd; const int* petok; const float* pegate; unsigned char* Y; LAS unsigned char* plds;
    __device__ __forceinline__ void mid(f32x4 (&)[2][2][4][2], const Unit&, int, int, int, int) const {}
    __device__ __forceinline__ void pre(LAS unsigned char* lds, const Unit& u, int wid, int lane) const {
        const size_t eb = (size_t)u.e * NTOK + (size_t)u.ti * 256 + (size_t)(lane * 4);
        if (wid == 0) __builtin_amdgcn_global_load_lds((const unsigned*)(bd + u.e * D + u.pn * BM + lane * 4), (LAS unsigned*)(lds + EPRE_OFF), 16, 0, 0);
        else if (wid == 1) __builtin_amdgcn_global_load_lds((const unsigned*)(petok + eb), (LAS unsigned*)(lds + EPRE_OFF + 1024), 16, 0, 0);
        else if (wid == 2) __builtin_amdgcn_global_load_lds((const unsigned*)(pegate + eb), (LAS unsigned*)(lds + EPRE_OFF + 2048), 16, 0, 0);
    }
    __device__ __forceinline__ void operator()(const f32x4 (&acc)[2][2][4][2], const Unit& u, int wr, int wc, int fr, int fq) const {
        const int r0 = wr * 64 + opaque(fr), cl = wc * 32 + 8 * opaque(fq), col0 = u.pn * BM + cl;
        const LAS float* pb = (const LAS float*)(plds + EPRE_OFF) + cl;
        f32x4 b[2][2];
#pragma unroll
        for (int bj = 0; bj < 2; ++bj) { b[bj][0] = *(const LAS f32x4*)(pb + bj * HALF); b[bj][1] = *(const LAS f32x4*)(pb + bj * HALF + 4); }
        int info[2][4]; float gwv[2][4];
#pragma unroll
        for (int ai = 0; ai < 2; ++ai)
#pragma unroll
            for (int m = 0; m < 4; ++m) { const int r = r0 + ai * HALF + m * 16; info[ai][m] = *(const LAS int*)(plds + EPRE_OFF + 1024 + 4 * r); gwv[ai][m] = *(const LAS float*)(plds + EPRE_OFF + 2048 + 4 * r) * SY; }
        if (u.valid == 256) {
#pragma unroll
        for (int ai = 0; ai < 2; ++ai)
#pragma unroll
            for (int m = 0; m < 4; ++m) { const int r = r0 + ai * HALF + m * 16;
                { const float gw = gwv[ai][m];
                    unsigned char* op = Y + (size_t)info[ai][m] * 1024 + col0;
#pragma unroll
                    for (int bj = 0; bj < 2; ++bj) { constexpr float RS = 1.0f / (SH * SW); const f32x4 v0 = (acc[ai][bj][m][0] * RS + b[bj][0]) * gw, v1 = (acc[ai][bj][m][1] * RS + b[bj][1]) * gw;
                        u32x2 w; w.x = pk4_fp8(clamp_fp8(v0[0]), clamp_fp8(v0[1]), clamp_fp8(v0[2]), clamp_fp8(v0[3])); w.y = pk4_fp8(clamp_fp8(v1[0]), clamp_fp8(v1[1]), clamp_fp8(v1[2]), clamp_fp8(v1[3]));
                        *(u32x2*)(op + bj * HALF) = w; } } }
        } else {
#pragma unroll
        for (int ai = 0; ai < 2; ++ai)
#pragma unroll
            for (int m = 0; m < 4; ++m) { const int r = r0 + ai * HALF + m * 16;
                if (r < u.valid) { const float gw = gwv[ai][m];
                    unsigned char* op = Y + (size_t)info[ai][m] * 1024 + col0;
#pragma unroll
                    for (int bj = 0; bj < 2; ++bj) { constexpr float RS = 1.0f / (SH * SW); const f32x4 v0 = (acc[ai][bj][m][0] * RS + b[bj][0]) * gw, v1 = (acc[ai][bj][m][1] * RS + b[bj][1]) * gw;
                        u32x2 w; w.x = pk4_fp8(clamp_fp8(v0[0]), clamp_fp8(v0[1]), clamp_fp8(v0[2]), clamp_fp8(v0[3])); w.y = pk4_fp8(clamp_fp8(v1[0]), clamp_fp8(v1[1]), clamp_fp8(v1[2]), clamp_fp8(v1[3]));
                        *(u32x2*)(op + bj * HALF) = w; } } }
        }
    }
};
}

#define XB_TMO      128
#define XB_XCNT(j)  (256  + 64 * (j))
#define XB_XSUB(j)  (1280 + 64 * (j))
#define XB_XGEN(j)  (2304 + 64 * (j))
#define XB_TOP      3328
#define XB_TOPGEN   3392
#define XCD_BAR_WORDS 3456
#define XB_SPIN_CAP (1u << 18)
__device__ __forceinline__ unsigned xb_ld(unsigned* p)              { return __hip_atomic_load(p, __ATOMIC_RELAXED, __HIP_MEMORY_SCOPE_AGENT); }
__device__ __forceinline__ unsigned xb_add(unsigned* p, unsigned v) { return __hip_atomic_fetch_add(p, v, __ATOMIC_RELAXED, __HIP_MEMORY_SCOPE_AGENT); }
__device__ __forceinline__ unsigned xb_xcc_id() { return (unsigned)__builtin_amdgcn_s_getreg((3 << 11) | 20) & 0xFu; }
#define XB_SPIN(cond, bar) do { unsigned _sp = 0; while (cond) { __builtin_amdgcn_s_sleep(1); \
    if ((++_sp & 255u) == 0u) { if (xb_ld(&(bar)[XB_TMO])) break; if (_sp > XB_SPIN_CAP) { atomicAdd(&(bar)[XB_TMO], 1u); break; } } } } while (0)
struct XcdBarrier { unsigned* bar; unsigned x; volatile LAS unsigned* st; };
__device__ __forceinline__ XcdBarrier xcd_barrier_post(unsigned* bar, volatile LAS unsigned* st) {
    XcdBarrier b; b.bar = bar; b.x = xb_xcc_id(); b.st = st;
    if (threadIdx.x == 0) (void)xb_add(&bar[XB_XCNT(b.x)], 1u);
    return b;
}
__device__ __forceinline__ void xcd_barrier_complete(unsigned* bar, unsigned x, unsigned& nloc, unsigned& nx) {
    const unsigned G = gridDim.x * gridDim.y * gridDim.z;
    unsigned sum, cnt, mine, sp = 0u;
    for (;;) {
        sum = 0u; cnt = 0u; mine = 0u;
#pragma unroll
        for (unsigned j = 0; j < 16; ++j) { const unsigned c = xb_ld(&bar[XB_XCNT(j)]); sum += c; cnt += (c > 0u) ? 1u : 0u; mine = (j == x) ? c : mine; }
        if (sum == G) break;
        __builtin_amdgcn_s_sleep(1);
        if ((++sp & 255u) == 0u) { if (xb_ld(&bar[XB_TMO])) break; if (sp > XB_SPIN_CAP) { atomicAdd(&bar[XB_TMO], 1u); break; } }
    }
    nloc = mine > 0u ? mine : 1u; nx = cnt > 0u ? cnt : 1u;
}
__device__ __forceinline__ void xcd_barrier(const XcdBarrier& b) {
    asm volatile("s_waitcnt vmcnt(0)" ::: "memory");
    __syncthreads();
    if (threadIdx.x == 0) {
        unsigned* bar = b.bar;
        __builtin_amdgcn_s_waitcnt(0);
        unsigned nloc = b.st[0], nx = b.st[1];
        if (nloc == 0u) { xcd_barrier_complete(bar, b.x, nloc, nx); b.st[0] = nloc; b.st[1] = nx; }
        const unsigned old = xb_add(&bar[XB_XSUB(b.x)], 1u);
        const unsigned gen = old / nloc;
        if (old + 1u == (gen + 1u) * nloc) {
            __builtin_amdgcn_fence(__ATOMIC_RELEASE, "agent");
            asm volatile("s_waitcnt vmcnt(0)" ::: "memory");
            const unsigned og = xb_add(&bar[XB_TOP], 1u);
            const unsigned tg = og / nx;
            if (og + 1u == (tg + 1u) * nx) xb_add(&bar[XB_TOPGEN], 1u);
            else XB_SPIN(xb_ld(&bar[XB_TOPGEN]) == tg, bar);
            __builtin_amdgcn_fence(__ATOMIC_ACQUIRE, "agent");
            xb_add(&bar[XB_XGEN(b.x)], 1u);
            asm volatile("s_waitcnt vmcnt(0)" ::: "memory");
        } else {
            XB_SPIN(xb_ld(&bar[XB_XGEN(b.x)]) == gen, bar);
            __builtin_amdgcn_fence(__ATOMIC_ACQUIRE, "agent");
            asm volatile("s_waitcnt vmcnt(0)" ::: "memory");
        }
    }
    __syncthreads();
}

constexpr int NWAVES = 8;
struct Frame {
    LAS unsigned char* lds; volatile LAS unsigned* MISC; gu32* ctl;
    int tid, lane, wave, vcu, G;
    unsigned char* ws; unsigned char* dout;
};
__device__ __forceinline__ float wave_sum(float v) {
#pragma unroll
    for (int o = 1; o < 64; o <<= 1) v += __shfl_xor(v, o);
    return v;
}
__device__ __forceinline__ void transpose_item(const float* W, int N, int k0, int n0, bf16_t* WT, int ldw, size_t drow0, int dcol0, LAS float* scr, int lane) {
#pragma unroll 8
    for (int i = 0; i < 32; ++i) { const int kk = 2 * i + (lane >> 5); scr[kk * 33 + (lane & 31)] = W[(size_t)(k0 + kk) * N + n0 + (lane & 31)]; }
    LDS_WAIT(); asm volatile("" ::: "memory");
    const int c = lane & 7;
#pragma unroll
    for (int j = 0; j < 4; ++j) { const int n = (lane >> 3) + 8 * j; const LAS float* s = scr + (8 * c) * 33 + n;
        u32x4 o; o.x = cvt_pk_bf16(s[0 * 33], s[1 * 33]); o.y = cvt_pk_bf16(s[2 * 33], s[3 * 33]); o.z = cvt_pk_bf16(s[4 * 33], s[5 * 33]); o.w = cvt_pk_bf16(s[6 * 33], s[7 * 33]);
        *(GAS u32x4*)(WT + (drow0 + n) * (size_t)ldw + dcol0 + 8 * c) = o; }
    LDS_WAIT(); asm volatile("" ::: "memory");
}
__device__ __forceinline__ void transpose_item_f8(const float* W, int N, int k0, int n0, unsigned char* WT, int ldw, size_t drow0, int dcol0, LAS float* scr, int lane);
__device__ __forceinline__ void p0_convert(Frame& F, const float* x, const float* w_in, const float* w_pa, const float* w_pb, const float* w_out, const float* rw) {
    LAS float* scr = (LAS float*)(F.lds + F.wave * 17408);
    const int gw = F.vcu * NWAVES + F.wave, NGW = F.G * NWAVES;
    unsigned char* WIN = F.dout + DO_WIN; unsigned char* WCAT = F.dout + DO_WCAT; unsigned char* WOUT = F.ws + WS_WOUT;
    constexpr int I_IN = (D / 128) * (IN_COLS / 32), I_OUT = (D / 128) * (D / 32), I_PA = (256 / 128) * (D / 32), I_PB = (D / 128) * (D / 32);
    for (int it = gw; it < I_IN + I_OUT + I_PA + I_PB; it += NGW) {
        int r = it;
        if (r < I_IN) { const int nb = IN_COLS / 32; transpose_item_f8(w_in, IN_COLS, 128 * (r / nb), 32 * (r % nb), WIN, D, (size_t)(32 * (r % nb)), 128 * (r / nb), scr, F.lane); continue; } r -= I_IN;
        if (r < I_OUT) { const int nb = D / 32; transpose_item_f8(w_out, D, 128 * (r / nb), 32 * (r % nb), WOUT, D, (size_t)(32 * (r % nb)), 128 * (r / nb), scr, F.lane); continue; } r -= I_OUT;
        if (r < I_PA) { const int nb = D / 32; transpose_item_f8(w_pa, D, 128 * (r / nb), 32 * (r % nb), WCAT, OAB_P, (size_t)(32 * (r % nb)), 128 * (r / nb), scr, F.lane); continue; } r -= I_PA;
        { const int nb = D / 32; transpose_item_f8(w_pb, D, 128 * (r / nb), 32 * (r % nb), WCAT, OAB_P, (size_t)(32 * (r % nb)), 256 + 128 * (r / nb), scr, F.lane); }
    }
    { bf16_t* WRT = (bf16_t*)(F.ws + WS_WRT);
      for (int i = gw * 64 + F.lane; i < NEXP * D; i += NGW * 64) { const int e = i >> 10, k = i & (D - 1); const float w = rw[k * NEXP + e];
          const unsigned hi = cvt_pk_bf16(w, 0.f) & 0xffffu; const float r = w - __uint_as_float(hi << 16);
          WRT[i] = (bf16_t)hi; WRT[NEXP * D + i] = (bf16_t)(cvt_pk_bf16(r, 0.f) & 0xffffu); } }
    unsigned char* XQ = F.dout + DO_XB;
    const size_t n16 = (size_t)NTOK * D / 16;
    for (size_t i = (size_t)gw * 64 + F.lane; i < n16; i += (size_t)NGW * 64) {
        const f32x4 a = *(const GAS f32x4*)(x + i * 16), b = *(const GAS f32x4*)(x + i * 16 + 4), c = *(const GAS f32x4*)(x + i * 16 + 8), d = *(const GAS f32x4*)(x + i * 16 + 12);
        u32x4 o;
        o.x = pk4_fp8(clamp_fp8(a[0] * SXIN), clamp_fp8(a[1] * SXIN), clamp_fp8(a[2] * SXIN), clamp_fp8(a[3] * SXIN)); o.y = pk4_fp8(clamp_fp8(b[0] * SXIN), clamp_fp8(b[1] * SXIN), clamp_fp8(b[2] * SXIN), clamp_fp8(b[3] * SXIN));
        o.z = pk4_fp8(clamp_fp8(c[0] * SXIN), clamp_fp8(c[1] * SXIN), clamp_fp8(c[2] * SXIN), clamp_fp8(c[3] * SXIN)); o.w = pk4_fp8(clamp_fp8(d[0] * SXIN), clamp_fp8(d[1] * SXIN), clamp_fp8(d[2] * SXIN), clamp_fp8(d[3] * SXIN));
        *(GAS u32x4*)(XQ + i * 16) = o;
    }
}
__device__ __forceinline__ void transpose_item_f8(const float* W, int N, int k0, int n0, unsigned char* WT, int ldw, size_t drow0, int dcol0, LAS float* scr, int lane) {
    f32x4 wv[16];
#pragma unroll
    for (int i = 0; i < 16; ++i) wv[i] = *(const GAS f32x4*)(W + (size_t)(k0 + 8 * i + (lane >> 3)) * N + n0 + (lane & 7) * 4);
#pragma unroll
    for (int i = 0; i < 16; ++i) { LAS float* d = scr + (8 * i + (lane >> 3)) * 33 + (lane & 7) * 4; d[0] = wv[i][0]; d[1] = wv[i][1]; d[2] = wv[i][2]; d[3] = wv[i][3]; }
    LDS_WAIT(); asm volatile("" ::: "memory");
    const int c = lane & 7;
#pragma unroll
    for (int j = 0; j < 4; ++j) { const int n = (lane >> 3) + 8 * j; const LAS float* s = scr + (16 * c) * 33 + n;
        u32x4 o;
        o.x = pk4_fp8(clamp_fp8(s[0 * 33] * SW), clamp_fp8(s[1 * 33] * SW), clamp_fp8(s[2 * 33] * SW), clamp_fp8(s[3 * 33] * SW));
        o.y = pk4_fp8(clamp_fp8(s[4 * 33] * SW), clamp_fp8(s[5 * 33] * SW), clamp_fp8(s[6 * 33] * SW), clamp_fp8(s[7 * 33] * SW));
        o.z = pk4_fp8(clamp_fp8(s[8 * 33] * SW), clamp_fp8(s[9 * 33] * SW), clamp_fp8(s[10 * 33] * SW), clamp_fp8(s[11 * 33] * SW));
        o.w = pk4_fp8(clamp_fp8(s[12 * 33] * SW), clamp_fp8(s[13 * 33] * SW), clamp_fp8(s[14 * 33] * SW), clamp_fp8(s[15 * 33] * SW));
        *(GAS u32x4*)(WT + (drow0 + n) * (size_t)ldw + dcol0 + 16 * c) = o; }
    LDS_WAIT(); asm volatile("" ::: "memory");
}
__device__ __forceinline__ void p3_convert_moe(Frame& F, const float* w_gate, const float* w_up, const float* w_down, int wg, int nwg) {
    LAS float* scr = (LAS float*)(F.lds + F.wave * 17408);
    const int gw = wg * NWAVES + F.wave, NGW = nwg * NWAVES;
    unsigned char* WGU = F.ws + WS_WGU; unsigned char* WD = F.ws + WS_WD;
    constexpr int IPM = (D / 128) * (DFF / 32);
    for (int it = gw; it < NEXP * 3 * IPM; it += NGW) {
        const int e = it / (3 * IPM), r3 = it % (3 * IPM), which = r3 / IPM, r = r3 % IPM, kb = r / 32, nb = r % 32, k0 = 128 * kb, n0 = 32 * nb;
        const size_t moff = (size_t)e * D * DFF;
        if (which == 2) transpose_item_f8(w_down + moff, D, k0, n0, WD + moff, DFF, (size_t)n0, k0, scr, F.lane);
        else { const int pn = n0 >> 7, jj = n0 & 127; transpose_item_f8((which ? w_up : w_gate) + moff, DFF, k0, n0, WGU + 2 * moff, D, (size_t)(256 * pn + 128 * which + jj), k0, scr, F.lane); }
    }
}
typedef short v4i16_t __attribute__((ext_vector_type(4)));
__device__ __forceinline__ s16x4 tr_read(const LAS unsigned char* p) { return __builtin_bit_cast(s16x4, __builtin_amdgcn_ds_read_tr16_b64_v4i16((LAS v4i16_t*)p)); }
template <int C>
__device__ __forceinline__ void tr_read8(s16x4 (&r)[8], unsigned addr) {
#define TRR(i) asm volatile("ds_read_b64_tr_b16 %0, %1 offset:%2" : "=v"(r[i]) : "v"(addr), "n"(C * 4096 + (i) * 512))
    TRR(0); TRR(1); TRR(2); TRR(3); TRR(4); TRR(5); TRR(6); TRR(7);
#undef TRR
}
__device__ __forceinline__ void tr_wait8(s16x4 (&r)[8]) {
    asm volatile("s_waitcnt lgkmcnt(0)" : "+v"(r[0]), "+v"(r[1]), "+v"(r[2]), "+v"(r[3]), "+v"(r[4]), "+v"(r[5]), "+v"(r[6]), "+v"(r[7]));
}
template <int C>
__device__ __forceinline__ void pv_tile(s16x4 (&cur)[8], s16x4 (&prev)[8], bf16x8 (&pf)[2], bf16x8 (&pfprev)[2], unsigned vbase, const f32x16& Sc, f32x16 (&O)[2]) {
#pragma unroll
    for (int s = 0; s < 2; ++s) { u32x4 w; w.x = cvt_pk_bf16(Sc[8 * s + 0], Sc[8 * s + 1]); w.y = cvt_pk_bf16(Sc[8 * s + 2], Sc[8 * s + 3]);
        w.z = cvt_pk_bf16(Sc[8 * s + 4], Sc[8 * s + 5]); w.w = cvt_pk_bf16(Sc[8 * s + 6], Sc[8 * s + 7]); pf[s] = __builtin_bit_cast(bf16x8, w); }
    tr_read8<C>(cur, vbase);
    if (C > 0) { asm volatile("" :: "v"(prev[0]), "v"(prev[1]), "v"(prev[2]), "v"(prev[3]), "v"(prev[4]), "v"(prev[5]), "v"(prev[6]), "v"(prev[7]) : "memory");
                 asm volatile("" :: "v"(pfprev[0]), "v"(pfprev[1]) : "memory"); }
    tr_wait8(cur);
    __builtin_amdgcn_sched_barrier(0);
#pragma unroll
    for (int blk = 0; blk < 2; ++blk)
#pragma unroll
        for (int s = 0; s < 2; ++s) { const s16x4 lo = cur[(blk * 2 + s) * 2], hi = cur[(blk * 2 + s) * 2 + 1];
            O[blk] = __builtin_amdgcn_mfma_f32_32x32x16_bf16((bf16x8){lo[0], lo[1], lo[2], lo[3], hi[0], hi[1], hi[2], hi[3]}, pf[s], O[blk], 0, 0, 0); }
    __builtin_amdgcn_sched_barrier(0);
}
constexpr int ATT_KOFF = 0, ATT_QOFF = 12 * 2048, ATT_VOFF = 12 * 4096, ATT_STG = 24 * 4096, ATT_STGW = 4608;
static_assert(ATT_STG + 8 * ATT_STGW <= SCR_BYTES, "attention LDS map");
struct AKV { const unsigned char* qseq; const unsigned char* kseq; const bf16_t* vseq; int jt0, nkt, jq; };
__device__ __forceinline__ AKV attn_kv(const Frame& F, int U) {
    const unsigned char* HQ = F.ws + WS_HQ; AKV r;
    if (U < 2048) {
        const int b = U >> 8, kvh = (U >> 7) & 1, j = U & 127, hq = kvh * 8 + F.wave;
        r.qseq = HQ + HQ_QS + (size_t)(b * 16 + hq) * SEQ * 64; r.kseq = HQ + HQ_KS + (size_t)(b * 2 + kvh) * SEQ * 64; r.vseq = (const bf16_t*)(HQ + HQ_VS) + (size_t)(b * 2 + kvh) * SEQ * 64;
        r.jt0 = j - 4; r.nkt = 5; r.jq = j;
    } else {
        const int v = U - 2048, g = v >> 9, w_ = v & 511, b = w_ >> 6, x = w_ & 63, hh = x >> 4, y = x & 15;
        const int dil = (g == 0) ? 1 : (g == 1) ? 4 : 16;
        const int res = (g == 0) ? 0 : (g == 1) ? (y >> 2) : y;
        const int j0 = (g == 0) ? y * 8 : (g == 1) ? (y & 3) * 8 : 0;
        const size_t seq = ((size_t)((g * NB + b) * 4 + hh) * SEQ + (size_t)res * (SEQ / dil)) * 64;
        r.qseq = HQ + HQ_QD + seq; r.kseq = HQ + HQ_KD + seq; r.vseq = (const bf16_t*)(HQ + HQ_VD) + seq;
        r.jt0 = j0 - 4; r.nkt = 12; r.jq = j0 + F.wave;
    }
    return r;
}
__device__ __forceinline__ unsigned attn_koff(int lane) { return (unsigned)((lane >> 2) * 64 + (((lane & 3) ^ ((lane >> 4) & 3)) * 16)); }
__device__ __forceinline__ unsigned attn_voff(int lane) { return (unsigned)((lane >> 2) * 128 + (lane & 3) * 16); }
__device__ __forceinline__ void attn_issue_k(LAS unsigned char* lds, int lane, int wave, const AKV& u) {
    const unsigned koff = attn_koff(lane);
    for (int p = wave; p < u.nkt * 2; p += 8) {
        const int s = p >> 1, qt = p & 1; const int tj = u.jt0 + s; const size_t pos0 = (size_t)(32 * (tj >= 0 ? tj : 0) + 16 * qt);
        __builtin_amdgcn_global_load_lds((const unsigned*)((const char*)u.kseq + pos0 * 64 + koff), (LAS unsigned*)(lds + ATT_KOFF + s * 2048 + qt * 1024), 16, 0, 0);
    }
}
__device__ __forceinline__ void attn_issue_q(LAS unsigned char* lds, int lane, int wave, const AKV& u) {
    const unsigned koff = attn_koff(lane);
#pragma unroll
    for (int qt = 0; qt < 2; ++qt)
        __builtin_amdgcn_global_load_lds((const unsigned*)((const char*)u.qseq + (size_t)(32 * u.jq + 16 * qt) * 64 + koff), (LAS unsigned*)(lds + ATT_QOFF + wave * 2048 + qt * 1024), 16, 0, 0);
}
template <int NKT>
__device__ __forceinline__ int attn_issue_v(LAS unsigned char* lds, int lane, int wave, const AKV& u) {
    const int w4 = (wave + 4) & 7;
    const unsigned voff = attn_voff(lane);
#pragma unroll
    for (int i = 0; i < (NKT * 4 + 7) / 8; ++i) { const int p = w4 + 8 * i;
        if (p < NKT * 4) { const int s = p >> 2, qt = p & 3; const int tj = u.jt0 + s; const int blk = qt >> 1, part = qt & 1;
            const size_t pos0 = (size_t)(32 * (tj >= 0 ? tj : 0) + 16 * part);
            __builtin_amdgcn_global_load_lds((const unsigned*)((const char*)u.vseq + pos0 * 128 + blk * 64 + voff), (LAS unsigned*)(lds + ATT_VOFF + s * 4096 + blk * 2048 + part * 1024), 16, 0, 0); } }
    return NKT == 12 ? 6 : (w4 < 4 ? 3 : 2);
}
__device__ __forceinline__ void attn_wait(int n) {
#define AW(N) asm volatile("s_waitcnt vmcnt(" #N ")" ::: "memory")
    if (n == 11) AW(11); else if (n == 8) AW(8); else if (n == 7) AW(7); else if (n == 6) AW(6); else if (n == 5) AW(5); else if (n == 4) AW(4); else if (n == 3) AW(3); else if (n == 2) AW(2); else AW(0);
#undef AW
}
template <bool swa>
__device__ __forceinline__ void attn_unit(LAS unsigned char* lds, int lane, int wave, const AKV& u, int s0,
                                          float sl2, float sink2, bf16_t* ob, unsigned op, float* lseb, unsigned lsep, bool hasn, const AKV& nx) {
    const int i32 = lane & 31, h = lane >> 5;
    const int jq = u.jq;
    constexpr float QKS = SQ * SK, RQK = 1.0f / (SQ * SK), NEG_RAW = -1.0e30f;
    f32x16 bias;
#pragma unroll
    for (int r = 0; r < 16; ++r) { const int kk = (r & 3) + 8 * (r >> 2) + 4 * h; bias[r] = sl2 * QKS * (float)(kk - i32); }
    __builtin_amdgcn_s_barrier();
    asm volatile("" ::: "memory");
    f32x16 S[5];
    float m2 = sink2;
    const int kro = i32 * 64 + h * 8, ksw = (i32 >> 2) & 3;
    long qf[4];
#pragma unroll
    for (int d0 = 0; d0 < 4; ++d0) qf[d0] = *(const LAS long*)(lds + ATT_QOFF + wave * 2048 + kro + ((d0 ^ ksw) * 16));
    long kf[2][4];
#pragma unroll
    for (int c = 0; c < 5; ++c) {
        const bool tv = (jq - 4 + c) >= 0;
        const LAS unsigned char* ks = lds + ATT_KOFF + (s0 + c) * 2048 + kro;
#pragma unroll
        for (int d0 = 0; d0 < 4; ++d0) kf[c & 1][d0] = *(const LAS long*)(ks + ((d0 ^ ksw) * 16));
        if (c > 0) asm volatile("" :: "v"(kf[(c - 1) & 1][0]), "v"(kf[(c - 1) & 1][1]), "v"(kf[(c - 1) & 1][2]), "v"(kf[(c - 1) & 1][3]) : "memory");
        f32x16 a = bias;
#pragma unroll
        for (int d0 = 0; d0 < 4; ++d0) a = __builtin_amdgcn_mfma_f32_32x32x16_fp8_fp8(kf[c & 1][d0], qf[d0], a, 0, 0, 0);
        if (c == 0 || c == 4) {
#pragma unroll
            for (int r = 0; r < 16; ++r) { const int kk = (r & 3) + 8 * (r >> 2) + 4 * h;
                const bool ok = (c == 4) ? (kk <= i32) : (swa ? (kk > i32) : (kk >= i32));
                a[r] = ok ? a[r] : NEG_RAW; }
        }
        float mt = fmaxf(fmaxf(a[0], a[1]), a[2]);
#pragma unroll
        for (int r = 3; r < 15; r += 2) mt = fmaxf(fmaxf(mt, a[r]), a[r + 1]);
        mt = fmaxf(mt, a[15]);
        m2 = fmaxf(m2, __builtin_fmaf(mt, RQK, tv ? -sl2 * (float)(32 * (4 - c)) : NEG_RAW));
        S[c] = a;
    }
    m2 = fmaxf(m2, __shfl_xor(m2, 32));
    float l = 0.f;
#pragma unroll
    for (int c = 0; c < 5; ++c) {
        const float offc = ((jq - 4 + c) >= 0 ? -sl2 * (float)(32 * (4 - c)) : NEG_RAW) - m2;
#pragma unroll
        for (int r = 0; r < 16; ++r) { const float p = __builtin_amdgcn_exp2f(__builtin_fmaf(S[c][r], RQK, offc)); S[c][r] = p; l += p; }
    }
    l += __shfl_xor(l, 32);
    l += __builtin_amdgcn_exp2f(sink2 - m2);
    asm volatile("" :: "v"(kf[0][0]), "v"(kf[0][1]), "v"(kf[0][2]), "v"(kf[0][3]), "v"(kf[1][0]), "v"(kf[1][1]), "v"(kf[1][2]), "v"(kf[1][3]) : "memory");
    asm volatile("s_waitcnt vmcnt(0) lgkmcnt(0)" : "+v"(l) :: "memory");
    __builtin_amdgcn_s_barrier();
    asm volatile("" ::: "memory");
    if (hasn) { attn_issue_k(lds, lane, wave, nx); attn_issue_q(lds, lane, wave, nx); }
    f32x16 O[2]; O[0] = (f32x16){}; O[1] = (f32x16){};
    const int vaddr0 = ((lane >> 4) & 1) * 32 + (lane & 3) * 8 + (4 * h + ((lane & 15) >> 2)) * 64;
    const unsigned vbase = (unsigned)(size_t)(lds + ATT_VOFF) + (unsigned)(s0 * 4096 + vaddr0);
    s16x4 va[2][8]; bf16x8 pf[2][2];
    pv_tile<0>(va[0], va[1], pf[0], pf[1], vbase, S[0], O); pv_tile<1>(va[1], va[0], pf[1], pf[0], vbase, S[1], O); pv_tile<2>(va[0], va[1], pf[0], pf[1], vbase, S[2], O);
    pv_tile<3>(va[1], va[0], pf[1], pf[0], vbase, S[3], O); pv_tile<4>(va[0], va[1], pf[0], pf[1], vbase, S[4], O);
    asm volatile("" :: "v"(pf[0][0]), "v"(pf[0][1]), "v"(pf[1][0]), "v"(pf[1][1]) : "memory");
    asm volatile("" :: "v"(va[0][0]), "v"(va[0][1]), "v"(va[0][2]), "v"(va[0][3]), "v"(va[0][4]), "v"(va[0][5]), "v"(va[0][6]), "v"(va[0][7]) : "memory");
    asm volatile("" :: "v"(va[1][0]), "v"(va[1][1]), "v"(va[1][2]), "v"(va[1][3]), "v"(va[1][4]), "v"(va[1][5]), "v"(va[1][6]), "v"(va[1][7]) : "memory");
    __builtin_amdgcn_s_barrier();
    asm volatile("" ::: "memory");
    int nv = 0;
    if (hasn) { if (nx.nkt == 12) nv = attn_issue_v<12>(lds, lane, wave, nx); else nv = attn_issue_v<5>(lds, lane, wave, nx); }
    const float inv = 1.0f / l;
    LAS unsigned char* stg = lds + ATT_STG + wave * ATT_STGW;
    if (swa) {
        const float is = inv * SO;
#pragma unroll
        for (int blk = 0; blk < 2; ++blk)
#pragma unroll
            for (int g4 = 0; g4 < 4; ++g4) { const int d0 = blk * 32 + 8 * g4 + 4 * h;
                *(LAS unsigned*)(stg + i32 * 80 + d0) = pk4_fp8_pad(clamp_fp8(O[blk][4 * g4 + 0] * is), clamp_fp8(O[blk][4 * g4 + 1] * is), clamp_fp8(O[blk][4 * g4 + 2] * is), clamp_fp8(O[blk][4 * g4 + 3] * is)); }
        asm volatile("s_waitcnt lgkmcnt(0)" ::: "memory");
#pragma unroll
        for (int it = 0; it < 2; ++it) { const int row = it * 16 + (lane >> 2), ch = lane & 3;
            const u32x4 v = *(const LAS u32x4*)(stg + row * 80 + ch * 16);
            *(u32x4*)((char*)ob + (size_t)(32 * jq + row) * op + ch * 16) = v; }
    } else {
#pragma unroll
        for (int blk = 0; blk < 2; ++blk)
#pragma unroll
            for (int g4 = 0; g4 < 4; ++g4) { const int d0 = blk * 32 + 8 * g4 + 4 * h;
                u32x2 w; w.x = cvt_pk_bf16(O[blk][4 * g4 + 0] * inv, O[blk][4 * g4 + 1] * inv); w.y = cvt_pk_bf16(O[blk][4 * g4 + 2] * inv, O[blk][4 * g4 + 3] * inv);
                *(LAS u32x2*)(stg + i32 * 144 + d0 * 2) = w; }
        asm volatile("s_waitcnt lgkmcnt(0)" ::: "memory");
#pragma unroll
        for (int it = 0; it < 4; ++it) { const int row = it * 8 + (lane >> 3), ch = lane & 7;
            const u32x4 v = *(const LAS u32x4*)(stg + row * 144 + ch * 16);
            *(u32x4*)((char*)ob + (size_t)(32 * jq + row) * op + ch * 16) = v; }
    }
    if (lseb != nullptr && h == 0) lseb[(size_t)(32 * jq + i32) * lsep] = (m2 + __builtin_amdgcn_logf(l)) * LN2;
    attn_wait(hasn ? nv + (swa ? 2 : 5) : 0);
}
__device__ __forceinline__ void p2_attention(Frame& F, const float* sinks) {
    unsigned char* OAB = F.dout + DO_OAB; bf16_t* OAG = (bf16_t*)(F.ws + WS_OAG); float* LSE = (float*)(F.ws + WS_LSE);
    constexpr int NUNIT = 2048 + 1536;
    int U = F.vcu; if (U >= NUNIT) return;
    float snk0 = sinks[F.wave] * LOG2E, snk1 = sinks[8 + F.wave] * LOG2E;
    asm volatile("" : "+v"(snk0), "+v"(snk1));
    AKV cur = attn_kv(F, U);
    attn_issue_k(F.lds, F.lane, F.wave, cur);
    attn_issue_q(F.lds, F.lane, F.wave, cur);
    { const int nv0 = (cur.nkt == 12) ? attn_issue_v<12>(F.lds, F.lane, F.wave, cur) : attn_issue_v<5>(F.lds, F.lane, F.wave, cur); attn_wait(nv0); }
    for (;;) {
        const int Un = U + F.G; const bool hasn = Un < NUNIT;
        const AKV nxt = attn_kv(F, hasn ? Un : U);
        if (U < 2048) {
            const int b = U >> 8, kvh = (U >> 7) & 1, hq = kvh * 8 + F.wave;
            const float slope = exp2f(-8.0f * (float)(hq + 1) / 28.0f);
            attn_unit<true>(F.lds, F.lane, F.wave, cur, 0, slope * LOG2E, kvh ? snk1 : snk0, (bf16_t*)(OAB + (size_t)b * SEQ * OAB_P + 256 + hq * 64), OAB_P, nullptr, 0, hasn, nxt);
        } else {
            const int v = U - 2048, g = v >> 9, w_ = v & 511, b = w_ >> 6, x = w_ & 63, hh = x >> 4, y = x & 15;
            const int dil = (g == 0) ? 1 : (g == 1) ? 4 : 16;
            const int res = (g == 0) ? 0 : (g == 1) ? (y >> 2) : y;
            const size_t tok0 = (size_t)b * SEQ + res;
            const float slope = exp2f(-8.0f * (float)(16 + g * 4 + hh + 1) / 28.0f);
            attn_unit<false>(F.lds, F.lane, F.wave, cur, F.wave, slope * (float)dil * LOG2E, NEG_BIG,
                             OAG + ((size_t)g * NTOK + tok0) * 256 + hh * 64, (unsigned)(dil * 256 * 2), LSE + ((size_t)g * NTOK + tok0) * 4 + hh, (unsigned)(dil * 4), hasn, nxt);
        }
        if (!hasn) break;
        U = Un; cur = nxt;
    }
}
__device__ __forceinline__ void p3_merge(Frame& F) {
    const bf16_t* OAG = (const bf16_t*)(F.ws + WS_OAG); const float* LSE = (const float*)(F.ws + WS_LSE); unsigned char* OAB = F.dout + DO_OAB;
    const int gw = F.vcu * NWAVES + F.wave, NGW = F.G * NWAVES;
    for (int idx = gw; idx < NTOK / 2; idx += NGW) {
        const int tok = idx * 2 + (F.lane >> 5), c8 = F.lane & 31, hh = c8 >> 3;
        float ls[3]; u32x4 o[3];
#pragma unroll
        for (int g = 0; g < 3; ++g) { ls[g] = LSE[((size_t)g * NTOK + tok) * 4 + hh]; o[g] = *(const u32x4*)(OAG + ((size_t)g * NTOK + tok) * 256 + c8 * 8); }
        const float m = fmaxf(fmaxf(ls[0], ls[1]), ls[2]);
        float w[3]; float sum = 0.f;
#pragma unroll
        for (int g = 0; g < 3; ++g) { w[g] = __builtin_amdgcn_exp2f((ls[g] - m) * LOG2E); sum += w[g]; }
        const float is = 1.0f / sum; float r[8];
#pragma unroll
        for (int q = 0; q < 8; ++q) r[q] = 0.f;
#pragma unroll
        for (int g = 0; g < 3; ++g) { const float wg = w[g] * is;
            r[0] += wg * bf_lo(o[g].x); r[1] += wg * bf_hi(o[g].x); r[2] += wg * bf_lo(o[g].y); r[3] += wg * bf_hi(o[g].y);
            r[4] += wg * bf_lo(o[g].z); r[5] += wg * bf_hi(o[g].z); r[6] += wg * bf_lo(o[g].w); r[7] += wg * bf_hi(o[g].w); }
        u32x2 out; out.x = pk4_fp8(clamp_fp8(r[0] * SO), clamp_fp8(r[1] * SO), clamp_fp8(r[2] * SO), clamp_fp8(r[3] * SO)); out.y = pk4_fp8(clamp_fp8(r[4] * SO), clamp_fp8(r[5] * SO), clamp_fp8(r[6] * SO), clamp_fp8(r[7] * SO));
        *(u32x2*)(OAB + (size_t)tok * OAB_P + c8 * 8) = out;
    }
}

__device__ __forceinline__ void p6_router(Frame& F, const bf16_t* y, const float* stat, const float* gam, const float* bet, bf16_t* x1b, unsigned char* x1q, const float* rb, int cw_ecnt, size_t pe_off) {
    constexpr int WPITCH = 2064;
    constexpr int WIMG = 64 * WPITCH;
    constexpr int GOFF = WIMG + 2048;
    static_assert(GOFF + 8192 <= SCR_BYTES, "router LDS map");
    LAS int* wcnt = (LAS int*)(F.lds + WIMG + F.wave * 256); LAS int* wbase = wcnt + 32;
    int* petok = (int*)(F.ws + WS_PETOK + pe_off); float* pegate = (float*)(F.ws + WS_PEGATE + pe_off);
    const bf16_t* WRT = (const bf16_t*)(F.ws + WS_WRT);
    const int gw = F.vcu * NWAVES + F.wave, NGW = F.G * NWAVES, lane = F.lane, j = lane & 15, kq = lane >> 4;
    __syncthreads();
    for (int q = F.tid; q < 64 * 128; q += NWAVES * 64) { const u32x4 v = *(const u32x4*)((const char*)WRT + (size_t)q * 16); *(LAS u32x4*)(F.lds + (q >> 7) * WPITCH + (q & 127) * 16) = v; }
    for (int q = F.tid; q < 512; q += NWAVES * 64) { const f32x4 v = (q < 256) ? *(const f32x4*)(gam + q * 4) : *(const f32x4*)(bet + (q - 256) * 4); *(LAS f32x4*)(F.lds + GOFF + q * 16) = v; }
    __syncthreads();
    const LAS unsigned char* wrow = F.lds + j * WPITCH + kq * 16;
    const LAS float* gl = (const LAS float*)(F.lds + GOFF) + 8 * kq; const LAS float* bl = gl + 1024;
    for (int tb = F.vcu * NWAVES; tb < NTOK / 16; tb += NGW) {
        const int tt = tb + F.wave; const bool valid = tt < NTOK / 16; const int t0 = (valid ? tt : 0) * 16;
        float mean, rstd;
        { const f32x4* sp = (const f32x4*)(stat + (size_t)(t0 + j) * 32); float s1 = 0.f, s2 = 0.f;
#pragma unroll
          for (int q = 0; q < 8; ++q) { const f32x4 v = sp[q]; s1 += v[0] + v[2]; s2 += v[1] + v[3]; }
          mean = s1 * (1.0f / D); const float var = fmaxf(s2 * (1.0f / D) - mean * mean, 0.f); rstd = 1.0f / sqrtf(var + LN_EPS); }
        f32x4 acc[2]; acc[0] = (f32x4){0.f, 0.f, 0.f, 0.f}; acc[1] = acc[0];
        const bf16_t* yrow = y + (size_t)(t0 + j) * D + 8 * kq;
        bf16_t* xbrow = (valid ? x1b : (bf16_t*)(F.ws + 300 * MiB)) + (size_t)(t0 + j) * D + 8 * kq; unsigned char* xqrow = (valid ? x1q : F.ws + 300 * MiB) + (size_t)(t0 + j) * D + 8 * kq;
        bf16x8 wf[2][4]; wf[1][0] = (bf16x8){}; wf[1][1] = wf[1][0]; wf[1][2] = wf[1][0]; wf[1][3] = wf[1][0];
        u32x4 yv[4], yn[4];
#pragma unroll
        for (int u = 0; u < 4; ++u) yv[u] = *(const u32x4*)(yrow + 32 * u);
#pragma unroll 1
        for (int so = 0; so < D / 32; so += 4) {
            const int sn = (so + 4 < D / 32) ? so + 4 : so;
#pragma unroll
            for (int u = 0; u < 4; ++u) yn[u] = *(const u32x4*)(yrow + 32 * (sn + u));
#pragma unroll
            for (int u = 0; u < 4; ++u) { const int sI = so + u;
                wf[u & 1][0] = *(const LAS bf16x8*)(wrow + 64 * sI); wf[u & 1][1] = *(const LAS bf16x8*)(wrow + 16 * WPITCH + 64 * sI);
                wf[u & 1][2] = *(const LAS bf16x8*)(wrow + 32 * WPITCH + 64 * sI); wf[u & 1][3] = *(const LAS bf16x8*)(wrow + 48 * WPITCH + 64 * sI);
                const f32x4 g0 = *(const LAS f32x4*)(gl + 32 * sI), g1 = *(const LAS f32x4*)(gl + 32 * sI + 4), b0 = *(const LAS f32x4*)(bl + 32 * sI), b1 = *(const LAS f32x4*)(bl + 32 * sI + 4);
                asm volatile("" :: "v"(wf[(u + 1) & 1][0]), "v"(wf[(u + 1) & 1][1]), "v"(wf[(u + 1) & 1][2]), "v"(wf[(u + 1) & 1][3]) : "memory");
                f32x4 n0, n1;
                n0[0] = (bf_lo(yv[u].x) - mean) * rstd * g0[0] + b0[0]; n0[1] = (bf_hi(yv[u].x) - mean) * rstd * g0[1] + b0[1]; n0[2] = (bf_lo(yv[u].y) - mean) * rstd * g0[2] + b0[2]; n0[3] = (bf_hi(yv[u].y) - mean) * rstd * g0[3] + b0[3];
                n1[0] = (bf_lo(yv[u].z) - mean) * rstd * g1[0] + b1[0]; n1[1] = (bf_hi(yv[u].z) - mean) * rstd * g1[1] + b1[1]; n1[2] = (bf_lo(yv[u].w) - mean) * rstd * g1[2] + b1[2]; n1[3] = (bf_hi(yv[u].w) - mean) * rstd * g1[3] + b1[3];
                u32x4 xw; xw.x = cvt_pk_bf16(n0[0], n0[1]); xw.y = cvt_pk_bf16(n0[2], n0[3]); xw.z = cvt_pk_bf16(n1[0], n1[1]); xw.w = cvt_pk_bf16(n1[2], n1[3]);
                *(u32x4*)(xbrow + 32 * sI) = xw;
                { u32x2 q8; q8.x = pk4_fp8(clamp_fp8(n0[0] * SX), clamp_fp8(n0[1] * SX), clamp_fp8(n0[2] * SX), clamp_fp8(n0[3] * SX)); q8.y = pk4_fp8(clamp_fp8(n1[0] * SX), clamp_fp8(n1[1] * SX), clamp_fp8(n1[2] * SX), clamp_fp8(n1[3] * SX));
                  *(u32x2*)(xqrow + 32 * sI) = q8; }
                const bf16x8 xh = __builtin_bit_cast(bf16x8, xw);
                acc[0] = __builtin_amdgcn_mfma_f32_16x16x32_bf16(wf[u & 1][0], xh, acc[0], 0, 0, 0); acc[1] = __builtin_amdgcn_mfma_f32_16x16x32_bf16(wf[u & 1][1], xh, acc[1], 0, 0, 0);
                acc[0] = __builtin_amdgcn_mfma_f32_16x16x32_bf16(wf[u & 1][2], xh, acc[0], 0, 0, 0); acc[1] = __builtin_amdgcn_mfma_f32_16x16x32_bf16(wf[u & 1][3], xh, acc[1], 0, 0, 0); }
#pragma unroll
            for (int u = 0; u < 4; ++u) yv[u] = yn[u];
        }
        float lg[8];
#pragma unroll
        for (int q = 0; q < 8; ++q) lg[q] = acc[q >> 2][q & 3] + rb[16 * (q >> 2) + 4 * kq + (q & 3)];
        unsigned taken = 0u; float tv[4]; int ti[4];
#pragma unroll
        for (int k = 0; k < 4; ++k) {
            float bv = -3.0e38f; int bi = 64;
#pragma unroll
            for (int q = 0; q < 8; ++q) { const bool free_ = ((taken >> q) & 1u) == 0u; if (free_ && lg[q] > bv) { bv = lg[q]; bi = 16 * (q >> 2) + 4 * kq + (q & 3); } }
            const int mybi = bi;
#pragma unroll
            for (int o = 16; o < 64; o <<= 1) { const float ov = __shfl_xor(bv, o); const int oi = __shfl_xor(bi, o); const bool keep = (bv > ov) || (bv == ov && bi < oi); bv = keep ? bv : ov; bi = keep ? bi : oi; }
            tv[k] = bv; ti[k] = bi;
            if (bi == mybi && ((bi >> 2) & 3) == kq) taken |= 1u << (4 * (bi >> 4) + (bi & 3));
        }
        float gk[4]; float gs = 0.f;
#pragma unroll
        for (int k = 0; k < 4; ++k) { gk[k] = __builtin_amdgcn_exp2f((tv[k] - tv[0]) * LOG2E); gs += gk[k]; }
        const float gi = 1.0f / gs;
        if (lane < 32) wcnt[lane] = 0;
        asm volatile("s_waitcnt lgkmcnt(0)" ::: "memory");
        const int e0 = (kq == 0) ? ti[0] : (kq == 1) ? ti[1] : (kq == 2) ? ti[2] : ti[3];
        const float g0 = ((kq == 0) ? gk[0] : (kq == 1) ? gk[1] : (kq == 2) ? gk[2] : gk[3]) * gi;
        int r0 = 0;
        if (valid) r0 = __hip_atomic_fetch_add(wcnt + e0, 1, __ATOMIC_RELAXED, __HIP_MEMORY_SCOPE_WORKGROUP);
        asm volatile("s_waitcnt lgkmcnt(0)" ::: "memory");
        __syncthreads();
        if (F.wave == 0 && lane < 32) { int c[NWAVES]; int tot = 0;
#pragma unroll
            for (int w = 0; w < NWAVES; ++w) { c[w] = *(LAS int*)(F.lds + WIMG + w * 256 + 4 * lane); tot += c[w]; }
            int b = 0; if (tot > 0) b = (int)__hip_atomic_fetch_add((unsigned*)(F.ctl + cw_ecnt + 64 * lane), (unsigned)tot, RLX_AGENT);
#pragma unroll
            for (int w = 0; w < NWAVES; ++w) { *(LAS int*)(F.lds + WIMG + w * 256 + 128 + 4 * lane) = b; b += c[w]; } }
        asm volatile("s_waitcnt vmcnt(0) lgkmcnt(0)" ::: "memory");
        __syncthreads();
        if (valid) { const int p0 = wbase[e0] + r0;
            petok[(size_t)e0 * NTOK + p0] = (t0 + j) * 4 + kq; pegate[(size_t)e0 * NTOK + p0] = g0; }
        asm volatile("s_waitcnt lgkmcnt(0)" ::: "memory");
        __syncthreads();
    }
}
__device__ __forceinline__ int moe_tables(Frame& F) {
    LAS int* cnt = (LAS int*)(F.lds + MOE_OFF); LAS int* fs = (LAS int*)(F.lds + MOE_OFF + 128); LAS unsigned char* te = F.lds + MOE_OFF + 128 + 136;
    __syncthreads();
    if (F.tid < NEXP) cnt[F.tid] = (int)__hip_atomic_load(F.ctl + CW_ECNT + 64 * F.tid, RLX_AGENT);
    __syncthreads();
    if (F.tid == 0) { int s = 0; for (int e = 0; e < NEXP; ++e) { fs[e] = s; s += (cnt[e] + 255) >> 8; } fs[NEXP] = s; }
    __syncthreads();
    const int T = fs[NEXP];
    for (int t = F.tid; t < T; t += NWAVES * 64) { int e = 0;
#pragma unroll 8
        for (int q = 1; q < NEXP; ++q) e += (fs[q] <= t) ? 1 : 0;
        te[t] = (unsigned char)e; }
    __syncthreads();
    return T;
}
__device__ __forceinline__ void p9_final(Frame& F, const float* gam, const float* bet, const float* out, float* outw, bool poison) {
    const bf16_t* X1B = (const bf16_t*)(F.ws + WS_X1B);
    const int gw = F.vcu * NWAVES + F.wave, NGW = F.G * NWAVES, lane = F.lane;
    const float qnan = __builtin_nanf("");
    const f32x4 g0 = *(const f32x4*)(gam + lane * 16), g1 = *(const f32x4*)(gam + lane * 16 + 4), g2 = *(const f32x4*)(gam + lane * 16 + 8), g3 = *(const f32x4*)(gam + lane * 16 + 12);
    const f32x4 b0 = *(const f32x4*)(bet + lane * 16), b1 = *(const f32x4*)(bet + lane * 16 + 4), b2 = *(const f32x4*)(bet + lane * 16 + 8), b3 = *(const f32x4*)(bet + lane * 16 + 12);
    for (int tok0 = gw; tok0 < NTOK; tok0 += 2 * NGW) {
        u32x4 xa[2], xb[2], y0[2], y1[2], y2[2], y3[2];
#pragma unroll
        for (int tI = 0; tI < 2; ++tI) { const int tok = min(tok0 + tI * NGW, NTOK - 1);
            const unsigned char* y = (const unsigned char*)out + (size_t)tok * 4096 + lane * 16;
            xa[tI] = *(const u32x4*)(X1B + (size_t)tok * D + lane * 16); xb[tI] = *(const u32x4*)(X1B + (size_t)tok * D + lane * 16 + 8);
            y0[tI] = *(const u32x4*)(y); y1[tI] = *(const u32x4*)(y + 1024); y2[tI] = *(const u32x4*)(y + 2048); y3[tI] = *(const u32x4*)(y + 3072); }
#pragma unroll
        for (int tI = 0; tI < 2; ++tI) { const int tok = tok0 + tI * NGW; if (tok >= NTOK) break;
            float v[16];
#pragma unroll
            for (int w = 0; w < 4; ++w) { const unsigned xw = (w < 2) ? xa[tI][2 * w] : xb[tI][2 * (w - 2)], xw2 = (w < 2) ? xa[tI][2 * w + 1] : xb[tI][2 * (w - 2) + 1];
                v[4 * w + 0] = DN_ALPHA * bf_lo(xw); v[4 * w + 1] = DN_ALPHA * bf_hi(xw); v[4 * w + 2] = DN_ALPHA * bf_lo(xw2); v[4 * w + 3] = DN_ALPHA * bf_hi(xw2);
                f32x2 lo = __builtin_amdgcn_cvt_pk_f32_fp8((int)y0[tI][w], false) + __builtin_amdgcn_cvt_pk_f32_fp8((int)y1[tI][w], false) + __builtin_amdgcn_cvt_pk_f32_fp8((int)y2[tI][w], false) + __builtin_amdgcn_cvt_pk_f32_fp8((int)y3[tI][w], false);
                f32x2 hi = __builtin_amdgcn_cvt_pk_f32_fp8((int)y0[tI][w], true) + __builtin_amdgcn_cvt_pk_f32_fp8((int)y1[tI][w], true) + __builtin_amdgcn_cvt_pk_f32_fp8((int)y2[tI][w], true) + __builtin_amdgcn_cvt_pk_f32_fp8((int)y3[tI][w], true);
                v[4 * w + 0] += lo[0] * (1.0f / SY); v[4 * w + 1] += lo[1] * (1.0f / SY); v[4 * w + 2] += hi[0] * (1.0f / SY); v[4 * w + 3] += hi[1] * (1.0f / SY); }
            float s = 0.f;
#pragma unroll
            for (int q = 0; q < 16; ++q) s += v[q];
            const float mean = wave_sum(s) * (1.0f / D); float s2 = 0.f;
#pragma unroll
            for (int q = 0; q < 16; ++q) { v[q] -= mean; s2 += v[q] * v[q]; }
            const float rstd = 1.0f / sqrtf(wave_sum(s2) * (1.0f / D) + LN_EPS);
            f32x4 o0, o1, o2, o3;
#pragma unroll
            for (int q = 0; q < 4; ++q) { o0[q] = v[q] * rstd * g0[q] + b0[q]; o1[q] = v[4 + q] * rstd * g1[q] + b1[q]; o2[q] = v[8 + q] * rstd * g2[q] + b2[q]; o3[q] = v[12 + q] * rstd * g3[q] + b3[q]; }
            if (poison) { o0 = (f32x4){qnan, qnan, qnan, qnan}; o1 = o0; o2 = o0; o3 = o0; }
            float* op = outw + (size_t)tok * D + lane * 16;
            *(f32x4*)(op) = o0; *(f32x4*)(op + 4) = o1; *(f32x4*)(op + 8) = o2; *(f32x4*)(op + 12) = o3; }
    }
}
#define CAS __attribute__((address_space(4)))
__device__ __forceinline__ const float* arg_in(int i) {
    const unsigned char CAS* ka = (const unsigned char CAS*)__builtin_amdgcn_kernarg_segment_ptr();
    asm volatile("" : "+s"(ka));
    return *(const float* const CAS*)(ka + 8 * i);
}
struct Args { const float* in[18]; float* out; unsigned char* ws; int ph_lo, ph_hi; };
__global__ void __launch_bounds__(NWAVES * 64, 2) fwd_kernel(Args args) {
    extern __shared__ __attribute__((aligned(16))) unsigned char lds[];
    Frame F;
    F.lds = (LAS unsigned char*)lds;
    F.MISC = (volatile LAS unsigned*)(F.lds + MISC_OFF);
    F.tid = threadIdx.x; F.lane = F.tid & 63; F.wave = __builtin_amdgcn_readfirstlane(F.tid >> 6);
    F.G = gridDim.x; { const int bx = blockIdx.x; F.vcu = (F.G % 8 == 0) ? (bx % 8) * (F.G / 8) + bx / 8 : bx; }
    F.ws = args.ws; F.dout = (unsigned char*)args.out;
    F.ctl = (gu32*)(args.ws + WS_CTL);
    for (int u = F.tid; u < (LDS_BYTES - LDSCTL_OFF) / 4; u += NWAVES * 64) ((LAS unsigned*)(F.lds + LDSCTL_OFF))[u] = 0u;
    __syncthreads();
    XcdBarrier bar; bar.bar = (unsigned*)(F.ctl + CW_BAR); bar.x = 0; bar.st = nullptr;
    if (N_LAUNCHES == 1) bar = xcd_barrier_post((unsigned*)(F.ctl + CW_BAR), F.MISC + 8);
    const int lo = args.ph_lo, hi = args.ph_hi;
#ifdef ONLY_PHASE
#define IN(k) ((k) == ONLY_PHASE && lo <= (k) && (k) < hi)
#else
#define IN(k) (lo <= (k) && (k) < hi)
#endif
#define SEAM(k) do { if (IN(k) && IN((k) + 1)) xcd_barrier(bar); } while (0)
    unsigned char* HQ = F.ws + WS_HQ; unsigned char* SG = F.ws + WS_SG;

#define PHASE(k, ...) do { if (IN(k)) { __VA_ARGS__ if (DUP_PHASE == (k)) { __VA_ARGS__ } } } while (0)
    PHASE(0, p0_convert(F, arg_in(0), arg_in(1), arg_in(3), arg_in(4), arg_in(5), arg_in(8));); SEAM(0);
    PHASE(1,
        { const int gemm_wgs = (F.G == 256) ? 192 : F.G;
          if ((int)blockIdx.x < gemm_wgs) {
            pg8::Gemm g{(const char*)(F.dout + DO_XB), (const char*)(F.dout + DO_WIN), D, D, D / 128}; pg8::StaticOrder S; S.init(NTOK, IN_COLS, gemm_wgs, (int)blockIdx.x);
            pg8::EpiInProj E{HQ, SG, 1.0f / (SXIN * SW)};
            pg8::gemm_phase<pg8::EpiInProj, pg8::StaticOrder, true, false, true>(F.lds, g, S, E); }
          if (gemm_wgs == F.G) p3_convert_moe(F, arg_in(10), arg_in(12), arg_in(14), F.vcu, F.G);
          else if ((int)blockIdx.x >= gemm_wgs) p3_convert_moe(F, arg_in(10), arg_in(12), arg_in(14), (int)blockIdx.x - gemm_wgs, F.G - gemm_wgs); }
    ); SEAM(1);
    PHASE(2, p2_attention(F, arg_in(2));); SEAM(2);
    PHASE(3, p3_merge(F);); SEAM(3);
    PHASE(4,
        { pg8::Gemm g{(const char*)(F.dout + DO_OAB), (const char*)(F.dout + DO_WCAT), OAB_P, OAB_P, OAB_P / 128}; pg8::StaticOrder S; S.init(NTOK, D, F.G, (int)blockIdx.x);
        pg8::EpiGate E{SG, F.ws + WS_MRG};
        pg8::gemm_phase<pg8::EpiGate, pg8::StaticOrder, true, false, true>(F.lds, g, S, E); }
    ); SEAM(4);
    PHASE(5,
        { pg8::Gemm g{(const char*)(F.ws + WS_MRG), (const char*)(F.ws + WS_WOUT), D, D, D / 128}; pg8::StaticOrder S; S.init(NTOK, D, F.G, (int)blockIdx.x);
        pg8::EpiY E{arg_in(0), (bf16_t*)(F.ws + WS_Y), (float*)(F.ws + WS_STAT), 1.0f / (SM * SW)};
        pg8::gemm_phase<pg8::EpiY, pg8::StaticOrder, true, false, true>(F.lds, g, S, E); }
    ); SEAM(5);
    if (IN(6)) { if (DUP_PHASE == 6) p6_router(F, (const bf16_t*)(F.ws + WS_Y), (const float*)(F.ws + WS_STAT), arg_in(6), arg_in(7), (bf16_t*)(F.ws + 264 * MiB), F.ws + 330 * MiB, arg_in(9), CW_ECNT + 64 * NEXP, (size_t)362 * MiB - WS_PETOK);
        p6_router(F, (const bf16_t*)(F.ws + WS_Y), (const float*)(F.ws + WS_STAT), arg_in(6), arg_in(7), (bf16_t*)(F.ws + WS_X1B), F.ws + WS_X1Q, arg_in(9), CW_ECNT, 0); } SEAM(6);
    PHASE(7,
        { const int T = moe_tables(F);
        pg8::Gemm g{(const char*)(F.ws + WS_X1Q), (const char*)(F.ws + WS_WGU), D, D, D / 128};
        pg8::MoeOrder S{T, 8, F.G, (int)blockIdx.x, (const LAS int*)(F.lds + MOE_OFF), (const LAS int*)(F.lds + MOE_OFF + 128), (const LAS unsigned char*)(F.lds + MOE_OFF + 128 + 136),
                        (const int*)(F.ws + WS_PETOK), (size_t)2048 * D, true, (unsigned)D};
        pg8::EpiGU E{arg_in(11), arg_in(13), F.ws + WS_HDN, F.lds};
        pg8::gemm_phase<pg8::EpiGU, pg8::MoeOrder, true, true, true>(F.lds, g, S, E); }
    ); SEAM(7);
    PHASE(8,
        { const int T = moe_tables(F);
        pg8::Gemm g{(const char*)(F.ws + WS_HDN), (const char*)(F.ws + WS_WD), DFF, DFF, DFF / 128};
        pg8::MoeOrder S{T, 4, F.G, (int)blockIdx.x, (const LAS int*)(F.lds + MOE_OFF), (const LAS int*)(F.lds + MOE_OFF + 128), (const LAS unsigned char*)(F.lds + MOE_OFF + 128 + 136),
                        (const int*)(F.ws + WS_PETOK), (size_t)D * DFF, false, 0u};
        pg8::EpiDown E{arg_in(15), (const int*)(F.ws + WS_PETOK), (const float*)(F.ws + WS_PEGATE), F.dout, F.lds};
        pg8::gemm_phase<pg8::EpiDown, pg8::MoeOrder, true, false, true>(F.lds, g, S, E); }
    ); SEAM(8);
    if (IN(9)) {
        bool poison = (__hip_atomic_load(F.ctl + CW_TMO, RLX_AGENT) != 0u) || (__hip_atomic_load(F.ctl + CW_BAR + XB_TMO, RLX_AGENT) != 0u);
        if (DUP_PHASE == 9) p9_final(F, arg_in(16), arg_in(17), (const float*)F.dout, (float*)(F.ws + 194 * MiB), poison);
        p9_final(F, arg_in(16), arg_in(17), (const float*)F.dout, (float*)F.dout, poison);
    }
#undef PHASE
#undef IN
#undef SEAM
}

extern "C" void kernel_launch(void* const* d_in, const int* in_sizes, int n_in, void* d_out, int out_size, void* d_ws, size_t ws_size, hipStream_t stream) {
    static int grid = 0;
    if (grid == 0) {
        if (n_in != 18 || in_sizes[0] != NTOK * D || out_size != NTOK * D || ws_size < WS_END) { fprintf(stderr, "kernel_launch: unexpected shapes (n_in %d, ws %zu); nothing launched\n", n_in, ws_size); grid = -1; return; }
        int dev = 0, cus = 0, per_cu = 0;
        if (hipGetDevice(&dev) != hipSuccess || hipDeviceGetAttribute(&cus, hipDeviceAttributeMultiprocessorCount, dev) != hipSuccess) { grid = -1; return; }
        if (hipFuncSetAttribute((const void*)fwd_kernel, hipFuncAttributeMaxDynamicSharedMemorySize, LDS_BYTES) != hipSuccess) { fprintf(stderr, "kernel_launch: hipFuncSetAttribute failed\n"); grid = -1; return; }
        if (hipOccupancyMaxActiveBlocksPerMultiprocessor(&per_cu, (const void*)fwd_kernel, NWAVES * 64, LDS_BYTES) != hipSuccess || per_cu < 1) fprintf(stderr, "kernel_launch: occupancy query reports %d\n", per_cu);
        (void)hipGetLastError();
        grid = cus;
    }
    if (grid < 0) return;
    if (hipMemsetAsync((char*)d_ws + WS_CTL, 0, CTL_ZERO_BYTES, stream) != hipSuccess) return;
    Args a{};
    for (int i = 0; i < 18; ++i) a.in[i] = (const float*)d_in[i];
    a.out = (float*)d_out; a.ws = (unsigned char*)d_ws;
    if (N_LAUNCHES == 1) { a.ph_lo = 0; a.ph_hi = N_PHASES; hipLaunchKernelGGL(fwd_kernel, dim3(grid), dim3(NWAVES * 64), LDS_BYTES, stream, a); }
    else for (int p = 0; p < N_PHASES; ++p) { a.ph_lo = p; a.ph_hi = p + 1; hipLaunchKernelGGL(fwd_kernel, dim3(grid), dim3(NWAVES * 64), LDS_BYTES, stream, a); }
}
```

```cpp
#include <hip/hip_runtime.h>
#include <cstdio>
#include <cstdint>

#define GAS __attribute__((address_space(1)))
#define LAS __attribute__((address_space(3)))
typedef unsigned short bf16_t;
typedef short bf16x8 __attribute__((ext_vector_type(8)));
typedef short s16x4 __attribute__((ext_vector_type(4)));
typedef float f32x2 __attribute__((ext_vector_type(2)));
typedef float f32x4 __attribute__((ext_vector_type(4)));
typedef float f32x16 __attribute__((ext_vector_type(16)));
typedef unsigned u32x2 __attribute__((ext_vector_type(2)));
typedef unsigned u32x4 __attribute__((ext_vector_type(4)));
typedef GAS unsigned gu32;

#ifndef MK_N_LAUNCHES
#define MK_N_LAUNCHES 1
#endif
#ifndef DUP_PHASE
#define DUP_PHASE -1
#endif
constexpr int N_PHASES = 10;
constexpr int N_LAUNCHES = MK_N_LAUNCHES;

constexpr int NB = 8, SEQ = 4096, D = 1024, NTOK = NB * SEQ;
constexpr int HQ_P = 3584;
constexpr int SG_P = 2048;
constexpr int OAB_P = 1280;
constexpr int IN_COLS = 5632;
constexpr int NEXP = 32, TOPK = 4, DFF = 1024;
constexpr int MAX_MT = 544;
constexpr float LN_EPS = 1e-5f;
constexpr float DN_ALPHA = 1.189207115002721f;
constexpr float LOG2E = 1.4426950408889634f, LN2 = 0.6931471805599453f;
constexpr float QSCALE = 0.125f * LOG2E;
constexpr float NEG_BIG = -1e30f;

constexpr size_t MiB = 1u << 20;
constexpr size_t WS_CTL = 0, CTL_ZERO_BYTES = 1 * MiB;
constexpr size_t WS_XBUF = 1 * MiB;
constexpr size_t WS_Y = 194 * MiB;
constexpr size_t WS_STAT = 258 * MiB;
constexpr size_t WS_HQ = 2 * MiB;
constexpr size_t HQ_QD = 0, HQ_KD = 48 * MiB, HQ_VD = 96 * MiB, HQ_QS = 144 * MiB, HQ_KS = 208 * MiB, HQ_VS = 216 * MiB;
constexpr size_t WS_WGU = 404 * MiB;
constexpr size_t WS_WD = 468 * MiB;
constexpr size_t WS_X1B = 98 * MiB;
constexpr size_t WS_X1Q = 162 * MiB;
constexpr size_t WS_HDN = 194 * MiB;
constexpr size_t WS_SG = 226 * MiB;
constexpr size_t WS_YS23 = 330 * MiB;
constexpr size_t WS_OAG = 354 * MiB;
constexpr size_t WS_LSE = 402 * MiB;
constexpr size_t WS_MRG = 2 * MiB;
constexpr size_t WS_WOUT = 530 * MiB;
constexpr size_t WS_PETOK = 532 * MiB;
constexpr size_t WS_PEGATE = 536 * MiB;
constexpr size_t WS_WRT = 540 * MiB;
constexpr size_t WS_END = 540 * MiB + 256 * 1024;
constexpr float SX = 8.0f, SW = 512.0f, SH = 4.0f, SXIN = 8.0f, SY = 64.0f, SM = 64.0f, SO = 64.0f, SSG = 256.0f, SQ = 64.0f, SK = 16.0f;
static_assert(WS_HQ + (size_t)NTOK * HQ_P * 2 <= WS_SG && WS_SG + (size_t)NTOK * SG_P <= WS_OAG && WS_OAG + (size_t)3 * NTOK * 256 * 2 <= WS_LSE && WS_LSE + (size_t)3 * NTOK * 4 * 4 <= WS_WGU, "ws map 1");
static_assert(WS_WGU + (size_t)NEXP * 2048 * D <= WS_WD && WS_WD + (size_t)NEXP * D * DFF <= WS_WOUT && WS_MRG + (size_t)NTOK * D <= WS_X1B && WS_X1B + (size_t)NTOK * D * 2 <= WS_X1Q && WS_X1Q + (size_t)NTOK * D <= WS_HDN, "ws map 2");
static_assert(WS_HDN + (size_t)MAX_MT * 256 * DFF <= WS_OAG && WS_WOUT + (size_t)D * D <= WS_PETOK, "ws map 3");
constexpr size_t DO_XB = 0;
constexpr size_t DO_OAB = 0;
constexpr size_t DO_WIN = 96 * MiB;
constexpr size_t DO_WCAT = 108 * MiB;
constexpr int CW_TMO = 0, CW_CODE = 1;
constexpr int CW_BAR = 4096;
constexpr int CW_SEAM = 16384;
constexpr int CW_ECNT = 32768;
static_assert((CW_ECNT + 2 * 64 * NEXP) * 4 <= (int)CTL_ZERO_BYTES, "CTL words inside the memset region");

constexpr int RING_BYTES = 131072;
constexpr int SCR_BYTES = 143360;
constexpr int LDSCTL_OFF = SCR_BYTES;
constexpr int MISC_OFF = LDSCTL_OFF + 320;
constexpr int MOE_OFF = LDSCTL_OFF + 512;
constexpr int LDS_BYTES = 147456;
static_assert(MOE_OFF + 128 + 136 + MAX_MT <= LDS_BYTES, "LDS map");

#define RLX_AGENT __ATOMIC_RELAXED, __HIP_MEMORY_SCOPE_AGENT
#define LDS_WAIT() asm volatile("s_waitcnt lgkmcnt(0)" ::: "memory")
#define VM_WAIT() asm volatile("s_waitcnt vmcnt(0)" ::: "memory")

__device__ __forceinline__ unsigned cvt_pk_bf16(float lo, float hi) { unsigned r; asm volatile("v_cvt_pk_bf16_f32 %0, %1, %2" : "=v"(r) : "v"(lo), "v"(hi)); return r; }
__device__ __forceinline__ int opaque(int v) { asm volatile("" : "+v"(v)); return v; }
__device__ __forceinline__ unsigned pk4_fp8(float a, float b, float c, float d) { int w = 0; w = __builtin_amdgcn_cvt_pk_fp8_f32(a, b, w, false); w = __builtin_amdgcn_cvt_pk_fp8_f32(c, d, w, true); return (unsigned)w; }
__device__ __forceinline__ unsigned f2e4m3_sw(float x) {
    const float a = __builtin_amdgcn_fmed3f(fabsf(x), 9.5367431640625e-07f, 448.f);
    const int e1 = max(__builtin_amdgcn_frexp_expf(a), -5);
    const unsigned m = (unsigned)__builtin_rintf(__builtin_amdgcn_ldexpf(a, 4 - e1));
    return ((__float_as_uint(x) >> 24) & 0x80u) | (unsigned)((e1 << 3) + 40 + (int)m); }
__device__ __forceinline__ unsigned pk4_fp8_pad(float a, float b, float c, float d) {
    unsigned w;
    asm("v_cvt_pk_fp8_f32 %0, %1, %2\n\ts_nop 1" : "=v"(w) : "v"(a), "v"(b));
    asm("v_cvt_pk_fp8_f32 %0, %1, %2 op_sel:[0,0,1]\n\ts_nop 1" : "+v"(w) : "v"(c), "v"(d));
    return w; }
__device__ __forceinline__ float clamp_fp8(float v) { return __builtin_amdgcn_fmed3f(v, -448.0f, 448.0f); }
__device__ __forceinline__ float bf_lo(unsigned w) { return __uint_as_float(w << 16); }
__device__ __forceinline__ float bf_hi(unsigned w) { return __uint_as_float(w & 0xffff0000u); }
__device__ __forceinline__ float fast_sigmoid(float g) { g = fminf(fmaxf(g, -60.f), 60.f); return __builtin_amdgcn_rcpf(1.0f + __builtin_amdgcn_exp2f(-g * LOG2E)); }

namespace pg8 {
constexpr int BM = 256, BK = 64, HALF = 128, HTB = HALF * BK * 2, STAGE_BYTES = 8 * HTB, NXCD = 8, WGM = 8;
constexpr int EPRE_OFF = STAGE_BYTES;
static_assert(EPRE_OFF + 3072 <= SCR_BYTES, "epilogue prefetch area");
__host__ __device__ __forceinline__ int lds_byte(int r, int c) { const int st = (r >> 4) * 2 + (c >> 5), rr = r & 15, cc = c & 31, ob = rr * 64 + cc * 2; return st * 1024 + (ob ^ (((ob >> 9) & 1) << 5)); }
__host__ __device__ __forceinline__ void stage_rc(int b, int& R, int& C) { const int st = b / 1024, sb = b % 1024, swz = sb ^ (((sb >> 9) & 1) << 5); R = (st >> 1) * 16 + swz / 64; C = (st & 1) * 32 + (swz % 64) / 2; }
__host__ __device__ __forceinline__ int perm32(int rho) { const int n = rho >> 4, i = rho & 15; return 8 * (i >> 2) + 4 * n + (i & 3); }

struct Unit { int pm, pn, e, ti, valid; };
struct Gemm { const char* A; const char* Bt; int lda, ldb, nt; };

__device__ __forceinline__ bool tile_of(long L, int nM, int nN, int& pm, int& pn) {
    const int nwg = nM * nN; if (L >= nwg) return false;
    int wgid = (int)L; { const int q = nwg / NXCD, r = nwg % NXCD, xcd = wgid % NXCD, off = wgid / NXCD; wgid = (xcd < r ? xcd * (q + 1) : r * (q + 1) + (xcd - r) * q) + off; }
    const int nig = WGM * nN, gid = wgid / nig, fm = gid * WGM, gsz = (nM - fm) < WGM ? (nM - fm) : WGM;
    pm = fm + ((wgid % nig) % gsz); pn = (wgid % nig) / gsz; return true;
}
struct StaticOrder {
    int nM, nN, G, c;
    __device__ __forceinline__ void init(int M, int N, int G_, int c_) { nM = M / BM; nN = N / BM; G = G_; c = c_; }
    __device__ __forceinline__ bool next(int i, Unit& u) const { u.e = 0; u.ti = 0; u.valid = 256; return tile_of((long)i * G + c, nM, nN, u.pm, u.pn); }
    __device__ __forceinline__ const char* a_ptr(const Gemm& g, const Unit& u) const { return g.A + (size_t)u.pm * 256 * g.lda; }
    __device__ __forceinline__ const char* b_ptr(const Gemm& g, const Unit& u) const { return g.Bt + (size_t)u.pn * 256 * g.ldb; }
    __device__ __forceinline__ unsigned row_off(const Unit&, int) const { return 0u; }
};
struct MoeOrder {
    int T, nN, G, c; const LAS int* cnt; const LAS int* fs; const LAS unsigned char* te;
    const int* petok; size_t b_exp_stride; bool gather; unsigned rowbytes;
    __device__ __forceinline__ bool next(int i, Unit& u) const {
        if (!tile_of((long)i * G + c, T, nN, u.pm, u.pn)) return false;
        u.e = __builtin_amdgcn_readfirstlane((int)te[u.pm]); u.ti = u.pm - __builtin_amdgcn_readfirstlane(fs[u.e]); const int left = __builtin_amdgcn_readfirstlane(cnt[u.e]) - u.ti * 256; u.valid = left < 256 ? left : 256; return true;
    }
    __device__ __forceinline__ const char* a_ptr(const Gemm& g, const Unit& u) const { return gather ? g.A : g.A + (size_t)u.pm * 256 * g.lda; }
    __device__ __forceinline__ const char* b_ptr(const Gemm& g, const Unit& u) const { return g.Bt + (size_t)u.e * b_exp_stride + (size_t)u.pn * 256 * g.ldb; }
    __device__ __forceinline__ unsigned row_off(const Unit& u, int R) const {
        int tok = 0; if (R < u.valid) tok = petok[(size_t)u.e * NTOK + u.ti * 256 + R] >> 2;
        return (unsigned)tok * rowbytes;
    }
};

typedef int v8i32 __attribute__((ext_vector_type(8)));
template <class Epi, class Sched, bool ALIGN_EPI, bool GATHER, bool F8 = false>
__device__ __forceinline__ void gemm_phase(LAS unsigned char* lds, const Gemm g, const Sched& S, const Epi& E) {
    const int tid = threadIdx.x, wid = __builtin_amdgcn_readfirstlane(tid >> 6), lane = tid & 63, wr = wid >> 2, wc = wid & 3, fr = lane & 15, fq = lane >> 4;
    const int nt = g.nt;
    unsigned voffA[2], voffB[2]; int RA[2], CA2[2];
#pragma unroll
    for (int i = 0; i < 2; ++i) { int R, C; stage_rc(tid * 16 + i * 8192, R, C); const int Rb = Epi::PERM ? ((R & ~31) + perm32(R & 31)) : R;
        voffA[i] = (unsigned)(R * g.lda + C * 2); voffB[i] = (unsigned)(Rb * g.ldb + C * 2); RA[i] = R; CA2[i] = C * 2; }
    const size_t kstep = (size_t)(BK * 2);
    const size_t hstepA = (size_t)HALF * g.lda, hstepB = (size_t)HALF * g.ldb;
    const unsigned ldsw = (unsigned)wid * 1024u;
    const int aoff = lds_byte(wr * 64 + fr, fq * 8), boff = lds_byte(wc * 32 + fr, fq * 8);
    const int aoff0 = aoff, boff0 = boff, aoff1 = aoff + 1024, boff1 = boff + 1024;
#define PG8_SA(b, h) (((b) * 2 + (h)) * HTB)
#define PG8_SB(b, h) ((4 + (b) * 2 + (h)) * HTB)
#define PG8_STAGE(bufoff, gbase, voff) do { _Pragma("unroll") for (int _i = 0; _i < 2; ++_i) \
        __builtin_amdgcn_global_load_lds((const unsigned*)((const char*)(gbase) + (voff)[_i]), (LAS unsigned*)(lds + (bufoff) + ldsw + _i * 8192), 16, 0, 0); } while (0)
#define PG8_STAGE_A(bufoff, kp, h, nx) do { if constexpr (GATHER) { unsigned _v[2]; _v[0] = (nx) ? gN[h][0] : gC[h][0]; _v[1] = (nx) ? gN[h][1] : gC[h][1]; PG8_STAGE(bufoff, kp, _v); } \
        else { PG8_STAGE(bufoff, (kp) + (h) * hstepA, voffA); } } while (0)
#define PG8_LDA(dst, b, h) do { _Pragma("unroll") for (int m = 0; m < 4; ++m) _Pragma("unroll") for (int k = 0; k < 2; ++k) dst[m][k] = *(const LAS bf16x8*)(lds + PG8_SA(b, h) + (k ? aoff1 : aoff0) + m * 2048); } while (0)
#define PG8_LDB(dst, b, h) do { _Pragma("unroll") for (int n = 0; n < 2; ++n) _Pragma("unroll") for (int k = 0; k < 2; ++k) dst[n][k] = *(const LAS bf16x8*)(lds + PG8_SB(b, h) + (k ? boff1 : boff0) + n * 2048); } while (0)
#define PG8_F8OP(X) __builtin_bit_cast(v8i32, __builtin_shufflevector(X[0], X[1], 0, 1, 2, 3, 4, 5, 6, 7, 8, 9, 10, 11, 12, 13, 14, 15))
#define PG8_MMA(ai, bj, At, Bt) do { __builtin_amdgcn_s_setprio(1); if constexpr (F8) { _Pragma("unroll") for (int m = 0; m < 4; ++m) _Pragma("unroll") for (int n = 0; n < 2; ++n) \
        asm volatile("v_mfma_scale_f32_16x16x128_f8f6f4 %0, %1, %2, %0, %3, %3 op_sel_hi:[0,0,0]" : "+v"(acc[ai][bj][m][n]) : "v"(PG8_F8OP(Bt[n])), "v"(PG8_F8OP(At[m])), "v"(one_scale)); } \
        else { _Pragma("unroll") for (int m = 0; m < 4; ++m) _Pragma("unroll") for (int n = 0; n < 2; ++n) _Pragma("unroll") for (int k = 0; k < 2; ++k) \
        acc[ai][bj][m][n] = __builtin_amdgcn_mfma_f32_16x16x32_bf16(Bt[n][k], At[m][k], acc[ai][bj][m][n], 0, 0, 0); } __builtin_amdgcn_s_setprio(0); } while (0)
#define PG8_WAIT_V(n) asm volatile("s_waitcnt vmcnt(" #n ")" ::: "memory")
#define PG8_WAIT_L(n) asm volatile("s_waitcnt lgkmcnt(" #n ")" ::: "memory")
#define PG8_BAR __builtin_amdgcn_s_barrier()
#define PG8_SCHED __builtin_amdgcn_sched_barrier(0)
    Unit cur, nxt; int ui = 0;
    if (!S.next(0, cur)) return;
    int one_scale = 0x7f7f7f7f; if constexpr (F8) asm volatile("" : "+v"(one_scale));
    unsigned gC[2][2], gN[2][2];
#pragma unroll
    for (int h = 0; h < 2; ++h)
#pragma unroll
        for (int i = 0; i < 2; ++i) { gC[h][i] = GATHER ? S.row_off(cur, h * HALF + RA[i]) + (unsigned)CA2[i] : 0u; gN[h][i] = gC[h][i]; }
    f32x4 acc[2][2][4][2];
#pragma unroll
    for (int a = 0; a < 2; ++a)
#pragma unroll
        for (int b = 0; b < 2; ++b)
#pragma unroll
            for (int m = 0; m < 4; ++m)
#pragma unroll
                for (int n = 0; n < 2; ++n) acc[a][b][m][n] = (f32x4){0.f, 0.f, 0.f, 0.f};
    bf16x8 At[4][2], B0[2][2], B1[2][2];
    const char* cA = S.a_ptr(g, cur); const char* cB = S.b_ptr(g, cur);
    PG8_STAGE(PG8_SB(0, 0), cB, voffB); PG8_STAGE(PG8_SB(0, 1), cB + hstepB, voffB); PG8_STAGE_A(PG8_SA(0, 0), cA, 0, false); PG8_STAGE_A(PG8_SA(0, 1), cA, 1, false);
    if (wr == 1) PG8_BAR;
    PG8_WAIT_V(2); PG8_BAR;
    PG8_STAGE(PG8_SB(1, 0), cB + kstep, voffB); PG8_STAGE_A(PG8_SA(1, 0), cA + kstep, 0, false); PG8_STAGE(PG8_SB(1, 1), cB + hstepB + kstep, voffB);
    PG8_WAIT_V(6); PG8_BAR;
    for (;;) {
        const bool has_next = S.next(ui + 1, nxt);
        const char* nA = has_next ? S.a_ptr(g, nxt) : cA; const char* nB = has_next ? S.b_ptr(g, nxt) : cB;
        if constexpr (GATHER) { if (has_next) {
#pragma unroll
            for (int h = 0; h < 2; ++h)
#pragma unroll
                for (int i = 0; i < 2; ++i) gN[h][i] = S.row_off(nxt, h * HALF + RA[i]) + (unsigned)CA2[i]; } }
#pragma unroll 1
        for (int t = 0; t < nt; t += 2) {
            const bool last = (t == nt - 2);
            asm volatile("" : "+v"(voffA[0]), "+v"(voffA[1]), "+v"(voffB[0]), "+v"(voffB[1]));
            if constexpr (Epi::HAS_MID) { if (t == Epi::MID_T) E.mid(acc, cur, wr, wc, fr, fq); }
            if constexpr (Epi::HAS_PRE) { if (last) E.pre(lds, cur, wid, lane); }
            const char* a1 = cA + (size_t)(t + 1) * kstep;
            const char* a2 = last ? nA : cA + (size_t)(t + 2) * kstep; const char* b2 = last ? nB : cB + (size_t)(t + 2) * kstep;
            const char* a3 = a2 + kstep; const char* b3 = b2 + kstep;
            PG8_LDB(B0, 0, 0); PG8_LDB(B1, 0, 1); PG8_SCHED; PG8_LDA(At, 0, 0); PG8_STAGE_A(PG8_SA(1, 1), a1, 1, false);
            PG8_WAIT_V(8); PG8_WAIT_L(0); PG8_BAR; PG8_MMA(0, 0, At, B0); PG8_MMA(0, 1, At, B1); PG8_BAR; PG8_SCHED;
            PG8_LDA(At, 0, 1); PG8_STAGE(PG8_SB(0, 0), b2, voffB); PG8_STAGE(PG8_SB(0, 1), b2 + hstepB, voffB); PG8_STAGE_A(PG8_SA(0, 0), a2, 0, last);
            PG8_WAIT_V(8); PG8_WAIT_L(0); PG8_BAR; PG8_MMA(1, 0, At, B0); PG8_MMA(1, 1, At, B1); PG8_BAR; PG8_SCHED;
            PG8_LDB(B0, 1, 0); PG8_LDB(B1, 1, 1); PG8_SCHED; PG8_LDA(At, 1, 0); PG8_STAGE_A(PG8_SA(0, 1), a2, 1, last);
            PG8_WAIT_V(8); PG8_WAIT_L(0); PG8_BAR; PG8_MMA(0, 0, At, B0); PG8_MMA(0, 1, At, B1); PG8_BAR; PG8_SCHED;
            PG8_LDA(At, 1, 1); PG8_STAGE(PG8_SB(1, 0), b3, voffB); PG8_STAGE(PG8_SB(1, 1), b3 + hstepB, voffB); PG8_STAGE_A(PG8_SA(1, 0), a3, 0, last);
            PG8_WAIT_V(8); PG8_WAIT_L(0); PG8_BAR; PG8_MMA(1, 0, At, B0); PG8_MMA(1, 1, At, B1); PG8_BAR; PG8_SCHED;
        }
        if constexpr (ALIGN_EPI) { if (wr == 0) PG8_BAR; }
        if constexpr (F8) asm volatile("s_nop 15\n\ts_nop 15" ::: "memory");
        if constexpr (!Epi::AFTER_DRAIN) { E(acc, cur, wr, wc, fr, fq); }
        if (!has_next) break;
#pragma unroll
        for (int a = 0; a < 2; ++a)
#pragma unroll
            for (int b = 0; b < 2; ++b)
#pragma unroll
                for (int m = 0; m < 4; ++m)
#pragma unroll
                    for (int n = 0; n < 2; ++n) acc[a][b][m][n] = (f32x4){0.f, 0.f, 0.f, 0.f};
        cur = nxt; cA = nA; cB = nB; ++ui;
#pragma unroll
        for (int h = 0; h < 2; ++h)
#pragma unroll
            for (int i = 0; i < 2; ++i) gC[h][i] = gN[h][i];
        if constexpr (ALIGN_EPI) { if (wr == 1) PG8_BAR; }
    }
    PG8_WAIT_V(0);
    if constexpr (!ALIGN_EPI) { if (wr == 0) PG8_BAR; }
    PG8_BAR;
    if constexpr (Epi::AFTER_DRAIN) { E.fused(acc, cur, wr, wc, fr, fq, lds, wid, lane); }
#undef PG8_SA
#undef PG8_SB
#undef PG8_STAGE
#undef PG8_STAGE_A
#undef PG8_LDA
#undef PG8_LDB
#undef PG8_MMA
#undef PG8_F8OP
#undef PG8_WAIT_V
#undef PG8_WAIT_L
#undef PG8_BAR
#undef PG8_SCHED
}
}

namespace pg8 {
__device__ __forceinline__ u32x4 pair16(u32x2 x, u32x2 y) {
    const auto sx = __builtin_amdgcn_permlane16_swap(x.x, y.x, false, false), sy = __builtin_amdgcn_permlane16_swap(x.y, y.y, false, false);
    u32x4 o; o.x = sx[0]; o.y = sy[0]; o.z = sx[1]; o.w = sy[1]; return o; }
__device__ __forceinline__ void unpair16(u32x4 v, u32x2& x, u32x2& y) {
    const auto sx = __builtin_amdgcn_permlane16_swap(v.x, v.z, false, false), sy = __builtin_amdgcn_permlane16_swap(v.y, v.w, false, false);
    x.x = sx[0]; x.y = sy[0]; y.x = sx[1]; y.y = sy[1]; }
struct EpiInProj {
    static constexpr bool PERM = true, AFTER_DRAIN = false, HAS_MID = false, HAS_PRE = false; static constexpr int MID_T = 0;
    unsigned char* HQ; unsigned char* SG; float rs;
    __device__ __forceinline__ void mid(f32x4 (&)[2][2][4][2], const Unit&, int, int, int, int) const {}
    __device__ __forceinline__ void operator()(const f32x4 (&acc)[2][2][4][2], const Unit& u, int wr, int wc, int fr, int fq) const {
        const int row0 = u.pm * BM + wr * 64 + opaque(fr), pn = u.pn;
        const bool gate = pn >= 14; const bool qs = (pn < 3) || (pn >= 9 && pn < 13);
        const float sc = (qs ? QSCALE : 1.0f) * rs; const int dcol = (wc & 1) * 32 + 8 * fq;
        const int fqo = fq & 1;
#pragma unroll
        for (int ai = 0; ai < 2; ++ai)
#pragma unroll
            for (int m = 0; m < 4; ++m) { const int row = row0 + ai * HALF + m * 16, b = row >> 12, t = row & (SEQ - 1);
                if (gate || pn < 6 || (pn >= 9 && pn < 13)) {
                    u32x2 w8[2];
#pragma unroll
                    for (int bj = 0; bj < 2; ++bj) { f32x4 v0 = acc[ai][bj][m][0], v1 = acc[ai][bj][m][1];
                        if (gate) {
#pragma unroll
                            for (int q = 0; q < 4; ++q) { v0[q] = fmaxf(fast_sigmoid(v0[q] * rs) * SSG, 0.001953125f); v1[q] = fmaxf(fast_sigmoid(v1[q] * rs) * SSG, 0.001953125f); }
                            w8[bj].x = pk4_fp8(v0[0], v0[1], v0[2], v0[3]); w8[bj].y = pk4_fp8(v1[0], v1[1], v1[2], v1[3]); }
                        else { const float qk = sc * ((pn >= 3 && pn < 6) ? SK : SQ); v0 = v0 * qk; v1 = v1 * qk;
                            w8[bj].x = pk4_fp8(clamp_fp8(v0[0]), clamp_fp8(v0[1]), clamp_fp8(v0[2]), clamp_fp8(v0[3])); w8[bj].y = pk4_fp8(clamp_fp8(v1[0]), clamp_fp8(v1[1]), clamp_fp8(v1[2]), clamp_fp8(v1[3])); } }
                    unsigned char* dp;
                    if (gate) dp = SG + (size_t)row * SG_P + (pn - 14) * 256 + wc * 32 + 8 * fq + (fqo ? HALF - 8 : 0);
                    else { const int hl = (wc >> 1) + 2 * fqo; size_t rowi; unsigned char* base8;
                        if (pn < 9) { const int ty = pn / 3, g = pn - 3 * ty, sh = 2 * g, pos = ((t & ((1 << sh) - 1)) << (12 - sh)) + (t >> sh);
                            rowi = (size_t)(((g * NB + b) * 4 + hl) * SEQ + pos); base8 = HQ + (size_t)ty * (48 * MiB); }
                        else { rowi = (size_t)((b * 16 + (pn - 9) * 4 + hl) * SEQ + t); base8 = HQ + HQ_QS; }
                        dp = base8 + rowi * 64 + dcol - 8 * fqo; }
                    *(u32x4*)dp = pair16(w8[0], w8[1]);
                    continue; }
#pragma unroll
                for (int bj = 0; bj < 2; ++bj) { f32x4 v0 = acc[ai][bj][m][0], v1 = acc[ai][bj][m][1];
                    bf16_t* dst;
                    if (gate) {
#pragma unroll
                        for (int q = 0; q < 4; ++q) { v0[q] = fmaxf(fast_sigmoid(v0[q] * rs) * SSG, 0.001953125f); v1[q] = fmaxf(fast_sigmoid(v1[q] * rs) * SSG, 0.001953125f); }
                        u32x2 w8; w8.x = pk4_fp8(v0[0], v0[1], v0[2], v0[3]); w8.y = pk4_fp8(v1[0], v1[1], v1[2], v1[3]);
                        *(u32x2*)(SG + (size_t)row * SG_P + (pn - 14) * 256 + bj * HALF + wc * 32 + 8 * fq) = w8; continue; }
                    else { v0 = v0 * sc; v1 = v1 * sc; const int hl = bj * 2 + (wc >> 1);
                        size_t rowi; unsigned char* base8; float qk; bool is8;
                        if (pn < 9) { const int ty = pn / 3, g = pn - 3 * ty, sh = 2 * g, pos = ((t & ((1 << sh) - 1)) << (12 - sh)) + (t >> sh);
                            rowi = (size_t)(((g * NB + b) * 4 + hl) * SEQ + pos); base8 = HQ + (size_t)ty * (48 * MiB); is8 = ty < 2; qk = ty == 0 ? SQ : SK; }
                        else if (pn < 13) { rowi = (size_t)((b * 16 + (pn - 9) * 4 + hl) * SEQ + t); base8 = HQ + HQ_QS; is8 = true; qk = SQ; }
                        else { rowi = (size_t)((b * 2 + (wc >> 1)) * SEQ + t); base8 = HQ + (bj ? HQ_VS : HQ_KS); is8 = (bj == 0); qk = SK; }
                        if (is8) { u32x2 w8; w8.x = pk4_fp8(clamp_fp8(v0[0] * qk), clamp_fp8(v0[1] * qk), clamp_fp8(v0[2] * qk), clamp_fp8(v0[3] * qk)); w8.y = pk4_fp8(clamp_fp8(v1[0] * qk), clamp_fp8(v1[1] * qk), clamp_fp8(v1[2] * qk), clamp_fp8(v1[3] * qk));
                            *(u32x2*)(base8 + rowi * 64 + dcol) = w8; continue; }
                        dst = (bf16_t*)base8 + rowi * 64 + dcol; }
                    u32x4 w; w.x = cvt_pk_bf16(v0[0], v0[1]); w.y = cvt_pk_bf16(v0[2], v0[3]); w.z = cvt_pk_bf16(v1[0], v1[1]); w.w = cvt_pk_bf16(v1[2], v1[3]);
                    *(u32x4*)dst = w; } }
    }
};
struct EpiGate {
    static constexpr bool PERM = true, AFTER_DRAIN = false, HAS_MID = true, HAS_PRE = false; static constexpr int MID_T = 2;
    const unsigned char* __restrict__ SG; unsigned char* __restrict__ O;
    __device__ __forceinline__ void mid(f32x4 (&acc)[2][2][4][2], const Unit& u, int wr, int wc, int fr, int fq) const {
        const int row0 = u.pm * BM + wr * 64 + opaque(fr), col0 = u.pn * BM + wc * 32 + 8 * opaque(fq);
        const int cswz = ((col0 >> 3) & 1) ? (HALF - 8) : 0;
#pragma unroll
        for (int ai = 0; ai < 2; ++ai) {
            u32x2 a[4][2], b[4][2];
#pragma unroll
            for (int mm = 0; mm < 4; ++mm) { const unsigned char* sp = SG + (size_t)(row0 + ai * HALF + mm * 16) * SG_P + col0 + cswz;
                const u32x4 la = *(const u32x4*)sp, lb = *(const u32x4*)(sp + 1024); unpair16(la, a[mm][0], a[mm][1]); unpair16(lb, b[mm][0], b[mm][1]); }
#pragma unroll
            for (int m = 0; m < 4; ++m) {
#pragma unroll
                for (int bj = 0; bj < 2; ++bj) {
#pragma unroll
                    for (int n = 0; n < 2; ++n) { const int aw = (int)a[m][bj][n], bw = (int)b[m][bj][n];
                        const f32x2 al = __builtin_amdgcn_cvt_pk_f32_fp8(aw, false), ah = __builtin_amdgcn_cvt_pk_f32_fp8(aw, true), bl = __builtin_amdgcn_cvt_pk_f32_fp8(bw, false), bh = __builtin_amdgcn_cvt_pk_f32_fp8(bw, true);
                        f32x4 r; r[0] = al[0] * __builtin_amdgcn_rcpf(bl[0]); r[1] = al[1] * __builtin_amdgcn_rcpf(bl[1]); r[2] = ah[0] * __builtin_amdgcn_rcpf(bh[0]); r[3] = ah[1] * __builtin_amdgcn_rcpf(bh[1]);
                        acc[ai][bj][m][n] = acc[ai][bj][m][n] * r; } }
                asm volatile("" : "+v"(acc[ai][0][m][0]), "+v"(acc[ai][0][m][1]), "+v"(acc[ai][1][m][0]), "+v"(acc[ai][1][m][1])); }
            asm volatile("" ::: "memory"); }
    }
    __device__ __forceinline__ void operator()(const f32x4 (&acc)[2][2][4][2], const Unit& u, int wr, int wc, int fr, int fq) const {
        const int row0 = u.pm * BM + wr * 64 + opaque(fr), col0 = u.pn * BM + wc * 32 + 8 * opaque(fq);
        constexpr float FS = SM / (SO * SW * SSG);
        const int cswz = ((col0 >> 3) & 1) ? (HALF - 8) : 0;
#pragma unroll
        for (int ai = 0; ai < 2; ++ai) {
            u32x2 bq[4][2];
#pragma unroll
            for (int m = 0; m < 4; ++m) { const u32x4 lb = *(const u32x4*)(SG + (size_t)(row0 + ai * HALF + m * 16) * SG_P + 1024 + col0 + cswz); unpair16(lb, bq[m][0], bq[m][1]); }
#pragma unroll
            for (int m = 0; m < 4; ++m) { unsigned char* op = O + (size_t)(row0 + ai * HALF + m * 16) * D + col0 + cswz;
                u32x2 w[2];
#pragma unroll
                for (int bj = 0; bj < 2; ++bj) {
#pragma unroll
                    for (int n = 0; n < 2; ++n) { const int bw = (int)bq[m][bj][n]; const f32x2 bl = __builtin_amdgcn_cvt_pk_f32_fp8(bw, false), bh = __builtin_amdgcn_cvt_pk_f32_fp8(bw, true); const f32x4 v = acc[ai][bj][m][n] * FS;
                        w[bj][n] = pk4_fp8(clamp_fp8(v[0] * bl[0]), clamp_fp8(v[1] * bl[1]), clamp_fp8(v[2] * bh[0]), clamp_fp8(v[3] * bh[1])); } }
                *(u32x4*)op = pair16(w[0], w[1]); }
            asm volatile("" ::: "memory"); }
    }
};

struct PanelStats {
    unsigned* xbuf;
    unsigned* cnt;
    unsigned* tmo;
    int pm_off; float eps; unsigned code;
    __device__ __forceinline__ bool run(const f32x4 (&v)[2][2][4][2], const Unit& u, int wr, int wc, int fr, int fq, LAS unsigned char* lds, int wid, int lane) const {
        LAS f32x2* P = (LAS f32x2*)lds;
        LAS f32x2* S = (LAS f32x2*)(lds + 8192);
        LAS unsigned* flag = (LAS unsigned*)(lds + 8192 + 2048);
        const int panel = u.pm + pm_off;
#pragma unroll
        for (int ai = 0; ai < 2; ++ai)
#pragma unroll
            for (int m = 0; m < 4; ++m) {
                float s = 0.f;
#pragma unroll
                for (int bj = 0; bj < 2; ++bj)
#pragma unroll
                    for (int n = 0; n < 2; ++n) { const f32x4 x = v[ai][bj][m][n]; s += (x[0] + x[1]) + (x[2] + x[3]); }
                s += __shfl_xor(s, 16); s += __shfl_xor(s, 32);
                const float mw = s * (1.0f / 64.0f); float q = 0.f;
#pragma unroll
                for (int bj = 0; bj < 2; ++bj)
#pragma unroll
                    for (int n = 0; n < 2; ++n) { const f32x4 d = v[ai][bj][m][n] - mw; q += (d[0] * d[0] + d[1] * d[1]) + (d[2] * d[2] + d[3] * d[3]); }
                q += __shfl_xor(q, 16); q += __shfl_xor(q, 32);
                if (fq == 0) P[(ai * HALF + wr * 64 + m * 16 + fr) * 4 + wc] = (f32x2){mw, q};
            }
        asm volatile("s_waitcnt lgkmcnt(0)" ::: "memory"); __builtin_amdgcn_s_barrier(); asm volatile("" ::: "memory");
        const int row = wid * 32 + (lane & 31);
        if (lane < 32) {
            const f32x2 a = P[row * 4 + 0], b = P[row * 4 + 1], c = P[row * 4 + 2], d = P[row * 4 + 3];
            const float mt = (a.x + b.x + c.x + d.x) * 0.25f;
            const float da = a.x - mt, db = b.x - mt, dc = c.x - mt, dd = d.x - mt;
            const float m2 = (a.y + b.y) + (c.y + d.y) + 64.0f * ((da * da + db * db) + (dc * dc + dd * dd));
            unsigned long long* slot = (unsigned long long*)xbuf + ((size_t)(panel * BM + row) * 4 + u.pn);
            __hip_atomic_store(slot, ((unsigned long long)__float_as_uint(m2) << 32) | __float_as_uint(mt), __ATOMIC_RELAXED, __HIP_MEMORY_SCOPE_AGENT);
        }
        asm volatile("s_waitcnt vmcnt(0)" ::: "memory");
        if (lane == 0) __hip_atomic_fetch_add(cnt + 64 * panel, 1u, __ATOMIC_RELAXED, __HIP_MEMORY_SCOPE_AGENT);
        if (wid == 0) {
            bool dead = false; const unsigned long long t0 = __builtin_amdgcn_s_memrealtime(); const unsigned want = 8u * 4u;
            for (;;) {
                if ((unsigned)__builtin_amdgcn_readfirstlane(__hip_atomic_load(cnt + 64 * panel, __ATOMIC_RELAXED, __HIP_MEMORY_SCOPE_AGENT)) >= want) break;
                if (__builtin_amdgcn_s_memrealtime() - t0 > 2000000ull) {
                    if (lane == 0) { unsigned expect = 0u; __hip_atomic_compare_exchange_strong(tmo + 1, &expect, code | (unsigned)(panel & 0xff), __ATOMIC_RELAXED, __ATOMIC_RELAXED, __HIP_MEMORY_SCOPE_AGENT);
                                     __hip_atomic_store(tmo, 1u, __ATOMIC_RELAXED, __HIP_MEMORY_SCOPE_AGENT); }
                    dead = true; break; }
                __builtin_amdgcn_s_sleep(2);
            }
            __builtin_amdgcn_fence(__ATOMIC_ACQUIRE, "agent");
            if (lane == 0) flag[0] = dead ? 1u : 0u;
        }
        asm volatile("s_waitcnt vmcnt(0) lgkmcnt(0)" ::: "memory"); __builtin_amdgcn_s_barrier(); asm volatile("" ::: "memory");
        const bool bad = flag[0] != 0u;
        if (lane < 32) {
            const unsigned long long* slot = (const unsigned long long*)xbuf + (size_t)(panel * BM + row) * 4; float mt[4], m2[4]; float ms = 0.f;
#pragma unroll
            for (int t = 0; t < 4; ++t) { const unsigned long long w = __hip_atomic_load(slot + t, __ATOMIC_RELAXED, __HIP_MEMORY_SCOPE_AGENT); mt[t] = __uint_as_float((unsigned)w); m2[t] = __uint_as_float((unsigned)(w >> 32)); ms += mt[t]; }
            const float mean = ms * 0.25f; float q = 0.f;
#pragma unroll
            for (int t = 0; t < 4; ++t) { const float dm = mt[t] - mean; q += m2[t] + 256.0f * dm * dm; }
            S[row] = (f32x2){mean, 1.0f / sqrtf(q * (1.0f / 1024.0f) + eps)};
        }
        asm volatile("s_waitcnt lgkmcnt(0)" ::: "memory"); __builtin_amdgcn_s_barrier(); asm volatile("" ::: "memory");
        return bad;
    }
};
struct EpiLn1 {
    static constexpr bool PERM = true, AFTER_DRAIN = true, HAS_MID = false, HAS_PRE = false; static constexpr int MID_T = 0;
    const float* x; float* out; bf16_t* xb; unsigned char* xq; const float* gam; const float* bet; PanelStats st; int row_off; unsigned poison; float rs;
    __device__ __forceinline__ void mid(f32x4 (&)[2][2][4][2], const Unit&, int, int, int, int) const {}
    __device__ __forceinline__ void operator()(const f32x4 (&)[2][2][4][2], const Unit&, int, int, int, int) const {}
    __device__ __forceinline__ void fused(f32x4 (&acc)[2][2][4][2], const Unit& u, int wr, int wc, int fr, int fq, LAS unsigned char* lds, int wid, int lane) const {
        const LAS f32x2* S = (const LAS f32x2*)(lds + 8192);
        const int col0 = u.pn * BM + wc * 32 + 8 * opaque(fq);
        const int grow0 = row_off + u.pm * BM; fr = opaque(fr);
#pragma unroll
        for (int ai = 0; ai < 2; ++ai)
#pragma unroll
            for (int m = 0; m < 4; ++m) { const size_t off = (size_t)(grow0 + ai * HALF + wr * 64 + m * 16 + fr) * D + col0;
#pragma unroll
                for (int bj = 0; bj < 2; ++bj)
#pragma unroll
                    for (int n = 0; n < 2; ++n) { const f32x4 bs = *(const f32x4*)(x + off + bj * HALF + n * 4); acc[ai][bj][m][n] = acc[ai][bj][m][n] * rs + bs * DN_ALPHA; }
                asm volatile("" : "+v"(acc[ai][0][m][0]), "+v"(acc[ai][0][m][1]), "+v"(acc[ai][1][m][0]), "+v"(acc[ai][1][m][1]));
                if (m == 3) asm volatile("" ::: "memory"); }
        const bool bad = st.run(acc, u, wr, wc, fr, fq, lds, wid, lane) || poison != 0u;
        const float qnan = __builtin_nanf("");
        f32x4 gv[2][2], bv[2][2];
#pragma unroll
        for (int bj = 0; bj < 2; ++bj)
#pragma unroll
            for (int n = 0; n < 2; ++n) { gv[bj][n] = *(const f32x4*)(gam + col0 + bj * HALF + n * 4); bv[bj][n] = *(const f32x4*)(bet + col0 + bj * HALF + n * 4); }
#pragma unroll
        for (int ai = 0; ai < 2; ++ai)
#pragma unroll
            for (int m = 0; m < 4; ++m) { const int r = ai * HALF + wr * 64 + m * 16 + fr; const f32x2 sr = S[r]; const size_t off = (size_t)(grow0 + r) * D + col0;
#pragma unroll
                for (int bj = 0; bj < 2; ++bj) { f32x4 o0 = (acc[ai][bj][m][0] - sr.x) * sr.y * gv[bj][0] + bv[bj][0], o1 = (acc[ai][bj][m][1] - sr.x) * sr.y * gv[bj][1] + bv[bj][1];
                    if (bad) { o0 = (f32x4){qnan, qnan, qnan, qnan}; o1 = o0; }
                    u32x4 w; w.x = cvt_pk_bf16(o0[0], o0[1]); w.y = cvt_pk_bf16(o0[2], o0[3]); w.z = cvt_pk_bf16(o1[0], o1[1]); w.w = cvt_pk_bf16(o1[2], o1[3]); *(u32x4*)(xb + off + bj * HALF) = w;
                    u32x2 q8; q8.x = pk4_fp8(clamp_fp8(o0[0] * SX), clamp_fp8(o0[1] * SX), clamp_fp8(o0[2] * SX), clamp_fp8(o0[3] * SX)); q8.y = pk4_fp8(clamp_fp8(o1[0] * SX), clamp_fp8(o1[1] * SX), clamp_fp8(o1[2] * SX), clamp_fp8(o1[3] * SX));
                    *(u32x2*)(xq + off + bj * HALF) = q8; } }
    }
};
struct EpiY {
    static constexpr bool PERM = true, AFTER_DRAIN = false, HAS_MID = false, HAS_PRE = false; static constexpr int MID_T = 0;
    const float* __restrict__ x; bf16_t* __restrict__ Y; float* __restrict__ ST; float rs;
    __device__ __forceinline__ void mid(f32x4 (&)[2][2][4][2], const Unit&, int, int, int, int) const {}
    __device__ __forceinline__ void operator()(const f32x4 (&acc)[2][2][4][2], const Unit& u, int wr, int wc, int fr, int fq) const {
        const int row0 = u.pm * BM + wr * 64 + opaque(fr), col0 = u.pn * BM + wc * 32 + 8 * opaque(fq);
#pragma unroll
        for (int ai = 0; ai < 2; ++ai) {
            f32x4 xv[4][2][2];
#pragma unroll
            for (int m = 0; m < 4; ++m)
#pragma unroll
                for (int bj = 0; bj < 2; ++bj)
#pragma unroll
                    for (int n = 0; n < 2; ++n) xv[m][bj][n] = *(const f32x4*)(x + (size_t)(row0 + ai * HALF + m * 16) * D + col0 + bj * HALF + n * 4);
#pragma unroll
            for (int m = 0; m < 4; ++m) { const size_t r = (size_t)(row0 + ai * HALF + m * 16); float s1 = 0.f, s2 = 0.f;
#pragma unroll
                for (int bj = 0; bj < 2; ++bj) { const f32x4 y0 = acc[ai][bj][m][0] * rs + xv[m][bj][0] * DN_ALPHA, y1 = acc[ai][bj][m][1] * rs + xv[m][bj][1] * DN_ALPHA;
                    s1 += (y0[0] + y0[1]) + (y0[2] + y0[3]) + (y1[0] + y1[1]) + (y1[2] + y1[3]);
                    s2 += (y0[0] * y0[0] + y0[1] * y0[1]) + (y0[2] * y0[2] + y0[3] * y0[3]) + (y1[0] * y1[0] + y1[1] * y1[1]) + (y1[2] * y1[2] + y1[3] * y1[3]);
                    u32x4 w; w.x = cvt_pk_bf16(y0[0], y0[1]); w.y = cvt_pk_bf16(y0[2], y0[3]); w.z = cvt_pk_bf16(y1[0], y1[1]); w.w = cvt_pk_bf16(y1[2], y1[3]);
                    *(u32x4*)(Y + r * D + col0 + bj * HALF) = w; }
                s1 += __shfl_xor(s1, 16); s1 += __shfl_xor(s1, 32); s2 += __shfl_xor(s2, 16); s2 += __shfl_xor(s2, 32);
                if (fq == 0) *(f32x2*)(ST + (r * 16 + u.pn * 4 + wc) * 2) = (f32x2){s1, s2}; }
            asm volatile("" ::: "memory"); }
    }
};
struct EpiGU {
    static constexpr bool PERM = true, AFTER_DRAIN = false, HAS_MID = false, HAS_PRE = true; static constexpr int MID_T = 0;
    const float* bg; const float* bu; unsigned char* H; LAS unsigned char* plds;
    __device__ __forceinline__ void mid(f32x4 (&)[2][2][4][2], const Unit&, int, int, int, int) const {}
    __device__ __forceinline__ void pre(LAS unsigned char* lds, const Unit& u, int wid, int lane) const {
        if (wid == 0) __builtin_amdgcn_global_load_lds((const unsigned*)((lane < 32 ? bg : bu) + u.e * DFF + u.pn * HALF + (lane & 31) * 4), (LAS unsigned*)(lds + EPRE_OFF), 16, 0, 0);
    }
    __device__ __forceinline__ void operator()(const f32x4 (&acc)[2][2][4][2], const Unit& u, int wr, int wc, int fr, int fq) const {
        const int row0 = u.pm * BM + wr * 64 + opaque(fr), jl = wc * 32 + 8 * opaque(fq), j0 = u.pn * HALF + jl;
        const LAS float* pb = (const LAS float*)(plds + EPRE_OFF) + jl;
        const f32x4 g0 = *(const LAS f32x4*)pb, g1 = *(const LAS f32x4*)(pb + 4), u0 = *(const LAS f32x4*)(pb + HALF), u1 = *(const LAS f32x4*)(pb + HALF + 4);
        f32x4 us0 = (u0 + 1.0f) * SH, us1 = (u1 + 1.0f) * SH;
        asm volatile("" : "+v"(us0), "+v"(us1));
        const int fqo = (jl >> 3) & 1;
#pragma unroll
        for (int ai = 0; ai < 2; ++ai)
#pragma unroll
            for (int m2 = 0; m2 < 4; m2 += 2) { u32x2 w[2];
#pragma unroll
              for (int mo = 0; mo < 2; ++mo) { const int m = m2 + mo;
                constexpr float RS = 1.0f / (SX * SW), CS = -1.702f * LOG2E;
                f32x4 h0, h1;
#pragma unroll
                for (int q = 0; q < 4; ++q) {
                    const float a = fminf(__builtin_fmaf(acc[ai][0][m][0][q], RS, g0[q]), 7.0f), b = fminf(__builtin_fmaf(acc[ai][0][m][1][q], RS, g1[q]), 7.0f);
                    const float ua = __builtin_amdgcn_fmed3f(__builtin_fmaf(acc[ai][1][m][0][q], RS * SH, us0[q]), -6.0f * SH, 8.0f * SH), ub = __builtin_amdgcn_fmed3f(__builtin_fmaf(acc[ai][1][m][1][q], RS * SH, us1[q]), -6.0f * SH, 8.0f * SH);
                    h0[q] = (a * __builtin_amdgcn_rcpf(1.0f + __builtin_amdgcn_exp2f(CS * a))) * ua;
                    h1[q] = (b * __builtin_amdgcn_rcpf(1.0f + __builtin_amdgcn_exp2f(CS * b))) * ub; }
                w[mo].x = pk4_fp8(h0[0], h0[1], h0[2], h0[3]); w[mo].y = pk4_fp8(h1[0], h1[1], h1[2], h1[3]); }
              *(u32x4*)(H + (size_t)(row0 + ai * HALF + (m2 + fqo) * 16) * DFF + j0 - 8 * fqo) = pair16(w[0], w[1]); }
    }
};
struct EpiDown {
    static constexpr bool PERM = true, AFTER_DRAIN = false, HAS_MID = false, HAS_PRE = true; static constexpr int MID_T = 0;
    const float* bd; const int* petok; const float* pegate; unsigned char* Y; LAS unsigned char* plds;
    __device__ __forceinline__ void mid(f32x4 (&)[2][2][4][2], const Unit&, int, int, int, int) const {}
    __device__ __forceinline__ void pre(LAS unsigned char* lds, const Unit& u, int wid, int lane) const {
        const size_t eb = (size_t)u.e * NTOK + (size_t)u.ti * 256 + (size_t)(lane * 4);
        if (wid == 0) __builtin_amdgcn_global_load_lds((const unsigned*)(bd + u.e * D + u.pn * BM + lane * 4), (LAS unsigned*)(lds + EPRE_OFF), 16, 0, 0);
        else if (wid == 1) __builtin_amdgcn_global_load_lds((const unsigned*)(petok + eb), (LAS unsigned*)(lds + EPRE_OFF + 1024), 16, 0, 0);
        else if (wid == 2) __builtin_amdgcn_global_load_lds((const unsigned*)(pegate + eb), (LAS unsigned*)(lds + EPRE_OFF + 2048), 16, 0, 0);
    }
    __device__ __forceinline__ void operator()(const f32x4 (&acc)[2][2][4][2], const Unit& u, int wr, int wc, int fr, int fq) const {
        const int r0 = wr * 64 + opaque(fr), cl = wc * 32 + 8 * opaque(fq), col0 = u.pn * BM + cl;
        const LAS float* pb = (const LAS float*)(plds + EPRE_OFF) + cl;
        f32x4 b[2][2];
#pragma unroll
        for (int bj = 0; bj < 2; ++bj) { b[bj][0] = *(const LAS f32x4*)(pb + bj * HALF); b[bj][1] = *(const LAS f32x4*)(pb + bj * HALF + 4); }
        int info[2][4]; float gwv[2][4];
#pragma unroll
        for (int ai = 0; ai < 2; ++ai)
#pragma unroll
            for (int m = 0; m < 4; ++m) { const int r = r0 + ai * HALF + m * 16; info[ai][m] = *(const LAS int*)(plds + EPRE_OFF + 1024 + 4 * r); gwv[ai][m] = *(const LAS float*)(plds + EPRE_OFF + 2048 + 4 * r) * SY; }
        if (u.valid == 256) {
            const int fqo = (col0 >> 3) & 1;
            const int cswz = fqo ? (HALF - 8) : 0;
#pragma unroll
        for (int ai = 0; ai < 2; ++ai)
#pragma unroll
            for (int m = 0; m < 4; ++m) {
                const float gw = gwv[ai][m];
                unsigned char* op = Y + (size_t)info[ai][m] * 1024 + col0 + cswz;
                u32x2 w[2];
#pragma unroll
                for (int bj = 0; bj < 2; ++bj) { constexpr float RS = 1.0f / (SH * SW); const f32x4 v0 = (acc[ai][bj][m][0] * RS + b[bj][0]) * gw, v1 = (acc[ai][bj][m][1] * RS + b[bj][1]) * gw;
                    w[bj].x = pk4_fp8(clamp_fp8(v0[0]), clamp_fp8(v0[1]), clamp_fp8(v0[2]), clamp_fp8(v0[3])); w[bj].y = pk4_fp8(clamp_fp8(v1[0]), clamp_fp8(v1[1]), clamp_fp8(v1[2]), clamp_fp8(v1[3])); }
                *(u32x4*)op = pair16(w[0], w[1]); }
        } else {
#pragma unroll
        for (int ai = 0; ai < 2; ++ai)
#pragma unroll
            for (int m = 0; m < 4; ++m) { const int r = r0 + ai * HALF + m * 16;
                if (r < u.valid) { const float gw = gwv[ai][m];
                    unsigned char* op = Y + (size_t)info[ai][m] * 1024 + col0;
#pragma unroll
                    for (int bj = 0; bj < 2; ++bj) { constexpr float RS = 1.0f / (SH * SW); const f32x4 v0 = (acc[ai][bj][m][0] * RS + b[bj][0]) * gw, v1 = (acc[ai][bj][m][1] * RS + b[bj][1]) * gw;
                        u32x2 w; w.x = pk4_fp8(clamp_fp8(v0[0]), clamp_fp8(v0[1]), clamp_fp8(v0[2]), clamp_fp8(v0[3])); w.y = pk4_fp8(clamp_fp8(v1[0]), clamp_fp8(v1[1]), clamp_fp8(v1[2]), clamp_fp8(v1[3]));
                        *(u32x2*)(op + bj * HALF) = w; } } }
        }
    }
};
}

#define XB_TMO      128
#define XB_XCNT(j)  (256  + 64 * (j))
#define XB_XSUB(j)  (1280 + 64 * (j))
#define XB_XGEN(j)  (2304 + 64 * (j))
#define XB_TOP      3328
#define XB_TOPGEN   3392
#define XCD_BAR_WORDS 3456
#define XB_SPIN_CAP (1u << 18)
__device__ __forceinline__ unsigned xb_ld(unsigned* p)              { return __hip_atomic_load(p, __ATOMIC_RELAXED, __HIP_MEMORY_SCOPE_AGENT); }
__device__ __forceinline__ unsigned xb_add(unsigned* p, unsigned v) { return __hip_atomic_fetch_add(p, v, __ATOMIC_RELAXED, __HIP_MEMORY_SCOPE_AGENT); }
__device__ __forceinline__ unsigned xb_xcc_id() { return (unsigned)__builtin_amdgcn_s_getreg((3 << 11) | 20) & 0xFu; }
#define XB_SPIN(cond, bar) do { unsigned _sp = 0; while (cond) { __builtin_amdgcn_s_sleep(1); \
    if ((++_sp & 255u) == 0u) { if (xb_ld(&(bar)[XB_TMO])) break; if (_sp > XB_SPIN_CAP) { atomicAdd(&(bar)[XB_TMO], 1u); break; } } } } while (0)
struct XcdBarrier { unsigned* bar; unsigned x; volatile LAS unsigned* st; };
__device__ __forceinline__ XcdBarrier xcd_barrier_post(unsigned* bar, volatile LAS unsigned* st) {
    XcdBarrier b; b.bar = bar; b.x = xb_xcc_id(); b.st = st;
    if (threadIdx.x == 0) (void)xb_add(&bar[XB_XCNT(b.x)], 1u);
    return b;
}
__device__ __forceinline__ void xcd_barrier_complete(unsigned* bar, unsigned x, unsigned& nloc, unsigned& nx) {
    const unsigned G = gridDim.x * gridDim.y * gridDim.z;
    unsigned sum, cnt, mine, sp = 0u;
    for (;;) {
        sum = 0u; cnt = 0u; mine = 0u;
#pragma unroll
        for (unsigned j = 0; j < 16; ++j) { const unsigned c = xb_ld(&bar[XB_XCNT(j)]); sum += c; cnt += (c > 0u) ? 1u : 0u; mine = (j == x) ? c : mine; }
        if (sum == G) break;
        __builtin_amdgcn_s_sleep(1);
        if ((++sp & 255u) == 0u) { if (xb_ld(&bar[XB_TMO])) break; if (sp > XB_SPIN_CAP) { atomicAdd(&bar[XB_TMO], 1u); break; } }
    }
    nloc = mine > 0u ? mine : 1u; nx = cnt > 0u ? cnt : 1u;
}
__device__ __forceinline__ void xcd_barrier(const XcdBarrier& b) {
    asm volatile("s_waitcnt vmcnt(0)" ::: "memory");
    __syncthreads();
    if (threadIdx.x == 0) {
        unsigned* bar = b.bar;
        __builtin_amdgcn_s_waitcnt(0);
        unsigned nloc = b.st[0], nx = b.st[1];
        if (nloc == 0u) { xcd_barrier_complete(bar, b.x, nloc, nx); b.st[0] = nloc; b.st[1] = nx; }
        const unsigned old = xb_add(&bar[XB_XSUB(b.x)], 1u);
        const unsigned gen = old / nloc;
        if (old + 1u == (gen + 1u) * nloc) {
            __builtin_amdgcn_fence(__ATOMIC_RELEASE, "agent");
            asm volatile("s_waitcnt vmcnt(0)" ::: "memory");
            const unsigned og = xb_add(&bar[XB_TOP], 1u);
            const unsigned tg = og / nx;
            if (og + 1u == (tg + 1u) * nx) xb_add(&bar[XB_TOPGEN], 1u);
            else XB_SPIN(xb_ld(&bar[XB_TOPGEN]) == tg, bar);
            __builtin_amdgcn_fence(__ATOMIC_ACQUIRE, "agent");
            xb_add(&bar[XB_XGEN(b.x)], 1u);
            asm volatile("s_waitcnt vmcnt(0)" ::: "memory");
        } else {
            XB_SPIN(xb_ld(&bar[XB_XGEN(b.x)]) == gen, bar);
            __builtin_amdgcn_fence(__ATOMIC_ACQUIRE, "agent");
            asm volatile("s_waitcnt vmcnt(0)" ::: "memory");
        }
    }
    __syncthreads();
}

constexpr int NWAVES = 8;
struct Frame {
    LAS unsigned char* lds; volatile LAS unsigned* MISC; gu32* ctl;
    int tid, lane, wave, vcu, G;
    unsigned char* ws; unsigned char* dout;
};
__device__ __forceinline__ float wave_sum(float v) {
#pragma unroll
    for (int o = 1; o < 64; o <<= 1) v += __shfl_xor(v, o);
    return v;
}
__device__ __forceinline__ void transpose_item(const float* W, int N, int k0, int n0, bf16_t* WT, int ldw, size_t drow0, int dcol0, LAS float* scr, int lane) {
#pragma unroll 8
    for (int i = 0; i < 32; ++i) { const int kk = 2 * i + (lane >> 5); scr[kk * 33 + (lane & 31)] = W[(size_t)(k0 + kk) * N + n0 + (lane & 31)]; }
    LDS_WAIT(); asm volatile("" ::: "memory");
    const int c = lane & 7;
#pragma unroll
    for (int j = 0; j < 4; ++j) { const int n = (lane >> 3) + 8 * j; const LAS float* s = scr + (8 * c) * 33 + n;
        u32x4 o; o.x = cvt_pk_bf16(s[0 * 33], s[1 * 33]); o.y = cvt_pk_bf16(s[2 * 33], s[3 * 33]); o.z = cvt_pk_bf16(s[4 * 33], s[5 * 33]); o.w = cvt_pk_bf16(s[6 * 33], s[7 * 33]);
        *(GAS u32x4*)(WT + (drow0 + n) * (size_t)ldw + dcol0 + 8 * c) = o; }
    LDS_WAIT(); asm volatile("" ::: "memory");
}
__device__ __forceinline__ void transpose_item_f8(const float* W, int N, int k0, int n0, unsigned char* WT, int ldw, size_t drow0, int dcol0, LAS float* scr, int lane);
__device__ __forceinline__ void p0_convert(Frame& F, const float* x, const float* w_in, const float* w_pa, const float* w_pb, const float* w_out, const float* rw) {
    LAS float* scr = (LAS float*)(F.lds + F.wave * 17408);
    const int gw = F.vcu * NWAVES + F.wave, NGW = F.G * NWAVES;
    unsigned char* WIN = F.dout + DO_WIN; unsigned char* WCAT = F.dout + DO_WCAT; unsigned char* WOUT = F.ws + WS_WOUT;
    constexpr int I_IN = (D / 128) * (IN_COLS / 32), I_OUT = (D / 128) * (D / 32), I_PA = (256 / 128) * (D / 32), I_PB = (D / 128) * (D / 32);
    for (int it = gw; it < I_IN + I_OUT + I_PA + I_PB; it += NGW) {
        int r = it;
        if (r < I_IN) { const int nb = IN_COLS / 32; transpose_item_f8(w_in, IN_COLS, 128 * (r / nb), 32 * (r % nb), WIN, D, (size_t)(32 * (r % nb)), 128 * (r / nb), scr, F.lane); continue; } r -= I_IN;
        if (r < I_OUT) { const int nb = D / 32; transpose_item_f8(w_out, D, 128 * (r / nb), 32 * (r % nb), WOUT, D, (size_t)(32 * (r % nb)), 128 * (r / nb), scr, F.lane); continue; } r -= I_OUT;
        if (r < I_PA) { const int nb = D / 32; transpose_item_f8(w_pa, D, 128 * (r / nb), 32 * (r % nb), WCAT, OAB_P, (size_t)(32 * (r % nb)), 128 * (r / nb), scr, F.lane); continue; } r -= I_PA;
        { const int nb = D / 32; transpose_item_f8(w_pb, D, 128 * (r / nb), 32 * (r % nb), WCAT, OAB_P, (size_t)(32 * (r % nb)), 256 + 128 * (r / nb), scr, F.lane); }
    }
    { bf16_t* WRT = (bf16_t*)(F.ws + WS_WRT);
      for (int i = gw * 64 + F.lane; i < NEXP * D; i += NGW * 64) { const int e = i >> 10, k = i & (D - 1); const float w = rw[k * NEXP + e];
          const unsigned hi = cvt_pk_bf16(w, 0.f) & 0xffffu; const float r = w - __uint_as_float(hi << 16);
          WRT[i] = (bf16_t)hi; WRT[NEXP * D + i] = (bf16_t)(cvt_pk_bf16(r, 0.f) & 0xffffu); } }
    unsigned char* XQ = F.dout + DO_XB;
    const size_t n16 = (size_t)NTOK * D / 16;
    for (size_t i = (size_t)gw * 64 + F.lane; i < n16; i += (size_t)NGW * 64) {
        const f32x4 a = *(const GAS f32x4*)(x + i * 16), b = *(const GAS f32x4*)(x + i * 16 + 4), c = *(const GAS f32x4*)(x + i * 16 + 8), d = *(const GAS f32x4*)(x + i * 16 + 12);
        u32x4 o;
        o.x = pk4_fp8(clamp_fp8(a[0] * SXIN), clamp_fp8(a[1] * SXIN), clamp_fp8(a[2] * SXIN), clamp_fp8(a[3] * SXIN)); o.y = pk4_fp8(clamp_fp8(b[0] * SXIN), clamp_fp8(b[1] * SXIN), clamp_fp8(b[2] * SXIN), clamp_fp8(b[3] * SXIN));
        o.z = pk4_fp8(clamp_fp8(c[0] * SXIN), clamp_fp8(c[1] * SXIN), clamp_fp8(c[2] * SXIN), clamp_fp8(c[3] * SXIN)); o.w = pk4_fp8(clamp_fp8(d[0] * SXIN), clamp_fp8(d[1] * SXIN), clamp_fp8(d[2] * SXIN), clamp_fp8(d[3] * SXIN));
        *(GAS u32x4*)(XQ + i * 16) = o;
    }
}
__device__ __forceinline__ void transpose_item_f8(const float* W, int N, int k0, int n0, unsigned char* WT, int ldw, size_t drow0, int dcol0, LAS float* scr, int lane) {
    f32x4 wv[16];
#pragma unroll
    for (int i = 0; i < 16; ++i) wv[i] = *(const GAS f32x4*)(W + (size_t)(k0 + 8 * i + (lane >> 3)) * N + n0 + (lane & 7) * 4);
#pragma unroll
    for (int i = 0; i < 16; ++i) { LAS float* d = scr + (8 * i + (lane >> 3)) * 33 + (lane & 7) * 4; d[0] = wv[i][0]; d[1] = wv[i][1]; d[2] = wv[i][2]; d[3] = wv[i][3]; }
    LDS_WAIT(); asm volatile("" ::: "memory");
    const int c = lane & 7;
#pragma unroll
    for (int j = 0; j < 4; ++j) { const int n = (lane >> 3) + 8 * j; const LAS float* s = scr + (16 * c) * 33 + n;
        u32x4 o;
        o.x = pk4_fp8(clamp_fp8(s[0 * 33] * SW), clamp_fp8(s[1 * 33] * SW), clamp_fp8(s[2 * 33] * SW), clamp_fp8(s[3 * 33] * SW));
        o.y = pk4_fp8(clamp_fp8(s[4 * 33] * SW), clamp_fp8(s[5 * 33] * SW), clamp_fp8(s[6 * 33] * SW), clamp_fp8(s[7 * 33] * SW));
        o.z = pk4_fp8(clamp_fp8(s[8 * 33] * SW), clamp_fp8(s[9 * 33] * SW), clamp_fp8(s[10 * 33] * SW), clamp_fp8(s[11 * 33] * SW));
        o.w = pk4_fp8(clamp_fp8(s[12 * 33] * SW), clamp_fp8(s[13 * 33] * SW), clamp_fp8(s[14 * 33] * SW), clamp_fp8(s[15 * 33] * SW));
        *(GAS u32x4*)(WT + (drow0 + n) * (size_t)ldw + dcol0 + 16 * c) = o; }
    LDS_WAIT(); asm volatile("" ::: "memory");
}
__device__ __forceinline__ void p3_convert_moe(Frame& F, const float* w_gate, const float* w_up, const float* w_down, int wg, int nwg) {
    LAS float* scr = (LAS float*)(F.lds + F.wave * 17408);
    const int gw = wg * NWAVES + F.wave, NGW = nwg * NWAVES;
    unsigned char* WGU = F.ws + WS_WGU; unsigned char* WD = F.ws + WS_WD;
    constexpr int IPM = (D / 128) * (DFF / 32);
    for (int it = gw; it < NEXP * 3 * IPM; it += NGW) {
        const int e = it / (3 * IPM), r3 = it % (3 * IPM), which = r3 / IPM, r = r3 % IPM, kb = r / 32, nb = r % 32, k0 = 128 * kb, n0 = 32 * nb;
        const size_t moff = (size_t)e * D * DFF;
        if (which == 2) transpose_item_f8(w_down + moff, D, k0, n0, WD + moff, DFF, (size_t)n0, k0, scr, F.lane);
        else { const int pn = n0 >> 7, jj = n0 & 127; transpose_item_f8((which ? w_up : w_gate) + moff, DFF, k0, n0, WGU + 2 * moff, D, (size_t)(256 * pn + 128 * which + jj), k0, scr, F.lane); }
    }
}
typedef short v4i16_t __attribute__((ext_vector_type(4)));
__device__ __forceinline__ s16x4 tr_read(const LAS unsigned char* p) { return __builtin_bit_cast(s16x4, __builtin_amdgcn_ds_read_tr16_b64_v4i16((LAS v4i16_t*)p)); }
template <int C>
__device__ __forceinline__ void tr_read8(s16x4 (&r)[8], unsigned addr) {
#define TRR(i) asm volatile("ds_read_b64_tr_b16 %0, %1 offset:%2" : "=v"(r[i]) : "v"(addr), "n"(C * 4096 + (i) * 512))
    TRR(0); TRR(1); TRR(2); TRR(3); TRR(4); TRR(5); TRR(6); TRR(7);
#undef TRR
}
__device__ __forceinline__ void tr_wait8(s16x4 (&r)[8]) {
    asm volatile("s_waitcnt lgkmcnt(0)" : "+v"(r[0]), "+v"(r[1]), "+v"(r[2]), "+v"(r[3]), "+v"(r[4]), "+v"(r[5]), "+v"(r[6]), "+v"(r[7]));
}
template <int C>
__device__ __forceinline__ void pv_tile(s16x4 (&cur)[8], s16x4 (&prev)[8], bf16x8 (&pf)[2], bf16x8 (&pfprev)[2], unsigned vbase, const f32x16& Sc, f32x16 (&O)[2]) {
#pragma unroll
    for (int s = 0; s < 2; ++s) { u32x4 w; w.x = cvt_pk_bf16(Sc[8 * s + 0], Sc[8 * s + 1]); w.y = cvt_pk_bf16(Sc[8 * s + 2], Sc[8 * s + 3]);
        w.z = cvt_pk_bf16(Sc[8 * s + 4], Sc[8 * s + 5]); w.w = cvt_pk_bf16(Sc[8 * s + 6], Sc[8 * s + 7]); pf[s] = __builtin_bit_cast(bf16x8, w); }
    tr_read8<C>(cur, vbase);
    if (C > 0) { asm volatile("" :: "v"(prev[0]), "v"(prev[1]), "v"(prev[2]), "v"(prev[3]), "v"(prev[4]), "v"(prev[5]), "v"(prev[6]), "v"(prev[7]) : "memory");
                 asm volatile("" :: "v"(pfprev[0]), "v"(pfprev[1]) : "memory"); }
    tr_wait8(cur);
    __builtin_amdgcn_sched_barrier(0);
#pragma unroll
    for (int blk = 0; blk < 2; ++blk)
#pragma unroll
        for (int s = 0; s < 2; ++s) { const s16x4 lo = cur[(blk * 2 + s) * 2], hi = cur[(blk * 2 + s) * 2 + 1];
            O[blk] = __builtin_amdgcn_mfma_f32_32x32x16_bf16((bf16x8){lo[0], lo[1], lo[2], lo[3], hi[0], hi[1], hi[2], hi[3]}, pf[s], O[blk], 0, 0, 0); }
    __builtin_amdgcn_sched_barrier(0);
}
constexpr int ATT_KOFF = 0, ATT_QOFF = 12 * 2048, ATT_VOFF = 12 * 4096, ATT_STG = 24 * 4096, ATT_STGW = 4608;
static_assert(ATT_STG + 8 * ATT_STGW <= SCR_BYTES, "attention LDS map");
struct AKV { const unsigned char* qseq; const unsigned char* kseq; const bf16_t* vseq; int jt0, nkt, jq; };
__device__ __forceinline__ AKV attn_kv(const Frame& F, int U) {
    const unsigned char* HQ = F.ws + WS_HQ; AKV r;
    if (U < 2048) {
        const int b = U >> 8, kvh = (U >> 7) & 1, j = U & 127, hq = kvh * 8 + F.wave;
        r.qseq = HQ + HQ_QS + (size_t)(b * 16 + hq) * SEQ * 64; r.kseq = HQ + HQ_KS + (size_t)(b * 2 + kvh) * SEQ * 64; r.vseq = (const bf16_t*)(HQ + HQ_VS) + (size_t)(b * 2 + kvh) * SEQ * 64;
        r.jt0 = j - 4; r.nkt = 5; r.jq = j;
    } else {
        const int v = U - 2048, g = v >> 9, w_ = v & 511, b = w_ >> 6, x = w_ & 63, hh = x >> 4, y = x & 15;
        const int dil = (g == 0) ? 1 : (g == 1) ? 4 : 16;
        const int res = (g == 0) ? 0 : (g == 1) ? (y >> 2) : y;
        const int j0 = (g == 0) ? y * 8 : (g == 1) ? (y & 3) * 8 : 0;
        const size_t seq = ((size_t)((g * NB + b) * 4 + hh) * SEQ + (size_t)res * (SEQ / dil)) * 64;
        r.qseq = HQ + HQ_QD + seq; r.kseq = HQ + HQ_KD + seq; r.vseq = (const bf16_t*)(HQ + HQ_VD) + seq;
        r.jt0 = j0 - 4; r.nkt = 12; r.jq = j0 + F.wave;
    }
    return r;
}
__device__ __forceinline__ unsigned attn_koff(int lane) { return (unsigned)((lane >> 2) * 64 + (((lane & 3) ^ ((lane >> 4) & 3)) * 16)); }
__device__ __forceinline__ unsigned attn_voff(int lane) { return (unsigned)((lane >> 2) * 128 + (lane & 3) * 16); }
__device__ __forceinline__ void attn_issue_k(LAS unsigned char* lds, int lane, int wave, const AKV& u) {
    const unsigned koff = attn_koff(lane);
    for (int p = wave; p < u.nkt * 2; p += 8) {
        const int s = p >> 1, qt = p & 1; const int tj = u.jt0 + s; const size_t pos0 = (size_t)(32 * (tj >= 0 ? tj : 0) + 16 * qt);
        __builtin_amdgcn_global_load_lds((const unsigned*)((const char*)u.kseq + pos0 * 64 + koff), (LAS unsigned*)(lds + ATT_KOFF + s * 2048 + qt * 1024), 16, 0, 0);
    }
}
__device__ __forceinline__ void attn_issue_q(LAS unsigned char* lds, int lane, int wave, const AKV& u) {
    const unsigned koff = attn_koff(lane);
#pragma unroll
    for (int qt = 0; qt < 2; ++qt)
        __builtin_amdgcn_global_load_lds((const unsigned*)((const char*)u.qseq + (size_t)(32 * u.jq + 16 * qt) * 64 + koff), (LAS unsigned*)(lds + ATT_QOFF + wave * 2048 + qt * 1024), 16, 0, 0);
}
template <int NKT>
__device__ __forceinline__ int attn_issue_v(LAS unsigned char* lds, int lane, int wave, const AKV& u) {
    const int w4 = (wave + 4) & 7;
    const unsigned voff = attn_voff(lane);
#pragma unroll
    for (int i = 0; i < (NKT * 4 + 7) / 8; ++i) { const int p = w4 + 8 * i;
        if (p < NKT * 4) { const int s = p >> 2, qt = p & 3; const int tj = u.jt0 + s; const int blk = qt >> 1, part = qt & 1;
            const size_t pos0 = (size_t)(32 * (tj >= 0 ? tj : 0) + 16 * part);
            __builtin_amdgcn_global_load_lds((const unsigned*)((const char*)u.vseq + pos0 * 128 + blk * 64 + voff), (LAS unsigned*)(lds + ATT_VOFF + s * 4096 + blk * 2048 + part * 1024), 16, 0, 0); } }
    return NKT == 12 ? 6 : (w4 < 4 ? 3 : 2);
}
__device__ __forceinline__ void attn_wait(int n) {
#define AW(N) asm volatile("s_waitcnt vmcnt(" #N ")" ::: "memory")
    if (n == 11) AW(11); else if (n == 8) AW(8); else if (n == 7) AW(7); else if (n == 6) AW(6); else if (n == 5) AW(5); else if (n == 4) AW(4); else if (n == 3) AW(3); else if (n == 2) AW(2); else AW(0);
#undef AW
}
template <bool swa>
__device__ __forceinline__ void attn_unit(LAS unsigned char* lds, int lane, int wave, const AKV& u, int s0,
                                          float sl2, float sink2, bf16_t* ob, unsigned op, float* lseb, unsigned lsep, bool hasn, const AKV& nx) {
    const int i32 = lane & 31, h = lane >> 5;
    const int jq = u.jq;
    constexpr float QKS = SQ * SK, RQK = 1.0f / (SQ * SK), NEG_RAW = -1.0e30f;
    f32x16 bias;
#pragma unroll
    for (int r = 0; r < 16; ++r) { const int kk = (r & 3) + 8 * (r >> 2) + 4 * h; bias[r] = sl2 * QKS * (float)(kk - i32); }
    __builtin_amdgcn_s_barrier();
    asm volatile("" ::: "memory");
    f32x16 S[5];
    float m2 = sink2;
    const int kro = i32 * 64 + h * 8, ksw = (i32 >> 2) & 3;
    long qf[4];
#pragma unroll
    for (int d0 = 0; d0 < 4; ++d0) qf[d0] = *(const LAS long*)(lds + ATT_QOFF + wave * 2048 + kro + ((d0 ^ ksw) * 16));
    long kf[2][4];
#pragma unroll
    for (int c = 0; c < 5; ++c) {
        const bool tv = (jq - 4 + c) >= 0;
        const LAS unsigned char* ks = lds + ATT_KOFF + (s0 + c) * 2048 + kro;
#pragma unroll
        for (int d0 = 0; d0 < 4; ++d0) kf[c & 1][d0] = *(const LAS long*)(ks + ((d0 ^ ksw) * 16));
        if (c > 0) asm volatile("" :: "v"(kf[(c - 1) & 1][0]), "v"(kf[(c - 1) & 1][1]), "v"(kf[(c - 1) & 1][2]), "v"(kf[(c - 1) & 1][3]) : "memory");
        f32x16 a = bias;
#pragma unroll
        for (int d0 = 0; d0 < 4; ++d0) a = __builtin_amdgcn_mfma_f32_32x32x16_fp8_fp8(kf[c & 1][d0], qf[d0], a, 0, 0, 0);
        if (c == 0 || c == 4) {
#pragma unroll
            for (int r = 0; r < 16; ++r) { const int kk = (r & 3) + 8 * (r >> 2) + 4 * h;
                const bool ok = (c == 4) ? (kk <= i32) : (swa ? (kk > i32) : (kk >= i32));
                a[r] = ok ? a[r] : NEG_RAW; }
        }
        float mt = fmaxf(fmaxf(a[0], a[1]), a[2]);
#pragma unroll
        for (int r = 3; r < 15; r += 2) mt = fmaxf(fmaxf(mt, a[r]), a[r + 1]);
        mt = fmaxf(mt, a[15]);
        m2 = fmaxf(m2, __builtin_fmaf(mt, RQK, tv ? -sl2 * (float)(32 * (4 - c)) : NEG_RAW));
        S[c] = a;
    }
    m2 = fmaxf(m2, __shfl_xor(m2, 32));
    float l = 0.f;
#pragma unroll
    for (int c = 0; c < 5; ++c) {
        const float offc = ((jq - 4 + c) >= 0 ? -sl2 * (float)(32 * (4 - c)) : NEG_RAW) - m2;
#pragma unroll
        for (int r = 0; r < 16; ++r) { const float p = __builtin_amdgcn_exp2f(__builtin_fmaf(S[c][r], RQK, offc)); S[c][r] = p; l += p; }
    }
    l += __shfl_xor(l, 32);
    l += __builtin_amdgcn_exp2f(sink2 - m2);
    asm volatile("" :: "v"(kf[0][0]), "v"(kf[0][1]), "v"(kf[0][2]), "v"(kf[0][3]), "v"(kf[1][0]), "v"(kf[1][1]), "v"(kf[1][2]), "v"(kf[1][3]) : "memory");
    asm volatile("s_waitcnt vmcnt(0) lgkmcnt(0)" : "+v"(l) :: "memory");
    __builtin_amdgcn_s_barrier();
    asm volatile("" ::: "memory");
    if (hasn) { attn_issue_k(lds, lane, wave, nx); attn_issue_q(lds, lane, wave, nx); }
    f32x16 O[2]; O[0] = (f32x16){}; O[1] = (f32x16){};
    const int vaddr0 = ((lane >> 4) & 1) * 32 + (lane & 3) * 8 + (4 * h + ((lane & 15) >> 2)) * 64;
    const unsigned vbase = (unsigned)(size_t)(lds + ATT_VOFF) + (unsigned)(s0 * 4096 + vaddr0);
    s16x4 va[2][8]; bf16x8 pf[2][2];
    pv_tile<0>(va[0], va[1], pf[0], pf[1], vbase, S[0], O); pv_tile<1>(va[1], va[0], pf[1], pf[0], vbase, S[1], O); pv_tile<2>(va[0], va[1], pf[0], pf[1], vbase, S[2], O);
    pv_tile<3>(va[1], va[0], pf[1], pf[0], vbase, S[3], O); pv_tile<4>(va[0], va[1], pf[0], pf[1], vbase, S[4], O);
    asm volatile("" :: "v"(pf[0][0]), "v"(pf[0][1]), "v"(pf[1][0]), "v"(pf[1][1]) : "memory");
    asm volatile("" :: "v"(va[0][0]), "v"(va[0][1]), "v"(va[0][2]), "v"(va[0][3]), "v"(va[0][4]), "v"(va[0][5]), "v"(va[0][6]), "v"(va[0][7]) : "memory");
    asm volatile("" :: "v"(va[1][0]), "v"(va[1][1]), "v"(va[1][2]), "v"(va[1][3]), "v"(va[1][4]), "v"(va[1][5]), "v"(va[1][6]), "v"(va[1][7]) : "memory");
    __builtin_amdgcn_s_barrier();
    asm volatile("" ::: "memory");
    int nv = 0;
    if (hasn) { if (nx.nkt == 12) nv = attn_issue_v<12>(lds, lane, wave, nx); else nv = attn_issue_v<5>(lds, lane, wave, nx); }
    const float inv = 1.0f / l;
    LAS unsigned char* stg = lds + ATT_STG + wave * ATT_STGW;
    if (swa) {
        const float is = inv * SO;
#pragma unroll
        for (int blk = 0; blk < 2; ++blk)
#pragma unroll
            for (int g4 = 0; g4 < 4; ++g4) { const int d0 = blk * 32 + 8 * g4 + 4 * h;
                *(LAS unsigned*)(stg + i32 * 80 + d0) = pk4_fp8_pad(clamp_fp8(O[blk][4 * g4 + 0] * is), clamp_fp8(O[blk][4 * g4 + 1] * is), clamp_fp8(O[blk][4 * g4 + 2] * is), clamp_fp8(O[blk][4 * g4 + 3] * is)); }
        asm volatile("s_waitcnt lgkmcnt(0)" ::: "memory");
#pragma unroll
        for (int it = 0; it < 2; ++it) { const int row = it * 16 + (lane >> 2), ch = lane & 3;
            const u32x4 v = *(const LAS u32x4*)(stg + row * 80 + ch * 16);
            *(u32x4*)((char*)ob + (size_t)(32 * jq + row) * op + ch * 16) = v; }
    } else {
#pragma unroll
        for (int blk = 0; blk < 2; ++blk)
#pragma unroll
            for (int g4 = 0; g4 < 4; ++g4) { const int d0 = blk * 32 + 8 * g4 + 4 * h;
                u32x2 w; w.x = cvt_pk_bf16(O[blk][4 * g4 + 0] * inv, O[blk][4 * g4 + 1] * inv); w.y = cvt_pk_bf16(O[blk][4 * g4 + 2] * inv, O[blk][4 * g4 + 3] * inv);
                *(LAS u32x2*)(stg + i32 * 144 + d0 * 2) = w; }
        asm volatile("s_waitcnt lgkmcnt(0)" ::: "memory");
#pragma unroll
        for (int it = 0; it < 4; ++it) { const int row = it * 8 + (lane >> 3), ch = lane & 7;
            const u32x4 v = *(const LAS u32x4*)(stg + row * 144 + ch * 16);
            *(u32x4*)((char*)ob + (size_t)(32 * jq + row) * op + ch * 16) = v; }
    }
    if (lseb != nullptr && h == 0) lseb[(size_t)(32 * jq + i32) * lsep] = (m2 + __builtin_amdgcn_logf(l)) * LN2;
    attn_wait(hasn ? nv + (swa ? 2 : 5) : 0);
}
__device__ __forceinline__ void p2_attention(Frame& F, const float* sinks) {
    unsigned char* OAB = F.dout + DO_OAB; bf16_t* OAG = (bf16_t*)(F.ws + WS_OAG); float* LSE = (float*)(F.ws + WS_LSE);
    constexpr int NUNIT = 2048 + 1536;
    int U = F.vcu; if (U >= NUNIT) return;
    float snk0 = sinks[F.wave] * LOG2E, snk1 = sinks[8 + F.wave] * LOG2E;
    asm volatile("" : "+v"(snk0), "+v"(snk1));
    AKV cur = attn_kv(F, U);
    attn_issue_k(F.lds, F.lane, F.wave, cur);
    attn_issue_q(F.lds, F.lane, F.wave, cur);
    { const int nv0 = (cur.nkt == 12) ? attn_issue_v<12>(F.lds, F.lane, F.wave, cur) : attn_issue_v<5>(F.lds, F.lane, F.wave, cur); attn_wait(nv0); }
    for (;;) {
        const int Un = U + F.G; const bool hasn = Un < NUNIT;
        const AKV nxt = attn_kv(F, hasn ? Un : U);
        if (U < 2048) {
            const int b = U >> 8, kvh = (U >> 7) & 1, hq = kvh * 8 + F.wave;
            const float slope = exp2f(-8.0f * (float)(hq + 1) / 28.0f);
            attn_unit<true>(F.lds, F.lane, F.wave, cur, 0, slope * LOG2E, kvh ? snk1 : snk0, (bf16_t*)(OAB + (size_t)b * SEQ * OAB_P + 256 + hq * 64), OAB_P, nullptr, 0, hasn, nxt);
        } else {
            const int v = U - 2048, g = v >> 9, w_ = v & 511, b = w_ >> 6, x = w_ & 63, hh = x >> 4, y = x & 15;
            const int dil = (g == 0) ? 1 : (g == 1) ? 4 : 16;
            const int res = (g == 0) ? 0 : (g == 1) ? (y >> 2) : y;
            const size_t tok0 = (size_t)b * SEQ + res;
            const float slope = exp2f(-8.0f * (float)(16 + g * 4 + hh + 1) / 28.0f);
            attn_unit<false>(F.lds, F.lane, F.wave, cur, F.wave, slope * (float)dil * LOG2E, NEG_BIG,
                             OAG + ((size_t)g * NTOK + tok0) * 256 + hh * 64, (unsigned)(dil * 256 * 2), LSE + ((size_t)g * NTOK + tok0) * 4 + hh, (unsigned)(dil * 4), hasn, nxt);
        }
        if (!hasn) break;
        U = Un; cur = nxt;
    }
}
__device__ __forceinline__ void p3_merge(Frame& F) {
    const bf16_t* OAG = (const bf16_t*)(F.ws + WS_OAG); const float* LSE = (const float*)(F.ws + WS_LSE); unsigned char* OAB = F.dout + DO_OAB;
    const int gw = F.vcu * NWAVES + F.wave, NGW = F.G * NWAVES;
    for (int idx = gw; idx < NTOK / 2; idx += NGW) {
        const int tok = idx * 2 + (F.lane >> 5), c8 = F.lane & 31, hh = c8 >> 3;
        float ls[3]; u32x4 o[3];
#pragma unroll
        for (int g = 0; g < 3; ++g) { ls[g] = LSE[((size_t)g * NTOK + tok) * 4 + hh]; o[g] = *(const u32x4*)(OAG + ((size_t)g * NTOK + tok) * 256 + c8 * 8); }
        const float m = fmaxf(fmaxf(ls[0], ls[1]), ls[2]);
        float w[3]; float sum = 0.f;
#pragma unroll
        for (int g = 0; g < 3; ++g) { w[g] = __builtin_amdgcn_exp2f((ls[g] - m) * LOG2E); sum += w[g]; }
        const float is = 1.0f / sum; float r[8];
#pragma unroll
        for (int q = 0; q < 8; ++q) r[q] = 0.f;
#pragma unroll
        for (int g = 0; g < 3; ++g) { const float wg = w[g] * is;
            r[0] += wg * bf_lo(o[g].x); r[1] += wg * bf_hi(o[g].x); r[2] += wg * bf_lo(o[g].y); r[3] += wg * bf_hi(o[g].y);
            r[4] += wg * bf_lo(o[g].z); r[5] += wg * bf_hi(o[g].z); r[6] += wg * bf_lo(o[g].w); r[7] += wg * bf_hi(o[g].w); }
        u32x2 out; out.x = pk4_fp8(clamp_fp8(r[0] * SO), clamp_fp8(r[1] * SO), clamp_fp8(r[2] * SO), clamp_fp8(r[3] * SO)); out.y = pk4_fp8(clamp_fp8(r[4] * SO), clamp_fp8(r[5] * SO), clamp_fp8(r[6] * SO), clamp_fp8(r[7] * SO));
        *(u32x2*)(OAB + (size_t)tok * OAB_P + c8 * 8) = out;
    }
}

__device__ __forceinline__ void p6_router(Frame& F, const bf16_t* y, const float* stat, const float* gam, const float* bet, bf16_t* x1b, unsigned char* x1q, const float* rb, int cw_ecnt, size_t pe_off) {
    constexpr int WPITCH = 2064;
    constexpr int WIMG = 64 * WPITCH;
    constexpr int GOFF = WIMG + 2048;
    static_assert(GOFF + 8192 <= SCR_BYTES, "router LDS map");
    LAS int* wcnt = (LAS int*)(F.lds + WIMG + F.wave * 256); LAS int* wbase = wcnt + 32;
    int* petok = (int*)(F.ws + WS_PETOK + pe_off); float* pegate = (float*)(F.ws + WS_PEGATE + pe_off);
    const bf16_t* WRT = (const bf16_t*)(F.ws + WS_WRT);
    const int gw = F.vcu * NWAVES + F.wave, NGW = F.G * NWAVES, lane = F.lane, j = lane & 15, kq = lane >> 4;
    __syncthreads();
    for (int q = F.tid; q < 64 * 128; q += NWAVES * 64) { const u32x4 v = *(const u32x4*)((const char*)WRT + (size_t)q * 16); *(LAS u32x4*)(F.lds + (q >> 7) * WPITCH + (q & 127) * 16) = v; }
    for (int q = F.tid; q < 512; q += NWAVES * 64) { const f32x4 v = (q < 256) ? *(const f32x4*)(gam + q * 4) : *(const f32x4*)(bet + (q - 256) * 4); *(LAS f32x4*)(F.lds + GOFF + q * 16) = v; }
    __syncthreads();
    const LAS unsigned char* wrow = F.lds + j * WPITCH + kq * 16;
    const LAS float* gl = (const LAS float*)(F.lds + GOFF) + 8 * kq; const LAS float* bl = gl + 1024;
    for (int tb = F.vcu * NWAVES; tb < NTOK / 16; tb += NGW) {
        const int tt = tb + F.wave; const bool valid = tt < NTOK / 16; const int t0 = (valid ? tt : 0) * 16;
        float mean, rstd;
        { const f32x4* sp = (const f32x4*)(stat + (size_t)(t0 + j) * 32); float s1 = 0.f, s2 = 0.f;
#pragma unroll
          for (int q = 0; q < 8; ++q) { const f32x4 v = sp[q]; s1 += v[0] + v[2]; s2 += v[1] + v[3]; }
          mean = s1 * (1.0f / D); const float var = fmaxf(s2 * (1.0f / D) - mean * mean, 0.f); rstd = 1.0f / sqrtf(var + LN_EPS); }
        f32x4 acc[2]; acc[0] = (f32x4){0.f, 0.f, 0.f, 0.f}; acc[1] = acc[0];
        const bf16_t* yrow = y + (size_t)(t0 + j) * D + 8 * kq;
        bf16_t* xbrow = (valid ? x1b : (bf16_t*)(F.ws + 300 * MiB)) + (size_t)(t0 + j) * D + 8 * kq; unsigned char* xqrow = (valid ? x1q : F.ws + 300 * MiB) + (size_t)(t0 + j) * D + 8 * kq;
        bf16x8 wf[2][4]; wf[1][0] = (bf16x8){}; wf[1][1] = wf[1][0]; wf[1][2] = wf[1][0]; wf[1][3] = wf[1][0];
        u32x4 yv[4], yn[4];
#pragma unroll
        for (int u = 0; u < 4; ++u) yv[u] = *(const u32x4*)(yrow + 32 * u);
#pragma unroll 1
        for (int so = 0; so < D / 32; so += 4) {
            const int sn = (so + 4 < D / 32) ? so + 4 : so;
#pragma unroll
            for (int u = 0; u < 4; ++u) yn[u] = *(const u32x4*)(yrow + 32 * (sn + u));
#pragma unroll
            for (int u = 0; u < 4; ++u) { const int sI = so + u;
                wf[u & 1][0] = *(const LAS bf16x8*)(wrow + 64 * sI); wf[u & 1][1] = *(const LAS bf16x8*)(wrow + 16 * WPITCH + 64 * sI);
                wf[u & 1][2] = *(const LAS bf16x8*)(wrow + 32 * WPITCH + 64 * sI); wf[u & 1][3] = *(const LAS bf16x8*)(wrow + 48 * WPITCH + 64 * sI);
                const f32x4 g0 = *(const LAS f32x4*)(gl + 32 * sI), g1 = *(const LAS f32x4*)(gl + 32 * sI + 4), b0 = *(const LAS f32x4*)(bl + 32 * sI), b1 = *(const LAS f32x4*)(bl + 32 * sI + 4);
                asm volatile("" :: "v"(wf[(u + 1) & 1][0]), "v"(wf[(u + 1) & 1][1]), "v"(wf[(u + 1) & 1][2]), "v"(wf[(u + 1) & 1][3]) : "memory");
                f32x4 n0, n1;
                n0[0] = (bf_lo(yv[u].x) - mean) * rstd * g0[0] + b0[0]; n0[1] = (bf_hi(yv[u].x) - mean) * rstd * g0[1] + b0[1]; n0[2] = (bf_lo(yv[u].y) - mean) * rstd * g0[2] + b0[2]; n0[3] = (bf_hi(yv[u].y) - mean) * rstd * g0[3] + b0[3];
                n1[0] = (bf_lo(yv[u].z) - mean) * rstd * g1[0] + b1[0]; n1[1] = (bf_hi(yv[u].z) - mean) * rstd * g1[1] + b1[1]; n1[2] = (bf_lo(yv[u].w) - mean) * rstd * g1[2] + b1[2]; n1[3] = (bf_hi(yv[u].w) - mean) * rstd * g1[3] + b1[3];
                u32x4 xw; xw.x = cvt_pk_bf16(n0[0], n0[1]); xw.y = cvt_pk_bf16(n0[2], n0[3]); xw.z = cvt_pk_bf16(n1[0], n1[1]); xw.w = cvt_pk_bf16(n1[2], n1[3]);
                *(u32x4*)(xbrow + 32 * sI) = xw;
                { u32x2 q8; q8.x = pk4_fp8(clamp_fp8(n0[0] * SX), clamp_fp8(n0[1] * SX), clamp_fp8(n0[2] * SX), clamp_fp8(n0[3] * SX)); q8.y = pk4_fp8(clamp_fp8(n1[0] * SX), clamp_fp8(n1[1] * SX), clamp_fp8(n1[2] * SX), clamp_fp8(n1[3] * SX));
                  *(u32x2*)(xqrow + 32 * sI) = q8; }
                const bf16x8 xh = __builtin_bit_cast(bf16x8, xw);
                acc[0] = __builtin_amdgcn_mfma_f32_16x16x32_bf16(wf[u & 1][0], xh, acc[0], 0, 0, 0); acc[1] = __builtin_amdgcn_mfma_f32_16x16x32_bf16(wf[u & 1][1], xh, acc[1], 0, 0, 0);
                acc[0] = __builtin_amdgcn_mfma_f32_16x16x32_bf16(wf[u & 1][2], xh, acc[0], 0, 0, 0); acc[1] = __builtin_amdgcn_mfma_f32_16x16x32_bf16(wf[u & 1][3], xh, acc[1], 0, 0, 0); }
#pragma unroll
            for (int u = 0; u < 4; ++u) yv[u] = yn[u];
        }
        float lg[8];
#pragma unroll
        for (int q = 0; q < 8; ++q) lg[q] = acc[q >> 2][q & 3] + rb[16 * (q >> 2) + 4 * kq + (q & 3)];
        unsigned taken = 0u; float tv[4]; int ti[4];
#pragma unroll
        for (int k = 0; k < 4; ++k) {
            float bv = -3.0e38f; int bi = 64;
#pragma unroll
            for (int q = 0; q < 8; ++q) { const bool free_ = ((taken >> q) & 1u) == 0u; if (free_ && lg[q] > bv) { bv = lg[q]; bi = 16 * (q >> 2) + 4 * kq + (q & 3); } }
            const int mybi = bi;
#pragma unroll
            for (int o = 16; o < 64; o <<= 1) { const float ov = __shfl_xor(bv, o); const int oi = __shfl_xor(bi, o); const bool keep = (bv > ov) || (bv == ov && bi < oi); bv = keep ? bv : ov; bi = keep ? bi : oi; }
            tv[k] = bv; ti[k] = bi;
            if (bi == mybi && ((bi >> 2) & 3) == kq) taken |= 1u << (4 * (bi >> 4) + (bi & 3));
        }
        float gk[4]; float gs = 0.f;
#pragma unroll
        for (int k = 0; k < 4; ++k) { gk[k] = __builtin_amdgcn_exp2f((tv[k] - tv[0]) * LOG2E); gs += gk[k]; }
        const float gi = 1.0f / gs;
        if (lane < 32) wcnt[lane] = 0;
        asm volatile("s_waitcnt lgkmcnt(0)" ::: "memory");
        const int e0 = (kq == 0) ? ti[0] : (kq == 1) ? ti[1] : (kq == 2) ? ti[2] : ti[3];
        const float g0 = ((kq == 0) ? gk[0] : (kq == 1) ? gk[1] : (kq == 2) ? gk[2] : gk[3]) * gi;
        int r0 = 0;
        if (valid) r0 = __hip_atomic_fetch_add(wcnt + e0, 1, __ATOMIC_RELAXED, __HIP_MEMORY_SCOPE_WORKGROUP);
        asm volatile("s_waitcnt lgkmcnt(0)" ::: "memory");
        __syncthreads();
        if (F.wave == 0 && lane < 32) { int c[NWAVES]; int tot = 0;
#pragma unroll
            for (int w = 0; w < NWAVES; ++w) { c[w] = *(LAS int*)(F.lds + WIMG + w * 256 + 4 * lane); tot += c[w]; }
            int b = 0; if (tot > 0) b = (int)__hip_atomic_fetch_add((unsigned*)(F.ctl + cw_ecnt + 64 * lane), (unsigned)tot, RLX_AGENT);
#pragma unroll
            for (int w = 0; w < NWAVES; ++w) { *(LAS int*)(F.lds + WIMG + w * 256 + 128 + 4 * lane) = b; b += c[w]; } }
        asm volatile("s_waitcnt vmcnt(0) lgkmcnt(0)" ::: "memory");
        __syncthreads();
        if (valid) { const int p0 = wbase[e0] + r0;
            petok[(size_t)e0 * NTOK + p0] = (t0 + j) * 4 + kq; pegate[(size_t)e0 * NTOK + p0] = g0; }
        asm volatile("s_waitcnt lgkmcnt(0)" ::: "memory");
        __syncthreads();
    }
}
__device__ __forceinline__ int moe_tables(Frame& F) {
    LAS int* cnt = (LAS int*)(F.lds + MOE_OFF); LAS int* fs = (LAS int*)(F.lds + MOE_OFF + 128); LAS unsigned char* te = F.lds + MOE_OFF + 128 + 136;
    __syncthreads();
    if (F.tid < NEXP) cnt[F.tid] = (int)__hip_atomic_load(F.ctl + CW_ECNT + 64 * F.tid, RLX_AGENT);
    __syncthreads();
    if (F.tid == 0) { int s = 0; for (int e = 0; e < NEXP; ++e) { fs[e] = s; s += (cnt[e] + 255) >> 8; } fs[NEXP] = s; }
    __syncthreads();
    const int T = fs[NEXP];
    for (int t = F.tid; t < T; t += NWAVES * 64) { int e = 0;
#pragma unroll 8
        for (int q = 1; q < NEXP; ++q) e += (fs[q] <= t) ? 1 : 0;
        te[t] = (unsigned char)e; }
    __syncthreads();
    return T;
}
__device__ __forceinline__ void p9_final(Frame& F, const float* gam, const float* bet, const float* out, float* outw, bool poison) {
    const bf16_t* X1B = (const bf16_t*)(F.ws + WS_X1B);
    const int gw = F.vcu * NWAVES + F.wave, NGW = F.G * NWAVES, lane = F.lane;
    const float qnan = __builtin_nanf("");
    const f32x4 g0 = *(const f32x4*)(gam + lane * 16), g1 = *(const f32x4*)(gam + lane * 16 + 4), g2 = *(const f32x4*)(gam + lane * 16 + 8), g3 = *(const f32x4*)(gam + lane * 16 + 12);
    const f32x4 b0 = *(const f32x4*)(bet + lane * 16), b1 = *(const f32x4*)(bet + lane * 16 + 4), b2 = *(const f32x4*)(bet + lane * 16 + 8), b3 = *(const f32x4*)(bet + lane * 16 + 12);
    for (int tok0 = gw; tok0 < NTOK; tok0 += 2 * NGW) {
        u32x4 xa[2], xb[2], y0[2], y1[2], y2[2], y3[2];
#pragma unroll
        for (int tI = 0; tI < 2; ++tI) { const int tok = min(tok0 + tI * NGW, NTOK - 1);
            const unsigned char* y = (const unsigned char*)out + (size_t)tok * 4096 + lane * 16;
            xa[tI] = *(const u32x4*)(X1B + (size_t)tok * D + lane * 16); xb[tI] = *(const u32x4*)(X1B + (size_t)tok * D + lane * 16 + 8);
            y0[tI] = *(const u32x4*)(y); y1[tI] = *(const u32x4*)(y + 1024); y2[tI] = *(const u32x4*)(y + 2048); y3[tI] = *(const u32x4*)(y + 3072); }
#pragma unroll
        for (int tI = 0; tI < 2; ++tI) { const int tok = tok0 + tI * NGW; if (tok >= NTOK) break;
            float v[16];
#pragma unroll
            for (int w = 0; w < 4; ++w) { const unsigned xw = (w < 2) ? xa[tI][2 * w] : xb[tI][2 * (w - 2)], xw2 = (w < 2) ? xa[tI][2 * w + 1] : xb[tI][2 * (w - 2) + 1];
                v[4 * w + 0] = DN_ALPHA * bf_lo(xw); v[4 * w + 1] = DN_ALPHA * bf_hi(xw); v[4 * w + 2] = DN_ALPHA * bf_lo(xw2); v[4 * w + 3] = DN_ALPHA * bf_hi(xw2);
                f32x2 lo = __builtin_amdgcn_cvt_pk_f32_fp8((int)y0[tI][w], false) + __builtin_amdgcn_cvt_pk_f32_fp8((int)y1[tI][w], false) + __builtin_amdgcn_cvt_pk_f32_fp8((int)y2[tI][w], false) + __builtin_amdgcn_cvt_pk_f32_fp8((int)y3[tI][w], false);
                f32x2 hi = __builtin_amdgcn_cvt_pk_f32_fp8((int)y0[tI][w], true) + __builtin_amdgcn_cvt_pk_f32_fp8((int)y1[tI][w], true) + __builtin_amdgcn_cvt_pk_f32_fp8((int)y2[tI][w], true) + __builtin_amdgcn_cvt_pk_f32_fp8((int)y3[tI][w], true);
                v[4 * w + 0] += lo[0] * (1.0f / SY); v[4 * w + 1] += lo[1] * (1.0f / SY); v[4 * w + 2] += hi[0] * (1.0f / SY); v[4 * w + 3] += hi[1] * (1.0f / SY); }
            float s = 0.f;
#pragma unroll
            for (int q = 0; q < 16; ++q) s += v[q];
            const float mean = wave_sum(s) * (1.0f / D); float s2 = 0.f;
#pragma unroll
            for (int q = 0; q < 16; ++q) { v[q] -= mean; s2 += v[q] * v[q]; }
            const float rstd = 1.0f / sqrtf(wave_sum(s2) * (1.0f / D) + LN_EPS);
            f32x4 o0, o1, o2, o3;
#pragma unroll
            for (int q = 0; q < 4; ++q) { o0[q] = v[q] * rstd * g0[q] + b0[q]; o1[q] = v[4 + q] * rstd * g1[q] + b1[q]; o2[q] = v[8 + q] * rstd * g2[q] + b2[q]; o3[q] = v[12 + q] * rstd * g3[q] + b3[q]; }
            if (poison) { o0 = (f32x4){qnan, qnan, qnan, qnan}; o1 = o0; o2 = o0; o3 = o0; }
            float* op = outw + (size_t)tok * D + lane * 16;
            *(f32x4*)(op) = o0; *(f32x4*)(op + 4) = o1; *(f32x4*)(op + 8) = o2; *(f32x4*)(op + 12) = o3; }
    }
}
#define CAS __attribute__((address_space(4)))
__device__ __forceinline__ const float* arg_in(int i) {
    const unsigned char CAS* ka = (const unsigned char CAS*)__builtin_amdgcn_kernarg_segment_ptr();
    asm volatile("" : "+s"(ka));
    return *(const float* const CAS*)(ka + 8 * i);
}
struct Args { const float* in[18]; float* out; unsigned char* ws; int ph_lo, ph_hi; };
__global__ void __launch_bounds__(NWAVES * 64, 2) fwd_kernel(Args args) {
    extern __shared__ __attribute__((aligned(16))) unsigned char lds[];
    Frame F;
    F.lds = (LAS unsigned char*)lds;
    F.MISC = (volatile LAS unsigned*)(F.lds + MISC_OFF);
    F.tid = threadIdx.x; F.lane = F.tid & 63; F.wave = __builtin_amdgcn_readfirstlane(F.tid >> 6);
    F.G = gridDim.x; { const int bx = blockIdx.x; F.vcu = (F.G % 8 == 0) ? (bx % 8) * (F.G / 8) + bx / 8 : bx; }
    F.ws = args.ws; F.dout = (unsigned char*)args.out;
    F.ctl = (gu32*)(args.ws + WS_CTL);
    for (int u = F.tid; u < (LDS_BYTES - LDSCTL_OFF) / 4; u += NWAVES * 64) ((LAS unsigned*)(F.lds + LDSCTL_OFF))[u] = 0u;
    __syncthreads();
    XcdBarrier bar; bar.bar = (unsigned*)(F.ctl + CW_BAR); bar.x = 0; bar.st = nullptr;
    if (N_LAUNCHES == 1) bar = xcd_barrier_post((unsigned*)(F.ctl + CW_BAR), F.MISC + 8);
    const int lo = args.ph_lo, hi = args.ph_hi;
#ifdef ONLY_PHASE
#define IN(k) ((k) == ONLY_PHASE && lo <= (k) && (k) < hi)
#else
#define IN(k) (lo <= (k) && (k) < hi)
#endif
#define SEAM(k) do { if (IN(k) && IN((k) + 1)) xcd_barrier(bar); } while (0)
    unsigned char* HQ = F.ws + WS_HQ; unsigned char* SG = F.ws + WS_SG;

#define PHASE(k, ...) do { if (IN(k)) { __VA_ARGS__ if (DUP_PHASE == (k)) { __VA_ARGS__ } } } while (0)
    PHASE(0, p0_convert(F, arg_in(0), arg_in(1), arg_in(3), arg_in(4), arg_in(5), arg_in(8));); SEAM(0);
    PHASE(1,
        { const int gemm_wgs = (F.G == 256) ? 192 : F.G;
          if ((int)blockIdx.x < gemm_wgs) {
            pg8::Gemm g{(const char*)(F.dout + DO_XB), (const char*)(F.dout + DO_WIN), D, D, D / 128}; pg8::StaticOrder S; S.init(NTOK, IN_COLS, gemm_wgs, (int)blockIdx.x);
            pg8::EpiInProj E{HQ, SG, 1.0f / (SXIN * SW)};
            pg8::gemm_phase<pg8::EpiInProj, pg8::StaticOrder, true, false, true>(F.lds, g, S, E); }
          if (gemm_wgs == F.G) p3_convert_moe(F, arg_in(10), arg_in(12), arg_in(14), F.vcu, F.G);
          else if ((int)blockIdx.x >= gemm_wgs) p3_convert_moe(F, arg_in(10), arg_in(12), arg_in(14), (int)blockIdx.x - gemm_wgs, F.G - gemm_wgs); }
    ); SEAM(1);
    PHASE(2, p2_attention(F, arg_in(2));); SEAM(2);
    PHASE(3, p3_merge(F);); SEAM(3);
    PHASE(4,
        { pg8::Gemm g{(const char*)(F.dout + DO_OAB), (const char*)(F.dout + DO_WCAT), OAB_P, OAB_P, OAB_P / 128}; pg8::StaticOrder S; S.init(NTOK, D, F.G, (int)blockIdx.x);
        pg8::EpiGate E{SG, F.ws + WS_MRG};
        pg8::gemm_phase<pg8::EpiGate, pg8::StaticOrder, true, false, true>(F.lds, g, S, E); }
    ); SEAM(4);
    PHASE(5,
        { pg8::Gemm g{(const char*)(F.ws + WS_MRG), (const char*)(F.ws + WS_WOUT), D, D, D / 128}; pg8::StaticOrder S; S.init(NTOK, D, F.G, (int)blockIdx.x);
        pg8::EpiY E{arg_in(0), (bf16_t*)(F.ws + WS_Y), (float*)(F.ws + WS_STAT), 1.0f / (SM * SW)};
        pg8::gemm_phase<pg8::EpiY, pg8::StaticOrder, true, false, true>(F.lds, g, S, E); }
    ); SEAM(5);
    if (IN(6)) { if (DUP_PHASE == 6) p6_router(F, (const bf16_t*)(F.ws + WS_Y), (const float*)(F.ws + WS_STAT), arg_in(6), arg_in(7), (bf16_t*)(F.ws + 264 * MiB), F.ws + 330 * MiB, arg_in(9), CW_ECNT + 64 * NEXP, (size_t)362 * MiB - WS_PETOK);
        p6_router(F, (const bf16_t*)(F.ws + WS_Y), (const float*)(F.ws + WS_STAT), arg_in(6), arg_in(7), (bf16_t*)(F.ws + WS_X1B), F.ws + WS_X1Q, arg_in(9), CW_ECNT, 0); } SEAM(6);
    PHASE(7,
        { const int T = moe_tables(F);
        pg8::Gemm g{(const char*)(F.ws + WS_X1Q), (const char*)(F.ws + WS_WGU), D, D, D / 128};
        pg8::MoeOrder S{T, 8, F.G, (int)blockIdx.x, (const LAS int*)(F.lds + MOE_OFF), (const LAS int*)(F.lds + MOE_OFF + 128), (const LAS unsigned char*)(F.lds + MOE_OFF + 128 + 136),
                        (const int*)(F.ws + WS_PETOK), (size_t)2048 * D, true, (unsigned)D};
        pg8::EpiGU E{arg_in(11), arg_in(13), F.ws + WS_HDN, F.lds};
        pg8::gemm_phase<pg8::EpiGU, pg8::MoeOrder, true, true, true>(F.lds, g, S, E); }
    ); SEAM(7);
    PHASE(8,
        { const int T = moe_tables(F);
        pg8::Gemm g{(const char*)(F.ws + WS_HDN), (const char*)(F.ws + WS_WD), DFF, DFF, DFF / 128};
        pg8::MoeOrder S{T, 4, F.G, (int)blockIdx.x, (const LAS int*)(F.lds + MOE_OFF), (const LAS int*)(F.lds + MOE_OFF + 128), (const LAS unsigned char*)(F.lds + MOE_OFF + 128 + 136),
                        (const int*)(F.ws + WS_PETOK), (size_t)D * DFF, false, 0u};
        pg8::EpiDown E{arg_in(15), (const int*)(F.ws + WS_PETOK), (const float*)(F.ws + WS_PEGATE), F.dout, F.lds};
        pg8::gemm_phase<pg8::EpiDown, pg8::MoeOrder, true, false, true>(F.lds, g, S, E); }
    ); SEAM(8);
    if (IN(9)) {
        bool poison = (__hip_atomic_load(F.ctl + CW_TMO, RLX_AGENT) != 0u) || (__hip_atomic_load(F.ctl + CW_BAR + XB_TMO, RLX_AGENT) != 0u);
        if (DUP_PHASE == 9) p9_final(F, arg_in(16), arg_in(17), (const float*)F.dout, (float*)(F.ws + 194 * MiB), poison);
        p9_final(F, arg_in(16), arg_in(17), (const float*)F.dout, (float*)F.dout, poison);
    }
#undef PHASE
#undef IN
#undef SEAM
}

extern "C" void kernel_launch(void* const* d_in, const int* in_sizes, int n_in, void* d_out, int out_size, void* d_ws, size_t ws_size, hipStream_t stream) {
    static int grid = 0;
    if (grid == 0) {
        if (n_in != 18 || in_sizes[0] != NTOK * D || out_size != NTOK * D || ws_size < WS_END) { fprintf(stderr, "kernel_launch: unexpected shapes (n_in %d, ws %zu); nothing launched\n", n_in, ws_size); grid = -1; return; }
        int dev = 0, cus = 0, per_cu = 0;
        if (hipGetDevice(&dev) != hipSuccess || hipDeviceGetAttribute(&cus, hipDeviceAttributeMultiprocessorCount, dev) != hipSuccess) { grid = -1; return; }
        if (hipFuncSetAttribute((const void*)fwd_kernel, hipFuncAttributeMaxDynamicSharedMemorySize, LDS_BYTES) != hipSuccess) { fprintf(stderr, "kernel_launch: hipFuncSetAttribute failed\n"); grid = -1; return; }
        if (hipOccupancyMaxActiveBlocksPerMultiprocessor(&per_cu, (const void*)fwd_kernel, NWAVES * 64, LDS_BYTES) != hipSuccess || per_cu < 1) fprintf(stderr, "kernel_launch: occupancy query reports %d\n", per_cu);
        (void)hipGetLastError();
        grid = cus;
    }
    if (grid < 0) return;
    if (hipMemsetAsync((char*)d_ws + WS_CTL, 0, CTL_ZERO_BYTES, stream) != hipSuccess) return;
    Args a{};
    for (int i = 0; i < 18; ++i) a.in[i] = (const float*)d_in[i];
    a.out = (float*)d_out; a.ws = (unsigned char*)d_ws;
    if (N_LAUNCHES == 1) { a.ph_lo = 0; a.ph_hi = N_PHASES; hipLaunchKernelGGL(fwd_kernel, dim3(grid), dim3(NWAVES * 64), LDS_BYTES, stream, a); }
    else for (int p = 0; p < N_PHASES; ++p) { a.ph_lo = p; a.ph_hi = p + 1; hipLaunchKernelGGL(fwd_kernel, dim3(grid), dim3(NWAVES * 64), LDS_BYTES, stream, a); }
}
```

```cpp
#include <hip/hip_runtime.h>
#include <cstdio>
#include <cstdint>

#define GAS __attribute__((address_space(1)))
#define LAS __attribute__((address_space(3)))
typedef unsigned short bf16_t;
typedef short bf16x8 __attribute__((ext_vector_type(8)));
typedef short s16x4 __attribute__((ext_vector_type(4)));
typedef float f32x2 __attribute__((ext_vector_type(2)));
typedef float f32x4 __attribute__((ext_vector_type(4)));
typedef float f32x16 __attribute__((ext_vector_type(16)));
typedef unsigned u32x2 __attribute__((ext_vector_type(2)));
typedef unsigned u32x4 __attribute__((ext_vector_type(4)));
typedef GAS unsigned gu32;

#ifndef MK_N_LAUNCHES
#define MK_N_LAUNCHES 1
#endif
#ifndef DUP_PHASE
#define DUP_PHASE -1
#endif
constexpr int N_PHASES = 10;
constexpr int N_LAUNCHES = MK_N_LAUNCHES;

constexpr int NB = 8, SEQ = 4096, D = 1024, NTOK = NB * SEQ;
constexpr int HQ_P = 3584;
constexpr int SG_P = 2048;
constexpr int OAB_P = 1280;
constexpr int IN_COLS = 5632;
constexpr int NEXP = 32, TOPK = 4, DFF = 1024;
constexpr int MAX_MT = 544;
constexpr float LN_EPS = 1e-5f;
constexpr float DN_ALPHA = 1.189207115002721f;
constexpr float LOG2E = 1.4426950408889634f, LN2 = 0.6931471805599453f;
constexpr float QSCALE = 0.125f * LOG2E;
constexpr float NEG_BIG = -1e30f;

constexpr size_t MiB = 1u << 20;
constexpr size_t WS_CTL = 0, CTL_ZERO_BYTES = 1 * MiB;
constexpr size_t WS_XBUF = 1 * MiB;
constexpr size_t WS_Y = 194 * MiB;
constexpr size_t WS_STAT = 258 * MiB;
constexpr size_t WS_HQ = 2 * MiB;
constexpr size_t HQ_QD = 0, HQ_KD = 48 * MiB, HQ_VD = 96 * MiB, HQ_QS = 144 * MiB, HQ_KS = 208 * MiB, HQ_VS = 216 * MiB;
constexpr size_t WS_WGU = 404 * MiB;
constexpr size_t WS_WD = 468 * MiB;
constexpr size_t WS_X1B = 98 * MiB;
constexpr size_t WS_X1Q = 162 * MiB;
constexpr size_t WS_HDN = 194 * MiB;
constexpr size_t WS_SG = 226 * MiB;
constexpr size_t WS_YS23 = 330 * MiB;
constexpr size_t WS_OAG = 354 * MiB;
constexpr size_t WS_LSE = 402 * MiB;
constexpr size_t WS_MRG = 2 * MiB;
constexpr size_t WS_WOUT = 530 * MiB;
constexpr size_t WS_PETOK = 532 * MiB;
constexpr size_t WS_PEGATE = 536 * MiB;
constexpr size_t WS_WRT = 540 * MiB;
constexpr size_t WS_END = 540 * MiB + 256 * 1024;
constexpr float SX = 8.0f, SW = 512.0f, SH = 4.0f, SXIN = 8.0f, SY = 64.0f, SM = 64.0f, SO = 64.0f, SSG = 256.0f, SQ = 64.0f, SK = 16.0f;
static_assert(WS_HQ + (size_t)NTOK * HQ_P * 2 <= WS_SG && WS_SG + (size_t)NTOK * SG_P <= WS_OAG && WS_OAG + (size_t)3 * NTOK * 256 * 2 <= WS_LSE && WS_LSE + (size_t)3 * NTOK * 4 * 4 <= WS_WGU, "ws map 1");
static_assert(WS_WGU + (size_t)NEXP * 2048 * D <= WS_WD && WS_WD + (size_t)NEXP * D * DFF <= WS_WOUT && WS_MRG + (size_t)NTOK * D <= WS_X1B && WS_X1B + (size_t)NTOK * D * 2 <= WS_X1Q && WS_X1Q + (size_t)NTOK * D <= WS_HDN, "ws map 2");
static_assert(WS_HDN + (size_t)MAX_MT * 256 * DFF <= WS_OAG && WS_WOUT + (size_t)D * D <= WS_PETOK, "ws map 3");
constexpr size_t DO_XB = 0;
constexpr size_t DO_OAB = 0;
constexpr size_t DO_WIN = 96 * MiB;
constexpr size_t DO_WCAT = 108 * MiB;
constexpr int CW_TMO = 0, CW_CODE = 1;
constexpr int CW_BAR = 4096;
constexpr int CW_SEAM = 16384;
constexpr int CW_ECNT = 32768;
static_assert((CW_ECNT + 2 * 64 * NEXP) * 4 <= (int)CTL_ZERO_BYTES, "CTL words inside the memset region");

constexpr int RING_BYTES = 131072;
constexpr int SCR_BYTES = 143360;
constexpr int LDSCTL_OFF = SCR_BYTES;
constexpr int MISC_OFF = LDSCTL_OFF + 320;
constexpr int MOE_OFF = LDSCTL_OFF + 512;
constexpr int LDS_BYTES = 147456;
static_assert(MOE_OFF + 128 + 136 + MAX_MT <= LDS_BYTES, "LDS map");

#define RLX_AGENT __ATOMIC_RELAXED, __HIP_MEMORY_SCOPE_AGENT
#define LDS_WAIT() asm volatile("s_waitcnt lgkmcnt(0)" ::: "memory")
#define VM_WAIT() asm volatile("s_waitcnt vmcnt(0)" ::: "memory")

__device__ __forceinline__ unsigned cvt_pk_bf16(float lo, float hi) { unsigned r; asm volatile("v_cvt_pk_bf16_f32 %0, %1, %2" : "=v"(r) : "v"(lo), "v"(hi)); return r; }
__device__ __forceinline__ int opaque(int v) { asm volatile("" : "+v"(v)); return v; }
__device__ __forceinline__ unsigned pk4_fp8(float a, float b, float c, float d) { int w = 0; w = __builtin_amdgcn_cvt_pk_fp8_f32(a, b, w, false); w = __builtin_amdgcn_cvt_pk_fp8_f32(c, d, w, true); return (unsigned)w; }
__device__ __forceinline__ unsigned f2e4m3_sw(float x) {
    const float a = __builtin_amdgcn_fmed3f(fabsf(x), 9.5367431640625e-07f, 448.f);
    const int e1 = max(__builtin_amdgcn_frexp_expf(a), -5);
    const unsigned m = (unsigned)__builtin_rintf(__builtin_amdgcn_ldexpf(a, 4 - e1));
    return ((__float_as_uint(x) >> 24) & 0x80u) | (unsigned)((e1 << 3) + 40 + (int)m); }
__device__ __forceinline__ unsigned pk4_fp8_pad(float a, float b, float c, float d) {
    unsigned w;
    asm("v_cvt_pk_fp8_f32 %0, %1, %2\n\ts_nop 1" : "=v"(w) : "v"(a), "v"(b));
    asm("v_cvt_pk_fp8_f32 %0, %1, %2 op_sel:[0,0,1]\n\ts_nop 1" : "+v"(w) : "v"(c), "v"(d));
    return w; }
__device__ __forceinline__ float clamp_fp8(float v) { return __builtin_amdgcn_fmed3f(v, -448.0f, 448.0f); }
__device__ __forceinline__ float bf_lo(unsigned w) { return __uint_as_float(w << 16); }
__device__ __forceinline__ float bf_hi(unsigned w) { return __uint_as_float(w & 0xffff0000u); }
__device__ __forceinline__ float fast_sigmoid(float g) { g = fminf(fmaxf(g, -60.f), 60.f); return __builtin_amdgcn_rcpf(1.0f + __builtin_amdgcn_exp2f(-g * LOG2E)); }

namespace pg8 {
constexpr int BM = 256, BK = 64, HALF = 128, HTB = HALF * BK * 2, STAGE_BYTES = 8 * HTB, NXCD = 8, WGM = 8;
constexpr int EPRE_OFF = STAGE_BYTES;
static_assert(EPRE_OFF + 3072 <= SCR_BYTES, "epilogue prefetch area");
__host__ __device__ __forceinline__ int lds_byte(int r, int c) { const int st = (r >> 4) * 2 + (c >> 5), rr = r & 15, cc = c & 31, ob = rr * 64 + cc * 2; return st * 1024 + (ob ^ (((ob >> 9) & 1) << 5)); }
__host__ __device__ __forceinline__ void stage_rc(int b, int& R, int& C) { const int st = b / 1024, sb = b % 1024, swz = sb ^ (((sb >> 9) & 1) << 5); R = (st >> 1) * 16 + swz / 64; C = (st & 1) * 32 + (swz % 64) / 2; }
__host__ __device__ __forceinline__ int perm32(int rho) { const int n = rho >> 4, i = rho & 15; return 8 * (i >> 2) + 4 * n + (i & 3); }

struct Unit { int pm, pn, e, ti, valid; };
struct Gemm { const char* A; const char* Bt; int lda, ldb, nt; };

__device__ __forceinline__ bool tile_of(long L, int nM, int nN, int& pm, int& pn) {
    const int nwg = nM * nN; if (L >= nwg) return false;
    int wgid = (int)L; { const int q = nwg / NXCD, r = nwg % NXCD, xcd = wgid % NXCD, off = wgid / NXCD; wgid = (xcd < r ? xcd * (q + 1) : r * (q + 1) + (xcd - r) * q) + off; }
    const int nig = WGM * nN, gid = wgid / nig, fm = gid * WGM, gsz = (nM - fm) < WGM ? (nM - fm) : WGM;
    pm = fm + ((wgid % nig) % gsz); pn = (wgid % nig) / gsz; return true;
}
struct StaticOrder {
    int nM, nN, G, c;
    __device__ __forceinline__ void init(int M, int N, int G_, int c_) { nM = M / BM; nN = N / BM; G = G_; c = c_; }
    __device__ __forceinline__ bool next(int i, Unit& u) const { u.e = 0; u.ti = 0; u.valid = 256; return tile_of((long)i * G + c, nM, nN, u.pm, u.pn); }
    __device__ __forceinline__ const char* a_ptr(const Gemm& g, const Unit& u) const { return g.A + (size_t)u.pm * 256 * g.lda; }
    __device__ __forceinline__ const char* b_ptr(const Gemm& g, const Unit& u) const { return g.Bt + (size_t)u.pn * 256 * g.ldb; }
    __device__ __forceinline__ unsigned row_off(const Unit&, int) const { return 0u; }
};
struct MoeOrder {
    int T, nN, G, c; const LAS int* cnt; const LAS int* fs; const LAS unsigned char* te;
    const int* petok; size_t b_exp_stride; bool gather; unsigned rowbytes;
    __device__ __forceinline__ bool next(int i, Unit& u) const {
        if (!tile_of((long)i * G + c, T, nN, u.pm, u.pn)) return false;
        u.e = __builtin_amdgcn_readfirstlane((int)te[u.pm]); u.ti = u.pm - __builtin_amdgcn_readfirstlane(fs[u.e]); const int left = __builtin_amdgcn_readfirstlane(cnt[u.e]) - u.ti * 256; u.valid = left < 256 ? left : 256; return true;
    }
    __device__ __forceinline__ const char* a_ptr(const Gemm& g, const Unit& u) const { return gather ? g.A : g.A + (size_t)u.pm * 256 * g.lda; }
    __device__ __forceinline__ const char* b_ptr(const Gemm& g, const Unit& u) const { return g.Bt + (size_t)u.e * b_exp_stride + (size_t)u.pn * 256 * g.ldb; }
    __device__ __forceinline__ unsigned row_off(const Unit& u, int R) const {
        int tok = 0; if (R < u.valid) tok = petok[(size_t)u.e * NTOK + u.ti * 256 + R] >> 2;
        return (unsigned)tok * rowbytes;
    }
};

typedef int v8i32 __attribute__((ext_vector_type(8)));
template <class Epi, class Sched, bool ALIGN_EPI, bool GATHER, bool F8 = false>
__device__ __forceinline__ void gemm_phase(LAS unsigned char* lds, const Gemm g, const Sched& S, const Epi& E) {
    const int tid = threadIdx.x, wid = __builtin_amdgcn_readfirstlane(tid >> 6), lane = tid & 63, wr = wid >> 2, wc = wid & 3, fr = lane & 15, fq = lane >> 4;
    const int nt = g.nt;
    unsigned voffA[2], voffB[2]; int RA[2], CA2[2];
#pragma unroll
    for (int i = 0; i < 2; ++i) { int R, C; stage_rc(tid * 16 + i * 8192, R, C); const int Rb = Epi::PERM ? ((R & ~31) + perm32(R & 31)) : R;
        voffA[i] = (unsigned)(R * g.lda + C * 2); voffB[i] = (unsigned)(Rb * g.ldb + C * 2); RA[i] = R; CA2[i] = C * 2; }
    const size_t kstep = (size_t)(BK * 2);
    const size_t hstepA = (size_t)HALF * g.lda, hstepB = (size_t)HALF * g.ldb;
    const unsigned ldsw = (unsigned)wid * 1024u;
    const int aoff = lds_byte(wr * 64 + fr, fq * 8), boff = lds_byte(wc * 32 + fr, fq * 8);
    const int aoff0 = aoff, boff0 = boff, aoff1 = aoff + 1024, boff1 = boff + 1024;
#define PG8_SA(b, h) (((b) * 2 + (h)) * HTB)
#define PG8_SB(b, h) ((4 + (b) * 2 + (h)) * HTB)
#define PG8_STAGE(bufoff, gbase, voff) do { _Pragma("unroll") for (int _i = 0; _i < 2; ++_i) \
        __builtin_amdgcn_global_load_lds((const unsigned*)((const char*)(gbase) + (voff)[_i]), (LAS unsigned*)(lds + (bufoff) + ldsw + _i * 8192), 16, 0, 0); } while (0)
#define PG8_STAGE_A(bufoff, kp, h, nx) do { if constexpr (GATHER) { unsigned _v[2]; _v[0] = (nx) ? gN[h][0] : gC[h][0]; _v[1] = (nx) ? gN[h][1] : gC[h][1]; PG8_STAGE(bufoff, kp, _v); } \
        else { PG8_STAGE(bufoff, (kp) + (h) * hstepA, voffA); } } while (0)
#define PG8_LDA(dst, b, h) do { _Pragma("unroll") for (int m = 0; m < 4; ++m) _Pragma("unroll") for (int k = 0; k < 2; ++k) dst[m][k] = *(const LAS bf16x8*)(lds + PG8_SA(b, h) + (k ? aoff1 : aoff0) + m * 2048); } while (0)
#define PG8_LDB(dst, b, h) do { _Pragma("unroll") for (int n = 0; n < 2; ++n) _Pragma("unroll") for (int k = 0; k < 2; ++k) dst[n][k] = *(const LAS bf16x8*)(lds + PG8_SB(b, h) + (k ? boff1 : boff0) + n * 2048); } while (0)
#define PG8_F8OP(X) __builtin_bit_cast(v8i32, __builtin_shufflevector(X[0], X[1], 0, 1, 2, 3, 4, 5, 6, 7, 8, 9, 10, 11, 12, 13, 14, 15))
#define PG8_MMA(ai, bj, At, Bt) do { __builtin_amdgcn_s_setprio(1); if constexpr (F8) { _Pragma("unroll") for (int m = 0; m < 4; ++m) _Pragma("unroll") for (int n = 0; n < 2; ++n) \
        asm volatile("v_mfma_scale_f32_16x16x128_f8f6f4 %0, %1, %2, %0, %3, %3 op_sel_hi:[0,0,0]" : "+v"(acc[ai][bj][m][n]) : "v"(PG8_F8OP(Bt[n])), "v"(PG8_F8OP(At[m])), "v"(one_scale)); } \
        else { _Pragma("unroll") for (int m = 0; m < 4; ++m) _Pragma("unroll") for (int n = 0; n < 2; ++n) _Pragma("unroll") for (int k = 0; k < 2; ++k) \
        acc[ai][bj][m][n] = __builtin_amdgcn_mfma_f32_16x16x32_bf16(Bt[n][k], At[m][k], acc[ai][bj][m][n], 0, 0, 0); } __builtin_amdgcn_s_setprio(0); } while (0)
#define PG8_WAIT_V(n) asm volatile("s_waitcnt vmcnt(" #n ")" ::: "memory")
#define PG8_WAIT_L(n) asm volatile("s_waitcnt lgkmcnt(" #n ")" ::: "memory")
#define PG8_BAR __builtin_amdgcn_s_barrier()
#define PG8_SCHED __builtin_amdgcn_sched_barrier(0)
    Unit cur, nxt; int ui = 0;
    if (!S.next(0, cur)) return;
    int one_scale = 0x7f7f7f7f; if constexpr (F8) asm volatile("" : "+v"(one_scale));
    unsigned gC[2][2], gN[2][2];
#pragma unroll
    for (int h = 0; h < 2; ++h)
#pragma unroll
        for (int i = 0; i < 2; ++i) { gC[h][i] = GATHER ? S.row_off(cur, h * HALF + RA[i]) + (unsigned)CA2[i] : 0u; gN[h][i] = gC[h][i]; }
    f32x4 acc[2][2][4][2];
#pragma unroll
    for (int a = 0; a < 2; ++a)
#pragma unroll
        for (int b = 0; b < 2; ++b)
#pragma unroll
            for (int m = 0; m < 4; ++m)
#pragma unroll
                for (int n = 0; n < 2; ++n) acc[a][b][m][n] = (f32x4){0.f, 0.f, 0.f, 0.f};
    bf16x8 At[4][2], B0[2][2], B1[2][2];
    const char* cA = S.a_ptr(g, cur); const char* cB = S.b_ptr(g, cur);
    PG8_STAGE(PG8_SB(0, 0), cB, voffB); PG8_STAGE(PG8_SB(0, 1), cB + hstepB, voffB); PG8_STAGE_A(PG8_SA(0, 0), cA, 0, false); PG8_STAGE_A(PG8_SA(0, 1), cA, 1, false);
    if (wr == 1) PG8_BAR;
    PG8_WAIT_V(2); PG8_BAR;
    PG8_STAGE(PG8_SB(1, 0), cB + kstep, voffB); PG8_STAGE_A(PG8_SA(1, 0), cA + kstep, 0, false); PG8_STAGE(PG8_SB(1, 1), cB + hstepB + kstep, voffB);
    PG8_WAIT_V(6); PG8_BAR;
    for (;;) {
        const bool has_next = S.next(ui + 1, nxt);
        const char* nA = has_next ? S.a_ptr(g, nxt) : cA; const char* nB = has_next ? S.b_ptr(g, nxt) : cB;
        if constexpr (GATHER) { if (has_next) {
#pragma unroll
            for (int h = 0; h < 2; ++h)
#pragma unroll
                for (int i = 0; i < 2; ++i) gN[h][i] = S.row_off(nxt, h * HALF + RA[i]) + (unsigned)CA2[i]; } }
#pragma unroll 1
        for (int t = 0; t < nt; t += 2) {
            const bool last = (t == nt - 2);
            asm volatile("" : "+v"(voffA[0]), "+v"(voffA[1]), "+v"(voffB[0]), "+v"(voffB[1]));
            if constexpr (Epi::HAS_MID) { if (t == Epi::MID_T) E.mid(acc, cur, wr, wc, fr, fq); }
            if constexpr (Epi::HAS_PRE) { if (last) E.pre(lds, cur, wid, lane); }
            const char* a1 = cA + (size_t)(t + 1) * kstep;
            const char* a2 = last ? nA : cA + (size_t)(t + 2) * kstep; const char* b2 = last ? nB : cB + (size_t)(t + 2) * kstep;
            const char* a3 = a2 + kstep; const char* b3 = b2 + kstep;
            PG8_LDB(B0, 0, 0); PG8_LDB(B1, 0, 1); PG8_SCHED; PG8_LDA(At, 0, 0); PG8_STAGE_A(PG8_SA(1, 1), a1, 1, false);
            PG8_WAIT_V(8); PG8_WAIT_L(0); PG8_BAR; PG8_MMA(0, 0, At, B0); PG8_MMA(0, 1, At, B1); PG8_BAR; PG8_SCHED;
            PG8_LDA(At, 0, 1); PG8_STAGE(PG8_SB(0, 0), b2, voffB); PG8_STAGE(PG8_SB(0, 1), b2 + hstepB, voffB); PG8_STAGE_A(PG8_SA(0, 0), a2, 0, last);
            PG8_WAIT_V(8); PG8_WAIT_L(0); PG8_BAR; PG8_MMA(1, 0, At, B0); PG8_MMA(1, 1, At, B1); PG8_BAR; PG8_SCHED;
            PG8_LDB(B0, 1, 0); PG8_LDB(B1, 1, 1); PG8_SCHED; PG8_LDA(At, 1, 0); PG8_STAGE_A(PG8_SA(0, 1), a2, 1, last);
            PG8_WAIT_V(8); PG8_WAIT_L(0); PG8_BAR; PG8_MMA(0, 0, At, B0); PG8_MMA(0, 1, At, B1); PG8_BAR; PG8_SCHED;
            PG8_LDA(At, 1, 1); PG8_STAGE(PG8_SB(1, 0), b3, voffB); PG8_STAGE(PG8_SB(1, 1), b3 + hstepB, voffB); PG8_STAGE_A(PG8_SA(1, 0), a3, 0, last);
            PG8_WAIT_V(8); PG8_WAIT_L(0); PG8_BAR; PG8_MMA(1, 0, At, B0); PG8_MMA(1, 1, At, B1); PG8_BAR; PG8_SCHED;
        }
        if constexpr (ALIGN_EPI) { if (wr == 0) PG8_BAR; }
        if constexpr (F8) asm volatile("s_nop 15\n\ts_nop 15" ::: "memory");
        if constexpr (!Epi::AFTER_DRAIN) { E(acc, cur, wr, wc, fr, fq); }
        if (!has_next) break;
#pragma unroll
        for (int a = 0; a < 2; ++a)
#pragma unroll
            for (int b = 0; b < 2; ++b)
#pragma unroll
                for (int m = 0; m < 4; ++m)
#pragma unroll
                    for (int n = 0; n < 2; ++n) acc[a][b][m][n] = (f32x4){0.f, 0.f, 0.f, 0.f};
        cur = nxt; cA = nA; cB = nB; ++ui;
#pragma unroll
        for (int h = 0; h < 2; ++h)
#pragma unroll
            for (int i = 0; i < 2; ++i) gC[h][i] = gN[h][i];
        if constexpr (ALIGN_EPI) { if (wr == 1) PG8_BAR; }
    }
    PG8_WAIT_V(0);
    if constexpr (!ALIGN_EPI) { if (wr == 0) PG8_BAR; }
    PG8_BAR;
    if constexpr (Epi::AFTER_DRAIN) { E.fused(acc, cur, wr, wc, fr, fq, lds, wid, lane); }
#undef PG8_SA
#undef PG8_SB
#undef PG8_STAGE
#undef PG8_STAGE_A
#undef PG8_LDA
#undef PG8_LDB
#undef PG8_MMA
#undef PG8_F8OP
#undef PG8_WAIT_V
#undef PG8_WAIT_L
#undef PG8_BAR
#undef PG8_SCHED
}
}

namespace pg8 {
__device__ __forceinline__ u32x4 pair16(u32x2 x, u32x2 y) {
    const auto sx = __builtin_amdgcn_permlane16_swap(x.x, y.x, false, false), sy = __builtin_amdgcn_permlane16_swap(x.y, y.y, false, false);
    u32x4 o; o.x = sx[0]; o.y = sy[0]; o.z = sx[1]; o.w = sy[1]; return o; }
__device__ __forceinline__ void unpair16(u32x4 v, u32x2& x, u32x2& y) {
    const auto sx = __builtin_amdgcn_permlane16_swap(v.x, v.z, false, false), sy = __builtin_amdgcn_permlane16_swap(v.y, v.w, false, false);
    x.x = sx[0]; x.y = sy[0]; y.x = sx[1]; y.y = sy[1]; }
struct EpiInProj {
    static constexpr bool PERM = true, AFTER_DRAIN = false, HAS_MID = false, HAS_PRE = false; static constexpr int MID_T = 0;
    unsigned char* HQ; unsigned char* SG; float rs;
    __device__ __forceinline__ void mid(f32x4 (&)[2][2][4][2], const Unit&, int, int, int, int) const {}
    __device__ __forceinline__ void operator()(const f32x4 (&acc)[2][2][4][2], const Unit& u, int wr, int wc, int fr, int fq) const {
        const int row0 = u.pm * BM + wr * 64 + opaque(fr), pn = u.pn;
        const bool gate = pn >= 14; const bool qs = (pn < 3) || (pn >= 9 && pn < 13);
        const float sc = (qs ? QSCALE : 1.0f) * rs; const int dcol = (wc & 1) * 32 + 8 * fq;
        const int fqo = fq & 1; const float nrl = -rs * LOG2E;
#pragma unroll
        for (int ai = 0; ai < 2; ++ai)
#pragma unroll
            for (int m = 0; m < 4; ++m) { const int row = row0 + ai * HALF + m * 16, b = row >> 12, t = row & (SEQ - 1);
                if (gate || pn < 6 || (pn >= 9 && pn < 13)) {
                    u32x2 w8[2];
#pragma unroll
                    for (int bj = 0; bj < 2; ++bj) { f32x4 v0 = acc[ai][bj][m][0], v1 = acc[ai][bj][m][1];
                        if (gate) {
#pragma unroll
                            for (int q = 0; q < 4; ++q) {
                                v0[q] = fmaxf(__builtin_amdgcn_rcpf(__builtin_fmaf(__builtin_amdgcn_exp2f(v0[q] * nrl), 1.0f / SSG, 1.0f / SSG)), 0.001953125f);
                                v1[q] = fmaxf(__builtin_amdgcn_rcpf(__builtin_fmaf(__builtin_amdgcn_exp2f(v1[q] * nrl), 1.0f / SSG, 1.0f / SSG)), 0.001953125f); }
                            w8[bj].x = pk4_fp8(v0[0], v0[1], v0[2], v0[3]); w8[bj].y = pk4_fp8(v1[0], v1[1], v1[2], v1[3]); }
                        else { const float qk = sc * ((pn >= 3 && pn < 6) ? SK : SQ); v0 = v0 * qk; v1 = v1 * qk;
                            w8[bj].x = pk4_fp8(clamp_fp8(v0[0]), clamp_fp8(v0[1]), clamp_fp8(v0[2]), clamp_fp8(v0[3])); w8[bj].y = pk4_fp8(clamp_fp8(v1[0]), clamp_fp8(v1[1]), clamp_fp8(v1[2]), clamp_fp8(v1[3])); } }
                    unsigned char* dp;
                    if (gate) dp = SG + (size_t)row * SG_P + (pn - 14) * 256 + wc * 32 + 8 * fq + (fqo ? HALF - 8 : 0);
                    else { const int hl = (wc >> 1) + 2 * fqo; size_t rowi; unsigned char* base8;
                        if (pn < 9) { const int ty = pn / 3, g = pn - 3 * ty, sh = 2 * g, pos = ((t & ((1 << sh) - 1)) << (12 - sh)) + (t >> sh);
                            rowi = (size_t)(((g * NB + b) * 4 + hl) * SEQ + pos); base8 = HQ + (size_t)ty * (48 * MiB); }
                        else { rowi = (size_t)((b * 16 + (pn - 9) * 4 + hl) * SEQ + t); base8 = HQ + HQ_QS; }
                        dp = base8 + rowi * 64 + dcol - 8 * fqo; }
                    *(u32x4*)dp = pair16(w8[0], w8[1]);
                    continue; }
#pragma unroll
                for (int bj = 0; bj < 2; ++bj) { f32x4 v0 = acc[ai][bj][m][0], v1 = acc[ai][bj][m][1];
                    bf16_t* dst;
                    if (gate) {
#pragma unroll
                        for (int q = 0; q < 4; ++q) { v0[q] = fmaxf(fast_sigmoid(v0[q] * rs) * SSG, 0.001953125f); v1[q] = fmaxf(fast_sigmoid(v1[q] * rs) * SSG, 0.001953125f); }
                        u32x2 w8; w8.x = pk4_fp8(v0[0], v0[1], v0[2], v0[3]); w8.y = pk4_fp8(v1[0], v1[1], v1[2], v1[3]);
                        *(u32x2*)(SG + (size_t)row * SG_P + (pn - 14) * 256 + bj * HALF + wc * 32 + 8 * fq) = w8; continue; }
                    else { v0 = v0 * sc; v1 = v1 * sc; const int hl = bj * 2 + (wc >> 1);
                        size_t rowi; unsigned char* base8; float qk; bool is8;
                        if (pn < 9) { const int ty = pn / 3, g = pn - 3 * ty, sh = 2 * g, pos = ((t & ((1 << sh) - 1)) << (12 - sh)) + (t >> sh);
                            rowi = (size_t)(((g * NB + b) * 4 + hl) * SEQ + pos); base8 = HQ + (size_t)ty * (48 * MiB); is8 = ty < 2; qk = ty == 0 ? SQ : SK; }
                        else if (pn < 13) { rowi = (size_t)((b * 16 + (pn - 9) * 4 + hl) * SEQ + t); base8 = HQ + HQ_QS; is8 = true; qk = SQ; }
                        else { rowi = (size_t)((b * 2 + (wc >> 1)) * SEQ + t); base8 = HQ + (bj ? HQ_VS : HQ_KS); is8 = (bj == 0); qk = SK; }
                        if (is8) { u32x2 w8; w8.x = pk4_fp8(clamp_fp8(v0[0] * qk), clamp_fp8(v0[1] * qk), clamp_fp8(v0[2] * qk), clamp_fp8(v0[3] * qk)); w8.y = pk4_fp8(clamp_fp8(v1[0] * qk), clamp_fp8(v1[1] * qk), clamp_fp8(v1[2] * qk), clamp_fp8(v1[3] * qk));
                            *(u32x2*)(base8 + rowi * 64 + dcol) = w8; continue; }
                        dst = (bf16_t*)base8 + rowi * 64 + dcol; }
                    u32x4 w; w.x = cvt_pk_bf16(v0[0], v0[1]); w.y = cvt_pk_bf16(v0[2], v0[3]); w.z = cvt_pk_bf16(v1[0], v1[1]); w.w = cvt_pk_bf16(v1[2], v1[3]);
                    *(u32x4*)dst = w; } }
    }
};
struct EpiGate {
    static constexpr bool PERM = true, AFTER_DRAIN = false, HAS_MID = true, HAS_PRE = false; static constexpr int MID_T = 2;
    const unsigned char* __restrict__ SG; unsigned char* __restrict__ O;
    __device__ __forceinline__ void mid(f32x4 (&acc)[2][2][4][2], const Unit& u, int wr, int wc, int fr, int fq) const {
        const int row0 = u.pm * BM + wr * 64 + opaque(fr), col0 = u.pn * BM + wc * 32 + 8 * opaque(fq);
        const int cswz = ((col0 >> 3) & 1) ? (HALF - 8) : 0;
#pragma unroll
        for (int ai = 0; ai < 2; ++ai) {
            u32x2 a[4][2], b[4][2];
#pragma unroll
            for (int mm = 0; mm < 4; ++mm) { const unsigned char* sp = SG + (size_t)(row0 + ai * HALF + mm * 16) * SG_P + col0 + cswz;
                const u32x4 la = *(const u32x4*)sp, lb = *(const u32x4*)(sp + 1024); unpair16(la, a[mm][0], a[mm][1]); unpair16(lb, b[mm][0], b[mm][1]); }
#pragma unroll
            for (int m = 0; m < 4; ++m) {
#pragma unroll
                for (int bj = 0; bj < 2; ++bj) {
#pragma unroll
                    for (int n = 0; n < 2; ++n) { const int aw = (int)a[m][bj][n], bw = (int)b[m][bj][n];
                        const f32x2 al = __builtin_amdgcn_cvt_pk_f32_fp8(aw, false), ah = __builtin_amdgcn_cvt_pk_f32_fp8(aw, true), bl = __builtin_amdgcn_cvt_pk_f32_fp8(bw, false), bh = __builtin_amdgcn_cvt_pk_f32_fp8(bw, true);
                        f32x4 r; r[0] = al[0] * __builtin_amdgcn_rcpf(bl[0]); r[1] = al[1] * __builtin_amdgcn_rcpf(bl[1]); r[2] = ah[0] * __builtin_amdgcn_rcpf(bh[0]); r[3] = ah[1] * __builtin_amdgcn_rcpf(bh[1]);
                        acc[ai][bj][m][n] = acc[ai][bj][m][n] * r; } }
                asm volatile("" : "+v"(acc[ai][0][m][0]), "+v"(acc[ai][0][m][1]), "+v"(acc[ai][1][m][0]), "+v"(acc[ai][1][m][1])); }
            asm volatile("" ::: "memory"); }
    }
    __device__ __forceinline__ void operator()(const f32x4 (&acc)[2][2][4][2], const Unit& u, int wr, int wc, int fr, int fq) const {
        const int row0 = u.pm * BM + wr * 64 + opaque(fr), col0 = u.pn * BM + wc * 32 + 8 * opaque(fq);
        constexpr float FS = SM / (SO * SW * SSG);
        const int cswz = ((col0 >> 3) & 1) ? (HALF - 8) : 0;
#pragma unroll
        for (int ai = 0; ai < 2; ++ai) {
            u32x2 bq[4][2];
#pragma unroll
            for (int m = 0; m < 4; ++m) { const u32x4 lb = *(const u32x4*)(SG + (size_t)(row0 + ai * HALF + m * 16) * SG_P + 1024 + col0 + cswz); unpair16(lb, bq[m][0], bq[m][1]); }
#pragma unroll
            for (int m = 0; m < 4; ++m) { unsigned char* op = O + (size_t)(row0 + ai * HALF + m * 16) * D + col0 + cswz;
                u32x2 w[2];
#pragma unroll
                for (int bj = 0; bj < 2; ++bj) {
#pragma unroll
                    for (int n = 0; n < 2; ++n) { const int bw = (int)bq[m][bj][n]; const f32x2 bl = __builtin_amdgcn_cvt_pk_f32_fp8(bw, false), bh = __builtin_amdgcn_cvt_pk_f32_fp8(bw, true); const f32x4 v = acc[ai][bj][m][n] * FS;
                        w[bj][n] = pk4_fp8(clamp_fp8(v[0] * bl[0]), clamp_fp8(v[1] * bl[1]), clamp_fp8(v[2] * bh[0]), clamp_fp8(v[3] * bh[1])); } }
                *(u32x4*)op = pair16(w[0], w[1]); }
            asm volatile("" ::: "memory"); }
    }
};

struct PanelStats {
    unsigned* xbuf;
    unsigned* cnt;
    unsigned* tmo;
    int pm_off; float eps; unsigned code;
    __device__ __forceinline__ bool run(const f32x4 (&v)[2][2][4][2], const Unit& u, int wr, int wc, int fr, int fq, LAS unsigned char* lds, int wid, int lane) const {
        LAS f32x2* P = (LAS f32x2*)lds;
        LAS f32x2* S = (LAS f32x2*)(lds + 8192);
        LAS unsigned* flag = (LAS unsigned*)(lds + 8192 + 2048);
        const int panel = u.pm + pm_off;
#pragma unroll
        for (int ai = 0; ai < 2; ++ai)
#pragma unroll
            for (int m = 0; m < 4; ++m) {
                float s = 0.f;
#pragma unroll
                for (int bj = 0; bj < 2; ++bj)
#pragma unroll
                    for (int n = 0; n < 2; ++n) { const f32x4 x = v[ai][bj][m][n]; s += (x[0] + x[1]) + (x[2] + x[3]); }
                s += __shfl_xor(s, 16); s += __shfl_xor(s, 32);
                const float mw = s * (1.0f / 64.0f); float q = 0.f;
#pragma unroll
                for (int bj = 0; bj < 2; ++bj)
#pragma unroll
                    for (int n = 0; n < 2; ++n) { const f32x4 d = v[ai][bj][m][n] - mw; q += (d[0] * d[0] + d[1] * d[1]) + (d[2] * d[2] + d[3] * d[3]); }
                q += __shfl_xor(q, 16); q += __shfl_xor(q, 32);
                if (fq == 0) P[(ai * HALF + wr * 64 + m * 16 + fr) * 4 + wc] = (f32x2){mw, q};
            }
        asm volatile("s_waitcnt lgkmcnt(0)" ::: "memory"); __builtin_amdgcn_s_barrier(); asm volatile("" ::: "memory");
        const int row = wid * 32 + (lane & 31);
        if (lane < 32) {
            const f32x2 a = P[row * 4 + 0], b = P[row * 4 + 1], c = P[row * 4 + 2], d = P[row * 4 + 3];
            const float mt = (a.x + b.x + c.x + d.x) * 0.25f;
            const float da = a.x - mt, db = b.x - mt, dc = c.x - mt, dd = d.x - mt;
            const float m2 = (a.y + b.y) + (c.y + d.y) + 64.0f * ((da * da + db * db) + (dc * dc + dd * dd));
            unsigned long long* slot = (unsigned long long*)xbuf + ((size_t)(panel * BM + row) * 4 + u.pn);
            __hip_atomic_store(slot, ((unsigned long long)__float_as_uint(m2) << 32) | __float_as_uint(mt), __ATOMIC_RELAXED, __HIP_MEMORY_SCOPE_AGENT);
        }
        asm volatile("s_waitcnt vmcnt(0)" ::: "memory");
        if (lane == 0) __hip_atomic_fetch_add(cnt + 64 * panel, 1u, __ATOMIC_RELAXED, __HIP_MEMORY_SCOPE_AGENT);
        if (wid == 0) {
            bool dead = false; const unsigned long long t0 = __builtin_amdgcn_s_memrealtime(); const unsigned want = 8u * 4u;
            for (;;) {
                if ((unsigned)__builtin_amdgcn_readfirstlane(__hip_atomic_load(cnt + 64 * panel, __ATOMIC_RELAXED, __HIP_MEMORY_SCOPE_AGENT)) >= want) break;
                if (__builtin_amdgcn_s_memrealtime() - t0 > 2000000ull) {
                    if (lane == 0) { unsigned expect = 0u; __hip_atomic_compare_exchange_strong(tmo + 1, &expect, code | (unsigned)(panel & 0xff), __ATOMIC_RELAXED, __ATOMIC_RELAXED, __HIP_MEMORY_SCOPE_AGENT);
                                     __hip_atomic_store(tmo, 1u, __ATOMIC_RELAXED, __HIP_MEMORY_SCOPE_AGENT); }
                    dead = true; break; }
                __builtin_amdgcn_s_sleep(2);
            }
            __builtin_amdgcn_fence(__ATOMIC_ACQUIRE, "agent");
            if (lane == 0) flag[0] = dead ? 1u : 0u;
        }
        asm volatile("s_waitcnt vmcnt(0) lgkmcnt(0)" ::: "memory"); __builtin_amdgcn_s_barrier(); asm volatile("" ::: "memory");
        const bool bad = flag[0] != 0u;
        if (lane < 32) {
            const unsigned long long* slot = (const unsigned long long*)xbuf + (size_t)(panel * BM + row) * 4; float mt[4], m2[4]; float ms = 0.f;
#pragma unroll
            for (int t = 0; t < 4; ++t) { const unsigned long long w = __hip_atomic_load(slot + t, __ATOMIC_RELAXED, __HIP_MEMORY_SCOPE_AGENT); mt[t] = __uint_as_float((unsigned)w); m2[t] = __uint_as_float((unsigned)(w >> 32)); ms += mt[t]; }
            const float mean = ms * 0.25f; float q = 0.f;
#pragma unroll
            for (int t = 0; t < 4; ++t) { const float dm = mt[t] - mean; q += m2[t] + 256.0f * dm * dm; }
            S[row] = (f32x2){mean, 1.0f / sqrtf(q * (1.0f / 1024.0f) + eps)};
        }
        asm volatile("s_waitcnt lgkmcnt(0)" ::: "memory"); __builtin_amdgcn_s_barrier(); asm volatile("" ::: "memory");
        return bad;
    }
};
struct EpiLn1 {
    static constexpr bool PERM = true, AFTER_DRAIN = true, HAS_MID = false, HAS_PRE = false; static constexpr int MID_T = 0;
    const float* x; float* out; bf16_t* xb; unsigned char* xq; const float* gam; const float* bet; PanelStats st; int row_off; unsigned poison; float rs;
    __device__ __forceinline__ void mid(f32x4 (&)[2][2][4][2], const Unit&, int, int, int, int) const {}
    __device__ __forceinline__ void operator()(const f32x4 (&)[2][2][4][2], const Unit&, int, int, int, int) const {}
    __device__ __forceinline__ void fused(f32x4 (&acc)[2][2][4][2], const Unit& u, int wr, int wc, int fr, int fq, LAS unsigned char* lds, int wid, int lane) const {
        const LAS f32x2* S = (const LAS f32x2*)(lds + 8192);
        const int col0 = u.pn * BM + wc * 32 + 8 * opaque(fq);
        const int grow0 = row_off + u.pm * BM; fr = opaque(fr);
#pragma unroll
        for (int ai = 0; ai < 2; ++ai)
#pragma unroll
            for (int m = 0; m < 4; ++m) { const size_t off = (size_t)(grow0 + ai * HALF + wr * 64 + m * 16 + fr) * D + col0;
#pragma unroll
                for (int bj = 0; bj < 2; ++bj)
#pragma unroll
                    for (int n = 0; n < 2; ++n) { const f32x4 bs = *(const f32x4*)(x + off + bj * HALF + n * 4); acc[ai][bj][m][n] = acc[ai][bj][m][n] * rs + bs * DN_ALPHA; }
                asm volatile("" : "+v"(acc[ai][0][m][0]), "+v"(acc[ai][0][m][1]), "+v"(acc[ai][1][m][0]), "+v"(acc[ai][1][m][1]));
                if (m == 3) asm volatile("" ::: "memory"); }
        const bool bad = st.run(acc, u, wr, wc, fr, fq, lds, wid, lane) || poison != 0u;
        const float qnan = __builtin_nanf("");
        f32x4 gv[2][2], bv[2][2];
#pragma unroll
        for (int bj = 0; bj < 2; ++bj)
#pragma unroll
            for (int n = 0; n < 2; ++n) { gv[bj][n] = *(const f32x4*)(gam + col0 + bj * HALF + n * 4); bv[bj][n] = *(const f32x4*)(bet + col0 + bj * HALF + n * 4); }
#pragma unroll
        for (int ai = 0; ai < 2; ++ai)
#pragma unroll
            for (int m = 0; m < 4; ++m) { const int r = ai * HALF + wr * 64 + m * 16 + fr; const f32x2 sr = S[r]; const size_t off = (size_t)(grow0 + r) * D + col0;
#pragma unroll
                for (int bj = 0; bj < 2; ++bj) { f32x4 o0 = (acc[ai][bj][m][0] - sr.x) * sr.y * gv[bj][0] + bv[bj][0], o1 = (acc[ai][bj][m][1] - sr.x) * sr.y * gv[bj][1] + bv[bj][1];
                    if (bad) { o0 = (f32x4){qnan, qnan, qnan, qnan}; o1 = o0; }
                    u32x4 w; w.x = cvt_pk_bf16(o0[0], o0[1]); w.y = cvt_pk_bf16(o0[2], o0[3]); w.z = cvt_pk_bf16(o1[0], o1[1]); w.w = cvt_pk_bf16(o1[2], o1[3]); *(u32x4*)(xb + off + bj * HALF) = w;
                    u32x2 q8; q8.x = pk4_fp8(clamp_fp8(o0[0] * SX), clamp_fp8(o0[1] * SX), clamp_fp8(o0[2] * SX), clamp_fp8(o0[3] * SX)); q8.y = pk4_fp8(clamp_fp8(o1[0] * SX), clamp_fp8(o1[1] * SX), clamp_fp8(o1[2] * SX), clamp_fp8(o1[3] * SX));
                    *(u32x2*)(xq + off + bj * HALF) = q8; } }
    }
};
struct EpiY {
    static constexpr bool PERM = true, AFTER_DRAIN = false, HAS_MID = false, HAS_PRE = false; static constexpr int MID_T = 0;
    const float* __restrict__ x; bf16_t* __restrict__ Y; float* __restrict__ ST; float rs;
    __device__ __forceinline__ void mid(f32x4 (&)[2][2][4][2], const Unit&, int, int, int, int) const {}
    __device__ __forceinline__ void operator()(const f32x4 (&acc)[2][2][4][2], const Unit& u, int wr, int wc, int fr, int fq) const {
        const int row0 = u.pm * BM + wr * 64 + opaque(fr), col0 = u.pn * BM + wc * 32 + 8 * opaque(fq);
#pragma unroll
        for (int ai = 0; ai < 2; ++ai) {
            f32x4 xv[4][2][2];
#pragma unroll
            for (int m = 0; m < 4; ++m)
#pragma unroll
                for (int bj = 0; bj < 2; ++bj)
#pragma unroll
                    for (int n = 0; n < 2; ++n) xv[m][bj][n] = *(const f32x4*)(x + (size_t)(row0 + ai * HALF + m * 16) * D + col0 + bj * HALF + n * 4);
#pragma unroll
            for (int m = 0; m < 4; ++m) { const size_t r = (size_t)(row0 + ai * HALF + m * 16); float s1 = 0.f, s2 = 0.f;
#pragma unroll
                for (int bj = 0; bj < 2; ++bj) { const f32x4 y0 = acc[ai][bj][m][0] * rs + xv[m][bj][0] * DN_ALPHA, y1 = acc[ai][bj][m][1] * rs + xv[m][bj][1] * DN_ALPHA;
                    s1 += (y0[0] + y0[1]) + (y0[2] + y0[3]) + (y1[0] + y1[1]) + (y1[2] + y1[3]);
                    s2 += (y0[0] * y0[0] + y0[1] * y0[1]) + (y0[2] * y0[2] + y0[3] * y0[3]) + (y1[0] * y1[0] + y1[1] * y1[1]) + (y1[2] * y1[2] + y1[3] * y1[3]);
                    u32x4 w; w.x = cvt_pk_bf16(y0[0], y0[1]); w.y = cvt_pk_bf16(y0[2], y0[3]); w.z = cvt_pk_bf16(y1[0], y1[1]); w.w = cvt_pk_bf16(y1[2], y1[3]);
                    *(u32x4*)(Y + r * D + col0 + bj * HALF) = w; }
                s1 += __shfl_xor(s1, 16); s1 += __shfl_xor(s1, 32); s2 += __shfl_xor(s2, 16); s2 += __shfl_xor(s2, 32);
                if (fq == 0) *(f32x2*)(ST + (r * 16 + u.pn * 4 + wc) * 2) = (f32x2){s1, s2}; }
            asm volatile("" ::: "memory"); }
    }
};
struct EpiGU {
    static constexpr bool PERM = true, AFTER_DRAIN = false, HAS_MID = false, HAS_PRE = true; static constexpr int MID_T = 0;
    const float* bg; const float* bu; unsigned char* H; LAS unsigned char* plds;
    __device__ __forceinline__ void mid(f32x4 (&)[2][2][4][2], const Unit&, int, int, int, int) const {}
    __device__ __forceinline__ void pre(LAS unsigned char* lds, const Unit& u, int wid, int lane) const {
        if (wid == 0) __builtin_amdgcn_global_load_lds((const unsigned*)((lane < 32 ? bg : bu) + u.e * DFF + u.pn * HALF + (lane & 31) * 4), (LAS unsigned*)(lds + EPRE_OFF), 16, 0, 0);
    }
    __device__ __forceinline__ void operator()(const f32x4 (&acc)[2][2][4][2], const Unit& u, int wr, int wc, int fr, int fq) const {
        const int row0 = u.pm * BM + wr * 64 + opaque(fr), jl = wc * 32 + 8 * opaque(fq), j0 = u.pn * HALF + jl;
        const LAS float* pb = (const LAS float*)(plds + EPRE_OFF) + jl;
        const f32x4 g0 = *(const LAS f32x4*)pb, g1 = *(const LAS f32x4*)(pb + 4), u0 = *(const LAS f32x4*)(pb + HALF), u1 = *(const LAS f32x4*)(pb + HALF + 4);
        f32x4 us0 = (u0 + 1.0f) * SH, us1 = (u1 + 1.0f) * SH;
        asm volatile("" : "+v"(us0), "+v"(us1));
        const int fqo = (jl >> 3) & 1;
#pragma unroll
        for (int ai = 0; ai < 2; ++ai)
#pragma unroll
            for (int m2 = 0; m2 < 4; m2 += 2) { u32x2 w[2];
#pragma unroll
              for (int mo = 0; mo < 2; ++mo) { const int m = m2 + mo;
                constexpr float RS = 1.0f / (SX * SW), CS = -1.702f * LOG2E;
                f32x4 h0, h1;
#pragma unroll
                for (int q = 0; q < 4; ++q) {
                    const float a = fminf(__builtin_fmaf(acc[ai][0][m][0][q], RS, g0[q]), 7.0f), b = fminf(__builtin_fmaf(acc[ai][0][m][1][q], RS, g1[q]), 7.0f);
                    const float ua = __builtin_amdgcn_fmed3f(__builtin_fmaf(acc[ai][1][m][0][q], RS * SH, us0[q]), -6.0f * SH, 8.0f * SH), ub = __builtin_amdgcn_fmed3f(__builtin_fmaf(acc[ai][1][m][1][q], RS * SH, us1[q]), -6.0f * SH, 8.0f * SH);
                    h0[q] = (a * __builtin_amdgcn_rcpf(1.0f + __builtin_amdgcn_exp2f(CS * a))) * ua;
                    h1[q] = (b * __builtin_amdgcn_rcpf(1.0f + __builtin_amdgcn_exp2f(CS * b))) * ub; }
                w[mo].x = pk4_fp8(h0[0], h0[1], h0[2], h0[3]); w[mo].y = pk4_fp8(h1[0], h1[1], h1[2], h1[3]); }
              *(u32x4*)(H + (size_t)(row0 + ai * HALF + (m2 + fqo) * 16) * DFF + j0 - 8 * fqo) = pair16(w[0], w[1]); }
    }
};
struct EpiDown {
    static constexpr bool PERM = true, AFTER_DRAIN = false, HAS_MID = false, HAS_PRE = true; static constexpr int MID_T = 0;
    const float* bd; const int* petok; const float* pegate; unsigned char* Y; LAS unsigned char* plds;
    __device__ __forceinline__ void mid(f32x4 (&)[2][2][4][2], const Unit&, int, int, int, int) const {}
    __device__ __forceinline__ void pre(LAS unsigned char* lds, const Unit& u, int wid, int lane) const {
        const size_t eb = (size_t)u.e * NTOK + (size_t)u.ti * 256 + (size_t)(lane * 4);
        if (wid == 0) __builtin_amdgcn_global_load_lds((const unsigned*)(bd + u.e * D + u.pn * BM + lane * 4), (LAS unsigned*)(lds + EPRE_OFF), 16, 0, 0);
        else if (wid == 1) __builtin_amdgcn_global_load_lds((const unsigned*)(petok + eb), (LAS unsigned*)(lds + EPRE_OFF + 1024), 16, 0, 0);
        else if (wid == 2) __builtin_amdgcn_global_load_lds((const unsigned*)(pegate + eb), (LAS unsigned*)(lds + EPRE_OFF + 2048), 16, 0, 0);
    }
    __device__ __forceinline__ void operator()(const f32x4 (&acc)[2][2][4][2], const Unit& u, int wr, int wc, int fr, int fq) const {
        const int r0 = wr * 64 + opaque(fr), cl = wc * 32 + 8 * opaque(fq), col0 = u.pn * BM + cl;
        const LAS float* pb = (const LAS float*)(plds + EPRE_OFF) + cl;
        f32x4 b[2][2];
#pragma unroll
        for (int bj = 0; bj < 2; ++bj) { b[bj][0] = *(const LAS f32x4*)(pb + bj * HALF); b[bj][1] = *(const LAS f32x4*)(pb + bj * HALF + 4); }
        int info[2][4]; float gwv[2][4];
#pragma unroll
        for (int ai = 0; ai < 2; ++ai)
#pragma unroll
            for (int m = 0; m < 4; ++m) { const int r = r0 + ai * HALF + m * 16; info[ai][m] = *(const LAS int*)(plds + EPRE_OFF + 1024 + 4 * r); gwv[ai][m] = *(const LAS float*)(plds + EPRE_OFF + 2048 + 4 * r) * SY; }
        if (u.valid == 256) {
            const int fqo = (col0 >> 3) & 1;
            const int cswz = fqo ? (HALF - 8) : 0;
#pragma unroll
        for (int ai = 0; ai < 2; ++ai)
#pragma unroll
            for (int m = 0; m < 4; ++m) {
                const float gw = gwv[ai][m];
                unsigned char* op = Y + (size_t)info[ai][m] * 1024 + col0 + cswz;
                u32x2 w[2];
#pragma unroll
                for (int bj = 0; bj < 2; ++bj) { constexpr float RS = 1.0f / (SH * SW); const f32x4 v0 = (acc[ai][bj][m][0] * RS + b[bj][0]) * gw, v1 = (acc[ai][bj][m][1] * RS + b[bj][1]) * gw;
                    w[bj].x = pk4_fp8(clamp_fp8(v0[0]), clamp_fp8(v0[1]), clamp_fp8(v0[2]), clamp_fp8(v0[3])); w[bj].y = pk4_fp8(clamp_fp8(v1[0]), clamp_fp8(v1[1]), clamp_fp8(v1[2]), clamp_fp8(v1[3])); }
                *(u32x4*)op = pair16(w[0], w[1]); }
        } else {
#pragma unroll
        for (int ai = 0; ai < 2; ++ai)
#pragma unroll
            for (int m = 0; m < 4; ++m) { const int r = r0 + ai * HALF + m * 16;
                if (r < u.valid) { const float gw = gwv[ai][m];
                    unsigned char* op = Y + (size_t)info[ai][m] * 1024 + col0;
#pragma unroll
                    for (int bj = 0; bj < 2; ++bj) { constexpr float RS = 1.0f / (SH * SW); const f32x4 v0 = (acc[ai][bj][m][0] * RS + b[bj][0]) * gw, v1 = (acc[ai][bj][m][1] * RS + b[bj][1]) * gw;
                        u32x2 w; w.x = pk4_fp8(clamp_fp8(v0[0]), clamp_fp8(v0[1]), clamp_fp8(v0[2]), clamp_fp8(v0[3])); w.y = pk4_fp8(clamp_fp8(v1[0]), clamp_fp8(v1[1]), clamp_fp8(v1[2]), clamp_fp8(v1[3]));
                        *(u32x2*)(op + bj * HALF) = w; } } }
        }
    }
};
}

#define XB_TMO      128
#define XB_XCNT(j)  (256  + 64 * (j))
#define XB_XSUB(j)  (1280 + 64 * (j))
#define XB_XGEN(j)  (2304 + 64 * (j))
#define XB_TOP      3328
#define XB_TOPGEN   3392
#define XCD_BAR_WORDS 3456
#define XB_SPIN_CAP (1u << 18)
__device__ __forceinline__ unsigned xb_ld(unsigned* p)              { return __hip_atomic_load(p, __ATOMIC_RELAXED, __HIP_MEMORY_SCOPE_AGENT); }
__device__ __forceinline__ unsigned xb_add(unsigned* p, unsigned v) { return __hip_atomic_fetch_add(p, v, __ATOMIC_RELAXED, __HIP_MEMORY_SCOPE_AGENT); }
__device__ __forceinline__ unsigned xb_xcc_id() { return (unsigned)__builtin_amdgcn_s_getreg((3 << 11) | 20) & 0xFu; }
#define XB_SPIN(cond, bar) do { unsigned _sp = 0; while (cond) { __builtin_amdgcn_s_sleep(1); \
    if ((++_sp & 255u) == 0u) { if (xb_ld(&(bar)[XB_TMO])) break; if (_sp > XB_SPIN_CAP) { atomicAdd(&(bar)[XB_TMO], 1u); break; } } } } while (0)
struct XcdBarrier { unsigned* bar; unsigned x; volatile LAS unsigned* st; };
__device__ __forceinline__ XcdBarrier xcd_barrier_post(unsigned* bar, volatile LAS unsigned* st) {
    XcdBarrier b; b.bar = bar; b.x = xb_xcc_id(); b.st = st;
    if (threadIdx.x == 0) (void)xb_add(&bar[XB_XCNT(b.x)], 1u);
    return b;
}
__device__ __forceinline__ void xcd_barrier_complete(unsigned* bar, unsigned x, unsigned& nloc, unsigned& nx) {
    const unsigned G = gridDim.x * gridDim.y * gridDim.z;
    unsigned sum, cnt, mine, sp = 0u;
    for (;;) {
        sum = 0u; cnt = 0u; mine = 0u;
#pragma unroll
        for (unsigned j = 0; j < 16; ++j) { const unsigned c = xb_ld(&bar[XB_XCNT(j)]); sum += c; cnt += (c > 0u) ? 1u : 0u; mine = (j == x) ? c : mine; }
        if (sum == G) break;
        __builtin_amdgcn_s_sleep(1);
        if ((++sp & 255u) == 0u) { if (xb_ld(&bar[XB_TMO])) break; if (sp > XB_SPIN_CAP) { atomicAdd(&bar[XB_TMO], 1u); break; } }
    }
    nloc = mine > 0u ? mine : 1u; nx = cnt > 0u ? cnt : 1u;
}
__device__ __forceinline__ void xcd_barrier(const XcdBarrier& b) {
    asm volatile("s_waitcnt vmcnt(0)" ::: "memory");
    __syncthreads();
    if (threadIdx.x == 0) {
        unsigned* bar = b.bar;
        __builtin_amdgcn_s_waitcnt(0);
        unsigned nloc = b.st[0], nx = b.st[1];
        if (nloc == 0u) { xcd_barrier_complete(bar, b.x, nloc, nx); b.st[0] = nloc; b.st[1] = nx; }
        const unsigned old = xb_add(&bar[XB_XSUB(b.x)], 1u);
        const unsigned gen = old / nloc;
        if (old + 1u == (gen + 1u) * nloc) {
            __builtin_amdgcn_fence(__ATOMIC_RELEASE, "agent");
            asm volatile("s_waitcnt vmcnt(0)" ::: "memory");
            const unsigned og = xb_add(&bar[XB_TOP], 1u);
            const unsigned tg = og / nx;
            if (og + 1u == (tg + 1u) * nx) xb_add(&bar[XB_TOPGEN], 1u);
            else XB_SPIN(xb_ld(&bar[XB_TOPGEN]) == tg, bar);
            __builtin_amdgcn_fence(__ATOMIC_ACQUIRE, "agent");
            xb_add(&bar[XB_XGEN(b.x)], 1u);
            asm volatile("s_waitcnt vmcnt(0)" ::: "memory");
        } else {
            XB_SPIN(xb_ld(&bar[XB_XGEN(b.x)]) == gen, bar);
            __builtin_amdgcn_fence(__ATOMIC_ACQUIRE, "agent");
            asm volatile("s_waitcnt vmcnt(0)" ::: "memory");
        }
    }
    __syncthreads();
}

constexpr int NWAVES = 8;
struct Frame {
    LAS unsigned char* lds; volatile LAS unsigned* MISC; gu32* ctl;
    int tid, lane, wave, vcu, G;
    unsigned char* ws; unsigned char* dout;
};
__device__ __forceinline__ float wave_sum(float v) {
#pragma unroll
    for (int o = 1; o < 64; o <<= 1) v += __shfl_xor(v, o);
    return v;
}
__device__ __forceinline__ void transpose_item(const float* W, int N, int k0, int n0, bf16_t* WT, int ldw, size_t drow0, int dcol0, LAS float* scr, int lane) {
#pragma unroll 8
    for (int i = 0; i < 32; ++i) { const int kk = 2 * i + (lane >> 5); scr[kk * 33 + (lane & 31)] = W[(size_t)(k0 + kk) * N + n0 + (lane & 31)]; }
    LDS_WAIT(); asm volatile("" ::: "memory");
    const int c = lane & 7;
#pragma unroll
    for (int j = 0; j < 4; ++j) { const int n = (lane >> 3) + 8 * j; const LAS float* s = scr + (8 * c) * 33 + n;
        u32x4 o; o.x = cvt_pk_bf16(s[0 * 33], s[1 * 33]); o.y = cvt_pk_bf16(s[2 * 33], s[3 * 33]); o.z = cvt_pk_bf16(s[4 * 33], s[5 * 33]); o.w = cvt_pk_bf16(s[6 * 33], s[7 * 33]);
        *(GAS u32x4*)(WT + (drow0 + n) * (size_t)ldw + dcol0 + 8 * c) = o; }
    LDS_WAIT(); asm volatile("" ::: "memory");
}
__device__ __forceinline__ void transpose_item_f8(const float* W, int N, int k0, int n0, unsigned char* WT, int ldw, size_t drow0, int dcol0, LAS float* scr, int lane);
__device__ __forceinline__ void p0_convert(Frame& F, const float* x, const float* w_in, const float* w_pa, const float* w_pb, const float* w_out, const float* rw) {
    LAS float* scr = (LAS float*)(F.lds + F.wave * 17408);
    const int gw = F.vcu * NWAVES + F.wave, NGW = F.G * NWAVES;
    unsigned char* WIN = F.dout + DO_WIN; unsigned char* WCAT = F.dout + DO_WCAT; unsigned char* WOUT = F.ws + WS_WOUT;
    constexpr int I_IN = (D / 128) * (IN_COLS / 32), I_OUT = (D / 128) * (D / 32), I_PA = (256 / 128) * (D / 32), I_PB = (D / 128) * (D / 32);
    for (int it = gw; it < I_IN + I_OUT + I_PA + I_PB; it += NGW) {
        int r = it;
        if (r < I_IN) { const int nb = IN_COLS / 32; transpose_item_f8(w_in, IN_COLS, 128 * (r / nb), 32 * (r % nb), WIN, D, (size_t)(32 * (r % nb)), 128 * (r / nb), scr, F.lane); continue; } r -= I_IN;
        if (r < I_OUT) { const int nb = D / 32; transpose_item_f8(w_out, D, 128 * (r / nb), 32 * (r % nb), WOUT, D, (size_t)(32 * (r % nb)), 128 * (r / nb), scr, F.lane); continue; } r -= I_OUT;
        if (r < I_PA) { const int nb = D / 32; transpose_item_f8(w_pa, D, 128 * (r / nb), 32 * (r % nb), WCAT, OAB_P, (size_t)(32 * (r % nb)), 128 * (r / nb), scr, F.lane); continue; } r -= I_PA;
        { const int nb = D / 32; transpose_item_f8(w_pb, D, 128 * (r / nb), 32 * (r % nb), WCAT, OAB_P, (size_t)(32 * (r % nb)), 256 + 128 * (r / nb), scr, F.lane); }
    }
    { bf16_t* WRT = (bf16_t*)(F.ws + WS_WRT);
      for (int i = gw * 64 + F.lane; i < NEXP * D; i += NGW * 64) { const int e = i >> 10, k = i & (D - 1); const float w = rw[k * NEXP + e];
          const unsigned hi = cvt_pk_bf16(w, 0.f) & 0xffffu; const float r = w - __uint_as_float(hi << 16);
          WRT[i] = (bf16_t)hi; WRT[NEXP * D + i] = (bf16_t)(cvt_pk_bf16(r, 0.f) & 0xffffu); } }
    unsigned char* XQ = F.dout + DO_XB;
    const size_t n16 = (size_t)NTOK * D / 16;
    for (size_t i = (size_t)gw * 64 + F.lane; i < n16; i += (size_t)NGW * 64) {
        const f32x4 a = *(const GAS f32x4*)(x + i * 16), b = *(const GAS f32x4*)(x + i * 16 + 4), c = *(const GAS f32x4*)(x + i * 16 + 8), d = *(const GAS f32x4*)(x + i * 16 + 12);
        u32x4 o;
        o.x = pk4_fp8(clamp_fp8(a[0] * SXIN), clamp_fp8(a[1] * SXIN), clamp_fp8(a[2] * SXIN), clamp_fp8(a[3] * SXIN)); o.y = pk4_fp8(clamp_fp8(b[0] * SXIN), clamp_fp8(b[1] * SXIN), clamp_fp8(b[2] * SXIN), clamp_fp8(b[3] * SXIN));
        o.z = pk4_fp8(clamp_fp8(c[0] * SXIN), clamp_fp8(c[1] * SXIN), clamp_fp8(c[2] * SXIN), clamp_fp8(c[3] * SXIN)); o.w = pk4_fp8(clamp_fp8(d[0] * SXIN), clamp_fp8(d[1] * SXIN), clamp_fp8(d[2] * SXIN), clamp_fp8(d[3] * SXIN));
        *(GAS u32x4*)(XQ + i * 16) = o;
    }
}
__device__ __forceinline__ void transpose_item_f8(const float* W, int N, int k0, int n0, unsigned char* WT, int ldw, size_t drow0, int dcol0, LAS float* scr, int lane) {
    f32x4 wv[16];
#pragma unroll
    for (int i = 0; i < 16; ++i) wv[i] = *(const GAS f32x4*)(W + (size_t)(k0 + 8 * i + (lane >> 3)) * N + n0 + (lane & 7) * 4);
#pragma unroll
    for (int i = 0; i < 16; ++i) { LAS float* d = scr + (8 * i + (lane >> 3)) * 33 + (lane & 7) * 4; d[0] = wv[i][0]; d[1] = wv[i][1]; d[2] = wv[i][2]; d[3] = wv[i][3]; }
    LDS_WAIT(); asm volatile("" ::: "memory");
    const int c = lane & 7;
#pragma unroll
    for (int j = 0; j < 4; ++j) { const int n = (lane >> 3) + 8 * j; const LAS float* s = scr + (16 * c) * 33 + n;
        u32x4 o;
        o.x = pk4_fp8(clamp_fp8(s[0 * 33] * SW), clamp_fp8(s[1 * 33] * SW), clamp_fp8(s[2 * 33] * SW), clamp_fp8(s[3 * 33] * SW));
        o.y = pk4_fp8(clamp_fp8(s[4 * 33] * SW), clamp_fp8(s[5 * 33] * SW), clamp_fp8(s[6 * 33] * SW), clamp_fp8(s[7 * 33] * SW));
        o.z = pk4_fp8(clamp_fp8(s[8 * 33] * SW), clamp_fp8(s[9 * 33] * SW), clamp_fp8(s[10 * 33] * SW), clamp_fp8(s[11 * 33] * SW));
        o.w = pk4_fp8(clamp_fp8(s[12 * 33] * SW), clamp_fp8(s[13 * 33] * SW), clamp_fp8(s[14 * 33] * SW), clamp_fp8(s[15 * 33] * SW));
        *(GAS u32x4*)(WT + (drow0 + n) * (size_t)ldw + dcol0 + 16 * c) = o; }
    LDS_WAIT(); asm volatile("" ::: "memory");
}
__device__ __forceinline__ void p3_convert_moe(Frame& F, const float* w_gate, const float* w_up, const float* w_down, int wg, int nwg) {
    LAS float* scr = (LAS float*)(F.lds + F.wave * 17408);
    const int gw = wg * NWAVES + F.wave, NGW = nwg * NWAVES;
    unsigned char* WGU = F.ws + WS_WGU; unsigned char* WD = F.ws + WS_WD;
    constexpr int IPM = (D / 128) * (DFF / 32);
    for (int it = gw; it < NEXP * 3 * IPM; it += NGW) {
        const int e = it / (3 * IPM), r3 = it % (3 * IPM), which = r3 / IPM, r = r3 % IPM, kb = r / 32, nb = r % 32, k0 = 128 * kb, n0 = 32 * nb;
        const size_t moff = (size_t)e * D * DFF;
        if (which == 2) transpose_item_f8(w_down + moff, D, k0, n0, WD + moff, DFF, (size_t)n0, k0, scr, F.lane);
        else { const int pn = n0 >> 7, jj = n0 & 127; transpose_item_f8((which ? w_up : w_gate) + moff, DFF, k0, n0, WGU + 2 * moff, D, (size_t)(256 * pn + 128 * which + jj), k0, scr, F.lane); }
    }
}
typedef short v4i16_t __attribute__((ext_vector_type(4)));
__device__ __forceinline__ s16x4 tr_read(const LAS unsigned char* p) { return __builtin_bit_cast(s16x4, __builtin_amdgcn_ds_read_tr16_b64_v4i16((LAS v4i16_t*)p)); }
template <int C>
__device__ __forceinline__ void tr_read8(s16x4 (&r)[8], unsigned addr) {
#define TRR(i) asm volatile("ds_read_b64_tr_b16 %0, %1 offset:%2" : "=v"(r[i]) : "v"(addr), "n"(C * 4096 + (i) * 512))
    TRR(0); TRR(1); TRR(2); TRR(3); TRR(4); TRR(5); TRR(6); TRR(7);
#undef TRR
}
__device__ __forceinline__ void tr_wait8(s16x4 (&r)[8]) {
    asm volatile("s_waitcnt lgkmcnt(0)" : "+v"(r[0]), "+v"(r[1]), "+v"(r[2]), "+v"(r[3]), "+v"(r[4]), "+v"(r[5]), "+v"(r[6]), "+v"(r[7]));
}
template <int C>
__device__ __forceinline__ void pv_tile(s16x4 (&cur)[8], s16x4 (&prev)[8], bf16x8 (&pf)[2], bf16x8 (&pfprev)[2], unsigned vbase, const f32x16& Sc, f32x16 (&O)[2]) {
#pragma unroll
    for (int s = 0; s < 2; ++s) { u32x4 w; w.x = cvt_pk_bf16(Sc[8 * s + 0], Sc[8 * s + 1]); w.y = cvt_pk_bf16(Sc[8 * s + 2], Sc[8 * s + 3]);
        w.z = cvt_pk_bf16(Sc[8 * s + 4], Sc[8 * s + 5]); w.w = cvt_pk_bf16(Sc[8 * s + 6], Sc[8 * s + 7]); pf[s] = __builtin_bit_cast(bf16x8, w); }
    tr_read8<C>(cur, vbase);
    if (C > 0) { asm volatile("" :: "v"(prev[0]), "v"(prev[1]), "v"(prev[2]), "v"(prev[3]), "v"(prev[4]), "v"(prev[5]), "v"(prev[6]), "v"(prev[7]) : "memory");
                 asm volatile("" :: "v"(pfprev[0]), "v"(pfprev[1]) : "memory"); }
    tr_wait8(cur);
    __builtin_amdgcn_sched_barrier(0);
#pragma unroll
    for (int blk = 0; blk < 2; ++blk)
#pragma unroll
        for (int s = 0; s < 2; ++s) { const s16x4 lo = cur[(blk * 2 + s) * 2], hi = cur[(blk * 2 + s) * 2 + 1];
            O[blk] = __builtin_amdgcn_mfma_f32_32x32x16_bf16((bf16x8){lo[0], lo[1], lo[2], lo[3], hi[0], hi[1], hi[2], hi[3]}, pf[s], O[blk], 0, 0, 0); }
    __builtin_amdgcn_sched_barrier(0);
}
constexpr int ATT_KOFF = 0, ATT_QOFF = 12 * 2048, ATT_VOFF = 12 * 4096, ATT_STG = 24 * 4096, ATT_STGW = 4608;
static_assert(ATT_STG + 8 * ATT_STGW <= SCR_BYTES, "attention LDS map");
struct AKV { const unsigned char* qseq; const unsigned char* kseq; const bf16_t* vseq; int jt0, nkt, jq; };
__device__ __forceinline__ AKV attn_kv(const Frame& F, int U) {
    const unsigned char* HQ = F.ws + WS_HQ; AKV r;
    if (U < 2048) {
        const int b = U >> 8, kvh = (U >> 7) & 1, j = U & 127, hq = kvh * 8 + F.wave;
        r.qseq = HQ + HQ_QS + (size_t)(b * 16 + hq) * SEQ * 64; r.kseq = HQ + HQ_KS + (size_t)(b * 2 + kvh) * SEQ * 64; r.vseq = (const bf16_t*)(HQ + HQ_VS) + (size_t)(b * 2 + kvh) * SEQ * 64;
        r.jt0 = j - 4; r.nkt = 5; r.jq = j;
    } else {
        const int v = U - 2048, g = v >> 9, w_ = v & 511, b = w_ >> 6, x = w_ & 63, hh = x >> 4, y = x & 15;
        const int dil = (g == 0) ? 1 : (g == 1) ? 4 : 16;
        const int res = (g == 0) ? 0 : (g == 1) ? (y >> 2) : y;
        const int j0 = (g == 0) ? y * 8 : (g == 1) ? (y & 3) * 8 : 0;
        const size_t seq = ((size_t)((g * NB + b) * 4 + hh) * SEQ + (size_t)res * (SEQ / dil)) * 64;
        r.qseq = HQ + HQ_QD + seq; r.kseq = HQ + HQ_KD + seq; r.vseq = (const bf16_t*)(HQ + HQ_VD) + seq;
        r.jt0 = j0 - 4; r.nkt = 12; r.jq = j0 + F.wave;
    }
    return r;
}
__device__ __forceinline__ unsigned attn_koff(int lane) { return (unsigned)((lane >> 2) * 64 + (((lane & 3) ^ ((lane >> 4) & 3)) * 16)); }
__device__ __forceinline__ unsigned attn_voff(int lane) { return (unsigned)((lane >> 2) * 128 + (lane & 3) * 16); }
__device__ __forceinline__ void attn_issue_k(LAS unsigned char* lds, int lane, int wave, const AKV& u) {
    const unsigned koff = attn_koff(lane);
    for (int p = wave; p < u.nkt * 2; p += 8) {
        const int s = p >> 1, qt = p & 1; const int tj = u.jt0 + s; const size_t pos0 = (size_t)(32 * (tj >= 0 ? tj : 0) + 16 * qt);
        __builtin_amdgcn_global_load_lds((const unsigned*)((const char*)u.kseq + pos0 * 64 + koff), (LAS unsigned*)(lds + ATT_KOFF + s * 2048 + qt * 1024), 16, 0, 0);
    }
}
__device__ __forceinline__ void attn_issue_q(LAS unsigned char* lds, int lane, int wave, const AKV& u) {
    const unsigned koff = attn_koff(lane);
#pragma unroll
    for (int qt = 0; qt < 2; ++qt)
        __builtin_amdgcn_global_load_lds((const unsigned*)((const char*)u.qseq + (size_t)(32 * u.jq + 16 * qt) * 64 + koff), (LAS unsigned*)(lds + ATT_QOFF + wave * 2048 + qt * 1024), 16, 0, 0);
}
template <int NKT>
__device__ __forceinline__ int attn_issue_v(LAS unsigned char* lds, int lane, int wave, const AKV& u) {
    const int w4 = (wave + 4) & 7;
    const unsigned voff = attn_voff(lane);
#pragma unroll
    for (int i = 0; i < (NKT * 4 + 7) / 8; ++i) { const int p = w4 + 8 * i;
        if (p < NKT * 4) { const int s = p >> 2, qt = p & 3; const int tj = u.jt0 + s; const int blk = qt >> 1, part = qt & 1;
            const size_t pos0 = (size_t)(32 * (tj >= 0 ? tj : 0) + 16 * part);
            __builtin_amdgcn_global_load_lds((const unsigned*)((const char*)u.vseq + pos0 * 128 + blk * 64 + voff), (LAS unsigned*)(lds + ATT_VOFF + s * 4096 + blk * 2048 + part * 1024), 16, 0, 0); } }
    return NKT == 12 ? 6 : (w4 < 4 ? 3 : 2);
}
__device__ __forceinline__ void attn_wait(int n) {
#define AW(N) asm volatile("s_waitcnt vmcnt(" #N ")" ::: "memory")
    if (n == 11) AW(11); else if (n == 8) AW(8); else if (n == 7) AW(7); else if (n == 6) AW(6); else if (n == 5) AW(5); else if (n == 4) AW(4); else if (n == 3) AW(3); else if (n == 2) AW(2); else AW(0);
#undef AW
}
template <bool swa>
__device__ __forceinline__ void attn_unit(LAS unsigned char* lds, int lane, int wave, const AKV& u, int s0,
                                          float sl2, float sink2, bf16_t* ob, unsigned op, float* lseb, unsigned lsep, bool hasn, const AKV& nx) {
    const int i32 = lane & 31, h = lane >> 5;
    const int jq = u.jq;
    constexpr float QKS = SQ * SK, RQK = 1.0f / (SQ * SK), NEG_RAW = -1.0e30f;
    f32x16 bias;
#pragma unroll
    for (int r = 0; r < 16; ++r) { const int kk = (r & 3) + 8 * (r >> 2) + 4 * h; bias[r] = sl2 * QKS * (float)(kk - i32); }
    __builtin_amdgcn_s_barrier();
    asm volatile("" ::: "memory");
    f32x16 S[5];
    float m2 = sink2;
    const int kro = i32 * 64 + h * 8, ksw = (i32 >> 2) & 3;
    long qf[4];
#pragma unroll
    for (int d0 = 0; d0 < 4; ++d0) qf[d0] = *(const LAS long*)(lds + ATT_QOFF + wave * 2048 + kro + ((d0 ^ ksw) * 16));
    long kf[2][4];
#pragma unroll
    for (int c = 0; c < 5; ++c) {
        const bool tv = (jq - 4 + c) >= 0;
        const LAS unsigned char* ks = lds + ATT_KOFF + (s0 + c) * 2048 + kro;
#pragma unroll
        for (int d0 = 0; d0 < 4; ++d0) kf[c & 1][d0] = *(const LAS long*)(ks + ((d0 ^ ksw) * 16));
        if (c > 0) asm volatile("" :: "v"(kf[(c - 1) & 1][0]), "v"(kf[(c - 1) & 1][1]), "v"(kf[(c - 1) & 1][2]), "v"(kf[(c - 1) & 1][3]) : "memory");
        f32x16 a = bias;
#pragma unroll
        for (int d0 = 0; d0 < 4; ++d0) a = __builtin_amdgcn_mfma_f32_32x32x16_fp8_fp8(kf[c & 1][d0], qf[d0], a, 0, 0, 0);
        if (c == 0 || c == 4) {
#pragma unroll
            for (int r = 0; r < 16; ++r) { const int kk = (r & 3) + 8 * (r >> 2) + 4 * h;
                const bool ok = (c == 4) ? (kk <= i32) : (swa ? (kk > i32) : (kk >= i32));
                a[r] = ok ? a[r] : NEG_RAW; }
        }
        float mt = fmaxf(fmaxf(a[0], a[1]), a[2]);
#pragma unroll
        for (int r = 3; r < 15; r += 2) mt = fmaxf(fmaxf(mt, a[r]), a[r + 1]);
        mt = fmaxf(mt, a[15]);
        m2 = fmaxf(m2, __builtin_fmaf(mt, RQK, tv ? -sl2 * (float)(32 * (4 - c)) : NEG_RAW));
        S[c] = a;
    }
    m2 = fmaxf(m2, __shfl_xor(m2, 32));
    float l = 0.f;
#pragma unroll
    for (int c = 0; c < 5; ++c) {
        const float offc = ((jq - 4 + c) >= 0 ? -sl2 * (float)(32 * (4 - c)) : NEG_RAW) - m2;
#pragma unroll
        for (int r = 0; r < 16; ++r) { const float p = __builtin_amdgcn_exp2f(__builtin_fmaf(S[c][r], RQK, offc)); S[c][r] = p; l += p; }
    }
    l += __shfl_xor(l, 32);
    l += __builtin_amdgcn_exp2f(sink2 - m2);
    asm volatile("" :: "v"(kf[0][0]), "v"(kf[0][1]), "v"(kf[0][2]), "v"(kf[0][3]), "v"(kf[1][0]), "v"(kf[1][1]), "v"(kf[1][2]), "v"(kf[1][3]) : "memory");
    asm volatile("s_waitcnt vmcnt(0) lgkmcnt(0)" : "+v"(l) :: "memory");
    __builtin_amdgcn_s_barrier();
    asm volatile("" ::: "memory");
    if (hasn) { attn_issue_k(lds, lane, wave, nx); attn_issue_q(lds, lane, wave, nx); }
    f32x16 O[2]; O[0] = (f32x16){}; O[1] = (f32x16){};
    const int vaddr0 = ((lane >> 4) & 1) * 32 + (lane & 3) * 8 + (4 * h + ((lane & 15) >> 2)) * 64;
    const unsigned vbase = (unsigned)(size_t)(lds + ATT_VOFF) + (unsigned)(s0 * 4096 + vaddr0);
    s16x4 va[2][8]; bf16x8 pf[2][2];
    pv_tile<0>(va[0], va[1], pf[0], pf[1], vbase, S[0], O); pv_tile<1>(va[1], va[0], pf[1], pf[0], vbase, S[1], O); pv_tile<2>(va[0], va[1], pf[0], pf[1], vbase, S[2], O);
    pv_tile<3>(va[1], va[0], pf[1], pf[0], vbase, S[3], O); pv_tile<4>(va[0], va[1], pf[0], pf[1], vbase, S[4], O);
    asm volatile("" :: "v"(pf[0][0]), "v"(pf[0][1]), "v"(pf[1][0]), "v"(pf[1][1]) : "memory");
    asm volatile("" :: "v"(va[0][0]), "v"(va[0][1]), "v"(va[0][2]), "v"(va[0][3]), "v"(va[0][4]), "v"(va[0][5]), "v"(va[0][6]), "v"(va[0][7]) : "memory");
    asm volatile("" :: "v"(va[1][0]), "v"(va[1][1]), "v"(va[1][2]), "v"(va[1][3]), "v"(va[1][4]), "v"(va[1][5]), "v"(va[1][6]), "v"(va[1][7]) : "memory");
    __builtin_amdgcn_s_barrier();
    asm volatile("" ::: "memory");
    int nv = 0;
    if (hasn) { if (nx.nkt == 12) nv = attn_issue_v<12>(lds, lane, wave, nx); else nv = attn_issue_v<5>(lds, lane, wave, nx); }
    const float inv = 1.0f / l;
    LAS unsigned char* stg = lds + ATT_STG + wave * ATT_STGW;
    if (swa) {
        const float is = inv * SO;
#pragma unroll
        for (int blk = 0; blk < 2; ++blk)
#pragma unroll
            for (int g4 = 0; g4 < 4; ++g4) { const int d0 = blk * 32 + 8 * g4 + 4 * h;
                *(LAS unsigned*)(stg + i32 * 80 + d0) = pk4_fp8_pad(clamp_fp8(O[blk][4 * g4 + 0] * is), clamp_fp8(O[blk][4 * g4 + 1] * is), clamp_fp8(O[blk][4 * g4 + 2] * is), clamp_fp8(O[blk][4 * g4 + 3] * is)); }
        asm volatile("s_waitcnt lgkmcnt(0)" ::: "memory");
#pragma unroll
        for (int it = 0; it < 2; ++it) { const int row = it * 16 + (lane >> 2), ch = lane & 3;
            const u32x4 v = *(const LAS u32x4*)(stg + row * 80 + ch * 16);
            *(u32x4*)((char*)ob + (size_t)(32 * jq + row) * op + ch * 16) = v; }
    } else {
#pragma unroll
        for (int blk = 0; blk < 2; ++blk)
#pragma unroll
            for (int g4 = 0; g4 < 4; ++g4) { const int d0 = blk * 32 + 8 * g4 + 4 * h;
                u32x2 w; w.x = cvt_pk_bf16(O[blk][4 * g4 + 0] * inv, O[blk][4 * g4 + 1] * inv); w.y = cvt_pk_bf16(O[blk][4 * g4 + 2] * inv, O[blk][4 * g4 + 3] * inv);
                *(LAS u32x2*)(stg + i32 * 144 + d0 * 2) = w; }
        asm volatile("s_waitcnt lgkmcnt(0)" ::: "memory");
#pragma unroll
        for (int it = 0; it < 4; ++it) { const int row = it * 8 + (lane >> 3), ch = lane & 7;
            const u32x4 v = *(const LAS u32x4*)(stg + row * 144 + ch * 16);
            *(u32x4*)((char*)ob + (size_t)(32 * jq + row) * op + ch * 16) = v; }
    }
    if (lseb != nullptr && h == 0) lseb[(size_t)(32 * jq + i32) * lsep] = (m2 + __builtin_amdgcn_logf(l)) * LN2;
    attn_wait(hasn ? nv + (swa ? 2 : 5) : 0);
}
__device__ __forceinline__ void p2_attention(Frame& F, const float* sinks) {
    unsigned char* OAB = F.dout + DO_OAB; bf16_t* OAG = (bf16_t*)(F.ws + WS_OAG); float* LSE = (float*)(F.ws + WS_LSE);
    constexpr int NUNIT = 2048 + 1536;
    int U = F.vcu; if (U >= NUNIT) return;
    float snk0 = sinks[F.wave] * LOG2E, snk1 = sinks[8 + F.wave] * LOG2E;
    asm volatile("" : "+v"(snk0), "+v"(snk1));
    AKV cur = attn_kv(F, U);
    attn_issue_k(F.lds, F.lane, F.wave, cur);
    attn_issue_q(F.lds, F.lane, F.wave, cur);
    { const int nv0 = (cur.nkt == 12) ? attn_issue_v<12>(F.lds, F.lane, F.wave, cur) : attn_issue_v<5>(F.lds, F.lane, F.wave, cur); attn_wait(nv0); }
    for (;;) {
        const int Un = U + F.G; const bool hasn = Un < NUNIT;
        const AKV nxt = attn_kv(F, hasn ? Un : U);
        if (U < 2048) {
            const int b = U >> 8, kvh = (U >> 7) & 1, hq = kvh * 8 + F.wave;
            const float slope = exp2f(-8.0f * (float)(hq + 1) / 28.0f);
            attn_unit<true>(F.lds, F.lane, F.wave, cur, 0, slope * LOG2E, kvh ? snk1 : snk0, (bf16_t*)(OAB + (size_t)b * SEQ * OAB_P + 256 + hq * 64), OAB_P, nullptr, 0, hasn, nxt);
        } else {
            const int v = U - 2048, g = v >> 9, w_ = v & 511, b = w_ >> 6, x = w_ & 63, hh = x >> 4, y = x & 15;
            const int dil = (g == 0) ? 1 : (g == 1) ? 4 : 16;
            const int res = (g == 0) ? 0 : (g == 1) ? (y >> 2) : y;
            const size_t tok0 = (size_t)b * SEQ + res;
            const float slope = exp2f(-8.0f * (float)(16 + g * 4 + hh + 1) / 28.0f);
            attn_unit<false>(F.lds, F.lane, F.wave, cur, F.wave, slope * (float)dil * LOG2E, NEG_BIG,
                             OAG + ((size_t)g * NTOK + tok0) * 256 + hh * 64, (unsigned)(dil * 256 * 2), LSE + ((size_t)g * NTOK + tok0) * 4 + hh, (unsigned)(dil * 4), hasn, nxt);
        }
        if (!hasn) break;
        U = Un; cur = nxt;
    }
}
__device__ __forceinline__ void p3_merge(Frame& F) {
    const bf16_t* OAG = (const bf16_t*)(F.ws + WS_OAG); const float* LSE = (const float*)(F.ws + WS_LSE); unsigned char* OAB = F.dout + DO_OAB;
    const int gw = F.vcu * NWAVES + F.wave, NGW = F.G * NWAVES;
    for (int idx = gw; idx < NTOK / 2; idx += NGW) {
        const int tok = idx * 2 + (F.lane >> 5), c8 = F.lane & 31, hh = c8 >> 3;
        float ls[3]; u32x4 o[3];
#pragma unroll
        for (int g = 0; g < 3; ++g) { ls[g] = LSE[((size_t)g * NTOK + tok) * 4 + hh]; o[g] = *(const u32x4*)(OAG + ((size_t)g * NTOK + tok) * 256 + c8 * 8); }
        const float m = fmaxf(fmaxf(ls[0], ls[1]), ls[2]);
        float w[3]; float sum = 0.f;
#pragma unroll
        for (int g = 0; g < 3; ++g) { w[g] = __builtin_amdgcn_exp2f((ls[g] - m) * LOG2E); sum += w[g]; }
        const float is = 1.0f / sum; float r[8];
#pragma unroll
        for (int q = 0; q < 8; ++q) r[q] = 0.f;
#pragma unroll
        for (int g = 0; g < 3; ++g) { const float wg = w[g] * is;
            r[0] += wg * bf_lo(o[g].x); r[1] += wg * bf_hi(o[g].x); r[2] += wg * bf_lo(o[g].y); r[3] += wg * bf_hi(o[g].y);
            r[4] += wg * bf_lo(o[g].z); r[5] += wg * bf_hi(o[g].z); r[6] += wg * bf_lo(o[g].w); r[7] += wg * bf_hi(o[g].w); }
        u32x2 out; out.x = pk4_fp8(clamp_fp8(r[0] * SO), clamp_fp8(r[1] * SO), clamp_fp8(r[2] * SO), clamp_fp8(r[3] * SO)); out.y = pk4_fp8(clamp_fp8(r[4] * SO), clamp_fp8(r[5] * SO), clamp_fp8(r[6] * SO), clamp_fp8(r[7] * SO));
        *(u32x2*)(OAB + (size_t)tok * OAB_P + c8 * 8) = out;
    }
}

__device__ __forceinline__ void p6_router(Frame& F, const bf16_t* y, const float* stat, const float* gam, const float* bet, bf16_t* x1b, unsigned char* x1q, const float* rb, int cw_ecnt, size_t pe_off) {
    constexpr int WPITCH = 2064;
    constexpr int WIMG = 64 * WPITCH;
    constexpr int GOFF = WIMG + 2048;
    static_assert(GOFF + 8192 <= SCR_BYTES, "router LDS map");
    LAS int* wcnt = (LAS int*)(F.lds + WIMG + F.wave * 256); LAS int* wbase = wcnt + 32;
    int* petok = (int*)(F.ws + WS_PETOK + pe_off); float* pegate = (float*)(F.ws + WS_PEGATE + pe_off);
    const bf16_t* WRT = (const bf16_t*)(F.ws + WS_WRT);
    const int gw = F.vcu * NWAVES + F.wave, NGW = F.G * NWAVES, lane = F.lane, j = lane & 15, kq = lane >> 4;
    __syncthreads();
    for (int q = F.tid; q < 64 * 128; q += NWAVES * 64) { const u32x4 v = *(const u32x4*)((const char*)WRT + (size_t)q * 16); *(LAS u32x4*)(F.lds + (q >> 7) * WPITCH + (q & 127) * 16) = v; }
    for (int q = F.tid; q < 512; q += NWAVES * 64) { const f32x4 v = (q < 256) ? *(const f32x4*)(gam + q * 4) : *(const f32x4*)(bet + (q - 256) * 4); *(LAS f32x4*)(F.lds + GOFF + q * 16) = v; }
    __syncthreads();
    const LAS unsigned char* wrow = F.lds + j * WPITCH + kq * 16;
    const LAS float* gl = (const LAS float*)(F.lds + GOFF) + 8 * kq; const LAS float* bl = gl + 1024;
    for (int tb = F.vcu * NWAVES; tb < NTOK / 16; tb += NGW) {
        const int tt = tb + F.wave; const bool valid = tt < NTOK / 16; const int t0 = (valid ? tt : 0) * 16;
        float mean, rstd;
        { const f32x4* sp = (const f32x4*)(stat + (size_t)(t0 + j) * 32); float s1 = 0.f, s2 = 0.f;
#pragma unroll
          for (int q = 0; q < 8; ++q) { const f32x4 v = sp[q]; s1 += v[0] + v[2]; s2 += v[1] + v[3]; }
          mean = s1 * (1.0f / D); const float var = fmaxf(s2 * (1.0f / D) - mean * mean, 0.f); rstd = 1.0f / sqrtf(var + LN_EPS); }
        f32x4 acc[2]; acc[0] = (f32x4){0.f, 0.f, 0.f, 0.f}; acc[1] = acc[0];
        const bf16_t* yrow = y + (size_t)(t0 + j) * D + 8 * kq;
        bf16_t* xbrow = (valid ? x1b : (bf16_t*)(F.ws + 300 * MiB)) + (size_t)(t0 + j) * D + 8 * kq; unsigned char* xqrow = (valid ? x1q : F.ws + 300 * MiB) + (size_t)(t0 + j) * D + 8 * kq;
        bf16x8 wf[2][4]; wf[1][0] = (bf16x8){}; wf[1][1] = wf[1][0]; wf[1][2] = wf[1][0]; wf[1][3] = wf[1][0];
        u32x4 yv[4], yn[4];
#pragma unroll
        for (int u = 0; u < 4; ++u) yv[u] = *(const u32x4*)(yrow + 32 * u);
#pragma unroll 1
        for (int so = 0; so < D / 32; so += 4) {
            const int sn = (so + 4 < D / 32) ? so + 4 : so;
#pragma unroll
            for (int u = 0; u < 4; ++u) yn[u] = *(const u32x4*)(yrow + 32 * (sn + u));
#pragma unroll
            for (int u = 0; u < 4; ++u) { const int sI = so + u;
                wf[u & 1][0] = *(const LAS bf16x8*)(wrow + 64 * sI); wf[u & 1][1] = *(const LAS bf16x8*)(wrow + 16 * WPITCH + 64 * sI);
                wf[u & 1][2] = *(const LAS bf16x8*)(wrow + 32 * WPITCH + 64 * sI); wf[u & 1][3] = *(const LAS bf16x8*)(wrow + 48 * WPITCH + 64 * sI);
                const f32x4 g0 = *(const LAS f32x4*)(gl + 32 * sI), g1 = *(const LAS f32x4*)(gl + 32 * sI + 4), b0 = *(const LAS f32x4*)(bl + 32 * sI), b1 = *(const LAS f32x4*)(bl + 32 * sI + 4);
                asm volatile("" :: "v"(wf[(u + 1) & 1][0]), "v"(wf[(u + 1) & 1][1]), "v"(wf[(u + 1) & 1][2]), "v"(wf[(u + 1) & 1][3]) : "memory");
                f32x4 n0, n1;
                n0[0] = (bf_lo(yv[u].x) - mean) * rstd * g0[0] + b0[0]; n0[1] = (bf_hi(yv[u].x) - mean) * rstd * g0[1] + b0[1]; n0[2] = (bf_lo(yv[u].y) - mean) * rstd * g0[2] + b0[2]; n0[3] = (bf_hi(yv[u].y) - mean) * rstd * g0[3] + b0[3];
                n1[0] = (bf_lo(yv[u].z) - mean) * rstd * g1[0] + b1[0]; n1[1] = (bf_hi(yv[u].z) - mean) * rstd * g1[1] + b1[1]; n1[2] = (bf_lo(yv[u].w) - mean) * rstd * g1[2] + b1[2]; n1[3] = (bf_hi(yv[u].w) - mean) * rstd * g1[3] + b1[3];
                u32x4 xw; xw.x = cvt_pk_bf16(n0[0], n0[1]); xw.y = cvt_pk_bf16(n0[2], n0[3]); xw.z = cvt_pk_bf16(n1[0], n1[1]); xw.w = cvt_pk_bf16(n1[2], n1[3]);
                *(u32x4*)(xbrow + 32 * sI) = xw;
                { u32x2 q8; q8.x = pk4_fp8(clamp_fp8(n0[0] * SX), clamp_fp8(n0[1] * SX), clamp_fp8(n0[2] * SX), clamp_fp8(n0[3] * SX)); q8.y = pk4_fp8(clamp_fp8(n1[0] * SX), clamp_fp8(n1[1] * SX), clamp_fp8(n1[2] * SX), clamp_fp8(n1[3] * SX));
                  *(u32x2*)(xqrow + 32 * sI) = q8; }
                const bf16x8 xh = __builtin_bit_cast(bf16x8, xw);
                acc[0] = __builtin_amdgcn_mfma_f32_16x16x32_bf16(wf[u & 1][0], xh, acc[0], 0, 0, 0); acc[1] = __builtin_amdgcn_mfma_f32_16x16x32_bf16(wf[u & 1][1], xh, acc[1], 0, 0, 0);
                acc[0] = __builtin_amdgcn_mfma_f32_16x16x32_bf16(wf[u & 1][2], xh, acc[0], 0, 0, 0); acc[1] = __builtin_amdgcn_mfma_f32_16x16x32_bf16(wf[u & 1][3], xh, acc[1], 0, 0, 0); }
#pragma unroll
            for (int u = 0; u < 4; ++u) yv[u] = yn[u];
        }
        float lg[8];
#pragma unroll
        for (int q = 0; q < 8; ++q) lg[q] = acc[q >> 2][q & 3] + rb[16 * (q >> 2) + 4 * kq + (q & 3)];
        unsigned taken = 0u; float tv[4]; int ti[4];
#pragma unroll
        for (int k = 0; k < 4; ++k) {
            float bv = -3.0e38f; int bi = 64;
#pragma unroll
            for (int q = 0; q < 8; ++q) { const bool free_ = ((taken >> q) & 1u) == 0u; if (free_ && lg[q] > bv) { bv = lg[q]; bi = 16 * (q >> 2) + 4 * kq + (q & 3); } }
            const int mybi = bi;
#pragma unroll
            for (int o = 16; o < 64; o <<= 1) { const float ov = __shfl_xor(bv, o); const int oi = __shfl_xor(bi, o); const bool keep = (bv > ov) || (bv == ov && bi < oi); bv = keep ? bv : ov; bi = keep ? bi : oi; }
            tv[k] = bv; ti[k] = bi;
            if (bi == mybi && ((bi >> 2) & 3) == kq) taken |= 1u << (4 * (bi >> 4) + (bi & 3));
        }
        float gk[4]; float gs = 0.f;
#pragma unroll
        for (int k = 0; k < 4; ++k) { gk[k] = __builtin_amdgcn_exp2f((tv[k] - tv[0]) * LOG2E); gs += gk[k]; }
        const float gi = 1.0f / gs;
        if (lane < 32) wcnt[lane] = 0;
        asm volatile("s_waitcnt lgkmcnt(0)" ::: "memory");
        const int e0 = (kq == 0) ? ti[0] : (kq == 1) ? ti[1] : (kq == 2) ? ti[2] : ti[3];
        const float g0 = ((kq == 0) ? gk[0] : (kq == 1) ? gk[1] : (kq == 2) ? gk[2] : gk[3]) * gi;
        int r0 = 0;
        if (valid) r0 = __hip_atomic_fetch_add(wcnt + e0, 1, __ATOMIC_RELAXED, __HIP_MEMORY_SCOPE_WORKGROUP);
        asm volatile("s_waitcnt lgkmcnt(0)" ::: "memory");
        __syncthreads();
        if (F.wave == 0 && lane < 32) { int c[NWAVES]; int tot = 0;
#pragma unroll
            for (int w = 0; w < NWAVES; ++w) { c[w] = *(LAS int*)(F.lds + WIMG + w * 256 + 4 * lane); tot += c[w]; }
            int b = 0; if (tot > 0) b = (int)__hip_atomic_fetch_add((unsigned*)(F.ctl + cw_ecnt + 64 * lane), (unsigned)tot, RLX_AGENT);
#pragma unroll
            for (int w = 0; w < NWAVES; ++w) { *(LAS int*)(F.lds + WIMG + w * 256 + 128 + 4 * lane) = b; b += c[w]; } }
        asm volatile("s_waitcnt vmcnt(0) lgkmcnt(0)" ::: "memory");
        __syncthreads();
        if (valid) { const int p0 = wbase[e0] + r0;
            petok[(size_t)e0 * NTOK + p0] = (t0 + j) * 4 + kq; pegate[(size_t)e0 * NTOK + p0] = g0; }
        asm volatile("s_waitcnt lgkmcnt(0)" ::: "memory");
        __syncthreads();
    }
}
__device__ __forceinline__ int moe_tables(Frame& F) {
    LAS int* cnt = (LAS int*)(F.lds + MOE_OFF); LAS int* fs = (LAS int*)(F.lds + MOE_OFF + 128); LAS unsigned char* te = F.lds + MOE_OFF + 128 + 136;
    __syncthreads();
    if (F.tid < NEXP) cnt[F.tid] = (int)__hip_atomic_load(F.ctl + CW_ECNT + 64 * F.tid, RLX_AGENT);
    __syncthreads();
    if (F.tid == 0) { int s = 0; for (int e = 0; e < NEXP; ++e) { fs[e] = s; s += (cnt[e] + 255) >> 8; } fs[NEXP] = s; }
    __syncthreads();
    const int T = fs[NEXP];
    for (int t = F.tid; t < T; t += NWAVES * 64) { int e = 0;
#pragma unroll 8
        for (int q = 1; q < NEXP; ++q) e += (fs[q] <= t) ? 1 : 0;
        te[t] = (unsigned char)e; }
    __syncthreads();
    return T;
}
__device__ __forceinline__ void p9_final(Frame& F, const float* gam, const float* bet, const float* out, float* outw, bool poison) {
    const bf16_t* X1B = (const bf16_t*)(F.ws + WS_X1B);
    const int gw = F.vcu * NWAVES + F.wave, NGW = F.G * NWAVES, lane = F.lane;
    const float qnan = __builtin_nanf("");
    const f32x4 g0 = *(const f32x4*)(gam + lane * 16), g1 = *(const f32x4*)(gam + lane * 16 + 4), g2 = *(const f32x4*)(gam + lane * 16 + 8), g3 = *(const f32x4*)(gam + lane * 16 + 12);
    const f32x4 b0 = *(const f32x4*)(bet + lane * 16), b1 = *(const f32x4*)(bet + lane * 16 + 4), b2 = *(const f32x4*)(bet + lane * 16 + 8), b3 = *(const f32x4*)(bet + lane * 16 + 12);
    for (int tok0 = gw; tok0 < NTOK; tok0 += 2 * NGW) {
        u32x4 xa[2], xb[2], y0[2], y1[2], y2[2], y3[2];
#pragma unroll
        for (int tI = 0; tI < 2; ++tI) { const int tok = min(tok0 + tI * NGW, NTOK - 1);
            const unsigned char* y = (const unsigned char*)out + (size_t)tok * 4096 + lane * 16;
            xa[tI] = *(const u32x4*)(X1B + (size_t)tok * D + lane * 16); xb[tI] = *(const u32x4*)(X1B + (size_t)tok * D + lane * 16 + 8);
            y0[tI] = *(const u32x4*)(y); y1[tI] = *(const u32x4*)(y + 1024); y2[tI] = *(const u32x4*)(y + 2048); y3[tI] = *(const u32x4*)(y + 3072); }
#pragma unroll
        for (int tI = 0; tI < 2; ++tI) { const int tok = tok0 + tI * NGW; if (tok >= NTOK) break;
            float v[16];
#pragma unroll
            for (int w = 0; w < 4; ++w) { const unsigned xw = (w < 2) ? xa[tI][2 * w] : xb[tI][2 * (w - 2)], xw2 = (w < 2) ? xa[tI][2 * w + 1] : xb[tI][2 * (w - 2) + 1];
                v[4 * w + 0] = DN_ALPHA * bf_lo(xw); v[4 * w + 1] = DN_ALPHA * bf_hi(xw); v[4 * w + 2] = DN_ALPHA * bf_lo(xw2); v[4 * w + 3] = DN_ALPHA * bf_hi(xw2);
                f32x2 lo = __builtin_amdgcn_cvt_pk_f32_fp8((int)y0[tI][w], false) + __builtin_amdgcn_cvt_pk_f32_fp8((int)y1[tI][w], false) + __builtin_amdgcn_cvt_pk_f32_fp8((int)y2[tI][w], false) + __builtin_amdgcn_cvt_pk_f32_fp8((int)y3[tI][w], false);
                f32x2 hi = __builtin_amdgcn_cvt_pk_f32_fp8((int)y0[tI][w], true) + __builtin_amdgcn_cvt_pk_f32_fp8((int)y1[tI][w], true) + __builtin_amdgcn_cvt_pk_f32_fp8((int)y2[tI][w], true) + __builtin_amdgcn_cvt_pk_f32_fp8((int)y3[tI][w], true);
                v[4 * w + 0] += lo[0] * (1.0f / SY); v[4 * w + 1] += lo[1] * (1.0f / SY); v[4 * w + 2] += hi[0] * (1.0f / SY); v[4 * w + 3] += hi[1] * (1.0f / SY); }
            float s = 0.f;
#pragma unroll
            for (int q = 0; q < 16; ++q) s += v[q];
            const float mean = wave_sum(s) * (1.0f / D); float s2 = 0.f;
#pragma unroll
            for (int q = 0; q < 16; ++q) { v[q] -= mean; s2 += v[q] * v[q]; }
            const float rstd = 1.0f / sqrtf(wave_sum(s2) * (1.0f / D) + LN_EPS);
            f32x4 o0, o1, o2, o3;
#pragma unroll
            for (int q = 0; q < 4; ++q) { o0[q] = v[q] * rstd * g0[q] + b0[q]; o1[q] = v[4 + q] * rstd * g1[q] + b1[q]; o2[q] = v[8 + q] * rstd * g2[q] + b2[q]; o3[q] = v[12 + q] * rstd * g3[q] + b3[q]; }
            if (poison) { o0 = (f32x4){qnan, qnan, qnan, qnan}; o1 = o0; o2 = o0; o3 = o0; }
            float* op = outw + (size_t)tok * D + lane * 16;
            *(f32x4*)(op) = o0; *(f32x4*)(op + 4) = o1; *(f32x4*)(op + 8) = o2; *(f32x4*)(op + 12) = o3; }
    }
}
#define CAS __attribute__((address_space(4)))
__device__ __forceinline__ const float* arg_in(int i) {
    const unsigned char CAS* ka = (const unsigned char CAS*)__builtin_amdgcn_kernarg_segment_ptr();
    asm volatile("" : "+s"(ka));
    return *(const float* const CAS*)(ka + 8 * i);
}
struct Args { const float* in[18]; float* out; unsigned char* ws; int ph_lo, ph_hi; };
__global__ void __launch_bounds__(NWAVES * 64, 2) fwd_kernel(Args args) {
    extern __shared__ __attribute__((aligned(16))) unsigned char lds[];
    Frame F;
    F.lds = (LAS unsigned char*)lds;
    F.MISC = (volatile LAS unsigned*)(F.lds + MISC_OFF);
    F.tid = threadIdx.x; F.lane = F.tid & 63; F.wave = __builtin_amdgcn_readfirstlane(F.tid >> 6);
    F.G = gridDim.x; { const int bx = blockIdx.x; F.vcu = (F.G % 8 == 0) ? (bx % 8) * (F.G / 8) + bx / 8 : bx; }
    F.ws = args.ws; F.dout = (unsigned char*)args.out;
    F.ctl = (gu32*)(args.ws + WS_CTL);
    for (int u = F.tid; u < (LDS_BYTES - LDSCTL_OFF) / 4; u += NWAVES * 64) ((LAS unsigned*)(F.lds + LDSCTL_OFF))[u] = 0u;
    __syncthreads();
    XcdBarrier bar; bar.bar = (unsigned*)(F.ctl + CW_BAR); bar.x = 0; bar.st = nullptr;
    if (N_LAUNCHES == 1) bar = xcd_barrier_post((unsigned*)(F.ctl + CW_BAR), F.MISC + 8);
    const int lo = args.ph_lo, hi = args.ph_hi;
#ifdef ONLY_PHASE
#define IN(k) ((k) == ONLY_PHASE && lo <= (k) && (k) < hi)
#else
#define IN(k) (lo <= (k) && (k) < hi)
#endif
#define SEAM(k) do { if (IN(k) && IN((k) + 1)) xcd_barrier(bar); } while (0)
    unsigned char* HQ = F.ws + WS_HQ; unsigned char* SG = F.ws + WS_SG;

#define PHASE(k, ...) do { if (IN(k)) { __VA_ARGS__ if (DUP_PHASE == (k)) { __VA_ARGS__ } } } while (0)
    PHASE(0, p0_convert(F, arg_in(0), arg_in(1), arg_in(3), arg_in(4), arg_in(5), arg_in(8));); SEAM(0);
    PHASE(1,
        { const int gemm_wgs = (F.G == 256) ? 192 : F.G;
          if ((int)blockIdx.x < gemm_wgs) {
            pg8::Gemm g{(const char*)(F.dout + DO_XB), (const char*)(F.dout + DO_WIN), D, D, D / 128}; pg8::StaticOrder S; S.init(NTOK, IN_COLS, gemm_wgs, (int)blockIdx.x);
            pg8::EpiInProj E{HQ, SG, 1.0f / (SXIN * SW)};
            pg8::gemm_phase<pg8::EpiInProj, pg8::StaticOrder, true, false, true>(F.lds, g, S, E); }
          if (gemm_wgs == F.G) p3_convert_moe(F, arg_in(10), arg_in(12), arg_in(14), F.vcu, F.G);
          else if ((int)blockIdx.x >= gemm_wgs) p3_convert_moe(F, arg_in(10), arg_in(12), arg_in(14), (int)blockIdx.x - gemm_wgs, F.G - gemm_wgs); }
    ); SEAM(1);
    PHASE(2, p2_attention(F, arg_in(2));); SEAM(2);
    PHASE(3, p3_merge(F);); SEAM(3);
    PHASE(4,
        { pg8::Gemm g{(const char*)(F.dout + DO_OAB), (const char*)(F.dout + DO_WCAT), OAB_P, OAB_P, OAB_P / 128}; pg8::StaticOrder S; S.init(NTOK, D, F.G, (int)blockIdx.x);
        pg8::EpiGate E{SG, F.ws + WS_MRG};
        pg8::gemm_phase<pg8::EpiGate, pg8::StaticOrder, true, false, true>(F.lds, g, S, E); }
    ); SEAM(4);
    PHASE(5,
        { pg8::Gemm g{(const char*)(F.ws + WS_MRG), (const char*)(F.ws + WS_WOUT), D, D, D / 128}; pg8::StaticOrder S; S.init(NTOK, D, F.G, (int)blockIdx.x);
        pg8::EpiY E{arg_in(0), (bf16_t*)(F.ws + WS_Y), (float*)(F.ws + WS_STAT), 1.0f / (SM * SW)};
        pg8::gemm_phase<pg8::EpiY, pg8::StaticOrder, true, false, true>(F.lds, g, S, E); }
    ); SEAM(5);
    if (IN(6)) { if (DUP_PHASE == 6) p6_router(F, (const bf16_t*)(F.ws + WS_Y), (const float*)(F.ws + WS_STAT), arg_in(6), arg_in(7), (bf16_t*)(F.ws + 264 * MiB), F.ws + 330 * MiB, arg_in(9), CW_ECNT + 64 * NEXP, (size_t)362 * MiB - WS_PETOK);
        p6_router(F, (const bf16_t*)(F.ws + WS_Y), (const float*)(F.ws + WS_STAT), arg_in(6), arg_in(7), (bf16_t*)(F.ws + WS_X1B), F.ws + WS_X1Q, arg_in(9), CW_ECNT, 0); } SEAM(6);
    PHASE(7,
        { const int T = moe_tables(F);
        pg8::Gemm g{(const char*)(F.ws + WS_X1Q), (const char*)(F.ws + WS_WGU), D, D, D / 128};
        pg8::MoeOrder S{T, 8, F.G, (int)blockIdx.x, (const LAS int*)(F.lds + MOE_OFF), (const LAS int*)(F.lds + MOE_OFF + 128), (const LAS unsigned char*)(F.lds + MOE_OFF + 128 + 136),
                        (const int*)(F.ws + WS_PETOK), (size_t)2048 * D, true, (unsigned)D};
        pg8::EpiGU E{arg_in(11), arg_in(13), F.ws + WS_HDN, F.lds};
        pg8::gemm_phase<pg8::EpiGU, pg8::MoeOrder, true, true, true>(F.lds, g, S, E); }
    ); SEAM(7);
    PHASE(8,
        { const int T = moe_tables(F);
        pg8::Gemm g{(const char*)(F.ws + WS_HDN), (const char*)(F.ws + WS_WD), DFF, DFF, DFF / 128};
        pg8::MoeOrder S{T, 4, F.G, (int)blockIdx.x, (const LAS int*)(F.lds + MOE_OFF), (const LAS int*)(F.lds + MOE_OFF + 128), (const LAS unsigned char*)(F.lds + MOE_OFF + 128 + 136),
                        (const int*)(F.ws + WS_PETOK), (size_t)D * DFF, false, 0u};
        pg8::EpiDown E{arg_in(15), (const int*)(F.ws + WS_PETOK), (const float*)(F.ws + WS_PEGATE), F.dout, F.lds};
        pg8::gemm_phase<pg8::EpiDown, pg8::MoeOrder, true, false, true>(F.lds, g, S, E); }
    ); SEAM(8);
    if (IN(9)) {
        bool poison = (__hip_atomic_load(F.ctl + CW_TMO, RLX_AGENT) != 0u) || (__hip_atomic_load(F.ctl + CW_BAR + XB_TMO, RLX_AGENT) != 0u);
        if (DUP_PHASE == 9) p9_final(F, arg_in(16), arg_in(17), (const float*)F.dout, (float*)(F.ws + 194 * MiB), poison);
        p9_final(F, arg_in(16), arg_in(17), (const float*)F.dout, (float*)F.dout, poison);
    }
#undef PHASE
#undef IN
#undef SEAM
}

extern "C" void kernel_launch(void* const* d_in, const int* in_sizes, int n_in, void* d_out, int out_size, void* d_ws, size_t ws_size, hipStream_t stream) {
    static int grid = 0;
    if (grid == 0) {
        if (n_in != 18 || in_sizes[0] != NTOK * D || out_size != NTOK * D || ws_size < WS_END) { fprintf(stderr, "kernel_launch: unexpected shapes (n_in %d, ws %zu); nothing launched\n", n_in, ws_size); grid = -1; return; }
        int dev = 0, cus = 0, per_cu = 0;
        if (hipGetDevice(&dev) != hipSuccess || hipDeviceGetAttribute(&cus, hipDeviceAttributeMultiprocessorCount, dev) != hipSuccess) { grid = -1; return; }
        if (hipFuncSetAttribute((const void*)fwd_kernel, hipFuncAttributeMaxDynamicSharedMemorySize, LDS_BYTES) != hipSuccess) { fprintf(stderr, "kernel_launch: hipFuncSetAttribute failed\n"); grid = -1; return; }
        if (hipOccupancyMaxActiveBlocksPerMultiprocessor(&per_cu, (const void*)fwd_kernel, NWAVES * 64, LDS_BYTES) != hipSuccess || per_cu < 1) fprintf(stderr, "kernel_launch: occupancy query reports %d\n", per_cu);
        (void)hipGetLastError();
        grid = cus;
    }
    if (grid < 0) return;
    if (hipMemsetAsync((char*)d_ws + WS_CTL, 0, CTL_ZERO_BYTES, stream) != hipSuccess) return;
    Args a{};
    for (int i = 0; i < 18; ++i) a.in[i] = (const float*)d_in[i];
    a.out = (float*)d_out; a.ws = (unsigned char*)d_ws;
    if (N_LAUNCHES == 1) { a.ph_lo = 0; a.ph_hi = N_PHASES; hipLaunchKernelGGL(fwd_kernel, dim3(grid), dim3(NWAVES * 64), LDS_BYTES, stream, a); }
    else for (int p = 0; p < N_PHASES; ++p) { a.ph_lo = p; a.ph_hi = p + 1; hipLaunchKernelGGL(fwd_kernel, dim3(grid), dim3(NWAVES * 64), LDS_BYTES, stream, a); }
}
```

```cpp
#include <hip/hip_runtime.h>
#include <cstdio>
#include <cstdint>

#define GAS __attribute__((address_space(1)))
#define LAS __attribute__((address_space(3)))
typedef unsigned short bf16_t;
typedef short bf16x8 __attribute__((ext_vector_type(8)));
typedef short s16x4 __attribute__((ext_vector_type(4)));
typedef float f32x2 __attribute__((ext_vector_type(2)));
typedef float f32x4 __attribute__((ext_vector_type(4)));
typedef float f32x16 __attribute__((ext_vector_type(16)));
typedef unsigned u32x2 __attribute__((ext_vector_type(2)));
typedef unsigned u32x4 __attribute__((ext_vector_type(4)));
typedef GAS unsigned gu32;

#ifndef MK_N_LAUNCHES
#define MK_N_LAUNCHES 1
#endif
#ifndef DUP_PHASE
#define DUP_PHASE -1
#endif
constexpr int N_PHASES = 10;
constexpr int N_LAUNCHES = MK_N_LAUNCHES;

constexpr int NB = 8, SEQ = 4096, D = 1024, NTOK = NB * SEQ;
constexpr int HQ_P = 3584;
constexpr int SG_P = 2048;
constexpr int OAB_P = 1280;
constexpr int IN_COLS = 5632;
constexpr int NEXP = 32, TOPK = 4, DFF = 1024;
constexpr int MAX_MT = 544;
constexpr float LN_EPS = 1e-5f;
constexpr float DN_ALPHA = 1.189207115002721f;
constexpr float LOG2E = 1.4426950408889634f, LN2 = 0.6931471805599453f;
constexpr float QSCALE = 0.125f * LOG2E;
constexpr float NEG_BIG = -1e30f;

constexpr size_t MiB = 1u << 20;
constexpr size_t WS_CTL = 0, CTL_ZERO_BYTES = 1 * MiB;
constexpr size_t WS_XBUF = 1 * MiB;
constexpr size_t WS_Y = 194 * MiB;
constexpr size_t WS_STAT = 258 * MiB;
constexpr size_t WS_HQ = 2 * MiB;
constexpr size_t HQ_QD = 0, HQ_KD = 48 * MiB, HQ_VD = 96 * MiB, HQ_QS = 144 * MiB, HQ_KS = 208 * MiB, HQ_VS = 216 * MiB;
constexpr size_t WS_WGU = 404 * MiB;
constexpr size_t WS_WD = 468 * MiB;
constexpr size_t WS_X1B = 98 * MiB;
constexpr size_t WS_X1Q = 162 * MiB;
constexpr size_t WS_HDN = 194 * MiB;
constexpr size_t WS_SG = 226 * MiB;
constexpr size_t WS_YS23 = 330 * MiB;
constexpr size_t WS_OAG = 354 * MiB;
constexpr size_t WS_LSE = 402 * MiB;
constexpr size_t WS_MRG = 2 * MiB;
constexpr size_t WS_WOUT = 530 * MiB;
constexpr size_t WS_PETOK = 532 * MiB;
constexpr size_t WS_PEGATE = 536 * MiB;
constexpr size_t WS_WRT = 540 * MiB;
constexpr size_t WS_END = 540 * MiB + 256 * 1024;
constexpr float SX = 8.0f, SW = 512.0f, SH = 4.0f, SXIN = 8.0f, SY = 64.0f, SM = 64.0f, SO = 64.0f, SSG = 256.0f, SQ = 64.0f, SK = 16.0f;
static_assert(WS_HQ + (size_t)NTOK * HQ_P * 2 <= WS_SG && WS_SG + (size_t)NTOK * SG_P <= WS_OAG && WS_OAG + (size_t)3 * NTOK * 256 * 2 <= WS_LSE && WS_LSE + (size_t)3 * NTOK * 4 * 4 <= WS_WGU, "ws map 1");
static_assert(WS_WGU + (size_t)NEXP * 2048 * D <= WS_WD && WS_WD + (size_t)NEXP * D * DFF <= WS_WOUT && WS_MRG + (size_t)NTOK * D <= WS_X1B && WS_X1B + (size_t)NTOK * D * 2 <= WS_X1Q && WS_X1Q + (size_t)NTOK * D <= WS_HDN, "ws map 2");
static_assert(WS_HDN + (size_t)MAX_MT * 256 * DFF <= WS_OAG && WS_WOUT + (size_t)D * D <= WS_PETOK, "ws map 3");
constexpr size_t DO_XB = 0;
constexpr size_t DO_OAB = 0;
constexpr size_t DO_WIN = 96 * MiB;
constexpr size_t DO_WCAT = 108 * MiB;
constexpr int CW_TMO = 0, CW_CODE = 1;
constexpr int CW_BAR = 4096;
constexpr int CW_SEAM = 16384;
constexpr int CW_ECNT = 32768;
static_assert((CW_ECNT + 2 * 64 * NEXP) * 4 <= (int)CTL_ZERO_BYTES, "CTL words inside the memset region");

constexpr int RING_BYTES = 131072;
constexpr int SCR_BYTES = 143360;
constexpr int LDSCTL_OFF = SCR_BYTES;
constexpr int MISC_OFF = LDSCTL_OFF + 320;
constexpr int MOE_OFF = LDSCTL_OFF + 512;
constexpr int LDS_BYTES = 147456;
static_assert(MOE_OFF + 128 + 136 + MAX_MT <= LDS_BYTES, "LDS map");

#define RLX_AGENT __ATOMIC_RELAXED, __HIP_MEMORY_SCOPE_AGENT
#define LDS_WAIT() asm volatile("s_waitcnt lgkmcnt(0)" ::: "memory")
#define VM_WAIT() asm volatile("s_waitcnt vmcnt(0)" ::: "memory")

__device__ __forceinline__ unsigned cvt_pk_bf16(float lo, float hi) { unsigned r; asm volatile("v_cvt_pk_bf16_f32 %0, %1, %2" : "=v"(r) : "v"(lo), "v"(hi)); return r; }
__device__ __forceinline__ int opaque(int v) { asm volatile("" : "+v"(v)); return v; }
__device__ __forceinline__ unsigned pk4_fp8(float a, float b, float c, float d) { int w = 0; w = __builtin_amdgcn_cvt_pk_fp8_f32(a, b, w, false); w = __builtin_amdgcn_cvt_pk_fp8_f32(c, d, w, true); return (unsigned)w; }
__device__ __forceinline__ unsigned f2e4m3_sw(float x) {
    const float a = __builtin_amdgcn_fmed3f(fabsf(x), 9.5367431640625e-07f, 448.f);
    const int e1 = max(__builtin_amdgcn_frexp_expf(a), -5);
    const unsigned m = (unsigned)__builtin_rintf(__builtin_amdgcn_ldexpf(a, 4 - e1));
    return ((__float_as_uint(x) >> 24) & 0x80u) | (unsigned)((e1 << 3) + 40 + (int)m); }
__device__ __forceinline__ unsigned pk4_fp8_pad(float a, float b, float c, float d) {
    unsigned w;
    asm("v_cvt_pk_fp8_f32 %0, %1, %2\n\ts_nop 1" : "=v"(w) : "v"(a), "v"(b));
    asm("v_cvt_pk_fp8_f32 %0, %1, %2 op_sel:[0,0,1]\n\ts_nop 1" : "+v"(w) : "v"(c), "v"(d));
    return w; }
__device__ __forceinline__ float clamp_fp8(float v) { return __builtin_amdgcn_fmed3f(v, -448.0f, 448.0f); }
__device__ __forceinline__ float bf_lo(unsigned w) { return __uint_as_float(w << 16); }
__device__ __forceinline__ float bf_hi(unsigned w) { return __uint_as_float(w & 0xffff0000u); }
__device__ __forceinline__ float fast_sigmoid(float g) { g = fminf(fmaxf(g, -60.f), 60.f); return __builtin_amdgcn_rcpf(1.0f + __builtin_amdgcn_exp2f(-g * LOG2E)); }

namespace pg8 {
constexpr int BM = 256, BK = 64, HALF = 128, HTB = HALF * BK * 2, STAGE_BYTES = 8 * HTB, NXCD = 8, WGM = 8;
constexpr int EPRE_OFF = STAGE_BYTES;
static_assert(EPRE_OFF + 3072 <= SCR_BYTES, "epilogue prefetch area");
__host__ __device__ __forceinline__ int lds_byte(int r, int c) { const int st = (r >> 4) * 2 + (c >> 5), rr = r & 15, cc = c & 31, ob = rr * 64 + cc * 2; return st * 1024 + (ob ^ (((ob >> 9) & 1) << 5)); }
__host__ __device__ __forceinline__ void stage_rc(int b, int& R, int& C) { const int st = b / 1024, sb = b % 1024, swz = sb ^ (((sb >> 9) & 1) << 5); R = (st >> 1) * 16 + swz / 64; C = (st & 1) * 32 + (swz % 64) / 2; }
__host__ __device__ __forceinline__ int perm32(int rho) { const int n = rho >> 4, i = rho & 15; return 8 * (i >> 2) + 4 * n + (i & 3); }

struct Unit { int pm, pn, e, ti, valid; };
struct Gemm { const char* A; const char* Bt; int lda, ldb, nt; };

__device__ __forceinline__ bool tile_of(long L, int nM, int nN, int& pm, int& pn) {
    const int nwg = nM * nN; if (L >= nwg) return false;
    int wgid = (int)L; { const int q = nwg / NXCD, r = nwg % NXCD, xcd = wgid % NXCD, off = wgid / NXCD; wgid = (xcd < r ? xcd * (q + 1) : r * (q + 1) + (xcd - r) * q) + off; }
    const int nig = WGM * nN, gid = wgid / nig, fm = gid * WGM, gsz = (nM - fm) < WGM ? (nM - fm) : WGM;
    pm = fm + ((wgid % nig) % gsz); pn = (wgid % nig) / gsz; return true;
}
struct StaticOrder {
    int nM, nN, G, c;
    __device__ __forceinline__ void init(int M, int N, int G_, int c_) { nM = M / BM; nN = N / BM; G = G_; c = c_; }
    __device__ __forceinline__ bool next(int i, Unit& u) const { u.e = 0; u.ti = 0; u.valid = 256; return tile_of((long)i * G + c, nM, nN, u.pm, u.pn); }
    __device__ __forceinline__ const char* a_ptr(const Gemm& g, const Unit& u) const { return g.A + (size_t)u.pm * 256 * g.lda; }
    __device__ __forceinline__ const char* b_ptr(const Gemm& g, const Unit& u) const { return g.Bt + (size_t)u.pn * 256 * g.ldb; }
    __device__ __forceinline__ unsigned row_off(const Unit&, int) const { return 0u; }
};
struct MoeOrder {
    int T, nN, G, c; const LAS int* cnt; const LAS int* fs; const LAS unsigned char* te;
    const int* petok; size_t b_exp_stride; bool gather; unsigned rowbytes;
    __device__ __forceinline__ bool next(int i, Unit& u) const {
        if (!tile_of((long)i * G + c, T, nN, u.pm, u.pn)) return false;
        u.e = __builtin_amdgcn_readfirstlane((int)te[u.pm]); u.ti = u.pm - __builtin_amdgcn_readfirstlane(fs[u.e]); const int left = __builtin_amdgcn_readfirstlane(cnt[u.e]) - u.ti * 256; u.valid = left < 256 ? left : 256; return true;
    }
    __device__ __forceinline__ const char* a_ptr(const Gemm& g, const Unit& u) const { return gather ? g.A : g.A + (size_t)u.pm * 256 * g.lda; }
    __device__ __forceinline__ const char* b_ptr(const Gemm& g, const Unit& u) const { return g.Bt + (size_t)u.e * b_exp_stride + (size_t)u.pn * 256 * g.ldb; }
    __device__ __forceinline__ unsigned row_off(const Unit& u, int R) const {
        int tok = 0; if (R < u.valid) tok = petok[(size_t)u.e * NTOK + u.ti * 256 + R] >> 2;
        return (unsigned)tok * rowbytes;
    }
};

typedef int v8i32 __attribute__((ext_vector_type(8)));
template <class Epi, class Sched, bool ALIGN_EPI, bool GATHER, bool F8 = false>
__device__ __forceinline__ void gemm_phase(LAS unsigned char* lds, const Gemm g, const Sched& S, const Epi& E) {
    const int tid = threadIdx.x, wid = __builtin_amdgcn_readfirstlane(tid >> 6), lane = tid & 63, wr = wid >> 2, wc = wid & 3, fr = lane & 15, fq = lane >> 4;
    const int nt = g.nt;
    unsigned voffA[2], voffB[2]; int RA[2], CA2[2];
#pragma unroll
    for (int i = 0; i < 2; ++i) { int R, C; stage_rc(tid * 16 + i * 8192, R, C); const int Rb = Epi::PERM ? ((R & ~31) + perm32(R & 31)) : R;
        voffA[i] = (unsigned)(R * g.lda + C * 2); voffB[i] = (unsigned)(Rb * g.ldb + C * 2); RA[i] = R; CA2[i] = C * 2; }
    const size_t kstep = (size_t)(BK * 2);
    const size_t hstepA = (size_t)HALF * g.lda, hstepB = (size_t)HALF * g.ldb;
    const unsigned ldsw = (unsigned)wid * 1024u;
    const int aoff = lds_byte(wr * 64 + fr, fq * 8), boff = lds_byte(wc * 32 + fr, fq * 8);
    const int aoff0 = aoff, boff0 = boff, aoff1 = aoff + 1024, boff1 = boff + 1024;
#define PG8_SA(b, h) (((b) * 2 + (h)) * HTB)
#define PG8_SB(b, h) ((4 + (b) * 2 + (h)) * HTB)
#define PG8_STAGE(bufoff, gbase, voff) do { _Pragma("unroll") for (int _i = 0; _i < 2; ++_i) \
        __builtin_amdgcn_global_load_lds((const unsigned*)((const char*)(gbase) + (voff)[_i]), (LAS unsigned*)(lds + (bufoff) + ldsw + _i * 8192), 16, 0, 0); } while (0)
#define PG8_STAGE_A(bufoff, kp, h, nx) do { if constexpr (GATHER) { unsigned _v[2]; _v[0] = (nx) ? gN[h][0] : gC[h][0]; _v[1] = (nx) ? gN[h][1] : gC[h][1]; PG8_STAGE(bufoff, kp, _v); } \
        else { PG8_STAGE(bufoff, (kp) + (h) * hstepA, voffA); } } while (0)
#define PG8_LDA(dst, b, h) do { _Pragma("unroll") for (int m = 0; m < 4; ++m) _Pragma("unroll") for (int k = 0; k < 2; ++k) dst[m][k] = *(const LAS bf16x8*)(lds + PG8_SA(b, h) + (k ? aoff1 : aoff0) + m * 2048); } while (0)
#define PG8_LDB(dst, b, h) do { _Pragma("unroll") for (int n = 0; n < 2; ++n) _Pragma("unroll") for (int k = 0; k < 2; ++k) dst[n][k] = *(const LAS bf16x8*)(lds + PG8_SB(b, h) + (k ? boff1 : boff0) + n * 2048); } while (0)
#define PG8_F8OP(X) __builtin_bit_cast(v8i32, __builtin_shufflevector(X[0], X[1], 0, 1, 2, 3, 4, 5, 6, 7, 8, 9, 10, 11, 12, 13, 14, 15))
#define PG8_MMA(ai, bj, At, Bt) do { __builtin_amdgcn_s_setprio(1); if constexpr (F8) { _Pragma("unroll") for (int m = 0; m < 4; ++m) _Pragma("unroll") for (int n = 0; n < 2; ++n) \
        asm volatile("v_mfma_scale_f32_16x16x128_f8f6f4 %0, %1, %2, %0, %3, %3 op_sel_hi:[0,0,0]" : "+v"(acc[ai][bj][m][n]) : "v"(PG8_F8OP(Bt[n])), "v"(PG8_F8OP(At[m])), "v"(one_scale)); } \
        else { _Pragma("unroll") for (int m = 0; m < 4; ++m) _Pragma("unroll") for (int n = 0; n < 2; ++n) _Pragma("unroll") for (int k = 0; k < 2; ++k) \
        acc[ai][bj][m][n] = __builtin_amdgcn_mfma_f32_16x16x32_bf16(Bt[n][k], At[m][k], acc[ai][bj][m][n], 0, 0, 0); } __builtin_amdgcn_s_setprio(0); } while (0)
#define PG8_WAIT_V(n) asm volatile("s_waitcnt vmcnt(" #n ")" ::: "memory")
#define PG8_WAIT_L(n) asm volatile("s_waitcnt lgkmcnt(" #n ")" ::: "memory")
#define PG8_BAR __builtin_amdgcn_s_barrier()
#define PG8_SCHED __builtin_amdgcn_sched_barrier(0)
    Unit cur, nxt; int ui = 0;
    if (!S.next(0, cur)) return;
    int one_scale = 0x7f7f7f7f; if constexpr (F8) asm volatile("" : "+v"(one_scale));
    unsigned gC[2][2], gN[2][2];
#pragma unroll
    for (int h = 0; h < 2; ++h)
#pragma unroll
        for (int i = 0; i < 2; ++i) { gC[h][i] = GATHER ? S.row_off(cur, h * HALF + RA[i]) + (unsigned)CA2[i] : 0u; gN[h][i] = gC[h][i]; }
    f32x4 acc[2][2][4][2];
#pragma unroll
    for (int a = 0; a < 2; ++a)
#pragma unroll
        for (int b = 0; b < 2; ++b)
#pragma unroll
            for (int m = 0; m < 4; ++m)
#pragma unroll
                for (int n = 0; n < 2; ++n) acc[a][b][m][n] = (f32x4){0.f, 0.f, 0.f, 0.f};
    bf16x8 At[4][2], B0[2][2], B1[2][2];
    const char* cA = S.a_ptr(g, cur); const char* cB = S.b_ptr(g, cur);
    PG8_STAGE(PG8_SB(0, 0), cB, voffB); PG8_STAGE(PG8_SB(0, 1), cB + hstepB, voffB); PG8_STAGE_A(PG8_SA(0, 0), cA, 0, false); PG8_STAGE_A(PG8_SA(0, 1), cA, 1, false);
    if (wr == 1) PG8_BAR;
    PG8_WAIT_V(2); PG8_BAR;
    PG8_STAGE(PG8_SB(1, 0), cB + kstep, voffB); PG8_STAGE_A(PG8_SA(1, 0), cA + kstep, 0, false); PG8_STAGE(PG8_SB(1, 1), cB + hstepB + kstep, voffB);
    PG8_WAIT_V(6); PG8_BAR;
    for (;;) {
        const bool has_next = S.next(ui + 1, nxt);
        const char* nA = has_next ? S.a_ptr(g, nxt) : cA; const char* nB = has_next ? S.b_ptr(g, nxt) : cB;
        if constexpr (GATHER) { if (has_next) {
#pragma unroll
            for (int h = 0; h < 2; ++h)
#pragma unroll
                for (int i = 0; i < 2; ++i) gN[h][i] = S.row_off(nxt, h * HALF + RA[i]) + (unsigned)CA2[i]; } }
#pragma unroll 1
        for (int t = 0; t < nt; t += 2) {
            const bool last = (t == nt - 2);
            asm volatile("" : "+v"(voffA[0]), "+v"(voffA[1]), "+v"(voffB[0]), "+v"(voffB[1]));
            if constexpr (Epi::HAS_MID) { if (t == Epi::MID_T) E.mid(acc, cur, wr, wc, fr, fq); }
            if constexpr (Epi::HAS_PRE) { if (last) E.pre(lds, cur, wid, lane); }
            const char* a1 = cA + (size_t)(t + 1) * kstep;
            const char* a2 = last ? nA : cA + (size_t)(t + 2) * kstep; const char* b2 = last ? nB : cB + (size_t)(t + 2) * kstep;
            const char* a3 = a2 + kstep; const char* b3 = b2 + kstep;
            PG8_LDB(B0, 0, 0); PG8_LDB(B1, 0, 1); PG8_SCHED; PG8_LDA(At, 0, 0); PG8_STAGE_A(PG8_SA(1, 1), a1, 1, false);
            PG8_WAIT_V(8); PG8_WAIT_L(0); PG8_BAR; PG8_MMA(0, 0, At, B0); PG8_MMA(0, 1, At, B1); PG8_BAR; PG8_SCHED;
            PG8_LDA(At, 0, 1); PG8_STAGE(PG8_SB(0, 0), b2, voffB); PG8_STAGE(PG8_SB(0, 1), b2 + hstepB, voffB); PG8_STAGE_A(PG8_SA(0, 0), a2, 0, last);
            PG8_WAIT_V(8); PG8_WAIT_L(0); PG8_BAR; PG8_MMA(1, 0, At, B0); PG8_MMA(1, 1, At, B1); PG8_BAR; PG8_SCHED;
            PG8_LDB(B0, 1, 0); PG8_LDB(B1, 1, 1); PG8_SCHED; PG8_LDA(At, 1, 0); PG8_STAGE_A(PG8_SA(0, 1), a2, 1, last);
            PG8_WAIT_V(8); PG8_WAIT_L(0); PG8_BAR; PG8_MMA(0, 0, At, B0); PG8_MMA(0, 1, At, B1); PG8_BAR; PG8_SCHED;
            PG8_LDA(At, 1, 1); PG8_STAGE(PG8_SB(1, 0), b3, voffB); PG8_STAGE(PG8_SB(1, 1), b3 + hstepB, voffB); PG8_STAGE_A(PG8_SA(1, 0), a3, 0, last);
            PG8_WAIT_V(8); PG8_WAIT_L(0); PG8_BAR; PG8_MMA(1, 0, At, B0); PG8_MMA(1, 1, At, B1); PG8_BAR; PG8_SCHED;
        }
        if constexpr (ALIGN_EPI) { if (wr == 0) PG8_BAR; }
        if constexpr (F8) asm volatile("s_nop 15\n\ts_nop 15" ::: "memory");
        if constexpr (!Epi::AFTER_DRAIN) { E(acc, cur, wr, wc, fr, fq); }
        if (!has_next) break;
#pragma unroll
        for (int a = 0; a < 2; ++a)
#pragma unroll
            for (int b = 0; b < 2; ++b)
#pragma unroll
                for (int m = 0; m < 4; ++m)
#pragma unroll
                    for (int n = 0; n < 2; ++n) acc[a][b][m][n] = (f32x4){0.f, 0.f, 0.f, 0.f};
        cur = nxt; cA = nA; cB = nB; ++ui;
#pragma unroll
        for (int h = 0; h < 2; ++h)
#pragma unroll
            for (int i = 0; i < 2; ++i) gC[h][i] = gN[h][i];
        if constexpr (ALIGN_EPI) { if (wr == 1) PG8_BAR; }
    }
    PG8_WAIT_V(0);
    if constexpr (!ALIGN_EPI) { if (wr == 0) PG8_BAR; }
    PG8_BAR;
    if constexpr (Epi::AFTER_DRAIN) { E.fused(acc, cur, wr, wc, fr, fq, lds, wid, lane); }
#undef PG8_SA
#undef PG8_SB
#undef PG8_STAGE
#undef PG8_STAGE_A
#undef PG8_LDA
#undef PG8_LDB
#undef PG8_MMA
#undef PG8_F8OP
#undef PG8_WAIT_V
#undef PG8_WAIT_L
#undef PG8_BAR
#undef PG8_SCHED
}
}

namespace pg8 {
__device__ __forceinline__ u32x4 pair16(u32x2 x, u32x2 y) {
    const auto sx = __builtin_amdgcn_permlane16_swap(x.x, y.x, false, false), sy = __builtin_amdgcn_permlane16_swap(x.y, y.y, false, false);
    u32x4 o; o.x = sx[0]; o.y = sy[0]; o.z = sx[1]; o.w = sy[1]; return o; }
__device__ __forceinline__ void unpair16(u32x4 v, u32x2& x, u32x2& y) {
    const auto sx = __builtin_amdgcn_permlane16_swap(v.x, v.z, false, false), sy = __builtin_amdgcn_permlane16_swap(v.y, v.w, false, false);
    x.x = sx[0]; x.y = sy[0]; y.x = sx[1]; y.y = sy[1]; }
struct EpiInProj {
    static constexpr bool PERM = true, AFTER_DRAIN = false, HAS_MID = false, HAS_PRE = false; static constexpr int MID_T = 0;
    unsigned char* HQ; unsigned char* SG; float rs;
    __device__ __forceinline__ void mid(f32x4 (&)[2][2][4][2], const Unit&, int, int, int, int) const {}
    __device__ __forceinline__ void operator()(const f32x4 (&acc)[2][2][4][2], const Unit& u, int wr, int wc, int fr, int fq) const {
        const int row0 = u.pm * BM + wr * 64 + opaque(fr), pn = u.pn;
        const bool gate = pn >= 14; const bool qs = (pn < 3) || (pn >= 9 && pn < 13);
        const float sc = (qs ? QSCALE : 1.0f) * rs; const int dcol = (wc & 1) * 32 + 8 * fq;
        const int fqo = fq & 1; const float nrl = -rs * LOG2E;
#pragma unroll
        for (int ai = 0; ai < 2; ++ai)
#pragma unroll
            for (int m = 0; m < 4; ++m) { const int row = row0 + ai * HALF + m * 16, b = row >> 12, t = row & (SEQ - 1);
                if (gate || pn < 6 || (pn >= 9 && pn < 13)) {
                    u32x2 w8[2];
#pragma unroll
                    for (int bj = 0; bj < 2; ++bj) { f32x4 v0 = acc[ai][bj][m][0], v1 = acc[ai][bj][m][1];
                        if (gate) {
#pragma unroll
                            for (int q = 0; q < 4; ++q) {
                                v0[q] = fmaxf(__builtin_amdgcn_rcpf(__builtin_fmaf(__builtin_amdgcn_exp2f(v0[q] * nrl), 1.0f / SSG, 1.0f / SSG)), 0.001953125f);
                                v1[q] = fmaxf(__builtin_amdgcn_rcpf(__builtin_fmaf(__builtin_amdgcn_exp2f(v1[q] * nrl), 1.0f / SSG, 1.0f / SSG)), 0.001953125f); }
                            w8[bj].x = pk4_fp8(v0[0], v0[1], v0[2], v0[3]); w8[bj].y = pk4_fp8(v1[0], v1[1], v1[2], v1[3]); }
                        else { const float qk = sc * ((pn >= 3 && pn < 6) ? SK : SQ); v0 = v0 * qk; v1 = v1 * qk;
                            w8[bj].x = pk4_fp8(clamp_fp8(v0[0]), clamp_fp8(v0[1]), clamp_fp8(v0[2]), clamp_fp8(v0[3])); w8[bj].y = pk4_fp8(clamp_fp8(v1[0]), clamp_fp8(v1[1]), clamp_fp8(v1[2]), clamp_fp8(v1[3])); } }
                    unsigned char* dp;
                    if (gate) dp = SG + (size_t)row * SG_P + (pn - 14) * 256 + wc * 32 + 8 * fq + (fqo ? HALF - 8 : 0);
                    else { const int hl = (wc >> 1) + 2 * fqo; size_t rowi; unsigned char* base8;
                        if (pn < 9) { const int ty = pn / 3, g = pn - 3 * ty, sh = 2 * g, pos = ((t & ((1 << sh) - 1)) << (12 - sh)) + (t >> sh);
                            rowi = (size_t)(((g * NB + b) * 4 + hl) * SEQ + pos); base8 = HQ + (size_t)ty * (48 * MiB); }
                        else { rowi = (size_t)((b * 16 + (pn - 9) * 4 + hl) * SEQ + t); base8 = HQ + HQ_QS; }
                        dp = base8 + rowi * 64 + dcol - 8 * fqo; }
                    *(u32x4*)dp = pair16(w8[0], w8[1]);
                    continue; }
#pragma unroll
                for (int bj = 0; bj < 2; ++bj) { f32x4 v0 = acc[ai][bj][m][0], v1 = acc[ai][bj][m][1];
                    bf16_t* dst;
                    if (gate) {
#pragma unroll
                        for (int q = 0; q < 4; ++q) { v0[q] = fmaxf(fast_sigmoid(v0[q] * rs) * SSG, 0.001953125f); v1[q] = fmaxf(fast_sigmoid(v1[q] * rs) * SSG, 0.001953125f); }
                        u32x2 w8; w8.x = pk4_fp8(v0[0], v0[1], v0[2], v0[3]); w8.y = pk4_fp8(v1[0], v1[1], v1[2], v1[3]);
                        *(u32x2*)(SG + (size_t)row * SG_P + (pn - 14) * 256 + bj * HALF + wc * 32 + 8 * fq) = w8; continue; }
                    else { v0 = v0 * sc; v1 = v1 * sc; const int hl = bj * 2 + (wc >> 1);
                        size_t rowi; unsigned char* base8; float qk; bool is8;
                        if (pn < 9) { const int ty = pn / 3, g = pn - 3 * ty, sh = 2 * g, pos = ((t & ((1 << sh) - 1)) << (12 - sh)) + (t >> sh);
                            rowi = (size_t)(((g * NB + b) * 4 + hl) * SEQ + pos); base8 = HQ + (size_t)ty * (48 * MiB); is8 = ty < 2; qk = ty == 0 ? SQ : SK; }
                        else if (pn < 13) { rowi = (size_t)((b * 16 + (pn - 9) * 4 + hl) * SEQ + t); base8 = HQ + HQ_QS; is8 = true; qk = SQ; }
                        else { rowi = (size_t)((b * 2 + (wc >> 1)) * SEQ + t); base8 = HQ + (bj ? HQ_VS : HQ_KS); is8 = (bj == 0); qk = SK; }
                        if (is8) { u32x2 w8; w8.x = pk4_fp8(clamp_fp8(v0[0] * qk), clamp_fp8(v0[1] * qk), clamp_fp8(v0[2] * qk), clamp_fp8(v0[3] * qk)); w8.y = pk4_fp8(clamp_fp8(v1[0] * qk), clamp_fp8(v1[1] * qk), clamp_fp8(v1[2] * qk), clamp_fp8(v1[3] * qk));
                            *(u32x2*)(base8 + rowi * 64 + dcol) = w8; continue; }
                        dst = (bf16_t*)base8 + rowi * 64 + dcol; }
                    u32x4 w; w.x = cvt_pk_bf16(v0[0], v0[1]); w.y = cvt_pk_bf16(v0[2], v0[3]); w.z = cvt_pk_bf16(v1[0], v1[1]); w.w = cvt_pk_bf16(v1[2], v1[3]);
                    *(u32x4*)dst = w; } }
    }
};
struct EpiGate {
    static constexpr bool PERM = true, AFTER_DRAIN = false, HAS_MID = true, HAS_PRE = false; static constexpr int MID_T = 2;
    const unsigned char* __restrict__ SG; unsigned char* __restrict__ O;
    __device__ __forceinline__ void mid(f32x4 (&acc)[2][2][4][2], const Unit& u, int wr, int wc, int fr, int fq) const {
        const int row0 = u.pm * BM + wr * 64 + opaque(fr), col0 = u.pn * BM + wc * 32 + 8 * opaque(fq);
        const int cswz = ((col0 >> 3) & 1) ? (HALF - 8) : 0;
#pragma unroll
        for (int ai = 0; ai < 2; ++ai) {
            u32x2 a[4][2], b[4][2];
#pragma unroll
            for (int mm = 0; mm < 4; ++mm) { const unsigned char* sp = SG + (size_t)(row0 + ai * HALF + mm * 16) * SG_P + col0 + cswz;
                const u32x4 la = *(const u32x4*)sp, lb = *(const u32x4*)(sp + 1024); unpair16(la, a[mm][0], a[mm][1]); unpair16(lb, b[mm][0], b[mm][1]); }
#pragma unroll
            for (int m = 0; m < 4; ++m) {
#pragma unroll
                for (int bj = 0; bj < 2; ++bj) {
#pragma unroll
                    for (int n = 0; n < 2; ++n) { const int aw = (int)a[m][bj][n], bw = (int)b[m][bj][n];
                        const f32x2 al = __builtin_amdgcn_cvt_pk_f32_fp8(aw, false), ah = __builtin_amdgcn_cvt_pk_f32_fp8(aw, true), bl = __builtin_amdgcn_cvt_pk_f32_fp8(bw, false), bh = __builtin_amdgcn_cvt_pk_f32_fp8(bw, true);
                        f32x4 r; r[0] = al[0] * __builtin_amdgcn_rcpf(bl[0]); r[1] = al[1] * __builtin_amdgcn_rcpf(bl[1]); r[2] = ah[0] * __builtin_amdgcn_rcpf(bh[0]); r[3] = ah[1] * __builtin_amdgcn_rcpf(bh[1]);
                        acc[ai][bj][m][n] = acc[ai][bj][m][n] * r; } }
                asm volatile("" : "+v"(acc[ai][0][m][0]), "+v"(acc[ai][0][m][1]), "+v"(acc[ai][1][m][0]), "+v"(acc[ai][1][m][1])); }
            asm volatile("" ::: "memory"); }
    }
    __device__ __forceinline__ void operator()(const f32x4 (&acc)[2][2][4][2], const Unit& u, int wr, int wc, int fr, int fq) const {
        const int row0 = u.pm * BM + wr * 64 + opaque(fr), col0 = u.pn * BM + wc * 32 + 8 * opaque(fq);
        constexpr float FS = SM / (SO * SW * SSG);
        const int cswz = ((col0 >> 3) & 1) ? (HALF - 8) : 0;
#pragma unroll
        for (int ai = 0; ai < 2; ++ai) {
            u32x2 bq[4][2];
#pragma unroll
            for (int m = 0; m < 4; ++m) { const u32x4 lb = *(const u32x4*)(SG + (size_t)(row0 + ai * HALF + m * 16) * SG_P + 1024 + col0 + cswz); unpair16(lb, bq[m][0], bq[m][1]); }
#pragma unroll
            for (int m = 0; m < 4; ++m) { unsigned char* op = O + (size_t)(row0 + ai * HALF + m * 16) * D + col0 + cswz;
                u32x2 w[2];
#pragma unroll
                for (int bj = 0; bj < 2; ++bj) {
#pragma unroll
                    for (int n = 0; n < 2; ++n) { const int bw = (int)bq[m][bj][n]; const f32x2 bl = __builtin_amdgcn_cvt_pk_f32_fp8(bw, false), bh = __builtin_amdgcn_cvt_pk_f32_fp8(bw, true); const f32x4 v = acc[ai][bj][m][n] * FS;
                        w[bj][n] = pk4_fp8(clamp_fp8(v[0] * bl[0]), clamp_fp8(v[1] * bl[1]), clamp_fp8(v[2] * bh[0]), clamp_fp8(v[3] * bh[1])); } }
                *(u32x4*)op = pair16(w[0], w[1]); }
            asm volatile("" ::: "memory"); }
    }
};

struct PanelStats {
    unsigned* xbuf;
    unsigned* cnt;
    unsigned* tmo;
    int pm_off; float eps; unsigned code;
    __device__ __forceinline__ bool run(const f32x4 (&v)[2][2][4][2], const Unit& u, int wr, int wc, int fr, int fq, LAS unsigned char* lds, int wid, int lane) const {
        LAS f32x2* P = (LAS f32x2*)lds;
        LAS f32x2* S = (LAS f32x2*)(lds + 8192);
        LAS unsigned* flag = (LAS unsigned*)(lds + 8192 + 2048);
        const int panel = u.pm + pm_off;
#pragma unroll
        for (int ai = 0; ai < 2; ++ai)
#pragma unroll
            for (int m = 0; m < 4; ++m) {
                float s = 0.f;
#pragma unroll
                for (int bj = 0; bj < 2; ++bj)
#pragma unroll
                    for (int n = 0; n < 2; ++n) { const f32x4 x = v[ai][bj][m][n]; s += (x[0] + x[1]) + (x[2] + x[3]); }
                s += __shfl_xor(s, 16); s += __shfl_xor(s, 32);
                const float mw = s * (1.0f / 64.0f); float q = 0.f;
#pragma unroll
                for (int bj = 0; bj < 2; ++bj)
#pragma unroll
                    for (int n = 0; n < 2; ++n) { const f32x4 d = v[ai][bj][m][n] - mw; q += (d[0] * d[0] + d[1] * d[1]) + (d[2] * d[2] + d[3] * d[3]); }
                q += __shfl_xor(q, 16); q += __shfl_xor(q, 32);
                if (fq == 0) P[(ai * HALF + wr * 64 + m * 16 + fr) * 4 + wc] = (f32x2){mw, q};
            }
        asm volatile("s_waitcnt lgkmcnt(0)" ::: "memory"); __builtin_amdgcn_s_barrier(); asm volatile("" ::: "memory");
        const int row = wid * 32 + (lane & 31);
        if (lane < 32) {
            const f32x2 a = P[row * 4 + 0], b = P[row * 4 + 1], c = P[row * 4 + 2], d = P[row * 4 + 3];
            const float mt = (a.x + b.x + c.x + d.x) * 0.25f;
            const float da = a.x - mt, db = b.x - mt, dc = c.x - mt, dd = d.x - mt;
            const float m2 = (a.y + b.y) + (c.y + d.y) + 64.0f * ((da * da + db * db) + (dc * dc + dd * dd));
            unsigned long long* slot = (unsigned long long*)xbuf + ((size_t)(panel * BM + row) * 4 + u.pn);
            __hip_atomic_store(slot, ((unsigned long long)__float_as_uint(m2) << 32) | __float_as_uint(mt), __ATOMIC_RELAXED, __HIP_MEMORY_SCOPE_AGENT);
        }
        asm volatile("s_waitcnt vmcnt(0)" ::: "memory");
        if (lane == 0) __hip_atomic_fetch_add(cnt + 64 * panel, 1u, __ATOMIC_RELAXED, __HIP_MEMORY_SCOPE_AGENT);
        if (wid == 0) {
            bool dead = false; const unsigned long long t0 = __builtin_amdgcn_s_memrealtime(); const unsigned want = 8u * 4u;
            for (;;) {
                if ((unsigned)__builtin_amdgcn_readfirstlane(__hip_atomic_load(cnt + 64 * panel, __ATOMIC_RELAXED, __HIP_MEMORY_SCOPE_AGENT)) >= want) break;
                if (__builtin_amdgcn_s_memrealtime() - t0 > 2000000ull) {
                    if (lane == 0) { unsigned expect = 0u; __hip_atomic_compare_exchange_strong(tmo + 1, &expect, code | (unsigned)(panel & 0xff), __ATOMIC_RELAXED, __ATOMIC_RELAXED, __HIP_MEMORY_SCOPE_AGENT);
                                     __hip_atomic_store(tmo, 1u, __ATOMIC_RELAXED, __HIP_MEMORY_SCOPE_AGENT); }
                    dead = true; break; }
                __builtin_amdgcn_s_sleep(2);
            }
            __builtin_amdgcn_fence(__ATOMIC_ACQUIRE, "agent");
            if (lane == 0) flag[0] = dead ? 1u : 0u;
        }
        asm volatile("s_waitcnt vmcnt(0) lgkmcnt(0)" ::: "memory"); __builtin_amdgcn_s_barrier(); asm volatile("" ::: "memory");
        const bool bad = flag[0] != 0u;
        if (lane < 32) {
            const unsigned long long* slot = (const unsigned long long*)xbuf + (size_t)(panel * BM + row) * 4; float mt[4], m2[4]; float ms = 0.f;
#pragma unroll
            for (int t = 0; t < 4; ++t) { const unsigned long long w = __hip_atomic_load(slot + t, __ATOMIC_RELAXED, __HIP_MEMORY_SCOPE_AGENT); mt[t] = __uint_as_float((unsigned)w); m2[t] = __uint_as_float((unsigned)(w >> 32)); ms += mt[t]; }
            const float mean = ms * 0.25f; float q = 0.f;
#pragma unroll
            for (int t = 0; t < 4; ++t) { const float dm = mt[t] - mean; q += m2[t] + 256.0f * dm * dm; }
            S[row] = (f32x2){mean, 1.0f / sqrtf(q * (1.0f / 1024.0f) + eps)};
        }
        asm volatile("s_waitcnt lgkmcnt(0)" ::: "memory"); __builtin_amdgcn_s_barrier(); asm volatile("" ::: "memory");
        return bad;
    }
};
struct EpiLn1 {
    static constexpr bool PERM = true, AFTER_DRAIN = true, HAS_MID = false, HAS_PRE = false; static constexpr int MID_T = 0;
    const float* x; float* out; bf16_t* xb; unsigned char* xq; const float* gam; const float* bet; PanelStats st; int row_off; unsigned poison; float rs;
    __device__ __forceinline__ void mid(f32x4 (&)[2][2][4][2], const Unit&, int, int, int, int) const {}
    __device__ __forceinline__ void operator()(const f32x4 (&)[2][2][4][2], const Unit&, int, int, int, int) const {}
    __device__ __forceinline__ void fused(f32x4 (&acc)[2][2][4][2], const Unit& u, int wr, int wc, int fr, int fq, LAS unsigned char* lds, int wid, int lane) const {
        const LAS f32x2* S = (const LAS f32x2*)(lds + 8192);
        const int col0 = u.pn * BM + wc * 32 + 8 * opaque(fq);
        const int grow0 = row_off + u.pm * BM; fr = opaque(fr);
#pragma unroll
        for (int ai = 0; ai < 2; ++ai)
#pragma unroll
            for (int m = 0; m < 4; ++m) { const size_t off = (size_t)(grow0 + ai * HALF + wr * 64 + m * 16 + fr) * D + col0;
#pragma unroll
                for (int bj = 0; bj < 2; ++bj)
#pragma unroll
                    for (int n = 0; n < 2; ++n) { const f32x4 bs = *(const f32x4*)(x + off + bj * HALF + n * 4); acc[ai][bj][m][n] = acc[ai][bj][m][n] * rs + bs * DN_ALPHA; }
                asm volatile("" : "+v"(acc[ai][0][m][0]), "+v"(acc[ai][0][m][1]), "+v"(acc[ai][1][m][0]), "+v"(acc[ai][1][m][1]));
                if (m == 3) asm volatile("" ::: "memory"); }
        const bool bad = st.run(acc, u, wr, wc, fr, fq, lds, wid, lane) || poison != 0u;
        const float qnan = __builtin_nanf("");
        f32x4 gv[2][2], bv[2][2];
#pragma unroll
        for (int bj = 0; bj < 2; ++bj)
#pragma unroll
            for (int n = 0; n < 2; ++n) { gv[bj][n] = *(const f32x4*)(gam + col0 + bj * HALF + n * 4); bv[bj][n] = *(const f32x4*)(bet + col0 + bj * HALF + n * 4); }
#pragma unroll
        for (int ai = 0; ai < 2; ++ai)
#pragma unroll
            for (int m = 0; m < 4; ++m) { const int r = ai * HALF + wr * 64 + m * 16 + fr; const f32x2 sr = S[r]; const size_t off = (size_t)(grow0 + r) * D + col0;
#pragma unroll
                for (int bj = 0; bj < 2; ++bj) { f32x4 o0 = (acc[ai][bj][m][0] - sr.x) * sr.y * gv[bj][0] + bv[bj][0], o1 = (acc[ai][bj][m][1] - sr.x) * sr.y * gv[bj][1] + bv[bj][1];
                    if (bad) { o0 = (f32x4){qnan, qnan, qnan, qnan}; o1 = o0; }
                    u32x4 w; w.x = cvt_pk_bf16(o0[0], o0[1]); w.y = cvt_pk_bf16(o0[2], o0[3]); w.z = cvt_pk_bf16(o1[0], o1[1]); w.w = cvt_pk_bf16(o1[2], o1[3]); *(u32x4*)(xb + off + bj * HALF) = w;
                    u32x2 q8; q8.x = pk4_fp8(clamp_fp8(o0[0] * SX), clamp_fp8(o0[1] * SX), clamp_fp8(o0[2] * SX), clamp_fp8(o0[3] * SX)); q8.y = pk4_fp8(clamp_fp8(o1[0] * SX), clamp_fp8(o1[1] * SX), clamp_fp8(o1[2] * SX), clamp_fp8(o1[3] * SX));
                    *(u32x2*)(xq + off + bj * HALF) = q8; } }
    }
};
struct EpiY {
    static constexpr bool PERM = true, AFTER_DRAIN = false, HAS_MID = false, HAS_PRE = false; static constexpr int MID_T = 0;
    const float* __restrict__ x; bf16_t* __restrict__ Y; float* __restrict__ ST; float rs;
    __device__ __forceinline__ void mid(f32x4 (&)[2][2][4][2], const Unit&, int, int, int, int) const {}
    __device__ __forceinline__ void operator()(const f32x4 (&acc)[2][2][4][2], const Unit& u, int wr, int wc, int fr, int fq) const {
        const int row0 = u.pm * BM + wr * 64 + opaque(fr), col0 = u.pn * BM + wc * 32 + 8 * opaque(fq);
#pragma unroll
        for (int ai = 0; ai < 2; ++ai) {
            f32x4 xv[4][2][2];
#pragma unroll
            for (int m = 0; m < 4; ++m)
#pragma unroll
                for (int bj = 0; bj < 2; ++bj)
#pragma unroll
                    for (int n = 0; n < 2; ++n) xv[m][bj][n] = *(const f32x4*)(x + (size_t)(row0 + ai * HALF + m * 16) * D + col0 + bj * HALF + n * 4);
#pragma unroll
            for (int m = 0; m < 4; ++m) { const size_t r = (size_t)(row0 + ai * HALF + m * 16); float s1 = 0.f, s2 = 0.f;
#pragma unroll
                for (int bj = 0; bj < 2; ++bj) { const f32x4 y0 = acc[ai][bj][m][0] * rs + xv[m][bj][0] * DN_ALPHA, y1 = acc[ai][bj][m][1] * rs + xv[m][bj][1] * DN_ALPHA;
                    s1 += (y0[0] + y0[1]) + (y0[2] + y0[3]) + (y1[0] + y1[1]) + (y1[2] + y1[3]);
                    s2 += (y0[0] * y0[0] + y0[1] * y0[1]) + (y0[2] * y0[2] + y0[3] * y0[3]) + (y1[0] * y1[0] + y1[1] * y1[1]) + (y1[2] * y1[2] + y1[3] * y1[3]);
                    u32x4 w; w.x = cvt_pk_bf16(y0[0], y0[1]); w.y = cvt_pk_bf16(y0[2], y0[3]); w.z = cvt_pk_bf16(y1[0], y1[1]); w.w = cvt_pk_bf16(y1[2], y1[3]);
                    *(u32x4*)(Y + r * D + col0 + bj * HALF) = w; }
                s1 += __shfl_xor(s1, 16); s1 += __shfl_xor(s1, 32); s2 += __shfl_xor(s2, 16); s2 += __shfl_xor(s2, 32);
                if (fq == 0) *(f32x2*)(ST + (r * 16 + u.pn * 4 + wc) * 2) = (f32x2){s1, s2}; }
            asm volatile("" ::: "memory"); }
    }
};
struct EpiGU {
    static constexpr bool PERM = true, AFTER_DRAIN = false, HAS_MID = false, HAS_PRE = true; static constexpr int MID_T = 0;
    const float* bg; const float* bu; unsigned char* H; LAS unsigned char* plds;
    __device__ __forceinline__ void mid(f32x4 (&)[2][2][4][2], const Unit&, int, int, int, int) const {}
    __device__ __forceinline__ void pre(LAS unsigned char* lds, const Unit& u, int wid, int lane) const {
        if (wid == 0) __builtin_amdgcn_global_load_lds((const unsigned*)((lane < 32 ? bg : bu) + u.e * DFF + u.pn * HALF + (lane & 31) * 4), (LAS unsigned*)(lds + EPRE_OFF), 16, 0, 0);
    }
    __device__ __forceinline__ void operator()(const f32x4 (&acc)[2][2][4][2], const Unit& u, int wr, int wc, int fr, int fq) const {
        const int row0 = u.pm * BM + wr * 64 + opaque(fr), jl = wc * 32 + 8 * opaque(fq), j0 = u.pn * HALF + jl;
        const LAS float* pb = (const LAS float*)(plds + EPRE_OFF) + jl;
        const f32x4 g0 = *(const LAS f32x4*)pb, g1 = *(const LAS f32x4*)(pb + 4), u0 = *(const LAS f32x4*)(pb + HALF), u1 = *(const LAS f32x4*)(pb + HALF + 4);
        f32x4 us0 = (u0 + 1.0f) * SH, us1 = (u1 + 1.0f) * SH;
        asm volatile("" : "+v"(us0), "+v"(us1));
        const int fqo = (jl >> 3) & 1;
#pragma unroll
        for (int ai = 0; ai < 2; ++ai)
#pragma unroll
            for (int m2 = 0; m2 < 4; m2 += 2) { u32x2 w[2];
#pragma unroll
              for (int mo = 0; mo < 2; ++mo) { const int m = m2 + mo;
                constexpr float RS = 1.0f / (SX * SW), CS = -1.702f * LOG2E;
                f32x4 h0, h1;
#pragma unroll
                for (int q = 0; q < 4; ++q) {
                    const float a = fminf(__builtin_fmaf(acc[ai][0][m][0][q], RS, g0[q]), 7.0f), b = fminf(__builtin_fmaf(acc[ai][0][m][1][q], RS, g1[q]), 7.0f);
                    const float ua = __builtin_amdgcn_fmed3f(__builtin_fmaf(acc[ai][1][m][0][q], RS * SH, us0[q]), -6.0f * SH, 8.0f * SH), ub = __builtin_amdgcn_fmed3f(__builtin_fmaf(acc[ai][1][m][1][q], RS * SH, us1[q]), -6.0f * SH, 8.0f * SH);
                    h0[q] = (a * __builtin_amdgcn_rcpf(1.0f + __builtin_amdgcn_exp2f(CS * a))) * ua;
                    h1[q] = (b * __builtin_amdgcn_rcpf(1.0f + __builtin_amdgcn_exp2f(CS * b))) * ub; }
                w[mo].x = pk4_fp8(h0[0], h0[1], h0[2], h0[3]); w[mo].y = pk4_fp8(h1[0], h1[1], h1[2], h1[3]); }
              *(u32x4*)(H + (size_t)(row0 + ai * HALF + (m2 + fqo) * 16) * DFF + j0 - 8 * fqo) = pair16(w[0], w[1]); }
    }
};
struct EpiDown {
    static constexpr bool PERM = true, AFTER_DRAIN = false, HAS_MID = false, HAS_PRE = true; static constexpr int MID_T = 0;
    const float* bd; const int* petok; const float* pegate; unsigned char* Y; LAS unsigned char* plds;
    __device__ __forceinline__ void mid(f32x4 (&)[2][2][4][2], const Unit&, int, int, int, int) const {}
    __device__ __forceinline__ void pre(LAS unsigned char* lds, const Unit& u, int wid, int lane) const {
        const size_t eb = (size_t)u.e * NTOK + (size_t)u.ti * 256 + (size_t)(lane * 4);
        if (wid == 0) __builtin_amdgcn_global_load_lds((const unsigned*)(bd + u.e * D + u.pn * BM + lane * 4), (LAS unsigned*)(lds + EPRE_OFF), 16, 0, 0);
        else if (wid == 1) __builtin_amdgcn_global_load_lds((const unsigned*)(petok + eb), (LAS unsigned*)(lds + EPRE_OFF + 1024), 16, 0, 0);
        else if (wid == 2) __builtin_amdgcn_global_load_lds((const unsigned*)(pegate + eb), (LAS unsigned*)(lds + EPRE_OFF + 2048), 16, 0, 0);
    }
    __device__ __forceinline__ void operator()(const f32x4 (&acc)[2][2][4][2], const Unit& u, int wr, int wc, int fr, int fq) const {
        const int r0 = wr * 64 + opaque(fr), cl = wc * 32 + 8 * opaque(fq), col0 = u.pn * BM + cl;
        const LAS float* pb = (const LAS float*)(plds + EPRE_OFF) + cl;
        f32x4 b[2][2];
#pragma unroll
        for (int bj = 0; bj < 2; ++bj) { b[bj][0] = *(const LAS f32x4*)(pb + bj * HALF); b[bj][1] = *(const LAS f32x4*)(pb + bj * HALF + 4); }
        int info[2][4]; float gwv[2][4];
#pragma unroll
        for (int ai = 0; ai < 2; ++ai)
#pragma unroll
            for (int m = 0; m < 4; ++m) { const int r = r0 + ai * HALF + m * 16; info[ai][m] = *(const LAS int*)(plds + EPRE_OFF + 1024 + 4 * r); gwv[ai][m] = *(const LAS float*)(plds + EPRE_OFF + 2048 + 4 * r) * SY; }
        if (u.valid == 256) {
            const int fqo = (col0 >> 3) & 1;
            const int cswz = fqo ? (HALF - 8) : 0;
#pragma unroll
        for (int ai = 0; ai < 2; ++ai)
#pragma unroll
            for (int m = 0; m < 4; ++m) {
                const float gw = gwv[ai][m];
                unsigned char* op = Y + (size_t)info[ai][m] * 1024 + col0 + cswz;
                u32x2 w[2];
#pragma unroll
                for (int bj = 0; bj < 2; ++bj) { constexpr float RS = 1.0f / (SH * SW); const f32x4 v0 = (acc[ai][bj][m][0] * RS + b[bj][0]) * gw, v1 = (acc[ai][bj][m][1] * RS + b[bj][1]) * gw;
                    w[bj].x = pk4_fp8(clamp_fp8(v0[0]), clamp_fp8(v0[1]), clamp_fp8(v0[2]), clamp_fp8(v0[3])); w[bj].y = pk4_fp8(clamp_fp8(v1[0]), clamp_fp8(v1[1]), clamp_fp8(v1[2]), clamp_fp8(v1[3])); }
                *(u32x4*)op = pair16(w[0], w[1]); }
        } else {
#pragma unroll
        for (int ai = 0; ai < 2; ++ai)
#pragma unroll
            for (int m = 0; m < 4; ++m) { const int r = r0 + ai * HALF + m * 16;
                if (r < u.valid) { const float gw = gwv[ai][m];
                    unsigned char* op = Y + (size_t)info[ai][m] * 1024 + col0;
#pragma unroll
                    for (int bj = 0; bj < 2; ++bj) { constexpr float RS = 1.0f / (SH * SW); const f32x4 v0 = (acc[ai][bj][m][0] * RS + b[bj][0]) * gw, v1 = (acc[ai][bj][m][1] * RS + b[bj][1]) * gw;
                        u32x2 w; w.x = pk4_fp8(clamp_fp8(v0[0]), clamp_fp8(v0[1]), clamp_fp8(v0[2]), clamp_fp8(v0[3])); w.y = pk4_fp8(clamp_fp8(v1[0]), clamp_fp8(v1[1]), clamp_fp8(v1[2]), clamp_fp8(v1[3]));
                        *(u32x2*)(op + bj * HALF) = w; } } }
        }
    }
};
}

#define XB_TMO      128
#define XB_XCNT(j)  (256  + 64 * (j))
#define XB_XSUB(j)  (1280 + 64 * (j))
#define XB_XGEN(j)  (2304 + 64 * (j))
#define XB_TOP      3328
#define XB_TOPGEN   3392
#define XCD_BAR_WORDS 3456
#define XB_SPIN_CAP (1u << 18)
__device__ __forceinline__ unsigned xb_ld(unsigned* p)              { return __hip_atomic_load(p, __ATOMIC_RELAXED, __HIP_MEMORY_SCOPE_AGENT); }
__device__ __forceinline__ unsigned xb_add(unsigned* p, unsigned v) { return __hip_atomic_fetch_add(p, v, __ATOMIC_RELAXED, __HIP_MEMORY_SCOPE_AGENT); }
__device__ __forceinline__ unsigned xb_xcc_id() { return (unsigned)__builtin_amdgcn_s_getreg((3 << 11) | 20) & 0xFu; }
#define XB_SPIN(cond, bar) do { unsigned _sp = 0; while (cond) { __builtin_amdgcn_s_sleep(1); \
    if ((++_sp & 255u) == 0u) { if (xb_ld(&(bar)[XB_TMO])) break; if (_sp > XB_SPIN_CAP) { atomicAdd(&(bar)[XB_TMO], 1u); break; } } } } while (0)
struct XcdBarrier { unsigned* bar; unsigned x; volatile LAS unsigned* st; };
__device__ __forceinline__ XcdBarrier xcd_barrier_post(unsigned* bar, volatile LAS unsigned* st) {
    XcdBarrier b; b.bar = bar; b.x = xb_xcc_id(); b.st = st;
    if (threadIdx.x == 0) (void)xb_add(&bar[XB_XCNT(b.x)], 1u);
    return b;
}
__device__ __forceinline__ void xcd_barrier_complete(unsigned* bar, unsigned x, unsigned& nloc, unsigned& nx) {
    const unsigned G = gridDim.x * gridDim.y * gridDim.z;
    unsigned sum, cnt, mine, sp = 0u;
    for (;;) {
        sum = 0u; cnt = 0u; mine = 0u;
#pragma unroll
        for (unsigned j = 0; j < 16; ++j) { const unsigned c = xb_ld(&bar[XB_XCNT(j)]); sum += c; cnt += (c > 0u) ? 1u : 0u; mine = (j == x) ? c : mine; }
        if (sum == G) break;
        __builtin_amdgcn_s_sleep(1);
        if ((++sp & 255u) == 0u) { if (xb_ld(&bar[XB_TMO])) break; if (sp > XB_SPIN_CAP) { atomicAdd(&bar[XB_TMO], 1u); break; } }
    }
    nloc = mine > 0u ? mine : 1u; nx = cnt > 0u ? cnt : 1u;
}
__device__ __forceinline__ void xcd_barrier(const XcdBarrier& b) {
    asm volatile("s_waitcnt vmcnt(0)" ::: "memory");
    __syncthreads();
    if (threadIdx.x == 0) {
        unsigned* bar = b.bar;
        __builtin_amdgcn_s_waitcnt(0);
        unsigned nloc = b.st[0], nx = b.st[1];
        if (nloc == 0u) { xcd_barrier_complete(bar, b.x, nloc, nx); b.st[0] = nloc; b.st[1] = nx; }
        const unsigned old = xb_add(&bar[XB_XSUB(b.x)], 1u);
        const unsigned gen = old / nloc;
        if (old + 1u == (gen + 1u) * nloc) {
            __builtin_amdgcn_fence(__ATOMIC_RELEASE, "agent");
            asm volatile("s_waitcnt vmcnt(0)" ::: "memory");
            const unsigned og = xb_add(&bar[XB_TOP], 1u);
            const unsigned tg = og / nx;
            if (og + 1u == (tg + 1u) * nx) xb_add(&bar[XB_TOPGEN], 1u);
            else XB_SPIN(xb_ld(&bar[XB_TOPGEN]) == tg, bar);
            __builtin_amdgcn_fence(__ATOMIC_ACQUIRE, "agent");
            xb_add(&bar[XB_XGEN(b.x)], 1u);
            asm volatile("s_waitcnt vmcnt(0)" ::: "memory");
        } else {
            XB_SPIN(xb_ld(&bar[XB_XGEN(b.x)]) == gen, bar);
            __builtin_amdgcn_fence(__ATOMIC_ACQUIRE, "agent");
            asm volatile("s_waitcnt vmcnt(0)" ::: "memory");
        }
    }
    __syncthreads();
}

constexpr int NWAVES = 8;
struct Frame {
    LAS unsigned char* lds; volatile LAS unsigned* MISC; gu32* ctl;
    int tid, lane, wave, vcu, G;
    unsigned char* ws; unsigned char* dout;
};
__device__ __forceinline__ float wave_sum(float v) {
#pragma unroll
    for (int o = 1; o < 64; o <<= 1) v += __shfl_xor(v, o);
    return v;
}
__device__ __forceinline__ void transpose_item(const float* W, int N, int k0, int n0, bf16_t* WT, int ldw, size_t drow0, int dcol0, LAS float* scr, int lane) {
#pragma unroll 8
    for (int i = 0; i < 32; ++i) { const int kk = 2 * i + (lane >> 5); scr[kk * 33 + (lane & 31)] = W[(size_t)(k0 + kk) * N + n0 + (lane & 31)]; }
    LDS_WAIT(); asm volatile("" ::: "memory");
    const int c = lane & 7;
#pragma unroll
    for (int j = 0; j < 4; ++j) { const int n = (lane >> 3) + 8 * j; const LAS float* s = scr + (8 * c) * 33 + n;
        u32x4 o; o.x = cvt_pk_bf16(s[0 * 33], s[1 * 33]); o.y = cvt_pk_bf16(s[2 * 33], s[3 * 33]); o.z = cvt_pk_bf16(s[4 * 33], s[5 * 33]); o.w = cvt_pk_bf16(s[6 * 33], s[7 * 33]);
        *(GAS u32x4*)(WT + (drow0 + n) * (size_t)ldw + dcol0 + 8 * c) = o; }
    LDS_WAIT(); asm volatile("" ::: "memory");
}
__device__ __forceinline__ void transpose_item_f8(const float* W, int N, int k0, int n0, unsigned char* WT, int ldw, size_t drow0, int dcol0, LAS float* scr, int lane);
__device__ __forceinline__ void p0_convert(Frame& F, const float* x, const float* w_in, const float* w_pa, const float* w_pb, const float* w_out, const float* rw) {
    LAS float* scr = (LAS float*)(F.lds + F.wave * 17408);
    const int gw = F.vcu * NWAVES + F.wave, NGW = F.G * NWAVES;
    unsigned char* WIN = F.dout + DO_WIN; unsigned char* WCAT = F.dout + DO_WCAT; unsigned char* WOUT = F.ws + WS_WOUT;
    constexpr int I_IN = (D / 128) * (IN_COLS / 32), I_OUT = (D / 128) * (D / 32), I_PA = (256 / 128) * (D / 32), I_PB = (D / 128) * (D / 32);
    for (int it = gw; it < I_IN + I_OUT + I_PA + I_PB; it += NGW) {
        int r = it;
        if (r < I_IN) { const int nb = IN_COLS / 32; transpose_item_f8(w_in, IN_COLS, 128 * (r / nb), 32 * (r % nb), WIN, D, (size_t)(32 * (r % nb)), 128 * (r / nb), scr, F.lane); continue; } r -= I_IN;
        if (r < I_OUT) { const int nb = D / 32; transpose_item_f8(w_out, D, 128 * (r / nb), 32 * (r % nb), WOUT, D, (size_t)(32 * (r % nb)), 128 * (r / nb), scr, F.lane); continue; } r -= I_OUT;
        if (r < I_PA) { const int nb = D / 32; transpose_item_f8(w_pa, D, 128 * (r / nb), 32 * (r % nb), WCAT, OAB_P, (size_t)(32 * (r % nb)), 128 * (r / nb), scr, F.lane); continue; } r -= I_PA;
        { const int nb = D / 32; transpose_item_f8(w_pb, D, 128 * (r / nb), 32 * (r % nb), WCAT, OAB_P, (size_t)(32 * (r % nb)), 256 + 128 * (r / nb), scr, F.lane); }
    }
    { bf16_t* WRT = (bf16_t*)(F.ws + WS_WRT);
      for (int i = gw * 64 + F.lane; i < NEXP * D; i += NGW * 64) { const int e = i >> 10, k = i & (D - 1); const float w = rw[k * NEXP + e];
          const unsigned hi = cvt_pk_bf16(w, 0.f) & 0xffffu; const float r = w - __uint_as_float(hi << 16);
          WRT[i] = (bf16_t)hi; WRT[NEXP * D + i] = (bf16_t)(cvt_pk_bf16(r, 0.f) & 0xffffu); } }
    unsigned char* XQ = F.dout + DO_XB;
    const size_t n16 = (size_t)NTOK * D / 16;
    for (size_t i = (size_t)gw * 64 + F.lane; i < n16; i += (size_t)NGW * 64) {
        const f32x4 a = *(const GAS f32x4*)(x + i * 16), b = *(const GAS f32x4*)(x + i * 16 + 4), c = *(const GAS f32x4*)(x + i * 16 + 8), d = *(const GAS f32x4*)(x + i * 16 + 12);
        u32x4 o;
        o.x = pk4_fp8(clamp_fp8(a[0] * SXIN), clamp_fp8(a[1] * SXIN), clamp_fp8(a[2] * SXIN), clamp_fp8(a[3] * SXIN)); o.y = pk4_fp8(clamp_fp8(b[0] * SXIN), clamp_fp8(b[1] * SXIN), clamp_fp8(b[2] * SXIN), clamp_fp8(b[3] * SXIN));
        o.z = pk4_fp8(clamp_fp8(c[0] * SXIN), clamp_fp8(c[1] * SXIN), clamp_fp8(c[2] * SXIN), clamp_fp8(c[3] * SXIN)); o.w = pk4_fp8(clamp_fp8(d[0] * SXIN), clamp_fp8(d[1] * SXIN), clamp_fp8(d[2] * SXIN), clamp_fp8(d[3] * SXIN));
        *(GAS u32x4*)(XQ + i * 16) = o;
    }
}
__device__ __forceinline__ void transpose_item_f8(const float* W, int N, int k0, int n0, unsigned char* WT, int ldw, size_t drow0, int dcol0, LAS float* scr, int lane) {
    f32x4 wv[16];
#pragma unroll
    for (int i = 0; i < 16; ++i) wv[i] = *(const GAS f32x4*)(W + (size_t)(k0 + 8 * i + (lane >> 3)) * N + n0 + (lane & 7) * 4);
#pragma unroll
    for (int i = 0; i < 16; ++i) { LAS float* d = scr + (8 * i + (lane >> 3)) * 33 + (lane & 7) * 4; d[0] = wv[i][0]; d[1] = wv[i][1]; d[2] = wv[i][2]; d[3] = wv[i][3]; }
    LDS_WAIT(); asm volatile("" ::: "memory");
    const int c = lane & 7;
#pragma unroll
    for (int j = 0; j < 4; ++j) { const int n = (lane >> 3) + 8 * j; const LAS float* s = scr + (16 * c) * 33 + n;
        u32x4 o;
        o.x = pk4_fp8(clamp_fp8(s[0 * 33] * SW), clamp_fp8(s[1 * 33] * SW), clamp_fp8(s[2 * 33] * SW), clamp_fp8(s[3 * 33] * SW));
        o.y = pk4_fp8(clamp_fp8(s[4 * 33] * SW), clamp_fp8(s[5 * 33] * SW), clamp_fp8(s[6 * 33] * SW), clamp_fp8(s[7 * 33] * SW));
        o.z = pk4_fp8(clamp_fp8(s[8 * 33] * SW), clamp_fp8(s[9 * 33] * SW), clamp_fp8(s[10 * 33] * SW), clamp_fp8(s[11 * 33] * SW));
        o.w = pk4_fp8(clamp_fp8(s[12 * 33] * SW), clamp_fp8(s[13 * 33] * SW), clamp_fp8(s[14 * 33] * SW), clamp_fp8(s[15 * 33] * SW));
        *(GAS u32x4*)(WT + (drow0 + n) * (size_t)ldw + dcol0 + 16 * c) = o; }
    LDS_WAIT(); asm volatile("" ::: "memory");
}
__device__ __forceinline__ void p3_convert_moe(Frame& F, const float* w_gate, const float* w_up, const float* w_down, int wg, int nwg) {
    LAS float* scr = (LAS float*)(F.lds + F.wave * 17408);
    const int gw = wg * NWAVES + F.wave, NGW = nwg * NWAVES;
    unsigned char* WGU = F.ws + WS_WGU; unsigned char* WD = F.ws + WS_WD;
    constexpr int IPM = (D / 128) * (DFF / 32);
    for (int it = gw; it < NEXP * 3 * IPM; it += NGW) {
        const int e = it / (3 * IPM), r3 = it % (3 * IPM), which = r3 / IPM, r = r3 % IPM, kb = r / 32, nb = r % 32, k0 = 128 * kb, n0 = 32 * nb;
        const size_t moff = (size_t)e * D * DFF;
        if (which == 2) transpose_item_f8(w_down + moff, D, k0, n0, WD + moff, DFF, (size_t)n0, k0, scr, F.lane);
        else { const int pn = n0 >> 7, jj = n0 & 127; transpose_item_f8((which ? w_up : w_gate) + moff, DFF, k0, n0, WGU + 2 * moff, D, (size_t)(256 * pn + 128 * which + jj), k0, scr, F.lane); }
    }
}
typedef short v4i16_t __attribute__((ext_vector_type(4)));
__device__ __forceinline__ s16x4 tr_read(const LAS unsigned char* p) { return __builtin_bit_cast(s16x4, __builtin_amdgcn_ds_read_tr16_b64_v4i16((LAS v4i16_t*)p)); }
template <int C>
__device__ __forceinline__ void tr_read8(s16x4 (&r)[8], unsigned addr) {
#define TRR(i) asm volatile("ds_read_b64_tr_b16 %0, %1 offset:%2" : "=v"(r[i]) : "v"(addr), "n"(C * 4096 + (i) * 512))
    TRR(0); TRR(1); TRR(2); TRR(3); TRR(4); TRR(5); TRR(6); TRR(7);
#undef TRR
}
__device__ __forceinline__ void tr_wait8(s16x4 (&r)[8]) {
    asm volatile("s_waitcnt lgkmcnt(0)" : "+v"(r[0]), "+v"(r[1]), "+v"(r[2]), "+v"(r[3]), "+v"(r[4]), "+v"(r[5]), "+v"(r[6]), "+v"(r[7]));
}
template <int C>
__device__ __forceinline__ void pv_tile(s16x4 (&cur)[8], s16x4 (&prev)[8], bf16x8 (&pf)[2], bf16x8 (&pfprev)[2], unsigned vbase, const f32x16& Sc, f32x16 (&O)[2]) {
#pragma unroll
    for (int s = 0; s < 2; ++s) { u32x4 w; w.x = cvt_pk_bf16(Sc[8 * s + 0], Sc[8 * s + 1]); w.y = cvt_pk_bf16(Sc[8 * s + 2], Sc[8 * s + 3]);
        w.z = cvt_pk_bf16(Sc[8 * s + 4], Sc[8 * s + 5]); w.w = cvt_pk_bf16(Sc[8 * s + 6], Sc[8 * s + 7]); pf[s] = __builtin_bit_cast(bf16x8, w); }
    tr_read8<C>(cur, vbase);
    if (C > 0) { asm volatile("" :: "v"(prev[0]), "v"(prev[1]), "v"(prev[2]), "v"(prev[3]), "v"(prev[4]), "v"(prev[5]), "v"(prev[6]), "v"(prev[7]) : "memory");
                 asm volatile("" :: "v"(pfprev[0]), "v"(pfprev[1]) : "memory"); }
    tr_wait8(cur);
    __builtin_amdgcn_sched_barrier(0);
#pragma unroll
    for (int blk = 0; blk < 2; ++blk)
#pragma unroll
        for (int s = 0; s < 2; ++s) { const s16x4 lo = cur[(blk * 2 + s) * 2], hi = cur[(blk * 2 + s) * 2 + 1];
            O[blk] = __builtin_amdgcn_mfma_f32_32x32x16_bf16((bf16x8){lo[0], lo[1], lo[2], lo[3], hi[0], hi[1], hi[2], hi[3]}, pf[s], O[blk], 0, 0, 0); }
    __builtin_amdgcn_sched_barrier(0);
}
constexpr int ATT_KOFF = 0, ATT_QOFF = 12 * 2048, ATT_VOFF = 12 * 4096, ATT_STG = 24 * 4096, ATT_STGW = 4608;
static_assert(ATT_STG + 8 * ATT_STGW <= SCR_BYTES, "attention LDS map");
struct AKV { const unsigned char* qseq; const unsigned char* kseq; const bf16_t* vseq; int jt0, nkt, jq; };
__device__ __forceinline__ AKV attn_kv(const Frame& F, int U) {
    const unsigned char* HQ = F.ws + WS_HQ; AKV r;
    if (U < 2048) {
        const int b = U >> 8, kvh = (U >> 7) & 1, j = U & 127, hq = kvh * 8 + F.wave;
        r.qseq = HQ + HQ_QS + (size_t)(b * 16 + hq) * SEQ * 64; r.kseq = HQ + HQ_KS + (size_t)(b * 2 + kvh) * SEQ * 64; r.vseq = (const bf16_t*)(HQ + HQ_VS) + (size_t)(b * 2 + kvh) * SEQ * 64;
        r.jt0 = j - 4; r.nkt = 5; r.jq = j;
    } else {
        const int v = U - 2048, g = v >> 9, w_ = v & 511, b = w_ >> 6, x = w_ & 63, hh = x >> 4, y = x & 15;
        const int dil = (g == 0) ? 1 : (g == 1) ? 4 : 16;
        const int res = (g == 0) ? 0 : (g == 1) ? (y >> 2) : y;
        const int j0 = (g == 0) ? y * 8 : (g == 1) ? (y & 3) * 8 : 0;
        const size_t seq = ((size_t)((g * NB + b) * 4 + hh) * SEQ + (size_t)res * (SEQ / dil)) * 64;
        r.qseq = HQ + HQ_QD + seq; r.kseq = HQ + HQ_KD + seq; r.vseq = (const bf16_t*)(HQ + HQ_VD) + seq;
        r.jt0 = j0 - 4; r.nkt = 12; r.jq = j0 + F.wave;
    }
    return r;
}
__device__ __forceinline__ unsigned attn_koff(int lane) { return (unsigned)((lane >> 2) * 64 + (((lane & 3) ^ ((lane >> 4) & 3)) * 16)); }
__device__ __forceinline__ unsigned attn_voff(int lane) { return (unsigned)((lane >> 2) * 128 + (lane & 3) * 16); }
__device__ __forceinline__ void attn_issue_k(LAS unsigned char* lds, int lane, int wave, const AKV& u) {
    const unsigned koff = attn_koff(lane);
    for (int p = wave; p < u.nkt * 2; p += 8) {
        const int s = p >> 1, qt = p & 1; const int tj = u.jt0 + s; const size_t pos0 = (size_t)(32 * (tj >= 0 ? tj : 0) + 16 * qt);
        __builtin_amdgcn_global_load_lds((const unsigned*)((const char*)u.kseq + pos0 * 64 + koff), (LAS unsigned*)(lds + ATT_KOFF + s * 2048 + qt * 1024), 16, 0, 0);
    }
}
__device__ __forceinline__ void attn_issue_q(LAS unsigned char* lds, int lane, int wave, const AKV& u) {
    const unsigned koff = attn_koff(lane);
#pragma unroll
    for (int qt = 0; qt < 2; ++qt)
        __builtin_amdgcn_global_load_lds((const unsigned*)((const char*)u.qseq + (size_t)(32 * u.jq + 16 * qt) * 64 + koff), (LAS unsigned*)(lds + ATT_QOFF + wave * 2048 + qt * 1024), 16, 0, 0);
}
template <int NKT>
__device__ __forceinline__ int attn_issue_v(LAS unsigned char* lds, int lane, int wave, const AKV& u) {
    const int w4 = (wave + 4) & 7;
    const unsigned voff = attn_voff(lane);
#pragma unroll
    for (int i = 0; i < (NKT * 4 + 7) / 8; ++i) { const int p = w4 + 8 * i;
        if (p < NKT * 4) { const int s = p >> 2, qt = p & 3; const int tj = u.jt0 + s; const int blk = qt >> 1, part = qt & 1;
            const size_t pos0 = (size_t)(32 * (tj >= 0 ? tj : 0) + 16 * part);
            __builtin_amdgcn_global_load_lds((const unsigned*)((const char*)u.vseq + pos0 * 128 + blk * 64 + voff), (LAS unsigned*)(lds + ATT_VOFF + s * 4096 + blk * 2048 + part * 1024), 16, 0, 0); } }
    return NKT == 12 ? 6 : (w4 < 4 ? 3 : 2);
}
__device__ __forceinline__ void attn_wait(int n) {
#define AW(N) asm volatile("s_waitcnt vmcnt(" #N ")" ::: "memory")
    if (n == 11) AW(11); else if (n == 8) AW(8); else if (n == 7) AW(7); else if (n == 6) AW(6); else if (n == 5) AW(5); else if (n == 4) AW(4); else if (n == 3) AW(3); else if (n == 2) AW(2); else AW(0);
#undef AW
}
template <bool swa>
__device__ __forceinline__ void attn_unit(LAS unsigned char* lds, int lane, int wave, const AKV& u, int s0,
                                          float sl2, float sink2, bf16_t* ob, unsigned op, float* lseb, unsigned lsep, bool hasn, const AKV& nx) {
    const int i32 = lane & 31, h = lane >> 5;
    const int jq = u.jq;
    constexpr float QKS = SQ * SK, RQK = 1.0f / (SQ * SK), NEG_RAW = -1.0e30f;
    f32x16 bias;
#pragma unroll
    for (int r = 0; r < 16; ++r) { const int kk = (r & 3) + 8 * (r >> 2) + 4 * h; bias[r] = sl2 * QKS * (float)(kk - i32); }
    __builtin_amdgcn_s_barrier();
    asm volatile("" ::: "memory");
    f32x16 S[5];
    float m2 = sink2;
    const int kro = i32 * 64 + h * 8, ksw = (i32 >> 2) & 3;
    long qf[4];
#pragma unroll
    for (int d0 = 0; d0 < 4; ++d0) qf[d0] = *(const LAS long*)(lds + ATT_QOFF + wave * 2048 + kro + ((d0 ^ ksw) * 16));
    long kf[2][4];
#pragma unroll
    for (int c = 0; c < 5; ++c) {
        const bool tv = (jq - 4 + c) >= 0;
        const LAS unsigned char* ks = lds + ATT_KOFF + (s0 + c) * 2048 + kro;
#pragma unroll
        for (int d0 = 0; d0 < 4; ++d0) kf[c & 1][d0] = *(const LAS long*)(ks + ((d0 ^ ksw) * 16));
        if (c > 0) asm volatile("" :: "v"(kf[(c - 1) & 1][0]), "v"(kf[(c - 1) & 1][1]), "v"(kf[(c - 1) & 1][2]), "v"(kf[(c - 1) & 1][3]) : "memory");
        f32x16 a = bias;
#pragma unroll
        for (int d0 = 0; d0 < 4; ++d0) a = __builtin_amdgcn_mfma_f32_32x32x16_fp8_fp8(kf[c & 1][d0], qf[d0], a, 0, 0, 0);
        if (c == 0 || c == 4) {
#pragma unroll
            for (int r = 0; r < 16; ++r) { const int kk = (r & 3) + 8 * (r >> 2) + 4 * h;
                const bool ok = (c == 4) ? (kk <= i32) : (swa ? (kk > i32) : (kk >= i32));
                a[r] = ok ? a[r] : NEG_RAW; }
        }
        float mt = fmaxf(fmaxf(a[0], a[1]), a[2]);
#pragma unroll
        for (int r = 3; r < 15; r += 2) mt = fmaxf(fmaxf(mt, a[r]), a[r + 1]);
        mt = fmaxf(mt, a[15]);
        m2 = fmaxf(m2, __builtin_fmaf(mt, RQK, tv ? -sl2 * (float)(32 * (4 - c)) : NEG_RAW));
        S[c] = a;
    }
    m2 = fmaxf(m2, __shfl_xor(m2, 32));
    float l = 0.f;
#pragma unroll
    for (int c = 0; c < 5; ++c) {
        const float offc = ((jq - 4 + c) >= 0 ? -sl2 * (float)(32 * (4 - c)) : NEG_RAW) - m2;
#pragma unroll
        for (int r = 0; r < 16; ++r) { const float p = __builtin_amdgcn_exp2f(__builtin_fmaf(S[c][r], RQK, offc)); S[c][r] = p; l += p; }
    }
    l += __shfl_xor(l, 32);
    l += __builtin_amdgcn_exp2f(sink2 - m2);
    asm volatile("" :: "v"(kf[0][0]), "v"(kf[0][1]), "v"(kf[0][2]), "v"(kf[0][3]), "v"(kf[1][0]), "v"(kf[1][1]), "v"(kf[1][2]), "v"(kf[1][3]) : "memory");
    asm volatile("s_waitcnt vmcnt(0) lgkmcnt(0)" : "+v"(l) :: "memory");
    __builtin_amdgcn_s_barrier();
    asm volatile("" ::: "memory");
    if (hasn) { attn_issue_k(lds, lane, wave, nx); attn_issue_q(lds, lane, wave, nx); }
    f32x16 O[2]; O[0] = (f32x16){}; O[1] = (f32x16){};
    const int vaddr0 = ((lane >> 4) & 1) * 32 + (lane & 3) * 8 + (4 * h + ((lane & 15) >> 2)) * 64;
    const unsigned vbase = (unsigned)(size_t)(lds + ATT_VOFF) + (unsigned)(s0 * 4096 + vaddr0);
    s16x4 va[2][8]; bf16x8 pf[2][2];
    pv_tile<0>(va[0], va[1], pf[0], pf[1], vbase, S[0], O); pv_tile<1>(va[1], va[0], pf[1], pf[0], vbase, S[1], O); pv_tile<2>(va[0], va[1], pf[0], pf[1], vbase, S[2], O);
    pv_tile<3>(va[1], va[0], pf[1], pf[0], vbase, S[3], O); pv_tile<4>(va[0], va[1], pf[0], pf[1], vbase, S[4], O);
    asm volatile("" :: "v"(pf[0][0]), "v"(pf[0][1]), "v"(pf[1][0]), "v"(pf[1][1]) : "memory");
    asm volatile("" :: "v"(va[0][0]), "v"(va[0][1]), "v"(va[0][2]), "v"(va[0][3]), "v"(va[0][4]), "v"(va[0][5]), "v"(va[0][6]), "v"(va[0][7]) : "memory");
    asm volatile("" :: "v"(va[1][0]), "v"(va[1][1]), "v"(va[1][2]), "v"(va[1][3]), "v"(va[1][4]), "v"(va[1][5]), "v"(va[1][6]), "v"(va[1][7]) : "memory");
    __builtin_amdgcn_s_barrier();
    asm volatile("" ::: "memory");
    int nv = 0;
    if (hasn) { if (nx.nkt == 12) nv = attn_issue_v<12>(lds, lane, wave, nx); else nv = attn_issue_v<5>(lds, lane, wave, nx); }
    const float inv = 1.0f / l;
    LAS unsigned char* stg = lds + ATT_STG + wave * ATT_STGW;
    if (swa) {
        const float is = inv * SO;
#pragma unroll
        for (int blk = 0; blk < 2; ++blk)
#pragma unroll
            for (int g4 = 0; g4 < 4; ++g4) { const int d0 = blk * 32 + 8 * g4 + 4 * h;
                *(LAS unsigned*)(stg + i32 * 80 + d0) = pk4_fp8_pad(clamp_fp8(O[blk][4 * g4 + 0] * is), clamp_fp8(O[blk][4 * g4 + 1] * is), clamp_fp8(O[blk][4 * g4 + 2] * is), clamp_fp8(O[blk][4 * g4 + 3] * is)); }
        asm volatile("s_waitcnt lgkmcnt(0)" ::: "memory");
#pragma unroll
        for (int it = 0; it < 2; ++it) { const int row = it * 16 + (lane >> 2), ch = lane & 3;
            const u32x4 v = *(const LAS u32x4*)(stg + row * 80 + ch * 16);
            *(u32x4*)((char*)ob + (size_t)(32 * jq + row) * op + ch * 16) = v; }
    } else {
#pragma unroll
        for (int blk = 0; blk < 2; ++blk)
#pragma unroll
            for (int g4 = 0; g4 < 4; ++g4) { const int d0 = blk * 32 + 8 * g4 + 4 * h;
                u32x2 w; w.x = cvt_pk_bf16(O[blk][4 * g4 + 0] * inv, O[blk][4 * g4 + 1] * inv); w.y = cvt_pk_bf16(O[blk][4 * g4 + 2] * inv, O[blk][4 * g4 + 3] * inv);
                *(LAS u32x2*)(stg + i32 * 144 + d0 * 2) = w; }
        asm volatile("s_waitcnt lgkmcnt(0)" ::: "memory");
#pragma unroll
        for (int it = 0; it < 4; ++it) { const int row = it * 8 + (lane >> 3), ch = lane & 7;
            const u32x4 v = *(const LAS u32x4*)(stg + row * 144 + ch * 16);
            *(u32x4*)((char*)ob + (size_t)(32 * jq + row) * op + ch * 16) = v; }
    }
    if (lseb != nullptr && h == 0) lseb[(size_t)(32 * jq + i32) * lsep] = (m2 + __builtin_amdgcn_logf(l)) * LN2;
    attn_wait(hasn ? nv + (swa ? 2 : 5) : 0);
}
__device__ __forceinline__ void p2_attention(Frame& F, const float* sinks) {
    unsigned char* OAB = F.dout + DO_OAB; bf16_t* OAG = (bf16_t*)(F.ws + WS_OAG); float* LSE = (float*)(F.ws + WS_LSE);
    constexpr int NUNIT = 2048 + 1536;
    int U = F.vcu; if (U >= NUNIT) return;
    float snk0 = sinks[F.wave] * LOG2E, snk1 = sinks[8 + F.wave] * LOG2E;
    asm volatile("" : "+v"(snk0), "+v"(snk1));
    AKV cur = attn_kv(F, U);
    attn_issue_k(F.lds, F.lane, F.wave, cur);
    attn_issue_q(F.lds, F.lane, F.wave, cur);
    { const int nv0 = (cur.nkt == 12) ? attn_issue_v<12>(F.lds, F.lane, F.wave, cur) : attn_issue_v<5>(F.lds, F.lane, F.wave, cur); attn_wait(nv0); }
    for (;;) {
        const int Un = U + F.G; const bool hasn = Un < NUNIT;
        const AKV nxt = attn_kv(F, hasn ? Un : U);
        if (U < 2048) {
            const int b = U >> 8, kvh = (U >> 7) & 1, hq = kvh * 8 + F.wave;
            const float slope = exp2f(-8.0f * (float)(hq + 1) / 28.0f);
            attn_unit<true>(F.lds, F.lane, F.wave, cur, 0, slope * LOG2E, kvh ? snk1 : snk0, (bf16_t*)(OAB + (size_t)b * SEQ * OAB_P + 256 + hq * 64), OAB_P, nullptr, 0, hasn, nxt);
        } else {
            const int v = U - 2048, g = v >> 9, w_ = v & 511, b = w_ >> 6, x = w_ & 63, hh = x >> 4, y = x & 15;
            const int dil = (g == 0) ? 1 : (g == 1) ? 4 : 16;
            const int res = (g == 0) ? 0 : (g == 1) ? (y >> 2) : y;
            const size_t tok0 = (size_t)b * SEQ + res;
            const float slope = exp2f(-8.0f * (float)(16 + g * 4 + hh + 1) / 28.0f);
            attn_unit<false>(F.lds, F.lane, F.wave, cur, F.wave, slope * (float)dil * LOG2E, NEG_BIG,
                             OAG + ((size_t)g * NTOK + tok0) * 256 + hh * 64, (unsigned)(dil * 256 * 2), LSE + ((size_t)g * NTOK + tok0) * 4 + hh, (unsigned)(dil * 4), hasn, nxt);
        }
        if (!hasn) break;
        U = Un; cur = nxt;
    }
}
__device__ __forceinline__ void p3_merge(Frame& F) {
    const bf16_t* OAG = (const bf16_t*)(F.ws + WS_OAG); const float* LSE = (const float*)(F.ws + WS_LSE); unsigned char* OAB = F.dout + DO_OAB;
    const int gw = F.vcu * NWAVES + F.wave, NGW = F.G * NWAVES;
    for (int idx = gw; idx < NTOK / 2; idx += NGW) {
        const int tok = idx * 2 + (F.lane >> 5), c8 = F.lane & 31, hh = c8 >> 3;
        float ls[3]; u32x4 o[3];
#pragma unroll
        for (int g = 0; g < 3; ++g) { ls[g] = LSE[((size_t)g * NTOK + tok) * 4 + hh]; o[g] = *(const u32x4*)(OAG + ((size_t)g * NTOK + tok) * 256 + c8 * 8); }
        const float m = fmaxf(fmaxf(ls[0], ls[1]), ls[2]);
        float w[3]; float sum = 0.f;
#pragma unroll
        for (int g = 0; g < 3; ++g) { w[g] = __builtin_amdgcn_exp2f((ls[g] - m) * LOG2E); sum += w[g]; }
        const float is = 1.0f / sum; float r[8];
#pragma unroll
        for (int q = 0; q < 8; ++q) r[q] = 0.f;
#pragma unroll
        for (int g = 0; g < 3; ++g) { const float wg = w[g] * is;
            r[0] += wg * bf_lo(o[g].x); r[1] += wg * bf_hi(o[g].x); r[2] += wg * bf_lo(o[g].y); r[3] += wg * bf_hi(o[g].y);
            r[4] += wg * bf_lo(o[g].z); r[5] += wg * bf_hi(o[g].z); r[6] += wg * bf_lo(o[g].w); r[7] += wg * bf_hi(o[g].w); }
        u32x2 out; out.x = pk4_fp8(clamp_fp8(r[0] * SO), clamp_fp8(r[1] * SO), clamp_fp8(r[2] * SO), clamp_fp8(r[3] * SO)); out.y = pk4_fp8(clamp_fp8(r[4] * SO), clamp_fp8(r[5] * SO), clamp_fp8(r[6] * SO), clamp_fp8(r[7] * SO));
        *(u32x2*)(OAB + (size_t)tok * OAB_P + c8 * 8) = out;
    }
}

__device__ __forceinline__ void p6_router(Frame& F, const bf16_t* y, const float* stat, const float* gam, const float* bet, bf16_t* x1b, unsigned char* x1q, const float* rb, int cw_ecnt, size_t pe_off) {
    constexpr int WPITCH = 2064;
    constexpr int WIMG = 64 * WPITCH;
    constexpr int GOFF = WIMG + 2048;
    static_assert(GOFF + 8192 <= SCR_BYTES, "router LDS map");
    LAS int* wcnt = (LAS int*)(F.lds + WIMG + F.wave * 256); LAS int* wbase = wcnt + 32;
    int* petok = (int*)(F.ws + WS_PETOK + pe_off); float* pegate = (float*)(F.ws + WS_PEGATE + pe_off);
    const bf16_t* WRT = (const bf16_t*)(F.ws + WS_WRT);
    const int gw = F.vcu * NWAVES + F.wave, NGW = F.G * NWAVES, lane = F.lane, j = lane & 15, kq = lane >> 4;
    __syncthreads();
    for (int q = F.tid; q < 64 * 128; q += NWAVES * 64) { const u32x4 v = *(const u32x4*)((const char*)WRT + (size_t)q * 16); *(LAS u32x4*)(F.lds + (q >> 7) * WPITCH + (q & 127) * 16) = v; }
    for (int q = F.tid; q < 512; q += NWAVES * 64) { const f32x4 v = (q < 256) ? *(const f32x4*)(gam + q * 4) : *(const f32x4*)(bet + (q - 256) * 4); *(LAS f32x4*)(F.lds + GOFF + q * 16) = v; }
    __syncthreads();
    const LAS unsigned char* wrow = F.lds + j * WPITCH + kq * 16;
    const LAS float* gl = (const LAS float*)(F.lds + GOFF) + 8 * kq; const LAS float* bl = gl + 1024;
    for (int tb = F.vcu * NWAVES; tb < NTOK / 16; tb += NGW) {
        const int tt = tb + F.wave; const bool valid = tt < NTOK / 16; const int t0 = (valid ? tt : 0) * 16;
        float mean, rstd;
        { const f32x4* sp = (const f32x4*)(stat + (size_t)(t0 + j) * 32); float s1 = 0.f, s2 = 0.f;
#pragma unroll
          for (int q = 0; q < 8; ++q) { const f32x4 v = sp[q]; s1 += v[0] + v[2]; s2 += v[1] + v[3]; }
          mean = s1 * (1.0f / D); const float var = fmaxf(s2 * (1.0f / D) - mean * mean, 0.f); rstd = 1.0f / sqrtf(var + LN_EPS); }
        f32x4 acc[2]; acc[0] = (f32x4){0.f, 0.f, 0.f, 0.f}; acc[1] = acc[0];
        const bf16_t* yrow = y + (size_t)(t0 + j) * D + 8 * kq;
        bf16_t* xbrow = (valid ? x1b : (bf16_t*)(F.ws + 300 * MiB)) + (size_t)(t0 + j) * D + 8 * kq; unsigned char* xqrow = (valid ? x1q : F.ws + 300 * MiB) + (size_t)(t0 + j) * D + 8 * kq;
        bf16x8 wf[2][4]; wf[1][0] = (bf16x8){}; wf[1][1] = wf[1][0]; wf[1][2] = wf[1][0]; wf[1][3] = wf[1][0];
        u32x4 yv[4], yn[4]; u32x2 q8prev = (u32x2){0u, 0u};
#pragma unroll
        for (int u = 0; u < 4; ++u) yv[u] = *(const u32x4*)(yrow + 32 * u);
#pragma unroll 1
        for (int so = 0; so < D / 32; so += 4) {
            const int sn = (so + 4 < D / 32) ? so + 4 : so;
#pragma unroll
            for (int u = 0; u < 4; ++u) yn[u] = *(const u32x4*)(yrow + 32 * (sn + u));
#pragma unroll
            for (int u = 0; u < 4; ++u) { const int sI = so + u;
                wf[u & 1][0] = *(const LAS bf16x8*)(wrow + 64 * sI); wf[u & 1][1] = *(const LAS bf16x8*)(wrow + 16 * WPITCH + 64 * sI);
                wf[u & 1][2] = *(const LAS bf16x8*)(wrow + 32 * WPITCH + 64 * sI); wf[u & 1][3] = *(const LAS bf16x8*)(wrow + 48 * WPITCH + 64 * sI);
                const f32x4 g0 = *(const LAS f32x4*)(gl + 32 * sI), g1 = *(const LAS f32x4*)(gl + 32 * sI + 4), b0 = *(const LAS f32x4*)(bl + 32 * sI), b1 = *(const LAS f32x4*)(bl + 32 * sI + 4);
                asm volatile("" :: "v"(wf[(u + 1) & 1][0]), "v"(wf[(u + 1) & 1][1]), "v"(wf[(u + 1) & 1][2]), "v"(wf[(u + 1) & 1][3]) : "memory");
                f32x4 n0, n1;
                n0[0] = (bf_lo(yv[u].x) - mean) * rstd * g0[0] + b0[0]; n0[1] = (bf_hi(yv[u].x) - mean) * rstd * g0[1] + b0[1]; n0[2] = (bf_lo(yv[u].y) - mean) * rstd * g0[2] + b0[2]; n0[3] = (bf_hi(yv[u].y) - mean) * rstd * g0[3] + b0[3];
                n1[0] = (bf_lo(yv[u].z) - mean) * rstd * g1[0] + b1[0]; n1[1] = (bf_hi(yv[u].z) - mean) * rstd * g1[1] + b1[1]; n1[2] = (bf_lo(yv[u].w) - mean) * rstd * g1[2] + b1[2]; n1[3] = (bf_hi(yv[u].w) - mean) * rstd * g1[3] + b1[3];
                u32x4 xw; xw.x = cvt_pk_bf16(n0[0], n0[1]); xw.y = cvt_pk_bf16(n0[2], n0[3]); xw.z = cvt_pk_bf16(n1[0], n1[1]); xw.w = cvt_pk_bf16(n1[2], n1[3]);
                *(u32x4*)(xbrow + 32 * sI) = xw;
                { u32x2 q8; q8.x = pk4_fp8(clamp_fp8(n0[0] * SX), clamp_fp8(n0[1] * SX), clamp_fp8(n0[2] * SX), clamp_fp8(n0[3] * SX)); q8.y = pk4_fp8(clamp_fp8(n1[0] * SX), clamp_fp8(n1[1] * SX), clamp_fp8(n1[2] * SX), clamp_fp8(n1[3] * SX));
                  if (u & 1) *(u32x4*)(xqrow + 32 * (sI - 1 + (kq & 1)) - 8 * (kq & 1)) = pg8::pair16(q8prev, q8); else q8prev = q8; }
                const bf16x8 xh = __builtin_bit_cast(bf16x8, xw);
                acc[0] = __builtin_amdgcn_mfma_f32_16x16x32_bf16(wf[u & 1][0], xh, acc[0], 0, 0, 0); acc[1] = __builtin_amdgcn_mfma_f32_16x16x32_bf16(wf[u & 1][1], xh, acc[1], 0, 0, 0);
                acc[0] = __builtin_amdgcn_mfma_f32_16x16x32_bf16(wf[u & 1][2], xh, acc[0], 0, 0, 0); acc[1] = __builtin_amdgcn_mfma_f32_16x16x32_bf16(wf[u & 1][3], xh, acc[1], 0, 0, 0); }
#pragma unroll
            for (int u = 0; u < 4; ++u) yv[u] = yn[u];
        }
        float lg[8];
#pragma unroll
        for (int q = 0; q < 8; ++q) lg[q] = acc[q >> 2][q & 3] + rb[16 * (q >> 2) + 4 * kq + (q & 3)];
        unsigned taken = 0u; float tv[4]; int ti[4];
#pragma unroll
        for (int k = 0; k < 4; ++k) {
            float bv = -3.0e38f; int bi = 64;
#pragma unroll
            for (int q = 0; q < 8; ++q) { const bool free_ = ((taken >> q) & 1u) == 0u; if (free_ && lg[q] > bv) { bv = lg[q]; bi = 16 * (q >> 2) + 4 * kq + (q & 3); } }
            const int mybi = bi;
#pragma unroll
            for (int o = 16; o < 64; o <<= 1) { const float ov = __shfl_xor(bv, o); const int oi = __shfl_xor(bi, o); const bool keep = (bv > ov) || (bv == ov && bi < oi); bv = keep ? bv : ov; bi = keep ? bi : oi; }
            tv[k] = bv; ti[k] = bi;
            if (bi == mybi && ((bi >> 2) & 3) == kq) taken |= 1u << (4 * (bi >> 4) + (bi & 3));
        }
        float gk[4]; float gs = 0.f;
#pragma unroll
        for (int k = 0; k < 4; ++k) { gk[k] = __builtin_amdgcn_exp2f((tv[k] - tv[0]) * LOG2E); gs += gk[k]; }
        const float gi = 1.0f / gs;
        if (lane < 32) wcnt[lane] = 0;
        asm volatile("s_waitcnt lgkmcnt(0)" ::: "memory");
        const int e0 = (kq == 0) ? ti[0] : (kq == 1) ? ti[1] : (kq == 2) ? ti[2] : ti[3];
        const float g0 = ((kq == 0) ? gk[0] : (kq == 1) ? gk[1] : (kq == 2) ? gk[2] : gk[3]) * gi;
        int r0 = 0;
        if (valid) r0 = __hip_atomic_fetch_add(wcnt + e0, 1, __ATOMIC_RELAXED, __HIP_MEMORY_SCOPE_WORKGROUP);
        asm volatile("s_waitcnt lgkmcnt(0)" ::: "memory");
        __syncthreads();
        if (F.wave == 0 && lane < 32) { int c[NWAVES]; int tot = 0;
#pragma unroll
            for (int w = 0; w < NWAVES; ++w) { c[w] = *(LAS int*)(F.lds + WIMG + w * 256 + 4 * lane); tot += c[w]; }
            int b = 0; if (tot > 0) b = (int)__hip_atomic_fetch_add((unsigned*)(F.ctl + cw_ecnt + 64 * lane), (unsigned)tot, RLX_AGENT);
#pragma unroll
            for (int w = 0; w < NWAVES; ++w) { *(LAS int*)(F.lds + WIMG + w * 256 + 128 + 4 * lane) = b; b += c[w]; } }
        asm volatile("s_waitcnt vmcnt(0) lgkmcnt(0)" ::: "memory");
        __syncthreads();
        if (valid) { const int p0 = wbase[e0] + r0;
            petok[(size_t)e0 * NTOK + p0] = (t0 + j) * 4 + kq; pegate[(size_t)e0 * NTOK + p0] = g0; }
        asm volatile("s_waitcnt lgkmcnt(0)" ::: "memory");
        __syncthreads();
    }
}
__device__ __forceinline__ int moe_tables(Frame& F) {
    LAS int* cnt = (LAS int*)(F.lds + MOE_OFF); LAS int* fs = (LAS int*)(F.lds + MOE_OFF + 128); LAS unsigned char* te = F.lds + MOE_OFF + 128 + 136;
    __syncthreads();
    if (F.tid < NEXP) cnt[F.tid] = (int)__hip_atomic_load(F.ctl + CW_ECNT + 64 * F.tid, RLX_AGENT);
    __syncthreads();
    if (F.tid == 0) { int s = 0; for (int e = 0; e < NEXP; ++e) { fs[e] = s; s += (cnt[e] + 255) >> 8; } fs[NEXP] = s; }
    __syncthreads();
    const int T = fs[NEXP];
    for (int t = F.tid; t < T; t += NWAVES * 64) { int e = 0;
#pragma unroll 8
        for (int q = 1; q < NEXP; ++q) e += (fs[q] <= t) ? 1 : 0;
        te[t] = (unsigned char)e; }
    __syncthreads();
    return T;
}
__device__ __forceinline__ void p9_final(Frame& F, const float* gam, const float* bet, const float* out, float* outw, bool poison) {
    const bf16_t* X1B = (const bf16_t*)(F.ws + WS_X1B);
    const int gw = F.vcu * NWAVES + F.wave, NGW = F.G * NWAVES, lane = F.lane;
    const float qnan = __builtin_nanf("");
    f32x4 g[4], bb[4];
#pragma unroll
    for (int k = 0; k < 4; ++k) { g[k] = *(const f32x4*)(gam + 256 * k + 4 * lane); bb[k] = *(const f32x4*)(bet + 256 * k + 4 * lane); }
    for (int tok0 = gw; tok0 < NTOK; tok0 += 2 * NGW) {
        u32x2 xw[2][4]; unsigned yw[2][4][4];
#pragma unroll
        for (int tI = 0; tI < 2; ++tI) { const int tok = min(tok0 + tI * NGW, NTOK - 1);
            const unsigned char* y = (const unsigned char*)out + (size_t)tok * 4096 + lane * 4;
#pragma unroll
            for (int k = 0; k < 4; ++k) { xw[tI][k] = *(const u32x2*)(X1B + (size_t)tok * D + 256 * k + 4 * lane);
#pragma unroll
                for (int s = 0; s < 4; ++s) yw[tI][s][k] = *(const unsigned*)(y + 1024 * s + 256 * k); } }
#pragma unroll
        for (int tI = 0; tI < 2; ++tI) { const int tok = tok0 + tI * NGW; if (tok >= NTOK) break;
            float v[16];
#pragma unroll
            for (int k = 0; k < 4; ++k) {
                v[4 * k + 0] = DN_ALPHA * bf_lo(xw[tI][k].x); v[4 * k + 1] = DN_ALPHA * bf_hi(xw[tI][k].x); v[4 * k + 2] = DN_ALPHA * bf_lo(xw[tI][k].y); v[4 * k + 3] = DN_ALPHA * bf_hi(xw[tI][k].y);
                f32x2 lo = __builtin_amdgcn_cvt_pk_f32_fp8((int)yw[tI][0][k], false) + __builtin_amdgcn_cvt_pk_f32_fp8((int)yw[tI][1][k], false) + __builtin_amdgcn_cvt_pk_f32_fp8((int)yw[tI][2][k], false) + __builtin_amdgcn_cvt_pk_f32_fp8((int)yw[tI][3][k], false);
                f32x2 hi = __builtin_amdgcn_cvt_pk_f32_fp8((int)yw[tI][0][k], true) + __builtin_amdgcn_cvt_pk_f32_fp8((int)yw[tI][1][k], true) + __builtin_amdgcn_cvt_pk_f32_fp8((int)yw[tI][2][k], true) + __builtin_amdgcn_cvt_pk_f32_fp8((int)yw[tI][3][k], true);
                v[4 * k + 0] += lo[0] * (1.0f / SY); v[4 * k + 1] += lo[1] * (1.0f / SY); v[4 * k + 2] += hi[0] * (1.0f / SY); v[4 * k + 3] += hi[1] * (1.0f / SY); }
            float s = 0.f;
#pragma unroll
            for (int q = 0; q < 16; ++q) s += v[q];
            const float mean = wave_sum(s) * (1.0f / D); float s2 = 0.f;
#pragma unroll
            for (int q = 0; q < 16; ++q) { v[q] -= mean; s2 += v[q] * v[q]; }
            const float rstd = 1.0f / sqrtf(wave_sum(s2) * (1.0f / D) + LN_EPS);
            float* op = outw + (size_t)tok * D + 4 * lane;
#pragma unroll
            for (int k = 0; k < 4; ++k) { f32x4 o;
#pragma unroll
                for (int q = 0; q < 4; ++q) o[q] = v[4 * k + q] * rstd * g[k][q] + bb[k][q];
                if (poison) o = (f32x4){qnan, qnan, qnan, qnan};
                *(f32x4*)(op + 256 * k) = o; }
        }
    }
}
#define CAS __attribute__((address_space(4)))
__device__ __forceinline__ const float* arg_in(int i) {
    const unsigned char CAS* ka = (const unsigned char CAS*)__builtin_amdgcn_kernarg_segment_ptr();
    asm volatile("" : "+s"(ka));
    return *(const float* const CAS*)(ka + 8 * i);
}
struct Args { const float* in[18]; float* out; unsigned char* ws; int ph_lo, ph_hi; };
__global__ void __launch_bounds__(NWAVES * 64, 2) fwd_kernel(Args args) {
    extern __shared__ __attribute__((aligned(16))) unsigned char lds[];
    Frame F;
    F.lds = (LAS unsigned char*)lds;
    F.MISC = (volatile LAS unsigned*)(F.lds + MISC_OFF);
    F.tid = threadIdx.x; F.lane = F.tid & 63; F.wave = __builtin_amdgcn_readfirstlane(F.tid >> 6);
    F.G = gridDim.x; { const int bx = blockIdx.x; F.vcu = (F.G % 8 == 0) ? (bx % 8) * (F.G / 8) + bx / 8 : bx; }
    F.ws = args.ws; F.dout = (unsigned char*)args.out;
    F.ctl = (gu32*)(args.ws + WS_CTL);
    for (int u = F.tid; u < (LDS_BYTES - LDSCTL_OFF) / 4; u += NWAVES * 64) ((LAS unsigned*)(F.lds + LDSCTL_OFF))[u] = 0u;
    __syncthreads();
    XcdBarrier bar; bar.bar = (unsigned*)(F.ctl + CW_BAR); bar.x = 0; bar.st = nullptr;
    if (N_LAUNCHES == 1) bar = xcd_barrier_post((unsigned*)(F.ctl + CW_BAR), F.MISC + 8);
    const int lo = args.ph_lo, hi = args.ph_hi;
#ifdef ONLY_PHASE
#define IN(k) ((k) == ONLY_PHASE && lo <= (k) && (k) < hi)
#else
#define IN(k) (lo <= (k) && (k) < hi)
#endif
#define SEAM(k) do { if (IN(k) && IN((k) + 1)) xcd_barrier(bar); } while (0)
    unsigned char* HQ = F.ws + WS_HQ; unsigned char* SG = F.ws + WS_SG;

#define PHASE(k, ...) do { if (IN(k)) { __VA_ARGS__ if (DUP_PHASE == (k)) { __VA_ARGS__ } } } while (0)
    PHASE(0, p0_convert(F, arg_in(0), arg_in(1), arg_in(3), arg_in(4), arg_in(5), arg_in(8));); SEAM(0);
    PHASE(1,
        { const int gemm_wgs = (F.G == 256) ? 192 : F.G;
          if ((int)blockIdx.x < gemm_wgs) {
            pg8::Gemm g{(const char*)(F.dout + DO_XB), (const char*)(F.dout + DO_WIN), D, D, D / 128}; pg8::StaticOrder S; S.init(NTOK, IN_COLS, gemm_wgs, (int)blockIdx.x);
            pg8::EpiInProj E{HQ, SG, 1.0f / (SXIN * SW)};
            pg8::gemm_phase<pg8::EpiInProj, pg8::StaticOrder, true, false, true>(F.lds, g, S, E); }
          if (gemm_wgs == F.G) p3_convert_moe(F, arg_in(10), arg_in(12), arg_in(14), F.vcu, F.G);
          else if ((int)blockIdx.x >= gemm_wgs) p3_convert_moe(F, arg_in(10), arg_in(12), arg_in(14), (int)blockIdx.x - gemm_wgs, F.G - gemm_wgs); }
    ); SEAM(1);
    PHASE(2, p2_attention(F, arg_in(2));); SEAM(2);
    PHASE(3, p3_merge(F);); SEAM(3);
    PHASE(4,
        { pg8::Gemm g{(const char*)(F.dout + DO_OAB), (const char*)(F.dout + DO_WCAT), OAB_P, OAB_P, OAB_P / 128}; pg8::StaticOrder S; S.init(NTOK, D, F.G, (int)blockIdx.x);
        pg8::EpiGate E{SG, F.ws + WS_MRG};
        pg8::gemm_phase<pg8::EpiGate, pg8::StaticOrder, true, false, true>(F.lds, g, S, E); }
    ); SEAM(4);
    PHASE(5,
        { pg8::Gemm g{(const char*)(F.ws + WS_MRG), (const char*)(F.ws + WS_WOUT), D, D, D / 128}; pg8::StaticOrder S; S.init(NTOK, D, F.G, (int)blockIdx.x);
        pg8::EpiY E{arg_in(0), (bf16_t*)(F.ws + WS_Y), (float*)(F.ws + WS_STAT), 1.0f / (SM * SW)};
        pg8::gemm_phase<pg8::EpiY, pg8::StaticOrder, true, false, true>(F.lds, g, S, E); }
    ); SEAM(5);
    if (IN(6)) { if (DUP_PHASE == 6) p6_router(F, (const bf16_t*)(F.ws + WS_Y), (const float*)(F.ws + WS_STAT), arg_in(6), arg_in(7), (bf16_t*)(F.ws + 264 * MiB), F.ws + 330 * MiB, arg_in(9), CW_ECNT + 64 * NEXP, (size_t)362 * MiB - WS_PETOK);
        p6_router(F, (const bf16_t*)(F.ws + WS_Y), (const float*)(F.ws + WS_STAT), arg_in(6), arg_in(7), (bf16_t*)(F.ws + WS_X1B), F.ws + WS_X1Q, arg_in(9), CW_ECNT, 0); } SEAM(6);
    PHASE(7,
        { const int T = moe_tables(F);
        pg8::Gemm g{(const char*)(F.ws + WS_X1Q), (const char*)(F.ws + WS_WGU), D, D, D / 128};
        pg8::MoeOrder S{T, 8, F.G, (int)blockIdx.x, (const LAS int*)(F.lds + MOE_OFF), (const LAS int*)(F.lds + MOE_OFF + 128), (const LAS unsigned char*)(F.lds + MOE_OFF + 128 + 136),
                        (const int*)(F.ws + WS_PETOK), (size_t)2048 * D, true, (unsigned)D};
        pg8::EpiGU E{arg_in(11), arg_in(13), F.ws + WS_HDN, F.lds};
        pg8::gemm_phase<pg8::EpiGU, pg8::MoeOrder, true, true, true>(F.lds, g, S, E); }
    ); SEAM(7);
    PHASE(8,
        { const int T = moe_tables(F);
        pg8::Gemm g{(const char*)(F.ws + WS_HDN), (const char*)(F.ws + WS_WD), DFF, DFF, DFF / 128};
        pg8::MoeOrder S{T, 4, F.G, (int)blockIdx.x, (const LAS int*)(F.lds + MOE_OFF), (const LAS int*)(F.lds + MOE_OFF + 128), (const LAS unsigned char*)(F.lds + MOE_OFF + 128 + 136),
                        (const int*)(F.ws + WS_PETOK), (size_t)D * DFF, false, 0u};
        pg8::EpiDown E{arg_in(15), (const int*)(F.ws + WS_PETOK), (const float*)(F.ws + WS_PEGATE), F.dout, F.lds};
        pg8::gemm_phase<pg8::EpiDown, pg8::MoeOrder, true, false, true>(F.lds, g, S, E); }
    ); SEAM(8);
    if (IN(9)) {
        bool poison = (__hip_atomic_load(F.ctl + CW_TMO, RLX_AGENT) != 0u) || (__hip_atomic_load(F.ctl + CW_BAR + XB_TMO, RLX_AGENT) != 0u);
        if (DUP_PHASE == 9) p9_final(F, arg_in(16), arg_in(17), (const float*)F.dout, (float*)(F.ws + 194 * MiB), poison);
        p9_final(F, arg_in(16), arg_in(17), (const float*)F.dout, (float*)F.dout, poison);
    }
#undef PHASE
#undef IN
#undef SEAM
}

extern "C" void kernel_launch(void* const* d_in, const int* in_sizes, int n_in, void* d_out, int out_size, void* d_ws, size_t ws_size, hipStream_t stream) {
    static int grid = 0;
    if (grid == 0) {
        if (n_in != 18 || in_sizes[0] != NTOK * D || out_size != NTOK * D || ws_size < WS_END) { fprintf(stderr, "kernel_launch: unexpected shapes (n_in %d, ws %zu); nothing launched\n", n_in, ws_size); grid = -1; return; }
        int dev = 0, cus = 0, per_cu = 0;
        if (hipGetDevice(&dev) != hipSuccess || hipDeviceGetAttribute(&cus, hipDeviceAttributeMultiprocessorCount, dev) != hipSuccess) { grid = -1; return; }
        if (hipFuncSetAttribute((const void*)fwd_kernel, hipFuncAttributeMaxDynamicSharedMemorySize, LDS_BYTES) != hipSuccess) { fprintf(stderr, "kernel_launch: hipFuncSetAttribute failed\n"); grid = -1; return; }
        if (hipOccupancyMaxActiveBlocksPerMultiprocessor(&per_cu, (const void*)fwd_kernel, NWAVES * 64, LDS_BYTES) != hipSuccess || per_cu < 1) fprintf(stderr, "kernel_launch: occupancy query reports %d\n", per_cu);
        (void)hipGetLastError();
        grid = cus;
    }
    if (grid < 0) return;
    if (hipMemsetAsync((char*)d_ws + WS_CTL, 0, CTL_ZERO_BYTES, stream) != hipSuccess) return;
    Args a{};
    for (int i = 0; i < 18; ++i) a.in[i] = (const float*)d_in[i];
    a.out = (float*)d_out; a.ws = (unsigned char*)d_ws;
    if (N_LAUNCHES == 1) { a.ph_lo = 0; a.ph_hi = N_PHASES; hipLaunchKernelGGL(fwd_kernel, dim3(grid), dim3(NWAVES * 64), LDS_BYTES, stream, a); }
    else for (int p = 0; p < N_PHASES; ++p) { a.ph_lo = p; a.ph_hi = p + 1; hipLaunchKernelGGL(fwd_kernel, dim3(grid), dim3(NWAVES * 64), LDS_BYTES, stream, a); }
}
```

```cpp
#include <hip/hip_runtime.h>
#include <cstdio>
#include <cstdint>

#define GAS __attribute__((address_space(1)))
#define LAS __attribute__((address_space(3)))
typedef unsigned short bf16_t;
typedef short bf16x8 __attribute__((ext_vector_type(8)));
typedef short s16x4 __attribute__((ext_vector_type(4)));
typedef float f32x2 __attribute__((ext_vector_type(2)));
typedef float f32x4 __attribute__((ext_vector_type(4)));
typedef float f32x16 __attribute__((ext_vector_type(16)));
typedef unsigned u32x2 __attribute__((ext_vector_type(2)));
typedef unsigned u32x4 __attribute__((ext_vector_type(4)));
typedef GAS unsigned gu32;

#ifndef MK_N_LAUNCHES
#define MK_N_LAUNCHES 1
#endif
#ifndef DUP_PHASE
#define DUP_PHASE -1
#endif
constexpr int N_PHASES = 10;
constexpr int N_LAUNCHES = MK_N_LAUNCHES;

constexpr int NB = 8, SEQ = 4096, D = 1024, NTOK = NB * SEQ;
constexpr int HQ_P = 3584;
constexpr int SG_P = 2048;
constexpr int OAB_P = 1280;
constexpr int IN_COLS = 5632;
constexpr int NEXP = 32, TOPK = 4, DFF = 1024;
constexpr int MAX_MT = 544;
constexpr float LN_EPS = 1e-5f;
constexpr float DN_ALPHA = 1.189207115002721f;
constexpr float LOG2E = 1.4426950408889634f, LN2 = 0.6931471805599453f;
constexpr float QSCALE = 0.125f * LOG2E;
constexpr float NEG_BIG = -1e30f;

constexpr size_t MiB = 1u << 20;
constexpr size_t WS_CTL = 0, CTL_ZERO_BYTES = 1 * MiB;
constexpr size_t WS_XBUF = 1 * MiB;
constexpr size_t WS_Y = 194 * MiB;
constexpr size_t WS_STAT = 258 * MiB;
constexpr size_t WS_HQ = 2 * MiB;
constexpr size_t HQ_QD = 0, HQ_KD = 48 * MiB, HQ_VD = 96 * MiB, HQ_QS = 144 * MiB, HQ_KS = 208 * MiB, HQ_VS = 216 * MiB;
constexpr size_t WS_WGU = 404 * MiB;
constexpr size_t WS_WD = 468 * MiB;
constexpr size_t WS_X1B = 98 * MiB;
constexpr size_t WS_X1Q = 162 * MiB;
constexpr size_t WS_HDN = 194 * MiB;
constexpr size_t WS_SG = 226 * MiB;
constexpr size_t WS_YS23 = 330 * MiB;
constexpr size_t WS_OAG = 354 * MiB;
constexpr size_t WS_LSE = 402 * MiB;
constexpr size_t WS_MRG = 2 * MiB;
constexpr size_t WS_WOUT = 530 * MiB;
constexpr size_t WS_PETOK = 532 * MiB;
constexpr size_t WS_PEGATE = 536 * MiB;
constexpr size_t WS_WRT = 540 * MiB;
constexpr size_t WS_END = 540 * MiB + 256 * 1024;
constexpr float SX = 8.0f, SW = 512.0f, SH = 4.0f, SXIN = 8.0f, SY = 64.0f, SM = 64.0f, SO = 64.0f, SSG = 256.0f, SQ = 64.0f, SK = 16.0f;
static_assert(WS_HQ + (size_t)NTOK * HQ_P * 2 <= WS_SG && WS_SG + (size_t)NTOK * SG_P <= WS_OAG && WS_OAG + (size_t)3 * NTOK * 256 * 2 <= WS_LSE && WS_LSE + (size_t)3 * NTOK * 4 * 4 <= WS_WGU, "ws map 1");
static_assert(WS_WGU + (size_t)NEXP * 2048 * D <= WS_WD && WS_WD + (size_t)NEXP * D * DFF <= WS_WOUT && WS_MRG + (size_t)NTOK * D <= WS_X1B && WS_X1B + (size_t)NTOK * D * 2 <= WS_X1Q && WS_X1Q + (size_t)NTOK * D <= WS_HDN, "ws map 2");
static_assert(WS_HDN + (size_t)MAX_MT * 256 * DFF <= WS_OAG && WS_WOUT + (size_t)D * D <= WS_PETOK, "ws map 3");
constexpr size_t DO_XB = 0;
constexpr size_t DO_OAB = 0;
constexpr size_t DO_WIN = 96 * MiB;
constexpr size_t DO_WCAT = 108 * MiB;
constexpr int CW_TMO = 0, CW_CODE = 1;
constexpr int CW_BAR = 4096;
constexpr int CW_SEAM = 16384;
constexpr int CW_ECNT = 32768;
static_assert((CW_ECNT + 2 * 64 * NEXP) * 4 <= (int)CTL_ZERO_BYTES, "CTL words inside the memset region");

constexpr int RING_BYTES = 131072;
constexpr int SCR_BYTES = 143360;
constexpr int LDSCTL_OFF = SCR_BYTES;
constexpr int MISC_OFF = LDSCTL_OFF + 320;
constexpr int MOE_OFF = LDSCTL_OFF + 512;
constexpr int LDS_BYTES = 147456;
static_assert(MOE_OFF + 128 + 136 + MAX_MT <= LDS_BYTES, "LDS map");

#define RLX_AGENT __ATOMIC_RELAXED, __HIP_MEMORY_SCOPE_AGENT
#define LDS_WAIT() asm volatile("s_waitcnt lgkmcnt(0)" ::: "memory")
#define VM_WAIT() asm volatile("s_waitcnt vmcnt(0)" ::: "memory")

__device__ __forceinline__ unsigned cvt_pk_bf16(float lo, float hi) { unsigned r; asm volatile("v_cvt_pk_bf16_f32 %0, %1, %2" : "=v"(r) : "v"(lo), "v"(hi)); return r; }
__device__ __forceinline__ int opaque(int v) { asm volatile("" : "+v"(v)); return v; }
__device__ __forceinline__ unsigned pk4_fp8(float a, float b, float c, float d) { int w = 0; w = __builtin_amdgcn_cvt_pk_fp8_f32(a, b, w, false); w = __builtin_amdgcn_cvt_pk_fp8_f32(c, d, w, true); return (unsigned)w; }
__device__ __forceinline__ unsigned f2e4m3_sw(float x) {
    const float a = __builtin_amdgcn_fmed3f(fabsf(x), 9.5367431640625e-07f, 448.f);
    const int e1 = max(__builtin_amdgcn_frexp_expf(a), -5);
    const unsigned m = (unsigned)__builtin_rintf(__builtin_amdgcn_ldexpf(a, 4 - e1));
    return ((__float_as_uint(x) >> 24) & 0x80u) | (unsigned)((e1 << 3) + 40 + (int)m); }
__device__ __forceinline__ unsigned pk4_fp8_pad(float a, float b, float c, float d) {
    unsigned w;
    asm("v_cvt_pk_fp8_f32 %0, %1, %2\n\ts_nop 1" : "=v"(w) : "v"(a), "v"(b));
    asm("v_cvt_pk_fp8_f32 %0, %1, %2 op_sel:[0,0,1]\n\ts_nop 1" : "+v"(w) : "v"(c), "v"(d));
    return w; }
__device__ __forceinline__ float clamp_fp8(float v) { return __builtin_amdgcn_fmed3f(v, -448.0f, 448.0f); }
__device__ __forceinline__ float bf_lo(unsigned w) { return __uint_as_float(w << 16); }
__device__ __forceinline__ float bf_hi(unsigned w) { return __uint_as_float(w & 0xffff0000u); }
__device__ __forceinline__ float fast_sigmoid(float g) { g = fminf(fmaxf(g, -60.f), 60.f); return __builtin_amdgcn_rcpf(1.0f + __builtin_amdgcn_exp2f(-g * LOG2E)); }

namespace pg8 {
constexpr int BM = 256, BK = 64, HALF = 128, HTB = HALF * BK * 2, STAGE_BYTES = 8 * HTB, NXCD = 8, WGM = 8;
constexpr int EPRE_OFF = STAGE_BYTES;
static_assert(EPRE_OFF + 3072 <= SCR_BYTES, "epilogue prefetch area");
__host__ __device__ __forceinline__ int lds_byte(int r, int c) { const int st = (r >> 4) * 2 + (c >> 5), rr = r & 15, cc = c & 31, ob = rr * 64 + cc * 2; return st * 1024 + (ob ^ (((ob >> 9) & 1) << 5)); }
__host__ __device__ __forceinline__ void stage_rc(int b, int& R, int& C) { const int st = b / 1024, sb = b % 1024, swz = sb ^ (((sb >> 9) & 1) << 5); R = (st >> 1) * 16 + swz / 64; C = (st & 1) * 32 + (swz % 64) / 2; }
__host__ __device__ __forceinline__ int perm32(int rho) { const int n = rho >> 4, i = rho & 15; return 8 * (i >> 2) + 4 * n + (i & 3); }

struct Unit { int pm, pn, e, ti, valid; };
struct Gemm { const char* A; const char* Bt; int lda, ldb, nt; };

__device__ __forceinline__ bool tile_of(long L, int nM, int nN, int& pm, int& pn) {
    const int nwg = nM * nN; if (L >= nwg) return false;
    int wgid = (int)L; { const int q = nwg / NXCD, r = nwg % NXCD, xcd = wgid % NXCD, off = wgid / NXCD; wgid = (xcd < r ? xcd * (q + 1) : r * (q + 1) + (xcd - r) * q) + off; }
    const int nig = WGM * nN, gid = wgid / nig, fm = gid * WGM, gsz = (nM - fm) < WGM ? (nM - fm) : WGM;
    pm = fm + ((wgid % nig) % gsz); pn = (wgid % nig) / gsz; return true;
}
struct StaticOrder {
    int nM, nN, G, c;
    __device__ __forceinline__ void init(int M, int N, int G_, int c_) { nM = M / BM; nN = N / BM; G = G_; c = c_; }
    __device__ __forceinline__ bool next(int i, Unit& u) const { u.e = 0; u.ti = 0; u.valid = 256; return tile_of((long)i * G + c, nM, nN, u.pm, u.pn); }
    __device__ __forceinline__ const char* a_ptr(const Gemm& g, const Unit& u) const { return g.A + (size_t)u.pm * 256 * g.lda; }
    __device__ __forceinline__ const char* b_ptr(const Gemm& g, const Unit& u) const { return g.Bt + (size_t)u.pn * 256 * g.ldb; }
    __device__ __forceinline__ unsigned row_off(const Unit&, int) const { return 0u; }
};
struct MoeOrder {
    int T, nN, G, c; const LAS int* cnt; const LAS int* fs; const LAS unsigned char* te;
    const int* petok; size_t b_exp_stride; bool gather; unsigned rowbytes;
    __device__ __forceinline__ bool next(int i, Unit& u) const {
        if (!tile_of((long)i * G + c, T, nN, u.pm, u.pn)) return false;
        u.e = __builtin_amdgcn_readfirstlane((int)te[u.pm]); u.ti = u.pm - __builtin_amdgcn_readfirstlane(fs[u.e]); const int left = __builtin_amdgcn_readfirstlane(cnt[u.e]) - u.ti * 256; u.valid = left < 256 ? left : 256; return true;
    }
    __device__ __forceinline__ const char* a_ptr(const Gemm& g, const Unit& u) const { return gather ? g.A : g.A + (size_t)u.pm * 256 * g.lda; }
    __device__ __forceinline__ const char* b_ptr(const Gemm& g, const Unit& u) const { return g.Bt + (size_t)u.e * b_exp_stride + (size_t)u.pn * 256 * g.ldb; }
    __device__ __forceinline__ unsigned row_off(const Unit& u, int R) const {
        int tok = 0; if (R < u.valid) tok = petok[(size_t)u.e * NTOK + u.ti * 256 + R] >> 2;
        return (unsigned)tok * rowbytes;
    }
};

typedef int v8i32 __attribute__((ext_vector_type(8)));
template <class Epi, class Sched, bool ALIGN_EPI, bool GATHER, bool F8 = false>
__device__ __forceinline__ void gemm_phase(LAS unsigned char* lds, const Gemm g, const Sched& S, const Epi& E) {
    const int tid = threadIdx.x, wid = __builtin_amdgcn_readfirstlane(tid >> 6), lane = tid & 63, wr = wid >> 2, wc = wid & 3, fr = lane & 15, fq = lane >> 4;
    const int nt = g.nt;
    unsigned voffA[2], voffB[2]; int RA[2], CA2[2];
#pragma unroll
    for (int i = 0; i < 2; ++i) { int R, C; stage_rc(tid * 16 + i * 8192, R, C); const int Rb = Epi::PERM ? ((R & ~31) + perm32(R & 31)) : R;
        voffA[i] = (unsigned)(R * g.lda + C * 2); voffB[i] = (unsigned)(Rb * g.ldb + C * 2); RA[i] = R; CA2[i] = C * 2; }
    const size_t kstep = (size_t)(BK * 2);
    const size_t hstepA = (size_t)HALF * g.lda, hstepB = (size_t)HALF * g.ldb;
    const unsigned ldsw = (unsigned)wid * 1024u;
    const int aoff = lds_byte(wr * 64 + fr, fq * 8), boff = lds_byte(wc * 32 + fr, fq * 8);
    const int aoff0 = aoff, boff0 = boff, aoff1 = aoff + 1024, boff1 = boff + 1024;
#define PG8_SA(b, h) (((b) * 2 + (h)) * HTB)
#define PG8_SB(b, h) ((4 + (b) * 2 + (h)) * HTB)
#define PG8_STAGE(bufoff, gbase, voff) do { _Pragma("unroll") for (int _i = 0; _i < 2; ++_i) \
        __builtin_amdgcn_global_load_lds((const unsigned*)((const char*)(gbase) + (voff)[_i]), (LAS unsigned*)(lds + (bufoff) + ldsw + _i * 8192), 16, 0, 0); } while (0)
#define PG8_STAGE_A(bufoff, kp, h, nx) do { if constexpr (GATHER) { unsigned _v[2]; _v[0] = (nx) ? gN[h][0] : gC[h][0]; _v[1] = (nx) ? gN[h][1] : gC[h][1]; PG8_STAGE(bufoff, kp, _v); } \
        else { PG8_STAGE(bufoff, (kp) + (h) * hstepA, voffA); } } while (0)
#define PG8_LDA(dst, b, h) do { _Pragma("unroll") for (int m = 0; m < 4; ++m) _Pragma("unroll") for (int k = 0; k < 2; ++k) dst[m][k] = *(const LAS bf16x8*)(lds + PG8_SA(b, h) + (k ? aoff1 : aoff0) + m * 2048); } while (0)
#define PG8_LDB(dst, b, h) do { _Pragma("unroll") for (int n = 0; n < 2; ++n) _Pragma("unroll") for (int k = 0; k < 2; ++k) dst[n][k] = *(const LAS bf16x8*)(lds + PG8_SB(b, h) + (k ? boff1 : boff0) + n * 2048); } while (0)
#define PG8_F8OP(X) __builtin_bit_cast(v8i32, __builtin_shufflevector(X[0], X[1], 0, 1, 2, 3, 4, 5, 6, 7, 8, 9, 10, 11, 12, 13, 14, 15))
#define PG8_MMA(ai, bj, At, Bt) do { __builtin_amdgcn_s_setprio(1); if constexpr (F8) { _Pragma("unroll") for (int m = 0; m < 4; ++m) _Pragma("unroll") for (int n = 0; n < 2; ++n) \
        asm volatile("v_mfma_scale_f32_16x16x128_f8f6f4 %0, %1, %2, %0, %3, %3 op_sel_hi:[0,0,0]" : "+v"(acc[ai][bj][m][n]) : "v"(PG8_F8OP(Bt[n])), "v"(PG8_F8OP(At[m])), "v"(one_scale)); } \
        else { _Pragma("unroll") for (int m = 0; m < 4; ++m) _Pragma("unroll") for (int n = 0; n < 2; ++n) _Pragma("unroll") for (int k = 0; k < 2; ++k) \
        acc[ai][bj][m][n] = __builtin_amdgcn_mfma_f32_16x16x32_bf16(Bt[n][k], At[m][k], acc[ai][bj][m][n], 0, 0, 0); } __builtin_amdgcn_s_setprio(0); } while (0)
#define PG8_WAIT_V(n) asm volatile("s_waitcnt vmcnt(" #n ")" ::: "memory")
#define PG8_WAIT_L(n) asm volatile("s_waitcnt lgkmcnt(" #n ")" ::: "memory")
#define PG8_BAR __builtin_amdgcn_s_barrier()
#define PG8_SCHED __builtin_amdgcn_sched_barrier(0)
    Unit cur, nxt; int ui = 0;
    if (!S.next(0, cur)) return;
    int one_scale = 0x7f7f7f7f; if constexpr (F8) asm volatile("" : "+v"(one_scale));
    unsigned gC[2][2], gN[2][2];
#pragma unroll
    for (int h = 0; h < 2; ++h)
#pragma unroll
        for (int i = 0; i < 2; ++i) { gC[h][i] = GATHER ? S.row_off(cur, h * HALF + RA[i]) + (unsigned)CA2[i] : 0u; gN[h][i] = gC[h][i]; }
    f32x4 acc[2][2][4][2];
#pragma unroll
    for (int a = 0; a < 2; ++a)
#pragma unroll
        for (int b = 0; b < 2; ++b)
#pragma unroll
            for (int m = 0; m < 4; ++m)
#pragma unroll
                for (int n = 0; n < 2; ++n) acc[a][b][m][n] = (f32x4){0.f, 0.f, 0.f, 0.f};
    bf16x8 At[4][2], B0[2][2], B1[2][2];
    const char* cA = S.a_ptr(g, cur); const char* cB = S.b_ptr(g, cur);
    PG8_STAGE(PG8_SB(0, 0), cB, voffB); PG8_STAGE(PG8_SB(0, 1), cB + hstepB, voffB); PG8_STAGE_A(PG8_SA(0, 0), cA, 0, false); PG8_STAGE_A(PG8_SA(0, 1), cA, 1, false);
    if (wr == 1) PG8_BAR;
    PG8_WAIT_V(2); PG8_BAR;
    PG8_STAGE(PG8_SB(1, 0), cB + kstep, voffB); PG8_STAGE_A(PG8_SA(1, 0), cA + kstep, 0, false); PG8_STAGE(PG8_SB(1, 1), cB + hstepB + kstep, voffB);
    PG8_WAIT_V(6); PG8_BAR;
    for (;;) {
        const bool has_next = S.next(ui + 1, nxt);
        const char* nA = has_next ? S.a_ptr(g, nxt) : cA; const char* nB = has_next ? S.b_ptr(g, nxt) : cB;
        if constexpr (GATHER) { if (has_next) {
#pragma unroll
            for (int h = 0; h < 2; ++h)
#pragma unroll
                for (int i = 0; i < 2; ++i) gN[h][i] = S.row_off(nxt, h * HALF + RA[i]) + (unsigned)CA2[i]; } }
#pragma unroll 1
        for (int t = 0; t < nt; t += 2) {
            const bool last = (t == nt - 2);
            asm volatile("" : "+v"(voffA[0]), "+v"(voffA[1]), "+v"(voffB[0]), "+v"(voffB[1]));
            if constexpr (Epi::HAS_MID) { if (t == Epi::MID_T) E.mid(acc, cur, wr, wc, fr, fq); }
            if constexpr (Epi::HAS_PRE) { if (last) E.pre(lds, cur, wid, lane); }
            const char* a1 = cA + (size_t)(t + 1) * kstep;
            const char* a2 = last ? nA : cA + (size_t)(t + 2) * kstep; const char* b2 = last ? nB : cB + (size_t)(t + 2) * kstep;
            const char* a3 = a2 + kstep; const char* b3 = b2 + kstep;
            PG8_LDB(B0, 0, 0); PG8_LDB(B1, 0, 1); PG8_SCHED; PG8_LDA(At, 0, 0); PG8_STAGE_A(PG8_SA(1, 1), a1, 1, false);
            PG8_WAIT_V(8); PG8_WAIT_L(0); PG8_BAR; PG8_MMA(0, 0, At, B0); PG8_MMA(0, 1, At, B1); PG8_BAR; PG8_SCHED;
            PG8_LDA(At, 0, 1); PG8_STAGE(PG8_SB(0, 0), b2, voffB); PG8_STAGE(PG8_SB(0, 1), b2 + hstepB, voffB); PG8_STAGE_A(PG8_SA(0, 0), a2, 0, last);
            PG8_WAIT_V(8); PG8_WAIT_L(0); PG8_BAR; PG8_MMA(1, 0, At, B0); PG8_MMA(1, 1, At, B1); PG8_BAR; PG8_SCHED;
            PG8_LDB(B0, 1, 0); PG8_LDB(B1, 1, 1); PG8_SCHED; PG8_LDA(At, 1, 0); PG8_STAGE_A(PG8_SA(0, 1), a2, 1, last);
            PG8_WAIT_V(8); PG8_WAIT_L(0); PG8_BAR; PG8_MMA(0, 0, At, B0); PG8_MMA(0, 1, At, B1); PG8_BAR; PG8_SCHED;
            PG8_LDA(At, 1, 1); PG8_STAGE(PG8_SB(1, 0), b3, voffB); PG8_STAGE(PG8_SB(1, 1), b3 + hstepB, voffB); PG8_STAGE_A(PG8_SA(1, 0), a3, 0, last);
            PG8_WAIT_V(8); PG8_WAIT_L(0); PG8_BAR; PG8_MMA(1, 0, At, B0); PG8_MMA(1, 1, At, B1); PG8_BAR; PG8_SCHED;
        }
        if constexpr (ALIGN_EPI) { if (wr == 0) PG8_BAR; }
        if constexpr (F8) asm volatile("s_nop 15\n\ts_nop 15" ::: "memory");
        if constexpr (!Epi::AFTER_DRAIN) { E(acc, cur, wr, wc, fr, fq); }
        if (!has_next) break;
#pragma unroll
        for (int a = 0; a < 2; ++a)
#pragma unroll
            for (int b = 0; b < 2; ++b)
#pragma unroll
                for (int m = 0; m < 4; ++m)
#pragma unroll
                    for (int n = 0; n < 2; ++n) acc[a][b][m][n] = (f32x4){0.f, 0.f, 0.f, 0.f};
        cur = nxt; cA = nA; cB = nB; ++ui;
#pragma unroll
        for (int h = 0; h < 2; ++h)
#pragma unroll
            for (int i = 0; i < 2; ++i) gC[h][i] = gN[h][i];
        if constexpr (ALIGN_EPI) { if (wr == 1) PG8_BAR; }
    }
    PG8_WAIT_V(0);
    if constexpr (!ALIGN_EPI) { if (wr == 0) PG8_BAR; }
    PG8_BAR;
    if constexpr (Epi::AFTER_DRAIN) { E.fused(acc, cur, wr, wc, fr, fq, lds, wid, lane); }
#undef PG8_SA
#undef PG8_SB
#undef PG8_STAGE
#undef PG8_STAGE_A
#undef PG8_LDA
#undef PG8_LDB
#undef PG8_MMA
#undef PG8_F8OP
#undef PG8_WAIT_V
#undef PG8_WAIT_L
#undef PG8_BAR
#undef PG8_SCHED
}
}

namespace pg8 {
__device__ __forceinline__ u32x4 pair16(u32x2 x, u32x2 y) {
    const auto sx = __builtin_amdgcn_permlane16_swap(x.x, y.x, false, false), sy = __builtin_amdgcn_permlane16_swap(x.y, y.y, false, false);
    u32x4 o; o.x = sx[0]; o.y = sy[0]; o.z = sx[1]; o.w = sy[1]; return o; }
__device__ __forceinline__ void unpair16(u32x4 v, u32x2& x, u32x2& y) {
    const auto sx = __builtin_amdgcn_permlane16_swap(v.x, v.z, false, false), sy = __builtin_amdgcn_permlane16_swap(v.y, v.w, false, false);
    x.x = sx[0]; x.y = sy[0]; y.x = sx[1]; y.y = sy[1]; }
struct EpiInProj {
    static constexpr bool PERM = true, AFTER_DRAIN = false, HAS_MID = false, HAS_PRE = false; static constexpr int MID_T = 0;
    unsigned char* HQ; unsigned char* SG; float rs;
    __device__ __forceinline__ void mid(f32x4 (&)[2][2][4][2], const Unit&, int, int, int, int) const {}
    __device__ __forceinline__ void operator()(const f32x4 (&acc)[2][2][4][2], const Unit& u, int wr, int wc, int fr, int fq) const {
        const int pn = u.pn, b = (u.pm * BM) >> 12, t0 = (u.pm * BM) & (SEQ - 1), lr = wr * 64 + opaque(fr), fqo = fq & 1;
        const int dcol = (wc & 1) * 32 + 8 * fq;
        if (pn >= 14) {
            const float nrl = -rs * LOG2E;
            unsigned char* ub = SG + (size_t)(u.pm * BM) * SG_P + (pn - 14) * 256;
            const unsigned vo = (unsigned)(lr * SG_P + wc * 32 + 8 * fq + (fqo ? HALF - 8 : 0));
#pragma unroll
            for (int ai = 0; ai < 2; ++ai)
#pragma unroll
                for (int m = 0; m < 4; ++m) { u32x2 w8[2];
#pragma unroll
                    for (int bj = 0; bj < 2; ++bj) { f32x4 v0 = acc[ai][bj][m][0], v1 = acc[ai][bj][m][1];
#pragma unroll
                        for (int q = 0; q < 4; ++q) {
                            v0[q] = fmaxf(__builtin_amdgcn_rcpf(__builtin_fmaf(__builtin_amdgcn_exp2f(v0[q] * nrl), 1.0f / SSG, 1.0f / SSG)), 0.001953125f);
                            v1[q] = fmaxf(__builtin_amdgcn_rcpf(__builtin_fmaf(__builtin_amdgcn_exp2f(v1[q] * nrl), 1.0f / SSG, 1.0f / SSG)), 0.001953125f); }
                        w8[bj].x = pk4_fp8(v0[0], v0[1], v0[2], v0[3]); w8[bj].y = pk4_fp8(v1[0], v1[1], v1[2], v1[3]); }
                    *(u32x4*)(ub + (vo + (unsigned)((ai * HALF + m * 16) * SG_P))) = pair16(w8[0], w8[1]); }
        } else if (pn < 6 || (pn >= 9 && pn < 13)) {
            const bool dilated = pn < 9; const int ty = dilated ? pn / 3 : 0, g = dilated ? pn - 3 * ty : 0, sh = 2 * g;
            const float qk = rs * ((pn >= 3 && pn < 6) ? SK : QSCALE * SQ);
            unsigned char* ub = dilated ? HQ + (size_t)ty * (48 * MiB) + (size_t)((g * NB + b) * 4) * SEQ * 64 : HQ + HQ_QS + (size_t)(b * 16 + (pn - 9) * 4) * SEQ * 64;
            const int hl = (wc >> 1) + 2 * fqo;
            const unsigned vo = (unsigned)(hl * SEQ * 64 + dcol - 8 * fqo); const int tl = t0 + lr, msk = (1 << sh) - 1;
#pragma unroll
            for (int ai = 0; ai < 2; ++ai)
#pragma unroll
                for (int m = 0; m < 4; ++m) { u32x2 w8[2];
#pragma unroll
                    for (int bj = 0; bj < 2; ++bj) { const f32x4 v0 = acc[ai][bj][m][0] * qk, v1 = acc[ai][bj][m][1] * qk;
                        w8[bj].x = pk4_fp8(clamp_fp8(v0[0]), clamp_fp8(v0[1]), clamp_fp8(v0[2]), clamp_fp8(v0[3])); w8[bj].y = pk4_fp8(clamp_fp8(v1[0]), clamp_fp8(v1[1]), clamp_fp8(v1[2]), clamp_fp8(v1[3])); }
                    const int t = tl + ai * HALF + m * 16, pos = ((t & msk) << (12 - sh)) + (t >> sh);
                    *(u32x4*)(ub + (vo + (unsigned)(pos * 64))) = pair16(w8[0], w8[1]); }
        } else if (pn < 9) {
            const int g = pn - 6, sh = 2 * g, tl = t0 + lr, msk = (1 << sh) - 1;
            unsigned char* ub = HQ + (size_t)2 * (48 * MiB) + (size_t)((g * NB + b) * 4) * SEQ * 128;
#pragma unroll
            for (int ai = 0; ai < 2; ++ai)
#pragma unroll
                for (int m = 0; m < 4; ++m) { const int t = tl + ai * HALF + m * 16, pos = ((t & msk) << (12 - sh)) + (t >> sh);
#pragma unroll
                    for (int bj = 0; bj < 2; ++bj) { const f32x4 v0 = acc[ai][bj][m][0] * rs, v1 = acc[ai][bj][m][1] * rs; const int hl = bj * 2 + (wc >> 1);
                        u32x4 w; w.x = cvt_pk_bf16(v0[0], v0[1]); w.y = cvt_pk_bf16(v0[2], v0[3]); w.z = cvt_pk_bf16(v1[0], v1[1]); w.w = cvt_pk_bf16(v1[2], v1[3]);
                        *(u32x4*)(ub + (unsigned)((hl * SEQ + pos) * 128 + dcol * 2)) = w; } }
        } else {
            unsigned char* ubk = HQ + HQ_KS + (size_t)(b * 2) * SEQ * 64; unsigned char* ubv = HQ + HQ_VS + (size_t)(b * 2) * SEQ * 128;
            const int tl = t0 + lr; const float qk = rs * SK;
#pragma unroll
            for (int ai = 0; ai < 2; ++ai)
#pragma unroll
                for (int m = 0; m < 4; ++m) { const int ri = (wc >> 1) * SEQ + tl + ai * HALF + m * 16;
                    { const f32x4 v0 = acc[ai][0][m][0] * qk, v1 = acc[ai][0][m][1] * qk; u32x2 w8;
                      w8.x = pk4_fp8(clamp_fp8(v0[0]), clamp_fp8(v0[1]), clamp_fp8(v0[2]), clamp_fp8(v0[3])); w8.y = pk4_fp8(clamp_fp8(v1[0]), clamp_fp8(v1[1]), clamp_fp8(v1[2]), clamp_fp8(v1[3]));
                      *(u32x2*)(ubk + (unsigned)(ri * 64 + dcol)) = w8; }
                    { const f32x4 v0 = acc[ai][1][m][0] * rs, v1 = acc[ai][1][m][1] * rs;
                      u32x4 w; w.x = cvt_pk_bf16(v0[0], v0[1]); w.y = cvt_pk_bf16(v0[2], v0[3]); w.z = cvt_pk_bf16(v1[0], v1[1]); w.w = cvt_pk_bf16(v1[2], v1[3]);
                      *(u32x4*)(ubv + (unsigned)(ri * 128 + dcol * 2)) = w; } }
        }
    }
};
struct EpiGate {
    static constexpr bool PERM = true, AFTER_DRAIN = false, HAS_MID = true, HAS_PRE = false; static constexpr int MID_T = 2;
    const unsigned char* __restrict__ SG; unsigned char* __restrict__ O;
    __device__ __forceinline__ void mid(f32x4 (&acc)[2][2][4][2], const Unit& u, int wr, int wc, int fr, int fq) const {
        const int row0 = u.pm * BM + wr * 64 + opaque(fr), col0 = u.pn * BM + wc * 32 + 8 * opaque(fq);
        const int cswz = ((col0 >> 3) & 1) ? (HALF - 8) : 0;
#pragma unroll
        for (int ai = 0; ai < 2; ++ai) {
            u32x2 a[4][2], b[4][2];
#pragma unroll
            for (int mm = 0; mm < 4; ++mm) { const unsigned char* sp = SG + (size_t)(row0 + ai * HALF + mm * 16) * SG_P + col0 + cswz;
                const u32x4 la = *(const u32x4*)sp, lb = *(const u32x4*)(sp + 1024); unpair16(la, a[mm][0], a[mm][1]); unpair16(lb, b[mm][0], b[mm][1]); }
#pragma unroll
            for (int m = 0; m < 4; ++m) {
#pragma unroll
                for (int bj = 0; bj < 2; ++bj) {
#pragma unroll
                    for (int n = 0; n < 2; ++n) { const int aw = (int)a[m][bj][n], bw = (int)b[m][bj][n];
                        const f32x2 al = __builtin_amdgcn_cvt_pk_f32_fp8(aw, false), ah = __builtin_amdgcn_cvt_pk_f32_fp8(aw, true), bl = __builtin_amdgcn_cvt_pk_f32_fp8(bw, false), bh = __builtin_amdgcn_cvt_pk_f32_fp8(bw, true);
                        f32x4 r; r[0] = al[0] * __builtin_amdgcn_rcpf(bl[0]); r[1] = al[1] * __builtin_amdgcn_rcpf(bl[1]); r[2] = ah[0] * __builtin_amdgcn_rcpf(bh[0]); r[3] = ah[1] * __builtin_amdgcn_rcpf(bh[1]);
                        acc[ai][bj][m][n] = acc[ai][bj][m][n] * r; } }
                asm volatile("" : "+v"(acc[ai][0][m][0]), "+v"(acc[ai][0][m][1]), "+v"(acc[ai][1][m][0]), "+v"(acc[ai][1][m][1])); }
            asm volatile("" ::: "memory"); }
    }
    __device__ __forceinline__ void operator()(const f32x4 (&acc)[2][2][4][2], const Unit& u, int wr, int wc, int fr, int fq) const {
        const int row0 = u.pm * BM + wr * 64 + opaque(fr), col0 = u.pn * BM + wc * 32 + 8 * opaque(fq);
        constexpr float FS = SM / (SO * SW * SSG);
        const int cswz = ((col0 >> 3) & 1) ? (HALF - 8) : 0;
#pragma unroll
        for (int ai = 0; ai < 2; ++ai) {
            u32x2 bq[4][2];
#pragma unroll
            for (int m = 0; m < 4; ++m) { const u32x4 lb = *(const u32x4*)(SG + (size_t)(row0 + ai * HALF + m * 16) * SG_P + 1024 + col0 + cswz); unpair16(lb, bq[m][0], bq[m][1]); }
#pragma unroll
            for (int m = 0; m < 4; ++m) { unsigned char* op = O + (size_t)(row0 + ai * HALF + m * 16) * D + col0 + cswz;
                u32x2 w[2];
#pragma unroll
                for (int bj = 0; bj < 2; ++bj) {
#pragma unroll
                    for (int n = 0; n < 2; ++n) { const int bw = (int)bq[m][bj][n]; const f32x2 bl = __builtin_amdgcn_cvt_pk_f32_fp8(bw, false), bh = __builtin_amdgcn_cvt_pk_f32_fp8(bw, true); const f32x4 v = acc[ai][bj][m][n] * FS;
                        w[bj][n] = pk4_fp8(clamp_fp8(v[0] * bl[0]), clamp_fp8(v[1] * bl[1]), clamp_fp8(v[2] * bh[0]), clamp_fp8(v[3] * bh[1])); } }
                *(u32x4*)op = pair16(w[0], w[1]); }
            asm volatile("" ::: "memory"); }
    }
};

struct PanelStats {
    unsigned* xbuf;
    unsigned* cnt;
    unsigned* tmo;
    int pm_off; float eps; unsigned code;
    __device__ __forceinline__ bool run(const f32x4 (&v)[2][2][4][2], const Unit& u, int wr, int wc, int fr, int fq, LAS unsigned char* lds, int wid, int lane) const {
        LAS f32x2* P = (LAS f32x2*)lds;
        LAS f32x2* S = (LAS f32x2*)(lds + 8192);
        LAS unsigned* flag = (LAS unsigned*)(lds + 8192 + 2048);
        const int panel = u.pm + pm_off;
#pragma unroll
        for (int ai = 0; ai < 2; ++ai)
#pragma unroll
            for (int m = 0; m < 4; ++m) {
                float s = 0.f;
#pragma unroll
                for (int bj = 0; bj < 2; ++bj)
#pragma unroll
                    for (int n = 0; n < 2; ++n) { const f32x4 x = v[ai][bj][m][n]; s += (x[0] + x[1]) + (x[2] + x[3]); }
                s += __shfl_xor(s, 16); s += __shfl_xor(s, 32);
                const float mw = s * (1.0f / 64.0f); float q = 0.f;
#pragma unroll
                for (int bj = 0; bj < 2; ++bj)
#pragma unroll
                    for (int n = 0; n < 2; ++n) { const f32x4 d = v[ai][bj][m][n] - mw; q += (d[0] * d[0] + d[1] * d[1]) + (d[2] * d[2] + d[3] * d[3]); }
                q += __shfl_xor(q, 16); q += __shfl_xor(q, 32);
                if (fq == 0) P[(ai * HALF + wr * 64 + m * 16 + fr) * 4 + wc] = (f32x2){mw, q};
            }
        asm volatile("s_waitcnt lgkmcnt(0)" ::: "memory"); __builtin_amdgcn_s_barrier(); asm volatile("" ::: "memory");
        const int row = wid * 32 + (lane & 31);
        if (lane < 32) {
            const f32x2 a = P[row * 4 + 0], b = P[row * 4 + 1], c = P[row * 4 + 2], d = P[row * 4 + 3];
            const float mt = (a.x + b.x + c.x + d.x) * 0.25f;
            const float da = a.x - mt, db = b.x - mt, dc = c.x - mt, dd = d.x - mt;
            const float m2 = (a.y + b.y) + (c.y + d.y) + 64.0f * ((da * da + db * db) + (dc * dc + dd * dd));
            unsigned long long* slot = (unsigned long long*)xbuf + ((size_t)(panel * BM + row) * 4 + u.pn);
            __hip_atomic_store(slot, ((unsigned long long)__float_as_uint(m2) << 32) | __float_as_uint(mt), __ATOMIC_RELAXED, __HIP_MEMORY_SCOPE_AGENT);
        }
        asm volatile("s_waitcnt vmcnt(0)" ::: "memory");
        if (lane == 0) __hip_atomic_fetch_add(cnt + 64 * panel, 1u, __ATOMIC_RELAXED, __HIP_MEMORY_SCOPE_AGENT);
        if (wid == 0) {
            bool dead = false; const unsigned long long t0 = __builtin_amdgcn_s_memrealtime(); const unsigned want = 8u * 4u;
            for (;;) {
                if ((unsigned)__builtin_amdgcn_readfirstlane(__hip_atomic_load(cnt + 64 * panel, __ATOMIC_RELAXED, __HIP_MEMORY_SCOPE_AGENT)) >= want) break;
                if (__builtin_amdgcn_s_memrealtime() - t0 > 2000000ull) {
                    if (lane == 0) { unsigned expect = 0u; __hip_atomic_compare_exchange_strong(tmo + 1, &expect, code | (unsigned)(panel & 0xff), __ATOMIC_RELAXED, __ATOMIC_RELAXED, __HIP_MEMORY_SCOPE_AGENT);
                                     __hip_atomic_store(tmo, 1u, __ATOMIC_RELAXED, __HIP_MEMORY_SCOPE_AGENT); }
                    dead = true; break; }
                __builtin_amdgcn_s_sleep(2);
            }
            __builtin_amdgcn_fence(__ATOMIC_ACQUIRE, "agent");
            if (lane == 0) flag[0] = dead ? 1u : 0u;
        }
        asm volatile("s_waitcnt vmcnt(0) lgkmcnt(0)" ::: "memory"); __builtin_amdgcn_s_barrier(); asm volatile("" ::: "memory");
        const bool bad = flag[0] != 0u;
        if (lane < 32) {
            const unsigned long long* slot = (const unsigned long long*)xbuf + (size_t)(panel * BM + row) * 4; float mt[4], m2[4]; float ms = 0.f;
#pragma unroll
            for (int t = 0; t < 4; ++t) { const unsigned long long w = __hip_atomic_load(slot + t, __ATOMIC_RELAXED, __HIP_MEMORY_SCOPE_AGENT); mt[t] = __uint_as_float((unsigned)w); m2[t] = __uint_as_float((unsigned)(w >> 32)); ms += mt[t]; }
            const float mean = ms * 0.25f; float q = 0.f;
#pragma unroll
            for (int t = 0; t < 4; ++t) { const float dm = mt[t] - mean; q += m2[t] + 256.0f * dm * dm; }
            S[row] = (f32x2){mean, 1.0f / sqrtf(q * (1.0f / 1024.0f) + eps)};
        }
        asm volatile("s_waitcnt lgkmcnt(0)" ::: "memory"); __builtin_amdgcn_s_barrier(); asm volatile("" ::: "memory");
        return bad;
    }
};
struct EpiLn1 {
    static constexpr bool PERM = true, AFTER_DRAIN = true, HAS_MID = false, HAS_PRE = false; static constexpr int MID_T = 0;
    const float* x; float* out; bf16_t* xb; unsigned char* xq; const float* gam; const float* bet; PanelStats st; int row_off; unsigned poison; float rs;
    __device__ __forceinline__ void mid(f32x4 (&)[2][2][4][2], const Unit&, int, int, int, int) const {}
    __device__ __forceinline__ void operator()(const f32x4 (&)[2][2][4][2], const Unit&, int, int, int, int) const {}
    __device__ __forceinline__ void fused(f32x4 (&acc)[2][2][4][2], const Unit& u, int wr, int wc, int fr, int fq, LAS unsigned char* lds, int wid, int lane) const {
        const LAS f32x2* S = (const LAS f32x2*)(lds + 8192);
        const int col0 = u.pn * BM + wc * 32 + 8 * opaque(fq);
        const int grow0 = row_off + u.pm * BM; fr = opaque(fr);
#pragma unroll
        for (int ai = 0; ai < 2; ++ai)
#pragma unroll
            for (int m = 0; m < 4; ++m) { const size_t off = (size_t)(grow0 + ai * HALF + wr * 64 + m * 16 + fr) * D + col0;
#pragma unroll
                for (int bj = 0; bj < 2; ++bj)
#pragma unroll
                    for (int n = 0; n < 2; ++n) { const f32x4 bs = *(const f32x4*)(x + off + bj * HALF + n * 4); acc[ai][bj][m][n] = acc[ai][bj][m][n] * rs + bs * DN_ALPHA; }
                asm volatile("" : "+v"(acc[ai][0][m][0]), "+v"(acc[ai][0][m][1]), "+v"(acc[ai][1][m][0]), "+v"(acc[ai][1][m][1]));
                if (m == 3) asm volatile("" ::: "memory"); }
        const bool bad = st.run(acc, u, wr, wc, fr, fq, lds, wid, lane) || poison != 0u;
        const float qnan = __builtin_nanf("");
        f32x4 gv[2][2], bv[2][2];
#pragma unroll
        for (int bj = 0; bj < 2; ++bj)
#pragma unroll
            for (int n = 0; n < 2; ++n) { gv[bj][n] = *(const f32x4*)(gam + col0 + bj * HALF + n * 4); bv[bj][n] = *(const f32x4*)(bet + col0 + bj * HALF + n * 4); }
#pragma unroll
        for (int ai = 0; ai < 2; ++ai)
#pragma unroll
            for (int m = 0; m < 4; ++m) { const int r = ai * HALF + wr * 64 + m * 16 + fr; const f32x2 sr = S[r]; const size_t off = (size_t)(grow0 + r) * D + col0;
#pragma unroll
                for (int bj = 0; bj < 2; ++bj) { f32x4 o0 = (acc[ai][bj][m][0] - sr.x) * sr.y * gv[bj][0] + bv[bj][0], o1 = (acc[ai][bj][m][1] - sr.x) * sr.y * gv[bj][1] + bv[bj][1];
                    if (bad) { o0 = (f32x4){qnan, qnan, qnan, qnan}; o1 = o0; }
                    u32x4 w; w.x = cvt_pk_bf16(o0[0], o0[1]); w.y = cvt_pk_bf16(o0[2], o0[3]); w.z = cvt_pk_bf16(o1[0], o1[1]); w.w = cvt_pk_bf16(o1[2], o1[3]); *(u32x4*)(xb + off + bj * HALF) = w;
                    u32x2 q8; q8.x = pk4_fp8(clamp_fp8(o0[0] * SX), clamp_fp8(o0[1] * SX), clamp_fp8(o0[2] * SX), clamp_fp8(o0[3] * SX)); q8.y = pk4_fp8(clamp_fp8(o1[0] * SX), clamp_fp8(o1[1] * SX), clamp_fp8(o1[2] * SX), clamp_fp8(o1[3] * SX));
                    *(u32x2*)(xq + off + bj * HALF) = q8; } }
    }
};
struct EpiY {
    static constexpr bool PERM = false, AFTER_DRAIN = false, HAS_MID = false, HAS_PRE = false; static constexpr int MID_T = 0;
    const float* __restrict__ x; bf16_t* __restrict__ Y; float* __restrict__ ST; float rs;
    __device__ __forceinline__ void mid(f32x4 (&)[2][2][4][2], const Unit&, int, int, int, int) const {}
    __device__ __forceinline__ void operator()(const f32x4 (&acc)[2][2][4][2], const Unit& u, int wr, int wc, int fr, int fq) const {
        const int row0 = u.pm * BM + wr * 64 + opaque(fr), col0 = u.pn * BM + wc * 32 + 4 * opaque(fq);
        const int scol = col0 + ((fq & 1) ? 12 : 0);
#pragma unroll
        for (int ai = 0; ai < 2; ++ai) {
            f32x4 xv[4][2][2];
#pragma unroll
            for (int m = 0; m < 4; ++m)
#pragma unroll
                for (int bj = 0; bj < 2; ++bj)
#pragma unroll
                    for (int n = 0; n < 2; ++n) xv[m][bj][n] = *(const f32x4*)(x + (size_t)(row0 + ai * HALF + m * 16) * D + col0 + bj * HALF + n * 16);
#pragma unroll
            for (int m = 0; m < 4; ++m) { const size_t r = (size_t)(row0 + ai * HALF + m * 16); float s1 = 0.f, s2 = 0.f;
#pragma unroll
                for (int bj = 0; bj < 2; ++bj) { const f32x4 y0 = acc[ai][bj][m][0] * rs + xv[m][bj][0] * DN_ALPHA, y1 = acc[ai][bj][m][1] * rs + xv[m][bj][1] * DN_ALPHA;
                    s1 += (y0[0] + y0[1]) + (y0[2] + y0[3]) + (y1[0] + y1[1]) + (y1[2] + y1[3]);
                    s2 += (y0[0] * y0[0] + y0[1] * y0[1]) + (y0[2] * y0[2] + y0[3] * y0[3]) + (y1[0] * y1[0] + y1[1] * y1[1]) + (y1[2] * y1[2] + y1[3] * y1[3]);
                    u32x2 w0, w1; w0.x = cvt_pk_bf16(y0[0], y0[1]); w0.y = cvt_pk_bf16(y0[2], y0[3]); w1.x = cvt_pk_bf16(y1[0], y1[1]); w1.y = cvt_pk_bf16(y1[2], y1[3]);
                    *(u32x4*)(Y + r * D + scol + bj * HALF) = pair16(w0, w1); }
                s1 += __shfl_xor(s1, 16); s1 += __shfl_xor(s1, 32); s2 += __shfl_xor(s2, 16); s2 += __shfl_xor(s2, 32);
                if (fq == 0) *(f32x2*)(ST + (r * 16 + u.pn * 4 + wc) * 2) = (f32x2){s1, s2}; }
            asm volatile("" ::: "memory"); }
    }
};
struct EpiGU {
    static constexpr bool PERM = true, AFTER_DRAIN = false, HAS_MID = false, HAS_PRE = true; static constexpr int MID_T = 0;
    const float* bg; const float* bu; unsigned char* H; LAS unsigned char* plds;
    __device__ __forceinline__ void mid(f32x4 (&)[2][2][4][2], const Unit&, int, int, int, int) const {}
    __device__ __forceinline__ void pre(LAS unsigned char* lds, const Unit& u, int wid, int lane) const {
        if (wid == 0) __builtin_amdgcn_global_load_lds((const unsigned*)((lane < 32 ? bg : bu) + u.e * DFF + u.pn * HALF + (lane & 31) * 4), (LAS unsigned*)(lds + EPRE_OFF), 16, 0, 0);
    }
    __device__ __forceinline__ void operator()(const f32x4 (&acc)[2][2][4][2], const Unit& u, int wr, int wc, int fr, int fq) const {
        const int row0 = u.pm * BM + wr * 64 + opaque(fr), jl = wc * 32 + 8 * opaque(fq), j0 = u.pn * HALF + jl;
        const LAS float* pb = (const LAS float*)(plds + EPRE_OFF) + jl;
        const f32x4 g0 = *(const LAS f32x4*)pb, g1 = *(const LAS f32x4*)(pb + 4), u0 = *(const LAS f32x4*)(pb + HALF), u1 = *(const LAS f32x4*)(pb + HALF + 4);
        f32x4 us0 = (u0 + 1.0f) * SH, us1 = (u1 + 1.0f) * SH;
        asm volatile("" : "+v"(us0), "+v"(us1));
        const int fqo = (jl >> 3) & 1;
#pragma unroll
        for (int ai = 0; ai < 2; ++ai)
#pragma unroll
            for (int m2 = 0; m2 < 4; m2 += 2) { u32x2 w[2];
#pragma unroll
              for (int mo = 0; mo < 2; ++mo) { const int m = m2 + mo;
                constexpr float RS = 1.0f / (SX * SW), CS = -1.702f * LOG2E;
                f32x4 h0, h1;
#pragma unroll
                for (int q = 0; q < 4; ++q) {
                    const float a = fminf(__builtin_fmaf(acc[ai][0][m][0][q], RS, g0[q]), 7.0f), b = fminf(__builtin_fmaf(acc[ai][0][m][1][q], RS, g1[q]), 7.0f);
                    const float ua = __builtin_amdgcn_fmed3f(__builtin_fmaf(acc[ai][1][m][0][q], RS * SH, us0[q]), -6.0f * SH, 8.0f * SH), ub = __builtin_amdgcn_fmed3f(__builtin_fmaf(acc[ai][1][m][1][q], RS * SH, us1[q]), -6.0f * SH, 8.0f * SH);
                    h0[q] = (a * __builtin_amdgcn_rcpf(1.0f + __builtin_amdgcn_exp2f(CS * a))) * ua;
                    h1[q] = (b * __builtin_amdgcn_rcpf(1.0f + __builtin_amdgcn_exp2f(CS * b))) * ub; }
                w[mo].x = pk4_fp8(h0[0], h0[1], h0[2], h0[3]); w[mo].y = pk4_fp8(h1[0], h1[1], h1[2], h1[3]); }
              *(u32x4*)(H + (size_t)(row0 + ai * HALF + (m2 + fqo) * 16) * DFF + j0 - 8 * fqo) = pair16(w[0], w[1]); }
    }
};
struct EpiDown {
    static constexpr bool PERM = true, AFTER_DRAIN = false, HAS_MID = false, HAS_PRE = true; static constexpr int MID_T = 0;
    const float* bd; const int* petok; const float* pegate; unsigned char* Y; LAS unsigned char* plds;
    __device__ __forceinline__ void mid(f32x4 (&)[2][2][4][2], const Unit&, int, int, int, int) const {}
    __device__ __forceinline__ void pre(LAS unsigned char* lds, const Unit& u, int wid, int lane) const {
        const size_t eb = (size_t)u.e * NTOK + (size_t)u.ti * 256 + (size_t)(lane * 4);
        if (wid == 0) __builtin_amdgcn_global_load_lds((const unsigned*)(bd + u.e * D + u.pn * BM + lane * 4), (LAS unsigned*)(lds + EPRE_OFF), 16, 0, 0);
        else if (wid == 1) __builtin_amdgcn_global_load_lds((const unsigned*)(petok + eb), (LAS unsigned*)(lds + EPRE_OFF + 1024), 16, 0, 0);
        else if (wid == 2) __builtin_amdgcn_global_load_lds((const unsigned*)(pegate + eb), (LAS unsigned*)(lds + EPRE_OFF + 2048), 16, 0, 0);
    }
    __device__ __forceinline__ void operator()(const f32x4 (&acc)[2][2][4][2], const Unit& u, int wr, int wc, int fr, int fq) const {
        const int r0 = wr * 64 + opaque(fr), cl = wc * 32 + 8 * opaque(fq), col0 = u.pn * BM + cl;
        const LAS float* pb = (const LAS float*)(plds + EPRE_OFF) + cl;
        f32x4 b[2][2];
#pragma unroll
        for (int bj = 0; bj < 2; ++bj) { b[bj][0] = *(const LAS f32x4*)(pb + bj * HALF); b[bj][1] = *(const LAS f32x4*)(pb + bj * HALF + 4); }
        int info[2][4]; float gwv[2][4];
#pragma unroll
        for (int ai = 0; ai < 2; ++ai)
#pragma unroll
            for (int m = 0; m < 4; ++m) { const int r = r0 + ai * HALF + m * 16; info[ai][m] = *(const LAS int*)(plds + EPRE_OFF + 1024 + 4 * r); gwv[ai][m] = *(const LAS float*)(plds + EPRE_OFF + 2048 + 4 * r) * SY; }
        if (u.valid == 256) {
            const int fqo = (col0 >> 3) & 1;
            const int cswz = fqo ? (HALF - 8) : 0;
#pragma unroll
        for (int ai = 0; ai < 2; ++ai)
#pragma unroll
            for (int m = 0; m < 4; ++m) {
                const float gw = gwv[ai][m];
                unsigned char* op = Y + (size_t)info[ai][m] * 1024 + col0 + cswz;
                u32x2 w[2];
#pragma unroll
                for (int bj = 0; bj < 2; ++bj) { constexpr float RS = 1.0f / (SH * SW); const f32x4 v0 = (acc[ai][bj][m][0] * RS + b[bj][0]) * gw, v1 = (acc[ai][bj][m][1] * RS + b[bj][1]) * gw;
                    w[bj].x = pk4_fp8(clamp_fp8(v0[0]), clamp_fp8(v0[1]), clamp_fp8(v0[2]), clamp_fp8(v0[3])); w[bj].y = pk4_fp8(clamp_fp8(v1[0]), clamp_fp8(v1[1]), clamp_fp8(v1[2]), clamp_fp8(v1[3])); }
                *(u32x4*)op = pair16(w[0], w[1]); }
        } else {
#pragma unroll
        for (int ai = 0; ai < 2; ++ai)
#pragma unroll
            for (int m = 0; m < 4; ++m) { const int r = r0 + ai * HALF + m * 16;
                if (r < u.valid) { const float gw = gwv[ai][m];
                    unsigned char* op = Y + (size_t)info[ai][m] * 1024 + col0;
#pragma unroll
                    for (int bj = 0; bj < 2; ++bj) { constexpr float RS = 1.0f / (SH * SW); const f32x4 v0 = (acc[ai][bj][m][0] * RS + b[bj][0]) * gw, v1 = (acc[ai][bj][m][1] * RS + b[bj][1]) * gw;
                        u32x2 w; w.x = pk4_fp8(clamp_fp8(v0[0]), clamp_fp8(v0[1]), clamp_fp8(v0[2]), clamp_fp8(v0[3])); w.y = pk4_fp8(clamp_fp8(v1[0]), clamp_fp8(v1[1]), clamp_fp8(v1[2]), clamp_fp8(v1[3]));
                        *(u32x2*)(op + bj * HALF) = w; } } }
        }
    }
};
}

#define XB_TMO      128
#define XB_XCNT(j)  (256  + 64 * (j))
#define XB_XSUB(j)  (1280 + 64 * (j))
#define XB_XGEN(j)  (2304 + 64 * (j))
#define XB_TOP      3328
#define XB_TOPGEN   3392
#define XCD_BAR_WORDS 3456
#define XB_SPIN_CAP (1u << 18)
__device__ __forceinline__ unsigned xb_ld(unsigned* p)              { return __hip_atomic_load(p, __ATOMIC_RELAXED, __HIP_MEMORY_SCOPE_AGENT); }
__device__ __forceinline__ unsigned xb_add(unsigned* p, unsigned v) { return __hip_atomic_fetch_add(p, v, __ATOMIC_RELAXED, __HIP_MEMORY_SCOPE_AGENT); }
__device__ __forceinline__ unsigned xb_xcc_id() { return (unsigned)__builtin_amdgcn_s_getreg((3 << 11) | 20) & 0xFu; }
#define XB_SPIN(cond, bar) do { unsigned _sp = 0; while (cond) { __builtin_amdgcn_s_sleep(1); \
    if ((++_sp & 255u) == 0u) { if (xb_ld(&(bar)[XB_TMO])) break; if (_sp > XB_SPIN_CAP) { atomicAdd(&(bar)[XB_TMO], 1u); break; } } } } while (0)
struct XcdBarrier { unsigned* bar; unsigned x; volatile LAS unsigned* st; };
__device__ __forceinline__ XcdBarrier xcd_barrier_post(unsigned* bar, volatile LAS unsigned* st) {
    XcdBarrier b; b.bar = bar; b.x = xb_xcc_id(); b.st = st;
    if (threadIdx.x == 0) (void)xb_add(&bar[XB_XCNT(b.x)], 1u);
    return b;
}
__device__ __forceinline__ void xcd_barrier_complete(unsigned* bar, unsigned x, unsigned& nloc, unsigned& nx) {
    const unsigned G = gridDim.x * gridDim.y * gridDim.z;
    unsigned sum, cnt, mine, sp = 0u;
    for (;;) {
        sum = 0u; cnt = 0u; mine = 0u;
#pragma unroll
        for (unsigned j = 0; j < 16; ++j) { const unsigned c = xb_ld(&bar[XB_XCNT(j)]); sum += c; cnt += (c > 0u) ? 1u : 0u; mine = (j == x) ? c : mine; }
        if (sum == G) break;
        __builtin_amdgcn_s_sleep(1);
        if ((++sp & 255u) == 0u) { if (xb_ld(&bar[XB_TMO])) break; if (sp > XB_SPIN_CAP) { atomicAdd(&bar[XB_TMO], 1u); break; } }
    }
    nloc = mine > 0u ? mine : 1u; nx = cnt > 0u ? cnt : 1u;
}
__device__ __forceinline__ void xcd_barrier(const XcdBarrier& b) {
    asm volatile("s_waitcnt vmcnt(0)" ::: "memory");
    __syncthreads();
    if (threadIdx.x == 0) {
        unsigned* bar = b.bar;
        __builtin_amdgcn_s_waitcnt(0);
        unsigned nloc = b.st[0], nx = b.st[1];
        if (nloc == 0u) { xcd_barrier_complete(bar, b.x, nloc, nx); b.st[0] = nloc; b.st[1] = nx; }
        const unsigned old = xb_add(&bar[XB_XSUB(b.x)], 1u);
        const unsigned gen = old / nloc;
        if (old + 1u == (gen + 1u) * nloc) {
            __builtin_amdgcn_fence(__ATOMIC_RELEASE, "agent");
            asm volatile("s_waitcnt vmcnt(0)" ::: "memory");
            const unsigned og = xb_add(&bar[XB_TOP], 1u);
            const unsigned tg = og / nx;
            if (og + 1u == (tg + 1u) * nx) xb_add(&bar[XB_TOPGEN], 1u);
            else XB_SPIN(xb_ld(&bar[XB_TOPGEN]) == tg, bar);
            __builtin_amdgcn_fence(__ATOMIC_ACQUIRE, "agent");
            xb_add(&bar[XB_XGEN(b.x)], 1u);
            asm volatile("s_waitcnt vmcnt(0)" ::: "memory");
        } else {
            XB_SPIN(xb_ld(&bar[XB_XGEN(b.x)]) == gen, bar);
            __builtin_amdgcn_fence(__ATOMIC_ACQUIRE, "agent");
            asm volatile("s_waitcnt vmcnt(0)" ::: "memory");
        }
    }
    __syncthreads();
}

constexpr int NWAVES = 8;
struct Frame {
    LAS unsigned char* lds; volatile LAS unsigned* MISC; gu32* ctl;
    int tid, lane, wave, vcu, G;
    unsigned char* ws; unsigned char* dout;
};
__device__ __forceinline__ float wave_sum(float v) {
#pragma unroll
    for (int o = 1; o < 64; o <<= 1) v += __shfl_xor(v, o);
    return v;
}
__device__ __forceinline__ void transpose_item(const float* W, int N, int k0, int n0, bf16_t* WT, int ldw, size_t drow0, int dcol0, LAS float* scr, int lane) {
#pragma unroll 8
    for (int i = 0; i < 32; ++i) { const int kk = 2 * i + (lane >> 5); scr[kk * 33 + (lane & 31)] = W[(size_t)(k0 + kk) * N + n0 + (lane & 31)]; }
    LDS_WAIT(); asm volatile("" ::: "memory");
    const int c = lane & 7;
#pragma unroll
    for (int j = 0; j < 4; ++j) { const int n = (lane >> 3) + 8 * j; const LAS float* s = scr + (8 * c) * 33 + n;
        u32x4 o; o.x = cvt_pk_bf16(s[0 * 33], s[1 * 33]); o.y = cvt_pk_bf16(s[2 * 33], s[3 * 33]); o.z = cvt_pk_bf16(s[4 * 33], s[5 * 33]); o.w = cvt_pk_bf16(s[6 * 33], s[7 * 33]);
        *(GAS u32x4*)(WT + (drow0 + n) * (size_t)ldw + dcol0 + 8 * c) = o; }
    LDS_WAIT(); asm volatile("" ::: "memory");
}
__device__ __forceinline__ void transpose_item_f8(const float* W, int N, int k0, int n0, unsigned char* WT, int ldw, size_t drow0, int dcol0, LAS float* scr, int lane);
__device__ __forceinline__ void p0_convert(Frame& F, const float* x, const float* w_in, const float* w_pa, const float* w_pb, const float* w_out, const float* rw) {
    LAS float* scr = (LAS float*)(F.lds + F.wave * 17408);
    const int gw = F.vcu * NWAVES + F.wave, NGW = F.G * NWAVES;
    unsigned char* WIN = F.dout + DO_WIN; unsigned char* WCAT = F.dout + DO_WCAT; unsigned char* WOUT = F.ws + WS_WOUT;
    constexpr int I_IN = (D / 128) * (IN_COLS / 32), I_OUT = (D / 128) * (D / 32), I_PA = (256 / 128) * (D / 32), I_PB = (D / 128) * (D / 32);
    for (int it = gw; it < I_IN + I_OUT + I_PA + I_PB; it += NGW) {
        int r = it;
        if (r < I_IN) { const int nb = IN_COLS / 32; transpose_item_f8(w_in, IN_COLS, 128 * (r / nb), 32 * (r % nb), WIN, D, (size_t)(32 * (r % nb)), 128 * (r / nb), scr, F.lane); continue; } r -= I_IN;
        if (r < I_OUT) { const int nb = D / 32; transpose_item_f8(w_out, D, 128 * (r / nb), 32 * (r % nb), WOUT, D, (size_t)(32 * (r % nb)), 128 * (r / nb), scr, F.lane); continue; } r -= I_OUT;
        if (r < I_PA) { const int nb = D / 32; transpose_item_f8(w_pa, D, 128 * (r / nb), 32 * (r % nb), WCAT, OAB_P, (size_t)(32 * (r % nb)), 128 * (r / nb), scr, F.lane); continue; } r -= I_PA;
        { const int nb = D / 32; transpose_item_f8(w_pb, D, 128 * (r / nb), 32 * (r % nb), WCAT, OAB_P, (size_t)(32 * (r % nb)), 256 + 128 * (r / nb), scr, F.lane); }
    }
    { bf16_t* WRT = (bf16_t*)(F.ws + WS_WRT);
      for (int i = gw * 64 + F.lane; i < NEXP * D; i += NGW * 64) { const int e = i >> 10, k = i & (D - 1); const float w = rw[k * NEXP + e];
          const unsigned hi = cvt_pk_bf16(w, 0.f) & 0xffffu; const float r = w - __uint_as_float(hi << 16);
          WRT[i] = (bf16_t)hi; WRT[NEXP * D + i] = (bf16_t)(cvt_pk_bf16(r, 0.f) & 0xffffu); } }
    unsigned char* XQ = F.dout + DO_XB;
    const size_t n16 = (size_t)NTOK * D / 16;
    for (size_t i = (size_t)gw * 64 + F.lane; i < n16; i += (size_t)NGW * 64) {
        const f32x4 a = *(const GAS f32x4*)(x + i * 16), b = *(const GAS f32x4*)(x + i * 16 + 4), c = *(const GAS f32x4*)(x + i * 16 + 8), d = *(const GAS f32x4*)(x + i * 16 + 12);
        u32x4 o;
        o.x = pk4_fp8(clamp_fp8(a[0] * SXIN), clamp_fp8(a[1] * SXIN), clamp_fp8(a[2] * SXIN), clamp_fp8(a[3] * SXIN)); o.y = pk4_fp8(clamp_fp8(b[0] * SXIN), clamp_fp8(b[1] * SXIN), clamp_fp8(b[2] * SXIN), clamp_fp8(b[3] * SXIN));
        o.z = pk4_fp8(clamp_fp8(c[0] * SXIN), clamp_fp8(c[1] * SXIN), clamp_fp8(c[2] * SXIN), clamp_fp8(c[3] * SXIN)); o.w = pk4_fp8(clamp_fp8(d[0] * SXIN), clamp_fp8(d[1] * SXIN), clamp_fp8(d[2] * SXIN), clamp_fp8(d[3] * SXIN));
        *(GAS u32x4*)(XQ + i * 16) = o;
    }
}
__device__ __forceinline__ void transpose_item_f8(const float* W, int N, int k0, int n0, unsigned char* WT, int ldw, size_t drow0, int dcol0, LAS float* scr, int lane) {
    f32x4 wv[16];
#pragma unroll
    for (int i = 0; i < 16; ++i) wv[i] = *(const GAS f32x4*)(W + (size_t)(k0 + 8 * i + (lane >> 3)) * N + n0 + (lane & 7) * 4);
#pragma unroll
    for (int i = 0; i < 16; ++i) { LAS float* d = scr + (8 * i + (lane >> 3)) * 33 + (lane & 7) * 4; d[0] = wv[i][0]; d[1] = wv[i][1]; d[2] = wv[i][2]; d[3] = wv[i][3]; }
    LDS_WAIT(); asm volatile("" ::: "memory");
    const int c = lane & 7;
#pragma unroll
    for (int j = 0; j < 4; ++j) { const int n = (lane >> 3) + 8 * j; const LAS float* s = scr + (16 * c) * 33 + n;
        u32x4 o;
        o.x = pk4_fp8(clamp_fp8(s[0 * 33] * SW), clamp_fp8(s[1 * 33] * SW), clamp_fp8(s[2 * 33] * SW), clamp_fp8(s[3 * 33] * SW));
        o.y = pk4_fp8(clamp_fp8(s[4 * 33] * SW), clamp_fp8(s[5 * 33] * SW), clamp_fp8(s[6 * 33] * SW), clamp_fp8(s[7 * 33] * SW));
        o.z = pk4_fp8(clamp_fp8(s[8 * 33] * SW), clamp_fp8(s[9 * 33] * SW), clamp_fp8(s[10 * 33] * SW), clamp_fp8(s[11 * 33] * SW));
        o.w = pk4_fp8(clamp_fp8(s[12 * 33] * SW), clamp_fp8(s[13 * 33] * SW), clamp_fp8(s[14 * 33] * SW), clamp_fp8(s[15 * 33] * SW));
        *(GAS u32x4*)(WT + (drow0 + n) * (size_t)ldw + dcol0 + 16 * c) = o; }
    LDS_WAIT(); asm volatile("" ::: "memory");
}
__device__ __forceinline__ void p3_convert_moe(Frame& F, const float* w_gate, const float* w_up, const float* w_down, int wg, int nwg) {
    LAS float* scr = (LAS float*)(F.lds + F.wave * 17408);
    const int gw = wg * NWAVES + F.wave, NGW = nwg * NWAVES;
    unsigned char* WGU = F.ws + WS_WGU; unsigned char* WD = F.ws + WS_WD;
    constexpr int IPM = (D / 128) * (DFF / 32);
    for (int it = gw; it < NEXP * 3 * IPM; it += NGW) {
        const int e = it / (3 * IPM), r3 = it % (3 * IPM), which = r3 / IPM, r = r3 % IPM, kb = r / 32, nb = r % 32, k0 = 128 * kb, n0 = 32 * nb;
        const size_t moff = (size_t)e * D * DFF;
        if (which == 2) transpose_item_f8(w_down + moff, D, k0, n0, WD + moff, DFF, (size_t)n0, k0, scr, F.lane);
        else { const int pn = n0 >> 7, jj = n0 & 127; transpose_item_f8((which ? w_up : w_gate) + moff, DFF, k0, n0, WGU + 2 * moff, D, (size_t)(256 * pn + 128 * which + jj), k0, scr, F.lane); }
    }
}
typedef short v4i16_t __attribute__((ext_vector_type(4)));
__device__ __forceinline__ s16x4 tr_read(const LAS unsigned char* p) { return __builtin_bit_cast(s16x4, __builtin_amdgcn_ds_read_tr16_b64_v4i16((LAS v4i16_t*)p)); }
template <int C>
__device__ __forceinline__ void tr_read8(s16x4 (&r)[8], unsigned addr) {
#define TRR(i) asm volatile("ds_read_b64_tr_b16 %0, %1 offset:%2" : "=v"(r[i]) : "v"(addr), "n"(C * 4096 + (i) * 512))
    TRR(0); TRR(1); TRR(2); TRR(3); TRR(4); TRR(5); TRR(6); TRR(7);
#undef TRR
}
__device__ __forceinline__ void tr_wait8(s16x4 (&r)[8]) {
    asm volatile("s_waitcnt lgkmcnt(0)" : "+v"(r[0]), "+v"(r[1]), "+v"(r[2]), "+v"(r[3]), "+v"(r[4]), "+v"(r[5]), "+v"(r[6]), "+v"(r[7]));
}
template <int C>
__device__ __forceinline__ void pv_tile(s16x4 (&cur)[8], s16x4 (&prev)[8], bf16x8 (&pf)[2], bf16x8 (&pfprev)[2], unsigned vbase, const f32x16& Sc, f32x16 (&O)[2]) {
#pragma unroll
    for (int s = 0; s < 2; ++s) { u32x4 w; w.x = cvt_pk_bf16(Sc[8 * s + 0], Sc[8 * s + 1]); w.y = cvt_pk_bf16(Sc[8 * s + 2], Sc[8 * s + 3]);
        w.z = cvt_pk_bf16(Sc[8 * s + 4], Sc[8 * s + 5]); w.w = cvt_pk_bf16(Sc[8 * s + 6], Sc[8 * s + 7]); pf[s] = __builtin_bit_cast(bf16x8, w); }
    tr_read8<C>(cur, vbase);
    if (C > 0) { asm volatile("" :: "v"(prev[0]), "v"(prev[1]), "v"(prev[2]), "v"(prev[3]), "v"(prev[4]), "v"(prev[5]), "v"(prev[6]), "v"(prev[7]) : "memory");
                 asm volatile("" :: "v"(pfprev[0]), "v"(pfprev[1]) : "memory"); }
    tr_wait8(cur);
    __builtin_amdgcn_sched_barrier(0);
#pragma unroll
    for (int blk = 0; blk < 2; ++blk)
#pragma unroll
        for (int s = 0; s < 2; ++s) { const s16x4 lo = cur[(blk * 2 + s) * 2], hi = cur[(blk * 2 + s) * 2 + 1];
            O[blk] = __builtin_amdgcn_mfma_f32_32x32x16_bf16((bf16x8){lo[0], lo[1], lo[2], lo[3], hi[0], hi[1], hi[2], hi[3]}, pf[s], O[blk], 0, 0, 0); }
    __builtin_amdgcn_sched_barrier(0);
}
constexpr int ATT_KOFF = 0, ATT_QOFF = 12 * 2048, ATT_VOFF = 12 * 4096, ATT_STG = 24 * 4096, ATT_STGW = 4608;
static_assert(ATT_STG + 8 * ATT_STGW <= SCR_BYTES, "attention LDS map");
struct AKV { const unsigned char* qseq; const unsigned char* kseq; const bf16_t* vseq; int jt0, nkt, jq; };
__device__ __forceinline__ AKV attn_kv(const Frame& F, int U) {
    const unsigned char* HQ = F.ws + WS_HQ; AKV r;
    if (U < 2048) {
        const int b = U >> 8, kvh = (U >> 7) & 1, j = U & 127, hq = kvh * 8 + F.wave;
        r.qseq = HQ + HQ_QS + (size_t)(b * 16 + hq) * SEQ * 64; r.kseq = HQ + HQ_KS + (size_t)(b * 2 + kvh) * SEQ * 64; r.vseq = (const bf16_t*)(HQ + HQ_VS) + (size_t)(b * 2 + kvh) * SEQ * 64;
        r.jt0 = j - 4; r.nkt = 5; r.jq = j;
    } else {
        const int v = U - 2048, g = v >> 9, w_ = v & 511, b = w_ >> 6, x = w_ & 63, hh = x >> 4, y = x & 15;
        const int dil = (g == 0) ? 1 : (g == 1) ? 4 : 16;
        const int res = (g == 0) ? 0 : (g == 1) ? (y >> 2) : y;
        const int j0 = (g == 0) ? y * 8 : (g == 1) ? (y & 3) * 8 : 0;
        const size_t seq = ((size_t)((g * NB + b) * 4 + hh) * SEQ + (size_t)res * (SEQ / dil)) * 64;
        r.qseq = HQ + HQ_QD + seq; r.kseq = HQ + HQ_KD + seq; r.vseq = (const bf16_t*)(HQ + HQ_VD) + seq;
        r.jt0 = j0 - 4; r.nkt = 12; r.jq = j0 + F.wave;
    }
    return r;
}
__device__ __forceinline__ unsigned attn_koff(int lane) { return (unsigned)((lane >> 2) * 64 + (((lane & 3) ^ ((lane >> 4) & 3)) * 16)); }
__device__ __forceinline__ unsigned attn_voff(int lane) { return (unsigned)((lane >> 2) * 128 + (lane & 3) * 16); }
__device__ __forceinline__ void attn_issue_k(LAS unsigned char* lds, int lane, int wave, const AKV& u) {
    const unsigned koff = attn_koff(lane);
    for (int p = wave; p < u.nkt * 2; p += 8) {
        const int s = p >> 1, qt = p & 1; const int tj = u.jt0 + s; const size_t pos0 = (size_t)(32 * (tj >= 0 ? tj : 0) + 16 * qt);
        __builtin_amdgcn_global_load_lds((const unsigned*)((const char*)u.kseq + pos0 * 64 + koff), (LAS unsigned*)(lds + ATT_KOFF + s * 2048 + qt * 1024), 16, 0, 0);
    }
}
__device__ __forceinline__ void attn_issue_q(LAS unsigned char* lds, int lane, int wave, const AKV& u) {
    const unsigned koff = attn_koff(lane);
#pragma unroll
    for (int qt = 0; qt < 2; ++qt)
        __builtin_amdgcn_global_load_lds((const unsigned*)((const char*)u.qseq + (size_t)(32 * u.jq + 16 * qt) * 64 + koff), (LAS unsigned*)(lds + ATT_QOFF + wave * 2048 + qt * 1024), 16, 0, 0);
}
template <int NKT>
__device__ __forceinline__ int attn_issue_v(LAS unsigned char* lds, int lane, int wave, const AKV& u) {
    const int w4 = (wave + 4) & 7;
    const unsigned voff = attn_voff(lane);
#pragma unroll
    for (int i = 0; i < (NKT * 4 + 7) / 8; ++i) { const int p = w4 + 8 * i;
        if (p < NKT * 4) { const int s = p >> 2, qt = p & 3; const int tj = u.jt0 + s; const int blk = qt >> 1, part = qt & 1;
            const size_t pos0 = (size_t)(32 * (tj >= 0 ? tj : 0) + 16 * part);
            __builtin_amdgcn_global_load_lds((const unsigned*)((const char*)u.vseq + pos0 * 128 + blk * 64 + voff), (LAS unsigned*)(lds + ATT_VOFF + s * 4096 + blk * 2048 + part * 1024), 16, 0, 0); } }
    return NKT == 12 ? 6 : (w4 < 4 ? 3 : 2);
}
__device__ __forceinline__ void attn_wait(int n) {
#define AW(N) asm volatile("s_waitcnt vmcnt(" #N ")" ::: "memory")
    if (n == 11) AW(11); else if (n == 8) AW(8); else if (n == 7) AW(7); else if (n == 6) AW(6); else if (n == 5) AW(5); else if (n == 4) AW(4); else if (n == 3) AW(3); else if (n == 2) AW(2); else AW(0);
#undef AW
}
template <bool swa>
__device__ __forceinline__ void attn_unit(LAS unsigned char* lds, int lane, int wave, const AKV& u, int s0,
                                          float sl2, float sink2, bf16_t* ob, unsigned op, float* lseb, unsigned lsep, bool hasn, const AKV& nx) {
    const int i32 = lane & 31, h = lane >> 5;
    const int jq = u.jq;
    constexpr float QKS = SQ * SK, RQK = 1.0f / (SQ * SK), NEG_RAW = -1.0e30f;
    f32x16 bias;
#pragma unroll
    for (int r = 0; r < 16; ++r) { const int kk = (r & 3) + 8 * (r >> 2) + 4 * h; bias[r] = sl2 * QKS * (float)(kk - i32); }
    __builtin_amdgcn_s_barrier();
    asm volatile("" ::: "memory");
    f32x16 S[5];
    float m2 = sink2;
    const int kro = i32 * 64 + h * 8, ksw = (i32 >> 2) & 3;
    long qf[4];
#pragma unroll
    for (int d0 = 0; d0 < 4; ++d0) qf[d0] = *(const LAS long*)(lds + ATT_QOFF + wave * 2048 + kro + ((d0 ^ ksw) * 16));
    long kf[2][4];
#pragma unroll
    for (int c = 0; c < 5; ++c) {
        const bool tv = (jq - 4 + c) >= 0;
        const LAS unsigned char* ks = lds + ATT_KOFF + (s0 + c) * 2048 + kro;
#pragma unroll
        for (int d0 = 0; d0 < 4; ++d0) kf[c & 1][d0] = *(const LAS long*)(ks + ((d0 ^ ksw) * 16));
        if (c > 0) asm volatile("" :: "v"(kf[(c - 1) & 1][0]), "v"(kf[(c - 1) & 1][1]), "v"(kf[(c - 1) & 1][2]), "v"(kf[(c - 1) & 1][3]) : "memory");
        f32x16 a = bias;
#pragma unroll
        for (int d0 = 0; d0 < 4; ++d0) a = __builtin_amdgcn_mfma_f32_32x32x16_fp8_fp8(kf[c & 1][d0], qf[d0], a, 0, 0, 0);
        if (c == 0 || c == 4) {
#pragma unroll
            for (int r = 0; r < 16; ++r) { const int kk = (r & 3) + 8 * (r >> 2) + 4 * h;
                const bool ok = (c == 4) ? (kk <= i32) : (swa ? (kk > i32) : (kk >= i32));
                a[r] = ok ? a[r] : NEG_RAW; }
        }
        float mt = fmaxf(fmaxf(a[0], a[1]), a[2]);
#pragma unroll
        for (int r = 3; r < 15; r += 2) mt = fmaxf(fmaxf(mt, a[r]), a[r + 1]);
        mt = fmaxf(mt, a[15]);
        m2 = fmaxf(m2, __builtin_fmaf(mt, RQK, tv ? -sl2 * (float)(32 * (4 - c)) : NEG_RAW));
        S[c] = a;
    }
    m2 = fmaxf(m2, __shfl_xor(m2, 32));
    float l = 0.f;
#pragma unroll
    for (int c = 0; c < 5; ++c) {
        const float offc = ((jq - 4 + c) >= 0 ? -sl2 * (float)(32 * (4 - c)) : NEG_RAW) - m2;
#pragma unroll
        for (int r = 0; r < 16; ++r) { const float p = __builtin_amdgcn_exp2f(__builtin_fmaf(S[c][r], RQK, offc)); S[c][r] = p; l += p; }
    }
    l += __shfl_xor(l, 32);
    l += __builtin_amdgcn_exp2f(sink2 - m2);
    asm volatile("" :: "v"(kf[0][0]), "v"(kf[0][1]), "v"(kf[0][2]), "v"(kf[0][3]), "v"(kf[1][0]), "v"(kf[1][1]), "v"(kf[1][2]), "v"(kf[1][3]) : "memory");
    asm volatile("s_waitcnt vmcnt(0) lgkmcnt(0)" : "+v"(l) :: "memory");
    __builtin_amdgcn_s_barrier();
    asm volatile("" ::: "memory");
    if (hasn) { attn_issue_k(lds, lane, wave, nx); attn_issue_q(lds, lane, wave, nx); }
    f32x16 O[2]; O[0] = (f32x16){}; O[1] = (f32x16){};
    const int vaddr0 = ((lane >> 4) & 1) * 32 + (lane & 3) * 8 + (4 * h + ((lane & 15) >> 2)) * 64;
    const unsigned vbase = (unsigned)(size_t)(lds + ATT_VOFF) + (unsigned)(s0 * 4096 + vaddr0);
    s16x4 va[2][8]; bf16x8 pf[2][2];
    pv_tile<0>(va[0], va[1], pf[0], pf[1], vbase, S[0], O); pv_tile<1>(va[1], va[0], pf[1], pf[0], vbase, S[1], O); pv_tile<2>(va[0], va[1], pf[0], pf[1], vbase, S[2], O);
    pv_tile<3>(va[1], va[0], pf[1], pf[0], vbase, S[3], O); pv_tile<4>(va[0], va[1], pf[0], pf[1], vbase, S[4], O);
    asm volatile("" :: "v"(pf[0][0]), "v"(pf[0][1]), "v"(pf[1][0]), "v"(pf[1][1]) : "memory");
    asm volatile("" :: "v"(va[0][0]), "v"(va[0][1]), "v"(va[0][2]), "v"(va[0][3]), "v"(va[0][4]), "v"(va[0][5]), "v"(va[0][6]), "v"(va[0][7]) : "memory");
    asm volatile("" :: "v"(va[1][0]), "v"(va[1][1]), "v"(va[1][2]), "v"(va[1][3]), "v"(va[1][4]), "v"(va[1][5]), "v"(va[1][6]), "v"(va[1][7]) : "memory");
    __builtin_amdgcn_s_barrier();
    asm volatile("" ::: "memory");
    int nv = 0;
    if (hasn) { if (nx.nkt == 12) nv = attn_issue_v<12>(lds, lane, wave, nx); else nv = attn_issue_v<5>(lds, lane, wave, nx); }
    const float inv = 1.0f / l;
    LAS unsigned char* stg = lds + ATT_STG + wave * ATT_STGW;
    if (swa) {
        const float is = inv * SO;
#pragma unroll
        for (int blk = 0; blk < 2; ++blk)
#pragma unroll
            for (int g4 = 0; g4 < 4; ++g4) { const int d0 = blk * 32 + 8 * g4 + 4 * h;
                *(LAS unsigned*)(stg + i32 * 80 + d0) = pk4_fp8_pad(clamp_fp8(O[blk][4 * g4 + 0] * is), clamp_fp8(O[blk][4 * g4 + 1] * is), clamp_fp8(O[blk][4 * g4 + 2] * is), clamp_fp8(O[blk][4 * g4 + 3] * is)); }
        asm volatile("s_waitcnt lgkmcnt(0)" ::: "memory");
#pragma unroll
        for (int it = 0; it < 2; ++it) { const int row = it * 16 + (lane >> 2), ch = lane & 3;
            const u32x4 v = *(const LAS u32x4*)(stg + row * 80 + ch * 16);
            *(u32x4*)((char*)ob + (size_t)(32 * jq + row) * op + ch * 16) = v; }
    } else {
#pragma unroll
        for (int blk = 0; blk < 2; ++blk)
#pragma unroll
            for (int g4 = 0; g4 < 4; ++g4) { const int d0 = blk * 32 + 8 * g4 + 4 * h;
                u32x2 w; w.x = cvt_pk_bf16(O[blk][4 * g4 + 0] * inv, O[blk][4 * g4 + 1] * inv); w.y = cvt_pk_bf16(O[blk][4 * g4 + 2] * inv, O[blk][4 * g4 + 3] * inv);
                *(LAS u32x2*)(stg + i32 * 144 + d0 * 2) = w; }
        asm volatile("s_waitcnt lgkmcnt(0)" ::: "memory");
#pragma unroll
        for (int it = 0; it < 4; ++it) { const int row = it * 8 + (lane >> 3), ch = lane & 7;
            const u32x4 v = *(const LAS u32x4*)(stg + row * 144 + ch * 16);
            *(u32x4*)((char*)ob + (size_t)(32 * jq + row) * op + ch * 16) = v; }
    }
    if (lseb != nullptr && h == 0) lseb[(size_t)(32 * jq + i32) * lsep] = (m2 + __builtin_amdgcn_logf(l)) * LN2;
    attn_wait(hasn ? nv + (swa ? 2 : 5) : 0);
}
__device__ __forceinline__ void p2_attention(Frame& F, const float* sinks) {
    unsigned char* OAB = F.dout + DO_OAB; bf16_t* OAG = (bf16_t*)(F.ws + WS_OAG); float* LSE = (float*)(F.ws + WS_LSE);
    constexpr int NUNIT = 2048 + 1536;
    int U = F.vcu; if (U >= NUNIT) return;
    float snk0 = sinks[F.wave] * LOG2E, snk1 = sinks[8 + F.wave] * LOG2E;
    asm volatile("" : "+v"(snk0), "+v"(snk1));
    AKV cur = attn_kv(F, U);
    attn_issue_k(F.lds, F.lane, F.wave, cur);
    attn_issue_q(F.lds, F.lane, F.wave, cur);
    { const int nv0 = (cur.nkt == 12) ? attn_issue_v<12>(F.lds, F.lane, F.wave, cur) : attn_issue_v<5>(F.lds, F.lane, F.wave, cur); attn_wait(nv0); }
    for (;;) {
        const int Un = U + F.G; const bool hasn = Un < NUNIT;
        const AKV nxt = attn_kv(F, hasn ? Un : U);
        if (U < 2048) {
            const int b = U >> 8, kvh = (U >> 7) & 1, hq = kvh * 8 + F.wave;
            const float slope = exp2f(-8.0f * (float)(hq + 1) / 28.0f);
            attn_unit<true>(F.lds, F.lane, F.wave, cur, 0, slope * LOG2E, kvh ? snk1 : snk0, (bf16_t*)(OAB + (size_t)b * SEQ * OAB_P + 256 + hq * 64), OAB_P, nullptr, 0, hasn, nxt);
        } else {
            const int v = U - 2048, g = v >> 9, w_ = v & 511, b = w_ >> 6, x = w_ & 63, hh = x >> 4, y = x & 15;
            const int dil = (g == 0) ? 1 : (g == 1) ? 4 : 16;
            const int res = (g == 0) ? 0 : (g == 1) ? (y >> 2) : y;
            const size_t tok0 = (size_t)b * SEQ + res;
            const float slope = exp2f(-8.0f * (float)(16 + g * 4 + hh + 1) / 28.0f);
            attn_unit<false>(F.lds, F.lane, F.wave, cur, F.wave, slope * (float)dil * LOG2E, NEG_BIG,
                             OAG + ((size_t)g * NTOK + tok0) * 256 + hh * 64, (unsigned)(dil * 256 * 2), LSE + ((size_t)g * NTOK + tok0) * 4 + hh, (unsigned)(dil * 4), hasn, nxt);
        }
        if (!hasn) break;
        U = Un; cur = nxt;
    }
}
__device__ __forceinline__ void p3_merge(Frame& F) {
    const bf16_t* OAG = (const bf16_t*)(F.ws + WS_OAG); const float* LSE = (const float*)(F.ws + WS_LSE); unsigned char* OAB = F.dout + DO_OAB;
    const int gw = F.vcu * NWAVES + F.wave, NGW = F.G * NWAVES;
    for (int idx = gw; idx < NTOK / 2; idx += NGW) {
        const int tok = idx * 2 + (F.lane >> 5), c8 = F.lane & 31, hh = c8 >> 3;
        float ls[3]; u32x4 o[3];
#pragma unroll
        for (int g = 0; g < 3; ++g) { ls[g] = LSE[((size_t)g * NTOK + tok) * 4 + hh]; o[g] = *(const u32x4*)(OAG + ((size_t)g * NTOK + tok) * 256 + c8 * 8); }
        const float m = fmaxf(fmaxf(ls[0], ls[1]), ls[2]);
        float w[3]; float sum = 0.f;
#pragma unroll
        for (int g = 0; g < 3; ++g) { w[g] = __builtin_amdgcn_exp2f((ls[g] - m) * LOG2E); sum += w[g]; }
        const float is = 1.0f / sum; float r[8];
#pragma unroll
        for (int q = 0; q < 8; ++q) r[q] = 0.f;
#pragma unroll
        for (int g = 0; g < 3; ++g) { const float wg = w[g] * is;
            r[0] += wg * bf_lo(o[g].x); r[1] += wg * bf_hi(o[g].x); r[2] += wg * bf_lo(o[g].y); r[3] += wg * bf_hi(o[g].y);
            r[4] += wg * bf_lo(o[g].z); r[5] += wg * bf_hi(o[g].z); r[6] += wg * bf_lo(o[g].w); r[7] += wg * bf_hi(o[g].w); }
        u32x2 out; out.x = pk4_fp8(clamp_fp8(r[0] * SO), clamp_fp8(r[1] * SO), clamp_fp8(r[2] * SO), clamp_fp8(r[3] * SO)); out.y = pk4_fp8(clamp_fp8(r[4] * SO), clamp_fp8(r[5] * SO), clamp_fp8(r[6] * SO), clamp_fp8(r[7] * SO));
        *(u32x2*)(OAB + (size_t)tok * OAB_P + c8 * 8) = out;
    }
}

__device__ __forceinline__ void p6_router(Frame& F, const bf16_t* y, const float* stat, const float* gam, const float* bet, bf16_t* x1b, unsigned char* x1q, const float* rb, int cw_ecnt, size_t pe_off) {
    constexpr int WPITCH = 2064;
    constexpr int WIMG = 64 * WPITCH;
    constexpr int GOFF = WIMG + 2048;
    static_assert(GOFF + 8192 <= SCR_BYTES, "router LDS map");
    LAS int* wcnt = (LAS int*)(F.lds + WIMG + F.wave * 256); LAS int* wbase = wcnt + 32;
    int* petok = (int*)(F.ws + WS_PETOK + pe_off); float* pegate = (float*)(F.ws + WS_PEGATE + pe_off);
    const bf16_t* WRT = (const bf16_t*)(F.ws + WS_WRT);
    const int gw = F.vcu * NWAVES + F.wave, NGW = F.G * NWAVES, lane = F.lane, j = lane & 15, kq = lane >> 4;
    __syncthreads();
    for (int q = F.tid; q < 64 * 128; q += NWAVES * 64) { const u32x4 v = *(const u32x4*)((const char*)WRT + (size_t)q * 16); *(LAS u32x4*)(F.lds + (q >> 7) * WPITCH + (q & 127) * 16) = v; }
    for (int q = F.tid; q < 512; q += NWAVES * 64) { const f32x4 v = (q < 256) ? *(const f32x4*)(gam + q * 4) : *(const f32x4*)(bet + (q - 256) * 4); *(LAS f32x4*)(F.lds + GOFF + q * 16) = v; }
    __syncthreads();
    const LAS unsigned char* wrow = F.lds + j * WPITCH + kq * 16;
    const LAS float* gl = (const LAS float*)(F.lds + GOFF) + 8 * kq; const LAS float* bl = gl + 1024;
    for (int tb = F.vcu * NWAVES; tb < NTOK / 16; tb += NGW) {
        const int tt = tb + F.wave; const bool valid = tt < NTOK / 16; const int t0 = (valid ? tt : 0) * 16;
        float mean, rstd;
        { const f32x4* sp = (const f32x4*)(stat + (size_t)(t0 + j) * 32); float s1 = 0.f, s2 = 0.f;
#pragma unroll
          for (int q = 0; q < 8; ++q) { const f32x4 v = sp[q]; s1 += v[0] + v[2]; s2 += v[1] + v[3]; }
          mean = s1 * (1.0f / D); const float var = fmaxf(s2 * (1.0f / D) - mean * mean, 0.f); rstd = 1.0f / sqrtf(var + LN_EPS); }
        f32x4 acc[2]; acc[0] = (f32x4){0.f, 0.f, 0.f, 0.f}; acc[1] = acc[0];
        const bf16_t* yrow = y + (size_t)(t0 + j) * D + 8 * kq;
        bf16_t* xbrow = (valid ? x1b : (bf16_t*)(F.ws + 300 * MiB)) + (size_t)(t0 + j) * D + 8 * kq; unsigned char* xqrow = (valid ? x1q : F.ws + 300 * MiB) + (size_t)(t0 + j) * D + 8 * kq;
        bf16x8 wf[2][4]; wf[1][0] = (bf16x8){}; wf[1][1] = wf[1][0]; wf[1][2] = wf[1][0]; wf[1][3] = wf[1][0];
        u32x4 yv[4], yn[4]; u32x2 q8prev = (u32x2){0u, 0u};
#pragma unroll
        for (int u = 0; u < 4; ++u) yv[u] = *(const u32x4*)(yrow + 32 * u);
#pragma unroll 1
        for (int so = 0; so < D / 32; so += 4) {
            const int sn = (so + 4 < D / 32) ? so + 4 : so;
#pragma unroll
            for (int u = 0; u < 4; ++u) yn[u] = *(const u32x4*)(yrow + 32 * (sn + u));
#pragma unroll
            for (int u = 0; u < 4; ++u) { const int sI = so + u;
                wf[u & 1][0] = *(const LAS bf16x8*)(wrow + 64 * sI); wf[u & 1][1] = *(const LAS bf16x8*)(wrow + 16 * WPITCH + 64 * sI);
                wf[u & 1][2] = *(const LAS bf16x8*)(wrow + 32 * WPITCH + 64 * sI); wf[u & 1][3] = *(const LAS bf16x8*)(wrow + 48 * WPITCH + 64 * sI);
                const f32x4 g0 = *(const LAS f32x4*)(gl + 32 * sI), g1 = *(const LAS f32x4*)(gl + 32 * sI + 4), b0 = *(const LAS f32x4*)(bl + 32 * sI), b1 = *(const LAS f32x4*)(bl + 32 * sI + 4);
                asm volatile("" :: "v"(wf[(u + 1) & 1][0]), "v"(wf[(u + 1) & 1][1]), "v"(wf[(u + 1) & 1][2]), "v"(wf[(u + 1) & 1][3]) : "memory");
                f32x4 n0, n1;
                n0[0] = (bf_lo(yv[u].x) - mean) * rstd * g0[0] + b0[0]; n0[1] = (bf_hi(yv[u].x) - mean) * rstd * g0[1] + b0[1]; n0[2] = (bf_lo(yv[u].y) - mean) * rstd * g0[2] + b0[2]; n0[3] = (bf_hi(yv[u].y) - mean) * rstd * g0[3] + b0[3];
                n1[0] = (bf_lo(yv[u].z) - mean) * rstd * g1[0] + b1[0]; n1[1] = (bf_hi(yv[u].z) - mean) * rstd * g1[1] + b1[1]; n1[2] = (bf_lo(yv[u].w) - mean) * rstd * g1[2] + b1[2]; n1[3] = (bf_hi(yv[u].w) - mean) * rstd * g1[3] + b1[3];
                u32x4 xw; xw.x = cvt_pk_bf16(n0[0], n0[1]); xw.y = cvt_pk_bf16(n0[2], n0[3]); xw.z = cvt_pk_bf16(n1[0], n1[1]); xw.w = cvt_pk_bf16(n1[2], n1[3]);
                *(u32x4*)(xbrow + 32 * sI) = xw;
                { u32x2 q8; q8.x = pk4_fp8(clamp_fp8(n0[0] * SX), clamp_fp8(n0[1] * SX), clamp_fp8(n0[2] * SX), clamp_fp8(n0[3] * SX)); q8.y = pk4_fp8(clamp_fp8(n1[0] * SX), clamp_fp8(n1[1] * SX), clamp_fp8(n1[2] * SX), clamp_fp8(n1[3] * SX));
                  if (u & 1) *(u32x4*)(xqrow + 32 * (sI - 1 + (kq & 1)) - 8 * (kq & 1)) = pg8::pair16(q8prev, q8); else q8prev = q8; }
                const bf16x8 xh = __builtin_bit_cast(bf16x8, xw);
                acc[0] = __builtin_amdgcn_mfma_f32_16x16x32_bf16(wf[u & 1][0], xh, acc[0], 0, 0, 0); acc[1] = __builtin_amdgcn_mfma_f32_16x16x32_bf16(wf[u & 1][1], xh, acc[1], 0, 0, 0);
                acc[0] = __builtin_amdgcn_mfma_f32_16x16x32_bf16(wf[u & 1][2], xh, acc[0], 0, 0, 0); acc[1] = __builtin_amdgcn_mfma_f32_16x16x32_bf16(wf[u & 1][3], xh, acc[1], 0, 0, 0); }
#pragma unroll
            for (int u = 0; u < 4; ++u) yv[u] = yn[u];
        }
        float lg[8];
#pragma unroll
        for (int q = 0; q < 8; ++q) lg[q] = acc[q >> 2][q & 3] + rb[16 * (q >> 2) + 4 * kq + (q & 3)];
        unsigned taken = 0u; float tv[4]; int ti[4];
#pragma unroll
        for (int k = 0; k < 4; ++k) {
            float bv = -3.0e38f; int bi = 64;
#pragma unroll
            for (int q = 0; q < 8; ++q) { const bool free_ = ((taken >> q) & 1u) == 0u; if (free_ && lg[q] > bv) { bv = lg[q]; bi = 16 * (q >> 2) + 4 * kq + (q & 3); } }
            const int mybi = bi;
#pragma unroll
            for (int o = 16; o < 64; o <<= 1) { const float ov = __shfl_xor(bv, o); const int oi = __shfl_xor(bi, o); const bool keep = (bv > ov) || (bv == ov && bi < oi); bv = keep ? bv : ov; bi = keep ? bi : oi; }
            tv[k] = bv; ti[k] = bi;
            if (bi == mybi && ((bi >> 2) & 3) == kq) taken |= 1u << (4 * (bi >> 4) + (bi & 3));
        }
        float gk[4]; float gs = 0.f;
#pragma unroll
        for (int k = 0; k < 4; ++k) { gk[k] = __builtin_amdgcn_exp2f((tv[k] - tv[0]) * LOG2E); gs += gk[k]; }
        const float gi = 1.0f / gs;
        if (lane < 32) wcnt[lane] = 0;
        asm volatile("s_waitcnt lgkmcnt(0)" ::: "memory");
        const int e0 = (kq == 0) ? ti[0] : (kq == 1) ? ti[1] : (kq == 2) ? ti[2] : ti[3];
        const float g0 = ((kq == 0) ? gk[0] : (kq == 1) ? gk[1] : (kq == 2) ? gk[2] : gk[3]) * gi;
        int r0 = 0;
        if (valid) r0 = __hip_atomic_fetch_add(wcnt + e0, 1, __ATOMIC_RELAXED, __HIP_MEMORY_SCOPE_WORKGROUP);
        asm volatile("s_waitcnt lgkmcnt(0)" ::: "memory");
        __syncthreads();
        if (F.wave == 0 && lane < 32) { int c[NWAVES]; int tot = 0;
#pragma unroll
            for (int w = 0; w < NWAVES; ++w) { c[w] = *(LAS int*)(F.lds + WIMG + w * 256 + 4 * lane); tot += c[w]; }
            int b = 0; if (tot > 0) b = (int)__hip_atomic_fetch_add((unsigned*)(F.ctl + cw_ecnt + 64 * lane), (unsigned)tot, RLX_AGENT);
#pragma unroll
            for (int w = 0; w < NWAVES; ++w) { *(LAS int*)(F.lds + WIMG + w * 256 + 128 + 4 * lane) = b; b += c[w]; } }
        asm volatile("s_waitcnt vmcnt(0) lgkmcnt(0)" ::: "memory");
        __syncthreads();
        if (valid) { const int p0 = wbase[e0] + r0;
            petok[(size_t)e0 * NTOK + p0] = (t0 + j) * 4 + kq; pegate[(size_t)e0 * NTOK + p0] = g0; }
        asm volatile("s_waitcnt lgkmcnt(0)" ::: "memory");
        __syncthreads();
    }
}
__device__ __forceinline__ int moe_tables(Frame& F) {
    LAS int* cnt = (LAS int*)(F.lds + MOE_OFF); LAS int* fs = (LAS int*)(F.lds + MOE_OFF + 128); LAS unsigned char* te = F.lds + MOE_OFF + 128 + 136;
    __syncthreads();
    if (F.tid < NEXP) cnt[F.tid] = (int)__hip_atomic_load(F.ctl + CW_ECNT + 64 * F.tid, RLX_AGENT);
    __syncthreads();
    if (F.tid == 0) { int s = 0; for (int e = 0; e < NEXP; ++e) { fs[e] = s; s += (cnt[e] + 255) >> 8; } fs[NEXP] = s; }
    __syncthreads();
    const int T = fs[NEXP];
    for (int t = F.tid; t < T; t += NWAVES * 64) { int e = 0;
#pragma unroll 8
        for (int q = 1; q < NEXP; ++q) e += (fs[q] <= t) ? 1 : 0;
        te[t] = (unsigned char)e; }
    __syncthreads();
    return T;
}
__device__ __forceinline__ void p9_final(Frame& F, const float* gam, const float* bet, const float* out, float* outw, bool poison) {
    const bf16_t* X1B = (const bf16_t*)(F.ws + WS_X1B);
    const int gw = F.vcu * NWAVES + F.wave, NGW = F.G * NWAVES, lane = F.lane;
    const float qnan = __builtin_nanf("");
    f32x4 g[4], bb[4];
#pragma unroll
    for (int k = 0; k < 4; ++k) { g[k] = *(const f32x4*)(gam + 256 * k + 4 * lane); bb[k] = *(const f32x4*)(bet + 256 * k + 4 * lane); }
    for (int tok0 = gw; tok0 < NTOK; tok0 += 2 * NGW) {
        u32x2 xw[2][4]; unsigned yw[2][4][4];
#pragma unroll
        for (int tI = 0; tI < 2; ++tI) { const int tok = min(tok0 + tI * NGW, NTOK - 1);
            const unsigned char* y = (const unsigned char*)out + (size_t)tok * 4096 + lane * 4;
#pragma unroll
            for (int k = 0; k < 4; ++k) { xw[tI][k] = *(const u32x2*)(X1B + (size_t)tok * D + 256 * k + 4 * lane);
#pragma unroll
                for (int s = 0; s < 4; ++s) yw[tI][s][k] = *(const unsigned*)(y + 1024 * s + 256 * k); } }
#pragma unroll
        for (int tI = 0; tI < 2; ++tI) { const int tok = tok0 + tI * NGW; if (tok >= NTOK) break;
            float v[16];
#pragma unroll
            for (int k = 0; k < 4; ++k) {
                v[4 * k + 0] = DN_ALPHA * bf_lo(xw[tI][k].x); v[4 * k + 1] = DN_ALPHA * bf_hi(xw[tI][k].x); v[4 * k + 2] = DN_ALPHA * bf_lo(xw[tI][k].y); v[4 * k + 3] = DN_ALPHA * bf_hi(xw[tI][k].y);
                f32x2 lo = __builtin_amdgcn_cvt_pk_f32_fp8((int)yw[tI][0][k], false) + __builtin_amdgcn_cvt_pk_f32_fp8((int)yw[tI][1][k], false) + __builtin_amdgcn_cvt_pk_f32_fp8((int)yw[tI][2][k], false) + __builtin_amdgcn_cvt_pk_f32_fp8((int)yw[tI][3][k], false);
                f32x2 hi = __builtin_amdgcn_cvt_pk_f32_fp8((int)yw[tI][0][k], true) + __builtin_amdgcn_cvt_pk_f32_fp8((int)yw[tI][1][k], true) + __builtin_amdgcn_cvt_pk_f32_fp8((int)yw[tI][2][k], true) + __builtin_amdgcn_cvt_pk_f32_fp8((int)yw[tI][3][k], true);
                v[4 * k + 0] += lo[0] * (1.0f / SY); v[4 * k + 1] += lo[1] * (1.0f / SY); v[4 * k + 2] += hi[0] * (1.0f / SY); v[4 * k + 3] += hi[1] * (1.0f / SY); }
            float s = 0.f;
#pragma unroll
            for (int q = 0; q < 16; ++q) s += v[q];
            const float mean = wave_sum(s) * (1.0f / D); float s2 = 0.f;
#pragma unroll
            for (int q = 0; q < 16; ++q) { v[q] -= mean; s2 += v[q] * v[q]; }
            const float rstd = 1.0f / sqrtf(wave_sum(s2) * (1.0f / D) + LN_EPS);
            float* op = outw + (size_t)tok * D + 4 * lane;
#pragma unroll
            for (int k = 0; k < 4; ++k) { f32x4 o;
#pragma unroll
                for (int q = 0; q < 4; ++q) o[q] = v[4 * k + q] * rstd * g[k][q] + bb[k][q];
                if (poison) o = (f32x4){qnan, qnan, qnan, qnan};
                *(f32x4*)(op + 256 * k) = o; }
        }
    }
}
#define CAS __attribute__((address_space(4)))
__device__ __forceinline__ const float* arg_in(int i) {
    const unsigned char CAS* ka = (const unsigned char CAS*)__builtin_amdgcn_kernarg_segment_ptr();
    asm volatile("" : "+s"(ka));
    return *(const float* const CAS*)(ka + 8 * i);
}
struct Args { const float* in[18]; float* out; unsigned char* ws; int ph_lo, ph_hi; };
__global__ void __launch_bounds__(NWAVES * 64, 2) fwd_kernel(Args args) {
    extern __shared__ __attribute__((aligned(16))) unsigned char lds[];
    Frame F;
    F.lds = (LAS unsigned char*)lds;
    F.MISC = (volatile LAS unsigned*)(F.lds + MISC_OFF);
    F.tid = threadIdx.x; F.lane = F.tid & 63; F.wave = __builtin_amdgcn_readfirstlane(F.tid >> 6);
    F.G = gridDim.x; { const int bx = blockIdx.x; F.vcu = (F.G % 8 == 0) ? (bx % 8) * (F.G / 8) + bx / 8 : bx; }
    F.ws = args.ws; F.dout = (unsigned char*)args.out;
    F.ctl = (gu32*)(args.ws + WS_CTL);
    for (int u = F.tid; u < (LDS_BYTES - LDSCTL_OFF) / 4; u += NWAVES * 64) ((LAS unsigned*)(F.lds + LDSCTL_OFF))[u] = 0u;
    __syncthreads();
    XcdBarrier bar; bar.bar = (unsigned*)(F.ctl + CW_BAR); bar.x = 0; bar.st = nullptr;
    if (N_LAUNCHES == 1) bar = xcd_barrier_post((unsigned*)(F.ctl + CW_BAR), F.MISC + 8);
    const int lo = args.ph_lo, hi = args.ph_hi;
#ifdef ONLY_PHASE
#define IN(k) ((k) == ONLY_PHASE && lo <= (k) && (k) < hi)
#else
#define IN(k) (lo <= (k) && (k) < hi)
#endif
#define SEAM(k) do { if (IN(k) && IN((k) + 1)) xcd_barrier(bar); } while (0)
    unsigned char* HQ = F.ws + WS_HQ; unsigned char* SG = F.ws + WS_SG;

#define PHASE(k, ...) do { if (IN(k)) { __VA_ARGS__ if (DUP_PHASE == (k)) { __VA_ARGS__ } } } while (0)
    PHASE(0, p0_convert(F, arg_in(0), arg_in(1), arg_in(3), arg_in(4), arg_in(5), arg_in(8));); SEAM(0);
    PHASE(1,
        { const int gemm_wgs = (F.G == 256) ? 192 : F.G;
          if ((int)blockIdx.x < gemm_wgs) {
            pg8::Gemm g{(const char*)(F.dout + DO_XB), (const char*)(F.dout + DO_WIN), D, D, D / 128}; pg8::StaticOrder S; S.init(NTOK, IN_COLS, gemm_wgs, (int)blockIdx.x);
            pg8::EpiInProj E{HQ, SG, 1.0f / (SXIN * SW)};
            pg8::gemm_phase<pg8::EpiInProj, pg8::StaticOrder, true, false, true>(F.lds, g, S, E); }
          if (gemm_wgs == F.G) p3_convert_moe(F, arg_in(10), arg_in(12), arg_in(14), F.vcu, F.G);
          else if ((int)blockIdx.x >= gemm_wgs) p3_convert_moe(F, arg_in(10), arg_in(12), arg_in(14), (int)blockIdx.x - gemm_wgs, F.G - gemm_wgs); }
    ); SEAM(1);
    PHASE(2, p2_attention(F, arg_in(2));); SEAM(2);
    PHASE(3, p3_merge(F);); SEAM(3);
    PHASE(4,
        { pg8::Gemm g{(const char*)(F.dout + DO_OAB), (const char*)(F.dout + DO_WCAT), OAB_P, OAB_P, OAB_P / 128}; pg8::StaticOrder S; S.init(NTOK, D, F.G, (int)blockIdx.x);
        pg8::EpiGate E{SG, F.ws + WS_MRG};
        pg8::gemm_phase<pg8::EpiGate, pg8::StaticOrder, true, false, true>(F.lds, g, S, E); }
    ); SEAM(4);
    PHASE(5,
        { pg8::Gemm g{(const char*)(F.ws + WS_MRG), (const char*)(F.ws + WS_WOUT), D, D, D / 128}; pg8::StaticOrder S; S.init(NTOK, D, F.G, (int)blockIdx.x);
        pg8::EpiY E{arg_in(0), (bf16_t*)(F.ws + WS_Y), (float*)(F.ws + WS_STAT), 1.0f / (SM * SW)};
        pg8::gemm_phase<pg8::EpiY, pg8::StaticOrder, true, false, true>(F.lds, g, S, E); }
    ); SEAM(5);
    if (IN(6)) { if (DUP_PHASE == 6) p6_router(F, (const bf16_t*)(F.ws + WS_Y), (const float*)(F.ws + WS_STAT), arg_in(6), arg_in(7), (bf16_t*)(F.ws + 264 * MiB), F.ws + 330 * MiB, arg_in(9), CW_ECNT + 64 * NEXP, (size_t)362 * MiB - WS_PETOK);
        p6_router(F, (const bf16_t*)(F.ws + WS_Y), (const float*)(F.ws + WS_STAT), arg_in(6), arg_in(7), (bf16_t*)(F.ws + WS_X1B), F.ws + WS_X1Q, arg_in(9), CW_ECNT, 0); } SEAM(6);
    PHASE(7,
        { const int T = moe_tables(F);
        pg8::Gemm g{(const char*)(F.ws + WS_X1Q), (const char*)(F.ws + WS_WGU), D, D, D / 128};
        pg8::MoeOrder S{T, 8, F.G, (int)blockIdx.x, (const LAS int*)(F.lds + MOE_OFF), (const LAS int*)(F.lds + MOE_OFF + 128), (const LAS unsigned char*)(F.lds + MOE_OFF + 128 + 136),
                        (const int*)(F.ws + WS_PETOK), (size_t)2048 * D, true, (unsigned)D};
        pg8::EpiGU E{arg_in(11), arg_in(13), F.ws + WS_HDN, F.lds};
        pg8::gemm_phase<pg8::EpiGU, pg8::MoeOrder, true, true, true>(F.lds, g, S, E); }
    ); SEAM(7);
    PHASE(8,
        { const int T = moe_tables(F);
        pg8::Gemm g{(const char*)(F.ws + WS_HDN), (const char*)(F.ws + WS_WD), DFF, DFF, DFF / 128};
        pg8::MoeOrder S{T, 4, F.G, (int)blockIdx.x, (const LAS int*)(F.lds + MOE_OFF), (const LAS int*)(F.lds + MOE_OFF + 128), (const LAS unsigned char*)(F.lds + MOE_OFF + 128 + 136),
                        (const int*)(F.ws + WS_PETOK), (size_t)D * DFF, false, 0u};
        pg8::EpiDown E{arg_in(15), (const int*)(F.ws + WS_PETOK), (const float*)(F.ws + WS_PEGATE), F.dout, F.lds};
        pg8::gemm_phase<pg8::EpiDown, pg8::MoeOrder, true, false, true>(F.lds, g, S, E); }
    ); SEAM(8);
    if (IN(9)) {
        bool poison = (__hip_atomic_load(F.ctl + CW_TMO, RLX_AGENT) != 0u) || (__hip_atomic_load(F.ctl + CW_BAR + XB_TMO, RLX_AGENT) != 0u);
        if (DUP_PHASE == 9) p9_final(F, arg_in(16), arg_in(17), (const float*)F.dout, (float*)(F.ws + 194 * MiB), poison);
        p9_final(F, arg_in(16), arg_in(17), (const float*)F.dout, (float*)F.dout, poison);
    }
#undef PHASE
#undef IN
#undef SEAM
}

extern "C" void kernel_launch(void* const* d_in, const int* in_sizes, int n_in, void* d_out, int out_size, void* d_ws, size_t ws_size, hipStream_t stream) {
    static int grid = 0;
    if (grid == 0) {
        if (n_in != 18 || in_sizes[0] != NTOK * D || out_size != NTOK * D || ws_size < WS_END) { fprintf(stderr, "kernel_launch: unexpected shapes (n_in %d, ws %zu); nothing launched\n", n_in, ws_size); grid = -1; return; }
        int dev = 0, cus = 0, per_cu = 0;
        if (hipGetDevice(&dev) != hipSuccess || hipDeviceGetAttribute(&cus, hipDeviceAttributeMultiprocessorCount, dev) != hipSuccess) { grid = -1; return; }
        if (hipFuncSetAttribute((const void*)fwd_kernel, hipFuncAttributeMaxDynamicSharedMemorySize, LDS_BYTES) != hipSuccess) { fprintf(stderr, "kernel_launch: hipFuncSetAttribute failed\n"); grid = -1; return; }
        if (hipOccupancyMaxActiveBlocksPerMultiprocessor(&per_cu, (const void*)fwd_kernel, NWAVES * 64, LDS_BYTES) != hipSuccess || per_cu < 1) fprintf(stderr, "kernel_launch: occupancy query reports %d\n", per_cu);
        (void)hipGetLastError();
        grid = cus;
    }
    if (grid < 0) return;
    if (hipMemsetAsync((char*)d_ws + WS_CTL, 0, CTL_ZERO_BYTES, stream) != hipSuccess) return;
    Args a{};
    for (int i = 0; i < 18; ++i) a.in[i] = (const float*)d_in[i];
    a.out = (float*)d_out; a.ws = (unsigned char*)d_ws;
    if (N_LAUNCHES == 1) { a.ph_lo = 0; a.ph_hi = N_PHASES; hipLaunchKernelGGL(fwd_kernel, dim3(grid), dim3(NWAVES * 64), LDS_BYTES, stream, a); }
    else for (int p = 0; p < N_PHASES; ++p) { a.ph_lo = p; a.ph_hi = p + 1; hipLaunchKernelGGL(fwd_kernel, dim3(grid), dim3(NWAVES * 64), LDS_BYTES, stream, a); }
}
```

```cpp
#include <hip/hip_runtime.h>
#include <cstdio>
#include <cstdint>

#define GAS __attribute__((address_space(1)))
#define LAS __attribute__((address_space(3)))
typedef unsigned short bf16_t;
typedef short bf16x8 __attribute__((ext_vector_type(8)));
typedef short s16x4 __attribute__((ext_vector_type(4)));
typedef float f32x2 __attribute__((ext_vector_type(2)));
typedef float f32x4 __attribute__((ext_vector_type(4)));
typedef float f32x16 __attribute__((ext_vector_type(16)));
typedef unsigned u32x2 __attribute__((ext_vector_type(2)));
typedef unsigned u32x4 __attribute__((ext_vector_type(4)));
typedef GAS unsigned gu32;

#ifndef MK_N_LAUNCHES
#define MK_N_LAUNCHES 1
#endif
#ifndef DUP_PHASE
#define DUP_PHASE -1
#endif
constexpr int N_PHASES = 10;
constexpr int N_LAUNCHES = MK_N_LAUNCHES;

constexpr int NB = 8, SEQ = 4096, D = 1024, NTOK = NB * SEQ;
constexpr int HQ_P = 3584;
constexpr int SG_P = 2048;
constexpr int OAB_P = 1280;
constexpr int IN_COLS = 5632;
constexpr int NEXP = 32, TOPK = 4, DFF = 1024;
constexpr int MAX_MT = 544;
constexpr float LN_EPS = 1e-5f;
constexpr float DN_ALPHA = 1.189207115002721f;
constexpr float LOG2E = 1.4426950408889634f, LN2 = 0.6931471805599453f;
constexpr float QSCALE = 0.125f * LOG2E;
constexpr float NEG_BIG = -1e30f;

constexpr size_t MiB = 1u << 20;
constexpr size_t WS_CTL = 0, CTL_ZERO_BYTES = 1 * MiB;
constexpr size_t WS_XBUF = 1 * MiB;
constexpr size_t WS_Y = 194 * MiB;
constexpr size_t WS_STAT = 258 * MiB;
constexpr size_t WS_HQ = 2 * MiB;
constexpr size_t HQ_QD = 0, HQ_KD = 48 * MiB, HQ_VD = 96 * MiB, HQ_QS = 144 * MiB, HQ_KS = 208 * MiB, HQ_VS = 216 * MiB;
constexpr size_t WS_WGU = 404 * MiB;
constexpr size_t WS_WD = 468 * MiB;
constexpr size_t WS_X1B = 98 * MiB;
constexpr size_t WS_X1Q = 162 * MiB;
constexpr size_t WS_HDN = 194 * MiB;
constexpr size_t WS_SG = 226 * MiB;
constexpr size_t WS_YS23 = 330 * MiB;
constexpr size_t WS_OAG = 354 * MiB;
constexpr size_t WS_LSE = 402 * MiB;
constexpr size_t WS_MRG = 2 * MiB;
constexpr size_t WS_WOUT = 530 * MiB;
constexpr size_t WS_PETOK = 532 * MiB;
constexpr size_t WS_PEGATE = 536 * MiB;
constexpr size_t WS_WRT = 540 * MiB;
constexpr size_t WS_END = 540 * MiB + 256 * 1024;
constexpr float SX = 8.0f, SW = 512.0f, SH = 4.0f, SXIN = 8.0f, SY = 64.0f, SM = 64.0f, SO = 64.0f, SSG = 256.0f, SQ = 64.0f, SK = 16.0f;
static_assert(WS_HQ + (size_t)NTOK * HQ_P * 2 <= WS_SG && WS_SG + (size_t)NTOK * SG_P <= WS_OAG && WS_OAG + (size_t)3 * NTOK * 256 * 2 <= WS_LSE && WS_LSE + (size_t)3 * NTOK * 4 * 4 <= WS_WGU, "ws map 1");
static_assert(WS_WGU + (size_t)NEXP * 2048 * D <= WS_WD && WS_WD + (size_t)NEXP * D * DFF <= WS_WOUT && WS_MRG + (size_t)NTOK * D <= WS_X1B && WS_X1B + (size_t)NTOK * D * 2 <= WS_X1Q && WS_X1Q + (size_t)NTOK * D <= WS_HDN, "ws map 2");
static_assert(WS_HDN + (size_t)MAX_MT * 256 * DFF <= WS_OAG && WS_WOUT + (size_t)D * D <= WS_PETOK, "ws map 3");
constexpr size_t DO_XB = 0;
constexpr size_t DO_OAB = 0;
constexpr size_t DO_WIN = 96 * MiB;
constexpr size_t DO_WCAT = 108 * MiB;
constexpr int CW_TMO = 0, CW_CODE = 1;
constexpr int CW_BAR = 4096;
constexpr int CW_SEAM = 16384;
constexpr int CW_ECNT = 32768;
static_assert((CW_ECNT + 2 * 64 * NEXP) * 4 <= (int)CTL_ZERO_BYTES, "CTL words inside the memset region");

constexpr int RING_BYTES = 131072;
constexpr int SCR_BYTES = 143360;
constexpr int LDSCTL_OFF = SCR_BYTES;
constexpr int MISC_OFF = LDSCTL_OFF + 320;
constexpr int MOE_OFF = LDSCTL_OFF + 512;
constexpr int LDS_BYTES = 147456;
static_assert(MOE_OFF + 128 + 136 + MAX_MT <= LDS_BYTES, "LDS map");

#define RLX_AGENT __ATOMIC_RELAXED, __HIP_MEMORY_SCOPE_AGENT
#define LDS_WAIT() asm volatile("s_waitcnt lgkmcnt(0)" ::: "memory")
#define VM_WAIT() asm volatile("s_waitcnt vmcnt(0)" ::: "memory")

__device__ __forceinline__ unsigned cvt_pk_bf16(float lo, float hi) { unsigned r; asm volatile("v_cvt_pk_bf16_f32 %0, %1, %2" : "=v"(r) : "v"(lo), "v"(hi)); return r; }
__device__ __forceinline__ int opaque(int v) { asm volatile("" : "+v"(v)); return v; }
__device__ __forceinline__ unsigned pk4_fp8(float a, float b, float c, float d) { int w = 0; w = __builtin_amdgcn_cvt_pk_fp8_f32(a, b, w, false); w = __builtin_amdgcn_cvt_pk_fp8_f32(c, d, w, true); return (unsigned)w; }
__device__ __forceinline__ unsigned f2e4m3_sw(float x) {
    const float a = __builtin_amdgcn_fmed3f(fabsf(x), 9.5367431640625e-07f, 448.f);
    const int e1 = max(__builtin_amdgcn_frexp_expf(a), -5);
    const unsigned m = (unsigned)__builtin_rintf(__builtin_amdgcn_ldexpf(a, 4 - e1));
    return ((__float_as_uint(x) >> 24) & 0x80u) | (unsigned)((e1 << 3) + 40 + (int)m); }
__device__ __forceinline__ unsigned pk4_fp8_pad(float a, float b, float c, float d) {
    unsigned w;
    asm("v_cvt_pk_fp8_f32 %0, %1, %2\n\ts_nop 1" : "=v"(w) : "v"(a), "v"(b));
    asm("v_cvt_pk_fp8_f32 %0, %1, %2 op_sel:[0,0,1]\n\ts_nop 1" : "+v"(w) : "v"(c), "v"(d));
    return w; }
__device__ __forceinline__ float clamp_fp8(float v) { return __builtin_amdgcn_fmed3f(v, -448.0f, 448.0f); }
__device__ __forceinline__ float bf_lo(unsigned w) { return __uint_as_float(w << 16); }
__device__ __forceinline__ float bf_hi(unsigned w) { return __uint_as_float(w & 0xffff0000u); }
__device__ __forceinline__ float fast_sigmoid(float g) { g = fminf(fmaxf(g, -60.f), 60.f); return __builtin_amdgcn_rcpf(1.0f + __builtin_amdgcn_exp2f(-g * LOG2E)); }

namespace pg8 {
constexpr int BM = 256, BK = 64, HALF = 128, HTB = HALF * BK * 2, STAGE_BYTES = 8 * HTB, NXCD = 8, WGM = 8;
constexpr int EPRE_OFF = STAGE_BYTES;
static_assert(EPRE_OFF + 3072 <= SCR_BYTES, "epilogue prefetch area");
__host__ __device__ __forceinline__ int lds_byte(int r, int c) { const int st = (r >> 4) * 2 + (c >> 5), rr = r & 15, cc = c & 31, ob = rr * 64 + cc * 2; return st * 1024 + (ob ^ (((ob >> 9) & 1) << 5)); }
__host__ __device__ __forceinline__ void stage_rc(int b, int& R, int& C) { const int st = b / 1024, sb = b % 1024, swz = sb ^ (((sb >> 9) & 1) << 5); R = (st >> 1) * 16 + swz / 64; C = (st & 1) * 32 + (swz % 64) / 2; }
__host__ __device__ __forceinline__ int perm32(int rho) { const int n = rho >> 4, i = rho & 15; return 8 * (i >> 2) + 4 * n + (i & 3); }

struct Unit { int pm, pn, e, ti, valid; };
struct Gemm { const char* A; const char* Bt; int lda, ldb, nt; };

__device__ __forceinline__ bool tile_of(long L, int nM, int nN, int& pm, int& pn) {
    const int nwg = nM * nN; if (L >= nwg) return false;
    int wgid = (int)L; { const int q = nwg / NXCD, r = nwg % NXCD, xcd = wgid % NXCD, off = wgid / NXCD; wgid = (xcd < r ? xcd * (q + 1) : r * (q + 1) + (xcd - r) * q) + off; }
    const int nig = WGM * nN, gid = wgid / nig, fm = gid * WGM, gsz = (nM - fm) < WGM ? (nM - fm) : WGM;
    pm = fm + ((wgid % nig) % gsz); pn = (wgid % nig) / gsz; return true;
}
struct StaticOrder {
    int nM, nN, G, c;
    __device__ __forceinline__ void init(int M, int N, int G_, int c_) { nM = M / BM; nN = N / BM; G = G_; c = c_; }
    __device__ __forceinline__ bool next(int i, Unit& u) const { u.e = 0; u.ti = 0; u.valid = 256; return tile_of((long)i * G + c, nM, nN, u.pm, u.pn); }
    __device__ __forceinline__ const char* a_ptr(const Gemm& g, const Unit& u) const { return g.A + (size_t)u.pm * 256 * g.lda; }
    __device__ __forceinline__ const char* b_ptr(const Gemm& g, const Unit& u) const { return g.Bt + (size_t)u.pn * 256 * g.ldb; }
    __device__ __forceinline__ unsigned row_off(const Unit&, int) const { return 0u; }
};
struct MoeOrder {
    int T, nN, G, c; const LAS int* cnt; const LAS int* fs; const LAS unsigned char* te;
    const int* petok; size_t b_exp_stride; bool gather; unsigned rowbytes;
    __device__ __forceinline__ bool next(int i, Unit& u) const {
        if (!tile_of((long)i * G + c, T, nN, u.pm, u.pn)) return false;
        u.e = __builtin_amdgcn_readfirstlane((int)te[u.pm]); u.ti = u.pm - __builtin_amdgcn_readfirstlane(fs[u.e]); const int left = __builtin_amdgcn_readfirstlane(cnt[u.e]) - u.ti * 256; u.valid = left < 256 ? left : 256; return true;
    }
    __device__ __forceinline__ const char* a_ptr(const Gemm& g, const Unit& u) const { return gather ? g.A : g.A + (size_t)u.pm * 256 * g.lda; }
    __device__ __forceinline__ const char* b_ptr(const Gemm& g, const Unit& u) const { return g.Bt + (size_t)u.e * b_exp_stride + (size_t)u.pn * 256 * g.ldb; }
    __device__ __forceinline__ unsigned row_off(const Unit& u, int R) const {
        int tok = 0; if (R < u.valid) tok = petok[(size_t)u.e * NTOK + u.ti * 256 + R] >> 2;
        return (unsigned)tok * rowbytes;
    }
};

typedef int v8i32 __attribute__((ext_vector_type(8)));
template <class Epi, class Sched, bool ALIGN_EPI, bool GATHER, bool F8 = false>
__device__ __forceinline__ void gemm_phase(LAS unsigned char* lds, const Gemm g, const Sched& S, const Epi& E) {
    const int tid = threadIdx.x, wid = __builtin_amdgcn_readfirstlane(tid >> 6), lane = tid & 63, wr = wid >> 2, wc = wid & 3, fr = lane & 15, fq = lane >> 4;
    const int nt = g.nt;
    unsigned voffA[2], voffB[2]; int RA[2], CA2[2];
#pragma unroll
    for (int i = 0; i < 2; ++i) { int R, C; stage_rc(tid * 16 + i * 8192, R, C); const int Rb = Epi::PERM ? ((R & ~31) + perm32(R & 31)) : R;
        voffA[i] = (unsigned)(R * g.lda + C * 2); voffB[i] = (unsigned)(Rb * g.ldb + C * 2); RA[i] = R; CA2[i] = C * 2; }
    const size_t kstep = (size_t)(BK * 2);
    const size_t hstepA = (size_t)HALF * g.lda, hstepB = (size_t)HALF * g.ldb;
    const unsigned ldsw = (unsigned)wid * 1024u;
    const int aoff = lds_byte(wr * 64 + fr, fq * 8), boff = lds_byte(wc * 32 + fr, fq * 8);
    const int aoff0 = aoff, boff0 = boff, aoff1 = aoff + 1024, boff1 = boff + 1024;
#define PG8_SA(b, h) (((b) * 2 + (h)) * HTB)
#define PG8_SB(b, h) ((4 + (b) * 2 + (h)) * HTB)
#define PG8_STAGE(bufoff, gbase, voff) do { _Pragma("unroll") for (int _i = 0; _i < 2; ++_i) \
        __builtin_amdgcn_global_load_lds((const unsigned*)((const char*)(gbase) + (voff)[_i]), (LAS unsigned*)(lds + (bufoff) + ldsw + _i * 8192), 16, 0, 0); } while (0)
#define PG8_STAGE_A(bufoff, kp, h, nx) do { if constexpr (GATHER) { unsigned _v[2]; _v[0] = (nx) ? gN[h][0] : gC[h][0]; _v[1] = (nx) ? gN[h][1] : gC[h][1]; PG8_STAGE(bufoff, kp, _v); } \
        else { PG8_STAGE(bufoff, (kp) + (h) * hstepA, voffA); } } while (0)
#define PG8_LDA(dst, b, h) do { _Pragma("unroll") for (int m = 0; m < 4; ++m) _Pragma("unroll") for (int k = 0; k < 2; ++k) dst[m][k] = *(const LAS bf16x8*)(lds + PG8_SA(b, h) + (k ? aoff1 : aoff0) + m * 2048); } while (0)
#define PG8_LDB(dst, b, h) do { _Pragma("unroll") for (int n = 0; n < 2; ++n) _Pragma("unroll") for (int k = 0; k < 2; ++k) dst[n][k] = *(const LAS bf16x8*)(lds + PG8_SB(b, h) + (k ? boff1 : boff0) + n * 2048); } while (0)
#define PG8_F8OP(X) __builtin_bit_cast(v8i32, __builtin_shufflevector(X[0], X[1], 0, 1, 2, 3, 4, 5, 6, 7, 8, 9, 10, 11, 12, 13, 14, 15))
#define PG8_MMA(ai, bj, At, Bt) do { __builtin_amdgcn_s_setprio(1); if constexpr (F8) { _Pragma("unroll") for (int m = 0; m < 4; ++m) _Pragma("unroll") for (int n = 0; n < 2; ++n) \
        asm volatile("v_mfma_scale_f32_16x16x128_f8f6f4 %0, %1, %2, %0, %3, %3 op_sel_hi:[0,0,0]" : "+v"(acc[ai][bj][m][n]) : "v"(PG8_F8OP(Bt[n])), "v"(PG8_F8OP(At[m])), "v"(one_scale)); } \
        else { _Pragma("unroll") for (int m = 0; m < 4; ++m) _Pragma("unroll") for (int n = 0; n < 2; ++n) _Pragma("unroll") for (int k = 0; k < 2; ++k) \
        acc[ai][bj][m][n] = __builtin_amdgcn_mfma_f32_16x16x32_bf16(Bt[n][k], At[m][k], acc[ai][bj][m][n], 0, 0, 0); } __builtin_amdgcn_s_setprio(0); } while (0)
#define PG8_WAIT_V(n) asm volatile("s_waitcnt vmcnt(" #n ")" ::: "memory")
#define PG8_WAIT_L(n) asm volatile("s_waitcnt lgkmcnt(" #n ")" ::: "memory")
#define PG8_BAR __builtin_amdgcn_s_barrier()
#define PG8_SCHED __builtin_amdgcn_sched_barrier(0)
    Unit cur, nxt; int ui = 0;
    if (!S.next(0, cur)) return;
    int one_scale = 0x7f7f7f7f; if constexpr (F8) asm volatile("" : "+v"(one_scale));
    unsigned gC[2][2], gN[2][2];
#pragma unroll
    for (int h = 0; h < 2; ++h)
#pragma unroll
        for (int i = 0; i < 2; ++i) { gC[h][i] = GATHER ? S.row_off(cur, h * HALF + RA[i]) + (unsigned)CA2[i] : 0u; gN[h][i] = gC[h][i]; }
    f32x4 acc[2][2][4][2];
#pragma unroll
    for (int a = 0; a < 2; ++a)
#pragma unroll
        for (int b = 0; b < 2; ++b)
#pragma unroll
            for (int m = 0; m < 4; ++m)
#pragma unroll
                for (int n = 0; n < 2; ++n) acc[a][b][m][n] = (f32x4){0.f, 0.f, 0.f, 0.f};
    bf16x8 At[4][2], B0[2][2], B1[2][2];
    const char* cA = S.a_ptr(g, cur); const char* cB = S.b_ptr(g, cur);
    PG8_STAGE(PG8_SB(0, 0), cB, voffB); PG8_STAGE(PG8_SB(0, 1), cB + hstepB, voffB); PG8_STAGE_A(PG8_SA(0, 0), cA, 0, false); PG8_STAGE_A(PG8_SA(0, 1), cA, 1, false);
    if (wr == 1) PG8_BAR;
    PG8_WAIT_V(2); PG8_BAR;
    PG8_STAGE(PG8_SB(1, 0), cB + kstep, voffB); PG8_STAGE_A(PG8_SA(1, 0), cA + kstep, 0, false); PG8_STAGE(PG8_SB(1, 1), cB + hstepB + kstep, voffB);
    PG8_WAIT_V(6); PG8_BAR;
    for (;;) {
        const bool has_next = S.next(ui + 1, nxt);
        const char* nA = has_next ? S.a_ptr(g, nxt) : cA; const char* nB = has_next ? S.b_ptr(g, nxt) : cB;
        if constexpr (GATHER) { if (has_next) {
#pragma unroll
            for (int h = 0; h < 2; ++h)
#pragma unroll
                for (int i = 0; i < 2; ++i) gN[h][i] = S.row_off(nxt, h * HALF + RA[i]) + (unsigned)CA2[i]; } }
#pragma unroll 1
        for (int t = 0; t < nt; t += 2) {
            const bool last = (t == nt - 2);
            asm volatile("" : "+v"(voffA[0]), "+v"(voffA[1]), "+v"(voffB[0]), "+v"(voffB[1]));
            if constexpr (Epi::HAS_MID) { if (t == Epi::MID_T) E.mid(acc, cur, wr, wc, fr, fq); }
            if constexpr (Epi::HAS_PRE) { if (last) E.pre(lds, cur, wid, lane); }
            const char* a1 = cA + (size_t)(t + 1) * kstep;
            const char* a2 = last ? nA : cA + (size_t)(t + 2) * kstep; const char* b2 = last ? nB : cB + (size_t)(t + 2) * kstep;
            const char* a3 = a2 + kstep; const char* b3 = b2 + kstep;
            PG8_LDB(B0, 0, 0); PG8_LDB(B1, 0, 1); PG8_SCHED; PG8_LDA(At, 0, 0); PG8_STAGE_A(PG8_SA(1, 1), a1, 1, false);
            PG8_WAIT_V(8); PG8_WAIT_L(0); PG8_BAR; PG8_MMA(0, 0, At, B0); PG8_MMA(0, 1, At, B1); PG8_BAR; PG8_SCHED;
            PG8_LDA(At, 0, 1); PG8_STAGE(PG8_SB(0, 0), b2, voffB); PG8_STAGE(PG8_SB(0, 1), b2 + hstepB, voffB); PG8_STAGE_A(PG8_SA(0, 0), a2, 0, last);
            PG8_WAIT_V(8); PG8_WAIT_L(0); PG8_BAR; PG8_MMA(1, 0, At, B0); PG8_MMA(1, 1, At, B1); PG8_BAR; PG8_SCHED;
            PG8_LDB(B0, 1, 0); PG8_LDB(B1, 1, 1); PG8_SCHED; PG8_LDA(At, 1, 0); PG8_STAGE_A(PG8_SA(0, 1), a2, 1, last);
            PG8_WAIT_V(8); PG8_WAIT_L(0); PG8_BAR; PG8_MMA(0, 0, At, B0); PG8_MMA(0, 1, At, B1); PG8_BAR; PG8_SCHED;
            PG8_LDA(At, 1, 1); PG8_STAGE(PG8_SB(1, 0), b3, voffB); PG8_STAGE(PG8_SB(1, 1), b3 + hstepB, voffB); PG8_STAGE_A(PG8_SA(1, 0), a3, 0, last);
            PG8_WAIT_V(8); PG8_WAIT_L(0); PG8_BAR; PG8_MMA(1, 0, At, B0); PG8_MMA(1, 1, At, B1); PG8_BAR; PG8_SCHED;
        }
        if constexpr (ALIGN_EPI) { if (wr == 0) PG8_BAR; }
        if constexpr (F8) asm volatile("s_nop 15\n\ts_nop 15" ::: "memory");
        if constexpr (!Epi::AFTER_DRAIN) { E(acc, cur, wr, wc, fr, fq); }
        if (!has_next) break;
#pragma unroll
        for (int a = 0; a < 2; ++a)
#pragma unroll
            for (int b = 0; b < 2; ++b)
#pragma unroll
                for (int m = 0; m < 4; ++m)
#pragma unroll
                    for (int n = 0; n < 2; ++n) acc[a][b][m][n] = (f32x4){0.f, 0.f, 0.f, 0.f};
        cur = nxt; cA = nA; cB = nB; ++ui;
#pragma unroll
        for (int h = 0; h < 2; ++h)
#pragma unroll
            for (int i = 0; i < 2; ++i) gC[h][i] = gN[h][i];
        if constexpr (ALIGN_EPI) { if (wr == 1) PG8_BAR; }
    }
    PG8_WAIT_V(0);
    if constexpr (!ALIGN_EPI) { if (wr == 0) PG8_BAR; }
    PG8_BAR;
    if constexpr (Epi::AFTER_DRAIN) { E.fused(acc, cur, wr, wc, fr, fq, lds, wid, lane); }
#undef PG8_SA
#undef PG8_SB
#undef PG8_STAGE
#undef PG8_STAGE_A
#undef PG8_LDA
#undef PG8_LDB
#undef PG8_MMA
#undef PG8_F8OP
#undef PG8_WAIT_V
#undef PG8_WAIT_L
#undef PG8_BAR
#undef PG8_SCHED
}
}

namespace pg8 {
__device__ __forceinline__ u32x4 pair16(u32x2 x, u32x2 y) {
    const auto sx = __builtin_amdgcn_permlane16_swap(x.x, y.x, false, false), sy = __builtin_amdgcn_permlane16_swap(x.y, y.y, false, false);
    u32x4 o; o.x = sx[0]; o.y = sy[0]; o.z = sx[1]; o.w = sy[1]; return o; }
__device__ __forceinline__ void unpair16(u32x4 v, u32x2& x, u32x2& y) {
    const auto sx = __builtin_amdgcn_permlane16_swap(v.x, v.z, false, false), sy = __builtin_amdgcn_permlane16_swap(v.y, v.w, false, false);
    x.x = sx[0]; x.y = sy[0]; y.x = sx[1]; y.y = sy[1]; }
struct EpiInProj {
    static constexpr bool PERM = true, AFTER_DRAIN = false, HAS_MID = false, HAS_PRE = false; static constexpr int MID_T = 0;
    unsigned char* HQ; unsigned char* SG; float rs;
    __device__ __forceinline__ void mid(f32x4 (&)[2][2][4][2], const Unit&, int, int, int, int) const {}
    __device__ __forceinline__ void operator()(const f32x4 (&acc)[2][2][4][2], const Unit& u, int wr, int wc, int fr, int fq) const {
        const int pn = u.pn, b = (u.pm * BM) >> 12, t0 = (u.pm * BM) & (SEQ - 1), lr = wr * 64 + opaque(fr), fqo = fq & 1;
        const int dcol = (wc & 1) * 32 + 8 * fq;
        if (pn >= 14) {
            const float nrl = -rs * LOG2E;
            unsigned char* ub = SG + (size_t)(u.pm * BM) * SG_P + (pn - 14) * 256;
            const unsigned vo = (unsigned)(lr * SG_P + wc * 32 + 8 * fq + (fqo ? HALF - 8 : 0));
#pragma unroll
            for (int ai = 0; ai < 2; ++ai)
#pragma unroll
                for (int m = 0; m < 4; ++m) { u32x2 w8[2];
#pragma unroll
                    for (int bj = 0; bj < 2; ++bj) { f32x4 v0 = acc[ai][bj][m][0], v1 = acc[ai][bj][m][1];
#pragma unroll
                        for (int q = 0; q < 4; ++q) {
                            v0[q] = fmaxf(__builtin_amdgcn_rcpf(__builtin_fmaf(__builtin_amdgcn_exp2f(v0[q] * nrl), 1.0f / SSG, 1.0f / SSG)), 0.001953125f);
                            v1[q] = fmaxf(__builtin_amdgcn_rcpf(__builtin_fmaf(__builtin_amdgcn_exp2f(v1[q] * nrl), 1.0f / SSG, 1.0f / SSG)), 0.001953125f); }
                        w8[bj].x = pk4_fp8(v0[0], v0[1], v0[2], v0[3]); w8[bj].y = pk4_fp8(v1[0], v1[1], v1[2], v1[3]); }
                    *(u32x4*)(ub + (vo + (unsigned)((ai * HALF + m * 16) * SG_P))) = pair16(w8[0], w8[1]); }
        } else if (pn < 6 || (pn >= 9 && pn < 13)) {
            const bool dilated = pn < 9; const int ty = dilated ? pn / 3 : 0, g = dilated ? pn - 3 * ty : 0, sh = 2 * g;
            const float qk = rs * ((pn >= 3 && pn < 6) ? SK : QSCALE * SQ);
            unsigned char* ub = dilated ? HQ + (size_t)ty * (48 * MiB) + (size_t)((g * NB + b) * 4) * SEQ * 64 : HQ + HQ_QS + (size_t)(b * 16 + (pn - 9) * 4) * SEQ * 64;
            const int hl = (wc >> 1) + 2 * fqo;
            const unsigned vo = (unsigned)(hl * SEQ * 64 + dcol - 8 * fqo); const int tl = t0 + lr, msk = (1 << sh) - 1;
#pragma unroll
            for (int ai = 0; ai < 2; ++ai)
#pragma unroll
                for (int m = 0; m < 4; ++m) { u32x2 w8[2];
#pragma unroll
                    for (int bj = 0; bj < 2; ++bj) { const f32x4 v0 = acc[ai][bj][m][0] * qk, v1 = acc[ai][bj][m][1] * qk;
                        w8[bj].x = pk4_fp8(clamp_fp8(v0[0]), clamp_fp8(v0[1]), clamp_fp8(v0[2]), clamp_fp8(v0[3])); w8[bj].y = pk4_fp8(clamp_fp8(v1[0]), clamp_fp8(v1[1]), clamp_fp8(v1[2]), clamp_fp8(v1[3])); }
                    const int t = tl + ai * HALF + m * 16, pos = ((t & msk) << (12 - sh)) + (t >> sh);
                    *(u32x4*)(ub + (vo + (unsigned)(pos * 64))) = pair16(w8[0], w8[1]); }
        } else if (pn < 9) {
            const int g = pn - 6, sh = 2 * g, tl = t0 + lr, msk = (1 << sh) - 1;
            unsigned char* ub = HQ + (size_t)2 * (48 * MiB) + (size_t)((g * NB + b) * 4) * SEQ * 128;
#pragma unroll
            for (int ai = 0; ai < 2; ++ai)
#pragma unroll
                for (int m = 0; m < 4; ++m) { const int t = tl + ai * HALF + m * 16, pos = ((t & msk) << (12 - sh)) + (t >> sh);
#pragma unroll
                    for (int bj = 0; bj < 2; ++bj) { const f32x4 v0 = acc[ai][bj][m][0] * rs, v1 = acc[ai][bj][m][1] * rs; const int hl = bj * 2 + (wc >> 1);
                        u32x4 w; w.x = cvt_pk_bf16(v0[0], v0[1]); w.y = cvt_pk_bf16(v0[2], v0[3]); w.z = cvt_pk_bf16(v1[0], v1[1]); w.w = cvt_pk_bf16(v1[2], v1[3]);
                        *(u32x4*)(ub + (unsigned)((hl * SEQ + pos) * 128 + dcol * 2)) = w; } }
        } else {
            unsigned char* ubk = HQ + HQ_KS + (size_t)(b * 2) * SEQ * 64; unsigned char* ubv = HQ + HQ_VS + (size_t)(b * 2) * SEQ * 128;
            const int tl = t0 + lr; const float qk = rs * SK;
#pragma unroll
            for (int ai = 0; ai < 2; ++ai)
#pragma unroll
                for (int m = 0; m < 4; ++m) { const int ri = (wc >> 1) * SEQ + tl + ai * HALF + m * 16;
                    { const f32x4 v0 = acc[ai][0][m][0] * qk, v1 = acc[ai][0][m][1] * qk; u32x2 w8;
                      w8.x = pk4_fp8(clamp_fp8(v0[0]), clamp_fp8(v0[1]), clamp_fp8(v0[2]), clamp_fp8(v0[3])); w8.y = pk4_fp8(clamp_fp8(v1[0]), clamp_fp8(v1[1]), clamp_fp8(v1[2]), clamp_fp8(v1[3]));
                      *(u32x2*)(ubk + (unsigned)(ri * 64 + dcol)) = w8; }
                    { const f32x4 v0 = acc[ai][1][m][0] * rs, v1 = acc[ai][1][m][1] * rs;
                      u32x4 w; w.x = cvt_pk_bf16(v0[0], v0[1]); w.y = cvt_pk_bf16(v0[2], v0[3]); w.z = cvt_pk_bf16(v1[0], v1[1]); w.w = cvt_pk_bf16(v1[2], v1[3]);
                      *(u32x4*)(ubv + (unsigned)(ri * 128 + dcol * 2)) = w; } }
        }
    }
};
struct EpiGate {
    static constexpr bool PERM = true, AFTER_DRAIN = false, HAS_MID = true, HAS_PRE = false; static constexpr int MID_T = 2;
    const unsigned char* __restrict__ SG; unsigned char* __restrict__ O;
    __device__ __forceinline__ void mid(f32x4 (&acc)[2][2][4][2], const Unit& u, int wr, int wc, int fr, int fq) const {
        const int row0 = u.pm * BM + wr * 64 + opaque(fr), col0 = u.pn * BM + wc * 32 + 8 * opaque(fq);
        const int cswz = ((col0 >> 3) & 1) ? (HALF - 8) : 0;
#pragma unroll
        for (int ai = 0; ai < 2; ++ai) {
            u32x2 a[4][2], b[4][2];
#pragma unroll
            for (int mm = 0; mm < 4; ++mm) { const unsigned char* sp = SG + (size_t)(row0 + ai * HALF + mm * 16) * SG_P + col0 + cswz;
                const u32x4 la = *(const u32x4*)sp, lb = *(const u32x4*)(sp + 1024); unpair16(la, a[mm][0], a[mm][1]); unpair16(lb, b[mm][0], b[mm][1]); }
#pragma unroll
            for (int m = 0; m < 4; ++m) {
#pragma unroll
                for (int bj = 0; bj < 2; ++bj) {
#pragma unroll
                    for (int n = 0; n < 2; ++n) { const int aw = (int)a[m][bj][n], bw = (int)b[m][bj][n];
                        const f32x2 al = __builtin_amdgcn_cvt_pk_f32_fp8(aw, false), ah = __builtin_amdgcn_cvt_pk_f32_fp8(aw, true), bl = __builtin_amdgcn_cvt_pk_f32_fp8(bw, false), bh = __builtin_amdgcn_cvt_pk_f32_fp8(bw, true);
                        f32x4 r; r[0] = al[0] * __builtin_amdgcn_rcpf(bl[0]); r[1] = al[1] * __builtin_amdgcn_rcpf(bl[1]); r[2] = ah[0] * __builtin_amdgcn_rcpf(bh[0]); r[3] = ah[1] * __builtin_amdgcn_rcpf(bh[1]);
                        acc[ai][bj][m][n] = acc[ai][bj][m][n] * r; } }
                asm volatile("" : "+v"(acc[ai][0][m][0]), "+v"(acc[ai][0][m][1]), "+v"(acc[ai][1][m][0]), "+v"(acc[ai][1][m][1])); }
            asm volatile("" ::: "memory"); }
    }
    __device__ __forceinline__ void operator()(const f32x4 (&acc)[2][2][4][2], const Unit& u, int wr, int wc, int fr, int fq) const {
        const int row0 = u.pm * BM + wr * 64 + opaque(fr), col0 = u.pn * BM + wc * 32 + 8 * opaque(fq);
        constexpr float FS = SM / (SO * SW * SSG);
        const int cswz = ((col0 >> 3) & 1) ? (HALF - 8) : 0;
#pragma unroll
        for (int ai = 0; ai < 2; ++ai) {
            u32x2 bq[4][2];
#pragma unroll
            for (int m = 0; m < 4; ++m) { const u32x4 lb = *(const u32x4*)(SG + (size_t)(row0 + ai * HALF + m * 16) * SG_P + 1024 + col0 + cswz); unpair16(lb, bq[m][0], bq[m][1]); }
#pragma unroll
            for (int m = 0; m < 4; ++m) { unsigned char* op = O + (size_t)(row0 + ai * HALF + m * 16) * D + col0 + cswz;
                u32x2 w[2];
#pragma unroll
                for (int bj = 0; bj < 2; ++bj) {
#pragma unroll
                    for (int n = 0; n < 2; ++n) { const int bw = (int)bq[m][bj][n]; const f32x2 bl = __builtin_amdgcn_cvt_pk_f32_fp8(bw, false), bh = __builtin_amdgcn_cvt_pk_f32_fp8(bw, true); const f32x4 v = acc[ai][bj][m][n] * FS;
                        w[bj][n] = pk4_fp8(clamp_fp8(v[0] * bl[0]), clamp_fp8(v[1] * bl[1]), clamp_fp8(v[2] * bh[0]), clamp_fp8(v[3] * bh[1])); } }
                *(u32x4*)op = pair16(w[0], w[1]); }
            asm volatile("" ::: "memory"); }
    }
};

struct PanelStats {
    unsigned* xbuf;
    unsigned* cnt;
    unsigned* tmo;
    int pm_off; float eps; unsigned code;
    __device__ __forceinline__ bool run(const f32x4 (&v)[2][2][4][2], const Unit& u, int wr, int wc, int fr, int fq, LAS unsigned char* lds, int wid, int lane) const {
        LAS f32x2* P = (LAS f32x2*)lds;
        LAS f32x2* S = (LAS f32x2*)(lds + 8192);
        LAS unsigned* flag = (LAS unsigned*)(lds + 8192 + 2048);
        const int panel = u.pm + pm_off;
#pragma unroll
        for (int ai = 0; ai < 2; ++ai)
#pragma unroll
            for (int m = 0; m < 4; ++m) {
                float s = 0.f;
#pragma unroll
                for (int bj = 0; bj < 2; ++bj)
#pragma unroll
                    for (int n = 0; n < 2; ++n) { const f32x4 x = v[ai][bj][m][n]; s += (x[0] + x[1]) + (x[2] + x[3]); }
                s += __shfl_xor(s, 16); s += __shfl_xor(s, 32);
                const float mw = s * (1.0f / 64.0f); float q = 0.f;
#pragma unroll
                for (int bj = 0; bj < 2; ++bj)
#pragma unroll
                    for (int n = 0; n < 2; ++n) { const f32x4 d = v[ai][bj][m][n] - mw; q += (d[0] * d[0] + d[1] * d[1]) + (d[2] * d[2] + d[3] * d[3]); }
                q += __shfl_xor(q, 16); q += __shfl_xor(q, 32);
                if (fq == 0) P[(ai * HALF + wr * 64 + m * 16 + fr) * 4 + wc] = (f32x2){mw, q};
            }
        asm volatile("s_waitcnt lgkmcnt(0)" ::: "memory"); __builtin_amdgcn_s_barrier(); asm volatile("" ::: "memory");
        const int row = wid * 32 + (lane & 31);
        if (lane < 32) {
            const f32x2 a = P[row * 4 + 0], b = P[row * 4 + 1], c = P[row * 4 + 2], d = P[row * 4 + 3];
            const float mt = (a.x + b.x + c.x + d.x) * 0.25f;
            const float da = a.x - mt, db = b.x - mt, dc = c.x - mt, dd = d.x - mt;
            const float m2 = (a.y + b.y) + (c.y + d.y) + 64.0f * ((da * da + db * db) + (dc * dc + dd * dd));
            unsigned long long* slot = (unsigned long long*)xbuf + ((size_t)(panel * BM + row) * 4 + u.pn);
            __hip_atomic_store(slot, ((unsigned long long)__float_as_uint(m2) << 32) | __float_as_uint(mt), __ATOMIC_RELAXED, __HIP_MEMORY_SCOPE_AGENT);
        }
        asm volatile("s_waitcnt vmcnt(0)" ::: "memory");
        if (lane == 0) __hip_atomic_fetch_add(cnt + 64 * panel, 1u, __ATOMIC_RELAXED, __HIP_MEMORY_SCOPE_AGENT);
        if (wid == 0) {
            bool dead = false; const unsigned long long t0 = __builtin_amdgcn_s_memrealtime(); const unsigned want = 8u * 4u;
            for (;;) {
                if ((unsigned)__builtin_amdgcn_readfirstlane(__hip_atomic_load(cnt + 64 * panel, __ATOMIC_RELAXED, __HIP_MEMORY_SCOPE_AGENT)) >= want) break;
                if (__builtin_amdgcn_s_memrealtime() - t0 > 2000000ull) {
                    if (lane == 0) { unsigned expect = 0u; __hip_atomic_compare_exchange_strong(tmo + 1, &expect, code | (unsigned)(panel & 0xff), __ATOMIC_RELAXED, __ATOMIC_RELAXED, __HIP_MEMORY_SCOPE_AGENT);
                                     __hip_atomic_store(tmo, 1u, __ATOMIC_RELAXED, __HIP_MEMORY_SCOPE_AGENT); }
                    dead = true; break; }
                __builtin_amdgcn_s_sleep(2);
            }
            __builtin_amdgcn_fence(__ATOMIC_ACQUIRE, "agent");
            if (lane == 0) flag[0] = dead ? 1u : 0u;
        }
        asm volatile("s_waitcnt vmcnt(0) lgkmcnt(0)" ::: "memory"); __builtin_amdgcn_s_barrier(); asm volatile("" ::: "memory");
        const bool bad = flag[0] != 0u;
        if (lane < 32) {
            const unsigned long long* slot = (const unsigned long long*)xbuf + (size_t)(panel * BM + row) * 4; float mt[4], m2[4]; float ms = 0.f;
#pragma unroll
            for (int t = 0; t < 4; ++t) { const unsigned long long w = __hip_atomic_load(slot + t, __ATOMIC_RELAXED, __HIP_MEMORY_SCOPE_AGENT); mt[t] = __uint_as_float((unsigned)w); m2[t] = __uint_as_float((unsigned)(w >> 32)); ms += mt[t]; }
            const float mean = ms * 0.25f; float q = 0.f;
#pragma unroll
            for (int t = 0; t < 4; ++t) { const float dm = mt[t] - mean; q += m2[t] + 256.0f * dm * dm; }
            S[row] = (f32x2){mean, 1.0f / sqrtf(q * (1.0f / 1024.0f) + eps)};
        }
        asm volatile("s_waitcnt lgkmcnt(0)" ::: "memory"); __builtin_amdgcn_s_barrier(); asm volatile("" ::: "memory");
        return bad;
    }
};
struct EpiLn1 {
    static constexpr bool PERM = true, AFTER_DRAIN = true, HAS_MID = false, HAS_PRE = false; static constexpr int MID_T = 0;
    const float* x; float* out; bf16_t* xb; unsigned char* xq; const float* gam; const float* bet; PanelStats st; int row_off; unsigned poison; float rs;
    __device__ __forceinline__ void mid(f32x4 (&)[2][2][4][2], const Unit&, int, int, int, int) const {}
    __device__ __forceinline__ void operator()(const f32x4 (&)[2][2][4][2], const Unit&, int, int, int, int) const {}
    __device__ __forceinline__ void fused(f32x4 (&acc)[2][2][4][2], const Unit& u, int wr, int wc, int fr, int fq, LAS unsigned char* lds, int wid, int lane) const {
        const LAS f32x2* S = (const LAS f32x2*)(lds + 8192);
        const int col0 = u.pn * BM + wc * 32 + 8 * opaque(fq);
        const int grow0 = row_off + u.pm * BM; fr = opaque(fr);
#pragma unroll
        for (int ai = 0; ai < 2; ++ai)
#pragma unroll
            for (int m = 0; m < 4; ++m) { const size_t off = (size_t)(grow0 + ai * HALF + wr * 64 + m * 16 + fr) * D + col0;
#pragma unroll
                for (int bj = 0; bj < 2; ++bj)
#pragma unroll
                    for (int n = 0; n < 2; ++n) { const f32x4 bs = *(const f32x4*)(x + off + bj * HALF + n * 4); acc[ai][bj][m][n] = acc[ai][bj][m][n] * rs + bs * DN_ALPHA; }
                asm volatile("" : "+v"(acc[ai][0][m][0]), "+v"(acc[ai][0][m][1]), "+v"(acc[ai][1][m][0]), "+v"(acc[ai][1][m][1]));
                if (m == 3) asm volatile("" ::: "memory"); }
        const bool bad = st.run(acc, u, wr, wc, fr, fq, lds, wid, lane) || poison != 0u;
        const float qnan = __builtin_nanf("");
        f32x4 gv[2][2], bv[2][2];
#pragma unroll
        for (int bj = 0; bj < 2; ++bj)
#pragma unroll
            for (int n = 0; n < 2; ++n) { gv[bj][n] = *(const f32x4*)(gam + col0 + bj * HALF + n * 4); bv[bj][n] = *(const f32x4*)(bet + col0 + bj * HALF + n * 4); }
#pragma unroll
        for (int ai = 0; ai < 2; ++ai)
#pragma unroll
            for (int m = 0; m < 4; ++m) { const int r = ai * HALF + wr * 64 + m * 16 + fr; const f32x2 sr = S[r]; const size_t off = (size_t)(grow0 + r) * D + col0;
#pragma unroll
                for (int bj = 0; bj < 2; ++bj) { f32x4 o0 = (acc[ai][bj][m][0] - sr.x) * sr.y * gv[bj][0] + bv[bj][0], o1 = (acc[ai][bj][m][1] - sr.x) * sr.y * gv[bj][1] + bv[bj][1];
                    if (bad) { o0 = (f32x4){qnan, qnan, qnan, qnan}; o1 = o0; }
                    u32x4 w; w.x = cvt_pk_bf16(o0[0], o0[1]); w.y = cvt_pk_bf16(o0[2], o0[3]); w.z = cvt_pk_bf16(o1[0], o1[1]); w.w = cvt_pk_bf16(o1[2], o1[3]); *(u32x4*)(xb + off + bj * HALF) = w;
                    u32x2 q8; q8.x = pk4_fp8(clamp_fp8(o0[0] * SX), clamp_fp8(o0[1] * SX), clamp_fp8(o0[2] * SX), clamp_fp8(o0[3] * SX)); q8.y = pk4_fp8(clamp_fp8(o1[0] * SX), clamp_fp8(o1[1] * SX), clamp_fp8(o1[2] * SX), clamp_fp8(o1[3] * SX));
                    *(u32x2*)(xq + off + bj * HALF) = q8; } }
    }
};
struct EpiY {
    static constexpr bool PERM = false, AFTER_DRAIN = false, HAS_MID = false, HAS_PRE = false; static constexpr int MID_T = 0;
    const float* __restrict__ x; bf16_t* __restrict__ Y; float* __restrict__ ST; float rs;
    __device__ __forceinline__ void mid(f32x4 (&)[2][2][4][2], const Unit&, int, int, int, int) const {}
    __device__ __forceinline__ void operator()(const f32x4 (&acc)[2][2][4][2], const Unit& u, int wr, int wc, int fr, int fq) const {
        const int row0 = u.pm * BM + wr * 64 + opaque(fr), col0 = u.pn * BM + wc * 32 + 4 * opaque(fq);
        const int scol = col0 + ((fq & 1) ? 12 : 0);
#pragma unroll
        for (int ai = 0; ai < 2; ++ai) {
            f32x4 xv[4][2][2];
#pragma unroll
            for (int m = 0; m < 4; ++m)
#pragma unroll
                for (int bj = 0; bj < 2; ++bj)
#pragma unroll
                    for (int n = 0; n < 2; ++n) xv[m][bj][n] = *(const f32x4*)(x + (size_t)(row0 + ai * HALF + m * 16) * D + col0 + bj * HALF + n * 16);
#pragma unroll
            for (int m = 0; m < 4; ++m) { const size_t r = (size_t)(row0 + ai * HALF + m * 16); float s1 = 0.f, s2 = 0.f;
#pragma unroll
                for (int bj = 0; bj < 2; ++bj) { const f32x4 y0 = acc[ai][bj][m][0] * rs + xv[m][bj][0] * DN_ALPHA, y1 = acc[ai][bj][m][1] * rs + xv[m][bj][1] * DN_ALPHA;
                    s1 += (y0[0] + y0[1]) + (y0[2] + y0[3]) + (y1[0] + y1[1]) + (y1[2] + y1[3]);
                    s2 += (y0[0] * y0[0] + y0[1] * y0[1]) + (y0[2] * y0[2] + y0[3] * y0[3]) + (y1[0] * y1[0] + y1[1] * y1[1]) + (y1[2] * y1[2] + y1[3] * y1[3]);
                    u32x2 w0, w1; w0.x = cvt_pk_bf16(y0[0], y0[1]); w0.y = cvt_pk_bf16(y0[2], y0[3]); w1.x = cvt_pk_bf16(y1[0], y1[1]); w1.y = cvt_pk_bf16(y1[2], y1[3]);
                    *(u32x4*)(Y + r * D + scol + bj * HALF) = pair16(w0, w1); }
                s1 += __shfl_xor(s1, 16); s1 += __shfl_xor(s1, 32); s2 += __shfl_xor(s2, 16); s2 += __shfl_xor(s2, 32);
                if (fq == 0) *(f32x2*)(ST + (r * 16 + u.pn * 4 + wc) * 2) = (f32x2){s1, s2}; }
            asm volatile("" ::: "memory"); }
    }
};
struct EpiGU {
    static constexpr bool PERM = true, AFTER_DRAIN = false, HAS_MID = false, HAS_PRE = true; static constexpr int MID_T = 0;
    const float* bg; const float* bu; unsigned char* H; LAS unsigned char* plds;
    __device__ __forceinline__ void mid(f32x4 (&)[2][2][4][2], const Unit&, int, int, int, int) const {}
    __device__ __forceinline__ void pre(LAS unsigned char* lds, const Unit& u, int wid, int lane) const {
        if (wid == 0) __builtin_amdgcn_global_load_lds((const unsigned*)((lane < 32 ? bg : bu) + u.e * DFF + u.pn * HALF + (lane & 31) * 4), (LAS unsigned*)(lds + EPRE_OFF), 16, 0, 0);
    }
    __device__ __forceinline__ void operator()(const f32x4 (&acc)[2][2][4][2], const Unit& u, int wr, int wc, int fr, int fq) const {
        const int row0 = u.pm * BM + wr * 64 + opaque(fr), jl = wc * 32 + 8 * opaque(fq), j0 = u.pn * HALF + jl;
        const LAS float* pb = (const LAS float*)(plds + EPRE_OFF) + jl;
        const f32x4 g0 = *(const LAS f32x4*)pb, g1 = *(const LAS f32x4*)(pb + 4), u0 = *(const LAS f32x4*)(pb + HALF), u1 = *(const LAS f32x4*)(pb + HALF + 4);
        f32x4 us0 = (u0 + 1.0f) * SH, us1 = (u1 + 1.0f) * SH;
        asm volatile("" : "+v"(us0), "+v"(us1));
        const int fqo = (jl >> 3) & 1;
#pragma unroll
        for (int ai = 0; ai < 2; ++ai)
#pragma unroll
            for (int m2 = 0; m2 < 4; m2 += 2) { u32x2 w[2];
#pragma unroll
              for (int mo = 0; mo < 2; ++mo) { const int m = m2 + mo;
                constexpr float RS = 1.0f / (SX * SW), CS = -1.702f * LOG2E;
                f32x4 h0, h1;
#pragma unroll
                for (int q = 0; q < 4; ++q) {
                    const float a = fminf(__builtin_fmaf(acc[ai][0][m][0][q], RS, g0[q]), 7.0f), b = fminf(__builtin_fmaf(acc[ai][0][m][1][q], RS, g1[q]), 7.0f);
                    const float ua = __builtin_amdgcn_fmed3f(__builtin_fmaf(acc[ai][1][m][0][q], RS * SH, us0[q]), -6.0f * SH, 8.0f * SH), ub = __builtin_amdgcn_fmed3f(__builtin_fmaf(acc[ai][1][m][1][q], RS * SH, us1[q]), -6.0f * SH, 8.0f * SH);
                    h0[q] = (a * __builtin_amdgcn_rcpf(1.0f + __builtin_amdgcn_exp2f(CS * a))) * ua;
                    h1[q] = (b * __builtin_amdgcn_rcpf(1.0f + __builtin_amdgcn_exp2f(CS * b))) * ub; }
                w[mo].x = pk4_fp8(h0[0], h0[1], h0[2], h0[3]); w[mo].y = pk4_fp8(h1[0], h1[1], h1[2], h1[3]); }
              *(u32x4*)(H + (size_t)(row0 + ai * HALF + (m2 + fqo) * 16) * DFF + j0 - 8 * fqo) = pair16(w[0], w[1]); }
    }
};
struct EpiDown {
    static constexpr bool PERM = true, AFTER_DRAIN = false, HAS_MID = false, HAS_PRE = true; static constexpr int MID_T = 0;
    const float* bd; const int* petok; const float* pegate; unsigned char* Y; LAS unsigned char* plds;
    __device__ __forceinline__ void mid(f32x4 (&)[2][2][4][2], const Unit&, int, int, int, int) const {}
    __device__ __forceinline__ void pre(LAS unsigned char* lds, const Unit& u, int wid, int lane) const {
        const size_t eb = (size_t)u.e * NTOK + (size_t)u.ti * 256 + (size_t)(lane * 4);
        if (wid == 0) __builtin_amdgcn_global_load_lds((const unsigned*)(bd + u.e * D + u.pn * BM + lane * 4), (LAS unsigned*)(lds + EPRE_OFF), 16, 0, 0);
        else if (wid == 1) __builtin_amdgcn_global_load_lds((const unsigned*)(petok + eb), (LAS unsigned*)(lds + EPRE_OFF + 1024), 16, 0, 0);
        else if (wid == 2) __builtin_amdgcn_global_load_lds((const unsigned*)(pegate + eb), (LAS unsigned*)(lds + EPRE_OFF + 2048), 16, 0, 0);
    }
    __device__ __forceinline__ void operator()(const f32x4 (&acc)[2][2][4][2], const Unit& u, int wr, int wc, int fr, int fq) const {
        const int r0 = wr * 64 + opaque(fr), cl = wc * 32 + 8 * opaque(fq), col0 = u.pn * BM + cl;
        const LAS float* pb = (const LAS float*)(plds + EPRE_OFF) + cl;
        f32x4 b[2][2];
#pragma unroll
        for (int bj = 0; bj < 2; ++bj) { b[bj][0] = *(const LAS f32x4*)(pb + bj * HALF); b[bj][1] = *(const LAS f32x4*)(pb + bj * HALF + 4); }
        int info[2][4]; float gwv[2][4];
#pragma unroll
        for (int ai = 0; ai < 2; ++ai)
#pragma unroll
            for (int m = 0; m < 4; ++m) { const int r = r0 + ai * HALF + m * 16; info[ai][m] = *(const LAS int*)(plds + EPRE_OFF + 1024 + 4 * r); gwv[ai][m] = *(const LAS float*)(plds + EPRE_OFF + 2048 + 4 * r) * SY; }
        if (u.valid == 256) {
            const int fqo = (col0 >> 3) & 1;
            const int cswz = fqo ? (HALF - 8) : 0;
#pragma unroll
        for (int ai = 0; ai < 2; ++ai)
#pragma unroll
            for (int m = 0; m < 4; ++m) {
                const float gw = gwv[ai][m];
                unsigned char* op = Y + (size_t)info[ai][m] * 1024 + col0 + cswz;
                u32x2 w[2];
#pragma unroll
                for (int bj = 0; bj < 2; ++bj) { constexpr float RS = 1.0f / (SH * SW); const f32x4 v0 = (acc[ai][bj][m][0] * RS + b[bj][0]) * gw, v1 = (acc[ai][bj][m][1] * RS + b[bj][1]) * gw;
                    w[bj].x = pk4_fp8(clamp_fp8(v0[0]), clamp_fp8(v0[1]), clamp_fp8(v0[2]), clamp_fp8(v0[3])); w[bj].y = pk4_fp8(clamp_fp8(v1[0]), clamp_fp8(v1[1]), clamp_fp8(v1[2]), clamp_fp8(v1[3])); }
                *(u32x4*)op = pair16(w[0], w[1]); }
        } else {
#pragma unroll
        for (int ai = 0; ai < 2; ++ai)
#pragma unroll
            for (int m = 0; m < 4; ++m) { const int r = r0 + ai * HALF + m * 16;
                if (r < u.valid) { const float gw = gwv[ai][m];
                    unsigned char* op = Y + (size_t)info[ai][m] * 1024 + col0;
#pragma unroll
                    for (int bj = 0; bj < 2; ++bj) { constexpr float RS = 1.0f / (SH * SW); const f32x4 v0 = (acc[ai][bj][m][0] * RS + b[bj][0]) * gw, v1 = (acc[ai][bj][m][1] * RS + b[bj][1]) * gw;
                        u32x2 w; w.x = pk4_fp8(clamp_fp8(v0[0]), clamp_fp8(v0[1]), clamp_fp8(v0[2]), clamp_fp8(v0[3])); w.y = pk4_fp8(clamp_fp8(v1[0]), clamp_fp8(v1[1]), clamp_fp8(v1[2]), clamp_fp8(v1[3]));
                        *(u32x2*)(op + bj * HALF) = w; } } }
        }
    }
};
}

#define XB_TMO      128
#define XB_XCNT(j)  (256  + 64 * (j))
#define XB_XSUB(j)  (1280 + 64 * (j))
#define XB_XGEN(j)  (2304 + 64 * (j))
#define XB_TOP      3328
#define XB_TOPGEN   3392
#define XCD_BAR_WORDS 3456
#define XB_SPIN_CAP (1u << 18)
__device__ __forceinline__ unsigned xb_ld(unsigned* p)              { return __hip_atomic_load(p, __ATOMIC_RELAXED, __HIP_MEMORY_SCOPE_AGENT); }
__device__ __forceinline__ unsigned xb_add(unsigned* p, unsigned v) { return __hip_atomic_fetch_add(p, v, __ATOMIC_RELAXED, __HIP_MEMORY_SCOPE_AGENT); }
__device__ __forceinline__ unsigned xb_xcc_id() { return (unsigned)__builtin_amdgcn_s_getreg((3 << 11) | 20) & 0xFu; }
#define XB_SPIN(cond, bar) do { unsigned _sp = 0; while (cond) { __builtin_amdgcn_s_sleep(1); \
    if ((++_sp & 255u) == 0u) { if (xb_ld(&(bar)[XB_TMO])) break; if (_sp > XB_SPIN_CAP) { atomicAdd(&(bar)[XB_TMO], 1u); break; } } } } while (0)
struct XcdBarrier { unsigned* bar; unsigned x; volatile LAS unsigned* st; };
__device__ __forceinline__ XcdBarrier xcd_barrier_post(unsigned* bar, volatile LAS unsigned* st) {
    XcdBarrier b; b.bar = bar; b.x = xb_xcc_id(); b.st = st;
    if (threadIdx.x == 0) (void)xb_add(&bar[XB_XCNT(b.x)], 1u);
    return b;
}
__device__ __forceinline__ void xcd_barrier_complete(unsigned* bar, unsigned x, unsigned& nloc, unsigned& nx) {
    const unsigned G = gridDim.x * gridDim.y * gridDim.z;
    unsigned sum, cnt, mine, sp = 0u;
    for (;;) {
        sum = 0u; cnt = 0u; mine = 0u;
#pragma unroll
        for (unsigned j = 0; j < 16; ++j) { const unsigned c = xb_ld(&bar[XB_XCNT(j)]); sum += c; cnt += (c > 0u) ? 1u : 0u; mine = (j == x) ? c : mine; }
        if (sum == G) break;
        __builtin_amdgcn_s_sleep(1);
        if ((++sp & 255u) == 0u) { if (xb_ld(&bar[XB_TMO])) break; if (sp > XB_SPIN_CAP) { atomicAdd(&bar[XB_TMO], 1u); break; } }
    }
    nloc = mine > 0u ? mine : 1u; nx = cnt > 0u ? cnt : 1u;
}
__device__ __forceinline__ void xcd_barrier(const XcdBarrier& b) {
    asm volatile("s_waitcnt vmcnt(0)" ::: "memory");
    __syncthreads();
    if (threadIdx.x == 0) {
        unsigned* bar = b.bar;
        __builtin_amdgcn_s_waitcnt(0);
        unsigned nloc = b.st[0], nx = b.st[1];
        if (nloc == 0u) { xcd_barrier_complete(bar, b.x, nloc, nx); b.st[0] = nloc; b.st[1] = nx; }
        const unsigned old = xb_add(&bar[XB_XSUB(b.x)], 1u);
        const unsigned gen = old / nloc;
        if (old + 1u == (gen + 1u) * nloc) {
            __builtin_amdgcn_fence(__ATOMIC_RELEASE, "agent");
            asm volatile("s_waitcnt vmcnt(0)" ::: "memory");
            const unsigned og = xb_add(&bar[XB_TOP], 1u);
            const unsigned tg = og / nx;
            if (og + 1u == (tg + 1u) * nx) xb_add(&bar[XB_TOPGEN], 1u);
            else XB_SPIN(xb_ld(&bar[XB_TOPGEN]) == tg, bar);
            __builtin_amdgcn_fence(__ATOMIC_ACQUIRE, "agent");
            xb_add(&bar[XB_XGEN(b.x)], 1u);
            asm volatile("s_waitcnt vmcnt(0)" ::: "memory");
        } else {
            XB_SPIN(xb_ld(&bar[XB_XGEN(b.x)]) == gen, bar);
            __builtin_amdgcn_fence(__ATOMIC_ACQUIRE, "agent");
            asm volatile("s_waitcnt vmcnt(0)" ::: "memory");
        }
    }
    __syncthreads();
}

constexpr int NWAVES = 8;
struct Frame {
    LAS unsigned char* lds; volatile LAS unsigned* MISC; gu32* ctl;
    int tid, lane, wave, vcu, G;
    unsigned char* ws; unsigned char* dout;
};
__device__ __forceinline__ float wave_sum(float v) {
#pragma unroll
    for (int o = 1; o < 64; o <<= 1) v += __shfl_xor(v, o);
    return v;
}
__device__ __forceinline__ void transpose_item(const float* W, int N, int k0, int n0, bf16_t* WT, int ldw, size_t drow0, int dcol0, LAS float* scr, int lane) {
#pragma unroll 8
    for (int i = 0; i < 32; ++i) { const int kk = 2 * i + (lane >> 5); scr[kk * 33 + (lane & 31)] = W[(size_t)(k0 + kk) * N + n0 + (lane & 31)]; }
    LDS_WAIT(); asm volatile("" ::: "memory");
    const int c = lane & 7;
#pragma unroll
    for (int j = 0; j < 4; ++j) { const int n = (lane >> 3) + 8 * j; const LAS float* s = scr + (8 * c) * 33 + n;
        u32x4 o; o.x = cvt_pk_bf16(s[0 * 33], s[1 * 33]); o.y = cvt_pk_bf16(s[2 * 33], s[3 * 33]); o.z = cvt_pk_bf16(s[4 * 33], s[5 * 33]); o.w = cvt_pk_bf16(s[6 * 33], s[7 * 33]);
        *(GAS u32x4*)(WT + (drow0 + n) * (size_t)ldw + dcol0 + 8 * c) = o; }
    LDS_WAIT(); asm volatile("" ::: "memory");
}
__device__ __forceinline__ void transpose_item_f8(const float* W, int N, int k0, int n0, unsigned char* WT, int ldw, size_t drow0, int dcol0, LAS float* scr, int lane);
__device__ __forceinline__ void transpose_item_f8r(const float* W, int N, int k0, int n0, unsigned char* WT, int ldw, size_t drow0, int dcol0, LAS float* scr, int lane) {
    (void)scr;
    const int kq = lane >> 3, ng = lane & 7;
    f32x4 wv[16];
#pragma unroll
    for (int i = 0; i < 16; ++i) wv[i] = *(const GAS f32x4*)(W + (size_t)(k0 + 16 * kq + i) * N + n0 + ng * 4);
    unsigned r[16];
#pragma unroll
    for (int i = 0; i < 16; ++i) r[i] = pk4_fp8(clamp_fp8(wv[i][0] * SW), clamp_fp8(wv[i][1] * SW), clamp_fp8(wv[i][2] * SW), clamp_fp8(wv[i][3] * SW));
    u32x4 o[4];
#pragma unroll
    for (int a4 = 0; a4 < 4; ++a4) {
        const unsigned t0 = __builtin_amdgcn_perm(r[4 * a4 + 1], r[4 * a4], 0x05010400u), t1 = __builtin_amdgcn_perm(r[4 * a4 + 1], r[4 * a4], 0x07030602u);
        const unsigned t2 = __builtin_amdgcn_perm(r[4 * a4 + 3], r[4 * a4 + 2], 0x05010400u), t3 = __builtin_amdgcn_perm(r[4 * a4 + 3], r[4 * a4 + 2], 0x07030602u);
        o[0][a4] = __builtin_amdgcn_perm(t2, t0, 0x05040100u); o[1][a4] = __builtin_amdgcn_perm(t2, t0, 0x07060302u);
        o[2][a4] = __builtin_amdgcn_perm(t3, t1, 0x05040100u); o[3][a4] = __builtin_amdgcn_perm(t3, t1, 0x07060302u); }
#pragma unroll
    for (int n = 0; n < 4; ++n) *(GAS u32x4*)(WT + (drow0 + 4 * ng + n) * (size_t)ldw + dcol0 + 16 * kq) = o[n];
}
__device__ __forceinline__ void p0_convert(Frame& F, const float* x, const float* w_in, const float* w_pa, const float* w_pb, const float* w_out, const float* rw) {
    LAS float* scr = (LAS float*)(F.lds + F.wave * 17408);
    const int gw = F.vcu * NWAVES + F.wave, NGW = F.G * NWAVES;
    unsigned char* WIN = F.dout + DO_WIN; unsigned char* WCAT = F.dout + DO_WCAT; unsigned char* WOUT = F.ws + WS_WOUT;
    constexpr int I_IN = (D / 128) * (IN_COLS / 32), I_OUT = (D / 128) * (D / 32), I_PA = (256 / 128) * (D / 32), I_PB = (D / 128) * (D / 32);
    for (int it = gw; it < I_IN + I_OUT + I_PA + I_PB; it += NGW) {
        int r = it;
        if (r < I_IN) { const int nb = IN_COLS / 32; transpose_item_f8r(w_in, IN_COLS, 128 * (r / nb), 32 * (r % nb), WIN, D, (size_t)(32 * (r % nb)), 128 * (r / nb), scr, F.lane); continue; } r -= I_IN;
        if (r < I_OUT) { const int nb = D / 32; transpose_item_f8r(w_out, D, 128 * (r / nb), 32 * (r % nb), WOUT, D, (size_t)(32 * (r % nb)), 128 * (r / nb), scr, F.lane); continue; } r -= I_OUT;
        if (r < I_PA) { const int nb = D / 32; transpose_item_f8r(w_pa, D, 128 * (r / nb), 32 * (r % nb), WCAT, OAB_P, (size_t)(32 * (r % nb)), 128 * (r / nb), scr, F.lane); continue; } r -= I_PA;
        { const int nb = D / 32; transpose_item_f8r(w_pb, D, 128 * (r / nb), 32 * (r % nb), WCAT, OAB_P, (size_t)(32 * (r % nb)), 256 + 128 * (r / nb), scr, F.lane); }
    }
    { bf16_t* WRT = (bf16_t*)(F.ws + WS_WRT);
      for (int i = gw * 64 + F.lane; i < NEXP * D; i += NGW * 64) { const int e = i >> 10, k = i & (D - 1); const float w = rw[k * NEXP + e];
          const unsigned hi = cvt_pk_bf16(w, 0.f) & 0xffffu; const float r = w - __uint_as_float(hi << 16);
          WRT[i] = (bf16_t)hi; WRT[NEXP * D + i] = (bf16_t)(cvt_pk_bf16(r, 0.f) & 0xffffu); } }
    unsigned char* XQ = F.dout + DO_XB;
    const size_t n16 = (size_t)NTOK * D / 16;
    for (size_t i = (size_t)gw * 64 + F.lane; i < n16; i += (size_t)NGW * 64) {
        const f32x4 a = *(const GAS f32x4*)(x + i * 16), b = *(const GAS f32x4*)(x + i * 16 + 4), c = *(const GAS f32x4*)(x + i * 16 + 8), d = *(const GAS f32x4*)(x + i * 16 + 12);
        u32x4 o;
        o.x = pk4_fp8(clamp_fp8(a[0] * SXIN), clamp_fp8(a[1] * SXIN), clamp_fp8(a[2] * SXIN), clamp_fp8(a[3] * SXIN)); o.y = pk4_fp8(clamp_fp8(b[0] * SXIN), clamp_fp8(b[1] * SXIN), clamp_fp8(b[2] * SXIN), clamp_fp8(b[3] * SXIN));
        o.z = pk4_fp8(clamp_fp8(c[0] * SXIN), clamp_fp8(c[1] * SXIN), clamp_fp8(c[2] * SXIN), clamp_fp8(c[3] * SXIN)); o.w = pk4_fp8(clamp_fp8(d[0] * SXIN), clamp_fp8(d[1] * SXIN), clamp_fp8(d[2] * SXIN), clamp_fp8(d[3] * SXIN));
        *(GAS u32x4*)(XQ + i * 16) = o;
    }
}
__device__ __forceinline__ void transpose_item_f8(const float* W, int N, int k0, int n0, unsigned char* WT, int ldw, size_t drow0, int dcol0, LAS float* scr, int lane) {
    f32x4 wv[16];
#pragma unroll
    for (int i = 0; i < 16; ++i) wv[i] = *(const GAS f32x4*)(W + (size_t)(k0 + 8 * i + (lane >> 3)) * N + n0 + (lane & 7) * 4);
#pragma unroll
    for (int i = 0; i < 16; ++i) { LAS float* d = scr + (8 * i + (lane >> 3)) * 33 + (lane & 7) * 4; d[0] = wv[i][0]; d[1] = wv[i][1]; d[2] = wv[i][2]; d[3] = wv[i][3]; }
    LDS_WAIT(); asm volatile("" ::: "memory");
    const int c = lane & 7;
#pragma unroll
    for (int j = 0; j < 4; ++j) { const int n = (lane >> 3) + 8 * j; const LAS float* s = scr + (16 * c) * 33 + n;
        u32x4 o;
        o.x = pk4_fp8(clamp_fp8(s[0 * 33] * SW), clamp_fp8(s[1 * 33] * SW), clamp_fp8(s[2 * 33] * SW), clamp_fp8(s[3 * 33] * SW));
        o.y = pk4_fp8(clamp_fp8(s[4 * 33] * SW), clamp_fp8(s[5 * 33] * SW), clamp_fp8(s[6 * 33] * SW), clamp_fp8(s[7 * 33] * SW));
        o.z = pk4_fp8(clamp_fp8(s[8 * 33] * SW), clamp_fp8(s[9 * 33] * SW), clamp_fp8(s[10 * 33] * SW), clamp_fp8(s[11 * 33] * SW));
        o.w = pk4_fp8(clamp_fp8(s[12 * 33] * SW), clamp_fp8(s[13 * 33] * SW), clamp_fp8(s[14 * 33] * SW), clamp_fp8(s[15 * 33] * SW));
        *(GAS u32x4*)(WT + (drow0 + n) * (size_t)ldw + dcol0 + 16 * c) = o; }
    LDS_WAIT(); asm volatile("" ::: "memory");
}
__device__ __forceinline__ void p3_convert_moe(Frame& F, const float* w_gate, const float* w_up, const float* w_down, int wg, int nwg) {
    LAS float* scr = (LAS float*)(F.lds + F.wave * 17408);
    const int gw = wg * NWAVES + F.wave, NGW = nwg * NWAVES;
    unsigned char* WGU = F.ws + WS_WGU; unsigned char* WD = F.ws + WS_WD;
    constexpr int IPM = (D / 128) * (DFF / 32);
    for (int it = gw; it < NEXP * 3 * IPM; it += NGW) {
        const int e = it / (3 * IPM), r3 = it % (3 * IPM), which = r3 / IPM, r = r3 % IPM, kb = r / 32, nb = r % 32, k0 = 128 * kb, n0 = 32 * nb;
        const size_t moff = (size_t)e * D * DFF;
        if (which == 2) transpose_item_f8(w_down + moff, D, k0, n0, WD + moff, DFF, (size_t)n0, k0, scr, F.lane);
        else { const int pn = n0 >> 7, jj = n0 & 127; transpose_item_f8((which ? w_up : w_gate) + moff, DFF, k0, n0, WGU + 2 * moff, D, (size_t)(256 * pn + 128 * which + jj), k0, scr, F.lane); }
    }
}
typedef short v4i16_t __attribute__((ext_vector_type(4)));
__device__ __forceinline__ s16x4 tr_read(const LAS unsigned char* p) { return __builtin_bit_cast(s16x4, __builtin_amdgcn_ds_read_tr16_b64_v4i16((LAS v4i16_t*)p)); }
template <int C>
__device__ __forceinline__ void tr_read8(s16x4 (&r)[8], unsigned addr) {
#define TRR(i) asm volatile("ds_read_b64_tr_b16 %0, %1 offset:%2" : "=v"(r[i]) : "v"(addr), "n"(C * 4096 + (i) * 512))
    TRR(0); TRR(1); TRR(2); TRR(3); TRR(4); TRR(5); TRR(6); TRR(7);
#undef TRR
}
__device__ __forceinline__ void tr_wait8(s16x4 (&r)[8]) {
    asm volatile("s_waitcnt lgkmcnt(0)" : "+v"(r[0]), "+v"(r[1]), "+v"(r[2]), "+v"(r[3]), "+v"(r[4]), "+v"(r[5]), "+v"(r[6]), "+v"(r[7]));
}
template <int C>
__device__ __forceinline__ void pv_tile(s16x4 (&cur)[8], s16x4 (&prev)[8], bf16x8 (&pf)[2], bf16x8 (&pfprev)[2], unsigned vbase, const f32x16& Sc, f32x16 (&O)[2]) {
#pragma unroll
    for (int s = 0; s < 2; ++s) { u32x4 w; w.x = cvt_pk_bf16(Sc[8 * s + 0], Sc[8 * s + 1]); w.y = cvt_pk_bf16(Sc[8 * s + 2], Sc[8 * s + 3]);
        w.z = cvt_pk_bf16(Sc[8 * s + 4], Sc[8 * s + 5]); w.w = cvt_pk_bf16(Sc[8 * s + 6], Sc[8 * s + 7]); pf[s] = __builtin_bit_cast(bf16x8, w); }
    tr_read8<C>(cur, vbase);
    if (C > 0) { asm volatile("" :: "v"(prev[0]), "v"(prev[1]), "v"(prev[2]), "v"(prev[3]), "v"(prev[4]), "v"(prev[5]), "v"(prev[6]), "v"(prev[7]) : "memory");
                 asm volatile("" :: "v"(pfprev[0]), "v"(pfprev[1]) : "memory"); }
    tr_wait8(cur);
    __builtin_amdgcn_sched_barrier(0);
#pragma unroll
    for (int blk = 0; blk < 2; ++blk)
#pragma unroll
        for (int s = 0; s < 2; ++s) { const s16x4 lo = cur[(blk * 2 + s) * 2], hi = cur[(blk * 2 + s) * 2 + 1];
            O[blk] = __builtin_amdgcn_mfma_f32_32x32x16_bf16((bf16x8){lo[0], lo[1], lo[2], lo[3], hi[0], hi[1], hi[2], hi[3]}, pf[s], O[blk], 0, 0, 0); }
    __builtin_amdgcn_sched_barrier(0);
}
constexpr int ATT_KOFF = 0, ATT_QOFF = 12 * 2048, ATT_VOFF = 12 * 4096, ATT_STG = 24 * 4096, ATT_STGW = 4608;
static_assert(ATT_STG + 8 * ATT_STGW <= SCR_BYTES, "attention LDS map");
struct AKV { const unsigned char* qseq; const unsigned char* kseq; const bf16_t* vseq; int jt0, nkt, jq; };
__device__ __forceinline__ AKV attn_kv(const Frame& F, int U) {
    const unsigned char* HQ = F.ws + WS_HQ; AKV r;
    if (U < 2048) {
        const int b = U >> 8, kvh = (U >> 7) & 1, j = U & 127, hq = kvh * 8 + F.wave;
        r.qseq = HQ + HQ_QS + (size_t)(b * 16 + hq) * SEQ * 64; r.kseq = HQ + HQ_KS + (size_t)(b * 2 + kvh) * SEQ * 64; r.vseq = (const bf16_t*)(HQ + HQ_VS) + (size_t)(b * 2 + kvh) * SEQ * 64;
        r.jt0 = j - 4; r.nkt = 5; r.jq = j;
    } else {
        const int v = U - 2048, g = v >> 9, w_ = v & 511, b = w_ >> 6, x = w_ & 63, hh = x >> 4, y = x & 15;
        const int dil = (g == 0) ? 1 : (g == 1) ? 4 : 16;
        const int res = (g == 0) ? 0 : (g == 1) ? (y >> 2) : y;
        const int j0 = (g == 0) ? y * 8 : (g == 1) ? (y & 3) * 8 : 0;
        const size_t seq = ((size_t)((g * NB + b) * 4 + hh) * SEQ + (size_t)res * (SEQ / dil)) * 64;
        r.qseq = HQ + HQ_QD + seq; r.kseq = HQ + HQ_KD + seq; r.vseq = (const bf16_t*)(HQ + HQ_VD) + seq;
        r.jt0 = j0 - 4; r.nkt = 12; r.jq = j0 + F.wave;
    }
    return r;
}
__device__ __forceinline__ unsigned attn_koff(int lane) { return (unsigned)((lane >> 2) * 64 + (((lane & 3) ^ ((lane >> 4) & 3)) * 16)); }
__device__ __forceinline__ unsigned attn_voff(int lane) { return (unsigned)((lane >> 2) * 128 + (lane & 3) * 16); }
__device__ __forceinline__ void attn_issue_k(LAS unsigned char* lds, int lane, int wave, const AKV& u) {
    const unsigned koff = attn_koff(lane);
    for (int p = wave; p < u.nkt * 2; p += 8) {
        const int s = p >> 1, qt = p & 1; const int tj = u.jt0 + s; const size_t pos0 = (size_t)(32 * (tj >= 0 ? tj : 0) + 16 * qt);
        __builtin_amdgcn_global_load_lds((const unsigned*)((const char*)u.kseq + pos0 * 64 + koff), (LAS unsigned*)(lds + ATT_KOFF + s * 2048 + qt * 1024), 16, 0, 0);
    }
}
__device__ __forceinline__ void attn_issue_q(LAS unsigned char* lds, int lane, int wave, const AKV& u) {
    const unsigned koff = attn_koff(lane);
#pragma unroll
    for (int qt = 0; qt < 2; ++qt)
        __builtin_amdgcn_global_load_lds((const unsigned*)((const char*)u.qseq + (size_t)(32 * u.jq + 16 * qt) * 64 + koff), (LAS unsigned*)(lds + ATT_QOFF + wave * 2048 + qt * 1024), 16, 0, 0);
}
template <int NKT>
__device__ __forceinline__ int attn_issue_v(LAS unsigned char* lds, int lane, int wave, const AKV& u) {
    const int w4 = (wave + 4) & 7;
    const unsigned voff = attn_voff(lane);
#pragma unroll
    for (int i = 0; i < (NKT * 4 + 7) / 8; ++i) { const int p = w4 + 8 * i;
        if (p < NKT * 4) { const int s = p >> 2, qt = p & 3; const int tj = u.jt0 + s; const int blk = qt >> 1, part = qt & 1;
            const size_t pos0 = (size_t)(32 * (tj >= 0 ? tj : 0) + 16 * part);
            __builtin_amdgcn_global_load_lds((const unsigned*)((const char*)u.vseq + pos0 * 128 + blk * 64 + voff), (LAS unsigned*)(lds + ATT_VOFF + s * 4096 + blk * 2048 + part * 1024), 16, 0, 0); } }
    return NKT == 12 ? 6 : (w4 < 4 ? 3 : 2);
}
__device__ __forceinline__ void attn_wait(int n) {
#define AW(N) asm volatile("s_waitcnt vmcnt(" #N ")" ::: "memory")
    if (n == 11) AW(11); else if (n == 8) AW(8); else if (n == 7) AW(7); else if (n == 6) AW(6); else if (n == 5) AW(5); else if (n == 4) AW(4); else if (n == 3) AW(3); else if (n == 2) AW(2); else AW(0);
#undef AW
}
template <bool swa>
__device__ __forceinline__ void attn_unit(LAS unsigned char* lds, int lane, int wave, const AKV& u, int s0,
                                          float sl2, float sink2, bf16_t* ob, unsigned op, float* lseb, unsigned lsep, bool hasn, const AKV& nx) {
    const int i32 = lane & 31, h = lane >> 5;
    const int jq = u.jq;
    constexpr float QKS = SQ * SK, RQK = 1.0f / (SQ * SK), NEG_RAW = -1.0e30f;
    f32x16 bias;
#pragma unroll
    for (int r = 0; r < 16; ++r) { const int kk = (r & 3) + 8 * (r >> 2) + 4 * h; bias[r] = sl2 * QKS * (float)(kk - i32); }
    __builtin_amdgcn_s_barrier();
    asm volatile("" ::: "memory");
    f32x16 S[5];
    float m2 = sink2;
    const int kro = i32 * 64 + h * 8, ksw = (i32 >> 2) & 3;
    long qf[4];
#pragma unroll
    for (int d0 = 0; d0 < 4; ++d0) qf[d0] = *(const LAS long*)(lds + ATT_QOFF + wave * 2048 + kro + ((d0 ^ ksw) * 16));
    long kf[2][4];
#pragma unroll
    for (int c = 0; c < 5; ++c) {
        const bool tv = (jq - 4 + c) >= 0;
        const LAS unsigned char* ks = lds + ATT_KOFF + (s0 + c) * 2048 + kro;
#pragma unroll
        for (int d0 = 0; d0 < 4; ++d0) kf[c & 1][d0] = *(const LAS long*)(ks + ((d0 ^ ksw) * 16));
        if (c > 0) asm volatile("" :: "v"(kf[(c - 1) & 1][0]), "v"(kf[(c - 1) & 1][1]), "v"(kf[(c - 1) & 1][2]), "v"(kf[(c - 1) & 1][3]) : "memory");
        f32x16 a = bias;
#pragma unroll
        for (int d0 = 0; d0 < 4; ++d0) a = __builtin_amdgcn_mfma_f32_32x32x16_fp8_fp8(kf[c & 1][d0], qf[d0], a, 0, 0, 0);
        if (c == 0 || c == 4) {
#pragma unroll
            for (int r = 0; r < 16; ++r) { const int kk = (r & 3) + 8 * (r >> 2) + 4 * h;
                const bool ok = (c == 4) ? (kk <= i32) : (swa ? (kk > i32) : (kk >= i32));
                a[r] = ok ? a[r] : NEG_RAW; }
        }
        float mt = fmaxf(fmaxf(a[0], a[1]), a[2]);
#pragma unroll
        for (int r = 3; r < 15; r += 2) mt = fmaxf(fmaxf(mt, a[r]), a[r + 1]);
        mt = fmaxf(mt, a[15]);
        m2 = fmaxf(m2, __builtin_fmaf(mt, RQK, tv ? -sl2 * (float)(32 * (4 - c)) : NEG_RAW));
        S[c] = a;
    }
    m2 = fmaxf(m2, __shfl_xor(m2, 32));
    float l = 0.f;
#pragma unroll
    for (int c = 0; c < 5; ++c) {
        const float offc = ((jq - 4 + c) >= 0 ? -sl2 * (float)(32 * (4 - c)) : NEG_RAW) - m2;
#pragma unroll
        for (int r = 0; r < 16; ++r) { const float p = __builtin_amdgcn_exp2f(__builtin_fmaf(S[c][r], RQK, offc)); S[c][r] = p; l += p; }
    }
    l += __shfl_xor(l, 32);
    l += __builtin_amdgcn_exp2f(sink2 - m2);
    asm volatile("" :: "v"(kf[0][0]), "v"(kf[0][1]), "v"(kf[0][2]), "v"(kf[0][3]), "v"(kf[1][0]), "v"(kf[1][1]), "v"(kf[1][2]), "v"(kf[1][3]) : "memory");
    asm volatile("s_waitcnt vmcnt(0) lgkmcnt(0)" : "+v"(l) :: "memory");
    __builtin_amdgcn_s_barrier();
    asm volatile("" ::: "memory");
    if (hasn) { attn_issue_k(lds, lane, wave, nx); attn_issue_q(lds, lane, wave, nx); }
    f32x16 O[2]; O[0] = (f32x16){}; O[1] = (f32x16){};
    const int vaddr0 = ((lane >> 4) & 1) * 32 + (lane & 3) * 8 + (4 * h + ((lane & 15) >> 2)) * 64;
    const unsigned vbase = (unsigned)(size_t)(lds + ATT_VOFF) + (unsigned)(s0 * 4096 + vaddr0);
    s16x4 va[2][8]; bf16x8 pf[2][2];
    pv_tile<0>(va[0], va[1], pf[0], pf[1], vbase, S[0], O); pv_tile<1>(va[1], va[0], pf[1], pf[0], vbase, S[1], O); pv_tile<2>(va[0], va[1], pf[0], pf[1], vbase, S[2], O);
    pv_tile<3>(va[1], va[0], pf[1], pf[0], vbase, S[3], O); pv_tile<4>(va[0], va[1], pf[0], pf[1], vbase, S[4], O);
    asm volatile("" :: "v"(pf[0][0]), "v"(pf[0][1]), "v"(pf[1][0]), "v"(pf[1][1]) : "memory");
    asm volatile("" :: "v"(va[0][0]), "v"(va[0][1]), "v"(va[0][2]), "v"(va[0][3]), "v"(va[0][4]), "v"(va[0][5]), "v"(va[0][6]), "v"(va[0][7]) : "memory");
    asm volatile("" :: "v"(va[1][0]), "v"(va[1][1]), "v"(va[1][2]), "v"(va[1][3]), "v"(va[1][4]), "v"(va[1][5]), "v"(va[1][6]), "v"(va[1][7]) : "memory");
    __builtin_amdgcn_s_barrier();
    asm volatile("" ::: "memory");
    int nv = 0;
    if (hasn) { if (nx.nkt == 12) nv = attn_issue_v<12>(lds, lane, wave, nx); else nv = attn_issue_v<5>(lds, lane, wave, nx); }
    const float inv = 1.0f / l;
    LAS unsigned char* stg = lds + ATT_STG + wave * ATT_STGW;
    if (swa) {
        const float is = inv * SO;
#pragma unroll
        for (int blk = 0; blk < 2; ++blk)
#pragma unroll
            for (int g4 = 0; g4 < 4; ++g4) { const int d0 = blk * 32 + 8 * g4 + 4 * h;
                *(LAS unsigned*)(stg + i32 * 80 + d0) = pk4_fp8_pad(clamp_fp8(O[blk][4 * g4 + 0] * is), clamp_fp8(O[blk][4 * g4 + 1] * is), clamp_fp8(O[blk][4 * g4 + 2] * is), clamp_fp8(O[blk][4 * g4 + 3] * is)); }
        asm volatile("s_waitcnt lgkmcnt(0)" ::: "memory");
#pragma unroll
        for (int it = 0; it < 2; ++it) { const int row = it * 16 + (lane >> 2), ch = lane & 3;
            const u32x4 v = *(const LAS u32x4*)(stg + row * 80 + ch * 16);
            *(u32x4*)((char*)ob + (size_t)(32 * jq + row) * op + ch * 16) = v; }
    } else {
#pragma unroll
        for (int blk = 0; blk < 2; ++blk)
#pragma unroll
            for (int g4 = 0; g4 < 4; ++g4) { const int d0 = blk * 32 + 8 * g4 + 4 * h;
                u32x2 w; w.x = cvt_pk_bf16(O[blk][4 * g4 + 0] * inv, O[blk][4 * g4 + 1] * inv); w.y = cvt_pk_bf16(O[blk][4 * g4 + 2] * inv, O[blk][4 * g4 + 3] * inv);
                *(LAS u32x2*)(stg + i32 * 144 + d0 * 2) = w; }
        asm volatile("s_waitcnt lgkmcnt(0)" ::: "memory");
#pragma unroll
        for (int it = 0; it < 4; ++it) { const int row = it * 8 + (lane >> 3), ch = lane & 7;
            const u32x4 v = *(const LAS u32x4*)(stg + row * 144 + ch * 16);
            *(u32x4*)((char*)ob + (size_t)(32 * jq + row) * op + ch * 16) = v; }
    }
    if (lseb != nullptr && h == 0) lseb[(size_t)(32 * jq + i32) * lsep] = (m2 + __builtin_amdgcn_logf(l)) * LN2;
    attn_wait(hasn ? nv + (swa ? 2 : 5) : 0);
}
__device__ __forceinline__ void p2_attention(Frame& F, const float* sinks) {
    unsigned char* OAB = F.dout + DO_OAB; bf16_t* OAG = (bf16_t*)(F.ws + WS_OAG); float* LSE = (float*)(F.ws + WS_LSE);
    constexpr int NUNIT = 2048 + 1536;
    int U = F.vcu; if (U >= NUNIT) return;
    float snk0 = sinks[F.wave] * LOG2E, snk1 = sinks[8 + F.wave] * LOG2E;
    asm volatile("" : "+v"(snk0), "+v"(snk1));
    AKV cur = attn_kv(F, U);
    attn_issue_k(F.lds, F.lane, F.wave, cur);
    attn_issue_q(F.lds, F.lane, F.wave, cur);
    { const int nv0 = (cur.nkt == 12) ? attn_issue_v<12>(F.lds, F.lane, F.wave, cur) : attn_issue_v<5>(F.lds, F.lane, F.wave, cur); attn_wait(nv0); }
    for (;;) {
        const int Un = U + F.G; const bool hasn = Un < NUNIT;
        const AKV nxt = attn_kv(F, hasn ? Un : U);
        if (U < 2048) {
            const int b = U >> 8, kvh = (U >> 7) & 1, hq = kvh * 8 + F.wave;
            const float slope = exp2f(-8.0f * (float)(hq + 1) / 28.0f);
            attn_unit<true>(F.lds, F.lane, F.wave, cur, 0, slope * LOG2E, kvh ? snk1 : snk0, (bf16_t*)(OAB + (size_t)b * SEQ * OAB_P + 256 + hq * 64), OAB_P, nullptr, 0, hasn, nxt);
        } else {
            const int v = U - 2048, g = v >> 9, w_ = v & 511, b = w_ >> 6, x = w_ & 63, hh = x >> 4, y = x & 15;
            const int dil = (g == 0) ? 1 : (g == 1) ? 4 : 16;
            const int res = (g == 0) ? 0 : (g == 1) ? (y >> 2) : y;
            const size_t tok0 = (size_t)b * SEQ + res;
            const float slope = exp2f(-8.0f * (float)(16 + g * 4 + hh + 1) / 28.0f);
            attn_unit<false>(F.lds, F.lane, F.wave, cur, F.wave, slope * (float)dil * LOG2E, NEG_BIG,
                             OAG + ((size_t)g * NTOK + tok0) * 256 + hh * 64, (unsigned)(dil * 256 * 2), LSE + ((size_t)g * NTOK + tok0) * 4 + hh, (unsigned)(dil * 4), hasn, nxt);
        }
        if (!hasn) break;
        U = Un; cur = nxt;
    }
}
__device__ __forceinline__ void p3_merge(Frame& F) {
    const bf16_t* OAG = (const bf16_t*)(F.ws + WS_OAG); const float* LSE = (const float*)(F.ws + WS_LSE); unsigned char* OAB = F.dout + DO_OAB;
    const int gw = F.vcu * NWAVES + F.wave, NGW = F.G * NWAVES;
    for (int idx = gw; idx < NTOK / 2; idx += NGW) {
        const int tok = idx * 2 + (F.lane >> 5), c8 = F.lane & 31, hh = c8 >> 3;
        float ls[3]; u32x4 o[3];
#pragma unroll
        for (int g = 0; g < 3; ++g) { ls[g] = LSE[((size_t)g * NTOK + tok) * 4 + hh]; o[g] = *(const u32x4*)(OAG + ((size_t)g * NTOK + tok) * 256 + c8 * 8); }
        const float m = fmaxf(fmaxf(ls[0], ls[1]), ls[2]);
        float w[3]; float sum = 0.f;
#pragma unroll
        for (int g = 0; g < 3; ++g) { w[g] = __builtin_amdgcn_exp2f((ls[g] - m) * LOG2E); sum += w[g]; }
        const float is = 1.0f / sum; float r[8];
#pragma unroll
        for (int q = 0; q < 8; ++q) r[q] = 0.f;
#pragma unroll
        for (int g = 0; g < 3; ++g) { const float wg = w[g] * is;
            r[0] += wg * bf_lo(o[g].x); r[1] += wg * bf_hi(o[g].x); r[2] += wg * bf_lo(o[g].y); r[3] += wg * bf_hi(o[g].y);
            r[4] += wg * bf_lo(o[g].z); r[5] += wg * bf_hi(o[g].z); r[6] += wg * bf_lo(o[g].w); r[7] += wg * bf_hi(o[g].w); }
        u32x2 out; out.x = pk4_fp8(clamp_fp8(r[0] * SO), clamp_fp8(r[1] * SO), clamp_fp8(r[2] * SO), clamp_fp8(r[3] * SO)); out.y = pk4_fp8(clamp_fp8(r[4] * SO), clamp_fp8(r[5] * SO), clamp_fp8(r[6] * SO), clamp_fp8(r[7] * SO));
        *(u32x2*)(OAB + (size_t)tok * OAB_P + c8 * 8) = out;
    }
}

__device__ __forceinline__ void p6_router(Frame& F, const bf16_t* y, const float* stat, const float* gam, const float* bet, bf16_t* x1b, unsigned char* x1q, const float* rb, int cw_ecnt, size_t pe_off) {
    constexpr int WPITCH = 2064;
    constexpr int WIMG = 64 * WPITCH;
    constexpr int GOFF = WIMG + 2048;
    static_assert(GOFF + 8192 <= SCR_BYTES, "router LDS map");
    LAS int* wcnt = (LAS int*)(F.lds + WIMG + F.wave * 256); LAS int* wbase = wcnt + 32;
    int* petok = (int*)(F.ws + WS_PETOK + pe_off); float* pegate = (float*)(F.ws + WS_PEGATE + pe_off);
    const bf16_t* WRT = (const bf16_t*)(F.ws + WS_WRT);
    const int gw = F.vcu * NWAVES + F.wave, NGW = F.G * NWAVES, lane = F.lane, j = lane & 15, kq = lane >> 4;
    __syncthreads();
    for (int q = F.tid; q < 64 * 128; q += NWAVES * 64) { const u32x4 v = *(const u32x4*)((const char*)WRT + (size_t)q * 16); *(LAS u32x4*)(F.lds + (q >> 7) * WPITCH + (q & 127) * 16) = v; }
    for (int q = F.tid; q < 512; q += NWAVES * 64) { const f32x4 v = (q < 256) ? *(const f32x4*)(gam + q * 4) : *(const f32x4*)(bet + (q - 256) * 4); *(LAS f32x4*)(F.lds + GOFF + q * 16) = v; }
    __syncthreads();
    const LAS unsigned char* wrow = F.lds + j * WPITCH + kq * 16;
    const LAS float* gl = (const LAS float*)(F.lds + GOFF) + 8 * kq; const LAS float* bl = gl + 1024;
    for (int tb = F.vcu * NWAVES; tb < NTOK / 16; tb += NGW) {
        const int tt = tb + F.wave; const bool valid = tt < NTOK / 16; const int t0 = (valid ? tt : 0) * 16;
        float mean, rstd;
        { const f32x4* sp = (const f32x4*)(stat + (size_t)(t0 + j) * 32); float s1 = 0.f, s2 = 0.f;
#pragma unroll
          for (int q = 0; q < 8; ++q) { const f32x4 v = sp[q]; s1 += v[0] + v[2]; s2 += v[1] + v[3]; }
          mean = s1 * (1.0f / D); const float var = fmaxf(s2 * (1.0f / D) - mean * mean, 0.f); rstd = 1.0f / sqrtf(var + LN_EPS); }
        f32x4 acc[2]; acc[0] = (f32x4){0.f, 0.f, 0.f, 0.f}; acc[1] = acc[0];
        const bf16_t* yrow = y + (size_t)(t0 + j) * D + 8 * kq;
        bf16_t* xbrow = (valid ? x1b : (bf16_t*)(F.ws + 300 * MiB)) + (size_t)(t0 + j) * D + 8 * kq; unsigned char* xqrow = (valid ? x1q : F.ws + 300 * MiB) + (size_t)(t0 + j) * D + 8 * kq;
        bf16x8 wf[2][4]; wf[1][0] = (bf16x8){}; wf[1][1] = wf[1][0]; wf[1][2] = wf[1][0]; wf[1][3] = wf[1][0];
        u32x4 yv[4], yn[4]; u32x2 q8prev = (u32x2){0u, 0u};
#pragma unroll
        for (int u = 0; u < 4; ++u) yv[u] = *(const u32x4*)(yrow + 32 * u);
#pragma unroll 1
        for (int so = 0; so < D / 32; so += 4) {
            const int sn = (so + 4 < D / 32) ? so + 4 : so;
#pragma unroll
            for (int u = 0; u < 4; ++u) yn[u] = *(const u32x4*)(yrow + 32 * (sn + u));
#pragma unroll
            for (int u = 0; u < 4; ++u) { const int sI = so + u;
                wf[u & 1][0] = *(const LAS bf16x8*)(wrow + 64 * sI); wf[u & 1][1] = *(const LAS bf16x8*)(wrow + 16 * WPITCH + 64 * sI);
                wf[u & 1][2] = *(const LAS bf16x8*)(wrow + 32 * WPITCH + 64 * sI); wf[u & 1][3] = *(const LAS bf16x8*)(wrow + 48 * WPITCH + 64 * sI);
                const f32x4 g0 = *(const LAS f32x4*)(gl + 32 * sI), g1 = *(const LAS f32x4*)(gl + 32 * sI + 4), b0 = *(const LAS f32x4*)(bl + 32 * sI), b1 = *(const LAS f32x4*)(bl + 32 * sI + 4);
                asm volatile("" :: "v"(wf[(u + 1) & 1][0]), "v"(wf[(u + 1) & 1][1]), "v"(wf[(u + 1) & 1][2]), "v"(wf[(u + 1) & 1][3]) : "memory");
                f32x4 n0, n1;
                n0[0] = (bf_lo(yv[u].x) - mean) * rstd * g0[0] + b0[0]; n0[1] = (bf_hi(yv[u].x) - mean) * rstd * g0[1] + b0[1]; n0[2] = (bf_lo(yv[u].y) - mean) * rstd * g0[2] + b0[2]; n0[3] = (bf_hi(yv[u].y) - mean) * rstd * g0[3] + b0[3];
                n1[0] = (bf_lo(yv[u].z) - mean) * rstd * g1[0] + b1[0]; n1[1] = (bf_hi(yv[u].z) - mean) * rstd * g1[1] + b1[1]; n1[2] = (bf_lo(yv[u].w) - mean) * rstd * g1[2] + b1[2]; n1[3] = (bf_hi(yv[u].w) - mean) * rstd * g1[3] + b1[3];
                u32x4 xw; xw.x = cvt_pk_bf16(n0[0], n0[1]); xw.y = cvt_pk_bf16(n0[2], n0[3]); xw.z = cvt_pk_bf16(n1[0], n1[1]); xw.w = cvt_pk_bf16(n1[2], n1[3]);
                *(u32x4*)(xbrow + 32 * sI) = xw;
                { u32x2 q8; q8.x = pk4_fp8(clamp_fp8(n0[0] * SX), clamp_fp8(n0[1] * SX), clamp_fp8(n0[2] * SX), clamp_fp8(n0[3] * SX)); q8.y = pk4_fp8(clamp_fp8(n1[0] * SX), clamp_fp8(n1[1] * SX), clamp_fp8(n1[2] * SX), clamp_fp8(n1[3] * SX));
                  if (u & 1) *(u32x4*)(xqrow + 32 * (sI - 1 + (kq & 1)) - 8 * (kq & 1)) = pg8::pair16(q8prev, q8); else q8prev = q8; }
                const bf16x8 xh = __builtin_bit_cast(bf16x8, xw);
                acc[0] = __builtin_amdgcn_mfma_f32_16x16x32_bf16(wf[u & 1][0], xh, acc[0], 0, 0, 0); acc[1] = __builtin_amdgcn_mfma_f32_16x16x32_bf16(wf[u & 1][1], xh, acc[1], 0, 0, 0);
                acc[0] = __builtin_amdgcn_mfma_f32_16x16x32_bf16(wf[u & 1][2], xh, acc[0], 0, 0, 0); acc[1] = __builtin_amdgcn_mfma_f32_16x16x32_bf16(wf[u & 1][3], xh, acc[1], 0, 0, 0); }
#pragma unroll
            for (int u = 0; u < 4; ++u) yv[u] = yn[u];
        }
        float lg[8];
#pragma unroll
        for (int q = 0; q < 8; ++q) lg[q] = acc[q >> 2][q & 3] + rb[16 * (q >> 2) + 4 * kq + (q & 3)];
        unsigned taken = 0u; float tv[4]; int ti[4];
#pragma unroll
        for (int k = 0; k < 4; ++k) {
            float bv = -3.0e38f; int bi = 64;
#pragma unroll
            for (int q = 0; q < 8; ++q) { const bool free_ = ((taken >> q) & 1u) == 0u; if (free_ && lg[q] > bv) { bv = lg[q]; bi = 16 * (q >> 2) + 4 * kq + (q & 3); } }
            const int mybi = bi;
#pragma unroll
            for (int o = 16; o < 64; o <<= 1) { const float ov = __shfl_xor(bv, o); const int oi = __shfl_xor(bi, o); const bool keep = (bv > ov) || (bv == ov && bi < oi); bv = keep ? bv : ov; bi = keep ? bi : oi; }
            tv[k] = bv; ti[k] = bi;
            if (bi == mybi && ((bi >> 2) & 3) == kq) taken |= 1u << (4 * (bi >> 4) + (bi & 3));
        }
        float gk[4]; float gs = 0.f;
#pragma unroll
        for (int k = 0; k < 4; ++k) { gk[k] = __builtin_amdgcn_exp2f((tv[k] - tv[0]) * LOG2E); gs += gk[k]; }
        const float gi = 1.0f / gs;
        if (lane < 32) wcnt[lane] = 0;
        asm volatile("s_waitcnt lgkmcnt(0)" ::: "memory");
        const int e0 = (kq == 0) ? ti[0] : (kq == 1) ? ti[1] : (kq == 2) ? ti[2] : ti[3];
        const float g0 = ((kq == 0) ? gk[0] : (kq == 1) ? gk[1] : (kq == 2) ? gk[2] : gk[3]) * gi;
        int r0 = 0;
        if (valid) r0 = __hip_atomic_fetch_add(wcnt + e0, 1, __ATOMIC_RELAXED, __HIP_MEMORY_SCOPE_WORKGROUP);
        asm volatile("s_waitcnt lgkmcnt(0)" ::: "memory");
        __syncthreads();
        if (F.wave == 0 && lane < 32) { int c[NWAVES]; int tot = 0;
#pragma unroll
            for (int w = 0; w < NWAVES; ++w) { c[w] = *(LAS int*)(F.lds + WIMG + w * 256 + 4 * lane); tot += c[w]; }
            int b = 0; if (tot > 0) b = (int)__hip_atomic_fetch_add((unsigned*)(F.ctl + cw_ecnt + 64 * lane), (unsigned)tot, RLX_AGENT);
#pragma unroll
            for (int w = 0; w < NWAVES; ++w) { *(LAS int*)(F.lds + WIMG + w * 256 + 128 + 4 * lane) = b; b += c[w]; } }
        asm volatile("s_waitcnt vmcnt(0) lgkmcnt(0)" ::: "memory");
        __syncthreads();
        if (valid) { const int p0 = wbase[e0] + r0;
            petok[(size_t)e0 * NTOK + p0] = (t0 + j) * 4 + kq; pegate[(size_t)e0 * NTOK + p0] = g0; }
        asm volatile("s_waitcnt lgkmcnt(0)" ::: "memory");
        __syncthreads();
    }
}
__device__ __forceinline__ int moe_tables(Frame& F) {
    LAS int* cnt = (LAS int*)(F.lds + MOE_OFF); LAS int* fs = (LAS int*)(F.lds + MOE_OFF + 128); LAS unsigned char* te = F.lds + MOE_OFF + 128 + 136;
    __syncthreads();
    if (F.tid < NEXP) cnt[F.tid] = (int)__hip_atomic_load(F.ctl + CW_ECNT + 64 * F.tid, RLX_AGENT);
    __syncthreads();
    if (F.tid == 0) { int s = 0; for (int e = 0; e < NEXP; ++e) { fs[e] = s; s += (cnt[e] + 255) >> 8; } fs[NEXP] = s; }
    __syncthreads();
    const int T = fs[NEXP];
    for (int t = F.tid; t < T; t += NWAVES * 64) { int e = 0;
#pragma unroll 8
        for (int q = 1; q < NEXP; ++q) e += (fs[q] <= t) ? 1 : 0;
        te[t] = (unsigned char)e; }
    __syncthreads();
    return T;
}
__device__ __forceinline__ void p9_final(Frame& F, const float* gam, const float* bet, const float* out, float* outw, bool poison) {
    const bf16_t* X1B = (const bf16_t*)(F.ws + WS_X1B);
    const int gw = F.vcu * NWAVES + F.wave, NGW = F.G * NWAVES, lane = F.lane;
    const float qnan = __builtin_nanf("");
    f32x4 g[4], bb[4];
#pragma unroll
    for (int k = 0; k < 4; ++k) { g[k] = *(const f32x4*)(gam + 256 * k + 4 * lane); bb[k] = *(const f32x4*)(bet + 256 * k + 4 * lane); }
    for (int tok0 = gw; tok0 < NTOK; tok0 += 2 * NGW) {
        u32x2 xw[2][4]; unsigned yw[2][4][4];
#pragma unroll
        for (int tI = 0; tI < 2; ++tI) { const int tok = min(tok0 + tI * NGW, NTOK - 1);
            const unsigned char* y = (const unsigned char*)out + (size_t)tok * 4096 + lane * 4;
#pragma unroll
            for (int k = 0; k < 4; ++k) { xw[tI][k] = *(const u32x2*)(X1B + (size_t)tok * D + 256 * k + 4 * lane);
#pragma unroll
                for (int s = 0; s < 4; ++s) yw[tI][s][k] = *(const unsigned*)(y + 1024 * s + 256 * k); } }
#pragma unroll
        for (int tI = 0; tI < 2; ++tI) { const int tok = tok0 + tI * NGW; if (tok >= NTOK) break;
            float v[16];
#pragma unroll
            for (int k = 0; k < 4; ++k) {
                v[4 * k + 0] = DN_ALPHA * bf_lo(xw[tI][k].x); v[4 * k + 1] = DN_ALPHA * bf_hi(xw[tI][k].x); v[4 * k + 2] = DN_ALPHA * bf_lo(xw[tI][k].y); v[4 * k + 3] = DN_ALPHA * bf_hi(xw[tI][k].y);
                f32x2 lo = __builtin_amdgcn_cvt_pk_f32_fp8((int)yw[tI][0][k], false) + __builtin_amdgcn_cvt_pk_f32_fp8((int)yw[tI][1][k], false) + __builtin_amdgcn_cvt_pk_f32_fp8((int)yw[tI][2][k], false) + __builtin_amdgcn_cvt_pk_f32_fp8((int)yw[tI][3][k], false);
                f32x2 hi = __builtin_amdgcn_cvt_pk_f32_fp8((int)yw[tI][0][k], true) + __builtin_amdgcn_cvt_pk_f32_fp8((int)yw[tI][1][k], true) + __builtin_amdgcn_cvt_pk_f32_fp8((int)yw[tI][2][k], true) + __builtin_amdgcn_cvt_pk_f32_fp8((int)yw[tI][3][k], true);
                v[4 * k + 0] += lo[0] * (1.0f / SY); v[4 * k + 1] += lo[1] * (1.0f / SY); v[4 * k + 2] += hi[0] * (1.0f / SY); v[4 * k + 3] += hi[1] * (1.0f / SY); }
            float s = 0.f;
#pragma unroll
            for (int q = 0; q < 16; ++q) s += v[q];
            const float mean = wave_sum(s) * (1.0f / D); float s2 = 0.f;
#pragma unroll
            for (int q = 0; q < 16; ++q) { v[q] -= mean; s2 += v[q] * v[q]; }
            const float rstd = 1.0f / sqrtf(wave_sum(s2) * (1.0f / D) + LN_EPS);
            float* op = outw + (size_t)tok * D + 4 * lane;
#pragma unroll
            for (int k = 0; k < 4; ++k) { f32x4 o;
#pragma unroll
                for (int q = 0; q < 4; ++q) o[q] = v[4 * k + q] * rstd * g[k][q] + bb[k][q];
                if (poison) o = (f32x4){qnan, qnan, qnan, qnan};
                *(f32x4*)(op + 256 * k) = o; }
        }
    }
}
#define CAS __attribute__((address_space(4)))
__device__ __forceinline__ const float* arg_in(int i) {
    const unsigned char CAS* ka = (const unsigned char CAS*)__builtin_amdgcn_kernarg_segment_ptr();
    asm volatile("" : "+s"(ka));
    return *(const float* const CAS*)(ka + 8 * i);
}
struct Args { const float* in[18]; float* out; unsigned char* ws; int ph_lo, ph_hi; };
__global__ void __launch_bounds__(NWAVES * 64, 2) fwd_kernel(Args args) {
    extern __shared__ __attribute__((aligned(16))) unsigned char lds[];
    Frame F;
    F.lds = (LAS unsigned char*)lds;
    F.MISC = (volatile LAS unsigned*)(F.lds + MISC_OFF);
    F.tid = threadIdx.x; F.lane = F.tid & 63; F.wave = __builtin_amdgcn_readfirstlane(F.tid >> 6);
    F.G = gridDim.x; { const int bx = blockIdx.x; F.vcu = (F.G % 8 == 0) ? (bx % 8) * (F.G / 8) + bx / 8 : bx; }
    F.ws = args.ws; F.dout = (unsigned char*)args.out;
    F.ctl = (gu32*)(args.ws + WS_CTL);
    for (int u = F.tid; u < (LDS_BYTES - LDSCTL_OFF) / 4; u += NWAVES * 64) ((LAS unsigned*)(F.lds + LDSCTL_OFF))[u] = 0u;
    __syncthreads();
    XcdBarrier bar; bar.bar = (unsigned*)(F.ctl + CW_BAR); bar.x = 0; bar.st = nullptr;
    if (N_LAUNCHES == 1) bar = xcd_barrier_post((unsigned*)(F.ctl + CW_BAR), F.MISC + 8);
    const int lo = args.ph_lo, hi = args.ph_hi;
#ifdef ONLY_PHASE
#define IN(k) ((k) == ONLY_PHASE && lo <= (k) && (k) < hi)
#else
#define IN(k) (lo <= (k) && (k) < hi)
#endif
#define SEAM(k) do { if (IN(k) && IN((k) + 1)) xcd_barrier(bar); } while (0)
    unsigned char* HQ = F.ws + WS_HQ; unsigned char* SG = F.ws + WS_SG;

#define PHASE(k, ...) do { if (IN(k)) { __VA_ARGS__ if (DUP_PHASE == (k)) { __VA_ARGS__ } } } while (0)
    PHASE(0, p0_convert(F, arg_in(0), arg_in(1), arg_in(3), arg_in(4), arg_in(5), arg_in(8));); SEAM(0);
    PHASE(1,
        { const int gemm_wgs = (F.G == 256) ? 192 : F.G;
          if ((int)blockIdx.x < gemm_wgs) {
            pg8::Gemm g{(const char*)(F.dout + DO_XB), (const char*)(F.dout + DO_WIN), D, D, D / 128}; pg8::StaticOrder S; S.init(NTOK, IN_COLS, gemm_wgs, (int)blockIdx.x);
            pg8::EpiInProj E{HQ, SG, 1.0f / (SXIN * SW)};
            pg8::gemm_phase<pg8::EpiInProj, pg8::StaticOrder, true, false, true>(F.lds, g, S, E); }
          if (gemm_wgs == F.G) p3_convert_moe(F, arg_in(10), arg_in(12), arg_in(14), F.vcu, F.G);
          else if ((int)blockIdx.x >= gemm_wgs) p3_convert_moe(F, arg_in(10), arg_in(12), arg_in(14), (int)blockIdx.x - gemm_wgs, F.G - gemm_wgs); }
    ); SEAM(1);
    PHASE(2, p2_attention(F, arg_in(2));); SEAM(2);
    PHASE(3, p3_merge(F);); SEAM(3);
    PHASE(4,
        { pg8::Gemm g{(const char*)(F.dout + DO_OAB), (const char*)(F.dout + DO_WCAT), OAB_P, OAB_P, OAB_P / 128}; pg8::StaticOrder S; S.init(NTOK, D, F.G, (int)blockIdx.x);
        pg8::EpiGate E{SG, F.ws + WS_MRG};
        pg8::gemm_phase<pg8::EpiGate, pg8::StaticOrder, true, false, true>(F.lds, g, S, E); }
    ); SEAM(4);
    PHASE(5,
        { pg8::Gemm g{(const char*)(F.ws + WS_MRG), (const char*)(F.ws + WS_WOUT), D, D, D / 128}; pg8::StaticOrder S; S.init(NTOK, D, F.G, (int)blockIdx.x);
        pg8::EpiY E{arg_in(0), (bf16_t*)(F.ws + WS_Y), (float*)(F.ws + WS_STAT), 1.0f / (SM * SW)};
        pg8::gemm_phase<pg8::EpiY, pg8::StaticOrder, true, false, true>(F.lds, g, S, E); }
    ); SEAM(5);
    if (IN(6)) { if (DUP_PHASE == 6) p6_router(F, (const bf16_t*)(F.ws + WS_Y), (const float*)(F.ws + WS_STAT), arg_in(6), arg_in(7), (bf16_t*)(F.ws + 264 * MiB), F.ws + 330 * MiB, arg_in(9), CW_ECNT + 64 * NEXP, (size_t)362 * MiB - WS_PETOK);
        p6_router(F, (const bf16_t*)(F.ws + WS_Y), (const float*)(F.ws + WS_STAT), arg_in(6), arg_in(7), (bf16_t*)(F.ws + WS_X1B), F.ws + WS_X1Q, arg_in(9), CW_ECNT, 0); } SEAM(6);
    PHASE(7,
        { const int T = moe_tables(F);
        pg8::Gemm g{(const char*)(F.ws + WS_X1Q), (const char*)(F.ws + WS_WGU), D, D, D / 128};
        pg8::MoeOrder S{T, 8, F.G, (int)blockIdx.x, (const LAS int*)(F.lds + MOE_OFF), (const LAS int*)(F.lds + MOE_OFF + 128), (const LAS unsigned char*)(F.lds + MOE_OFF + 128 + 136),
                        (const int*)(F.ws + WS_PETOK), (size_t)2048 * D, true, (unsigned)D};
        pg8::EpiGU E{arg_in(11), arg_in(13), F.ws + WS_HDN, F.lds};
        pg8::gemm_phase<pg8::EpiGU, pg8::MoeOrder, true, true, true>(F.lds, g, S, E); }
    ); SEAM(7);
    PHASE(8,
        { const int T = moe_tables(F);
        pg8::Gemm g{(const char*)(F.ws + WS_HDN), (const char*)(F.ws + WS_WD), DFF, DFF, DFF / 128};
        pg8::MoeOrder S{T, 4, F.G, (int)blockIdx.x, (const LAS int*)(F.lds + MOE_OFF), (const LAS int*)(F.lds + MOE_OFF + 128), (const LAS unsigned char*)(F.lds + MOE_OFF + 128 + 136),
                        (const int*)(F.ws + WS_PETOK), (size_t)D * DFF, false, 0u};
        pg8::EpiDown E{arg_in(15), (const int*)(F.ws + WS_PETOK), (const float*)(F.ws + WS_PEGATE), F.dout, F.lds};
        pg8::gemm_phase<pg8::EpiDown, pg8::MoeOrder, true, false, true>(F.lds, g, S, E); }
    ); SEAM(8);
    if (IN(9)) {
        bool poison = (__hip_atomic_load(F.ctl + CW_TMO, RLX_AGENT) != 0u) || (__hip_atomic_load(F.ctl + CW_BAR + XB_TMO, RLX_AGENT) != 0u);
        if (DUP_PHASE == 9) p9_final(F, arg_in(16), arg_in(17), (const float*)F.dout, (float*)(F.ws + 194 * MiB), poison);
        p9_final(F, arg_in(16), arg_in(17), (const float*)F.dout, (float*)F.dout, poison);
    }
#undef PHASE
#undef IN
#undef SEAM
}

extern "C" void kernel_launch(void* const* d_in, const int* in_sizes, int n_in, void* d_out, int out_size, void* d_ws, size_t ws_size, hipStream_t stream) {
    static int grid = 0;
    if (grid == 0) {
        if (n_in != 18 || in_sizes[0] != NTOK * D || out_size != NTOK * D || ws_size < WS_END) { fprintf(stderr, "kernel_launch: unexpected shapes (n_in %d, ws %zu); nothing launched\n", n_in, ws_size); grid = -1; return; }
        int dev = 0, cus = 0, per_cu = 0;
        if (hipGetDevice(&dev) != hipSuccess || hipDeviceGetAttribute(&cus, hipDeviceAttributeMultiprocessorCount, dev) != hipSuccess) { grid = -1; return; }
        if (hipFuncSetAttribute((const void*)fwd_kernel, hipFuncAttributeMaxDynamicSharedMemorySize, LDS_BYTES) != hipSuccess) { fprintf(stderr, "kernel_launch: hipFuncSetAttribute failed\n"); grid = -1; return; }
        if (hipOccupancyMaxActiveBlocksPerMultiprocessor(&per_cu, (const void*)fwd_kernel, NWAVES * 64, LDS_BYTES) != hipSuccess || per_cu < 1) fprintf(stderr, "kernel_launch: occupancy query reports %d\n", per_cu);
        (void)hipGetLastError();
        grid = cus;
    }
    if (grid < 0) return;
    if (hipMemsetAsync((char*)d_ws + WS_CTL, 0, CTL_ZERO_BYTES, stream) != hipSuccess) return;
    Args a{};
    for (int i = 0; i < 18; ++i) a.in[i] = (const float*)d_in[i];
    a.out = (float*)d_out; a.ws = (unsigned char*)d_ws;
    if (N_LAUNCHES == 1) { a.ph_lo = 0; a.ph_hi = N_PHASES; hipLaunchKernelGGL(fwd_kernel, dim3(grid), dim3(NWAVES * 64), LDS_BYTES, stream, a); }
    else for (int p = 0; p < N_PHASES; ++p) { a.ph_lo = p; a.ph_hi = p + 1; hipLaunchKernelGGL(fwd_kernel, dim3(grid), dim3(NWAVES * 64), LDS_BYTES, stream, a); }
}
```

```cpp
#include <hip/hip_runtime.h>
#include <cstdio>
#include <cstdint>

#define GAS __attribute__((address_space(1)))
#define LAS __attribute__((address_space(3)))
typedef unsigned short bf16_t;
typedef short bf16x8 __attribute__((ext_vector_type(8)));
typedef short s16x4 __attribute__((ext_vector_type(4)));
typedef float f32x2 __attribute__((ext_vector_type(2)));
typedef float f32x4 __attribute__((ext_vector_type(4)));
typedef float f32x16 __attribute__((ext_vector_type(16)));
typedef unsigned u32x2 __attribute__((ext_vector_type(2)));
typedef unsigned u32x4 __attribute__((ext_vector_type(4)));
typedef GAS unsigned gu32;

#ifndef MK_N_LAUNCHES
#define MK_N_LAUNCHES 1
#endif
#ifndef DUP_PHASE
#define DUP_PHASE -1
#endif
constexpr int N_PHASES = 10;
constexpr int N_LAUNCHES = MK_N_LAUNCHES;

constexpr int NB = 8, SEQ = 4096, D = 1024, NTOK = NB * SEQ;
constexpr int HQ_P = 3584;
constexpr int SG_P = 2048;
constexpr int OAB_P = 1280;
constexpr int IN_COLS = 5632;
constexpr int NEXP = 32, TOPK = 4, DFF = 1024;
constexpr int MAX_MT = 544;
constexpr float LN_EPS = 1e-5f;
constexpr float DN_ALPHA = 1.189207115002721f;
constexpr float LOG2E = 1.4426950408889634f, LN2 = 0.6931471805599453f;
constexpr float QSCALE = 0.125f * LOG2E;
constexpr float NEG_BIG = -1e30f;

constexpr size_t MiB = 1u << 20;
constexpr size_t WS_CTL = 0, CTL_ZERO_BYTES = 160 * 1024;
constexpr size_t WS_XBUF = 1 * MiB;
constexpr size_t WS_Y = 98 * MiB;
constexpr size_t WS_STAT = 34 * MiB;
constexpr size_t WS_HQ = 2 * MiB;
constexpr size_t HQ_QD = 0, HQ_KD = 48 * MiB, HQ_VD = 96 * MiB, HQ_QS = 144 * MiB, HQ_KS = 208 * MiB, HQ_VS = 216 * MiB;
constexpr size_t WS_WGU = 404 * MiB;
constexpr size_t WS_WD = 468 * MiB;
constexpr size_t WS_X1Q = 162 * MiB;
constexpr size_t WS_HDN = 194 * MiB;
constexpr size_t WS_SG = 226 * MiB;
constexpr size_t WS_YS23 = 330 * MiB;
constexpr size_t WS_OAG = 354 * MiB;
constexpr size_t WS_LSE = 402 * MiB;
constexpr size_t WS_MRG = 2 * MiB;
constexpr size_t WS_WOUT = 530 * MiB;
constexpr size_t WS_PETOK = 532 * MiB;
constexpr size_t WS_PEGATE = 536 * MiB;
constexpr size_t WS_WRT = 540 * MiB;
constexpr size_t WS_END = 540 * MiB + 256 * 1024;
constexpr float SX = 8.0f, SW = 512.0f, SH = 4.0f, SXIN = 8.0f, SY = 64.0f, SM = 64.0f, SO = 64.0f, SSG = 256.0f, SQ = 64.0f, SK = 16.0f;
static_assert(WS_HQ + (size_t)NTOK * HQ_P * 2 <= WS_SG && WS_SG + (size_t)NTOK * SG_P <= WS_OAG && WS_OAG + (size_t)3 * NTOK * 256 * 2 <= WS_LSE && WS_LSE + (size_t)3 * NTOK * 4 * 4 <= WS_WGU, "ws map 1");
static_assert(WS_WGU + (size_t)NEXP * 2048 * D <= WS_WD && WS_WD + (size_t)NEXP * D * DFF <= WS_WOUT && WS_MRG + (size_t)NTOK * D <= WS_STAT && WS_STAT + (size_t)NTOK * 32 * 4 <= WS_Y && WS_Y + (size_t)NTOK * D * 2 <= WS_X1Q && WS_X1Q + (size_t)NTOK * D <= WS_HDN, "ws map 2");
static_assert(WS_HDN + (size_t)MAX_MT * 256 * DFF <= WS_OAG && WS_WOUT + (size_t)D * D <= WS_PETOK, "ws map 3");
constexpr size_t DO_XB = 0;
constexpr size_t DO_OAB = 0;
constexpr size_t DO_WIN = 96 * MiB;
constexpr size_t DO_WCAT = 108 * MiB;
constexpr int CW_TMO = 0, CW_CODE = 1;
constexpr int CW_BAR = 4096;
constexpr int CW_SEAM = 16384;
constexpr int CW_ECNT = 32768;
static_assert((CW_ECNT + 2 * 64 * NEXP) * 4 <= (int)CTL_ZERO_BYTES, "CTL words inside the memset region");

constexpr int RING_BYTES = 131072;
constexpr int SCR_BYTES = 143360;
constexpr int LDSCTL_OFF = SCR_BYTES;
constexpr int MISC_OFF = LDSCTL_OFF + 320;
constexpr int MOE_OFF = LDSCTL_OFF + 512;
constexpr int LDS_BYTES = 147456;
static_assert(MOE_OFF + 128 + 136 + MAX_MT <= LDS_BYTES, "LDS map");

#define RLX_AGENT __ATOMIC_RELAXED, __HIP_MEMORY_SCOPE_AGENT
#define LDS_WAIT() asm volatile("s_waitcnt lgkmcnt(0)" ::: "memory")
#define VM_WAIT() asm volatile("s_waitcnt vmcnt(0)" ::: "memory")

__device__ __forceinline__ unsigned cvt_pk_bf16(float lo, float hi) { unsigned r; asm volatile("v_cvt_pk_bf16_f32 %0, %1, %2" : "=v"(r) : "v"(lo), "v"(hi)); return r; }
__device__ __forceinline__ int opaque(int v) { asm volatile("" : "+v"(v)); return v; }
__device__ __forceinline__ unsigned pk4_fp8(float a, float b, float c, float d) { int w = 0; w = __builtin_amdgcn_cvt_pk_fp8_f32(a, b, w, false); w = __builtin_amdgcn_cvt_pk_fp8_f32(c, d, w, true); return (unsigned)w; }
__device__ __forceinline__ unsigned f2e4m3_sw(float x) {
    const float a = __builtin_amdgcn_fmed3f(fabsf(x), 9.5367431640625e-07f, 448.f);
    const int e1 = max(__builtin_amdgcn_frexp_expf(a), -5);
    const unsigned m = (unsigned)__builtin_rintf(__builtin_amdgcn_ldexpf(a, 4 - e1));
    return ((__float_as_uint(x) >> 24) & 0x80u) | (unsigned)((e1 << 3) + 40 + (int)m); }
__device__ __forceinline__ unsigned pk4_fp8_pad(float a, float b, float c, float d) {
    unsigned w;
    asm("v_cvt_pk_fp8_f32 %0, %1, %2\n\ts_nop 1" : "=v"(w) : "v"(a), "v"(b));
    asm("v_cvt_pk_fp8_f32 %0, %1, %2 op_sel:[0,0,1]\n\ts_nop 1" : "+v"(w) : "v"(c), "v"(d));
    return w; }
__device__ __forceinline__ float clamp_fp8(float v) { return __builtin_amdgcn_fmed3f(v, -448.0f, 448.0f); }
__device__ __forceinline__ float bf_lo(unsigned w) { return __uint_as_float(w << 16); }
__device__ __forceinline__ float bf_hi(unsigned w) { return __uint_as_float(w & 0xffff0000u); }
__device__ __forceinline__ float fast_sigmoid(float g) { g = fminf(fmaxf(g, -60.f), 60.f); return __builtin_amdgcn_rcpf(1.0f + __builtin_amdgcn_exp2f(-g * LOG2E)); }

namespace pg8 {
constexpr int BM = 256, BK = 64, HALF = 128, HTB = HALF * BK * 2, STAGE_BYTES = 8 * HTB, NXCD = 8, WGM = 4;
constexpr int EPRE_OFF = STAGE_BYTES;
static_assert(EPRE_OFF + 3072 <= SCR_BYTES, "epilogue prefetch area");
__host__ __device__ __forceinline__ int lds_byte(int r, int c) { const int st = (r >> 4) * 2 + (c >> 5), rr = r & 15, cc = c & 31, ob = rr * 64 + cc * 2; return st * 1024 + (ob ^ (((ob >> 9) & 1) << 5)); }
__host__ __device__ __forceinline__ void stage_rc(int b, int& R, int& C) { const int st = b / 1024, sb = b % 1024, swz = sb ^ (((sb >> 9) & 1) << 5); R = (st >> 1) * 16 + swz / 64; C = (st & 1) * 32 + (swz % 64) / 2; }
__host__ __device__ __forceinline__ int perm32(int rho) { const int n = rho >> 4, i = rho & 15; return 8 * (i >> 2) + 4 * n + (i & 3); }

struct Unit { int pm, pn, e, ti, valid; };
struct Gemm { const char* A; const char* Bt; int lda, ldb, nt; };

__device__ __forceinline__ bool tile_of(long L, int nM, int nN, int& pm, int& pn) {
    const int nwg = nM * nN; if (L >= nwg) return false;
    int wgid = (int)L; { const int q = nwg / NXCD, r = nwg % NXCD, xcd = wgid % NXCD, off = wgid / NXCD; wgid = (xcd < r ? xcd * (q + 1) : r * (q + 1) + (xcd - r) * q) + off; }
    const int nig = WGM * nN, gid = wgid / nig, fm = gid * WGM, gsz = (nM - fm) < WGM ? (nM - fm) : WGM;
    pm = fm + ((wgid % nig) % gsz); pn = (wgid % nig) / gsz; return true;
}
struct StaticOrder {
    int nM, nN, G, c;
    __device__ __forceinline__ void init(int M, int N, int G_, int c_) { nM = M / BM; nN = N / BM; G = G_; c = c_; }
    __device__ __forceinline__ bool next(int i, Unit& u) const { u.e = 0; u.ti = 0; u.valid = 256; return tile_of((long)i * G + c, nM, nN, u.pm, u.pn); }
    __device__ __forceinline__ const char* a_ptr(const Gemm& g, const Unit& u) const { return g.A + (size_t)u.pm * 256 * g.lda; }
    __device__ __forceinline__ const char* b_ptr(const Gemm& g, const Unit& u) const { return g.Bt + (size_t)u.pn * 256 * g.ldb; }
    __device__ __forceinline__ unsigned row_off(const Unit&, int) const { return 0u; }
};
struct MoeOrder {
    int T, nN, G, c; const LAS int* cnt; const LAS int* fs; const LAS unsigned char* te;
    const int* petok; size_t b_exp_stride; bool gather; unsigned rowbytes;
    __device__ __forceinline__ bool next(int i, Unit& u) const {
        if (!tile_of((long)i * G + c, T, nN, u.pm, u.pn)) return false;
        u.e = __builtin_amdgcn_readfirstlane((int)te[u.pm]); u.ti = u.pm - __builtin_amdgcn_readfirstlane(fs[u.e]); const int left = __builtin_amdgcn_readfirstlane(cnt[u.e]) - u.ti * 256; u.valid = left < 256 ? left : 256; return true;
    }
    __device__ __forceinline__ const char* a_ptr(const Gemm& g, const Unit& u) const { return gather ? g.A : g.A + (size_t)u.pm * 256 * g.lda; }
    __device__ __forceinline__ const char* b_ptr(const Gemm& g, const Unit& u) const { return g.Bt + (size_t)u.e * b_exp_stride + (size_t)u.pn * 256 * g.ldb; }
    __device__ __forceinline__ void pre_rows(LAS unsigned char* lds, const Unit& u, int wid, int lane) const {
        if (wid == 0) __builtin_amdgcn_global_load_lds((const unsigned*)(petok + (size_t)u.e * NTOK + u.ti * 256 + lane * 4), (LAS unsigned*)(lds + EPRE_OFF + 1024), 16, 0, 0);
    }
    __device__ __forceinline__ unsigned row_off_lds(const LAS unsigned char* lds, const Unit& u, int R) const {
        int w = *(const LAS int*)(lds + EPRE_OFF + 1024 + 4 * R); asm volatile("" : "+v"(w));
        return (R < u.valid) ? (unsigned)(w >> 2) * rowbytes : 0u;
    }
    __device__ __forceinline__ unsigned row_off(const Unit& u, int R) const {
        int w = petok[(size_t)u.e * NTOK + u.ti * 256 + R]; asm volatile("" : "+v"(w));
        return (R < u.valid) ? (unsigned)(w >> 2) * rowbytes : 0u;
    }
};

typedef int v8i32 __attribute__((ext_vector_type(8)));
template <class Epi, class Sched, bool ALIGN_EPI, bool GATHER, bool F8 = false>
__device__ __forceinline__ void gemm_phase(LAS unsigned char* lds, const Gemm g, const Sched& S, const Epi& E) {
    const int tid = threadIdx.x, wid = __builtin_amdgcn_readfirstlane(tid >> 6), lane = tid & 63, wr = wid >> 2, wc = wid & 3, fr = lane & 15, fq = lane >> 4;
    const int nt = g.nt;
    unsigned voffA[2], voffB[2]; int RA[2], CA2[2];
#pragma unroll
    for (int i = 0; i < 2; ++i) { int R, C; stage_rc(tid * 16 + i * 8192, R, C); const int Rb = Epi::PERM ? ((R & ~31) + perm32(R & 31)) : R;
        voffA[i] = (unsigned)(R * g.lda + C * 2); voffB[i] = (unsigned)(Rb * g.ldb + C * 2); RA[i] = R; CA2[i] = C * 2; }
    const size_t kstep = (size_t)(BK * 2);
    const size_t hstepA = (size_t)HALF * g.lda, hstepB = (size_t)HALF * g.ldb;
    const unsigned ldsw = (unsigned)wid * 1024u;
    const int aoff = lds_byte(wr * 64 + fr, fq * 8), boff = lds_byte(wc * 32 + fr, fq * 8);
    const int aoff0 = aoff, boff0 = boff, aoff1 = aoff + 1024, boff1 = boff + 1024;
#define PG8_SA(b, h) (((b) * 2 + (h)) * HTB)
#define PG8_SB(b, h) ((4 + (b) * 2 + (h)) * HTB)
#define PG8_STAGE(bufoff, gbase, voff) do { _Pragma("unroll") for (int _i = 0; _i < 2; ++_i) \
        __builtin_amdgcn_global_load_lds((const unsigned*)((const char*)(gbase) + (voff)[_i]), (LAS unsigned*)(lds + (bufoff) + ldsw + _i * 8192), 16, 0, 0); } while (0)
#define PG8_STAGE_A(bufoff, kp, h, nx) do { if constexpr (GATHER) { unsigned _v[2]; _v[0] = (nx) ? gN[h][0] : gC[h][0]; _v[1] = (nx) ? gN[h][1] : gC[h][1]; PG8_STAGE(bufoff, kp, _v); } \
        else { PG8_STAGE(bufoff, (kp) + (h) * hstepA, voffA); } } while (0)
#define PG8_LDA(dst, b, h) do { _Pragma("unroll") for (int m = 0; m < 4; ++m) _Pragma("unroll") for (int k = 0; k < 2; ++k) dst[m][k] = *(const LAS bf16x8*)(lds + PG8_SA(b, h) + (k ? aoff1 : aoff0) + m * 2048); } while (0)
#define PG8_LDB(dst, b, h) do { _Pragma("unroll") for (int n = 0; n < 2; ++n) _Pragma("unroll") for (int k = 0; k < 2; ++k) dst[n][k] = *(const LAS bf16x8*)(lds + PG8_SB(b, h) + (k ? boff1 : boff0) + n * 2048); } while (0)
#define PG8_F8OP(X) __builtin_bit_cast(v8i32, __builtin_shufflevector(X[0], X[1], 0, 1, 2, 3, 4, 5, 6, 7, 8, 9, 10, 11, 12, 13, 14, 15))
#define PG8_MMA(ai, bj, At, Bt) do { if constexpr (!F8) __builtin_amdgcn_s_setprio(1); if constexpr (F8) { _Pragma("unroll") for (int m = 0; m < 4; ++m) _Pragma("unroll") for (int n = 0; n < 2; ++n) \
        asm volatile("v_mfma_scale_f32_16x16x128_f8f6f4 %0, %1, %2, %0, %3, %3 op_sel_hi:[0,0,0]" : "+v"(acc[ai][bj][m][n]) : "v"(PG8_F8OP(Bt[n])), "v"(PG8_F8OP(At[m])), "v"(one_scale)); } \
        else { _Pragma("unroll") for (int m = 0; m < 4; ++m) _Pragma("unroll") for (int n = 0; n < 2; ++n) _Pragma("unroll") for (int k = 0; k < 2; ++k) \
        acc[ai][bj][m][n] = __builtin_amdgcn_mfma_f32_16x16x32_bf16(Bt[n][k], At[m][k], acc[ai][bj][m][n], 0, 0, 0); } if constexpr (!F8) __builtin_amdgcn_s_setprio(0); } while (0)
#define PG8_MMA0(ai, bj, At, Bt) do { _Pragma("unroll") for (int m = 0; m < 4; ++m) _Pragma("unroll") for (int n = 0; n < 2; ++n) \
        asm volatile("v_mfma_scale_f32_16x16x128_f8f6f4 %0, %1, %2, 0, %3, %3 op_sel_hi:[0,0,0]" : "=&v"(acc[ai][bj][m][n]) : "v"(PG8_F8OP(Bt[n])), "v"(PG8_F8OP(At[m])), "v"(one_scale)); } while (0)
#define PG8_WAIT_V(n) asm volatile("s_waitcnt vmcnt(" #n ")" ::: "memory")
#define PG8_WAIT_L(n) asm volatile("s_waitcnt lgkmcnt(" #n ")" ::: "memory")
#define PG8_BAR __builtin_amdgcn_s_barrier()
#define PG8_SCHED __builtin_amdgcn_sched_barrier(0)
    Unit cur, nxt; int ui = 0;
    if (!S.next(0, cur)) return;
    int one_scale = 0x7f7f7f7f; if constexpr (F8) asm volatile("" : "+v"(one_scale));
    unsigned gC[2][2], gN[2][2];
#pragma unroll
    for (int h = 0; h < 2; ++h)
#pragma unroll
        for (int i = 0; i < 2; ++i) { gC[h][i] = GATHER ? S.row_off(cur, h * HALF + RA[i]) + (unsigned)CA2[i] : 0u; gN[h][i] = gC[h][i]; }
    f32x4 acc[2][2][4][2];
#pragma unroll
    for (int a = 0; a < 2; ++a)
#pragma unroll
        for (int b = 0; b < 2; ++b)
#pragma unroll
            for (int m = 0; m < 4; ++m)
#pragma unroll
                for (int n = 0; n < 2; ++n) { if constexpr (F8) asm volatile("" : "=v"(acc[a][b][m][n])); else acc[a][b][m][n] = (f32x4){0.f, 0.f, 0.f, 0.f}; }
    bf16x8 At[4][2], B0[2][2], B1[2][2];
    const char* cA = S.a_ptr(g, cur); const char* cB = S.b_ptr(g, cur);
    PG8_STAGE(PG8_SB(0, 0), cB, voffB); PG8_STAGE(PG8_SB(0, 1), cB + hstepB, voffB); PG8_STAGE_A(PG8_SA(0, 0), cA, 0, false); PG8_STAGE_A(PG8_SA(0, 1), cA, 1, false);
    if (wr == 1) PG8_BAR;
    PG8_WAIT_V(2); PG8_BAR;
    PG8_STAGE(PG8_SB(1, 0), cB + kstep, voffB); PG8_STAGE_A(PG8_SA(1, 0), cA + kstep, 0, false); PG8_STAGE(PG8_SB(1, 1), cB + hstepB + kstep, voffB);
    PG8_WAIT_V(6); PG8_BAR;
    for (;;) {
        const bool has_next = S.next(ui + 1, nxt);
        const char* nA = has_next ? S.a_ptr(g, nxt) : cA; const char* nB = has_next ? S.b_ptr(g, nxt) : cB;
#pragma unroll 1
        for (int t = 0; t < nt; t += 2) {
            const bool last = (t == nt - 2);
            asm volatile("" : "+v"(voffA[0]), "+v"(voffA[1]), "+v"(voffB[0]), "+v"(voffB[1]));
            if constexpr (GATHER) { if (has_next) { if (t == 0) S.pre_rows(lds, nxt, wid, lane);
                if (last) {
#pragma unroll
                    for (int h = 0; h < 2; ++h)
#pragma unroll
                        for (int i = 0; i < 2; ++i) gN[h][i] = S.row_off_lds(lds, nxt, h * HALF + RA[i]) + (unsigned)CA2[i]; } } }
            if constexpr (Epi::HAS_MID) { if (t == Epi::MID_T) E.mid(acc, cur, wr, wc, fr, fq); }
            if constexpr (Epi::HAS_PRE) { if (last) E.pre(lds, cur, wid, lane); }
            const char* a1 = cA + (size_t)(t + 1) * kstep;
            const char* a2 = last ? nA : cA + (size_t)(t + 2) * kstep; const char* b2 = last ? nB : cB + (size_t)(t + 2) * kstep;
            const char* a3 = a2 + kstep; const char* b3 = b2 + kstep;
            PG8_LDB(B0, 0, 0); PG8_LDB(B1, 0, 1); PG8_SCHED; PG8_LDA(At, 0, 0); PG8_STAGE_A(PG8_SA(1, 1), a1, 1, false);
            PG8_WAIT_V(8); PG8_WAIT_L(0); PG8_BAR; if (F8 && t == 0) { PG8_MMA0(0, 0, At, B0); PG8_MMA0(0, 1, At, B1); } else { PG8_MMA(0, 0, At, B0); PG8_MMA(0, 1, At, B1); } PG8_BAR; PG8_SCHED;
            PG8_LDA(At, 0, 1); PG8_STAGE(PG8_SB(0, 0), b2, voffB); PG8_STAGE(PG8_SB(0, 1), b2 + hstepB, voffB); PG8_STAGE_A(PG8_SA(0, 0), a2, 0, last);
            PG8_WAIT_V(8); PG8_WAIT_L(0); PG8_BAR; if (F8 && t == 0) { PG8_MMA0(1, 0, At, B0); PG8_MMA0(1, 1, At, B1); } else { PG8_MMA(1, 0, At, B0); PG8_MMA(1, 1, At, B1); } PG8_BAR; PG8_SCHED;
            PG8_LDB(B0, 1, 0); PG8_LDB(B1, 1, 1); PG8_SCHED; PG8_LDA(At, 1, 0); PG8_STAGE_A(PG8_SA(0, 1), a2, 1, last);
            PG8_WAIT_V(8); PG8_WAIT_L(0); PG8_BAR; PG8_MMA(0, 0, At, B0); PG8_MMA(0, 1, At, B1); PG8_BAR; PG8_SCHED;
            PG8_LDA(At, 1, 1); PG8_STAGE(PG8_SB(1, 0), b3, voffB); PG8_STAGE(PG8_SB(1, 1), b3 + hstepB, voffB); PG8_STAGE_A(PG8_SA(1, 0), a3, 0, last);
            PG8_WAIT_V(8); PG8_WAIT_L(0); PG8_BAR; PG8_MMA(1, 0, At, B0); PG8_MMA(1, 1, At, B1); PG8_BAR; PG8_SCHED;
        }
        if constexpr (ALIGN_EPI) { if (wr == 0) PG8_BAR; }
        if constexpr (F8) asm volatile("s_nop 15\n\ts_nop 15" ::: "memory");
        if constexpr (!Epi::AFTER_DRAIN) { E(acc, cur, wr, wc, fr, fq); }
        if (!has_next) break;
#pragma unroll
        for (int a = 0; a < 2; ++a)
#pragma unroll
            for (int b = 0; b < 2; ++b)
#pragma unroll
                for (int m = 0; m < 4; ++m)
#pragma unroll
                    for (int n = 0; n < 2; ++n) { if constexpr (!F8) acc[a][b][m][n] = (f32x4){0.f, 0.f, 0.f, 0.f}; }
        cur = nxt; cA = nA; cB = nB; ++ui;
#pragma unroll
        for (int h = 0; h < 2; ++h)
#pragma unroll
            for (int i = 0; i < 2; ++i) gC[h][i] = gN[h][i];
        if constexpr (ALIGN_EPI) { if (wr == 1) PG8_BAR; }
    }
    PG8_WAIT_V(0);
    if constexpr (!ALIGN_EPI) { if (wr == 0) PG8_BAR; }
    PG8_BAR;
    if constexpr (Epi::AFTER_DRAIN) { E.fused(acc, cur, wr, wc, fr, fq, lds, wid, lane); }
#undef PG8_SA
#undef PG8_SB
#undef PG8_STAGE
#undef PG8_STAGE_A
#undef PG8_LDA
#undef PG8_LDB
#undef PG8_MMA
#undef PG8_MMA0
#undef PG8_F8OP
#undef PG8_WAIT_V
#undef PG8_WAIT_L
#undef PG8_BAR
#undef PG8_SCHED
}
}

namespace pg8 {
__device__ __forceinline__ u32x4 pair16(u32x2 x, u32x2 y) {
    const auto sx = __builtin_amdgcn_permlane16_swap(x.x, y.x, false, false), sy = __builtin_amdgcn_permlane16_swap(x.y, y.y, false, false);
    u32x4 o; o.x = sx[0]; o.y = sy[0]; o.z = sx[1]; o.w = sy[1]; return o; }
__device__ __forceinline__ void unpair16(u32x4 v, u32x2& x, u32x2& y) {
    const auto sx = __builtin_amdgcn_permlane16_swap(v.x, v.z, false, false), sy = __builtin_amdgcn_permlane16_swap(v.y, v.w, false, false);
    x.x = sx[0]; x.y = sy[0]; y.x = sx[1]; y.y = sy[1]; }
struct EpiInProj {
    static constexpr bool PERM = true, AFTER_DRAIN = false, HAS_MID = false, HAS_PRE = false; static constexpr int MID_T = 0;
    unsigned char* HQ; unsigned char* SG; float rs;
    __device__ __forceinline__ void mid(f32x4 (&)[2][2][4][2], const Unit&, int, int, int, int) const {}
    __device__ __forceinline__ void operator()(const f32x4 (&acc)[2][2][4][2], const Unit& u, int wr, int wc, int fr, int fq) const {
        const int pn = u.pn, b = (u.pm * BM) >> 12, t0 = (u.pm * BM) & (SEQ - 1), lr = wr * 64 + opaque(fr), fqo = fq & 1;
        const int dcol = (wc & 1) * 32 + 8 * fq;
        if (pn >= 14) {
            const float nrl = -rs * LOG2E;
            unsigned char* ub = SG + (size_t)(u.pm * BM) * SG_P + (pn - 14) * 256;
            const unsigned vo = (unsigned)(lr * SG_P + wc * 32 + 8 * fq + (fqo ? HALF - 8 : 0));
#pragma unroll
            for (int ai = 0; ai < 2; ++ai)
#pragma unroll
                for (int m = 0; m < 4; ++m) { u32x2 w8[2];
#pragma unroll
                    for (int bj = 0; bj < 2; ++bj) { f32x4 v0 = acc[ai][bj][m][0], v1 = acc[ai][bj][m][1];
#pragma unroll
                        for (int q = 0; q < 4; q += 2) {
                            const f32x2 z0 = (f32x2){v0[q], v0[q + 1]} * nrl, z1 = (f32x2){v1[q], v1[q + 1]} * nrl;
                            const f32x2 d0 = (f32x2){__builtin_amdgcn_exp2f(z0[0]), __builtin_amdgcn_exp2f(z0[1])} * (1.0f / SSG) + (1.0f / SSG), d1 = (f32x2){__builtin_amdgcn_exp2f(z1[0]), __builtin_amdgcn_exp2f(z1[1])} * (1.0f / SSG) + (1.0f / SSG);
                            v0[q] = fmaxf(__builtin_amdgcn_rcpf(d0[0]), 0.001953125f); v0[q + 1] = fmaxf(__builtin_amdgcn_rcpf(d0[1]), 0.001953125f);
                            v1[q] = fmaxf(__builtin_amdgcn_rcpf(d1[0]), 0.001953125f); v1[q + 1] = fmaxf(__builtin_amdgcn_rcpf(d1[1]), 0.001953125f); }
                        w8[bj].x = pk4_fp8(v0[0], v0[1], v0[2], v0[3]); w8[bj].y = pk4_fp8(v1[0], v1[1], v1[2], v1[3]); }
                    *(u32x4*)(ub + (vo + (unsigned)((ai * HALF + m * 16) * SG_P))) = pair16(w8[0], w8[1]); }
        } else if (pn < 6 || (pn >= 9 && pn < 13)) {
            const bool dilated = pn < 9; const int ty = dilated ? pn / 3 : 0, g = dilated ? pn - 3 * ty : 0, sh = 2 * g;
            const float qk = rs * ((pn >= 3 && pn < 6) ? SK : QSCALE * SQ);
            unsigned char* ub = dilated ? HQ + (size_t)ty * (48 * MiB) + (size_t)((g * NB + b) * 4) * SEQ * 64 : HQ + HQ_QS + (size_t)(b * 16 + (pn - 9) * 4) * SEQ * 64;
            const int hl = (wc >> 1) + 2 * fqo;
            const unsigned vo = (unsigned)(hl * SEQ * 64 + dcol - 8 * fqo); const int tl = t0 + lr, msk = (1 << sh) - 1;
#pragma unroll
            for (int ai = 0; ai < 2; ++ai)
#pragma unroll
                for (int m = 0; m < 4; ++m) { u32x2 w8[2];
#pragma unroll
                    for (int bj = 0; bj < 2; ++bj) { const f32x4 v0 = acc[ai][bj][m][0] * qk, v1 = acc[ai][bj][m][1] * qk;
                        w8[bj].x = pk4_fp8(clamp_fp8(v0[0]), clamp_fp8(v0[1]), clamp_fp8(v0[2]), clamp_fp8(v0[3])); w8[bj].y = pk4_fp8(clamp_fp8(v1[0]), clamp_fp8(v1[1]), clamp_fp8(v1[2]), clamp_fp8(v1[3])); }
                    const int t = tl + ai * HALF + m * 16, pos = ((t & msk) << (12 - sh)) + (t >> sh);
                    *(u32x4*)(ub + (vo + (unsigned)(pos * 64))) = pair16(w8[0], w8[1]); }
        } else if (pn < 9) {
            const int g = pn - 6, sh = 2 * g, tl = t0 + lr, msk = (1 << sh) - 1;
            unsigned char* ub = HQ + (size_t)2 * (48 * MiB) + (size_t)((g * NB + b) * 4) * SEQ * 128;
#pragma unroll
            for (int ai = 0; ai < 2; ++ai)
#pragma unroll
                for (int m = 0; m < 4; ++m) { const int t = tl + ai * HALF + m * 16, pos = ((t & msk) << (12 - sh)) + (t >> sh);
#pragma unroll
                    for (int bj = 0; bj < 2; ++bj) { const f32x4 v0 = acc[ai][bj][m][0] * rs, v1 = acc[ai][bj][m][1] * rs; const int hl = bj * 2 + (wc >> 1);
                        u32x4 w; w.x = cvt_pk_bf16(v0[0], v0[1]); w.y = cvt_pk_bf16(v0[2], v0[3]); w.z = cvt_pk_bf16(v1[0], v1[1]); w.w = cvt_pk_bf16(v1[2], v1[3]);
                        *(u32x4*)(ub + (unsigned)((hl * SEQ + pos) * 128 + dcol * 2)) = w; } }
        } else {
            unsigned char* ubk = HQ + HQ_KS + (size_t)(b * 2) * SEQ * 64; unsigned char* ubv = HQ + HQ_VS + (size_t)(b * 2) * SEQ * 128;
            const int tl = t0 + lr; const float qk = rs * SK;
#pragma unroll
            for (int ai = 0; ai < 2; ++ai)
#pragma unroll
                for (int m = 0; m < 4; ++m) { const int ri = (wc >> 1) * SEQ + tl + ai * HALF + m * 16;
                    { const f32x4 v0 = acc[ai][0][m][0] * qk, v1 = acc[ai][0][m][1] * qk; u32x2 w8;
                      w8.x = pk4_fp8(clamp_fp8(v0[0]), clamp_fp8(v0[1]), clamp_fp8(v0[2]), clamp_fp8(v0[3])); w8.y = pk4_fp8(clamp_fp8(v1[0]), clamp_fp8(v1[1]), clamp_fp8(v1[2]), clamp_fp8(v1[3]));
                      *(u32x2*)(ubk + (unsigned)(ri * 64 + dcol)) = w8; }
                    { const f32x4 v0 = acc[ai][1][m][0] * rs, v1 = acc[ai][1][m][1] * rs;
                      u32x4 w; w.x = cvt_pk_bf16(v0[0], v0[1]); w.y = cvt_pk_bf16(v0[2], v0[3]); w.z = cvt_pk_bf16(v1[0], v1[1]); w.w = cvt_pk_bf16(v1[2], v1[3]);
                      *(u32x4*)(ubv + (unsigned)(ri * 128 + dcol * 2)) = w; } }
        }
    }
};
struct EpiGate {
    static constexpr bool PERM = true, AFTER_DRAIN = false, HAS_MID = true, HAS_PRE = false; static constexpr int MID_T = 2;
    const unsigned char* __restrict__ SG; unsigned char* __restrict__ O;
    __device__ __forceinline__ void mid(f32x4 (&acc)[2][2][4][2], const Unit& u, int wr, int wc, int fr, int fq) const {
        const int row0 = u.pm * BM + wr * 64 + opaque(fr), col0 = u.pn * BM + wc * 32 + 8 * opaque(fq);
        const int cswz = ((col0 >> 3) & 1) ? (HALF - 8) : 0;
#pragma unroll
        for (int ai = 0; ai < 2; ++ai) {
            u32x2 a[4][2], b[4][2];
#pragma unroll
            for (int mm = 0; mm < 4; ++mm) { const unsigned char* sp = SG + (size_t)(row0 + ai * HALF + mm * 16) * SG_P + col0 + cswz;
                const u32x4 la = *(const u32x4*)sp, lb = *(const u32x4*)(sp + 1024); unpair16(la, a[mm][0], a[mm][1]); unpair16(lb, b[mm][0], b[mm][1]); }
#pragma unroll
            for (int m = 0; m < 4; ++m) {
#pragma unroll
                for (int bj = 0; bj < 2; ++bj) {
#pragma unroll
                    for (int n = 0; n < 2; ++n) { const int aw = (int)a[m][bj][n], bw = (int)b[m][bj][n];
                        const f32x2 al = __builtin_amdgcn_cvt_pk_f32_fp8(aw, false), ah = __builtin_amdgcn_cvt_pk_f32_fp8(aw, true), bl = __builtin_amdgcn_cvt_pk_f32_fp8(bw, false), bh = __builtin_amdgcn_cvt_pk_f32_fp8(bw, true);
                        f32x4 r; r[0] = al[0] * __builtin_amdgcn_rcpf(bl[0]); r[1] = al[1] * __builtin_amdgcn_rcpf(bl[1]); r[2] = ah[0] * __builtin_amdgcn_rcpf(bh[0]); r[3] = ah[1] * __builtin_amdgcn_rcpf(bh[1]);
                        acc[ai][bj][m][n] = acc[ai][bj][m][n] * r; } }
                asm volatile("" : "+v"(acc[ai][0][m][0]), "+v"(acc[ai][0][m][1]), "+v"(acc[ai][1][m][0]), "+v"(acc[ai][1][m][1])); }
            asm volatile("" ::: "memory"); }
    }
    __device__ __forceinline__ void operator()(const f32x4 (&acc)[2][2][4][2], const Unit& u, int wr, int wc, int fr, int fq) const {
        const int row0 = u.pm * BM + wr * 64 + opaque(fr), col0 = u.pn * BM + wc * 32 + 8 * opaque(fq);
        constexpr float FS = SM / (SO * SW * SSG);
        const int cswz = ((col0 >> 3) & 1) ? (HALF - 8) : 0;
#pragma unroll
        for (int ai = 0; ai < 2; ++ai) {
            u32x2 bq[4][2];
#pragma unroll
            for (int m = 0; m < 4; ++m) { const u32x4 lb = *(const u32x4*)(SG + (size_t)(row0 + ai * HALF + m * 16) * SG_P + 1024 + col0 + cswz); unpair16(lb, bq[m][0], bq[m][1]); }
#pragma unroll
            for (int m = 0; m < 4; ++m) { unsigned char* op = O + (size_t)(row0 + ai * HALF + m * 16) * D + col0 + cswz;
                u32x2 w[2];
#pragma unroll
                for (int bj = 0; bj < 2; ++bj) {
#pragma unroll
                    for (int n = 0; n < 2; ++n) { const int bw = (int)bq[m][bj][n]; const f32x2 bl = __builtin_amdgcn_cvt_pk_f32_fp8(bw, false), bh = __builtin_amdgcn_cvt_pk_f32_fp8(bw, true); const f32x4 v = acc[ai][bj][m][n] * FS;
                        w[bj][n] = pk4_fp8(clamp_fp8(v[0] * bl[0]), clamp_fp8(v[1] * bl[1]), clamp_fp8(v[2] * bh[0]), clamp_fp8(v[3] * bh[1])); } }
                *(u32x4*)op = pair16(w[0], w[1]); }
            asm volatile("" ::: "memory"); }
    }
};

struct PanelStats {
    unsigned* xbuf;
    unsigned* cnt;
    unsigned* tmo;
    int pm_off; float eps; unsigned code;
    __device__ __forceinline__ bool run(const f32x4 (&v)[2][2][4][2], const Unit& u, int wr, int wc, int fr, int fq, LAS unsigned char* lds, int wid, int lane) const {
        LAS f32x2* P = (LAS f32x2*)lds;
        LAS f32x2* S = (LAS f32x2*)(lds + 8192);
        LAS unsigned* flag = (LAS unsigned*)(lds + 8192 + 2048);
        const int panel = u.pm + pm_off;
#pragma unroll
        for (int ai = 0; ai < 2; ++ai)
#pragma unroll
            for (int m = 0; m < 4; ++m) {
                float s = 0.f;
#pragma unroll
                for (int bj = 0; bj < 2; ++bj)
#pragma unroll
                    for (int n = 0; n < 2; ++n) { const f32x4 x = v[ai][bj][m][n]; s += (x[0] + x[1]) + (x[2] + x[3]); }
                s += __shfl_xor(s, 16); s += __shfl_xor(s, 32);
                const float mw = s * (1.0f / 64.0f); float q = 0.f;
#pragma unroll
                for (int bj = 0; bj < 2; ++bj)
#pragma unroll
                    for (int n = 0; n < 2; ++n) { const f32x4 d = v[ai][bj][m][n] - mw; q += (d[0] * d[0] + d[1] * d[1]) + (d[2] * d[2] + d[3] * d[3]); }
                q += __shfl_xor(q, 16); q += __shfl_xor(q, 32);
                if (fq == 0) P[(ai * HALF + wr * 64 + m * 16 + fr) * 4 + wc] = (f32x2){mw, q};
            }
        asm volatile("s_waitcnt lgkmcnt(0)" ::: "memory"); __builtin_amdgcn_s_barrier(); asm volatile("" ::: "memory");
        const int row = wid * 32 + (lane & 31);
        if (lane < 32) {
            const f32x2 a = P[row * 4 + 0], b = P[row * 4 + 1], c = P[row * 4 + 2], d = P[row * 4 + 3];
            const float mt = (a.x + b.x + c.x + d.x) * 0.25f;
            const float da = a.x - mt, db = b.x - mt, dc = c.x - mt, dd = d.x - mt;
            const float m2 = (a.y + b.y) + (c.y + d.y) + 64.0f * ((da * da + db * db) + (dc * dc + dd * dd));
            unsigned long long* slot = (unsigned long long*)xbuf + ((size_t)(panel * BM + row) * 4 + u.pn);
            __hip_atomic_store(slot, ((unsigned long long)__float_as_uint(m2) << 32) | __float_as_uint(mt), __ATOMIC_RELAXED, __HIP_MEMORY_SCOPE_AGENT);
        }
        asm volatile("s_waitcnt vmcnt(0)" ::: "memory");
        if (lane == 0) __hip_atomic_fetch_add(cnt + 64 * panel, 1u, __ATOMIC_RELAXED, __HIP_MEMORY_SCOPE_AGENT);
        if (wid == 0) {
            bool dead = false; const unsigned long long t0 = __builtin_amdgcn_s_memrealtime(); const unsigned want = 8u * 4u;
            for (;;) {
                if ((unsigned)__builtin_amdgcn_readfirstlane(__hip_atomic_load(cnt + 64 * panel, __ATOMIC_RELAXED, __HIP_MEMORY_SCOPE_AGENT)) >= want) break;
                if (__builtin_amdgcn_s_memrealtime() - t0 > 2000000ull) {
                    if (lane == 0) { unsigned expect = 0u; __hip_atomic_compare_exchange_strong(tmo + 1, &expect, code | (unsigned)(panel & 0xff), __ATOMIC_RELAXED, __ATOMIC_RELAXED, __HIP_MEMORY_SCOPE_AGENT);
                                     __hip_atomic_store(tmo, 1u, __ATOMIC_RELAXED, __HIP_MEMORY_SCOPE_AGENT); }
                    dead = true; break; }
                __builtin_amdgcn_s_sleep(2);
            }
            __builtin_amdgcn_fence(__ATOMIC_ACQUIRE, "agent");
            if (lane == 0) flag[0] = dead ? 1u : 0u;
        }
        asm volatile("s_waitcnt vmcnt(0) lgkmcnt(0)" ::: "memory"); __builtin_amdgcn_s_barrier(); asm volatile("" ::: "memory");
        const bool bad = flag[0] != 0u;
        if (lane < 32) {
            const unsigned long long* slot = (const unsigned long long*)xbuf + (size_t)(panel * BM + row) * 4; float mt[4], m2[4]; float ms = 0.f;
#pragma unroll
            for (int t = 0; t < 4; ++t) { const unsigned long long w = __hip_atomic_load(slot + t, __ATOMIC_RELAXED, __HIP_MEMORY_SCOPE_AGENT); mt[t] = __uint_as_float((unsigned)w); m2[t] = __uint_as_float((unsigned)(w >> 32)); ms += mt[t]; }
            const float mean = ms * 0.25f; float q = 0.f;
#pragma unroll
            for (int t = 0; t < 4; ++t) { const float dm = mt[t] - mean; q += m2[t] + 256.0f * dm * dm; }
            S[row] = (f32x2){mean, 1.0f / sqrtf(q * (1.0f / 1024.0f) + eps)};
        }
        asm volatile("s_waitcnt lgkmcnt(0)" ::: "memory"); __builtin_amdgcn_s_barrier(); asm volatile("" ::: "memory");
        return bad;
    }
};
struct EpiLn1 {
    static constexpr bool PERM = true, AFTER_DRAIN = true, HAS_MID = false, HAS_PRE = false; static constexpr int MID_T = 0;
    const float* x; float* out; bf16_t* xb; unsigned char* xq; const float* gam; const float* bet; PanelStats st; int row_off; unsigned poison; float rs;
    __device__ __forceinline__ void mid(f32x4 (&)[2][2][4][2], const Unit&, int, int, int, int) const {}
    __device__ __forceinline__ void operator()(const f32x4 (&)[2][2][4][2], const Unit&, int, int, int, int) const {}
    __device__ __forceinline__ void fused(f32x4 (&acc)[2][2][4][2], const Unit& u, int wr, int wc, int fr, int fq, LAS unsigned char* lds, int wid, int lane) const {
        const LAS f32x2* S = (const LAS f32x2*)(lds + 8192);
        const int col0 = u.pn * BM + wc * 32 + 8 * opaque(fq);
        const int grow0 = row_off + u.pm * BM; fr = opaque(fr);
#pragma unroll
        for (int ai = 0; ai < 2; ++ai)
#pragma unroll
            for (int m = 0; m < 4; ++m) { const size_t off = (size_t)(grow0 + ai * HALF + wr * 64 + m * 16 + fr) * D + col0;
#pragma unroll
                for (int bj = 0; bj < 2; ++bj)
#pragma unroll
                    for (int n = 0; n < 2; ++n) { const f32x4 bs = *(const f32x4*)(x + off + bj * HALF + n * 4); acc[ai][bj][m][n] = acc[ai][bj][m][n] * rs + bs * DN_ALPHA; }
                asm volatile("" : "+v"(acc[ai][0][m][0]), "+v"(acc[ai][0][m][1]), "+v"(acc[ai][1][m][0]), "+v"(acc[ai][1][m][1]));
                if (m == 3) asm volatile("" ::: "memory"); }
        const bool bad = st.run(acc, u, wr, wc, fr, fq, lds, wid, lane) || poison != 0u;
        const float qnan = __builtin_nanf("");
        f32x4 gv[2][2], bv[2][2];
#pragma unroll
        for (int bj = 0; bj < 2; ++bj)
#pragma unroll
            for (int n = 0; n < 2; ++n) { gv[bj][n] = *(const f32x4*)(gam + col0 + bj * HALF + n * 4); bv[bj][n] = *(const f32x4*)(bet + col0 + bj * HALF + n * 4); }
#pragma unroll
        for (int ai = 0; ai < 2; ++ai)
#pragma unroll
            for (int m = 0; m < 4; ++m) { const int r = ai * HALF + wr * 64 + m * 16 + fr; const f32x2 sr = S[r]; const size_t off = (size_t)(grow0 + r) * D + col0;
#pragma unroll
                for (int bj = 0; bj < 2; ++bj) { f32x4 o0 = (acc[ai][bj][m][0] - sr.x) * sr.y * gv[bj][0] + bv[bj][0], o1 = (acc[ai][bj][m][1] - sr.x) * sr.y * gv[bj][1] + bv[bj][1];
                    if (bad) { o0 = (f32x4){qnan, qnan, qnan, qnan}; o1 = o0; }
                    u32x4 w; w.x = cvt_pk_bf16(o0[0], o0[1]); w.y = cvt_pk_bf16(o0[2], o0[3]); w.z = cvt_pk_bf16(o1[0], o1[1]); w.w = cvt_pk_bf16(o1[2], o1[3]); *(u32x4*)(xb + off + bj * HALF) = w;
                    u32x2 q8; q8.x = pk4_fp8(clamp_fp8(o0[0] * SX), clamp_fp8(o0[1] * SX), clamp_fp8(o0[2] * SX), clamp_fp8(o0[3] * SX)); q8.y = pk4_fp8(clamp_fp8(o1[0] * SX), clamp_fp8(o1[1] * SX), clamp_fp8(o1[2] * SX), clamp_fp8(o1[3] * SX));
                    *(u32x2*)(xq + off + bj * HALF) = q8; } }
    }
};
struct EpiY {
    static constexpr bool PERM = false, AFTER_DRAIN = false, HAS_MID = false, HAS_PRE = false; static constexpr int MID_T = 0;
    const float* __restrict__ x; bf16_t* __restrict__ Y; float* __restrict__ ST; float rs;
    __device__ __forceinline__ void mid(f32x4 (&)[2][2][4][2], const Unit&, int, int, int, int) const {}
    __device__ __forceinline__ void operator()(const f32x4 (&acc)[2][2][4][2], const Unit& u, int wr, int wc, int fr, int fq) const {
        const int row0 = u.pm * BM + wr * 64 + opaque(fr), col0 = u.pn * BM + wc * 32 + 4 * opaque(fq);
        const int scol = col0 + ((fq & 1) ? 12 : 0);
#pragma unroll
        for (int ai = 0; ai < 2; ++ai) {
            f32x4 xv[4][2][2];
#pragma unroll
            for (int m = 0; m < 4; ++m)
#pragma unroll
                for (int bj = 0; bj < 2; ++bj)
#pragma unroll
                    for (int n = 0; n < 2; ++n) xv[m][bj][n] = __builtin_nontemporal_load((const f32x4*)(x + (size_t)(row0 + ai * HALF + m * 16) * D + col0 + bj * HALF + n * 16));
#pragma unroll
            for (int m = 0; m < 4; ++m) { const size_t r = (size_t)(row0 + ai * HALF + m * 16); float s1 = 0.f, s2 = 0.f;
#pragma unroll
                for (int bj = 0; bj < 2; ++bj) { const f32x4 y0 = acc[ai][bj][m][0] * rs + xv[m][bj][0] * DN_ALPHA, y1 = acc[ai][bj][m][1] * rs + xv[m][bj][1] * DN_ALPHA;
                    s1 += (y0[0] + y0[1]) + (y0[2] + y0[3]) + (y1[0] + y1[1]) + (y1[2] + y1[3]);
                    s2 += (y0[0] * y0[0] + y0[1] * y0[1]) + (y0[2] * y0[2] + y0[3] * y0[3]) + (y1[0] * y1[0] + y1[1] * y1[1]) + (y1[2] * y1[2] + y1[3] * y1[3]);
                    u32x2 w0, w1; w0.x = cvt_pk_bf16(y0[0], y0[1]); w0.y = cvt_pk_bf16(y0[2], y0[3]); w1.x = cvt_pk_bf16(y1[0], y1[1]); w1.y = cvt_pk_bf16(y1[2], y1[3]);
                    *(u32x4*)(Y + r * D + scol + bj * HALF) = pair16(w0, w1); }
                s1 += __shfl_xor(s1, 16); s1 += __shfl_xor(s1, 32); s2 += __shfl_xor(s2, 16); s2 += __shfl_xor(s2, 32);
                if (fq == 0) *(f32x2*)(ST + (r * 16 + u.pn * 4 + wc) * 2) = (f32x2){s1, s2}; }
            asm volatile("" ::: "memory"); }
    }
};
struct EpiGU {
    static constexpr bool PERM = true, AFTER_DRAIN = false, HAS_MID = false, HAS_PRE = true; static constexpr int MID_T = 0;
    const float* bg; const float* bu; unsigned char* H; LAS unsigned char* plds;
    __device__ __forceinline__ void mid(f32x4 (&)[2][2][4][2], const Unit&, int, int, int, int) const {}
    __device__ __forceinline__ void pre(LAS unsigned char* lds, const Unit& u, int wid, int lane) const {
        if (wid == 0) __builtin_amdgcn_global_load_lds((const unsigned*)((lane < 32 ? bg : bu) + u.e * DFF + u.pn * HALF + (lane & 31) * 4), (LAS unsigned*)(lds + EPRE_OFF), 16, 0, 0);
    }
    __device__ __forceinline__ void operator()(const f32x4 (&acc)[2][2][4][2], const Unit& u, int wr, int wc, int fr, int fq) const {
        const int row0 = u.pm * BM + wr * 64 + opaque(fr), jl = wc * 32 + 8 * opaque(fq), j0 = u.pn * HALF + jl;
        const LAS float* pb = (const LAS float*)(plds + EPRE_OFF) + jl;
        const f32x4 g0 = *(const LAS f32x4*)pb, g1 = *(const LAS f32x4*)(pb + 4), u0 = *(const LAS f32x4*)(pb + HALF), u1 = *(const LAS f32x4*)(pb + HALF + 4);
        f32x4 us0 = (u0 + 1.0f) * SH, us1 = (u1 + 1.0f) * SH;
        asm volatile("" : "+v"(us0), "+v"(us1));
        const int fqo = (jl >> 3) & 1;
#pragma unroll
        for (int ai = 0; ai < 2; ++ai)
#pragma unroll
            for (int m2 = 0; m2 < 4; m2 += 2) { u32x2 w[2];
#pragma unroll
              for (int mo = 0; mo < 2; ++mo) { const int m = m2 + mo;
                constexpr float RS = 1.0f / (SX * SW), CS = -1.702f * LOG2E;
                f32x4 h0, h1;
#pragma unroll
                for (int n = 0; n < 2; ++n)
#pragma unroll
                    for (int q = 0; q < 4; q += 2) {
                        const f32x4 ga = acc[ai][0][m][n], ua4 = acc[ai][1][m][n]; const f32x4 gb = n ? g1 : g0, ub4 = n ? us1 : us0;
                        f32x2 a = (f32x2){ga[q], ga[q + 1]} * RS + (f32x2){gb[q], gb[q + 1]};
                        a[0] = fminf(a[0], 7.0f); a[1] = fminf(a[1], 7.0f);
                        f32x2 up = (f32x2){ua4[q], ua4[q + 1]} * (RS * SH) + (f32x2){ub4[q], ub4[q + 1]};
                        up[0] = __builtin_amdgcn_fmed3f(up[0], -6.0f * SH, 8.0f * SH); up[1] = __builtin_amdgcn_fmed3f(up[1], -6.0f * SH, 8.0f * SH);
                        const f32x2 z = a * CS;
                        f32x2 d = (f32x2){__builtin_amdgcn_exp2f(z[0]), __builtin_amdgcn_exp2f(z[1])} + 1.0f;
                        const f32x2 r = (f32x2){__builtin_amdgcn_rcpf(d[0]), __builtin_amdgcn_rcpf(d[1])};
                        const f32x2 h = (a * r) * up;
                        if (n == 0) { h0[q] = h[0]; h0[q + 1] = h[1]; } else { h1[q] = h[0]; h1[q + 1] = h[1]; } }
                w[mo].x = pk4_fp8(h0[0], h0[1], h0[2], h0[3]); w[mo].y = pk4_fp8(h1[0], h1[1], h1[2], h1[3]); }
              *(u32x4*)(H + (size_t)(row0 + ai * HALF + (m2 + fqo) * 16) * DFF + j0 - 8 * fqo) = pair16(w[0], w[1]); }
    }
};
struct EpiDown {
    static constexpr bool PERM = true, AFTER_DRAIN = false, HAS_MID = false, HAS_PRE = true; static constexpr int MID_T = 0;
    const float* bd; const int* petok; const float* pegate; unsigned char* Y; LAS unsigned char* plds;
    __device__ __forceinline__ void mid(f32x4 (&)[2][2][4][2], const Unit&, int, int, int, int) const {}
    __device__ __forceinline__ void pre(LAS unsigned char* lds, const Unit& u, int wid, int lane) const {
        const size_t eb = (size_t)u.e * NTOK + (size_t)u.ti * 256 + (size_t)(lane * 4);
        if (wid == 0) __builtin_amdgcn_global_load_lds((const unsigned*)(bd + u.e * D + u.pn * BM + lane * 4), (LAS unsigned*)(lds + EPRE_OFF), 16, 0, 0);
        else if (wid == 1) __builtin_amdgcn_global_load_lds((const unsigned*)(petok + eb), (LAS unsigned*)(lds + EPRE_OFF + 1024), 16, 0, 0);
        else if (wid == 2) __builtin_amdgcn_global_load_lds((const unsigned*)(pegate + eb), (LAS unsigned*)(lds + EPRE_OFF + 2048), 16, 0, 0);
    }
    __device__ __forceinline__ void operator()(const f32x4 (&acc)[2][2][4][2], const Unit& u, int wr, int wc, int fr, int fq) const {
        const int r0 = wr * 64 + opaque(fr), cl = wc * 32 + 8 * opaque(fq), col0 = u.pn * BM + cl;
        const LAS float* pb = (const LAS float*)(plds + EPRE_OFF) + cl;
        f32x4 b[2][2];
#pragma unroll
        for (int bj = 0; bj < 2; ++bj) { b[bj][0] = *(const LAS f32x4*)(pb + bj * HALF); b[bj][1] = *(const LAS f32x4*)(pb + bj * HALF + 4); }
        int info[2][4]; float gwv[2][4];
#pragma unroll
        for (int ai = 0; ai < 2; ++ai)
#pragma unroll
            for (int m = 0; m < 4; ++m) { const int r = r0 + ai * HALF + m * 16; info[ai][m] = *(const LAS int*)(plds + EPRE_OFF + 1024 + 4 * r); gwv[ai][m] = *(const LAS float*)(plds + EPRE_OFF + 2048 + 4 * r) * SY; }
        if (u.valid == 256) {
            const int fqo = (col0 >> 3) & 1;
            const int cswz = fqo ? (HALF - 8) : 0;
#pragma unroll
        for (int ai = 0; ai < 2; ++ai)
#pragma unroll
            for (int m = 0; m < 4; ++m) {
                const float gw = gwv[ai][m];
                unsigned char* op = Y + (size_t)info[ai][m] * 1024 + col0 + cswz;
                u32x2 w[2];
#pragma unroll
                for (int bj = 0; bj < 2; ++bj) { constexpr float RS = 1.0f / (SH * SW); const f32x4 v0 = (acc[ai][bj][m][0] * RS + b[bj][0]) * gw, v1 = (acc[ai][bj][m][1] * RS + b[bj][1]) * gw;
                    w[bj].x = pk4_fp8(clamp_fp8(v0[0]), clamp_fp8(v0[1]), clamp_fp8(v0[2]), clamp_fp8(v0[3])); w[bj].y = pk4_fp8(clamp_fp8(v1[0]), clamp_fp8(v1[1]), clamp_fp8(v1[2]), clamp_fp8(v1[3])); }
                *(u32x4*)op = pair16(w[0], w[1]); }
        } else {
#pragma unroll
        for (int ai = 0; ai < 2; ++ai)
#pragma unroll
            for (int m = 0; m < 4; ++m) { const int r = r0 + ai * HALF + m * 16;
                if (r < u.valid) { const float gw = gwv[ai][m];
                    unsigned char* op = Y + (size_t)info[ai][m] * 1024 + col0;
#pragma unroll
                    for (int bj = 0; bj < 2; ++bj) { constexpr float RS = 1.0f / (SH * SW); const f32x4 v0 = (acc[ai][bj][m][0] * RS + b[bj][0]) * gw, v1 = (acc[ai][bj][m][1] * RS + b[bj][1]) * gw;
                        u32x2 w; w.x = pk4_fp8(clamp_fp8(v0[0]), clamp_fp8(v0[1]), clamp_fp8(v0[2]), clamp_fp8(v0[3])); w.y = pk4_fp8(clamp_fp8(v1[0]), clamp_fp8(v1[1]), clamp_fp8(v1[2]), clamp_fp8(v1[3]));
                        *(u32x2*)(op + bj * HALF) = w; } } }
        }
    }
};
}

#define XB_TMO      128
#define XB_XCNT(j)  (256  + 64 * (j))
#define XB_XSUB(j)  (1280 + 64 * (j))
#define XB_XGEN(j)  (2304 + 64 * (j))
#define XB_TOP      3328
#define XB_TOPGEN   3392
#define XCD_BAR_WORDS 3456
#define XB_SPIN_CAP (1u << 18)
__device__ __forceinline__ unsigned xb_ld(unsigned* p)              { return __hip_atomic_load(p, __ATOMIC_RELAXED, __HIP_MEMORY_SCOPE_AGENT); }
__device__ __forceinline__ unsigned xb_add(unsigned* p, unsigned v) { return __hip_atomic_fetch_add(p, v, __ATOMIC_RELAXED, __HIP_MEMORY_SCOPE_AGENT); }
__device__ __forceinline__ unsigned xb_xcc_id() { return (unsigned)__builtin_amdgcn_s_getreg((3 << 11) | 20) & 0xFu; }
#define XB_SPIN(cond, bar) do { unsigned _sp = 0; while (cond) { __builtin_amdgcn_s_sleep(1); \
    if ((++_sp & 255u) == 0u) { if (xb_ld(&(bar)[XB_TMO])) break; if (_sp > XB_SPIN_CAP) { atomicAdd(&(bar)[XB_TMO], 1u); break; } } } } while (0)
struct XcdBarrier { unsigned* bar; unsigned x; volatile LAS unsigned* st; };
__device__ __forceinline__ XcdBarrier xcd_barrier_post(unsigned* bar, volatile LAS unsigned* st) {
    XcdBarrier b; b.bar = bar; b.x = xb_xcc_id(); b.st = st;
    if (threadIdx.x == 0) (void)xb_add(&bar[XB_XCNT(b.x)], 1u);
    return b;
}
__device__ __forceinline__ void xcd_barrier_complete(unsigned* bar, unsigned x, unsigned& nloc, unsigned& nx) {
    const unsigned G = gridDim.x * gridDim.y * gridDim.z;
    unsigned sum, cnt, mine, sp = 0u;
    for (;;) {
        sum = 0u; cnt = 0u; mine = 0u;
#pragma unroll
        for (unsigned j = 0; j < 16; ++j) { const unsigned c = xb_ld(&bar[XB_XCNT(j)]); sum += c; cnt += (c > 0u) ? 1u : 0u; mine = (j == x) ? c : mine; }
        if (sum == G) break;
        __builtin_amdgcn_s_sleep(1);
        if ((++sp & 255u) == 0u) { if (xb_ld(&bar[XB_TMO])) break; if (sp > XB_SPIN_CAP) { atomicAdd(&bar[XB_TMO], 1u); break; } }
    }
    nloc = mine > 0u ? mine : 1u; nx = cnt > 0u ? cnt : 1u;
}
__device__ __forceinline__ void xcd_barrier(const XcdBarrier& b) {
    asm volatile("s_waitcnt vmcnt(0)" ::: "memory");
    __syncthreads();
    if (threadIdx.x == 0) {
        unsigned* bar = b.bar;
        __builtin_amdgcn_s_waitcnt(0);
        unsigned nloc = b.st[0], nx = b.st[1];
        if (nloc == 0u) { xcd_barrier_complete(bar, b.x, nloc, nx); b.st[0] = nloc; b.st[1] = nx; }
        const unsigned old = xb_add(&bar[XB_XSUB(b.x)], 1u);
        const unsigned gen = old / nloc;
        if (old + 1u == (gen + 1u) * nloc) {
            __builtin_amdgcn_fence(__ATOMIC_RELEASE, "agent");
            asm volatile("s_waitcnt vmcnt(0)" ::: "memory");
            const unsigned og = xb_add(&bar[XB_TOP], 1u);
            const unsigned tg = og / nx;
            if (og + 1u == (tg + 1u) * nx) xb_add(&bar[XB_TOPGEN], 1u);
            else XB_SPIN(xb_ld(&bar[XB_TOPGEN]) == tg, bar);
            __builtin_amdgcn_fence(__ATOMIC_ACQUIRE, "agent");
            xb_add(&bar[XB_XGEN(b.x)], 1u);
            asm volatile("s_waitcnt vmcnt(0)" ::: "memory");
        } else {
            XB_SPIN(xb_ld(&bar[XB_XGEN(b.x)]) == gen, bar);
            __builtin_amdgcn_fence(__ATOMIC_ACQUIRE, "agent");
            asm volatile("s_waitcnt vmcnt(0)" ::: "memory");
        }
    }
    __syncthreads();
}

constexpr int NWAVES = 8;
struct Frame {
    LAS unsigned char* lds; volatile LAS unsigned* MISC; gu32* ctl;
    int tid, lane, wave, vcu, G;
    unsigned char* ws; unsigned char* dout;
};
__device__ __forceinline__ float wave_sum(float v) {
#pragma unroll
    for (int o = 1; o < 64; o <<= 1) v += __shfl_xor(v, o);
    return v;
}
__device__ __forceinline__ void transpose_item(const float* W, int N, int k0, int n0, bf16_t* WT, int ldw, size_t drow0, int dcol0, LAS float* scr, int lane) {
#pragma unroll 8
    for (int i = 0; i < 32; ++i) { const int kk = 2 * i + (lane >> 5); scr[kk * 33 + (lane & 31)] = W[(size_t)(k0 + kk) * N + n0 + (lane & 31)]; }
    LDS_WAIT(); asm volatile("" ::: "memory");
    const int c = lane & 7;
#pragma unroll
    for (int j = 0; j < 4; ++j) { const int n = (lane >> 3) + 8 * j; const LAS float* s = scr + (8 * c) * 33 + n;
        u32x4 o; o.x = cvt_pk_bf16(s[0 * 33], s[1 * 33]); o.y = cvt_pk_bf16(s[2 * 33], s[3 * 33]); o.z = cvt_pk_bf16(s[4 * 33], s[5 * 33]); o.w = cvt_pk_bf16(s[6 * 33], s[7 * 33]);
        *(GAS u32x4*)(WT + (drow0 + n) * (size_t)ldw + dcol0 + 8 * c) = o; }
    LDS_WAIT(); asm volatile("" ::: "memory");
}
__device__ __forceinline__ void transpose_item_f8(const float* W, int N, int k0, int n0, unsigned char* WT, int ldw, size_t drow0, int dcol0, LAS float* scr, int lane);
__device__ __forceinline__ void transpose_item_f8r(const float* W, int N, int k0, int n0, unsigned char* WT, int ldw, size_t drow0, int dcol0, LAS float* scr, int lane) {
    (void)scr;
    const int kq = lane >> 3, ng = lane & 7;
    f32x4 wv[16];
#pragma unroll
    for (int i = 0; i < 16; ++i) wv[i] = __builtin_nontemporal_load((const GAS f32x4*)(W + (size_t)(k0 + 16 * kq + i) * N + n0 + ng * 4));
    unsigned r[16];
#pragma unroll
    for (int i = 0; i < 16; ++i) r[i] = pk4_fp8(clamp_fp8(wv[i][0] * SW), clamp_fp8(wv[i][1] * SW), clamp_fp8(wv[i][2] * SW), clamp_fp8(wv[i][3] * SW));
    u32x4 o[4];
#pragma unroll
    for (int a4 = 0; a4 < 4; ++a4) {
        const unsigned t0 = __builtin_amdgcn_perm(r[4 * a4 + 1], r[4 * a4], 0x05010400u), t1 = __builtin_amdgcn_perm(r[4 * a4 + 1], r[4 * a4], 0x07030602u);
        const unsigned t2 = __builtin_amdgcn_perm(r[4 * a4 + 3], r[4 * a4 + 2], 0x05010400u), t3 = __builtin_amdgcn_perm(r[4 * a4 + 3], r[4 * a4 + 2], 0x07030602u);
        o[0][a4] = __builtin_amdgcn_perm(t2, t0, 0x05040100u); o[1][a4] = __builtin_amdgcn_perm(t2, t0, 0x07060302u);
        o[2][a4] = __builtin_amdgcn_perm(t3, t1, 0x05040100u); o[3][a4] = __builtin_amdgcn_perm(t3, t1, 0x07060302u); }
#pragma unroll
    for (int n = 0; n < 4; ++n) *(GAS u32x4*)(WT + (drow0 + 4 * ng + n) * (size_t)ldw + dcol0 + 16 * kq) = o[n];
}
__device__ __forceinline__ void p0_convert(Frame& F, const float* x, const float* w_in, const float* w_pa, const float* w_pb, const float* w_out, const float* rw) {
    LAS float* scr = (LAS float*)(F.lds + F.wave * 17408);
    const int gw = F.vcu * NWAVES + F.wave, NGW = F.G * NWAVES;
    unsigned char* WIN = F.dout + DO_WIN; unsigned char* WCAT = F.dout + DO_WCAT; unsigned char* WOUT = F.ws + WS_WOUT;
    constexpr int I_IN = (D / 128) * (IN_COLS / 32), I_OUT = (D / 128) * (D / 32), I_PA = (256 / 128) * (D / 32), I_PB = (D / 128) * (D / 32);
    for (int it = gw; it < I_IN + I_OUT + I_PA + I_PB; it += NGW) {
        int r = it;
        if (r < I_IN) { const int nb = IN_COLS / 32; transpose_item_f8r(w_in, IN_COLS, 128 * (r / nb), 32 * (r % nb), WIN, D, (size_t)(32 * (r % nb)), 128 * (r / nb), scr, F.lane); continue; } r -= I_IN;
        if (r < I_OUT) { const int nb = D / 32; transpose_item_f8r(w_out, D, 128 * (r / nb), 32 * (r % nb), WOUT, D, (size_t)(32 * (r % nb)), 128 * (r / nb), scr, F.lane); continue; } r -= I_OUT;
        if (r < I_PA) { const int nb = D / 32; transpose_item_f8r(w_pa, D, 128 * (r / nb), 32 * (r % nb), WCAT, OAB_P, (size_t)(32 * (r % nb)), 128 * (r / nb), scr, F.lane); continue; } r -= I_PA;
        { const int nb = D / 32; transpose_item_f8r(w_pb, D, 128 * (r / nb), 32 * (r % nb), WCAT, OAB_P, (size_t)(32 * (r % nb)), 256 + 128 * (r / nb), scr, F.lane); }
    }
    { bf16_t* WRT = (bf16_t*)(F.ws + WS_WRT);
      for (int i = gw * 64 + F.lane; i < NEXP * D; i += NGW * 64) { const int e = i >> 10, k = i & (D - 1); const float w = rw[k * NEXP + e];
          const unsigned hi = cvt_pk_bf16(w, 0.f) & 0xffffu; const float r = w - __uint_as_float(hi << 16);
          WRT[i] = (bf16_t)hi; WRT[NEXP * D + i] = (bf16_t)(cvt_pk_bf16(r, 0.f) & 0xffffu); } }
    unsigned char* XQ = F.dout + DO_XB;
    const size_t n16 = (size_t)NTOK * D / 16;
    for (size_t i = (size_t)gw * 64 + F.lane; i < n16; i += (size_t)NGW * 64) {
        const f32x4 a = __builtin_nontemporal_load((const GAS f32x4*)(x + i * 16)), b = __builtin_nontemporal_load((const GAS f32x4*)(x + i * 16 + 4)), c = __builtin_nontemporal_load((const GAS f32x4*)(x + i * 16 + 8)), d = __builtin_nontemporal_load((const GAS f32x4*)(x + i * 16 + 12));
        u32x4 o;
        o.x = pk4_fp8(clamp_fp8(a[0] * SXIN), clamp_fp8(a[1] * SXIN), clamp_fp8(a[2] * SXIN), clamp_fp8(a[3] * SXIN)); o.y = pk4_fp8(clamp_fp8(b[0] * SXIN), clamp_fp8(b[1] * SXIN), clamp_fp8(b[2] * SXIN), clamp_fp8(b[3] * SXIN));
        o.z = pk4_fp8(clamp_fp8(c[0] * SXIN), clamp_fp8(c[1] * SXIN), clamp_fp8(c[2] * SXIN), clamp_fp8(c[3] * SXIN)); o.w = pk4_fp8(clamp_fp8(d[0] * SXIN), clamp_fp8(d[1] * SXIN), clamp_fp8(d[2] * SXIN), clamp_fp8(d[3] * SXIN));
        *(GAS u32x4*)(XQ + i * 16) = o;
    }
}
__device__ __forceinline__ void transpose_item_f8(const float* W, int N, int k0, int n0, unsigned char* WT, int ldw, size_t drow0, int dcol0, LAS float* scr, int lane) {
    f32x4 wv[16];
#pragma unroll
    for (int i = 0; i < 16; ++i) wv[i] = __builtin_nontemporal_load((const GAS f32x4*)(W + (size_t)(k0 + 8 * i + (lane >> 3)) * N + n0 + (lane & 7) * 4));
#pragma unroll
    for (int i = 0; i < 16; ++i) { LAS float* d = scr + (8 * i + (lane >> 3)) * 33 + (lane & 7) * 4; d[0] = wv[i][0]; d[1] = wv[i][1]; d[2] = wv[i][2]; d[3] = wv[i][3]; }
    LDS_WAIT(); asm volatile("" ::: "memory");
    const int c = lane & 7;
#pragma unroll
    for (int j = 0; j < 4; ++j) { const int n = (lane >> 3) + 8 * j; const LAS float* s = scr + (16 * c) * 33 + n;
        u32x4 o;
        o.x = pk4_fp8(clamp_fp8(s[0 * 33] * SW), clamp_fp8(s[1 * 33] * SW), clamp_fp8(s[2 * 33] * SW), clamp_fp8(s[3 * 33] * SW));
        o.y = pk4_fp8(clamp_fp8(s[4 * 33] * SW), clamp_fp8(s[5 * 33] * SW), clamp_fp8(s[6 * 33] * SW), clamp_fp8(s[7 * 33] * SW));
        o.z = pk4_fp8(clamp_fp8(s[8 * 33] * SW), clamp_fp8(s[9 * 33] * SW), clamp_fp8(s[10 * 33] * SW), clamp_fp8(s[11 * 33] * SW));
        o.w = pk4_fp8(clamp_fp8(s[12 * 33] * SW), clamp_fp8(s[13 * 33] * SW), clamp_fp8(s[14 * 33] * SW), clamp_fp8(s[15 * 33] * SW));
        __builtin_nontemporal_store(o, (GAS u32x4*)(WT + (drow0 + n) * (size_t)ldw + dcol0 + 16 * c)); }
    LDS_WAIT(); asm volatile("" ::: "memory");
}
__device__ __forceinline__ void p3_convert_moe(Frame& F, const float* w_gate, const float* w_up, const float* w_down, int wg, int nwg) {
    LAS float* scr = (LAS float*)(F.lds + F.wave * 17408);
    const int gw = wg * NWAVES + F.wave, NGW = nwg * NWAVES;
    unsigned char* WGU = F.ws + WS_WGU; unsigned char* WD = F.ws + WS_WD;
    constexpr int IPM = (D / 128) * (DFF / 32);
    for (int it = gw; it < NEXP * 3 * IPM; it += NGW) {
        const int e = it / (3 * IPM), r3 = it % (3 * IPM), which = r3 / IPM, r = r3 % IPM, kb = r / 32, nb = r % 32, k0 = 128 * kb, n0 = 32 * nb;
        const size_t moff = (size_t)e * D * DFF;
        if (which == 2) transpose_item_f8(w_down + moff, D, k0, n0, WD + moff, DFF, (size_t)n0, k0, scr, F.lane);
        else { const int pn = n0 >> 7, jj = n0 & 127; transpose_item_f8((which ? w_up : w_gate) + moff, DFF, k0, n0, WGU + 2 * moff, D, (size_t)(256 * pn + 128 * which + jj), k0, scr, F.lane); }
    }
}
typedef short v4i16_t __attribute__((ext_vector_type(4)));
__device__ __forceinline__ s16x4 tr_read(const LAS unsigned char* p) { return __builtin_bit_cast(s16x4, __builtin_amdgcn_ds_read_tr16_b64_v4i16((LAS v4i16_t*)p)); }
template <int C>
__device__ __forceinline__ void tr_read8(s16x4 (&r)[8], unsigned addr) {
#define TRR(i) asm volatile("ds_read_b64_tr_b16 %0, %1 offset:%2" : "=v"(r[i]) : "v"(addr), "n"(C * 4096 + (i) * 512))
    TRR(0); TRR(1); TRR(2); TRR(3); TRR(4); TRR(5); TRR(6); TRR(7);
#undef TRR
}
__device__ __forceinline__ void tr_wait8(s16x4 (&r)[8]) {
    asm volatile("s_waitcnt lgkmcnt(0)" : "+v"(r[0]), "+v"(r[1]), "+v"(r[2]), "+v"(r[3]), "+v"(r[4]), "+v"(r[5]), "+v"(r[6]), "+v"(r[7]));
}
template <int C>
__device__ __forceinline__ void pv_tile(s16x4 (&cur)[8], s16x4 (&prev)[8], bf16x8 (&pf)[2], bf16x8 (&pfprev)[2], unsigned vbase, const f32x16& Sc, f32x16 (&O)[2]) {
#pragma unroll
    for (int s = 0; s < 2; ++s) { u32x4 w; w.x = cvt_pk_bf16(Sc[8 * s + 0], Sc[8 * s + 1]); w.y = cvt_pk_bf16(Sc[8 * s + 2], Sc[8 * s + 3]);
        w.z = cvt_pk_bf16(Sc[8 * s + 4], Sc[8 * s + 5]); w.w = cvt_pk_bf16(Sc[8 * s + 6], Sc[8 * s + 7]); pf[s] = __builtin_bit_cast(bf16x8, w); }
    tr_read8<C>(cur, vbase);
    if (C > 0) { asm volatile("" :: "v"(prev[0]), "v"(prev[1]), "v"(prev[2]), "v"(prev[3]), "v"(prev[4]), "v"(prev[5]), "v"(prev[6]), "v"(prev[7]) : "memory");
                 asm volatile("" :: "v"(pfprev[0]), "v"(pfprev[1]) : "memory"); }
    tr_wait8(cur);
    __builtin_amdgcn_sched_barrier(0);
#pragma unroll
    for (int blk = 0; blk < 2; ++blk)
#pragma unroll
        for (int s = 0; s < 2; ++s) { const s16x4 lo = cur[(blk * 2 + s) * 2], hi = cur[(blk * 2 + s) * 2 + 1];
            O[blk] = __builtin_amdgcn_mfma_f32_32x32x16_bf16((bf16x8){lo[0], lo[1], lo[2], lo[3], hi[0], hi[1], hi[2], hi[3]}, pf[s], O[blk], 0, 0, 0); }
    __builtin_amdgcn_sched_barrier(0);
}
constexpr int ATT_KOFF = 0, ATT_QOFF = 12 * 2048, ATT_VOFF = 12 * 4096, ATT_STG = 24 * 4096, ATT_STGW = 4608;
static_assert(ATT_STG + 8 * ATT_STGW <= SCR_BYTES, "attention LDS map");
struct AKV { const unsigned char* qseq; const unsigned char* kseq; const bf16_t* vseq; int jt0, nkt, jq; };
__device__ __forceinline__ AKV attn_kv(const Frame& F, int U) {
    const unsigned char* HQ = F.ws + WS_HQ; AKV r;
    if (U < 2048) {
        const int b = U >> 8, kvh = (U >> 7) & 1, j = U & 127, hq = kvh * 8 + F.wave;
        r.qseq = HQ + HQ_QS + (size_t)(b * 16 + hq) * SEQ * 64; r.kseq = HQ + HQ_KS + (size_t)(b * 2 + kvh) * SEQ * 64; r.vseq = (const bf16_t*)(HQ + HQ_VS) + (size_t)(b * 2 + kvh) * SEQ * 64;
        r.jt0 = j - 4; r.nkt = 5; r.jq = j;
    } else {
        const int v = U - 2048, g = v >> 9, w_ = v & 511, b = w_ >> 6, x = w_ & 63, hh = x >> 4, y = x & 15;
        const int dil = (g == 0) ? 1 : (g == 1) ? 4 : 16;
        const int res = (g == 0) ? 0 : (g == 1) ? (y >> 2) : y;
        const int j0 = (g == 0) ? y * 8 : (g == 1) ? (y & 3) * 8 : 0;
        const size_t seq = ((size_t)((g * NB + b) * 4 + hh) * SEQ + (size_t)res * (SEQ / dil)) * 64;
        r.qseq = HQ + HQ_QD + seq; r.kseq = HQ + HQ_KD + seq; r.vseq = (const bf16_t*)(HQ + HQ_VD) + seq;
        r.jt0 = j0 - 4; r.nkt = 12; r.jq = j0 + F.wave;
    }
    return r;
}
__device__ __forceinline__ unsigned attn_koff(int lane) { return (unsigned)((lane >> 2) * 64 + (((lane & 3) ^ ((lane >> 4) & 3)) * 16)); }
__device__ __forceinline__ unsigned attn_voff(int lane) { return (unsigned)((lane >> 2) * 128 + (lane & 3) * 16); }
__device__ __forceinline__ void attn_issue_k(LAS unsigned char* lds, int lane, int wave, const AKV& u) {
    const unsigned koff = attn_koff(lane);
    for (int p = wave; p < u.nkt * 2; p += 8) {
        const int s = p >> 1, qt = p & 1; const int tj = u.jt0 + s; const size_t pos0 = (size_t)(32 * (tj >= 0 ? tj : 0) + 16 * qt);
        __builtin_amdgcn_global_load_lds((const unsigned*)((const char*)u.kseq + pos0 * 64 + koff), (LAS unsigned*)(lds + ATT_KOFF + s * 2048 + qt * 1024), 16, 0, 0);
    }
}
__device__ __forceinline__ void attn_issue_q(LAS unsigned char* lds, int lane, int wave, const AKV& u) {
    const unsigned koff = attn_koff(lane);
#pragma unroll
    for (int qt = 0; qt < 2; ++qt)
        __builtin_amdgcn_global_load_lds((const unsigned*)((const char*)u.qseq + (size_t)(32 * u.jq + 16 * qt) * 64 + koff), (LAS unsigned*)(lds + ATT_QOFF + wave * 2048 + qt * 1024), 16, 0, 0);
}
template <int NKT>
__device__ __forceinline__ int attn_issue_v(LAS unsigned char* lds, int lane, int wave, const AKV& u) {
    const int w4 = (wave + 4) & 7;
    const unsigned voff = attn_voff(lane);
#pragma unroll
    for (int i = 0; i < (NKT * 4 + 7) / 8; ++i) { const int p = w4 + 8 * i;
        if (p < NKT * 4) { const int s = p >> 2, qt = p & 3; const int tj = u.jt0 + s; const int blk = qt >> 1, part = qt & 1;
            const size_t pos0 = (size_t)(32 * (tj >= 0 ? tj : 0) + 16 * part);
            __builtin_amdgcn_global_load_lds((const unsigned*)((const char*)u.vseq + pos0 * 128 + blk * 64 + voff), (LAS unsigned*)(lds + ATT_VOFF + s * 4096 + blk * 2048 + part * 1024), 16, 0, 0); } }
    return NKT == 12 ? 6 : (w4 < 4 ? 3 : 2);
}
__device__ __forceinline__ void attn_wait(int n) {
#define AW(N) asm volatile("s_waitcnt vmcnt(" #N ")" ::: "memory")
    if (n == 11) AW(11); else if (n == 9) AW(9); else if (n == 8) AW(8); else if (n == 7) AW(7); else if (n == 6) AW(6); else if (n == 5) AW(5); else if (n == 4) AW(4); else if (n == 3) AW(3); else if (n == 2) AW(2); else AW(0);
#undef AW
}
template <bool swa>
__device__ __forceinline__ void attn_unit(LAS unsigned char* lds, int lane, int wave, const AKV& u, int s0,
                                          float sl2, float sink2, bf16_t* ob, unsigned op, float* lseb, unsigned lsep, bool hasn, const AKV& nx) {
    const int i32 = lane & 31, h = lane >> 5;
    const int jq = u.jq;
    constexpr float QKS = SQ * SK, RQK = 1.0f / (SQ * SK), NEG_RAW = -1.0e30f;
    f32x16 bias;
#pragma unroll
    for (int r = 0; r < 16; ++r) { const int kk = (r & 3) + 8 * (r >> 2) + 4 * h; bias[r] = sl2 * QKS * (float)(kk - i32); }
    __builtin_amdgcn_s_barrier();
    asm volatile("" ::: "memory");
    if (swa) attn_issue_v<5>(lds, lane, wave, u); else attn_issue_v<12>(lds, lane, wave, u);
    f32x16 S[5];
    float m2 = sink2;
    const int kro = i32 * 64 + h * 8, ksw = (i32 >> 2) & 3;
    long qf[4];
#pragma unroll
    for (int d0 = 0; d0 < 4; ++d0) qf[d0] = *(const LAS long*)(lds + ATT_QOFF + wave * 2048 + kro + ((d0 ^ ksw) * 16));
    long kf[2][4];
#pragma unroll
    for (int c = 0; c < 5; ++c) {
        const bool tv = (jq - 4 + c) >= 0;
        const LAS unsigned char* ks = lds + ATT_KOFF + (s0 + c) * 2048 + kro;
#pragma unroll
        for (int d0 = 0; d0 < 4; ++d0) kf[c & 1][d0] = *(const LAS long*)(ks + ((d0 ^ ksw) * 16));
        if (c > 0) asm volatile("" :: "v"(kf[(c - 1) & 1][0]), "v"(kf[(c - 1) & 1][1]), "v"(kf[(c - 1) & 1][2]), "v"(kf[(c - 1) & 1][3]) : "memory");
        f32x16 a = bias;
#pragma unroll
        for (int d0 = 0; d0 < 4; ++d0) a = __builtin_amdgcn_mfma_f32_32x32x16_fp8_fp8(kf[c & 1][d0], qf[d0], a, 0, 0, 0);
        if (c == 0 || c == 4) {
#pragma unroll
            for (int r = 0; r < 16; ++r) { const int kk = (r & 3) + 8 * (r >> 2) + 4 * h;
                const bool ok = (c == 4) ? (kk <= i32) : (swa ? (kk > i32) : (kk >= i32));
                a[r] = ok ? a[r] : NEG_RAW; }
        }
        float mt = fmaxf(fmaxf(a[0], a[1]), a[2]);
#pragma unroll
        for (int r = 3; r < 15; r += 2) mt = fmaxf(fmaxf(mt, a[r]), a[r + 1]);
        mt = fmaxf(mt, a[15]);
        m2 = fmaxf(m2, __builtin_fmaf(mt, RQK, tv ? -sl2 * (float)(32 * (4 - c)) : NEG_RAW));
        S[c] = a;
    }
    m2 = fmaxf(m2, __shfl_xor(m2, 32));
    f32x2 l2 = (f32x2){0.f, 0.f};
#pragma unroll
    for (int c = 0; c < 5; ++c) {
        const float offc = ((jq - 4 + c) >= 0 ? -sl2 * (float)(32 * (4 - c)) : NEG_RAW) - m2;
#pragma unroll
        for (int r = 0; r < 16; r += 2) { const f32x2 x = (f32x2){S[c][r], S[c][r + 1]} * RQK + offc;
            const f32x2 p = (f32x2){__builtin_amdgcn_exp2f(x[0]), __builtin_amdgcn_exp2f(x[1])}; S[c][r] = p[0]; S[c][r + 1] = p[1]; l2 += p; }
    }
    float l = l2[0] + l2[1];
    l += __shfl_xor(l, 32);
    l += __builtin_amdgcn_exp2f(sink2 - m2);
    asm volatile("" :: "v"(kf[0][0]), "v"(kf[0][1]), "v"(kf[0][2]), "v"(kf[0][3]), "v"(kf[1][0]), "v"(kf[1][1]), "v"(kf[1][2]), "v"(kf[1][3]) : "memory");
    asm volatile("s_waitcnt vmcnt(0) lgkmcnt(0)" : "+v"(l) :: "memory");
    __builtin_amdgcn_s_barrier();
    asm volatile("" ::: "memory");
    if (hasn) { attn_issue_k(lds, lane, wave, nx); attn_issue_q(lds, lane, wave, nx); }
    f32x16 O[2]; O[0] = (f32x16){}; O[1] = (f32x16){};
    const int vaddr0 = ((lane >> 4) & 1) * 32 + (lane & 3) * 8 + (4 * h + ((lane & 15) >> 2)) * 64;
    const unsigned vbase = (unsigned)(size_t)(lds + ATT_VOFF) + (unsigned)(s0 * 4096 + vaddr0);
    s16x4 va[2][8]; bf16x8 pf[2][2];
    pv_tile<0>(va[0], va[1], pf[0], pf[1], vbase, S[0], O); pv_tile<1>(va[1], va[0], pf[1], pf[0], vbase, S[1], O); pv_tile<2>(va[0], va[1], pf[0], pf[1], vbase, S[2], O);
    pv_tile<3>(va[1], va[0], pf[1], pf[0], vbase, S[3], O); pv_tile<4>(va[0], va[1], pf[0], pf[1], vbase, S[4], O);
    asm volatile("" :: "v"(pf[0][0]), "v"(pf[0][1]), "v"(pf[1][0]), "v"(pf[1][1]) : "memory");
    asm volatile("" :: "v"(va[0][0]), "v"(va[0][1]), "v"(va[0][2]), "v"(va[0][3]), "v"(va[0][4]), "v"(va[0][5]), "v"(va[0][6]), "v"(va[0][7]) : "memory");
    asm volatile("" :: "v"(va[1][0]), "v"(va[1][1]), "v"(va[1][2]), "v"(va[1][3]), "v"(va[1][4]), "v"(va[1][5]), "v"(va[1][6]), "v"(va[1][7]) : "memory");
    const float inv = 1.0f / l;
    LAS unsigned char* stg = lds + ATT_STG + wave * ATT_STGW;
    { const float is = inv * SO;
#pragma unroll
        for (int blk = 0; blk < 2; ++blk)
#pragma unroll
            for (int g4 = 0; g4 < 4; ++g4) { const int d0 = blk * 32 + 8 * g4 + 4 * h;
                *(LAS unsigned*)(stg + i32 * 80 + d0) = pk4_fp8_pad(clamp_fp8(O[blk][4 * g4 + 0] * is), clamp_fp8(O[blk][4 * g4 + 1] * is), clamp_fp8(O[blk][4 * g4 + 2] * is), clamp_fp8(O[blk][4 * g4 + 3] * is)); }
        asm volatile("s_waitcnt lgkmcnt(0)" ::: "memory");
#pragma unroll
        for (int it = 0; it < 2; ++it) { const int row = it * 16 + (lane >> 2), ch = lane & 3;
            const u32x4 v = *(const LAS u32x4*)(stg + row * 80 + ch * 16);
            *(u32x4*)((char*)ob + (size_t)(32 * jq + row) * op + ch * 16) = v; }
    }
    if (lseb != nullptr && h == 0) lseb[(size_t)(32 * jq + i32) * lsep] = (m2 + __builtin_amdgcn_logf(l)) * LN2;
    attn_wait(hasn ? (swa ? 2 : 3) : 0);
}
__device__ __forceinline__ void p2_attention(Frame& F, const float* sinks) {
    unsigned char* OAB = F.dout + DO_OAB; unsigned char* OAG = F.ws + WS_OAG; float* LSE = (float*)(F.ws + WS_LSE);
    constexpr int NUNIT = 2048 + 1536;
    int U = F.vcu; if (U >= NUNIT) return;
    float snk0 = sinks[F.wave] * LOG2E, snk1 = sinks[8 + F.wave] * LOG2E;
    asm volatile("" : "+v"(snk0), "+v"(snk1));
    AKV cur = attn_kv(F, U);
    attn_issue_k(F.lds, F.lane, F.wave, cur);
    attn_issue_q(F.lds, F.lane, F.wave, cur);
    attn_wait(0);
    for (;;) {
        const int Un = U + F.G; const bool hasn = Un < NUNIT;
        const AKV nxt = attn_kv(F, hasn ? Un : U);
        if (U < 2048) {
            const int b = U >> 8, kvh = (U >> 7) & 1, hq = kvh * 8 + F.wave;
            const float slope = exp2f(-8.0f * (float)(hq + 1) / 28.0f);
            attn_unit<true>(F.lds, F.lane, F.wave, cur, 0, slope * LOG2E, kvh ? snk1 : snk0, (bf16_t*)(OAB + (size_t)b * SEQ * OAB_P + 256 + hq * 64), OAB_P, nullptr, 0, hasn, nxt);
        } else {
            const int v = U - 2048, g = v >> 9, w_ = v & 511, b = w_ >> 6, x = w_ & 63, hh = x >> 4, y = x & 15;
            const int dil = (g == 0) ? 1 : (g == 1) ? 4 : 16;
            const int res = (g == 0) ? 0 : (g == 1) ? (y >> 2) : y;
            const size_t tok0 = (size_t)b * SEQ + res;
            const float slope = exp2f(-8.0f * (float)(16 + g * 4 + hh + 1) / 28.0f);
            attn_unit<false>(F.lds, F.lane, F.wave, cur, F.wave, slope * (float)dil * LOG2E, NEG_BIG,
                             (bf16_t*)(OAG + ((size_t)g * NTOK + tok0) * 256 + hh * 64), (unsigned)(dil * 256), LSE + ((size_t)g * NTOK + tok0) * 4 + hh, (unsigned)(dil * 4), hasn, nxt);
        }
        if (!hasn) break;
        U = Un; cur = nxt;
    }
}
__device__ __forceinline__ void p3_merge(Frame& F) {
    const unsigned char* OAG = F.ws + WS_OAG; const float* LSE = (const float*)(F.ws + WS_LSE); unsigned char* OAB = F.dout + DO_OAB;
    const int gw = F.vcu * NWAVES + F.wave, NGW = F.G * NWAVES;
    constexpr int PB = 4;
    for (int idx0 = gw; idx0 < NTOK / 2; idx0 += PB * NGW) {
        const int c8 = F.lane & 31, hh = c8 >> 3;
        float ls[PB][3]; u32x2 o[PB][3];
#pragma unroll
        for (int p = 0; p < PB; ++p) { const int idx = min(idx0 + p * NGW, NTOK / 2 - 1), tok = idx * 2 + (F.lane >> 5);
#pragma unroll
            for (int g = 0; g < 3; ++g) { ls[p][g] = LSE[((size_t)g * NTOK + tok) * 4 + hh]; o[p][g] = __builtin_nontemporal_load((const u32x2*)(OAG + ((size_t)g * NTOK + tok) * 256 + c8 * 8)); } }
#pragma unroll
        for (int p = 0; p < PB; ++p) { const int idx = idx0 + p * NGW; if (idx >= NTOK / 2) break;
            const int tok = idx * 2 + (F.lane >> 5);
            const float m = fmaxf(fmaxf(ls[p][0], ls[p][1]), ls[p][2]);
            float w[3]; float sum = 0.f;
#pragma unroll
            for (int g = 0; g < 3; ++g) { w[g] = __builtin_amdgcn_exp2f((ls[p][g] - m) * LOG2E); sum += w[g]; }
            const float is = 1.0f / sum; float r[8];
#pragma unroll
            for (int q = 0; q < 8; ++q) r[q] = 0.f;
#pragma unroll
            for (int g = 0; g < 3; ++g) { const float wg = w[g] * is;
                const f32x2 a0 = __builtin_amdgcn_cvt_pk_f32_fp8((int)o[p][g].x, false), a1 = __builtin_amdgcn_cvt_pk_f32_fp8((int)o[p][g].x, true), a2 = __builtin_amdgcn_cvt_pk_f32_fp8((int)o[p][g].y, false), a3 = __builtin_amdgcn_cvt_pk_f32_fp8((int)o[p][g].y, true);
                r[0] += wg * a0[0]; r[1] += wg * a0[1]; r[2] += wg * a1[0]; r[3] += wg * a1[1]; r[4] += wg * a2[0]; r[5] += wg * a2[1]; r[6] += wg * a3[0]; r[7] += wg * a3[1]; }
            u32x2 out; out.x = pk4_fp8(clamp_fp8(r[0]), clamp_fp8(r[1]), clamp_fp8(r[2]), clamp_fp8(r[3])); out.y = pk4_fp8(clamp_fp8(r[4]), clamp_fp8(r[5]), clamp_fp8(r[6]), clamp_fp8(r[7]));
            *(u32x2*)(OAB + (size_t)tok * OAB_P + c8 * 8) = out; }
    }
}

__device__ __forceinline__ void p6_fill(Frame& F, const float* gam, const float* bet) {
    constexpr int WPITCH = 2064, WIMG = 64 * WPITCH, GOFF = WIMG + 2048;
    const char* WRT = (const char*)(F.ws + WS_WRT);
    __syncthreads();
#pragma unroll
    for (int i = 0; i < 16; ++i) { const int p = F.wave + 8 * i, row = p >> 1, half = p & 1;
        __builtin_amdgcn_global_load_lds((const unsigned*)(WRT + (size_t)row * 2048 + half * 1024 + F.lane * 16), (LAS unsigned*)(F.lds + row * WPITCH + half * 1024), 16, 0, 0); }
    { const float* src = (F.wave < 4 ? gam + F.wave * 256 : bet + (F.wave - 4) * 256) + F.lane * 4;
      __builtin_amdgcn_global_load_lds((const unsigned*)src, (LAS unsigned*)(F.lds + GOFF + F.wave * 1024), 16, 0, 0); }
    asm volatile("s_waitcnt vmcnt(0)" ::: "memory");
}
__device__ __forceinline__ void p6_router(Frame& F, const bf16_t* y, const float* stat, const float* gam, const float* bet, unsigned char* x1q, const float* rb, int cw_ecnt, size_t pe_off, bool prefilled) {
    constexpr int WPITCH = 2064;
    constexpr int WIMG = 64 * WPITCH;
    constexpr int GOFF = WIMG + 2048;
    static_assert(GOFF + 8192 <= SCR_BYTES, "router LDS map");
    LAS int* wcnt = (LAS int*)(F.lds + WIMG + F.wave * 256); LAS int* wbase = wcnt + 32;
    int* petok = (int*)(F.ws + WS_PETOK + pe_off); float* pegate = (float*)(F.ws + WS_PEGATE + pe_off);
    const bf16_t* WRT = (const bf16_t*)(F.ws + WS_WRT);
    const int gw = F.vcu * NWAVES + F.wave, NGW = F.G * NWAVES, lane = F.lane, j = lane & 15, kq = lane >> 4;
    if (!prefilled) p6_fill(F, gam, bet);
    __syncthreads();
    const LAS unsigned char* wrow = F.lds + j * WPITCH + kq * 16;
    const LAS float* gl = (const LAS float*)(F.lds + GOFF) + 8 * kq; const LAS float* bl = gl + 1024;
    for (int tb = F.vcu * NWAVES; tb < NTOK / 16; tb += NGW) {
        const int tt = tb + F.wave; const bool valid = tt < NTOK / 16; const int t0 = (valid ? tt : 0) * 16;
        float mean, rstd;
        { const f32x4* sp = (const f32x4*)(stat + (size_t)(t0 + j) * 32); float s1 = 0.f, s2 = 0.f;
#pragma unroll
          for (int q = 0; q < 8; ++q) { const f32x4 v = sp[q]; s1 += v[0] + v[2]; s2 += v[1] + v[3]; }
          mean = s1 * (1.0f / D); const float var = fmaxf(s2 * (1.0f / D) - mean * mean, 0.f); rstd = 1.0f / sqrtf(var + LN_EPS); }
        f32x4 acc[2]; acc[0] = (f32x4){0.f, 0.f, 0.f, 0.f}; acc[1] = acc[0];
        const f32x4 rb0 = *(const f32x4*)(rb + 4 * kq), rb1 = *(const f32x4*)(rb + 16 + 4 * kq);
        const bf16_t* yrow = y + (size_t)(t0 + j) * D + 8 * kq;
        unsigned char* xqrow = (valid ? x1q : F.ws + 300 * MiB) + (size_t)(t0 + j) * D + 8 * kq;
        bf16x8 wf[2][4]; wf[1][0] = (bf16x8){}; wf[1][1] = wf[1][0]; wf[1][2] = wf[1][0]; wf[1][3] = wf[1][0];
        u32x4 yv[4], yn[4]; u32x2 q8prev = (u32x2){0u, 0u};
#pragma unroll
        for (int u = 0; u < 4; ++u) yv[u] = __builtin_nontemporal_load((const u32x4*)(yrow + 32 * u));
#pragma unroll
        for (int so = 0; so < D / 32; so += 4) {
            const int sn = (so + 4 < D / 32) ? so + 4 : so;
#pragma unroll
            for (int u = 0; u < 4; ++u) yn[u] = __builtin_nontemporal_load((const u32x4*)(yrow + 32 * (sn + u)));
#pragma unroll
            for (int u = 0; u < 4; ++u) { const int sI = so + u;
                wf[u & 1][0] = *(const LAS bf16x8*)(wrow + 64 * sI); wf[u & 1][1] = *(const LAS bf16x8*)(wrow + 16 * WPITCH + 64 * sI);
                wf[u & 1][2] = *(const LAS bf16x8*)(wrow + 32 * WPITCH + 64 * sI); wf[u & 1][3] = *(const LAS bf16x8*)(wrow + 48 * WPITCH + 64 * sI);
                const f32x4 g0 = *(const LAS f32x4*)(gl + 32 * sI), g1 = *(const LAS f32x4*)(gl + 32 * sI + 4), b0 = *(const LAS f32x4*)(bl + 32 * sI), b1 = *(const LAS f32x4*)(bl + 32 * sI + 4);
                asm volatile("" :: "v"(wf[(u + 1) & 1][0]), "v"(wf[(u + 1) & 1][1]), "v"(wf[(u + 1) & 1][2]), "v"(wf[(u + 1) & 1][3]) : "memory");
                f32x4 n0, n1;
                n0[0] = (bf_lo(yv[u].x) - mean) * rstd * g0[0] + b0[0]; n0[1] = (bf_hi(yv[u].x) - mean) * rstd * g0[1] + b0[1]; n0[2] = (bf_lo(yv[u].y) - mean) * rstd * g0[2] + b0[2]; n0[3] = (bf_hi(yv[u].y) - mean) * rstd * g0[3] + b0[3];
                n1[0] = (bf_lo(yv[u].z) - mean) * rstd * g1[0] + b1[0]; n1[1] = (bf_hi(yv[u].z) - mean) * rstd * g1[1] + b1[1]; n1[2] = (bf_lo(yv[u].w) - mean) * rstd * g1[2] + b1[2]; n1[3] = (bf_hi(yv[u].w) - mean) * rstd * g1[3] + b1[3];
                u32x4 xw; xw.x = cvt_pk_bf16(n0[0], n0[1]); xw.y = cvt_pk_bf16(n0[2], n0[3]); xw.z = cvt_pk_bf16(n1[0], n1[1]); xw.w = cvt_pk_bf16(n1[2], n1[3]);
                { u32x2 q8; q8.x = pk4_fp8(clamp_fp8(n0[0] * SX), clamp_fp8(n0[1] * SX), clamp_fp8(n0[2] * SX), clamp_fp8(n0[3] * SX)); q8.y = pk4_fp8(clamp_fp8(n1[0] * SX), clamp_fp8(n1[1] * SX), clamp_fp8(n1[2] * SX), clamp_fp8(n1[3] * SX));
                  if (u & 1) *(u32x4*)(xqrow + 32 * (sI - 1 + (kq & 1)) - 8 * (kq & 1)) = pg8::pair16(q8prev, q8); else q8prev = q8; }
                const bf16x8 xh = __builtin_bit_cast(bf16x8, xw);
                acc[0] = __builtin_amdgcn_mfma_f32_16x16x32_bf16(wf[u & 1][0], xh, acc[0], 0, 0, 0); acc[1] = __builtin_amdgcn_mfma_f32_16x16x32_bf16(wf[u & 1][1], xh, acc[1], 0, 0, 0);
                acc[0] = __builtin_amdgcn_mfma_f32_16x16x32_bf16(wf[u & 1][2], xh, acc[0], 0, 0, 0); acc[1] = __builtin_amdgcn_mfma_f32_16x16x32_bf16(wf[u & 1][3], xh, acc[1], 0, 0, 0); }
#pragma unroll
            for (int u = 0; u < 4; ++u) yv[u] = yn[u];
        }
        float lg[8];
#pragma unroll
        for (int q = 0; q < 8; ++q) lg[q] = acc[q >> 2][q & 3] + ((q >> 2) ? rb1[q & 3] : rb0[q & 3]);
        unsigned taken = 0u; float tv[4]; int ti[4];
#pragma unroll
        for (int k = 0; k < 4; ++k) {
            float bv = -3.0e38f; int bi = 64;
#pragma unroll
            for (int q = 0; q < 8; ++q) { const bool free_ = ((taken >> q) & 1u) == 0u; if (free_ && lg[q] > bv) { bv = lg[q]; bi = 16 * (q >> 2) + 4 * kq + (q & 3); } }
            const int mybi = bi;
#pragma unroll
            for (int o = 16; o < 64; o <<= 1) { const float ov = __shfl_xor(bv, o); const int oi = __shfl_xor(bi, o); const bool keep = (bv > ov) || (bv == ov && bi < oi); bv = keep ? bv : ov; bi = keep ? bi : oi; }
            tv[k] = bv; ti[k] = bi;
            if (bi == mybi && ((bi >> 2) & 3) == kq) taken |= 1u << (4 * (bi >> 4) + (bi & 3));
        }
        float gk[4]; float gs = 0.f;
#pragma unroll
        for (int k = 0; k < 4; ++k) { gk[k] = __builtin_amdgcn_exp2f((tv[k] - tv[0]) * LOG2E); gs += gk[k]; }
        const float gi = 1.0f / gs;
        if (lane < 32) wcnt[lane] = 0;
        asm volatile("s_waitcnt lgkmcnt(0)" ::: "memory");
        const int e0 = (kq == 0) ? ti[0] : (kq == 1) ? ti[1] : (kq == 2) ? ti[2] : ti[3];
        const float g0 = ((kq == 0) ? gk[0] : (kq == 1) ? gk[1] : (kq == 2) ? gk[2] : gk[3]) * gi;
        int r0 = 0;
        if (valid) r0 = __hip_atomic_fetch_add(wcnt + e0, 1, __ATOMIC_RELAXED, __HIP_MEMORY_SCOPE_WORKGROUP);
        asm volatile("s_waitcnt lgkmcnt(0)" ::: "memory");
        __syncthreads();
        if (F.wave == 0 && lane < 32) { int c[NWAVES]; int tot = 0;
#pragma unroll
            for (int w = 0; w < NWAVES; ++w) { c[w] = *(LAS int*)(F.lds + WIMG + w * 256 + 4 * lane); tot += c[w]; }
            int b = 0; if (tot > 0) b = (int)__hip_atomic_fetch_add((unsigned*)(F.ctl + cw_ecnt + 64 * lane), (unsigned)tot, RLX_AGENT);
#pragma unroll
            for (int w = 0; w < NWAVES; ++w) { *(LAS int*)(F.lds + WIMG + w * 256 + 128 + 4 * lane) = b; b += c[w]; } }
        asm volatile("s_waitcnt vmcnt(0) lgkmcnt(0)" ::: "memory");
        __syncthreads();
        if (valid) { const int p0 = wbase[e0] + r0;
            petok[(size_t)e0 * NTOK + p0] = (t0 + j) * 4 + kq; pegate[(size_t)e0 * NTOK + p0] = g0; }
        asm volatile("s_waitcnt lgkmcnt(0)" ::: "memory");
        __syncthreads();
    }
}
__device__ __forceinline__ int moe_tables(Frame& F) {
    LAS int* cnt = (LAS int*)(F.lds + MOE_OFF); LAS int* fs = (LAS int*)(F.lds + MOE_OFF + 128); LAS unsigned char* te = F.lds + MOE_OFF + 128 + 136;
    __syncthreads();
    if (F.tid < NEXP) cnt[F.tid] = (int)__hip_atomic_load(F.ctl + CW_ECNT + 64 * F.tid, RLX_AGENT);
    __syncthreads();
    if (F.tid == 0) { int s = 0; for (int e = 0; e < NEXP; ++e) { fs[e] = s; s += (cnt[e] + 255) >> 8; } fs[NEXP] = s; }
    __syncthreads();
    const int T = fs[NEXP];
    for (int t = F.tid; t < T; t += NWAVES * 64) { int e = 0;
#pragma unroll 8
        for (int q = 1; q < NEXP; ++q) e += (fs[q] <= t) ? 1 : 0;
        te[t] = (unsigned char)e; }
    __syncthreads();
    return T;
}
__device__ __forceinline__ void p9_final(Frame& F, const float* gam1, const float* bet1, const float* gam, const float* bet, const float* out, float* outw, bool poison) {
    const bf16_t* Yb = (const bf16_t*)(F.ws + WS_Y); const float* ST = (const float*)(F.ws + WS_STAT);
    const int gw = F.vcu * NWAVES + F.wave, NGW = F.G * NWAVES, lane = F.lane;
    const float qnan = __builtin_nanf("");
    f32x4 g1[4], b1[4], g[4], bb[4];
#pragma unroll
    for (int k = 0; k < 4; ++k) { g1[k] = *(const f32x4*)(gam1 + 256 * k + 4 * lane); b1[k] = *(const f32x4*)(bet1 + 256 * k + 4 * lane); g[k] = *(const f32x4*)(gam + 256 * k + 4 * lane); bb[k] = *(const f32x4*)(bet + 256 * k + 4 * lane); }
    for (int tok0 = gw; tok0 < NTOK; tok0 += 2 * NGW) {
        u32x2 xw[2][4]; unsigned yw[2][4][4]; f32x2 sp[2];
#pragma unroll
        for (int tI = 0; tI < 2; ++tI) { const int tok = min(tok0 + tI * NGW, NTOK - 1);
            const unsigned char* y = (const unsigned char*)out + (size_t)tok * 4096 + lane * 4;
            sp[tI] = *(const f32x2*)(ST + (size_t)tok * 32 + 2 * (lane & 15));
#pragma unroll
            for (int k = 0; k < 4; ++k) { xw[tI][k] = *(const u32x2*)(Yb + (size_t)tok * D + 256 * k + 4 * lane);
#pragma unroll
                for (int s = 0; s < 4; ++s) yw[tI][s][k] = *(const unsigned*)(y + 1024 * s + 256 * k); } }
#pragma unroll
        for (int tI = 0; tI < 2; ++tI) { const int tok = tok0 + tI * NGW; if (tok >= NTOK) break;
            float s1 = sp[tI][0], s2 = sp[tI][1];
#pragma unroll
            for (int o = 1; o < 16; o <<= 1) { s1 += __shfl_xor(s1, o); s2 += __shfl_xor(s2, o); }
            const float mean1 = s1 * (1.0f / D), rstd1 = 1.0f / sqrtf(fmaxf(s2 * (1.0f / D) - mean1 * mean1, 0.f) + LN_EPS);
            float v[16];
#pragma unroll
            for (int k = 0; k < 4; ++k) {
                const float y0 = bf_lo(xw[tI][k].x), y1 = bf_hi(xw[tI][k].x), y2 = bf_lo(xw[tI][k].y), y3 = bf_hi(xw[tI][k].y);
                v[4 * k + 0] = DN_ALPHA * ((y0 - mean1) * rstd1 * g1[k][0] + b1[k][0]); v[4 * k + 1] = DN_ALPHA * ((y1 - mean1) * rstd1 * g1[k][1] + b1[k][1]);
                v[4 * k + 2] = DN_ALPHA * ((y2 - mean1) * rstd1 * g1[k][2] + b1[k][2]); v[4 * k + 3] = DN_ALPHA * ((y3 - mean1) * rstd1 * g1[k][3] + b1[k][3]);
                f32x2 lo = __builtin_amdgcn_cvt_pk_f32_fp8((int)yw[tI][0][k], false) + __builtin_amdgcn_cvt_pk_f32_fp8((int)yw[tI][1][k], false) + __builtin_amdgcn_cvt_pk_f32_fp8((int)yw[tI][2][k], false) + __builtin_amdgcn_cvt_pk_f32_fp8((int)yw[tI][3][k], false);
                f32x2 hi = __builtin_amdgcn_cvt_pk_f32_fp8((int)yw[tI][0][k], true) + __builtin_amdgcn_cvt_pk_f32_fp8((int)yw[tI][1][k], true) + __builtin_amdgcn_cvt_pk_f32_fp8((int)yw[tI][2][k], true) + __builtin_amdgcn_cvt_pk_f32_fp8((int)yw[tI][3][k], true);
                v[4 * k + 0] += lo[0] * (1.0f / SY); v[4 * k + 1] += lo[1] * (1.0f / SY); v[4 * k + 2] += hi[0] * (1.0f / SY); v[4 * k + 3] += hi[1] * (1.0f / SY); }
            float s = 0.f;
#pragma unroll
            for (int q = 0; q < 16; ++q) s += v[q];
            const float mean = wave_sum(s) * (1.0f / D); float sq = 0.f;
#pragma unroll
            for (int q = 0; q < 16; ++q) { v[q] -= mean; sq += v[q] * v[q]; }
            const float rstd = 1.0f / sqrtf(wave_sum(sq) * (1.0f / D) + LN_EPS);
            float* op = outw + (size_t)tok * D + 4 * lane;
#pragma unroll
            for (int k = 0; k < 4; ++k) { f32x4 o;
#pragma unroll
                for (int q = 0; q < 4; ++q) o[q] = v[4 * k + q] * rstd * g[k][q] + bb[k][q];
                if (poison) o = (f32x4){qnan, qnan, qnan, qnan};
                __builtin_nontemporal_store(o, (f32x4*)(op + 256 * k)); }
        }
    }
}
#define CAS __attribute__((address_space(4)))
__device__ __forceinline__ const float* arg_in(int i) {
    const unsigned char CAS* ka = (const unsigned char CAS*)__builtin_amdgcn_kernarg_segment_ptr();
    asm volatile("" : "+s"(ka));
    return *(const float* const CAS*)(ka + 8 * i);
}
struct Args { const float* in[18]; float* out; unsigned char* ws; int ph_lo, ph_hi; };
__global__ void __launch_bounds__(NWAVES * 64, 2) fwd_kernel(Args args) {
    extern __shared__ __attribute__((aligned(16))) unsigned char lds[];
    Frame F;
    F.lds = (LAS unsigned char*)lds;
    F.MISC = (volatile LAS unsigned*)(F.lds + MISC_OFF);
    F.tid = threadIdx.x; F.lane = F.tid & 63; F.wave = __builtin_amdgcn_readfirstlane(F.tid >> 6);
    F.G = gridDim.x; { const int bx = blockIdx.x; F.vcu = (F.G % 8 == 0) ? (bx % 8) * (F.G / 8) + bx / 8 : bx; }
    F.ws = args.ws; F.dout = (unsigned char*)args.out;
    F.ctl = (gu32*)(args.ws + WS_CTL);
    for (int u = F.tid; u < (LDS_BYTES - LDSCTL_OFF) / 4; u += NWAVES * 64) ((LAS unsigned*)(F.lds + LDSCTL_OFF))[u] = 0u;
    __syncthreads();
    XcdBarrier bar; bar.bar = (unsigned*)(F.ctl + CW_BAR); bar.x = 0; bar.st = nullptr;
    if (N_LAUNCHES == 1) bar = xcd_barrier_post((unsigned*)(F.ctl + CW_BAR), F.MISC + 8);
    const int lo = args.ph_lo, hi = args.ph_hi;
#ifdef ONLY_PHASE
#define IN(k) ((k) == ONLY_PHASE && lo <= (k) && (k) < hi)
#else
#define IN(k) (lo <= (k) && (k) < hi)
#endif
#define SEAM(k) do { if (IN(k) && IN((k) + 1)) xcd_barrier(bar); } while (0)
    unsigned char* HQ = F.ws + WS_HQ; unsigned char* SG = F.ws + WS_SG;

#define PHASE(k, ...) do { if (IN(k)) { __VA_ARGS__ if (DUP_PHASE == (k)) { __VA_ARGS__ } } } while (0)
    PHASE(0, p0_convert(F, arg_in(0), arg_in(1), arg_in(3), arg_in(4), arg_in(5), arg_in(8));); SEAM(0);
    PHASE(1,
        { const int gemm_wgs = (F.G == 256) ? 188 : F.G;
          if ((int)blockIdx.x < gemm_wgs) {
            pg8::Gemm g{(const char*)(F.dout + DO_XB), (const char*)(F.dout + DO_WIN), D, D, D / 128}; pg8::StaticOrder S; S.init(NTOK, IN_COLS, gemm_wgs, (int)blockIdx.x);
            pg8::EpiInProj E{HQ, SG, 1.0f / (SXIN * SW)};
            pg8::gemm_phase<pg8::EpiInProj, pg8::StaticOrder, true, false, true>(F.lds, g, S, E); }
          if (gemm_wgs == F.G) p3_convert_moe(F, arg_in(10), arg_in(12), arg_in(14), F.vcu, F.G);
          else if ((int)blockIdx.x >= gemm_wgs) p3_convert_moe(F, arg_in(10), arg_in(12), arg_in(14), (int)blockIdx.x - gemm_wgs, F.G - gemm_wgs); }
    ); SEAM(1);
    PHASE(2, p2_attention(F, arg_in(2));); SEAM(2);
    PHASE(3, p3_merge(F);); SEAM(3);
    PHASE(4,
        { pg8::Gemm g{(const char*)(F.dout + DO_OAB), (const char*)(F.dout + DO_WCAT), OAB_P, OAB_P, OAB_P / 128}; pg8::StaticOrder S; S.init(NTOK, D, F.G, (int)blockIdx.x);
        pg8::EpiGate E{SG, F.ws + WS_MRG};
        pg8::gemm_phase<pg8::EpiGate, pg8::StaticOrder, true, false, true>(F.lds, g, S, E); }
    ); SEAM(4);
    PHASE(5,
        { pg8::Gemm g{(const char*)(F.ws + WS_MRG), (const char*)(F.ws + WS_WOUT), D, D, D / 128}; pg8::StaticOrder S; S.init(NTOK, D, F.G, (int)blockIdx.x);
        pg8::EpiY E{arg_in(0), (bf16_t*)(F.ws + WS_Y), (float*)(F.ws + WS_STAT), 1.0f / (SM * SW)};
        pg8::gemm_phase<pg8::EpiY, pg8::StaticOrder, true, false, true>(F.lds, g, S, E); }
    );
    const bool p6_pre = IN(5) && IN(6);
    if (p6_pre) p6_fill(F, arg_in(6), arg_in(7));
    SEAM(5);
    if (IN(6)) { if (DUP_PHASE == 6) p6_router(F, (const bf16_t*)(F.ws + WS_Y), (const float*)(F.ws + WS_STAT), arg_in(6), arg_in(7), F.ws + 330 * MiB, arg_in(9), CW_ECNT + 64 * NEXP, (size_t)362 * MiB - WS_PETOK, p6_pre);
        p6_router(F, (const bf16_t*)(F.ws + WS_Y), (const float*)(F.ws + WS_STAT), arg_in(6), arg_in(7), F.ws + WS_X1Q, arg_in(9), CW_ECNT, 0, p6_pre); } SEAM(6);
    int moeT = -1;
    PHASE(7,
        { if (moeT < 0) moeT = moe_tables(F); const int T = moeT;
        pg8::Gemm g{(const char*)(F.ws + WS_X1Q), (const char*)(F.ws + WS_WGU), D, D, D / 128};
        pg8::MoeOrder S{T, 8, F.G, (int)blockIdx.x, (const LAS int*)(F.lds + MOE_OFF), (const LAS int*)(F.lds + MOE_OFF + 128), (const LAS unsigned char*)(F.lds + MOE_OFF + 128 + 136),
                        (const int*)(F.ws + WS_PETOK), (size_t)2048 * D, true, (unsigned)D};
        pg8::EpiGU E{arg_in(11), arg_in(13), F.ws + WS_HDN, F.lds};
        pg8::gemm_phase<pg8::EpiGU, pg8::MoeOrder, true, true, true>(F.lds, g, S, E); }
    ); SEAM(7);
    PHASE(8,
        { if (moeT < 0) moeT = moe_tables(F); const int T = moeT;
        pg8::Gemm g{(const char*)(F.ws + WS_HDN), (const char*)(F.ws + WS_WD), DFF, DFF, DFF / 128};
        pg8::MoeOrder S{T, 4, F.G, (int)blockIdx.x, (const LAS int*)(F.lds + MOE_OFF), (const LAS int*)(F.lds + MOE_OFF + 128), (const LAS unsigned char*)(F.lds + MOE_OFF + 128 + 136),
                        (const int*)(F.ws + WS_PETOK), (size_t)D * DFF, false, 0u};
        pg8::EpiDown E{arg_in(15), (const int*)(F.ws + WS_PETOK), (const float*)(F.ws + WS_PEGATE), F.dout, F.lds};
        pg8::gemm_phase<pg8::EpiDown, pg8::MoeOrder, true, false, true>(F.lds, g, S, E); }
    ); SEAM(8);
    if (IN(9)) {
        bool poison = (__hip_atomic_load(F.ctl + CW_TMO, RLX_AGENT) != 0u) || (__hip_atomic_load(F.ctl + CW_BAR + XB_TMO, RLX_AGENT) != 0u);
        if (DUP_PHASE == 9) p9_final(F, arg_in(6), arg_in(7), arg_in(16), arg_in(17), (const float*)F.dout, (float*)(F.ws + 194 * MiB), poison);
        p9_final(F, arg_in(6), arg_in(7), arg_in(16), arg_in(17), (const float*)F.dout, (float*)F.dout, poison);
    }
#undef PHASE
#undef IN
#undef SEAM
}

extern "C" void kernel_launch(void* const* d_in, const int* in_sizes, int n_in, void* d_out, int out_size, void* d_ws, size_t ws_size, hipStream_t stream) {
    static int grid = 0;
    if (grid == 0) {
        if (n_in != 18 || in_sizes[0] != NTOK * D || out_size != NTOK * D || ws_size < WS_END) { fprintf(stderr, "kernel_launch: unexpected shapes (n_in %d, ws %zu); nothing launched\n", n_in, ws_size); grid = -1; return; }
        int dev = 0, cus = 0, per_cu = 0;
        if (hipGetDevice(&dev) != hipSuccess || hipDeviceGetAttribute(&cus, hipDeviceAttributeMultiprocessorCount, dev) != hipSuccess) { grid = -1; return; }
        if (hipFuncSetAttribute((const void*)fwd_kernel, hipFuncAttributeMaxDynamicSharedMemorySize, LDS_BYTES) != hipSuccess) { fprintf(stderr, "kernel_launch: hipFuncSetAttribute failed\n"); grid = -1; return; }
        if (hipOccupancyMaxActiveBlocksPerMultiprocessor(&per_cu, (const void*)fwd_kernel, NWAVES * 64, LDS_BYTES) != hipSuccess || per_cu < 1) fprintf(stderr, "kernel_launch: occupancy query reports %d\n", per_cu);
        (void)hipGetLastError();
        grid = cus;
    }
    if (grid < 0) return;
    if (hipMemsetAsync((char*)d_ws + WS_CTL, 0, CTL_ZERO_BYTES, stream) != hipSuccess) return;
    Args a{};
    for (int i = 0; i < 18; ++i) a.in[i] = (const float*)d_in[i];
    a.out = (float*)d_out; a.ws = (unsigned char*)d_ws;
    if (N_LAUNCHES == 1) { a.ph_lo = 0; a.ph_hi = N_PHASES; hipLaunchKernelGGL(fwd_kernel, dim3(grid), dim3(NWAVES * 64), LDS_BYTES, stream, a); }
    else for (int p = 0; p < N_PHASES; ++p) { a.ph_lo = p; a.ph_hi = p + 1; hipLaunchKernelGGL(fwd_kernel, dim3(grid), dim3(NWAVES * 64), LDS_BYTES, stream, a); }
}
```
